# Optimizing an MI355X kernel written in HIP

```python
import jax
import jax.numpy as jnp
from jax import lax

D_MODEL = 1024
BATCH = 32
SEQ = 256
DEPTH = 4
DEC_BATCH = 8
DEC_SEQ = 4096
PAST_LEN = 512

GRID_W = 64
HEAD_DIM = 64
A_HEADS = 8
A_KV_HEADS = 2
A_GROUPS = A_HEADS // A_KV_HEADS
A_WIDTH = A_HEADS * HEAD_DIM
B_HEADS = 8
B_NOPE = 64
B_ROPE = 32
B_VDIM = 64
B_KV_RANK = 128
B_WIDTH = B_HEADS * B_VDIM
C_HEADS = 8
C_WIDTH = C_HEADS * HEAD_DIM
C_DECAY_LORA = 64
C_AAA_LORA = 64
C_SHIFT_DIM = 3 * C_WIDTH + 2 * C_DECAY_LORA + 2 * C_AAA_LORA
N_BRANCHES = 3
IN_SPLITS = (A_WIDTH, A_KV_HEADS * HEAD_DIM, A_KV_HEADS * HEAD_DIM, A_WIDTH,
             B_HEADS * (B_NOPE + B_ROPE), B_KV_RANK, B_ROPE, B_WIDTH,
             C_SHIFT_DIM, C_WIDTH, N_BRANCHES * D_MODEL)
IN_DIM = sum(IN_SPLITS)
Q_BLOCK = 128
ROPE_THETA = 10000.0
NORM_EPS = 1e-6
C_GN_EPS = 64e-5

kernel_name = 'bidir_hybrid_flow_trunk_step'


def _rmsnorm(x, w):
    xf = x.astype(jnp.float32)
    y = xf * lax.rsqrt(jnp.mean(xf * xf, axis=-1, keepdims=True) + NORM_EPS)
    return (y * w.astype(jnp.float32)).astype(x.dtype)


def _split_in(u):
    idx = []
    acc = 0
    for s in IN_SPLITS[:-1]:
        acc += s
        idx.append(acc)
    return jnp.split(u, idx, axis=-1)


def _modulation(cond, w, b):
    m = jax.nn.silu(cond) @ w + b
    return jnp.split(m, 3, axis=-1)


def _grid_positions(n_tokens):
    rows = n_tokens // GRID_W
    row = jnp.repeat(jnp.arange(rows, dtype=jnp.int32), GRID_W)
    col = jnp.tile(jnp.arange(GRID_W, dtype=jnp.int32), rows)
    return row, col


def _rope_1d(x, pos):
    half = x.shape[-1] // 2
    inv = ROPE_THETA ** (-jnp.arange(half, dtype=jnp.float32) / half)
    ang = pos.astype(jnp.float32)[:, None] * inv[None, :]
    cos = jnp.cos(ang)[:, None, :]
    sin = jnp.sin(ang)[:, None, :]
    xf = x.astype(jnp.float32)
    x1, x2 = xf[..., :half], xf[..., half:]
    out = jnp.concatenate([x1 * cos - x2 * sin, x2 * cos + x1 * sin], axis=-1)
    return out.astype(x.dtype)


def _rope_2d(x, row, col):
    half = x.shape[-1] // 2
    return jnp.concatenate([_rope_1d(x[..., :half], row), _rope_1d(x[..., half:], col)], axis=-1)


def _block_attention(q, k, v):
    bsz, sq = q.shape[0], q.shape[1]
    n_blocks = sq // Q_BLOCK
    scale = q.shape[-1] ** -0.5
    qb = jnp.swapaxes(q.reshape((bsz, n_blocks, Q_BLOCK) + q.shape[2:]), 0, 1)

    def one_block(q_blk):
        s = jnp.einsum('bqkgd,bskd->bkgqs', q_blk, k, preferred_element_type=jnp.float32) * scale
        p = jax.nn.softmax(s, axis=-1)
        return jnp.einsum('bkgqs,bskd->bqkgd', p.astype(v.dtype), v)

    o = lax.map(one_block, qb)
    return jnp.swapaxes(o, 0, 1).reshape(bsz, sq, -1)


def _shift_centered(s, mu_prev, mu_next):
    prev = jnp.pad(s[:, :-1], ((0, 0), (1, 0), (0, 0)))
    nxt = jnp.pad(s[:, 1:], ((0, 0), (0, 1), (0, 0)))
    return s + mu_prev * (prev - s) + mu_next * (nxt - s)


def _wkv_scan(s0, r, w, k, v, a_vec, b_vec, reverse):
    xs = tuple(jnp.moveaxis(t, 1, 0) for t in (r, w, k, v, a_vec, b_vec))

    def step(state, inp):
        r_t, w_t, k_t, v_t, a_t, b_t = inp
        sa = jnp.einsum('bhij,bhj->bhi', state, a_t)
        state = (state * w_t[:, :, None, :] + sa[..., None] * b_t[:, :, None, :]
                 + v_t[..., None] * k_t[:, :, None, :])
        y_t = jnp.einsum('bhij,bhj->bhi', state, r_t)
        return state, y_t

    s_fin, ys = lax.scan(step, s0, xs, reverse=reverse)
    return s_fin, jnp.moveaxis(ys, 0, 1)


def _branch_c(c_in, s0_f, s0_b, lp):
    f32 = jnp.float32
    bsz, t = c_in.shape[:2]
    x = _shift_centered(c_in, lp['c_mu_prev'], lp['c_mu_next']).astype(f32)
    wdt = C_WIDTH
    r = x[..., :wdt]
    k = x[..., wdt:2 * wdt]
    v = x[..., 2 * wdt:3 * wdt]
    wd = x[..., 3 * wdt:3 * wdt + 2 * C_DECAY_LORA].reshape(bsz, t, 2, C_DECAY_LORA)
    ad = x[..., 3 * wdt + 2 * C_DECAY_LORA:].reshape(bsz, t, 2, C_AAA_LORA)

    def hd(z):
        return z.reshape(bsz, t, C_HEADS, HEAD_DIM)

    w0 = lp['c_w0'].astype(f32)
    w_up = lp['c_w_up'].astype(f32)
    a0 = lp['c_a0'].astype(f32)
    a_up = lp['c_a_up'].astype(f32)
    k_a = lp['c_k_a'].astype(f32)
    r_k = lp['c_r_k'].astype(f32)
    rh, vh = hd(r), hd(v)
    kk = hd(k * lp['c_k_k'].astype(f32))
    kk = kk / jnp.maximum(jnp.sqrt(jnp.sum(kk * kk, axis=-1, keepdims=True)), 1e-12)
    ys, bonuses, finals = [], [], []
    for d, s0 in ((0, s0_f), (1, s0_b)):
        w_raw = w0[d] + jnp.tanh(wd[:, :, d]) @ w_up[d]
        decay = jnp.exp(-jnp.exp(-jax.nn.softplus(-w_raw) - 0.5))
        a = jax.nn.sigmoid(a0[d] + ad[:, :, d] @ a_up[d])
        k_d = hd(k * (1.0 + (a - 1.0) * k_a))
        s_fin, y_d = _wkv_scan(s0.astype(f32), rh, hd(decay), k_d, vh, -kk, kk * hd(a), reverse=(d == 1))
        ys.append(y_d)
        bonuses.append(jnp.sum(rh * k_d * r_k, axis=-1, keepdims=True) * vh)
        finals.append(s_fin)
    y = ys[0] + ys[1]
    mu = jnp.mean(y, axis=-1, keepdims=True)
    var = jnp.mean(jnp.square(y - mu), axis=-1, keepdims=True)
    yn = ((y - mu) * lax.rsqrt(var + C_GN_EPS)).reshape(bsz, t, wdt)
    yn = yn * lp['c_lnx_w'].astype(f32) + lp['c_lnx_b'].astype(f32)
    yn = yn + (bonuses[0] + bonuses[1]).reshape(bsz, t, wdt)
    return yn, finals[0], finals[1]


def _a_qkv(a_q, a_k, a_v, lp):
    bsz, t = a_q.shape[:2]
    q = _rmsnorm(a_q.reshape(bsz, t, A_HEADS, HEAD_DIM), lp['a_qnorm_w'])
    k = _rmsnorm(a_k.reshape(bsz, t, A_KV_HEADS, HEAD_DIM), lp['a_knorm_w'])
    v = a_v.reshape(bsz, t, A_KV_HEADS, HEAD_DIM)
    return q, k, v


def _mla_attend(q, ckv_all, kr_all, lp):
    bsz, s = ckv_all.shape[:2]
    k_nope = (ckv_all @ lp['b_w_uk']).reshape(bsz, s, B_HEADS, B_NOPE)
    k_rope = jnp.broadcast_to(kr_all[:, :, None, :], (bsz, s, B_HEADS, B_ROPE))
    k = jnp.concatenate([k_nope, k_rope], axis=-1)
    v = (ckv_all @ lp['b_w_uv']).reshape(bsz, s, B_HEADS, B_VDIM)
    return _block_attention(q[:, :, :, None, :], k, v)


def _merge(gates, ya, yb, yc, lp):
    ga, gb, gc = jnp.split(jax.nn.sigmoid(gates), 3, axis=-1)
    mixed = ga * (ya @ lp['w_oa']) + gb * (yb @ lp['w_ob']) + gc * (yc @ lp['w_oc'])
    return mixed @ lp['w_out']


def _context_mixer(h, lp):
    bsz, t = h.shape[:2]
    a_q, a_k, a_v, a_z, b_q, b_ckv, b_kr, b_z, c_in, c_z, gates = _split_in(h @ lp['w_in'])
    q, k, v = _a_qkv(a_q, a_k, a_v, lp)
    ya = _block_attention(q.reshape(bsz, t, A_KV_HEADS, A_GROUPS, HEAD_DIM), k, v) * jax.nn.silu(a_z)
    qb = b_q.reshape(bsz, t, B_HEADS, B_NOPE + B_ROPE)
    ckv = _rmsnorm(b_ckv, lp['b_kvnorm_w'])
    yb = _mla_attend(qb, ckv, b_kr, lp) * jax.nn.silu(b_z)
    s0 = jnp.zeros((bsz, C_HEADS, HEAD_DIM, HEAD_DIM), jnp.float32)
    yc, s_f, s_b = _branch_c(c_in, s0, s0, lp)
    yc = yc.astype(h.dtype) * jax.nn.silu(c_z)
    return _merge(gates, ya, yb, yc, lp), k, v, ckv, b_kr, s_f, s_b


def _latent_mixer(h, lp, row, col, ctx_k, ctx_v, ctx_ckv, ctx_kr, s0_f, s0_b):
    bsz, t = h.shape[:2]
    a_q, a_k, a_v, a_z, b_q, b_ckv, b_kr, b_z, c_in, c_z, gates = _split_in(h @ lp['w_in'])
    q, k, v = _a_qkv(a_q, a_k, a_v, lp)
    q = _rope_2d(q, row, col)
    k = _rope_2d(k, row, col)
    k_all = jnp.concatenate([k, ctx_k.astype(k.dtype)], axis=1)
    v_all = jnp.concatenate([v, ctx_v.astype(v.dtype)], axis=1)
    ya = _block_attention(q.reshape(bsz, t, A_KV_HEADS, A_GROUPS, HEAD_DIM), k_all, v_all) * jax.nn.silu(a_z)
    qb = b_q.reshape(bsz, t, B_HEADS, B_NOPE + B_ROPE)
    qb = jnp.concatenate([qb[..., :B_NOPE], _rope_2d(qb[..., B_NOPE:], row, col)], axis=-1)
    kr = _rope_2d(b_kr[:, :, None, :], row, col)[:, :, 0, :]
    ckv = _rmsnorm(b_ckv, lp['b_kvnorm_w'])
    ckv_all = jnp.concatenate([ckv, ctx_ckv.astype(ckv.dtype)], axis=1)
    kr_all = jnp.concatenate([kr, ctx_kr.astype(kr.dtype)], axis=1)
    yb = _mla_attend(qb, ckv_all, kr_all, lp) * jax.nn.silu(b_z)
    yc, _, _ = _branch_c(c_in, s0_f, s0_b, lp)
    yc = yc.astype(h.dtype) * jax.nn.silu(c_z)
    return _merge(gates, ya, yb, yc, lp)


def setup_inputs(seed: int = 0) -> dict:
    key = jax.random.key(seed)
    keys = list(jax.random.split(key, 48))

    def nrm(shape, scale):
        return jax.random.normal(keys.pop(), shape, jnp.float32) * scale

    def uni(shape, lo, hi):
        return jax.random.uniform(keys.pop(), shape, jnp.float32, lo, hi)

    D = D_MODEL
    return {
        'x_prompt': nrm((BATCH, SEQ, D), 1.0),
        'x_sample': nrm((DEC_BATCH, DEC_SEQ, D), 1.0),
        'cache_a_k': nrm((DEC_BATCH, DEPTH, PAST_LEN, A_KV_HEADS, HEAD_DIM), 1.0),
        'cache_a_v': nrm((DEC_BATCH, DEPTH, PAST_LEN, A_KV_HEADS, HEAD_DIM), 1.0),
        'cache_b_ckv': nrm((DEC_BATCH, DEPTH, PAST_LEN, B_KV_RANK), 1.0),
        'cache_b_krope': nrm((DEC_BATCH, DEPTH, PAST_LEN, B_ROPE), 1.0),
        'state_c_fwd': nrm((DEC_BATCH, DEPTH, C_HEADS, HEAD_DIM, HEAD_DIM), 1.0),
        'state_c_bwd': nrm((DEC_BATCH, DEPTH, C_HEADS, HEAD_DIM, HEAD_DIM), 1.0),
        'c': nrm((DEC_BATCH, D), 1.0),
        'c_ctx': nrm((D,), 1.0),
        'norm_w': 1.0 + nrm((DEPTH, D), 0.1),
        'w_mod': nrm((DEPTH, D, 3 * D), 0.5 * D ** -0.5),
        'b_mod': nrm((DEPTH, 3 * D), 0.02),
        'w_in': nrm((DEPTH, D, IN_DIM), D ** -0.5),
        'a_qnorm_w': 1.0 + nrm((DEPTH, HEAD_DIM), 0.1),
        'a_knorm_w': 1.0 + nrm((DEPTH, HEAD_DIM), 0.1),
        'b_kvnorm_w': 1.0 + nrm((DEPTH, B_KV_RANK), 0.1),
        'b_w_uk': nrm((DEPTH, B_KV_RANK, B_HEADS * B_NOPE), B_KV_RANK ** -0.5),
        'b_w_uv': nrm((DEPTH, B_KV_RANK, B_HEADS * B_VDIM), B_KV_RANK ** -0.5),
        'c_mu_prev': uni((DEPTH, C_SHIFT_DIM), 0.0, 0.5),
        'c_mu_next': uni((DEPTH, C_SHIFT_DIM), 0.0, 0.5),
        'c_w0': uni((DEPTH, 2, C_WIDTH), -4.0, 1.0),
        'c_w_up': nrm((DEPTH, 2, C_DECAY_LORA, C_WIDTH), 0.5 * C_DECAY_LORA ** -0.5),
        'c_a0': nrm((DEPTH, 2, C_WIDTH), 0.1),
        'c_a_up': nrm((DEPTH, 2, C_AAA_LORA, C_WIDTH), 0.5 * C_AAA_LORA ** -0.5),
        'c_k_k': 0.85 + nrm((DEPTH, C_WIDTH), 0.05),
        'c_k_a': 1.0 + nrm((DEPTH, C_WIDTH), 0.05),
        'c_r_k': nrm((DEPTH, C_HEADS, HEAD_DIM), 0.1),
        'c_lnx_w': 1.0 + nrm((DEPTH, C_WIDTH), 0.1),
        'c_lnx_b': nrm((DEPTH, C_WIDTH), 0.01),
        'w_oa': nrm((DEPTH, A_WIDTH, D), A_WIDTH ** -0.5),
        'w_ob': nrm((DEPTH, B_WIDTH, D), B_WIDTH ** -0.5),
        'w_oc': nrm((DEPTH, C_WIDTH, D), C_WIDTH ** -0.5),
        'w_out': nrm((DEPTH, D, D), D ** -0.5),
        'final_norm_w': 1.0 + nrm((D,), 0.1),
    }


def reference(x_prompt, x_sample, cache_a_k, cache_a_v, cache_b_ckv, cache_b_krope, state_c_fwd, state_c_bwd,
              c, c_ctx, norm_w, w_mod, b_mod, w_in, a_qnorm_w, a_knorm_w, b_kvnorm_w, b_w_uk, b_w_uv,
              c_mu_prev, c_mu_next, c_w0, c_w_up, c_a0, c_a_up, c_k_k, c_k_a, c_r_k, c_lnx_w, c_lnx_b,
              w_oa, w_ob, w_oc, w_out, final_norm_w):
    dt = x_prompt.dtype
    row, col = _grid_positions(x_sample.shape[1])
    xp = x_prompt
    xs = x_sample
    new_ak, new_av, new_ckv, new_kr, new_sf, new_sb = [], [], [], [], [], []
    for l in range(DEPTH):
        lp = {
            'w_in': w_in[l], 'a_qnorm_w': a_qnorm_w[l], 'a_knorm_w': a_knorm_w[l],
            'b_kvnorm_w': b_kvnorm_w[l], 'b_w_uk': b_w_uk[l], 'b_w_uv': b_w_uv[l],
            'c_mu_prev': c_mu_prev[l], 'c_mu_next': c_mu_next[l], 'c_w0': c_w0[l], 'c_w_up': c_w_up[l],
            'c_a0': c_a0[l], 'c_a_up': c_a_up[l], 'c_k_k': c_k_k[l], 'c_k_a': c_k_a[l], 'c_r_k': c_r_k[l],
            'c_lnx_w': c_lnx_w[l], 'c_lnx_b': c_lnx_b[l],
            'w_oa': w_oa[l], 'w_ob': w_ob[l], 'w_oc': w_oc[l], 'w_out': w_out[l],
        }
        shift, scale, gate = _modulation(c_ctx[None, None, :], w_mod[l], b_mod[l])
        h = _rmsnorm(xp, norm_w[l]) * (1.0 + scale) + shift
        out, ak, av, ckv, kr, s_f, s_b = _context_mixer(h, lp)
        xp = xp + gate * out
        new_ak.append(ak)
        new_av.append(av)
        new_ckv.append(ckv)
        new_kr.append(kr)
        new_sf.append(s_f.astype(dt))
        new_sb.append(s_b.astype(dt))
        shift, scale, gate = _modulation(c[:, None, :], w_mod[l], b_mod[l])
        h = _rmsnorm(xs, norm_w[l]) * (1.0 + scale) + shift
        out = _latent_mixer(h, lp, row, col, cache_a_k[:, l], cache_a_v[:, l], cache_b_ckv[:, l],
                            cache_b_krope[:, l], state_c_fwd[:, l], state_c_bwd[:, l])
        xs = xs + gate * out
    y_prompt = _rmsnorm(xp, final_norm_w)
    y_sample = _rmsnorm(xs, final_norm_w)
    new_a_k = jnp.stack(new_ak, axis=1)
    new_a_v = jnp.stack(new_av, axis=1)
    new_b_ckv = jnp.stack(new_ckv, axis=1)
    new_b_krope = jnp.stack(new_kr, axis=1)
    new_c_state_fwd = jnp.stack(new_sf, axis=1)
    new_c_state_bwd = jnp.stack(new_sb, axis=1)
    return (y_prompt, y_sample, new_a_k, new_a_v, new_b_ckv, new_b_krope, new_c_state_fwd, new_c_state_bwd)
```

```cpp
#include <hip/hip_runtime.h>
#include <hip/hip_cooperative_groups.h>
#include <stdint.h>
#include <stdio.h>
namespace cg = cooperative_groups;

typedef unsigned short bf16_t;
typedef short bf16x8 __attribute__((ext_vector_type(8)));
typedef float f32x16 __attribute__((ext_vector_type(16)));
typedef float f32x4 __attribute__((ext_vector_type(4)));
typedef float f32x2 __attribute__((ext_vector_type(2)));
typedef unsigned u32x4 __attribute__((ext_vector_type(4)));
typedef unsigned u32x2 __attribute__((ext_vector_type(2)));
#define DI __device__ __forceinline__
#define MFMA32(a, b, c) __builtin_amdgcn_mfma_f32_32x32x16_bf16((a), (b), (c), 0, 0, 0)

constexpr int NT = 40960;
constexpr int NCTX = 8192;
constexpr int NK = 45056;
constexpr int ULD = 3488;
constexpr int MODLD = 3072;
constexpr int SMEM_BYTES = 78848;

constexpr size_t OFF_WIN = 0;
constexpr size_t OFF_WO = 16777216;
constexpr size_t OFF_WOUT = 19922944;
constexpr size_t OFF_WU = 22020096;
constexpr size_t OFF_MOD = 22282240;
constexpr size_t OFF_BONUS = 22724608;
constexpr size_t OFF_CS16 = 25346048;
constexpr size_t OFF_CS8 = 25354240;
constexpr size_t OFF_CNT = 25358336;
constexpr size_t OFF_U = 25358592;
constexpr size_t OFF_R1 = 311095552;
constexpr size_t OFF_KA = OFF_R1;
constexpr size_t OFF_VAT = 513208576;
constexpr size_t OFF_KN = OFF_R1 + 23068672;
constexpr size_t OFF_VBT = OFF_R1 + 69206016;
constexpr size_t OFF_KRB = OFF_R1 + 115343360;
constexpr size_t OFF_R2 = 429322496;
constexpr size_t WS_NEED = 524742912;

constexpr size_t OUT_AK = 41943040, OUT_AV = 46137344, OUT_CKV = 50331648, OUT_KR = 54525952, OUT_SF = 55574528, OUT_SB = 59768832;

struct Params {
  const float* in[35];
  float* out;
  char* ws;
  int ph_begin, ph_end;
};

enum { I_XP = 0, I_XS, I_CAK, I_CAV, I_CCKV, I_CKR, I_SF, I_SB, I_C, I_CCTX, I_NORMW, I_WMOD, I_BMOD, I_WIN, I_QNW, I_KNW, I_KVNW,
       I_WUK, I_WUV, I_MUP, I_MUN, I_W0, I_WUP, I_A0, I_AUP, I_KK, I_KA, I_RK, I_LNW, I_LNB, I_WOA, I_WOB, I_WOC, I_WOUT, I_FNW };

DI int threadIdx_x_raw() { return __builtin_amdgcn_workitem_id_x(); }
DI int otid() { int t = threadIdx_x_raw(); asm volatile("" : "+v"(t)); return t; }
DI const float* opq(const float* q) { asm volatile("" : "+s"(q)); return q; }
DI float* opq(float* q) { asm volatile("" : "+s"(q)); return q; }
DI float bf2f(bf16_t v) { return __uint_as_float(((unsigned)v) << 16); }
DI bf16_t f2bf(float x) { unsigned u = __float_as_uint(x); u += 0x7fffu + ((u >> 16) & 1u); return (bf16_t)(u >> 16); }
DI unsigned pack2(float a, float b) { return (unsigned)f2bf(a) | ((unsigned)f2bf(b) << 16); }
DI float lo16(unsigned w) { return __uint_as_float(w << 16); }
DI float hi16(unsigned w) { return __uint_as_float(w & 0xffff0000u); }
DI void unpack8(u32x4 w, float* v) { v[0] = lo16(w.x); v[1] = hi16(w.x); v[2] = lo16(w.y); v[3] = hi16(w.y); v[4] = lo16(w.z); v[5] = hi16(w.z); v[6] = lo16(w.w); v[7] = hi16(w.w); }
DI u32x4 pack8(const float* v) { u32x4 w; w.x = pack2(v[0], v[1]); w.y = pack2(v[2], v[3]); w.z = pack2(v[4], v[5]); w.w = pack2(v[6], v[7]); return w; }
DI int crow(int reg, int h) { return (reg & 3) + 8 * (reg >> 2) + 4 * h; }
DI int crowu(int reg) { return (reg & 3) + 8 * (reg >> 2); }
DI int perm16(int t) { return (t & ~12) | ((t & 4) << 1) | ((t & 8) >> 1); }
DI float sigmoidf_(float x) { return 1.0f / (1.0f + __expf(-x)); }
DI float siluf_(float x) { return x / (1.0f + __expf(-x)); }

DI void row_decode(int row, int& seq, int& t) {
  if (row < NCTX) { seq = row >> 8; t = row & 255; } else { seq = 32 + ((row - NCTX) >> 12); t = (row - NCTX) & 4095; }
}
DI int keyrow0(int seq) { return seq < 32 ? seq * 256 : NCTX + (seq - 32) * 4608; }
DI int seq_tk(int seq) { return seq < 32 ? 256 : 4608; }

template <int NJ>
DI void gemm_mainloop(f32x16 (&acc)[2][NJ], const bf16_t* __restrict__ A, int lda, int ks,
                      const bf16_t* __restrict__ Bt, int ldb, int K, char* smem) {
  constexpr int A_BYTES = 128 * 128;
  constexpr int B_BYTES = 64 * NJ * 128;
  constexpr int STAGE = A_BYTES + B_BYTES;
  const int tid = otid(), lane = tid & 63, wid = __builtin_amdgcn_readfirstlane(tid >> 6), wm = wid >> 1, wn = wid & 1;
  const int r = lane & 31, hh = lane >> 5;
  const int nk = K >> 6;
  const int lrow = tid >> 3, lc = tid & 7;
  u32x4 ra[4], rb[2 * NJ];
  const bf16_t* ap = A + (size_t)lrow * lda + lc * 8;
  const bf16_t* bp = Bt + (size_t)lrow * ldb + lc * 8;
#pragma unroll
  for (int p = 0; p < 4; ++p) ra[p] = *(const u32x4*)(ap + (size_t)(32 * p) * lda);
#pragma unroll
  for (int p = 0; p < 2 * NJ; ++p) rb[p] = *(const u32x4*)(bp + (size_t)(32 * p) * ldb);
  {
    char* base = smem;
#pragma unroll
    for (int p = 0; p < 4; ++p) { const int row = lrow + 32 * p; *(u32x4*)(base + row * 128 + ((lc ^ ((row >> 1) & 7)) << 4)) = ra[p]; }
#pragma unroll
    for (int p = 0; p < 2 * NJ; ++p) { const int row = lrow + 32 * p; *(u32x4*)(base + A_BYTES + row * 128 + ((lc ^ ((row >> 1) & 7)) << 4)) = rb[p]; }
  }
  __syncthreads();
  for (int kt = 0; kt < nk; ++kt) {
    if (kt + 1 < nk) {
      const bf16_t* ap2 = ap + (size_t)(kt + 1) * ks;
      const bf16_t* bp2 = bp + (size_t)(kt + 1) * 64;
#pragma unroll
      for (int p = 0; p < 4; ++p) ra[p] = *(const u32x4*)(ap2 + (size_t)(32 * p) * lda);
#pragma unroll
      for (int p = 0; p < 2 * NJ; ++p) rb[p] = *(const u32x4*)(bp2 + (size_t)(32 * p) * ldb);
    }
    const char* base = smem + (kt & 1) * STAGE;
#pragma unroll
    for (int s = 0; s < 4; ++s) {
      bf16x8 af[2], bfr[NJ];
#pragma unroll
      for (int i = 0; i < 2; ++i) { const int row = wm * 64 + i * 32 + r; af[i] = *(const bf16x8*)(base + row * 128 + (((2 * s + hh) ^ ((row >> 1) & 7)) << 4)); }
#pragma unroll
      for (int j = 0; j < NJ; ++j) { const int row = wn * (32 * NJ) + j * 32 + r; bfr[j] = *(const bf16x8*)(base + A_BYTES + row * 128 + (((2 * s + hh) ^ ((row >> 1) & 7)) << 4)); }
#pragma unroll
      for (int i = 0; i < 2; ++i)
#pragma unroll
        for (int j = 0; j < NJ; ++j) acc[i][j] = MFMA32(af[i], bfr[j], acc[i][j]);
    }
    if (kt + 1 < nk) {
      char* nb = smem + ((kt + 1) & 1) * STAGE;
#pragma unroll
      for (int p = 0; p < 4; ++p) { const int row = lrow + 32 * p; *(u32x4*)(nb + row * 128 + ((lc ^ ((row >> 1) & 7)) << 4)) = ra[p]; }
#pragma unroll
      for (int p = 0; p < 2 * NJ; ++p) { const int row = lrow + 32 * p; *(u32x4*)(nb + A_BYTES + row * 128 + ((lc ^ ((row >> 1) & 7)) << 4)) = rb[p]; }
    }
    __syncthreads();
  }
}

template <int NJ> DI void zero_acc(f32x16 (&acc)[2][NJ]) {
#pragma unroll
  for (int i = 0; i < 2; ++i)
#pragma unroll
    for (int j = 0; j < NJ; ++j)
#pragma unroll
      for (int e = 0; e < 16; ++e) acc[i][j][e] = 0.f;
}

DI void phase_prologue(const Params& p, char* smem) {
  const int tid = otid(), lane = tid & 63, wid = __builtin_amdgcn_readfirstlane(tid >> 6);
  float* mod = (float*)(p.ws + OFF_MOD);
  if (blockIdx.x == 0) {
    if (tid < 64) ((unsigned*)(p.ws + OFF_CNT))[tid] = 0u;
    float* cs16 = (float*)(p.ws + OFF_CS16);
    float* cs8 = (float*)(p.ws + OFF_CS8);
    for (int e = tid; e < 64 * 16; e += 256) { const int pos = e >> 4, i = e & 15; const float inv = expf(-9.210340371976184f * (float)i / 16.0f); const float a = (float)pos * inv; cs16[e * 2] = cosf(a); cs16[e * 2 + 1] = sinf(a); }
    for (int e = tid; e < 64 * 8; e += 256) { const int pos = e >> 3, i = e & 7; const float inv = expf(-9.210340371976184f * (float)i / 8.0f); const float a = (float)pos * inv; cs8[e * 2] = cosf(a); cs8[e * 2 + 1] = sinf(a); }
  }
  float* sl = (float*)smem;
  float* red = sl + 9 * 1024;
  for (int e = tid; e < 9 * 1024; e += 256) { const int j = e >> 10, k = e & 1023; const float* cc0 = opq(p.in[I_CCTX]); const float* cc1 = opq(p.in[I_C]); const float c = j == 0 ? cc0[k] : cc1[(j - 1) * 1024 + k]; sl[e] = siluf_(c); }
  __syncthreads();
  for (int item = blockIdx.x; item < 192; item += gridDim.x) {
    const int l = item / 48, n = (item % 48) * 64 + lane;
    const float* w = p.in[I_WMOD] + (size_t)l * 1024 * 3072 + n;
    float a[9];
#pragma unroll
    for (int j = 0; j < 9; ++j) a[j] = 0.f;
    for (int k = wid * 256; k < wid * 256 + 256; ++k) {
      const float wv = w[(size_t)k * 3072];
#pragma unroll
      for (int j = 0; j < 9; ++j) a[j] += sl[j * 1024 + k] * wv;
    }
#pragma unroll
    for (int j = 0; j < 9; ++j) red[(wid * 9 + j) * 64 + lane] = a[j];
    __syncthreads();
    for (int e = tid; e < 9 * 64; e += 256) {
      const int j = e >> 6, c = e & 63;
      const float s = red[(0 * 9 + j) * 64 + c] + red[(1 * 9 + j) * 64 + c] + red[(2 * 9 + j) * 64 + c] + red[(3 * 9 + j) * 64 + c];
      const int nn = (item % 48) * 64 + c;
      mod[((size_t)l * 9 + j) * MODLD + nn] = s + p.in[I_BMOD][l * 3072 + nn];
    }
    __syncthreads();
  }
}

DI const float* x_row_ptr(const Params& p, int l, int row) {
  const float* xp = opq(p.in[I_XP]); const float* xs = opq(p.in[I_XS]); const float* xo = opq((const float*)p.out);
  if (l == 0) return row < NCTX ? xp + (size_t)row * 1024 : xs + (size_t)(row - NCTX) * 1024;
  return xo + (size_t)row * 1024;
}
DI void norm_row(const Params& p, int l, int row, int lane) {
  const float* x = x_row_ptr(p, l, row);
  const int j = row < NCTX ? 0 : 1 + ((row - NCTX) >> 12);
  const float* mod = (const float*)(p.ws + OFF_MOD) + ((size_t)l * 9 + j) * MODLD;
  const float* nw = p.in[I_NORMW] + l * 1024;
  bf16_t* h = (bf16_t*)(p.ws + OFF_R1) + (size_t)row * 1024;
  f32x4 v[4]; float ss = 0.f;
#pragma unroll
  for (int i = 0; i < 4; ++i) { v[i] = *(const f32x4*)(x + lane * 4 + 256 * i); ss += v[i].x * v[i].x + v[i].y * v[i].y + v[i].z * v[i].z + v[i].w * v[i].w; }
#pragma unroll
  for (int o = 1; o < 64; o <<= 1) ss += __shfl_xor(ss, o);
  const float rs = rsqrtf(ss * (1.0f / 1024.0f) + 1e-6f);
#pragma unroll
  for (int i = 0; i < 4; ++i) {
    const int c = lane * 4 + 256 * i;
    const f32x4 w = *(const f32x4*)(nw + c), sh = *(const f32x4*)(mod + c), sc = *(const f32x4*)(mod + 1024 + c);
    u32x2 o;
    o.x = pack2(v[i].x * rs * w.x * (1.f + sc.x) + sh.x, v[i].y * rs * w.y * (1.f + sc.y) + sh.y);
    o.y = pack2(v[i].z * rs * w.z * (1.f + sc.z) + sh.z, v[i].w * rs * w.w * (1.f + sc.w) + sh.w);
    *(u32x2*)(h + c) = o;
  }
}

DI int win_srccol(int j) {
  if (j < 768) return j;
  if (j < 1696) return j + 512;
  if (j < 3488) return j + 1024;
  if (j < 3584) return -1;
  if (j < 5120) { const int jj = j - 3584; return jj < 512 ? 768 + jj : (jj < 1024 ? 2208 + (jj - 512) : 4512 + (jj - 1024)); }
  return 5024 + (j - 5120);
}
DI void conv_tile(const float* __restrict__ src, int ld_src, bf16_t* dst, int ld_dst, int k0, int n0, int kind, int srcoff, char* smem) {
  float* tile = (float*)smem;
  const int tid = otid();
  const int n = tid & 63;
  int sc = kind == 0 ? win_srccol(n0 + n) : (n0 + n - srcoff);
#pragma unroll
  for (int i = 0; i < 16; ++i) { const int k = i * 4 + (tid >> 6); tile[k * 65 + n] = sc >= 0 ? src[(size_t)(k0 + k) * ld_src + sc] : 0.f; }
  __syncthreads();
#pragma unroll
  for (int i = 0; i < 8; ++i) { const int nn = i * 8 + (tid >> 5), kk = (tid & 31) * 2; *(unsigned*)(dst + (size_t)(n0 + nn) * ld_dst + k0 + kk) = pack2(tile[kk * 65 + nn], tile[(kk + 1) * 65 + nn]); }
  __syncthreads();
}

DI void phase_norm_convert(const Params& p, int l, char* smem) {
  const int tid = otid(), lane = tid & 63, wid = __builtin_amdgcn_readfirstlane(tid >> 6);
  bf16_t* WinT = (bf16_t*)(p.ws + OFF_WIN); bf16_t* WoT = (bf16_t*)(p.ws + OFF_WO); bf16_t* WoutT = (bf16_t*)(p.ws + OFF_WOUT); bf16_t* WuT = (bf16_t*)(p.ws + OFF_WU);
  const int NI_WIN = 128 * 16, NI_WO = 3 * 16 * 8, NI_WOUT = 16 * 16, NI_WU = 16 * 2;
  const int NI_CONV = NI_WIN + NI_WO + NI_WOUT + NI_WU;
  for (int item = blockIdx.x; item < NI_CONV; item += gridDim.x) {
    int it = item;
    if (it < NI_WIN) { conv_tile(p.in[I_WIN] + (size_t)l * 1024 * 8096, 8096, WinT, 1024, (it & 15) * 64, (it >> 4) * 64, 0, 0, smem); continue; }
    it -= NI_WIN;
    if (it < NI_WO) { const int br = it / 128, r2 = it % 128; const float* src = (br == 0 ? opq(p.in[I_WOA]) : (br == 1 ? opq(p.in[I_WOB]) : opq(p.in[I_WOC]))) + (size_t)l * 512 * 1024; conv_tile(src, 1024, WoT + (size_t)br * 1024 * 512, 512, (r2 & 7) * 64, (r2 >> 3) * 64, 1, 0, smem); continue; }
    it -= NI_WO;
    if (it < NI_WOUT) { conv_tile(p.in[I_WOUT] + (size_t)l * 1024 * 1024, 1024, WoutT, 1024, (it & 15) * 64, (it >> 4) * 64, 1, 0, smem); continue; }
    it -= NI_WOUT;
    { const int nt = it >> 1, kt = it & 1; const bool uv = nt >= 8; const float* src = (uv ? opq(p.in[I_WUV]) : opq(p.in[I_WUK])) + (size_t)l * 128 * 512; conv_tile(src, 512, WuT, 128, kt * 64, nt * 64, 1, uv ? 512 : 0, smem); }
  }
  for (int item = blockIdx.x; item < NT / 4; item += gridDim.x) norm_row(p, l, item * 4 + wid, lane);
}

DI void phase_gemm1(const Params& p, int l, char* smem) {
  const int lane = otid() & 63, wid = __builtin_amdgcn_readfirstlane(otid() >> 6), wm = wid >> 1, wn = wid & 1, r = lane & 31, hh = lane >> 5;
  const bf16_t* H = (const bf16_t*)(p.ws + OFF_R1);
  const bf16_t* W = (const bf16_t*)(p.ws + OFF_WIN);
  bf16_t* U = (bf16_t*)(p.ws + OFF_U);
  bf16_t* VAT = (bf16_t*)(p.ws + OFF_VAT);
  const int NTN = 28, ntiles = 320 * NTN;
  for (int tile = blockIdx.x; tile < ntiles; tile += gridDim.x) {
    const int mt = tile / NTN, nt = tile % NTN, m0 = mt * 128, n0 = nt * 128;
    f32x16 acc[2][2]; zero_acc<2>(acc);
    gemm_mainloop<2>(acc, H + (size_t)m0 * 1024, 1024, 64, W + (size_t)n0 * 1024, 1024, 1024, smem);
    int seq, t0; row_decode(m0, seq, t0);
#pragma unroll
    for (int j = 0; j < 2; ++j) {
      const int cb = n0 + wn * 64 + j * 32;
      if (cb >= ULD) continue;
      const int col = cb + r;
      if (cb >= 640 && cb < 768) {
        const int kvh = (col - 640) >> 6, dv = col & 63, Tk = seq_tk(seq);
        bf16_t* vt = VAT + (size_t)128 * keyrow0(seq) + (size_t)(kvh * 64 + dv) * Tk;
#pragma unroll
        for (int i = 0; i < 2; ++i) {
          const int tt = t0 + wm * 64 + i * 32;
#pragma unroll
          for (int g2 = 0; g2 < 2; ++g2) {
            float v[8];
#pragma unroll
            for (int e = 0; e < 8; ++e) v[e] = acc[i][j][g2 * 8 + e];
            *(u32x4*)(vt + tt + 16 * g2 + 8 * hh) = pack8(v);
          }
          if (seq < 32) {
            float* o = p.out + OUT_AV + ((size_t)(seq * 4 + l) * 256 + tt) * 128;
            const int lo = 4 * hh * 128 + (col - 640);
#pragma unroll
            for (int e = 0; e < 16; ++e) (o + crowu(e) * 128)[lo] = acc[i][j][e];
          }
        }
      } else {
#pragma unroll
        for (int i = 0; i < 2; ++i) {
          bf16_t* up = U + (size_t)(m0 + wm * 64 + i * 32) * ULD;
          const int lo = 4 * hh * ULD + col;
#pragma unroll
          for (int e = 0; e < 16; ++e) (up + crowu(e) * ULD)[lo] = f2bf(acc[i][j][e]);
        }
      }
    }
  }
}

DI void post_row(const Params& p, int l, int row, int lane) {
  int seq, t; row_decode(row, seq, t);
  const bool lat = row >= NCTX;
  const int krow = keyrow0(seq) + t;
  const int prow = t >> 6, pcol = t & 63;
  bf16_t* u = (bf16_t*)(p.ws + OFF_U) + (size_t)row * ULD;
  const float* cs16 = (const float*)(p.ws + OFF_CS16);
  const float* cs8 = (const float*)(p.ws + OFF_CS8);
  const float LOG2E = 1.4426950408889634f;
#pragma unroll
  for (int which = 0; which < 2; ++which) {
    const int l8 = which == 0 ? lane : (lane & 15);
    const bf16_t* src = u + (which == 0 ? 0 : 512) + l8 * 8;
    float v[8]; unpack8(*(const u32x4*)src, v);
    float ss = 0.f;
#pragma unroll
    for (int i = 0; i < 8; ++i) ss += v[i] * v[i];
    ss += __shfl_xor(ss, 1); ss += __shfl_xor(ss, 2); ss += __shfl_xor(ss, 4);
    const float rs = rsqrtf(ss * (1.0f / 64.0f) + 1e-6f);
    const float* nw = (which == 0 ? opq(p.in[I_QNW]) : opq(p.in[I_KNW])) + l * 64 + (lane & 7) * 8;
#pragma unroll
    for (int i = 0; i < 8; ++i) v[i] = v[i] * rs * nw[i];
    float pv[8];
#pragma unroll
    for (int i = 0; i < 8; ++i) pv[i] = __shfl_xor(v[i], 2);
    if (lat) {
      const int pos = ((lane & 7) >> 2) ? pcol : prow;
      const bool lower = (lane & 2) == 0;
      const float* cs = cs16 + (pos * 16 + (lane & 1) * 8) * 2;
#pragma unroll
      for (int i = 0; i < 8; ++i) { const float c = cs[i * 2], s = cs[i * 2 + 1]; v[i] = lower ? v[i] * c - pv[i] * s : v[i] * c + pv[i] * s; }
    }
    if (which == 0) {
      const float sc = 0.125f * LOG2E;
#pragma unroll
      for (int i = 0; i < 8; ++i) v[i] *= sc;
      *(u32x4*)(u + lane * 8) = pack8(v);
    } else if (lane < 16) {
      bf16_t* KA = (bf16_t*)(p.ws + OFF_KA);
      *(u32x4*)(KA + (size_t)krow * 128 + lane * 8) = pack8(v);
      if (!lat) {
        float* o = p.out + OUT_AK + ((size_t)(seq * 4 + l) * 256 + t) * 128 + lane * 8;
        *(f32x4*)o = (f32x4){v[0], v[1], v[2], v[3]}; *(f32x4*)(o + 4) = (f32x4){v[4], v[5], v[6], v[7]};
      }
    }
  }
  {
    const float sc = 0.10206207261596577f * LOG2E;
    const int hd = lane >> 3;
    bf16_t* q = u + 768 + hd * 96;
    { float v[8]; unpack8(*(const u32x4*)(q + (lane & 7) * 8), v);
#pragma unroll
      for (int i = 0; i < 8; ++i) v[i] *= sc;
      *(u32x4*)(q + (lane & 7) * 8) = pack8(v); }
    { bf16_t* qr = q + 64 + (lane & 7) * 4;
      const u32x2 w = *(const u32x2*)qr;
      float v[4] = {lo16(w.x), hi16(w.x), lo16(w.y), hi16(w.y)}, pv[4];
#pragma unroll
      for (int i = 0; i < 4; ++i) pv[i] = __shfl_xor(v[i], 2);
      if (lat) {
        const int pos = ((lane & 7) >> 2) ? pcol : prow;
        const bool lower = (lane & 2) == 0;
        const float* cs = cs8 + (pos * 8 + (lane & 1) * 4) * 2;
#pragma unroll
        for (int i = 0; i < 4; ++i) { const float c = cs[i * 2], s = cs[i * 2 + 1]; v[i] = lower ? v[i] * c - pv[i] * s : v[i] * c + pv[i] * s; }
      }
      u32x2 o; o.x = pack2(v[0] * sc, v[1] * sc); o.y = pack2(v[2] * sc, v[3] * sc);
      *(u32x2*)qr = o; }
  }
  {
    const unsigned w = *(const unsigned*)(u + 1536 + lane * 2);
    float a = lo16(w), b = hi16(w);
    float ss = a * a + b * b;
#pragma unroll
    for (int o = 1; o < 64; o <<= 1) ss += __shfl_xor(ss, o);
    const float rs = rsqrtf(ss * (1.0f / 128.0f) + 1e-6f);
    const float* nw = p.in[I_KVNW] + l * 128 + lane * 2;
    a = a * rs * nw[0]; b = b * rs * nw[1];
    bf16_t* CKVN = (bf16_t*)(p.ws + OFF_R2);
    *(unsigned*)(CKVN + (size_t)krow * 128 + lane * 2) = pack2(a, b);
    if (!lat) { float* o = p.out + OUT_CKV + ((size_t)(seq * 4 + l) * 256 + t) * 128 + lane * 2; *(f32x2*)o = (f32x2){a, b}; }
  }
  {
    float v = bf2f(u[1664 + (lane & 31)]);
    const float pv = __shfl_xor(v, 8);
    if (!lat) { if (lane < 32) p.out[OUT_KR + ((size_t)(seq * 4 + l) * 256 + t) * 32 + lane] = v; }
    else {
      const int d = lane & 31; const int pos = (d >> 4) ? pcol : prow; const bool lower = (d & 8) == 0;
      const float* cs = cs8 + (pos * 8 + (d & 7)) * 2;
      v = lower ? v * cs[0] - pv * cs[1] : v * cs[0] + pv * cs[1];
    }
    if (lane < 32) ((bf16_t*)(p.ws + OFF_KRB))[(size_t)krow * 32 + lane] = f2bf(v);
  }
}
DI void post_cached_row(const Params& p, int l, int idx, int lane) {
  const int b = idx >> 9, j = idx & 511;
  const int kr0 = NCTX + b * 4608, krow = kr0 + 4096 + j;
  const size_t cb = ((size_t)(b * 4 + l) * 512 + j);
  bf16_t* KA = (bf16_t*)(p.ws + OFF_KA); bf16_t* VAT = (bf16_t*)(p.ws + OFF_VAT); bf16_t* CKVN = (bf16_t*)(p.ws + OFF_R2); bf16_t* KRB = (bf16_t*)(p.ws + OFF_KRB);
  { const f32x2 v = *(const f32x2*)(p.in[I_CAK] + cb * 128 + lane * 2); *(unsigned*)(KA + (size_t)krow * 128 + lane * 2) = pack2(v.x, v.y); }
  { const f32x2 v = *(const f32x2*)(p.in[I_CAV] + cb * 128 + lane * 2);
    bf16_t* vt = VAT + (size_t)128 * kr0 + (size_t)(lane * 2) * 4608 + perm16(4096 + j);
    vt[0] = f2bf(v.x); vt[4608] = f2bf(v.y); }
  { const f32x2 v = *(const f32x2*)(p.in[I_CCKV] + cb * 128 + lane * 2); *(unsigned*)(CKVN + (size_t)krow * 128 + lane * 2) = pack2(v.x, v.y); }
  if (lane < 32) KRB[(size_t)krow * 32 + lane] = f2bf(p.in[I_CKR][cb * 32 + lane]);
}
DI void phase_post(const Params& p, int l) {
  const int lane = otid() & 63, wid = __builtin_amdgcn_readfirstlane(otid() >> 6);
  for (int item = blockIdx.x; item < NT / 4 + 1024; item += gridDim.x) {
    if (item < NT / 4) post_row(p, l, item * 4 + wid, lane);
    else post_cached_row(p, l, (item - NT / 4) * 4 + wid, lane);
  }
}

DI void phase_upproj(const Params& p, char* smem) {
  const int lane = otid() & 63, wid = __builtin_amdgcn_readfirstlane(otid() >> 6), wm = wid >> 1, wn = wid & 1, r = lane & 31, hh = lane >> 5;
  const bf16_t* A = (const bf16_t*)(p.ws + OFF_R2);
  const bf16_t* W = (const bf16_t*)(p.ws + OFF_WU);
  bf16_t* KN = (bf16_t*)(p.ws + OFF_KN); bf16_t* VBT = (bf16_t*)(p.ws + OFF_VBT);
  const int ntiles = 352 * 8;
  for (int tile = blockIdx.x; tile < ntiles; tile += gridDim.x) {
    const int mt = tile >> 3, nt = tile & 7, m0 = mt * 128, n0 = nt * 128;
    f32x16 acc[2][2]; zero_acc<2>(acc);
    gemm_mainloop<2>(acc, A + (size_t)m0 * 128, 128, 64, W + (size_t)n0 * 128, 128, 128, smem);
    int seq, t0;
    if (m0 < NCTX) { seq = m0 >> 8; t0 = m0 & 255; } else { const int rr = m0 - NCTX; seq = 32 + rr / 4608; t0 = rr % 4608; }
#pragma unroll
    for (int j = 0; j < 2; ++j) {
      const int col = n0 + wn * 64 + j * 32 + r;
      if (n0 < 512) {
#pragma unroll
        for (int i = 0; i < 2; ++i) {
          bf16_t* kp = KN + (size_t)(m0 + wm * 64 + i * 32) * 512;
          const int lo = 4 * hh * 512 + col;
#pragma unroll
          for (int e = 0; e < 16; ++e) (kp + crowu(e) * 512)[lo] = f2bf(acc[i][j][e]);
        }
      } else {
        const int Tk = seq_tk(seq);
        bf16_t* vt = VBT + (size_t)512 * keyrow0(seq) + (size_t)(col - 512) * Tk;
#pragma unroll
        for (int i = 0; i < 2; ++i) {
          const int tt = t0 + wm * 64 + i * 32;
#pragma unroll
          for (int g2 = 0; g2 < 2; ++g2) {
            float v[8];
#pragma unroll
            for (int e = 0; e < 8; ++e) v[e] = acc[i][j][g2 * 8 + e];
            *(u32x4*)(vt + tt + 16 * g2 + 8 * hh) = pack8(v);
          }
        }
      }
    }
  }
}

template <int DQK>
DI void attn_item(const bf16_t* Qw, int q_ld, const bf16_t* K1, int k1_ld, const bf16_t* K2, int k2_ld,
                  const bf16_t* Vt, int vt_ld, int nkeys, bf16_t* Ow, int o_ld, char* smem) {
  constexpr int KS = DQK * 2 + 16;
  constexpr int KBYTES = 64 * KS;
  constexpr int VS = 144;
  constexpr int VBYTES = 64 * VS;
  constexpr int STAGE = KBYTES + VBYTES;
  constexpr int CPR = DQK / 8;
  constexpr int NKC = 64 * CPR / 256;
  constexpr int NS = DQK / 16;
  const int tid = otid(), lane = tid & 63, r = lane & 31, hh = lane >> 5;
  bf16x8 qf[NS];
#pragma unroll
  for (int s = 0; s < NS; ++s) qf[s] = *(const bf16x8*)(Qw + (size_t)r * q_ld + 16 * s + 8 * hh);
  f32x16 o[2];
#pragma unroll
  for (int n = 0; n < 2; ++n)
#pragma unroll
    for (int e = 0; e < 16; ++e) o[n][e] = 0.f;
  float m_run = -1e30f, lsum = 0.f;
  u32x4 rk[NKC], rv[2];
  int krow_[NKC], kc_[NKC];
#pragma unroll
  for (int q = 0; q < NKC; ++q) { const int id = q * 256 + tid; krow_[q] = id / CPR; kc_[q] = id % CPR; }
  const int vrow = tid >> 3, vc = tid & 7;
  auto gload = [&](int key0) {
#pragma unroll
    for (int q = 0; q < NKC; ++q) {
      const bf16_t* src = (DQK == 64 || kc_[q] < 8) ? K1 + (size_t)(key0 + krow_[q]) * k1_ld + kc_[q] * 8 : K2 + (size_t)(key0 + krow_[q]) * k2_ld + (kc_[q] - 8) * 8;
      rk[q] = *(const u32x4*)src;
    }
#pragma unroll
    for (int q = 0; q < 2; ++q) rv[q] = *(const u32x4*)(Vt + (size_t)(vrow + 32 * q) * vt_ld + key0 + vc * 8);
  };
  auto lstore = [&](int buf) {
    char* base = smem + buf * STAGE;
#pragma unroll
    for (int q = 0; q < NKC; ++q) *(u32x4*)(base + krow_[q] * KS + kc_[q] * 16) = rk[q];
#pragma unroll
    for (int q = 0; q < 2; ++q) *(u32x4*)(base + KBYTES + (vrow + 32 * q) * VS + vc * 16) = rv[q];
  };
  const int ntl = nkeys >> 6;
  gload(0); lstore(0); __syncthreads();
  for (int tl = 0; tl < ntl; ++tl) {
    if (tl + 1 < ntl) gload((tl + 1) * 64);
    const char* base = smem + (tl & 1) * STAGE;
    f32x16 s[2];
#pragma unroll
    for (int kb = 0; kb < 2; ++kb) {
#pragma unroll
      for (int e = 0; e < 16; ++e) s[kb][e] = 0.f;
#pragma unroll
      for (int ks = 0; ks < NS; ++ks) {
        const bf16x8 kf = *(const bf16x8*)(base + (kb * 32 + r) * KS + (2 * ks + hh) * 16);
        s[kb] = MFMA32(kf, qf[ks], s[kb]);
      }
    }
    float mx = s[0][0];
#pragma unroll
    for (int kb = 0; kb < 2; ++kb)
#pragma unroll
      for (int e = 0; e < 16; ++e) mx = fmaxf(mx, s[kb][e]);
    mx = fmaxf(mx, __shfl_xor(mx, 32));
    const float m_new = fmaxf(m_run, mx);
    const float alpha = __builtin_amdgcn_exp2f(m_run - m_new);
    m_run = m_new;
    float ps = 0.f;
#pragma unroll
    for (int kb = 0; kb < 2; ++kb)
#pragma unroll
      for (int e = 0; e < 16; ++e) { const float pe = __builtin_amdgcn_exp2f(s[kb][e] - m_new); s[kb][e] = pe; ps += pe; }
    lsum = lsum * alpha + ps;
#pragma unroll
    for (int n = 0; n < 2; ++n)
#pragma unroll
      for (int e = 0; e < 16; ++e) o[n][e] *= alpha;
#pragma unroll
    for (int kb = 0; kb < 2; ++kb)
#pragma unroll
      for (int s2 = 0; s2 < 2; ++s2) {
        u32x4 pw;
        pw.x = pack2(s[kb][8 * s2 + 0], s[kb][8 * s2 + 1]); pw.y = pack2(s[kb][8 * s2 + 2], s[kb][8 * s2 + 3]);
        pw.z = pack2(s[kb][8 * s2 + 4], s[kb][8 * s2 + 5]); pw.w = pack2(s[kb][8 * s2 + 6], s[kb][8 * s2 + 7]);
        const bf16x8 pf = __builtin_bit_cast(bf16x8, pw);
#pragma unroll
        for (int n = 0; n < 2; ++n) {
          const bf16x8 vf = *(const bf16x8*)(base + KBYTES + (32 * n + r) * VS + (kb * 32 + 16 * s2 + 8 * hh) * 2);
          o[n] = MFMA32(vf, pf, o[n]);
        }
      }
    if (tl + 1 < ntl) lstore((tl + 1) & 1);
    __syncthreads();
  }
  lsum += __shfl_xor(lsum, 32);
  const float inv = 1.0f / lsum;
#pragma unroll
  for (int n = 0; n < 2; ++n)
#pragma unroll
    for (int g = 0; g < 4; ++g) {
      u32x2 w; w.x = pack2(o[n][4 * g] * inv, o[n][4 * g + 1] * inv); w.y = pack2(o[n][4 * g + 2] * inv, o[n][4 * g + 3] * inv);
      *(u32x2*)(Ow + (size_t)r * o_ld + 32 * n + 8 * g + 4 * hh) = w;
    }
}

DI void scan_item(const Params& p, int l, int seq, int hd, int dir, char* smem) {
  const int tid = otid(), lane = tid & 63, jq = __builtin_amdgcn_readfirstlane(tid >> 6);
  const bool lat = seq >= 32;
  const int T = lat ? 4096 : 256;
  const int row0 = lat ? NCTX + (seq - 32) * 4096 : seq * 256;
  float* vA = (float*)smem; float* vW = vA + 2048; float* vB = vW + 2048; float* vK = vB + 2048; float* vR = vK + 2048; float* vV = vR + 2048;
  float* wdx = vV + 2048; float* adx = wdx + 2048; float* ybuf = adx + 2048; float* sax = ybuf + 2048;
  const bf16_t* U = (const bf16_t*)(p.ws + OFF_U);
  bf16_t* Y = (bf16_t*)(p.ws + OFF_R2) + (dir ? (size_t)NT * 512 : 0);
  float* bonus = (float*)(p.ws + OFF_BONUS);
  float S[16];
  if (lat) {
    const float* s0 = (dir ? opq(p.in[I_SB]) : opq(p.in[I_SF])) + ((size_t)((seq - 32) * 4 + l) * 8 + hd) * 4096 + lane * 64 + jq * 16;
#pragma unroll
    for (int q = 0; q < 4; ++q) { const f32x4 v = *(const f32x4*)(s0 + 4 * q); S[4 * q] = v.x; S[4 * q + 1] = v.y; S[4 * q + 2] = v.z; S[4 * q + 3] = v.w; }
  } else {
#pragma unroll
    for (int q = 0; q < 16; ++q) S[q] = 0.f;
  }
  const float* mup = p.in[I_MUP] + l * 1792; const float* mun = p.in[I_MUN] + l * 1792;
  const int nch = T >> 5;
  for (int ci = 0; ci < nch; ++ci) {
    const int t0 = (dir ? nch - 1 - ci : ci) * 32;
    {
      const int tt = tid >> 3, sub = tid & 7, t = t0 + tt;
      const bf16_t* base = U + (size_t)(row0 + t) * ULD + 1696;
      const bool hp = t > 0, hn = t < T - 1;
#pragma unroll
      for (int g = 0; g < 5; ++g) {
        const int col = (g < 3 ? g * 512 + hd * 64 : (g == 3 ? 1536 + dir * 64 : 1664 + dir * 64)) + sub * 8;
        float c[8], pv[8], nx[8];
        unpack8(*(const u32x4*)(base + col), c);
        if (hp) unpack8(*(const u32x4*)(base - ULD + col), pv); else { for (int i = 0; i < 8; ++i) pv[i] = 0.f; }
        if (hn) unpack8(*(const u32x4*)(base + ULD + col), nx); else { for (int i = 0; i < 8; ++i) nx[i] = 0.f; }
        float x[8];
#pragma unroll
        for (int i = 0; i < 8; ++i) x[i] = c[i] + mup[col + i] * (pv[i] - c[i]) + mun[col + i] * (nx[i] - c[i]);
        const int lo = tt * 64 + sub * 8;
        if (g == 0) { for (int i = 0; i < 8; ++i) vR[lo + i] = x[i]; }
        else if (g == 1) {
          float kk[8], ss = 0.f;
          const float* kkw = p.in[I_KK] + l * 512 + hd * 64 + sub * 8;
#pragma unroll
          for (int i = 0; i < 8; ++i) { kk[i] = x[i] * kkw[i]; ss += kk[i] * kk[i]; vK[lo + i] = x[i]; }
          ss += __shfl_xor(ss, 1); ss += __shfl_xor(ss, 2); ss += __shfl_xor(ss, 4);
          const float inv = 1.0f / fmaxf(sqrtf(ss), 1e-12f);
#pragma unroll
          for (int i = 0; i < 8; ++i) vA[lo + i] = kk[i] * inv;
        }
        else if (g == 2) { for (int i = 0; i < 8; ++i) vV[lo + i] = x[i]; }
        else if (g == 3) { for (int i = 0; i < 8; ++i) wdx[lo + i] = tanhf(x[i]); }
        else { for (int i = 0; i < 8; ++i) adx[lo + i] = x[i]; }
      }
    }
    __syncthreads();
    {
      const int hc = hd * 64 + lane;
      float aw[8], aa[8];
      const float w0v = p.in[I_W0][(l * 2 + dir) * 512 + hc], a0v = p.in[I_A0][(l * 2 + dir) * 512 + hc];
#pragma unroll
      for (int q = 0; q < 8; ++q) { aw[q] = w0v; aa[q] = a0v; }
      const float* wu = p.in[I_WUP] + (size_t)(l * 2 + dir) * 64 * 512 + hc;
      const float* au = p.in[I_AUP] + (size_t)(l * 2 + dir) * 64 * 512 + hc;
      for (int m = 0; m < 64; m += 4) {
        float w4[4], a4[4];
#pragma unroll
        for (int mm = 0; mm < 4; ++mm) { w4[mm] = wu[(m + mm) * 512]; a4[mm] = au[(m + mm) * 512]; }
#pragma unroll
        for (int q = 0; q < 8; ++q) {
          const f32x4 xw = *(const f32x4*)(wdx + (jq * 8 + q) * 64 + m);
          const f32x4 xa = *(const f32x4*)(adx + (jq * 8 + q) * 64 + m);
          aw[q] += xw.x * w4[0] + xw.y * w4[1] + xw.z * w4[2] + xw.w * w4[3];
          aa[q] += xa.x * a4[0] + xa.y * a4[1] + xa.z * a4[2] + xa.w * a4[3];
        }
      }
      const float kav = p.in[I_KA][l * 512 + hc], rkv = p.in[I_RK][l * 512 + hc];
#pragma unroll
      for (int q = 0; q < 8; ++q) {
        const int tt = jq * 8 + q, ix = tt * 64 + lane;
        const float decay = __expf(-0.6065306597126334f * sigmoidf_(aw[q]));
        const float ag = sigmoidf_(aa[q]);
        const float kk = vA[ix], k = vK[ix], rr = vR[ix];
        const float kd = k * (1.0f + (ag - 1.0f) * kav);
        vK[ix] = kd; vA[ix] = -kk; vB[ix] = kk * ag; vW[ix] = decay;
        float bs = rr * kd * rkv;
#pragma unroll
        for (int o = 1; o < 64; o <<= 1) bs += __shfl_xor(bs, o);
        if (lane == 0) bonus[((size_t)(row0 + t0 + tt) * 8 + hd) * 2 + dir] = bs;
      }
#pragma unroll
      for (int q = 0; q < 8; ++q) ybuf[tid * 8 + q] = 0.f;
    }
    __syncthreads();
    for (int si = 0; si < 32; ++si) {
      const int tt = dir ? 31 - si : si;
      const int vo = tt * 64 + jq * 16;
      float pa = 0.f;
#pragma unroll
      for (int q = 0; q < 4; ++q) { const f32x4 a = *(const f32x4*)(vA + vo + 4 * q); pa += S[4 * q] * a.x + S[4 * q + 1] * a.y + S[4 * q + 2] * a.z + S[4 * q + 3] * a.w; }
      float* sx = sax + (si & 1) * 256;
      sx[lane * 4 + jq] = pa;
      __syncthreads();
      const f32x4 sq = *(const f32x4*)(sx + lane * 4);
      const float sa = (sq.x + sq.y) + (sq.z + sq.w);
      const float vi = vV[tt * 64 + lane];
      float py = 0.f;
#pragma unroll
      for (int q = 0; q < 4; ++q) {
        const f32x4 w = *(const f32x4*)(vW + vo + 4 * q), b = *(const f32x4*)(vB + vo + 4 * q), k = *(const f32x4*)(vK + vo + 4 * q), rr = *(const f32x4*)(vR + vo + 4 * q);
        S[4 * q] = S[4 * q] * w.x + (sa * b.x + vi * k.x); py += S[4 * q] * rr.x;
        S[4 * q + 1] = S[4 * q + 1] * w.y + (sa * b.y + vi * k.y); py += S[4 * q + 1] * rr.y;
        S[4 * q + 2] = S[4 * q + 2] * w.z + (sa * b.z + vi * k.z); py += S[4 * q + 2] * rr.z;
        S[4 * q + 3] = S[4 * q + 3] * w.w + (sa * b.w + vi * k.w); py += S[4 * q + 3] * rr.w;
      }
      atomicAdd(&ybuf[tt * 64 + lane], py);
    }
    __syncthreads();
    {
      const int tt = tid >> 3, sub = tid & 7;
      float v[8];
#pragma unroll
      for (int i = 0; i < 8; ++i) v[i] = ybuf[tt * 64 + sub * 8 + i];
      *(u32x4*)(Y + (size_t)(row0 + t0 + tt) * 512 + hd * 64 + sub * 8) = pack8(v);
    }
    __syncthreads();
  }
  if (!lat) {
    float* o = opq(p.out) + (dir ? OUT_SB : OUT_SF) + ((size_t)(seq * 4 + l) * 8 + hd) * 4096 + lane * 64 + jq * 16;
#pragma unroll
    for (int q = 0; q < 4; ++q) *(f32x4*)(o + 4 * q) = (f32x4){S[4 * q], S[4 * q + 1], S[4 * q + 2], S[4 * q + 3]};
  }
}

DI void phase_mixers(const Params& p, int l, char* smem) {
  const int tid = otid(), wid = __builtin_amdgcn_readfirstlane(tid >> 6);
  unsigned* cnt = (unsigned*)(p.ws + OFF_CNT) + l;
  int* slot = (int*)(smem + SMEM_BYTES - 16);
  bf16_t* U = (bf16_t*)(p.ws + OFF_U);
  const bf16_t* KA = (const bf16_t*)(p.ws + OFF_KA); const bf16_t* VAT = (const bf16_t*)(p.ws + OFF_VAT);
  const bf16_t* KN = (const bf16_t*)(p.ws + OFF_KN); const bf16_t* VBT = (const bf16_t*)(p.ws + OFF_VBT); const bf16_t* KRB = (const bf16_t*)(p.ws + OFF_KRB);
  const int NITEMS = 128 + 4096 + 1536;
  for (;;) {
    if (tid == 0) *slot = (int)atomicAdd(cnt, 1u);
    __syncthreads();
    const int item = __builtin_amdgcn_readfirstlane(*slot);
    __syncthreads();
    if (item >= NITEMS) break;
    int kind, seq, a, qt;
    if (item < 128) { kind = 0; seq = 32 + (item >> 4); a = (item >> 1) & 7; qt = item & 1; }
    else if (item < 128 + 2048) { const int k = item - 128; kind = 1; seq = 32 + (k >> 8); a = (k >> 7) & 1; qt = k & 127; }
    else if (item < 128 + 4096) { const int k = item - 128 - 2048; kind = 2; seq = 32 + (k >> 8); a = (k >> 5) & 7; qt = k & 31; }
    else if (item < 128 + 4096 + 512) { const int k = item - 128 - 4096; kind = 0; seq = k >> 4; a = (k >> 1) & 7; qt = k & 1; }
    else if (item < 128 + 4096 + 1024) { const int k = item - 128 - 4096 - 512; kind = 1; seq = k >> 4; a = (k >> 3) & 1; qt = k & 7; }
    else { const int k = item - 128 - 4096 - 1024; kind = 2; seq = k >> 4; a = (k >> 1) & 7; qt = k & 1; }
    const int kr0 = keyrow0(seq), Tk = seq_tk(seq);
    const int row0 = seq < 32 ? seq * 256 : NCTX + (seq - 32) * 4096;
    if (kind == 0) scan_item(p, l, seq, a, qt, smem);
    else if (kind == 1) {
      const int qh = a * 4 + wid;
      bf16_t* q = U + (size_t)(row0 + qt * 32) * ULD + qh * 64;
      attn_item<64>(q, ULD, KA + (size_t)kr0 * 128 + a * 64, 128, nullptr, 0, VAT + (size_t)128 * kr0 + (size_t)(a * 64) * Tk, Tk, Tk, q, ULD, smem);
    } else {
      bf16_t* q = U + (size_t)(row0 + qt * 128 + wid * 32) * ULD + 768 + a * 96;
      attn_item<96>(q, ULD, KN + (size_t)kr0 * 512 + a * 64, 512, KRB + (size_t)kr0 * 32, 32, VBT + (size_t)512 * kr0 + (size_t)(a * 64) * Tk, Tk, Tk, q, ULD, smem);
    }
  }
}

DI void cpost_row(const Params& p, int l, int row, int lane) {
  int seq, t; row_decode(row, seq, t);
  const int T = seq < 32 ? 256 : 4096;
  const bf16_t* YF = (const bf16_t*)(p.ws + OFF_R2); const bf16_t* YB = YF + (size_t)NT * 512;
  bf16_t* u = (bf16_t*)(p.ws + OFF_U) + (size_t)row * ULD + 1696;
  const float* bonus = (const float*)(p.ws + OFF_BONUS);
  float yf[8], yb[8], y[8];
  unpack8(*(const u32x4*)(YF + (size_t)row * 512 + lane * 8), yf);
  unpack8(*(const u32x4*)(YB + (size_t)row * 512 + lane * 8), yb);
  float s = 0.f;
#pragma unroll
  for (int i = 0; i < 8; ++i) { y[i] = yf[i] + yb[i]; s += y[i]; }
  s += __shfl_xor(s, 1); s += __shfl_xor(s, 2); s += __shfl_xor(s, 4);
  const float mu = s * (1.0f / 64.0f);
  float q = 0.f;
#pragma unroll
  for (int i = 0; i < 8; ++i) { y[i] -= mu; q += y[i] * y[i]; }
  q += __shfl_xor(q, 1); q += __shfl_xor(q, 2); q += __shfl_xor(q, 4);
  const float rs = rsqrtf(q * (1.0f / 64.0f) + 64e-5f);
  const int col = 1024 + lane * 8;
  float c[8], pv[8], nx[8];
  unpack8(*(const u32x4*)(u + col), c);
  if (t > 0) unpack8(*(const u32x4*)(u - ULD + col), pv); else { for (int i = 0; i < 8; ++i) pv[i] = 0.f; }
  if (t < T - 1) unpack8(*(const u32x4*)(u + ULD + col), nx); else { for (int i = 0; i < 8; ++i) nx[i] = 0.f; }
  const float* mup = p.in[I_MUP] + l * 1792 + col; const float* mun = p.in[I_MUN] + l * 1792 + col;
  const float* lw = p.in[I_LNW] + l * 512 + lane * 8; const float* lb = p.in[I_LNB] + l * 512 + lane * 8;
  const f32x2 bsv = *(const f32x2*)(bonus + ((size_t)row * 8 + (lane >> 3)) * 2);
  const float bs = bsv.x + bsv.y;
  float o[8];
#pragma unroll
  for (int i = 0; i < 8; ++i) { const float v = c[i] + mup[i] * (pv[i] - c[i]) + mun[i] * (nx[i] - c[i]); o[i] = y[i] * rs * lw[i] + lb[i] + bs * v; }
  *(u32x4*)(u + lane * 8) = pack8(o);
}
DI void phase_renorm_cpost(const Params& p, int l) {
  const int lane = otid() & 63, wid = __builtin_amdgcn_readfirstlane(otid() >> 6);
  for (int item = blockIdx.x; item < NT / 4; item += gridDim.x) { const int row = item * 4 + wid; norm_row(p, l, row, lane); cpost_row(p, l, row, lane); }
}

DI void phase_zgemm(const Params& p, char* smem) {
  const int lane = otid() & 63, wid = __builtin_amdgcn_readfirstlane(otid() >> 6), wm = wid >> 1, wn = wid & 1, r = lane & 31, hh = lane >> 5;
  const bf16_t* H = (const bf16_t*)(p.ws + OFF_R1);
  const bf16_t* W = (const bf16_t*)(p.ws + OFF_WIN) + (size_t)3584 * 1024;
  bf16_t* U = (bf16_t*)(p.ws + OFF_U);
  const int ntiles = 320 * 12;
  for (int tile = blockIdx.x; tile < ntiles; tile += gridDim.x) {
    const int mt = tile / 12, nt = tile % 12, m0 = mt * 128, n0 = nt * 128;
    f32x16 acc[2][2]; zero_acc<2>(acc);
    gemm_mainloop<2>(acc, H + (size_t)m0 * 1024, 1024, 64, W + (size_t)n0 * 1024, 1024, 1024, smem);
#pragma unroll
    for (int j = 0; j < 2; ++j) {
      const int col = n0 + wn * 64 + j * 32 + r;
      const int br = col >> 9, cc = col & 511;
      const int ucol = br == 0 ? cc : (br == 1 ? 768 + (cc >> 6) * 96 + (cc & 63) : 1696 + cc);
#pragma unroll
      for (int i = 0; i < 2; ++i) {
        bf16_t* up = U + (size_t)(m0 + wm * 64 + i * 32) * ULD;
        const int lo = 4 * hh * ULD + ucol;
#pragma unroll
        for (int e = 0; e < 16; ++e) { bf16_t* q = up + crowu(e) * ULD; q[lo] = f2bf(bf2f(q[lo]) * siluf_(acc[i][j][e])); }
      }
    }
  }
}

DI void phase_merge(const Params& p, char* smem) {
  const int lane = otid() & 63, wid = __builtin_amdgcn_readfirstlane(otid() >> 6), wm = wid >> 1, wn = wid & 1, r = lane & 31, hh = lane >> 5;
  const bf16_t* H = (const bf16_t*)(p.ws + OFF_R1);
  const bf16_t* WG = (const bf16_t*)(p.ws + OFF_WIN) + (size_t)5120 * 1024;
  const bf16_t* WO = (const bf16_t*)(p.ws + OFF_WO);
  const bf16_t* U = (const bf16_t*)(p.ws + OFF_U);
  bf16_t* MX = (bf16_t*)(p.ws + OFF_R2);
  const int ntiles = 320 * 16;
  for (int tile = blockIdx.x; tile < ntiles; tile += gridDim.x) {
    const int mt = tile >> 4, nt = tile & 15, m0 = mt * 128, n0 = nt * 64;
    f32x16 mix[2][1]; zero_acc<1>(mix);
    f32x16 gs[2][1]; zero_acc<1>(gs);
#pragma unroll 1
    for (int step = 0; step < 6; ++step) {
      const int br = step >> 1, isT = step & 1;
      const int acol = br == 0 ? 0 : (br == 1 ? 768 : 1696);
      const bf16_t* Ap = isT ? U + (size_t)m0 * ULD + acol : H + (size_t)m0 * 1024;
      const bf16_t* Bp = isT ? WO + (size_t)(br * 1024 + n0) * 512 : WG + (size_t)(br * 1024 + n0) * 1024;
      f32x16 cur[2][1]; zero_acc<1>(cur);
      gemm_mainloop<1>(cur, Ap, isT ? ULD : 1024, (isT && br == 1) ? 96 : 64, Bp, isT ? 512 : 1024, isT ? 512 : 1024, smem);
      if (isT) {
#pragma unroll
        for (int i = 0; i < 2; ++i)
#pragma unroll
          for (int e = 0; e < 16; ++e) mix[i][0][e] += gs[i][0][e] * cur[i][0][e];
      } else {
#pragma unroll
        for (int i = 0; i < 2; ++i)
#pragma unroll
          for (int e = 0; e < 16; ++e) gs[i][0][e] = sigmoidf_(cur[i][0][e]);
      }
    }
    const int col = n0 + wn * 32 + r;
#pragma unroll
    for (int i = 0; i < 2; ++i) {
      bf16_t* mp = MX + (size_t)(m0 + wm * 64 + i * 32) * 1024;
      const int lo = 4 * hh * 1024 + col;
#pragma unroll
      for (int e = 0; e < 16; ++e) (mp + crowu(e) * 1024)[lo] = f2bf(mix[i][0][e]);
    }
  }
}

DI void phase_out(const Params& p, int l, char* smem) {
  const int lane = otid() & 63, wid = __builtin_amdgcn_readfirstlane(otid() >> 6), wm = wid >> 1, wn = wid & 1, r = lane & 31, hh = lane >> 5;
  const bf16_t* MX = (const bf16_t*)(p.ws + OFF_R2);
  const bf16_t* W = (const bf16_t*)(p.ws + OFF_WOUT);
  const int ntiles = 320 * 8;
  for (int tile = blockIdx.x; tile < ntiles; tile += gridDim.x) {
    const int mt = tile >> 3, nt = tile & 7, m0 = mt * 128, n0 = nt * 128;
    f32x16 acc[2][2]; zero_acc<2>(acc);
    gemm_mainloop<2>(acc, MX + (size_t)m0 * 1024, 1024, 64, W + (size_t)n0 * 1024, 1024, 1024, smem);
    const int jm = m0 < NCTX ? 0 : 1 + ((m0 - NCTX) >> 12);
    const float* gate = (const float*)(p.ws + OFF_MOD) + ((size_t)l * 9 + jm) * MODLD + 2048;
    const float* xsrc = x_row_ptr(p, l, m0);
#pragma unroll
    for (int j = 0; j < 2; ++j) {
      const int col = n0 + wn * 64 + j * 32 + r;
      const float gv = gate[col];
      const int lo = 4 * hh * 1024 + col;
#pragma unroll
      for (int i = 0; i < 2; ++i) {
        const float* xs = xsrc + (size_t)(wm * 64 + i * 32) * 1024;
        float* xo = p.out + (size_t)(m0 + wm * 64 + i * 32) * 1024;
#pragma unroll
        for (int e = 0; e < 16; ++e) (xo + crowu(e) * 1024)[lo] = (xs + crowu(e) * 1024)[lo] + gv * acc[i][j][e];
      }
    }
  }
}

DI void phase_final(const Params& p) {
  const int lane = otid() & 63, wid = __builtin_amdgcn_readfirstlane(otid() >> 6);
  const float* nw = p.in[I_FNW];
  for (int item = blockIdx.x; item < NT / 4; item += gridDim.x) {
    float* x = p.out + (size_t)(item * 4 + wid) * 1024;
    f32x4 v[4]; float ss = 0.f;
#pragma unroll
    for (int i = 0; i < 4; ++i) { v[i] = *(const f32x4*)(x + lane * 4 + 256 * i); ss += v[i].x * v[i].x + v[i].y * v[i].y + v[i].z * v[i].z + v[i].w * v[i].w; }
#pragma unroll
    for (int o = 1; o < 64; o <<= 1) ss += __shfl_xor(ss, o);
    const float rs = rsqrtf(ss * (1.0f / 1024.0f) + 1e-6f);
#pragma unroll
    for (int i = 0; i < 4; ++i) { const f32x4 w = *(const f32x4*)(nw + lane * 4 + 256 * i); *(f32x4*)(x + lane * 4 + 256 * i) = (f32x4){v[i].x * rs * w.x, v[i].y * rs * w.y, v[i].z * rs * w.z, v[i].w * rs * w.w}; }
  }
}

constexpr int NPHASES = 1 + 4 * 9 + 1;
__global__ void __launch_bounds__(256, 2) fwd_kernel(Params p) {
  __shared__ __attribute__((aligned(16))) char smem[SMEM_BYTES];
  cg::grid_group grid = cg::this_grid();
  for (int ph = p.ph_begin; ph < p.ph_end; ++ph) {
    if (ph == 0) phase_prologue(p, smem);
    else if (ph == NPHASES - 1) phase_final(p);
    else {
      const int l = (ph - 1) / 9, sp = (ph - 1) % 9;
      switch (sp) {
        case 0: phase_norm_convert(p, l, smem); break;
        case 1: phase_gemm1(p, l, smem); break;
        case 2: phase_post(p, l); break;
        case 3: phase_upproj(p, smem); break;
        case 4: phase_mixers(p, l, smem); break;
        case 5: phase_renorm_cpost(p, l); break;
        case 6: phase_zgemm(p, smem); break;
        case 7: phase_merge(p, smem); break;
        default: phase_out(p, l, smem); break;
      }
    }
    if (ph + 1 < p.ph_end) grid.sync();
  }
}

extern "C" void kernel_launch(void* const* d_in, const int* in_sizes, int n_in, void* d_out, int out_size, void* d_ws, size_t ws_size, hipStream_t stream) {
  if (ws_size < WS_NEED || n_in < 35) { fprintf(stderr, "workspace too small: %zu < %zu\n", ws_size, WS_NEED); return; }
  static int grid_blocks = 0;
  if (!grid_blocks) {
    int dev = 0, cus = 0, per_cu = 0;
    hipGetDevice(&dev);
    hipDeviceGetAttribute(&cus, hipDeviceAttributeMultiprocessorCount, dev);
    hipOccupancyMaxActiveBlocksPerMultiprocessor(&per_cu, fwd_kernel, 256, 0);
    if (per_cu < 1) per_cu = 1;
    if (per_cu > 2) per_cu = 2;
    grid_blocks = cus * per_cu;
  }
  Params p{};
  for (int i = 0; i < 35; ++i) p.in[i] = (const float*)d_in[i];
  p.out = (float*)d_out; p.ws = (char*)d_ws;
#ifndef ONE_LAUNCH
  for (int ph = 0; ph < NPHASES; ++ph) {
    p.ph_begin = ph; p.ph_end = ph + 1;
    hipLaunchKernelGGL(fwd_kernel, dim3(grid_blocks), dim3(256), 0, stream, p);
  }
#else
  p.ph_begin = 0; p.ph_end = NPHASES;
  void* args[] = {&p};
  hipError_t e = hipLaunchCooperativeKernel((void*)fwd_kernel, dim3(grid_blocks), dim3(256), args, 0, stream);
  if (e != hipSuccess) fprintf(stderr, "cooperative launch failed: %s (grid %d)\n", hipGetErrorString(e), grid_blocks);
#endif
}
```

```cpp
#define ONE_LAUNCH 1
#include <hip/hip_runtime.h>
#include <hip/hip_cooperative_groups.h>
#include <stdint.h>
#include <stdio.h>
namespace cg = cooperative_groups;

typedef unsigned short bf16_t;
typedef short bf16x8 __attribute__((ext_vector_type(8)));
typedef float f32x16 __attribute__((ext_vector_type(16)));
typedef float f32x4 __attribute__((ext_vector_type(4)));
typedef float f32x2 __attribute__((ext_vector_type(2)));
typedef unsigned u32x4 __attribute__((ext_vector_type(4)));
typedef unsigned u32x2 __attribute__((ext_vector_type(2)));
#define DI __device__ __forceinline__
#define MFMA32(a, b, c) __builtin_amdgcn_mfma_f32_32x32x16_bf16((a), (b), (c), 0, 0, 0)

constexpr int NT = 40960;
constexpr int NCTX = 8192;
constexpr int NK = 45056;
constexpr int ULD = 3488;
constexpr int MODLD = 3072;
constexpr int SMEM_BYTES = 78848;

constexpr size_t OFF_WIN = 0;
constexpr size_t OFF_WO = 16777216;
constexpr size_t OFF_WOUT = 19922944;
constexpr size_t OFF_WU = 22020096;
constexpr size_t OFF_MOD = 22282240;
constexpr size_t OFF_BONUS = 22724608;
constexpr size_t OFF_CS16 = 25346048;
constexpr size_t OFF_CS8 = 25354240;
constexpr size_t OFF_CNT = 25358336;
constexpr size_t OFF_U = 25358592;
constexpr size_t OFF_R1 = 311095552;
constexpr size_t OFF_KA = OFF_R1;
constexpr size_t OFF_VAT = 513208576;
constexpr size_t OFF_KN = OFF_R1 + 23068672;
constexpr size_t OFF_VBT = OFF_R1 + 69206016;
constexpr size_t OFF_KRB = OFF_R1 + 115343360;
constexpr size_t OFF_R2 = 429322496;
constexpr size_t WS_NEED = 524742912;

constexpr size_t OUT_AK = 41943040, OUT_AV = 46137344, OUT_CKV = 50331648, OUT_KR = 54525952, OUT_SF = 55574528, OUT_SB = 59768832;

struct Params {
  const float* in[35];
  float* out;
  char* ws;
  int ph_begin, ph_end;
};

enum { I_XP = 0, I_XS, I_CAK, I_CAV, I_CCKV, I_CKR, I_SF, I_SB, I_C, I_CCTX, I_NORMW, I_WMOD, I_BMOD, I_WIN, I_QNW, I_KNW, I_KVNW,
       I_WUK, I_WUV, I_MUP, I_MUN, I_W0, I_WUP, I_A0, I_AUP, I_KK, I_KA, I_RK, I_LNW, I_LNB, I_WOA, I_WOB, I_WOC, I_WOUT, I_FNW };

DI int threadIdx_x_raw() { return __builtin_amdgcn_workitem_id_x(); }
DI int otid() { int t = threadIdx_x_raw(); asm volatile("" : "+v"(t)); return t; }
DI const float* opq(const float* q) { asm volatile("" : "+s"(q)); return q; }
DI float* opq(float* q) { asm volatile("" : "+s"(q)); return q; }
DI float bf2f(bf16_t v) { return __uint_as_float(((unsigned)v) << 16); }
typedef __bf16 hbf16x2 __attribute__((ext_vector_type(2)));
DI unsigned pack2(float a, float b) { f32x2 v = {a, b}; hbf16x2 r = __builtin_convertvector(v, hbf16x2); return __builtin_bit_cast(unsigned, r); }
DI bf16_t f2bf(float x) { return (bf16_t)(pack2(x, 0.f) & 0xffffu); }
DI float xsum16(float x) { const unsigned u = __float_as_uint(x); auto r = __builtin_amdgcn_permlane16_swap(u, u, false, false); return __uint_as_float(r[0]) + __uint_as_float(r[1]); }
DI float xsum32(float x) { const unsigned u = __float_as_uint(x); auto r = __builtin_amdgcn_permlane32_swap(u, u, false, false); return __uint_as_float(r[0]) + __uint_as_float(r[1]); }
DI float lo16(unsigned w) { return __uint_as_float(w << 16); }
DI float hi16(unsigned w) { return __uint_as_float(w & 0xffff0000u); }
DI void unpack8(u32x4 w, float* v) { v[0] = lo16(w.x); v[1] = hi16(w.x); v[2] = lo16(w.y); v[3] = hi16(w.y); v[4] = lo16(w.z); v[5] = hi16(w.z); v[6] = lo16(w.w); v[7] = hi16(w.w); }
DI u32x4 pack8(const float* v) { u32x4 w; w.x = pack2(v[0], v[1]); w.y = pack2(v[2], v[3]); w.z = pack2(v[4], v[5]); w.w = pack2(v[6], v[7]); return w; }
DI int crow(int reg, int h) { return (reg & 3) + 8 * (reg >> 2) + 4 * h; }
DI int crowu(int reg) { return (reg & 3) + 8 * (reg >> 2); }
DI int perm16(int t) { return (t & ~12) | ((t & 4) << 1) | ((t & 8) >> 1); }
DI float sigmoidf_(float x) { return 1.0f / (1.0f + __expf(-x)); }
DI float siluf_(float x) { return x / (1.0f + __expf(-x)); }

DI void row_decode(int row, int& seq, int& t) {
  if (row < NCTX) { seq = row >> 8; t = row & 255; } else { seq = 32 + ((row - NCTX) >> 12); t = (row - NCTX) & 4095; }
}
DI int keyrow0(int seq) { return seq < 32 ? seq * 256 : NCTX + (seq - 32) * 4608; }
DI int seq_tk(int seq) { return seq < 32 ? 256 : 4608; }

template <int NJ>
DI void gemm_mainloop(f32x16 (&acc)[2][NJ], const bf16_t* __restrict__ A, int lda, int ks,
                      const bf16_t* __restrict__ Bt, int ldb, int K, char* smem) {
  constexpr int A_BYTES = 128 * 128;
  constexpr int B_BYTES = 64 * NJ * 128;
  constexpr int STAGE = A_BYTES + B_BYTES;
  const int tid = otid(), lane = tid & 63, wid = __builtin_amdgcn_readfirstlane(tid >> 6), wm = wid >> 1, wn = wid & 1;
  const int r = lane & 31, hh = lane >> 5;
  const int nk = K >> 6;
  const int lrow = tid >> 3, lc = tid & 7;
  u32x4 ra[4], rb[2 * NJ];
  const bf16_t* ap = A + (size_t)lrow * lda + lc * 8;
  const bf16_t* bp = Bt + (size_t)lrow * ldb + lc * 8;
#pragma unroll
  for (int p = 0; p < 4; ++p) ra[p] = *(const u32x4*)(ap + (size_t)(32 * p) * lda);
#pragma unroll
  for (int p = 0; p < 2 * NJ; ++p) rb[p] = *(const u32x4*)(bp + (size_t)(32 * p) * ldb);
  {
    char* base = smem;
#pragma unroll
    for (int p = 0; p < 4; ++p) { const int row = lrow + 32 * p; *(u32x4*)(base + row * 128 + ((lc ^ ((row >> 1) & 7)) << 4)) = ra[p]; }
#pragma unroll
    for (int p = 0; p < 2 * NJ; ++p) { const int row = lrow + 32 * p; *(u32x4*)(base + A_BYTES + row * 128 + ((lc ^ ((row >> 1) & 7)) << 4)) = rb[p]; }
  }
  __syncthreads();
  for (int kt = 0; kt < nk; ++kt) {
    if (kt + 1 < nk) {
      const bf16_t* ap2 = ap + (size_t)(kt + 1) * ks;
      const bf16_t* bp2 = bp + (size_t)(kt + 1) * 64;
#pragma unroll
      for (int p = 0; p < 4; ++p) ra[p] = *(const u32x4*)(ap2 + (size_t)(32 * p) * lda);
#pragma unroll
      for (int p = 0; p < 2 * NJ; ++p) rb[p] = *(const u32x4*)(bp2 + (size_t)(32 * p) * ldb);
    }
    const char* base = smem + (kt & 1) * STAGE;
#pragma unroll
    for (int s = 0; s < 4; ++s) {
      bf16x8 af[2], bfr[NJ];
#pragma unroll
      for (int i = 0; i < 2; ++i) { const int row = wm * 64 + i * 32 + r; af[i] = *(const bf16x8*)(base + row * 128 + (((2 * s + hh) ^ ((row >> 1) & 7)) << 4)); }
#pragma unroll
      for (int j = 0; j < NJ; ++j) { const int row = wn * (32 * NJ) + j * 32 + r; bfr[j] = *(const bf16x8*)(base + A_BYTES + row * 128 + (((2 * s + hh) ^ ((row >> 1) & 7)) << 4)); }
#pragma unroll
      for (int i = 0; i < 2; ++i)
#pragma unroll
        for (int j = 0; j < NJ; ++j) acc[i][j] = MFMA32(af[i], bfr[j], acc[i][j]);
    }
    if (kt + 1 < nk) {
      char* nb = smem + ((kt + 1) & 1) * STAGE;
#pragma unroll
      for (int p = 0; p < 4; ++p) { const int row = lrow + 32 * p; *(u32x4*)(nb + row * 128 + ((lc ^ ((row >> 1) & 7)) << 4)) = ra[p]; }
#pragma unroll
      for (int p = 0; p < 2 * NJ; ++p) { const int row = lrow + 32 * p; *(u32x4*)(nb + A_BYTES + row * 128 + ((lc ^ ((row >> 1) & 7)) << 4)) = rb[p]; }
    }
    __syncthreads();
  }
}

template <int NJ> DI void zero_acc(f32x16 (&acc)[2][NJ]) {
#pragma unroll
  for (int i = 0; i < 2; ++i)
#pragma unroll
    for (int j = 0; j < NJ; ++j)
#pragma unroll
      for (int e = 0; e < 16; ++e) acc[i][j][e] = 0.f;
}

DI void phase_prologue(const Params& p, char* smem) {
  const int tid = otid(), lane = tid & 63, wid = __builtin_amdgcn_readfirstlane(tid >> 6);
  float* mod = (float*)(p.ws + OFF_MOD);
  if (blockIdx.x == 0) {
    if (tid < 64) ((unsigned*)(p.ws + OFF_CNT))[tid] = 0u;
    float* cs16 = (float*)(p.ws + OFF_CS16);
    float* cs8 = (float*)(p.ws + OFF_CS8);
    for (int e = tid; e < 64 * 16; e += 256) { const int pos = e >> 4, i = e & 15; const float inv = expf(-9.210340371976184f * (float)i / 16.0f); const float a = (float)pos * inv; cs16[e * 2] = cosf(a); cs16[e * 2 + 1] = sinf(a); }
    for (int e = tid; e < 64 * 8; e += 256) { const int pos = e >> 3, i = e & 7; const float inv = expf(-9.210340371976184f * (float)i / 8.0f); const float a = (float)pos * inv; cs8[e * 2] = cosf(a); cs8[e * 2 + 1] = sinf(a); }
  }
  float* sl = (float*)smem;
  float* red = sl + 9 * 1024;
  for (int e = tid; e < 9 * 1024; e += 256) { const int j = e >> 10, k = e & 1023; const float* cc0 = opq(p.in[I_CCTX]); const float* cc1 = opq(p.in[I_C]); const float c = j == 0 ? cc0[k] : cc1[(j - 1) * 1024 + k]; sl[e] = siluf_(c); }
  __syncthreads();
  for (int item = blockIdx.x; item < 192; item += gridDim.x) {
    const int l = item / 48, n = (item % 48) * 64 + lane;
    const float* w = p.in[I_WMOD] + (size_t)l * 1024 * 3072 + n;
    float a[9];
#pragma unroll
    for (int j = 0; j < 9; ++j) a[j] = 0.f;
    for (int k = wid * 256; k < wid * 256 + 256; ++k) {
      const float wv = w[(size_t)k * 3072];
#pragma unroll
      for (int j = 0; j < 9; ++j) a[j] += sl[j * 1024 + k] * wv;
    }
#pragma unroll
    for (int j = 0; j < 9; ++j) red[(wid * 9 + j) * 64 + lane] = a[j];
    __syncthreads();
    for (int e = tid; e < 9 * 64; e += 256) {
      const int j = e >> 6, c = e & 63;
      const float s = red[(0 * 9 + j) * 64 + c] + red[(1 * 9 + j) * 64 + c] + red[(2 * 9 + j) * 64 + c] + red[(3 * 9 + j) * 64 + c];
      const int nn = (item % 48) * 64 + c;
      mod[((size_t)l * 9 + j) * MODLD + nn] = s + p.in[I_BMOD][l * 3072 + nn];
    }
    __syncthreads();
  }
}

DI const float* x_row_ptr(const Params& p, int l, int row) {
  const float* xp = opq(p.in[I_XP]); const float* xs = opq(p.in[I_XS]); const float* xo = opq((const float*)p.out);
  if (l == 0) return row < NCTX ? xp + (size_t)row * 1024 : xs + (size_t)(row - NCTX) * 1024;
  return xo + (size_t)row * 1024;
}
DI void norm_row(const Params& p, int l, int row, int lane) {
  const float* x = x_row_ptr(p, l, row);
  const int j = row < NCTX ? 0 : 1 + ((row - NCTX) >> 12);
  const float* mod = (const float*)(p.ws + OFF_MOD) + ((size_t)l * 9 + j) * MODLD;
  const float* nw = p.in[I_NORMW] + l * 1024;
  bf16_t* h = (bf16_t*)(p.ws + OFF_R1) + (size_t)row * 1024;
  f32x4 v[4]; float ss = 0.f;
#pragma unroll
  for (int i = 0; i < 4; ++i) { v[i] = *(const f32x4*)(x + lane * 4 + 256 * i); ss += v[i].x * v[i].x + v[i].y * v[i].y + v[i].z * v[i].z + v[i].w * v[i].w; }
#pragma unroll
  for (int o = 1; o < 64; o <<= 1) ss += __shfl_xor(ss, o);
  const float rs = rsqrtf(ss * (1.0f / 1024.0f) + 1e-6f);
#pragma unroll
  for (int i = 0; i < 4; ++i) {
    const int c = lane * 4 + 256 * i;
    const f32x4 w = *(const f32x4*)(nw + c), sh = *(const f32x4*)(mod + c), sc = *(const f32x4*)(mod + 1024 + c);
    u32x2 o;
    o.x = pack2(v[i].x * rs * w.x * (1.f + sc.x) + sh.x, v[i].y * rs * w.y * (1.f + sc.y) + sh.y);
    o.y = pack2(v[i].z * rs * w.z * (1.f + sc.z) + sh.z, v[i].w * rs * w.w * (1.f + sc.w) + sh.w);
    *(u32x2*)(h + c) = o;
  }
}

DI int win_srccol(int j) {
  if (j < 768) return j;
  if (j < 1696) return j + 512;
  if (j < 3488) return j + 1024;
  if (j < 3584) return -1;
  if (j < 5120) { const int jj = j - 3584; return jj < 512 ? 768 + jj : (jj < 1024 ? 2208 + (jj - 512) : 4512 + (jj - 1024)); }
  return 5024 + (j - 5120);
}
DI void conv_tile(const float* __restrict__ src, int ld_src, bf16_t* dst, int ld_dst, int k0, int n0, int kind, int srcoff, char* smem) {
  float* tile = (float*)smem;
  const int tid = otid();
  const int n = tid & 63;
  int sc = kind == 0 ? win_srccol(n0 + n) : (n0 + n - srcoff);
#pragma unroll
  for (int i = 0; i < 16; ++i) { const int k = i * 4 + (tid >> 6); tile[k * 65 + n] = sc >= 0 ? src[(size_t)(k0 + k) * ld_src + sc] : 0.f; }
  __syncthreads();
#pragma unroll
  for (int i = 0; i < 8; ++i) { const int nn = i * 8 + (tid >> 5), kk = (tid & 31) * 2; *(unsigned*)(dst + (size_t)(n0 + nn) * ld_dst + k0 + kk) = pack2(tile[kk * 65 + nn], tile[(kk + 1) * 65 + nn]); }
  __syncthreads();
}

DI void phase_norm_convert(const Params& p, int l, char* smem) {
  const int tid = otid(), lane = tid & 63, wid = __builtin_amdgcn_readfirstlane(tid >> 6);
  bf16_t* WinT = (bf16_t*)(p.ws + OFF_WIN); bf16_t* WoT = (bf16_t*)(p.ws + OFF_WO); bf16_t* WoutT = (bf16_t*)(p.ws + OFF_WOUT); bf16_t* WuT = (bf16_t*)(p.ws + OFF_WU);
  const int NI_WIN = 128 * 16, NI_WO = 3 * 16 * 8, NI_WOUT = 16 * 16, NI_WU = 16 * 2;
  const int NI_CONV = NI_WIN + NI_WO + NI_WOUT + NI_WU;
  for (int item = blockIdx.x; item < NI_CONV; item += gridDim.x) {
    int it = item;
    if (it < NI_WIN) { conv_tile(p.in[I_WIN] + (size_t)l * 1024 * 8096, 8096, WinT, 1024, (it & 15) * 64, (it >> 4) * 64, 0, 0, smem); continue; }
    it -= NI_WIN;
    if (it < NI_WO) { const int br = it / 128, r2 = it % 128; const float* src = (br == 0 ? opq(p.in[I_WOA]) : (br == 1 ? opq(p.in[I_WOB]) : opq(p.in[I_WOC]))) + (size_t)l * 512 * 1024; conv_tile(src, 1024, WoT + (size_t)br * 1024 * 512, 512, (r2 & 7) * 64, (r2 >> 3) * 64, 1, 0, smem); continue; }
    it -= NI_WO;
    if (it < NI_WOUT) { conv_tile(p.in[I_WOUT] + (size_t)l * 1024 * 1024, 1024, WoutT, 1024, (it & 15) * 64, (it >> 4) * 64, 1, 0, smem); continue; }
    it -= NI_WOUT;
    { const int nt = it >> 1, kt = it & 1; const bool uv = nt >= 8; const float* src = (uv ? opq(p.in[I_WUV]) : opq(p.in[I_WUK])) + (size_t)l * 128 * 512; conv_tile(src, 512, WuT, 128, kt * 64, nt * 64, 1, uv ? 512 : 0, smem); }
  }
  for (int item = blockIdx.x; item < NT / 4; item += gridDim.x) norm_row(p, l, item * 4 + wid, lane);
}

DI void phase_gemm1(const Params& p, int l, char* smem) {
  const int lane = otid() & 63, wid = __builtin_amdgcn_readfirstlane(otid() >> 6), wm = wid >> 1, wn = wid & 1, r = lane & 31, hh = lane >> 5;
  const bf16_t* H = (const bf16_t*)(p.ws + OFF_R1);
  const bf16_t* W = (const bf16_t*)(p.ws + OFF_WIN);
  bf16_t* U = (bf16_t*)(p.ws + OFF_U);
  bf16_t* VAT = (bf16_t*)(p.ws + OFF_VAT);
  const int NTN = 28, ntiles = 320 * NTN;
  for (int tile = blockIdx.x; tile < ntiles; tile += gridDim.x) {
    const int mt = tile / NTN, nt = tile % NTN, m0 = mt * 128, n0 = nt * 128;
    f32x16 acc[2][2]; zero_acc<2>(acc);
    gemm_mainloop<2>(acc, H + (size_t)m0 * 1024, 1024, 64, W + (size_t)n0 * 1024, 1024, 1024, smem);
    int seq, t0; row_decode(m0, seq, t0);
#pragma unroll
    for (int j = 0; j < 2; ++j) {
      const int cb = n0 + wn * 64 + j * 32;
      if (cb >= ULD) continue;
      const int col = cb + r;
      if (cb >= 640 && cb < 768) {
        const int kvh = (col - 640) >> 6, dv = col & 63, Tk = seq_tk(seq);
        bf16_t* vt = VAT + (size_t)128 * keyrow0(seq) + (size_t)(kvh * 64 + dv) * Tk;
#pragma unroll
        for (int i = 0; i < 2; ++i) {
          const int tt = t0 + wm * 64 + i * 32;
#pragma unroll
          for (int g2 = 0; g2 < 2; ++g2) {
            float v[8];
#pragma unroll
            for (int e = 0; e < 8; ++e) v[e] = acc[i][j][g2 * 8 + e];
            *(u32x4*)(vt + tt + 16 * g2 + 8 * hh) = pack8(v);
          }
          if (seq < 32) {
            float* o = p.out + OUT_AV + ((size_t)(seq * 4 + l) * 256 + tt) * 128;
            const int lo = 4 * hh * 128 + (col - 640);
#pragma unroll
            for (int e = 0; e < 16; ++e) (o + crowu(e) * 128)[lo] = acc[i][j][e];
          }
        }
      } else {
#pragma unroll
        for (int i = 0; i < 2; ++i) {
          bf16_t* up = U + (size_t)(m0 + wm * 64 + i * 32) * ULD;
          const int lo = 4 * hh * ULD + col;
#pragma unroll
          for (int e = 0; e < 16; ++e) (up + crowu(e) * ULD)[lo] = f2bf(acc[i][j][e]);
        }
      }
    }
  }
}

DI void post_row(const Params& p, int l, int row, int lane) {
  int seq, t; row_decode(row, seq, t);
  const bool lat = row >= NCTX;
  const int krow = keyrow0(seq) + t;
  const int prow = t >> 6, pcol = t & 63;
  bf16_t* u = (bf16_t*)(p.ws + OFF_U) + (size_t)row * ULD;
  const float* cs16 = (const float*)(p.ws + OFF_CS16);
  const float* cs8 = (const float*)(p.ws + OFF_CS8);
  const float LOG2E = 1.4426950408889634f;
#pragma unroll
  for (int which = 0; which < 2; ++which) {
    const int l8 = which == 0 ? lane : (lane & 15);
    const bf16_t* src = u + (which == 0 ? 0 : 512) + l8 * 8;
    float v[8]; unpack8(*(const u32x4*)src, v);
    float ss = 0.f;
#pragma unroll
    for (int i = 0; i < 8; ++i) ss += v[i] * v[i];
    ss += __shfl_xor(ss, 1); ss += __shfl_xor(ss, 2); ss += __shfl_xor(ss, 4);
    const float rs = rsqrtf(ss * (1.0f / 64.0f) + 1e-6f);
    const float* nw = (which == 0 ? opq(p.in[I_QNW]) : opq(p.in[I_KNW])) + l * 64 + (lane & 7) * 8;
#pragma unroll
    for (int i = 0; i < 8; ++i) v[i] = v[i] * rs * nw[i];
    float pv[8];
#pragma unroll
    for (int i = 0; i < 8; ++i) pv[i] = __shfl_xor(v[i], 2);
    if (lat) {
      const int pos = ((lane & 7) >> 2) ? pcol : prow;
      const bool lower = (lane & 2) == 0;
      const float* cs = cs16 + (pos * 16 + (lane & 1) * 8) * 2;
#pragma unroll
      for (int i = 0; i < 8; ++i) { const float c = cs[i * 2], s = cs[i * 2 + 1]; v[i] = lower ? v[i] * c - pv[i] * s : v[i] * c + pv[i] * s; }
    }
    if (which == 0) {
      const float sc = 0.125f * LOG2E;
#pragma unroll
      for (int i = 0; i < 8; ++i) v[i] *= sc;
      *(u32x4*)(u + lane * 8) = pack8(v);
    } else if (lane < 16) {
      bf16_t* KA = (bf16_t*)(p.ws + OFF_KA);
      *(u32x4*)(KA + (size_t)krow * 128 + lane * 8) = pack8(v);
      if (!lat) {
        float* o = p.out + OUT_AK + ((size_t)(seq * 4 + l) * 256 + t) * 128 + lane * 8;
        *(f32x4*)o = (f32x4){v[0], v[1], v[2], v[3]}; *(f32x4*)(o + 4) = (f32x4){v[4], v[5], v[6], v[7]};
      }
    }
  }
  {
    const float sc = 0.10206207261596577f * LOG2E;
    const int hd = lane >> 3;
    bf16_t* q = u + 768 + hd * 96;
    { float v[8]; unpack8(*(const u32x4*)(q + (lane & 7) * 8), v);
#pragma unroll
      for (int i = 0; i < 8; ++i) v[i] *= sc;
      *(u32x4*)(q + (lane & 7) * 8) = pack8(v); }
    { bf16_t* qr = q + 64 + (lane & 7) * 4;
      const u32x2 w = *(const u32x2*)qr;
      float v[4] = {lo16(w.x), hi16(w.x), lo16(w.y), hi16(w.y)}, pv[4];
#pragma unroll
      for (int i = 0; i < 4; ++i) pv[i] = __shfl_xor(v[i], 2);
      if (lat) {
        const int pos = ((lane & 7) >> 2) ? pcol : prow;
        const bool lower = (lane & 2) == 0;
        const float* cs = cs8 + (pos * 8 + (lane & 1) * 4) * 2;
#pragma unroll
        for (int i = 0; i < 4; ++i) { const float c = cs[i * 2], s = cs[i * 2 + 1]; v[i] = lower ? v[i] * c - pv[i] * s : v[i] * c + pv[i] * s; }
      }
      u32x2 o; o.x = pack2(v[0] * sc, v[1] * sc); o.y = pack2(v[2] * sc, v[3] * sc);
      *(u32x2*)qr = o; }
  }
  {
    const unsigned w = *(const unsigned*)(u + 1536 + lane * 2);
    float a = lo16(w), b = hi16(w);
    float ss = a * a + b * b;
#pragma unroll
    for (int o = 1; o < 64; o <<= 1) ss += __shfl_xor(ss, o);
    const float rs = rsqrtf(ss * (1.0f / 128.0f) + 1e-6f);
    const float* nw = p.in[I_KVNW] + l * 128 + lane * 2;
    a = a * rs * nw[0]; b = b * rs * nw[1];
    bf16_t* CKVN = (bf16_t*)(p.ws + OFF_R2);
    *(unsigned*)(CKVN + (size_t)krow * 128 + lane * 2) = pack2(a, b);
    if (!lat) { float* o = p.out + OUT_CKV + ((size_t)(seq * 4 + l) * 256 + t) * 128 + lane * 2; *(f32x2*)o = (f32x2){a, b}; }
  }
  {
    float v = bf2f(u[1664 + (lane & 31)]);
    const float pv = __shfl_xor(v, 8);
    if (!lat) { if (lane < 32) p.out[OUT_KR + ((size_t)(seq * 4 + l) * 256 + t) * 32 + lane] = v; }
    else {
      const int d = lane & 31; const int pos = (d >> 4) ? pcol : prow; const bool lower = (d & 8) == 0;
      const float* cs = cs8 + (pos * 8 + (d & 7)) * 2;
      v = lower ? v * cs[0] - pv * cs[1] : v * cs[0] + pv * cs[1];
    }
    if (lane < 32) ((bf16_t*)(p.ws + OFF_KRB))[(size_t)krow * 32 + lane] = f2bf(v);
  }
}
DI void post_cached_row(const Params& p, int l, int idx, int lane) {
  const int b = idx >> 9, j = idx & 511;
  const int kr0 = NCTX + b * 4608, krow = kr0 + 4096 + j;
  const size_t cb = ((size_t)(b * 4 + l) * 512 + j);
  bf16_t* KA = (bf16_t*)(p.ws + OFF_KA); bf16_t* VAT = (bf16_t*)(p.ws + OFF_VAT); bf16_t* CKVN = (bf16_t*)(p.ws + OFF_R2); bf16_t* KRB = (bf16_t*)(p.ws + OFF_KRB);
  { const f32x2 v = *(const f32x2*)(p.in[I_CAK] + cb * 128 + lane * 2); *(unsigned*)(KA + (size_t)krow * 128 + lane * 2) = pack2(v.x, v.y); }
  { const f32x2 v = *(const f32x2*)(p.in[I_CAV] + cb * 128 + lane * 2);
    bf16_t* vt = VAT + (size_t)128 * kr0 + (size_t)(lane * 2) * 4608 + perm16(4096 + j);
    vt[0] = f2bf(v.x); vt[4608] = f2bf(v.y); }
  { const f32x2 v = *(const f32x2*)(p.in[I_CCKV] + cb * 128 + lane * 2); *(unsigned*)(CKVN + (size_t)krow * 128 + lane * 2) = pack2(v.x, v.y); }
  if (lane < 32) KRB[(size_t)krow * 32 + lane] = f2bf(p.in[I_CKR][cb * 32 + lane]);
}
DI void phase_post(const Params& p, int l) {
  const int lane = otid() & 63, wid = __builtin_amdgcn_readfirstlane(otid() >> 6);
  for (int item = blockIdx.x; item < NT / 4 + 1024; item += gridDim.x) {
    if (item < NT / 4) post_row(p, l, item * 4 + wid, lane);
    else post_cached_row(p, l, (item - NT / 4) * 4 + wid, lane);
  }
}

DI void phase_upproj(const Params& p, char* smem) {
  const int lane = otid() & 63, wid = __builtin_amdgcn_readfirstlane(otid() >> 6), wm = wid >> 1, wn = wid & 1, r = lane & 31, hh = lane >> 5;
  const bf16_t* A = (const bf16_t*)(p.ws + OFF_R2);
  const bf16_t* W = (const bf16_t*)(p.ws + OFF_WU);
  bf16_t* KN = (bf16_t*)(p.ws + OFF_KN); bf16_t* VBT = (bf16_t*)(p.ws + OFF_VBT);
  const int ntiles = 352 * 8;
  for (int tile = blockIdx.x; tile < ntiles; tile += gridDim.x) {
    const int mt = tile >> 3, nt = tile & 7, m0 = mt * 128, n0 = nt * 128;
    f32x16 acc[2][2]; zero_acc<2>(acc);
    gemm_mainloop<2>(acc, A + (size_t)m0 * 128, 128, 64, W + (size_t)n0 * 128, 128, 128, smem);
    int seq, t0;
    if (m0 < NCTX) { seq = m0 >> 8; t0 = m0 & 255; } else { const int rr = m0 - NCTX; seq = 32 + rr / 4608; t0 = rr % 4608; }
#pragma unroll
    for (int j = 0; j < 2; ++j) {
      const int col = n0 + wn * 64 + j * 32 + r;
      if (n0 < 512) {
#pragma unroll
        for (int i = 0; i < 2; ++i) {
          bf16_t* kp = KN + (size_t)(m0 + wm * 64 + i * 32) * 512;
          const int lo = 4 * hh * 512 + col;
#pragma unroll
          for (int e = 0; e < 16; ++e) (kp + crowu(e) * 512)[lo] = f2bf(acc[i][j][e]);
        }
      } else {
        const int Tk = seq_tk(seq);
        bf16_t* vt = VBT + (size_t)512 * keyrow0(seq) + (size_t)(col - 512) * Tk;
#pragma unroll
        for (int i = 0; i < 2; ++i) {
          const int tt = t0 + wm * 64 + i * 32;
#pragma unroll
          for (int g2 = 0; g2 < 2; ++g2) {
            float v[8];
#pragma unroll
            for (int e = 0; e < 8; ++e) v[e] = acc[i][j][g2 * 8 + e];
            *(u32x4*)(vt + tt + 16 * g2 + 8 * hh) = pack8(v);
          }
        }
      }
    }
  }
}

template <int DQK>
DI void attn_item(const bf16_t* Qw, int q_ld, const bf16_t* K1, int k1_ld, const bf16_t* K2, int k2_ld,
                  const bf16_t* Vt, int vt_ld, int nkeys, bf16_t* Ow, int o_ld, char* smem) {
  constexpr int KS = DQK * 2 + 16;
  constexpr int KBYTES = 64 * KS;
  constexpr int VS = 144;
  constexpr int VBYTES = 64 * VS;
  constexpr int STAGE = KBYTES + VBYTES;
  constexpr int CPR = DQK / 8;
  constexpr int NKC = 64 * CPR / 256;
  constexpr int NS = DQK / 16;
  const int tid = otid(), lane = tid & 63, r = lane & 31, hh = lane >> 5;
  bf16x8 qf[NS];
#pragma unroll
  for (int s = 0; s < NS; ++s) qf[s] = *(const bf16x8*)(Qw + (size_t)r * q_ld + 16 * s + 8 * hh);
  f32x16 o[2];
#pragma unroll
  for (int n = 0; n < 2; ++n)
#pragma unroll
    for (int e = 0; e < 16; ++e) o[n][e] = 0.f;
  float m_run = -1e30f, lsum = 0.f;
  u32x4 rk[NKC], rv[2];
  int krow_[NKC], kc_[NKC];
#pragma unroll
  for (int q = 0; q < NKC; ++q) { const int id = q * 256 + tid; krow_[q] = id / CPR; kc_[q] = id % CPR; }
  const int vrow = tid >> 3, vc = tid & 7;
  auto gload = [&](int key0) {
#pragma unroll
    for (int q = 0; q < NKC; ++q) {
      const bf16_t* src = (DQK == 64 || kc_[q] < 8) ? K1 + (size_t)(key0 + krow_[q]) * k1_ld + kc_[q] * 8 : K2 + (size_t)(key0 + krow_[q]) * k2_ld + (kc_[q] - 8) * 8;
      rk[q] = *(const u32x4*)src;
    }
#pragma unroll
    for (int q = 0; q < 2; ++q) rv[q] = *(const u32x4*)(Vt + (size_t)(vrow + 32 * q) * vt_ld + key0 + vc * 8);
  };
  auto lstore = [&](int buf) {
    char* base = smem + buf * STAGE;
#pragma unroll
    for (int q = 0; q < NKC; ++q) *(u32x4*)(base + krow_[q] * KS + kc_[q] * 16) = rk[q];
#pragma unroll
    for (int q = 0; q < 2; ++q) *(u32x4*)(base + KBYTES + (vrow + 32 * q) * VS + vc * 16) = rv[q];
  };
  const int ntl = nkeys >> 6;
  gload(0); lstore(0); __syncthreads();
  for (int tl = 0; tl < ntl; ++tl) {
    if (tl + 1 < ntl) gload((tl + 1) * 64);
    const char* base = smem + (tl & 1) * STAGE;
    f32x16 s[2];
#pragma unroll
    for (int kb = 0; kb < 2; ++kb) {
#pragma unroll
      for (int e = 0; e < 16; ++e) s[kb][e] = 0.f;
#pragma unroll
      for (int ks = 0; ks < NS; ++ks) {
        const bf16x8 kf = *(const bf16x8*)(base + (kb * 32 + r) * KS + (2 * ks + hh) * 16);
        s[kb] = MFMA32(kf, qf[ks], s[kb]);
      }
    }
    float mx = s[0][0];
#pragma unroll
    for (int kb = 0; kb < 2; ++kb)
#pragma unroll
      for (int e = 0; e < 16; ++e) mx = fmaxf(mx, s[kb][e]);
    mx = fmaxf(mx, __shfl_xor(mx, 32));
    const float m_new = fmaxf(m_run, mx);
    const float alpha = __builtin_amdgcn_exp2f(m_run - m_new);
    m_run = m_new;
    float ps = 0.f;
#pragma unroll
    for (int kb = 0; kb < 2; ++kb)
#pragma unroll
      for (int e = 0; e < 16; ++e) { const float pe = __builtin_amdgcn_exp2f(s[kb][e] - m_new); s[kb][e] = pe; ps += pe; }
    lsum = lsum * alpha + ps;
#pragma unroll
    for (int n = 0; n < 2; ++n)
#pragma unroll
      for (int e = 0; e < 16; ++e) o[n][e] *= alpha;
#pragma unroll
    for (int kb = 0; kb < 2; ++kb)
#pragma unroll
      for (int s2 = 0; s2 < 2; ++s2) {
        u32x4 pw;
        pw.x = pack2(s[kb][8 * s2 + 0], s[kb][8 * s2 + 1]); pw.y = pack2(s[kb][8 * s2 + 2], s[kb][8 * s2 + 3]);
        pw.z = pack2(s[kb][8 * s2 + 4], s[kb][8 * s2 + 5]); pw.w = pack2(s[kb][8 * s2 + 6], s[kb][8 * s2 + 7]);
        const bf16x8 pf = __builtin_bit_cast(bf16x8, pw);
#pragma unroll
        for (int n = 0; n < 2; ++n) {
          const bf16x8 vf = *(const bf16x8*)(base + KBYTES + (32 * n + r) * VS + (kb * 32 + 16 * s2 + 8 * hh) * 2);
          o[n] = MFMA32(vf, pf, o[n]);
        }
      }
    if (tl + 1 < ntl) lstore((tl + 1) & 1);
    __syncthreads();
  }
  lsum += __shfl_xor(lsum, 32);
  const float inv = 1.0f / lsum;
#pragma unroll
  for (int n = 0; n < 2; ++n)
#pragma unroll
    for (int g = 0; g < 4; ++g) {
      u32x2 w; w.x = pack2(o[n][4 * g] * inv, o[n][4 * g + 1] * inv); w.y = pack2(o[n][4 * g + 2] * inv, o[n][4 * g + 3] * inv);
      *(u32x2*)(Ow + (size_t)r * o_ld + 32 * n + 8 * g + 4 * hh) = w;
    }
}

DI void scan_item(const Params& p, int l, int seq, int hd, int dir, char* smem) {
  const int tid = otid(), lane = tid & 63, wv = __builtin_amdgcn_readfirstlane(tid >> 6);
  const int i16 = lane & 15, jq = lane >> 4, r = lane & 31, hh = lane >> 5;
  const bool lat = seq >= 32;
  const int T = lat ? 4096 : 256;
  const int row0 = lat ? NCTX + (seq - 32) * 4096 : seq * 256;
  float* vA = (float*)smem; float* vK = vA + 2048; float* vR = vK + 2048; float* vV = vR + 2048; float* vW = vV + 2048; float* vB = vW + 2048; float* ybuf = vB + 2048;
  char* raw = smem + 32768;
  char* wdx = smem + 57344; char* adx = smem + 61952;
  float* tmpb = (float*)(smem + 66816);
  const bf16_t* U = (const bf16_t*)(p.ws + OFF_U);
  bf16_t* Y = (bf16_t*)(p.ws + OFF_R2) + (dir ? (size_t)NT * 512 : 0);
  float* bonus = (float*)(p.ws + OFF_BONUS);
  const int irow = 16 * wv + i16;
  f32x2 S[8];
  if (lat) {
    const float* s0 = (dir ? opq(p.in[I_SB]) : opq(p.in[I_SF])) + ((size_t)((seq - 32) * 4 + l) * 8 + hd) * 4096 + irow * 64 + jq * 16;
#pragma unroll
    for (int q = 0; q < 4; ++q) { const f32x4 v = *(const f32x4*)(s0 + 4 * q); S[2 * q] = (f32x2){v.x, v.y}; S[2 * q + 1] = (f32x2){v.z, v.w}; }
  } else {
#pragma unroll
    for (int q = 0; q < 8; ++q) S[q] = (f32x2){0.f, 0.f};
  }
  const int mat = wv >> 1, ntc = wv & 1, cch = ntc * 32 + r, hc = hd * 64 + cch;
  bf16x8 bfrag[4];
  {
    const float* W = (mat ? opq(p.in[I_AUP]) : opq(p.in[I_WUP])) + (size_t)(l * 2 + dir) * 64 * 512 + hc;
#pragma unroll
    for (int s4 = 0; s4 < 4; ++s4) {
      float w8[8];
#pragma unroll
      for (int j = 0; j < 8; ++j) w8[j] = W[(size_t)(16 * s4 + 8 * hh + j) * 512];
      bfrag[s4] = __builtin_bit_cast(bf16x8, pack8(w8));
    }
  }
  const float bias = (mat ? opq(p.in[I_A0]) : opq(p.in[I_W0]))[(l * 2 + dir) * 512 + hc];
  const float kav = p.in[I_KA][l * 512 + hc], rkv = p.in[I_RK][l * 512 + hc];
  const float* mup = p.in[I_MUP] + l * 1792; const float* mun = p.in[I_MUN] + l * 1792;
  const int nch = T >> 5;
  u32x4 pre[6];
  auto prefetch = [&](int t0) {
#pragma unroll
    for (int q = 0; q < 6; ++q) {
      const int id = q * 256 + tid;
      const int row = id / 40, cc = id - row * 40, g = cc >> 3, c8 = cc & 7;
      const int t = t0 - 1 + row;
      const int col = (g < 3 ? g * 512 + hd * 64 : (g == 3 ? 1536 + dir * 64 : 1664 + dir * 64)) + c8 * 8;
      u32x4 v = (u32x4){0u, 0u, 0u, 0u};
      if (id < 1360 && t >= 0 && t < T) v = *(const u32x4*)(U + (size_t)(row0 + t) * ULD + 1696 + col);
      pre[q] = v;
    }
  };
  prefetch((dir ? nch - 1 : 0) * 32);
  for (int ci = 0; ci < nch; ++ci) {
    const int t0 = (dir ? nch - 1 - ci : ci) * 32;
#pragma unroll
    for (int q = 0; q < 6; ++q) { const int id = q * 256 + tid; if (id < 1360) *(u32x4*)(raw + id * 16) = pre[q]; }
    __syncthreads();
    if (ci + 1 < nch) prefetch((dir ? nch - 2 - ci : ci + 1) * 32);
    {
      const int tt = tid >> 3, sub = tid & 7;
#pragma unroll
      for (int g = 0; g < 5; ++g) {
        const int col = (g < 3 ? g * 512 + hd * 64 : (g == 3 ? 1536 + dir * 64 : 1664 + dir * 64)) + sub * 8;
        float c[8], pv[8], nx[8], x[8];
        unpack8(*(const u32x4*)(raw + (tt + 1) * 640 + (g * 8 + sub) * 16), c);
        unpack8(*(const u32x4*)(raw + tt * 640 + (g * 8 + sub) * 16), pv);
        unpack8(*(const u32x4*)(raw + (tt + 2) * 640 + (g * 8 + sub) * 16), nx);
        const f32x4 mp0 = *(const f32x4*)(mup + col), mp1 = *(const f32x4*)(mup + col + 4), mn0 = *(const f32x4*)(mun + col), mn1 = *(const f32x4*)(mun + col + 4);
        const float mp[8] = {mp0.x, mp0.y, mp0.z, mp0.w, mp1.x, mp1.y, mp1.z, mp1.w}, mn[8] = {mn0.x, mn0.y, mn0.z, mn0.w, mn1.x, mn1.y, mn1.z, mn1.w};
#pragma unroll
        for (int i = 0; i < 8; ++i) x[i] = c[i] + mp[i] * (pv[i] - c[i]) + mn[i] * (nx[i] - c[i]);
        const int lo = tt * 64 + sub * 8;
        if (g == 0) { *(f32x4*)(vR + lo) = (f32x4){x[0], x[1], x[2], x[3]}; *(f32x4*)(vR + lo + 4) = (f32x4){x[4], x[5], x[6], x[7]}; }
        else if (g == 1) {
          float kk[8], ss = 0.f;
          const float* kkw = p.in[I_KK] + l * 512 + hd * 64 + sub * 8;
#pragma unroll
          for (int i = 0; i < 8; ++i) { kk[i] = x[i] * kkw[i]; ss += kk[i] * kk[i]; }
          *(f32x4*)(vK + lo) = (f32x4){x[0], x[1], x[2], x[3]}; *(f32x4*)(vK + lo + 4) = (f32x4){x[4], x[5], x[6], x[7]};
          ss += __shfl_xor(ss, 1); ss += __shfl_xor(ss, 2); ss += __shfl_xor(ss, 4);
          const float inv = 1.0f / fmaxf(sqrtf(ss), 1e-12f);
          *(f32x4*)(vA + lo) = (f32x4){kk[0] * inv, kk[1] * inv, kk[2] * inv, kk[3] * inv}; *(f32x4*)(vA + lo + 4) = (f32x4){kk[4] * inv, kk[5] * inv, kk[6] * inv, kk[7] * inv};
        }
        else if (g == 2) { *(f32x4*)(vV + lo) = (f32x4){x[0], x[1], x[2], x[3]}; *(f32x4*)(vV + lo + 4) = (f32x4){x[4], x[5], x[6], x[7]}; }
        else if (g == 3) { float th[8]; for (int i = 0; i < 8; ++i) th[i] = tanhf(x[i]); *(u32x4*)(wdx + tt * 144 + sub * 16) = pack8(th); }
        else { *(u32x4*)(adx + tt * 144 + sub * 16) = pack8(x); }
      }
    }
    __syncthreads();
    {
      f32x16 acc;
#pragma unroll
      for (int e = 0; e < 16; ++e) acc[e] = 0.f;
      const char* xb = mat ? adx : wdx;
#pragma unroll
      for (int s4 = 0; s4 < 4; ++s4) { const bf16x8 af = *(const bf16x8*)(xb + r * 144 + (16 * s4 + 8 * hh) * 2); acc = MFMA32(af, bfrag[s4], acc); }
      if (mat == 0) {
#pragma unroll
        for (int e = 0; e < 16; ++e) vW[crow(e, hh) * 64 + cch] = __expf(-0.6065306597126334f * sigmoidf_(bias + acc[e]));
      } else {
#pragma unroll
        for (int e = 0; e < 16; ++e) {
          const int ix = crow(e, hh) * 64 + cch;
          const float ag = sigmoidf_(bias + acc[e]);
          const float kk = vA[ix], k = vK[ix], rr = vR[ix];
          const float kd = k * (1.0f + (ag - 1.0f) * kav);
          vK[ix] = kd; vA[ix] = -kk; vB[ix] = kk * ag; tmpb[ix] = rr * kd * rkv;
        }
      }
    }
    __syncthreads();
    {
      const int tt = tid >> 3, sub = tid & 7;
      const f32x4 b0 = *(const f32x4*)(tmpb + tt * 64 + sub * 8), b1 = *(const f32x4*)(tmpb + tt * 64 + sub * 8 + 4);
      float bs = (b0.x + b0.y) + (b0.z + b0.w) + (b1.x + b1.y) + (b1.z + b1.w);
      bs += __shfl_xor(bs, 1); bs += __shfl_xor(bs, 2); bs += __shfl_xor(bs, 4);
      if (sub == 0) bonus[((size_t)(row0 + t0 + tt) * 8 + hd) * 2 + dir] = bs;
    }
#pragma unroll 2
    for (int si = 0; si < 32; ++si) {
      const int tt = dir ? 31 - si : si;
      const int vo = tt * 64 + jq * 16;
      f32x2 pa2 = (f32x2){0.f, 0.f};
#pragma unroll
      for (int q = 0; q < 4; ++q) { const f32x4 a = *(const f32x4*)(vA + vo + 4 * q); pa2 += S[2 * q] * (f32x2){a.x, a.y}; pa2 += S[2 * q + 1] * (f32x2){a.z, a.w}; }
      const float sa = xsum32(xsum16(pa2.x + pa2.y));
      const float vi = vV[tt * 64 + irow];
      const f32x2 sa2 = (f32x2){sa, sa}, vi2 = (f32x2){vi, vi};
      f32x2 py2 = (f32x2){0.f, 0.f};
#pragma unroll
      for (int q = 0; q < 4; ++q) {
        const f32x4 w = *(const f32x4*)(vW + vo + 4 * q), b = *(const f32x4*)(vB + vo + 4 * q), k = *(const f32x4*)(vK + vo + 4 * q), rr = *(const f32x4*)(vR + vo + 4 * q);
        S[2 * q] = S[2 * q] * (f32x2){w.x, w.y} + (sa2 * (f32x2){b.x, b.y} + vi2 * (f32x2){k.x, k.y}); py2 += S[2 * q] * (f32x2){rr.x, rr.y};
        S[2 * q + 1] = S[2 * q + 1] * (f32x2){w.z, w.w} + (sa2 * (f32x2){b.z, b.w} + vi2 * (f32x2){k.z, k.w}); py2 += S[2 * q + 1] * (f32x2){rr.z, rr.w};
      }
      const float py = xsum32(xsum16(py2.x + py2.y));
      if (jq == 0) ybuf[tt * 64 + irow] = py;
    }
    __syncthreads();
    {
      const int tt = tid >> 3, sub = tid & 7;
      float v[8];
      const f32x4 y0 = *(const f32x4*)(ybuf + tt * 64 + sub * 8), y1 = *(const f32x4*)(ybuf + tt * 64 + sub * 8 + 4);
      v[0] = y0.x; v[1] = y0.y; v[2] = y0.z; v[3] = y0.w; v[4] = y1.x; v[5] = y1.y; v[6] = y1.z; v[7] = y1.w;
      *(u32x4*)(Y + (size_t)(row0 + t0 + tt) * 512 + hd * 64 + sub * 8) = pack8(v);
    }
    __syncthreads();
  }
  if (!lat) {
    float* o = opq(p.out) + (dir ? OUT_SB : OUT_SF) + ((size_t)(seq * 4 + l) * 8 + hd) * 4096 + irow * 64 + jq * 16;
#pragma unroll
    for (int q = 0; q < 4; ++q) *(f32x4*)(o + 4 * q) = (f32x4){S[2 * q].x, S[2 * q].y, S[2 * q + 1].x, S[2 * q + 1].y};
  }
}

DI void phase_mixers(const Params& p, int l, char* smem) {
  const int tid = otid(), wid = __builtin_amdgcn_readfirstlane(tid >> 6);
  unsigned* cnt = (unsigned*)(p.ws + OFF_CNT) + l;
  int* slot = (int*)(smem + SMEM_BYTES - 16);
  bf16_t* U = (bf16_t*)(p.ws + OFF_U);
  const bf16_t* KA = (const bf16_t*)(p.ws + OFF_KA); const bf16_t* VAT = (const bf16_t*)(p.ws + OFF_VAT);
  const bf16_t* KN = (const bf16_t*)(p.ws + OFF_KN); const bf16_t* VBT = (const bf16_t*)(p.ws + OFF_VBT); const bf16_t* KRB = (const bf16_t*)(p.ws + OFF_KRB);
  const int NITEMS = 128 + 4096 + 1536;
  for (;;) {
    if (tid == 0) *slot = (int)atomicAdd(cnt, 1u);
    __syncthreads();
    const int item = __builtin_amdgcn_readfirstlane(*slot);
    __syncthreads();
    if (item >= NITEMS) break;
    int kind, seq, a, qt;
    if (item < 128) { kind = 0; seq = 32 + (item >> 4); a = (item >> 1) & 7; qt = item & 1; }
    else if (item < 128 + 2048) { const int k = item - 128; kind = 1; seq = 32 + (k >> 8); a = (k >> 7) & 1; qt = k & 127; }
    else if (item < 128 + 4096) { const int k = item - 128 - 2048; kind = 2; seq = 32 + (k >> 8); a = (k >> 5) & 7; qt = k & 31; }
    else if (item < 128 + 4096 + 512) { const int k = item - 128 - 4096; kind = 0; seq = k >> 4; a = (k >> 1) & 7; qt = k & 1; }
    else if (item < 128 + 4096 + 1024) { const int k = item - 128 - 4096 - 512; kind = 1; seq = k >> 4; a = (k >> 3) & 1; qt = k & 7; }
    else { const int k = item - 128 - 4096 - 1024; kind = 2; seq = k >> 4; a = (k >> 1) & 7; qt = k & 1; }
    const int kr0 = keyrow0(seq), Tk = seq_tk(seq);
    const int row0 = seq < 32 ? seq * 256 : NCTX + (seq - 32) * 4096;
    if (kind == 0) scan_item(p, l, seq, a, qt, smem);
    else if (kind == 1) {
      const int qh = a * 4 + wid;
      bf16_t* q = U + (size_t)(row0 + qt * 32) * ULD + qh * 64;
      attn_item<64>(q, ULD, KA + (size_t)kr0 * 128 + a * 64, 128, nullptr, 0, VAT + (size_t)128 * kr0 + (size_t)(a * 64) * Tk, Tk, Tk, q, ULD, smem);
    } else {
      bf16_t* q = U + (size_t)(row0 + qt * 128 + wid * 32) * ULD + 768 + a * 96;
      attn_item<96>(q, ULD, KN + (size_t)kr0 * 512 + a * 64, 512, KRB + (size_t)kr0 * 32, 32, VBT + (size_t)512 * kr0 + (size_t)(a * 64) * Tk, Tk, Tk, q, ULD, smem);
    }
  }
}

DI void cpost_row(const Params& p, int l, int row, int lane) {
  int seq, t; row_decode(row, seq, t);
  const int T = seq < 32 ? 256 : 4096;
  const bf16_t* YF = (const bf16_t*)(p.ws + OFF_R2); const bf16_t* YB = YF + (size_t)NT * 512;
  bf16_t* u = (bf16_t*)(p.ws + OFF_U) + (size_t)row * ULD + 1696;
  const float* bonus = (const float*)(p.ws + OFF_BONUS);
  float yf[8], yb[8], y[8];
  unpack8(*(const u32x4*)(YF + (size_t)row * 512 + lane * 8), yf);
  unpack8(*(const u32x4*)(YB + (size_t)row * 512 + lane * 8), yb);
  float s = 0.f;
#pragma unroll
  for (int i = 0; i < 8; ++i) { y[i] = yf[i] + yb[i]; s += y[i]; }
  s += __shfl_xor(s, 1); s += __shfl_xor(s, 2); s += __shfl_xor(s, 4);
  const float mu = s * (1.0f / 64.0f);
  float q = 0.f;
#pragma unroll
  for (int i = 0; i < 8; ++i) { y[i] -= mu; q += y[i] * y[i]; }
  q += __shfl_xor(q, 1); q += __shfl_xor(q, 2); q += __shfl_xor(q, 4);
  const float rs = rsqrtf(q * (1.0f / 64.0f) + 64e-5f);
  const int col = 1024 + lane * 8;
  float c[8], pv[8], nx[8];
  unpack8(*(const u32x4*)(u + col), c);
  if (t > 0) unpack8(*(const u32x4*)(u - ULD + col), pv); else { for (int i = 0; i < 8; ++i) pv[i] = 0.f; }
  if (t < T - 1) unpack8(*(const u32x4*)(u + ULD + col), nx); else { for (int i = 0; i < 8; ++i) nx[i] = 0.f; }
  const float* mup = p.in[I_MUP] + l * 1792 + col; const float* mun = p.in[I_MUN] + l * 1792 + col;
  const float* lw = p.in[I_LNW] + l * 512 + lane * 8; const float* lb = p.in[I_LNB] + l * 512 + lane * 8;
  const f32x2 bsv = *(const f32x2*)(bonus + ((size_t)row * 8 + (lane >> 3)) * 2);
  const float bs = bsv.x + bsv.y;
  float o[8];
#pragma unroll
  for (int i = 0; i < 8; ++i) { const float v = c[i] + mup[i] * (pv[i] - c[i]) + mun[i] * (nx[i] - c[i]); o[i] = y[i] * rs * lw[i] + lb[i] + bs * v; }
  *(u32x4*)(u + lane * 8) = pack8(o);
}
DI void phase_renorm_cpost(const Params& p, int l) {
  const int lane = otid() & 63, wid = __builtin_amdgcn_readfirstlane(otid() >> 6);
  for (int item = blockIdx.x; item < NT / 4; item += gridDim.x) { const int row = item * 4 + wid; norm_row(p, l, row, lane); cpost_row(p, l, row, lane); }
}

DI void phase_zgemm(const Params& p, char* smem) {
  const int lane = otid() & 63, wid = __builtin_amdgcn_readfirstlane(otid() >> 6), wm = wid >> 1, wn = wid & 1, r = lane & 31, hh = lane >> 5;
  const bf16_t* H = (const bf16_t*)(p.ws + OFF_R1);
  const bf16_t* W = (const bf16_t*)(p.ws + OFF_WIN) + (size_t)3584 * 1024;
  bf16_t* U = (bf16_t*)(p.ws + OFF_U);
  const int ntiles = 320 * 12;
  for (int tile = blockIdx.x; tile < ntiles; tile += gridDim.x) {
    const int mt = tile / 12, nt = tile % 12, m0 = mt * 128, n0 = nt * 128;
    f32x16 acc[2][2]; zero_acc<2>(acc);
    gemm_mainloop<2>(acc, H + (size_t)m0 * 1024, 1024, 64, W + (size_t)n0 * 1024, 1024, 1024, smem);
#pragma unroll
    for (int j = 0; j < 2; ++j) {
      const int col = n0 + wn * 64 + j * 32 + r;
      const int br = col >> 9, cc = col & 511;
      const int ucol = br == 0 ? cc : (br == 1 ? 768 + (cc >> 6) * 96 + (cc & 63) : 1696 + cc);
#pragma unroll
      for (int i = 0; i < 2; ++i) {
        bf16_t* up = U + (size_t)(m0 + wm * 64 + i * 32) * ULD;
        const int lo = 4 * hh * ULD + ucol;
#pragma unroll
        for (int e = 0; e < 16; ++e) { bf16_t* q = up + crowu(e) * ULD; q[lo] = f2bf(bf2f(q[lo]) * siluf_(acc[i][j][e])); }
      }
    }
  }
}

DI void phase_merge(const Params& p, char* smem) {
  const int lane = otid() & 63, wid = __builtin_amdgcn_readfirstlane(otid() >> 6), wm = wid >> 1, wn = wid & 1, r = lane & 31, hh = lane >> 5;
  const bf16_t* H = (const bf16_t*)(p.ws + OFF_R1);
  const bf16_t* WG = (const bf16_t*)(p.ws + OFF_WIN) + (size_t)5120 * 1024;
  const bf16_t* WO = (const bf16_t*)(p.ws + OFF_WO);
  const bf16_t* U = (const bf16_t*)(p.ws + OFF_U);
  bf16_t* MX = (bf16_t*)(p.ws + OFF_R2);
  const int ntiles = 320 * 16;
  for (int tile = blockIdx.x; tile < ntiles; tile += gridDim.x) {
    const int mt = tile >> 4, nt = tile & 15, m0 = mt * 128, n0 = nt * 64;
    f32x16 mix[2][1]; zero_acc<1>(mix);
    f32x16 gs[2][1]; zero_acc<1>(gs);
#pragma unroll 1
    for (int step = 0; step < 6; ++step) {
      const int br = step >> 1, isT = step & 1;
      const int acol = br == 0 ? 0 : (br == 1 ? 768 : 1696);
      const bf16_t* Ap = isT ? U + (size_t)m0 * ULD + acol : H + (size_t)m0 * 1024;
      const bf16_t* Bp = isT ? WO + (size_t)(br * 1024 + n0) * 512 : WG + (size_t)(br * 1024 + n0) * 1024;
      f32x16 cur[2][1]; zero_acc<1>(cur);
      gemm_mainloop<1>(cur, Ap, isT ? ULD : 1024, (isT && br == 1) ? 96 : 64, Bp, isT ? 512 : 1024, isT ? 512 : 1024, smem);
      if (isT) {
#pragma unroll
        for (int i = 0; i < 2; ++i)
#pragma unroll
          for (int e = 0; e < 16; ++e) mix[i][0][e] += gs[i][0][e] * cur[i][0][e];
      } else {
#pragma unroll
        for (int i = 0; i < 2; ++i)
#pragma unroll
          for (int e = 0; e < 16; ++e) gs[i][0][e] = sigmoidf_(cur[i][0][e]);
      }
    }
    const int col = n0 + wn * 32 + r;
#pragma unroll
    for (int i = 0; i < 2; ++i) {
      bf16_t* mp = MX + (size_t)(m0 + wm * 64 + i * 32) * 1024;
      const int lo = 4 * hh * 1024 + col;
#pragma unroll
      for (int e = 0; e < 16; ++e) (mp + crowu(e) * 1024)[lo] = f2bf(mix[i][0][e]);
    }
  }
}

DI void phase_out(const Params& p, int l, char* smem) {
  const int lane = otid() & 63, wid = __builtin_amdgcn_readfirstlane(otid() >> 6), wm = wid >> 1, wn = wid & 1, r = lane & 31, hh = lane >> 5;
  const bf16_t* MX = (const bf16_t*)(p.ws + OFF_R2);
  const bf16_t* W = (const bf16_t*)(p.ws + OFF_WOUT);
  const int ntiles = 320 * 8;
  for (int tile = blockIdx.x; tile < ntiles; tile += gridDim.x) {
    const int mt = tile >> 3, nt = tile & 7, m0 = mt * 128, n0 = nt * 128;
    f32x16 acc[2][2]; zero_acc<2>(acc);
    gemm_mainloop<2>(acc, MX + (size_t)m0 * 1024, 1024, 64, W + (size_t)n0 * 1024, 1024, 1024, smem);
    const int jm = m0 < NCTX ? 0 : 1 + ((m0 - NCTX) >> 12);
    const float* gate = (const float*)(p.ws + OFF_MOD) + ((size_t)l * 9 + jm) * MODLD + 2048;
    const float* xsrc = x_row_ptr(p, l, m0);
#pragma unroll
    for (int j = 0; j < 2; ++j) {
      const int col = n0 + wn * 64 + j * 32 + r;
      const float gv = gate[col];
      const int lo = 4 * hh * 1024 + col;
#pragma unroll
      for (int i = 0; i < 2; ++i) {
        const float* xs = xsrc + (size_t)(wm * 64 + i * 32) * 1024;
        float* xo = p.out + (size_t)(m0 + wm * 64 + i * 32) * 1024;
#pragma unroll
        for (int e = 0; e < 16; ++e) (xo + crowu(e) * 1024)[lo] = (xs + crowu(e) * 1024)[lo] + gv * acc[i][j][e];
      }
    }
  }
}

DI void phase_final(const Params& p) {
  const int lane = otid() & 63, wid = __builtin_amdgcn_readfirstlane(otid() >> 6);
  const float* nw = p.in[I_FNW];
  for (int item = blockIdx.x; item < NT / 4; item += gridDim.x) {
    float* x = p.out + (size_t)(item * 4 + wid) * 1024;
    f32x4 v[4]; float ss = 0.f;
#pragma unroll
    for (int i = 0; i < 4; ++i) { v[i] = *(const f32x4*)(x + lane * 4 + 256 * i); ss += v[i].x * v[i].x + v[i].y * v[i].y + v[i].z * v[i].z + v[i].w * v[i].w; }
#pragma unroll
    for (int o = 1; o < 64; o <<= 1) ss += __shfl_xor(ss, o);
    const float rs = rsqrtf(ss * (1.0f / 1024.0f) + 1e-6f);
#pragma unroll
    for (int i = 0; i < 4; ++i) { const f32x4 w = *(const f32x4*)(nw + lane * 4 + 256 * i); *(f32x4*)(x + lane * 4 + 256 * i) = (f32x4){v[i].x * rs * w.x, v[i].y * rs * w.y, v[i].z * rs * w.z, v[i].w * rs * w.w}; }
  }
}

constexpr int NPHASES = 1 + 4 * 9 + 1;
__global__ void __launch_bounds__(256, 2) fwd_kernel(Params p) {
  __shared__ __attribute__((aligned(16))) char smem[SMEM_BYTES];
  cg::grid_group grid = cg::this_grid();
  for (int ph = p.ph_begin; ph < p.ph_end; ++ph) {
    if (ph == 0) phase_prologue(p, smem);
    else if (ph == NPHASES - 1) phase_final(p);
    else {
      const int l = (ph - 1) / 9, sp = (ph - 1) % 9;
      switch (sp) {
        case 0: phase_norm_convert(p, l, smem); break;
        case 1: phase_gemm1(p, l, smem); break;
        case 2: phase_post(p, l); break;
        case 3: phase_upproj(p, smem); break;
        case 4: phase_mixers(p, l, smem); break;
        case 5: phase_renorm_cpost(p, l); break;
        case 6: phase_zgemm(p, smem); break;
        case 7: phase_merge(p, smem); break;
        default: phase_out(p, l, smem); break;
      }
    }
    if (ph + 1 < p.ph_end) grid.sync();
  }
}

extern "C" void kernel_launch(void* const* d_in, const int* in_sizes, int n_in, void* d_out, int out_size, void* d_ws, size_t ws_size, hipStream_t stream) {
  if (ws_size < WS_NEED || n_in < 35) { fprintf(stderr, "workspace too small: %zu < %zu\n", ws_size, WS_NEED); return; }
  static int grid_blocks = 0;
  if (!grid_blocks) {
    int dev = 0, cus = 0, per_cu = 0;
    hipGetDevice(&dev);
    hipDeviceGetAttribute(&cus, hipDeviceAttributeMultiprocessorCount, dev);
    hipOccupancyMaxActiveBlocksPerMultiprocessor(&per_cu, fwd_kernel, 256, 0);
    if (per_cu < 1) per_cu = 1;
    if (per_cu > 2) per_cu = 2;
    grid_blocks = cus * per_cu;
  }
  Params p{};
  for (int i = 0; i < 35; ++i) p.in[i] = (const float*)d_in[i];
  p.out = (float*)d_out; p.ws = (char*)d_ws;
#ifndef ONE_LAUNCH
  for (int ph = 0; ph < NPHASES; ++ph) {
    p.ph_begin = ph; p.ph_end = ph + 1;
    hipLaunchKernelGGL(fwd_kernel, dim3(grid_blocks), dim3(256), 0, stream, p);
  }
#else
  p.ph_begin = 0; p.ph_end = NPHASES;
  void* args[] = {&p};
  hipError_t e = hipLaunchCooperativeKernel((void*)fwd_kernel, dim3(grid_blocks), dim3(256), args, 0, stream);
  if (e != hipSuccess) fprintf(stderr, "cooperative launch failed: %s (grid %d)\n", hipGetErrorString(e), grid_blocks);
#endif
}
```

```cpp
#define ONE_LAUNCH 1
#include <hip/hip_runtime.h>
#include <hip/hip_cooperative_groups.h>
#include <stdint.h>
#include <stdio.h>
namespace cg = cooperative_groups;

typedef unsigned short bf16_t;
typedef short bf16x8 __attribute__((ext_vector_type(8)));
typedef float f32x16 __attribute__((ext_vector_type(16)));
typedef float f32x4 __attribute__((ext_vector_type(4)));
typedef float f32x2 __attribute__((ext_vector_type(2)));
typedef unsigned u32x4 __attribute__((ext_vector_type(4)));
typedef unsigned u32x2 __attribute__((ext_vector_type(2)));
#define DI __device__ __forceinline__
#define MFMA32(a, b, c) __builtin_amdgcn_mfma_f32_32x32x16_bf16((a), (b), (c), 0, 0, 0)

constexpr int NT = 40960;
constexpr int NCTX = 8192;
constexpr int NK = 45056;
constexpr int ULD = 3488;
constexpr int MODLD = 3072;
constexpr int SMEM_BYTES = 78848;

constexpr size_t OFF_WIN = 0;
constexpr size_t OFF_WO = 16777216;
constexpr size_t OFF_WOUT = 19922944;
constexpr size_t OFF_WU = 22020096;
constexpr size_t OFF_MOD = 22282240;
constexpr size_t OFF_BONUS = 22724608;
constexpr size_t OFF_CS16 = 25346048;
constexpr size_t OFF_CS8 = 25354240;
constexpr size_t OFF_CNT = 25358336;
constexpr size_t OFF_U = 25358592;
constexpr size_t OFF_R1 = 311095552;
constexpr size_t OFF_KA = OFF_R1;
constexpr size_t OFF_VAT = 513208576;
constexpr size_t OFF_KN = OFF_R1 + 23068672;
constexpr size_t OFF_VBT = OFF_R1 + 69206016;
constexpr size_t OFF_KRB = OFF_R1 + 115343360;
constexpr size_t OFF_R2 = 429322496;
constexpr size_t WS_NEED = 524742912;

constexpr size_t OUT_AK = 41943040, OUT_AV = 46137344, OUT_CKV = 50331648, OUT_KR = 54525952, OUT_SF = 55574528, OUT_SB = 59768832;

struct Params {
  const float* in[35];
  float* out;
  char* ws;
  int ph_begin, ph_end;
};

enum { I_XP = 0, I_XS, I_CAK, I_CAV, I_CCKV, I_CKR, I_SF, I_SB, I_C, I_CCTX, I_NORMW, I_WMOD, I_BMOD, I_WIN, I_QNW, I_KNW, I_KVNW,
       I_WUK, I_WUV, I_MUP, I_MUN, I_W0, I_WUP, I_A0, I_AUP, I_KK, I_KA, I_RK, I_LNW, I_LNB, I_WOA, I_WOB, I_WOC, I_WOUT, I_FNW };

DI int threadIdx_x_raw() { return __builtin_amdgcn_workitem_id_x(); }
DI int otid() { int t = threadIdx_x_raw(); asm volatile("" : "+v"(t)); return t; }
DI const float* opq(const float* q) { asm volatile("" : "+s"(q)); return q; }
DI float* opq(float* q) { asm volatile("" : "+s"(q)); return q; }
DI float bf2f(bf16_t v) { return __uint_as_float(((unsigned)v) << 16); }
typedef __bf16 hbf16x2 __attribute__((ext_vector_type(2)));
DI unsigned pack2(float a, float b) { f32x2 v = {a, b}; hbf16x2 r = __builtin_convertvector(v, hbf16x2); return __builtin_bit_cast(unsigned, r); }
DI bf16_t f2bf(float x) { return (bf16_t)(pack2(x, 0.f) & 0xffffu); }
DI float xsum16(float x) { const unsigned u = __float_as_uint(x); auto r = __builtin_amdgcn_permlane16_swap(u, u, false, false); return __uint_as_float(r[0]) + __uint_as_float(r[1]); }
DI float xsum32(float x) { const unsigned u = __float_as_uint(x); auto r = __builtin_amdgcn_permlane32_swap(u, u, false, false); return __uint_as_float(r[0]) + __uint_as_float(r[1]); }
DI float lo16(unsigned w) { return __uint_as_float(w << 16); }
DI float hi16(unsigned w) { return __uint_as_float(w & 0xffff0000u); }
DI void unpack8(u32x4 w, float* v) { v[0] = lo16(w.x); v[1] = hi16(w.x); v[2] = lo16(w.y); v[3] = hi16(w.y); v[4] = lo16(w.z); v[5] = hi16(w.z); v[6] = lo16(w.w); v[7] = hi16(w.w); }
DI u32x4 pack8(const float* v) { u32x4 w; w.x = pack2(v[0], v[1]); w.y = pack2(v[2], v[3]); w.z = pack2(v[4], v[5]); w.w = pack2(v[6], v[7]); return w; }
template <int K> DI float shx(float v) { return __int_as_float(__builtin_amdgcn_ds_swizzle(__float_as_int(v), 0x1f | (K << 10))); }
DI float wave_sum(float v) { v += shx<1>(v); v += shx<2>(v); v += shx<4>(v); v += shx<8>(v); v += shx<16>(v); return xsum32(v); }
DI float qsum(float v) {
  v += __int_as_float(__builtin_amdgcn_update_dpp(0, __float_as_int(v), 0xB1, 0xf, 0xf, true));
  v += __int_as_float(__builtin_amdgcn_update_dpp(0, __float_as_int(v), 0x4E, 0xf, 0xf, true));
  return v;
}
DI int crow(int reg, int h) { return (reg & 3) + 8 * (reg >> 2) + 4 * h; }
DI int crowu(int reg) { return (reg & 3) + 8 * (reg >> 2); }
DI int perm16(int t) { return (t & ~12) | ((t & 4) << 1) | ((t & 8) >> 1); }
DI float sigmoidf_(float x) { return 1.0f / (1.0f + __expf(-x)); }
DI float siluf_(float x) { return x / (1.0f + __expf(-x)); }

DI void row_decode(int row, int& seq, int& t) {
  if (row < NCTX) { seq = row >> 8; t = row & 255; } else { seq = 32 + ((row - NCTX) >> 12); t = (row - NCTX) & 4095; }
}
DI int keyrow0(int seq) { return seq < 32 ? seq * 256 : NCTX + (seq - 32) * 4608; }
DI int seq_tk(int seq) { return seq < 32 ? 256 : 4608; }

template <int NJ>
DI void gemm_mainloop(f32x16 (&acc)[2][NJ], const bf16_t* __restrict__ A, int lda, int ks,
                      const bf16_t* __restrict__ Bt, int ldb, int K, char* smem) {
  constexpr int A_BYTES = 128 * 128;
  constexpr int B_BYTES = 64 * NJ * 128;
  constexpr int STAGE = A_BYTES + B_BYTES;
  const int tid = otid(), lane = tid & 63, wid = __builtin_amdgcn_readfirstlane(tid >> 6), wm = wid >> 1, wn = wid & 1;
  const int r = lane & 31, hh = lane >> 5;
  const int nk = K >> 6;
  const int lrow = tid >> 3, lc = tid & 7;
  u32x4 ra[4], rb[2 * NJ];
  const bf16_t* ap = A + (size_t)lrow * lda + lc * 8;
  const bf16_t* bp = Bt + (size_t)lrow * ldb + lc * 8;
#pragma unroll
  for (int p = 0; p < 4; ++p) ra[p] = *(const u32x4*)(ap + (size_t)(32 * p) * lda);
#pragma unroll
  for (int p = 0; p < 2 * NJ; ++p) rb[p] = *(const u32x4*)(bp + (size_t)(32 * p) * ldb);
  {
    char* base = smem;
#pragma unroll
    for (int p = 0; p < 4; ++p) { const int row = lrow + 32 * p; *(u32x4*)(base + row * 128 + ((lc ^ ((row >> 1) & 7)) << 4)) = ra[p]; }
#pragma unroll
    for (int p = 0; p < 2 * NJ; ++p) { const int row = lrow + 32 * p; *(u32x4*)(base + A_BYTES + row * 128 + ((lc ^ ((row >> 1) & 7)) << 4)) = rb[p]; }
  }
  if (nk > 1) {
    const bf16_t* ap2 = ap + (size_t)ks;
    const bf16_t* bp2 = bp + (size_t)64;
#pragma unroll
    for (int p = 0; p < 4; ++p) ra[p] = *(const u32x4*)(ap2 + (size_t)(32 * p) * lda);
#pragma unroll
    for (int p = 0; p < 2 * NJ; ++p) rb[p] = *(const u32x4*)(bp2 + (size_t)(32 * p) * ldb);
  }
  __syncthreads();
  for (int kt = 0; kt < nk; ++kt) {
    const char* base = smem + (kt & 1) * STAGE;
#pragma unroll
    for (int s = 0; s < 4; ++s) {
      bf16x8 af[2], bfr[NJ];
#pragma unroll
      for (int i = 0; i < 2; ++i) { const int row = wm * 64 + i * 32 + r; af[i] = *(const bf16x8*)(base + row * 128 + (((2 * s + hh) ^ ((row >> 1) & 7)) << 4)); }
#pragma unroll
      for (int j = 0; j < NJ; ++j) { const int row = wn * (32 * NJ) + j * 32 + r; bfr[j] = *(const bf16x8*)(base + A_BYTES + row * 128 + (((2 * s + hh) ^ ((row >> 1) & 7)) << 4)); }
#pragma unroll
      for (int i = 0; i < 2; ++i)
#pragma unroll
        for (int j = 0; j < NJ; ++j) acc[i][j] = MFMA32(af[i], bfr[j], acc[i][j]);
    }
    if (kt + 1 < nk) {
      char* nb = smem + ((kt + 1) & 1) * STAGE;
#pragma unroll
      for (int p = 0; p < 4; ++p) { const int row = lrow + 32 * p; *(u32x4*)(nb + row * 128 + ((lc ^ ((row >> 1) & 7)) << 4)) = ra[p]; }
#pragma unroll
      for (int p = 0; p < 2 * NJ; ++p) { const int row = lrow + 32 * p; *(u32x4*)(nb + A_BYTES + row * 128 + ((lc ^ ((row >> 1) & 7)) << 4)) = rb[p]; }
      if (kt + 2 < nk) {
        const bf16_t* ap2 = ap + (size_t)(kt + 2) * ks;
        const bf16_t* bp2 = bp + (size_t)(kt + 2) * 64;
#pragma unroll
        for (int p = 0; p < 4; ++p) ra[p] = *(const u32x4*)(ap2 + (size_t)(32 * p) * lda);
#pragma unroll
        for (int p = 0; p < 2 * NJ; ++p) rb[p] = *(const u32x4*)(bp2 + (size_t)(32 * p) * ldb);
      }
    }
    __syncthreads();
  }
}

template <int NJ> DI void zero_acc(f32x16 (&acc)[2][NJ]) {
#pragma unroll
  for (int i = 0; i < 2; ++i)
#pragma unroll
    for (int j = 0; j < NJ; ++j)
#pragma unroll
      for (int e = 0; e < 16; ++e) acc[i][j][e] = 0.f;
}

DI void phase_prologue(const Params& p, char* smem) {
  const int tid = otid(), lane = tid & 63, wid = __builtin_amdgcn_readfirstlane(tid >> 6);
  float* mod = (float*)(p.ws + OFF_MOD);
  if (blockIdx.x == 0) {
    if (tid < 64) ((unsigned*)(p.ws + OFF_CNT))[tid] = 0u;
    float* cs16 = (float*)(p.ws + OFF_CS16);
    float* cs8 = (float*)(p.ws + OFF_CS8);
    for (int e = tid; e < 64 * 16; e += 256) { const int pos = e >> 4, i = e & 15; const float inv = expf(-9.210340371976184f * (float)i / 16.0f); const float a = (float)pos * inv; cs16[e * 2] = cosf(a); cs16[e * 2 + 1] = sinf(a); }
    for (int e = tid; e < 64 * 8; e += 256) { const int pos = e >> 3, i = e & 7; const float inv = expf(-9.210340371976184f * (float)i / 8.0f); const float a = (float)pos * inv; cs8[e * 2] = cosf(a); cs8[e * 2 + 1] = sinf(a); }
  }
  float* sl = (float*)smem;
  float* red = sl + 9 * 1024;
  for (int e = tid; e < 9 * 1024; e += 256) { const int j = e >> 10, k = e & 1023; const float* cc0 = opq(p.in[I_CCTX]); const float* cc1 = opq(p.in[I_C]); const float c = j == 0 ? cc0[k] : cc1[(j - 1) * 1024 + k]; sl[e] = siluf_(c); }
  __syncthreads();
  for (int item = blockIdx.x; item < 192; item += gridDim.x) {
    const int l = item / 48, n = (item % 48) * 64 + lane;
    const float* w = p.in[I_WMOD] + (size_t)l * 1024 * 3072 + n;
    float a[9];
#pragma unroll
    for (int j = 0; j < 9; ++j) a[j] = 0.f;
    for (int k = wid * 256; k < wid * 256 + 256; ++k) {
      const float wv = w[(size_t)k * 3072];
#pragma unroll
      for (int j = 0; j < 9; ++j) a[j] += sl[j * 1024 + k] * wv;
    }
#pragma unroll
    for (int j = 0; j < 9; ++j) red[(wid * 9 + j) * 64 + lane] = a[j];
    __syncthreads();
    for (int e = tid; e < 9 * 64; e += 256) {
      const int j = e >> 6, c = e & 63;
      const float s = red[(0 * 9 + j) * 64 + c] + red[(1 * 9 + j) * 64 + c] + red[(2 * 9 + j) * 64 + c] + red[(3 * 9 + j) * 64 + c];
      const int nn = (item % 48) * 64 + c;
      mod[((size_t)l * 9 + j) * MODLD + nn] = s + p.in[I_BMOD][l * 3072 + nn];
    }
    __syncthreads();
  }
}

DI const float* x_row_ptr(const Params& p, int l, int row) {
  const float* xp = opq(p.in[I_XP]); const float* xs = opq(p.in[I_XS]); const float* xo = opq((const float*)p.out);
  if (l == 0) return row < NCTX ? xp + (size_t)row * 1024 : xs + (size_t)(row - NCTX) * 1024;
  return xo + (size_t)row * 1024;
}
DI void norm_row(const Params& p, int l, int row, int lane) {
  const float* x = x_row_ptr(p, l, row);
  const int j = row < NCTX ? 0 : 1 + ((row - NCTX) >> 12);
  const float* mod = (const float*)(p.ws + OFF_MOD) + ((size_t)l * 9 + j) * MODLD;
  const float* nw = p.in[I_NORMW] + l * 1024;
  bf16_t* h = (bf16_t*)(p.ws + OFF_R1) + (size_t)row * 1024;
  f32x4 v[4]; float ss = 0.f;
#pragma unroll
  for (int i = 0; i < 4; ++i) { v[i] = *(const f32x4*)(x + lane * 4 + 256 * i); ss += v[i].x * v[i].x + v[i].y * v[i].y + v[i].z * v[i].z + v[i].w * v[i].w; }
ss = wave_sum(ss);
  const float rs = rsqrtf(ss * (1.0f / 1024.0f) + 1e-6f);
#pragma unroll
  for (int i = 0; i < 4; ++i) {
    const int c = lane * 4 + 256 * i;
    const f32x4 w = *(const f32x4*)(nw + c), sh = *(const f32x4*)(mod + c), sc = *(const f32x4*)(mod + 1024 + c);
    u32x2 o;
    o.x = pack2(v[i].x * rs * w.x * (1.f + sc.x) + sh.x, v[i].y * rs * w.y * (1.f + sc.y) + sh.y);
    o.y = pack2(v[i].z * rs * w.z * (1.f + sc.z) + sh.z, v[i].w * rs * w.w * (1.f + sc.w) + sh.w);
    *(u32x2*)(h + c) = o;
  }
}

DI int win_srccol(int j) {
  if (j < 768) return j;
  if (j < 1696) return j + 512;
  if (j < 3488) return j + 1024;
  if (j < 3584) return -1;
  if (j < 5120) { const int jj = j - 3584; return jj < 512 ? 768 + jj : (jj < 1024 ? 2208 + (jj - 512) : 4512 + (jj - 1024)); }
  return 5024 + (j - 5120);
}
DI void conv_tile(const float* __restrict__ src, int ld_src, bf16_t* dst, int ld_dst, int k0, int n0, int kind, int srcoff, char* smem) {
  float* tile = (float*)smem;
  const int tid = otid();
  const int n = tid & 63;
  int sc = kind == 0 ? win_srccol(n0 + n) : (n0 + n - srcoff);
#pragma unroll
  for (int i = 0; i < 16; ++i) { const int k = i * 4 + (tid >> 6); tile[k * 65 + n] = sc >= 0 ? src[(size_t)(k0 + k) * ld_src + sc] : 0.f; }
  __syncthreads();
#pragma unroll
  for (int i = 0; i < 8; ++i) { const int nn = i * 8 + (tid >> 5), kk = (tid & 31) * 2; *(unsigned*)(dst + (size_t)(n0 + nn) * ld_dst + k0 + kk) = pack2(tile[kk * 65 + nn], tile[(kk + 1) * 65 + nn]); }
  __syncthreads();
}

DI void phase_norm_convert(const Params& p, int l, char* smem) {
  const int tid = otid(), lane = tid & 63, wid = __builtin_amdgcn_readfirstlane(tid >> 6);
  bf16_t* WinT = (bf16_t*)(p.ws + OFF_WIN); bf16_t* WoT = (bf16_t*)(p.ws + OFF_WO); bf16_t* WoutT = (bf16_t*)(p.ws + OFF_WOUT); bf16_t* WuT = (bf16_t*)(p.ws + OFF_WU);
  const int NI_WIN = 128 * 16, NI_WO = 3 * 16 * 8, NI_WOUT = 16 * 16, NI_WU = 16 * 2;
  const int NI_CONV = NI_WIN + NI_WO + NI_WOUT + NI_WU;
  for (int item = blockIdx.x; item < NI_CONV; item += gridDim.x) {
    int it = item;
    if (it < NI_WIN) { conv_tile(p.in[I_WIN] + (size_t)l * 1024 * 8096, 8096, WinT, 1024, (it & 15) * 64, (it >> 4) * 64, 0, 0, smem); continue; }
    it -= NI_WIN;
    if (it < NI_WO) { const int br = it / 128, r2 = it % 128; const float* src = (br == 0 ? opq(p.in[I_WOA]) : (br == 1 ? opq(p.in[I_WOB]) : opq(p.in[I_WOC]))) + (size_t)l * 512 * 1024; conv_tile(src, 1024, WoT + (size_t)br * 1024 * 512, 512, (r2 & 7) * 64, (r2 >> 3) * 64, 1, 0, smem); continue; }
    it -= NI_WO;
    if (it < NI_WOUT) { conv_tile(p.in[I_WOUT] + (size_t)l * 1024 * 1024, 1024, WoutT, 1024, (it & 15) * 64, (it >> 4) * 64, 1, 0, smem); continue; }
    it -= NI_WOUT;
    { const int nt = it >> 1, kt = it & 1; const bool uv = nt >= 8; const float* src = (uv ? opq(p.in[I_WUV]) : opq(p.in[I_WUK])) + (size_t)l * 128 * 512; conv_tile(src, 512, WuT, 128, kt * 64, nt * 64, 1, uv ? 512 : 0, smem); }
  }
  for (int item = blockIdx.x; item < NT / 4; item += gridDim.x) norm_row(p, l, item * 4 + wid, lane);
}

DI void phase_gemm1(const Params& p, int l, char* smem) {
  const bf16_t* H = (const bf16_t*)(p.ws + OFF_R1);
  const bf16_t* W = (const bf16_t*)(p.ws + OFF_WIN);
  bf16_t* U = (bf16_t*)(p.ws + OFF_U);
  bf16_t* VAT = (bf16_t*)(p.ws + OFF_VAT);
  const int NTN = 28, ntiles = 320 * NTN;
  for (int tile = blockIdx.x; tile < ntiles; tile += gridDim.x) {
    const int mt = tile / NTN, nt = tile % NTN, m0 = mt * 128, n0 = nt * 128;
    f32x16 acc[2][2]; zero_acc<2>(acc);
    gemm_mainloop<2>(acc, H + (size_t)m0 * 1024, 1024, 64, W + (size_t)n0 * 1024, 1024, 1024, smem);
    const int lane = otid() & 63, wid = __builtin_amdgcn_readfirstlane(otid() >> 6), wm = wid >> 1, wn = wid & 1, r = lane & 31, hh = lane >> 5;
    int seq, t0; row_decode(m0, seq, t0);
#pragma unroll
    for (int j = 0; j < 2; ++j) {
      const int cb = n0 + wn * 64 + j * 32;
      if (cb >= ULD) continue;
      const int col = cb + r;
      if (cb >= 640 && cb < 768) {
        const int kvh = (col - 640) >> 6, dv = col & 63, Tk = seq_tk(seq);
        bf16_t* vt = VAT + (size_t)128 * keyrow0(seq) + (size_t)(kvh * 64 + dv) * Tk;
#pragma unroll
        for (int i = 0; i < 2; ++i) {
          const int tt = t0 + wm * 64 + i * 32;
#pragma unroll
          for (int g2 = 0; g2 < 2; ++g2) {
            float v[8];
#pragma unroll
            for (int e = 0; e < 8; ++e) v[e] = acc[i][j][g2 * 8 + e];
            *(u32x4*)(vt + tt + 16 * g2 + 8 * hh) = pack8(v);
          }
          if (seq < 32) {
            float* o = p.out + OUT_AV + ((size_t)(seq * 4 + l) * 256 + tt) * 128;
            const int lo = 4 * hh * 128 + (col - 640);
#pragma unroll
            for (int e = 0; e < 16; ++e) (o + crowu(e) * 128)[lo] = acc[i][j][e];
          }
        }
      } else {
#pragma unroll
        for (int i = 0; i < 2; ++i) {
          bf16_t* up = U + (size_t)(m0 + wm * 64 + i * 32) * ULD;
          const int lo = 4 * hh * ULD + col;
#pragma unroll
          for (int e = 0; e < 16; ++e) (up + crowu(e) * ULD)[lo] = f2bf(acc[i][j][e]);
        }
      }
    }
  }
}

DI void post_row(const Params& p, int l, int row, int lane) {
  int seq, t; row_decode(row, seq, t);
  const bool lat = row >= NCTX;
  const int krow = keyrow0(seq) + t;
  const int prow = t >> 6, pcol = t & 63;
  bf16_t* u = (bf16_t*)(p.ws + OFF_U) + (size_t)row * ULD;
  const float* cs16 = (const float*)(p.ws + OFF_CS16);
  const float* cs8 = (const float*)(p.ws + OFF_CS8);
  const float LOG2E = 1.4426950408889634f;
#pragma unroll
  for (int which = 0; which < 2; ++which) {
    const int l8 = which == 0 ? lane : (lane & 15);
    const bf16_t* src = u + (which == 0 ? 0 : 512) + l8 * 8;
    float v[8]; unpack8(*(const u32x4*)src, v);
    float ss = 0.f;
#pragma unroll
    for (int i = 0; i < 8; ++i) ss += v[i] * v[i];
    ss += shx<1>(ss); ss += shx<2>(ss); ss += shx<4>(ss);
    const float rs = rsqrtf(ss * (1.0f / 64.0f) + 1e-6f);
    const float* nw = (which == 0 ? opq(p.in[I_QNW]) : opq(p.in[I_KNW])) + l * 64 + (lane & 7) * 8;
#pragma unroll
    for (int i = 0; i < 8; ++i) v[i] = v[i] * rs * nw[i];
    float pv[8];
#pragma unroll
    for (int i = 0; i < 8; ++i) pv[i] = shx<2>(v[i]);
    if (lat) {
      const int pos = ((lane & 7) >> 2) ? pcol : prow;
      const bool lower = (lane & 2) == 0;
      const float* cs = cs16 + (pos * 16 + (lane & 1) * 8) * 2;
#pragma unroll
      for (int i = 0; i < 8; ++i) { const float c = cs[i * 2], s = cs[i * 2 + 1]; v[i] = lower ? v[i] * c - pv[i] * s : v[i] * c + pv[i] * s; }
    }
    if (which == 0) {
      const float sc = 0.125f * LOG2E;
#pragma unroll
      for (int i = 0; i < 8; ++i) v[i] *= sc;
      *(u32x4*)(u + lane * 8) = pack8(v);
    } else if (lane < 16) {
      bf16_t* KA = (bf16_t*)(p.ws + OFF_KA);
      *(u32x4*)(KA + (size_t)krow * 128 + lane * 8) = pack8(v);
      if (!lat) {
        float* o = p.out + OUT_AK + ((size_t)(seq * 4 + l) * 256 + t) * 128 + lane * 8;
        *(f32x4*)o = (f32x4){v[0], v[1], v[2], v[3]}; *(f32x4*)(o + 4) = (f32x4){v[4], v[5], v[6], v[7]};
      }
    }
  }
  {
    const float sc = 0.10206207261596577f * LOG2E;
    const int hd = lane >> 3;
    bf16_t* q = u + 768 + hd * 96;
    { float v[8]; unpack8(*(const u32x4*)(q + (lane & 7) * 8), v);
#pragma unroll
      for (int i = 0; i < 8; ++i) v[i] *= sc;
      *(u32x4*)(q + (lane & 7) * 8) = pack8(v); }
    { bf16_t* qr = q + 64 + (lane & 7) * 4;
      const u32x2 w = *(const u32x2*)qr;
      float v[4] = {lo16(w.x), hi16(w.x), lo16(w.y), hi16(w.y)}, pv[4];
#pragma unroll
      for (int i = 0; i < 4; ++i) pv[i] = shx<2>(v[i]);
      if (lat) {
        const int pos = ((lane & 7) >> 2) ? pcol : prow;
        const bool lower = (lane & 2) == 0;
        const float* cs = cs8 + (pos * 8 + (lane & 1) * 4) * 2;
#pragma unroll
        for (int i = 0; i < 4; ++i) { const float c = cs[i * 2], s = cs[i * 2 + 1]; v[i] = lower ? v[i] * c - pv[i] * s : v[i] * c + pv[i] * s; }
      }
      u32x2 o; o.x = pack2(v[0] * sc, v[1] * sc); o.y = pack2(v[2] * sc, v[3] * sc);
      *(u32x2*)qr = o; }
  }
  {
    const unsigned w = *(const unsigned*)(u + 1536 + lane * 2);
    float a = lo16(w), b = hi16(w);
    float ss = a * a + b * b;
ss = wave_sum(ss);
    const float rs = rsqrtf(ss * (1.0f / 128.0f) + 1e-6f);
    const float* nw = p.in[I_KVNW] + l * 128 + lane * 2;
    a = a * rs * nw[0]; b = b * rs * nw[1];
    bf16_t* CKVN = (bf16_t*)(p.ws + OFF_R2);
    *(unsigned*)(CKVN + (size_t)krow * 128 + lane * 2) = pack2(a, b);
    if (!lat) { float* o = p.out + OUT_CKV + ((size_t)(seq * 4 + l) * 256 + t) * 128 + lane * 2; *(f32x2*)o = (f32x2){a, b}; }
  }
  {
    float v = bf2f(u[1664 + (lane & 31)]);
    const float pv = shx<8>(v);
    if (!lat) { if (lane < 32) p.out[OUT_KR + ((size_t)(seq * 4 + l) * 256 + t) * 32 + lane] = v; }
    else {
      const int d = lane & 31; const int pos = (d >> 4) ? pcol : prow; const bool lower = (d & 8) == 0;
      const float* cs = cs8 + (pos * 8 + (d & 7)) * 2;
      v = lower ? v * cs[0] - pv * cs[1] : v * cs[0] + pv * cs[1];
    }
    if (lane < 32) ((bf16_t*)(p.ws + OFF_KRB))[(size_t)krow * 32 + lane] = f2bf(v);
  }
}
DI void post_cached_row(const Params& p, int l, int idx, int lane) {
  const int b = idx >> 9, j = idx & 511;
  const int kr0 = NCTX + b * 4608, krow = kr0 + 4096 + j;
  const size_t cb = ((size_t)(b * 4 + l) * 512 + j);
  bf16_t* KA = (bf16_t*)(p.ws + OFF_KA); bf16_t* VAT = (bf16_t*)(p.ws + OFF_VAT); bf16_t* CKVN = (bf16_t*)(p.ws + OFF_R2); bf16_t* KRB = (bf16_t*)(p.ws + OFF_KRB);
  { const f32x2 v = *(const f32x2*)(p.in[I_CAK] + cb * 128 + lane * 2); *(unsigned*)(KA + (size_t)krow * 128 + lane * 2) = pack2(v.x, v.y); }
  { const f32x2 v = *(const f32x2*)(p.in[I_CAV] + cb * 128 + lane * 2);
    bf16_t* vt = VAT + (size_t)128 * kr0 + (size_t)(lane * 2) * 4608 + perm16(4096 + j);
    vt[0] = f2bf(v.x); vt[4608] = f2bf(v.y); }
  { const f32x2 v = *(const f32x2*)(p.in[I_CCKV] + cb * 128 + lane * 2); *(unsigned*)(CKVN + (size_t)krow * 128 + lane * 2) = pack2(v.x, v.y); }
  if (lane < 32) KRB[(size_t)krow * 32 + lane] = f2bf(p.in[I_CKR][cb * 32 + lane]);
}
DI void phase_post(const Params& p, int l) {
  const int lane = otid() & 63, wid = __builtin_amdgcn_readfirstlane(otid() >> 6);
  for (int item = blockIdx.x; item < NT / 4 + 1024; item += gridDim.x) {
    if (item < NT / 4) post_row(p, l, item * 4 + wid, lane);
    else post_cached_row(p, l, (item - NT / 4) * 4 + wid, lane);
  }
}

DI void phase_upproj(const Params& p, char* smem) {
  const bf16_t* A = (const bf16_t*)(p.ws + OFF_R2);
  const bf16_t* W = (const bf16_t*)(p.ws + OFF_WU);
  bf16_t* KN = (bf16_t*)(p.ws + OFF_KN); bf16_t* VBT = (bf16_t*)(p.ws + OFF_VBT);
  const int ntiles = 352 * 8;
  for (int tile = blockIdx.x; tile < ntiles; tile += gridDim.x) {
    const int mt = tile >> 3, nt = tile & 7, m0 = mt * 128, n0 = nt * 128;
    f32x16 acc[2][2]; zero_acc<2>(acc);
    gemm_mainloop<2>(acc, A + (size_t)m0 * 128, 128, 64, W + (size_t)n0 * 128, 128, 128, smem);
    const int lane = otid() & 63, wid = __builtin_amdgcn_readfirstlane(otid() >> 6), wm = wid >> 1, wn = wid & 1, r = lane & 31, hh = lane >> 5;
    int seq, t0;
    if (m0 < NCTX) { seq = m0 >> 8; t0 = m0 & 255; } else { const int rr = m0 - NCTX; seq = 32 + rr / 4608; t0 = rr % 4608; }
#pragma unroll
    for (int j = 0; j < 2; ++j) {
      const int col = n0 + wn * 64 + j * 32 + r;
      if (n0 < 512) {
#pragma unroll
        for (int i = 0; i < 2; ++i) {
          bf16_t* kp = KN + (size_t)(m0 + wm * 64 + i * 32) * 512;
          const int lo = 4 * hh * 512 + col;
#pragma unroll
          for (int e = 0; e < 16; ++e) (kp + crowu(e) * 512)[lo] = f2bf(acc[i][j][e]);
        }
      } else {
        const int Tk = seq_tk(seq);
        bf16_t* vt = VBT + (size_t)512 * keyrow0(seq) + (size_t)(col - 512) * Tk;
#pragma unroll
        for (int i = 0; i < 2; ++i) {
          const int tt = t0 + wm * 64 + i * 32;
#pragma unroll
          for (int g2 = 0; g2 < 2; ++g2) {
            float v[8];
#pragma unroll
            for (int e = 0; e < 8; ++e) v[e] = acc[i][j][g2 * 8 + e];
            *(u32x4*)(vt + tt + 16 * g2 + 8 * hh) = pack8(v);
          }
        }
      }
    }
  }
}

template <int DQK>
DI void attn_item(const bf16_t* Qw, int q_ld, const bf16_t* K1, int k1_ld, const bf16_t* K2, int k2_ld,
                  const bf16_t* Vt, int vt_ld, int nkeys, bf16_t* Ow, int o_ld, char* smem) {
  constexpr int KS = DQK * 2 + 16;
  constexpr int KBYTES = 64 * KS;
  constexpr int VS = 144;
  constexpr int VBYTES = 64 * VS;
  constexpr int STAGE = KBYTES + VBYTES;
  constexpr int CPR = DQK / 8;
  constexpr int NKC = 64 * CPR / 256;
  constexpr int NS = DQK / 16;
  const int tid = otid(), lane = tid & 63, r = lane & 31, hh = lane >> 5;
  bf16x8 qf[NS];
#pragma unroll
  for (int s = 0; s < NS; ++s) qf[s] = *(const bf16x8*)(Qw + (size_t)r * q_ld + 16 * s + 8 * hh);
  f32x16 o[2];
#pragma unroll
  for (int n = 0; n < 2; ++n)
#pragma unroll
    for (int e = 0; e < 16; ++e) o[n][e] = 0.f;
  float m_run = -1e30f, lsum = 0.f;
  u32x4 rk[NKC], rv[2];
  int krow_[NKC], kc_[NKC];
#pragma unroll
  for (int q = 0; q < NKC; ++q) { const int id = q * 256 + tid; krow_[q] = id / CPR; kc_[q] = id % CPR; }
  const int vrow = tid >> 3, vc = tid & 7;
  auto gload = [&](int key0) {
#pragma unroll
    for (int q = 0; q < NKC; ++q) {
      const bf16_t* src = (DQK == 64 || kc_[q] < 8) ? K1 + (size_t)(key0 + krow_[q]) * k1_ld + kc_[q] * 8 : K2 + (size_t)(key0 + krow_[q]) * k2_ld + (kc_[q] - 8) * 8;
      rk[q] = *(const u32x4*)src;
    }
#pragma unroll
    for (int q = 0; q < 2; ++q) rv[q] = *(const u32x4*)(Vt + (size_t)(vrow + 32 * q) * vt_ld + key0 + vc * 8);
  };
  auto lstore = [&](int buf) {
    char* base = smem + buf * STAGE;
#pragma unroll
    for (int q = 0; q < NKC; ++q) *(u32x4*)(base + krow_[q] * KS + kc_[q] * 16) = rk[q];
#pragma unroll
    for (int q = 0; q < 2; ++q) *(u32x4*)(base + KBYTES + (vrow + 32 * q) * VS + vc * 16) = rv[q];
  };
  const int ntl = nkeys >> 6;
  gload(0); lstore(0);
  if (ntl > 1) gload(64);
  __syncthreads();
  for (int tl = 0; tl < ntl; ++tl) {
    const char* base = smem + (tl & 1) * STAGE;
    bf16x8 kf[2][NS], vf[2][2][2];
#pragma unroll
    for (int kb = 0; kb < 2; ++kb)
#pragma unroll
      for (int ks = 0; ks < NS; ++ks) kf[kb][ks] = *(const bf16x8*)(base + (kb * 32 + r) * KS + (2 * ks + hh) * 16);
    f32x16 s[2];
#pragma unroll
    for (int kb = 0; kb < 2; ++kb)
#pragma unroll
      for (int e = 0; e < 16; ++e) s[kb][e] = 0.f;
#pragma unroll
    for (int ks = 0; ks < NS; ++ks)
#pragma unroll
      for (int kb = 0; kb < 2; ++kb) s[kb] = MFMA32(kf[kb][ks], qf[ks], s[kb]);
#pragma unroll
    for (int kb = 0; kb < 2; ++kb)
#pragma unroll
      for (int s2 = 0; s2 < 2; ++s2)
#pragma unroll
        for (int n = 0; n < 2; ++n) vf[kb][s2][n] = *(const bf16x8*)(base + KBYTES + (32 * n + r) * VS + (kb * 32 + 16 * s2 + 8 * hh) * 2);
    float mx = s[0][0];
#pragma unroll
    for (int kb = 0; kb < 2; ++kb)
#pragma unroll
      for (int e = 0; e < 16; ++e) mx = fmaxf(mx, s[kb][e]);
    { const unsigned u = __float_as_uint(mx); auto sw = __builtin_amdgcn_permlane32_swap(u, u, false, false); mx = fmaxf(__uint_as_float(sw[0]), __uint_as_float(sw[1])); }
    const float m_new = fmaxf(m_run, mx);
    const float alpha = __builtin_amdgcn_exp2f(m_run - m_new);
    m_run = m_new;
    float ps = 0.f;
#pragma unroll
    for (int kb = 0; kb < 2; ++kb)
#pragma unroll
      for (int e = 0; e < 16; ++e) { const float pe = __builtin_amdgcn_exp2f(s[kb][e] - m_new); s[kb][e] = pe; ps += pe; }
    lsum = lsum * alpha + ps;
#pragma unroll
    for (int n = 0; n < 2; ++n)
#pragma unroll
      for (int e = 0; e < 16; ++e) o[n][e] *= alpha;
#pragma unroll
    for (int kb = 0; kb < 2; ++kb)
#pragma unroll
      for (int s2 = 0; s2 < 2; ++s2) {
        u32x4 pw;
        pw.x = pack2(s[kb][8 * s2 + 0], s[kb][8 * s2 + 1]); pw.y = pack2(s[kb][8 * s2 + 2], s[kb][8 * s2 + 3]);
        pw.z = pack2(s[kb][8 * s2 + 4], s[kb][8 * s2 + 5]); pw.w = pack2(s[kb][8 * s2 + 6], s[kb][8 * s2 + 7]);
        const bf16x8 pf = __builtin_bit_cast(bf16x8, pw);
#pragma unroll
        for (int n = 0; n < 2; ++n) o[n] = MFMA32(vf[kb][s2][n], pf, o[n]);
      }
    if (tl + 1 < ntl) { lstore((tl + 1) & 1); if (tl + 2 < ntl) gload((tl + 2) * 64); }
    __syncthreads();
  }
  lsum = xsum32(lsum);
  const float inv = 1.0f / lsum;
#pragma unroll
  for (int n = 0; n < 2; ++n)
#pragma unroll
    for (int g = 0; g < 4; ++g) {
      u32x2 w; w.x = pack2(o[n][4 * g] * inv, o[n][4 * g + 1] * inv); w.y = pack2(o[n][4 * g + 2] * inv, o[n][4 * g + 3] * inv);
      *(u32x2*)(Ow + (size_t)r * o_ld + 32 * n + 8 * g + 4 * hh) = w;
    }
}

DI void scan_item(const Params& p, int l, int seq, int hd, int dir, char* smem) {
  const int tid = otid(), lane = tid & 63, wv = __builtin_amdgcn_readfirstlane(tid >> 6);
  const int i16 = lane >> 2, jq = lane & 3, r = lane & 31, hh = lane >> 5;
  const bool lat = seq >= 32;
  const int T = lat ? 4096 : 256;
  const int row0 = lat ? NCTX + (seq - 32) * 4096 : seq * 256;
  float* vA = (float*)smem; float* vK = vA + 2048; float* vR = vK + 2048; float* vV = vR + 2048; float* vW = vV + 2048; float* vB = vW + 2048; float* ybuf = vB + 2048;
  char* raw = smem + 32768;
  char* wdx = smem + 57344; char* adx = smem + 61952;
  float* tmpb = (float*)(smem + 66816);
  const bf16_t* U = (const bf16_t*)(p.ws + OFF_U);
  bf16_t* Y = (bf16_t*)(p.ws + OFF_R2) + (dir ? (size_t)NT * 512 : 0);
  float* bonus = (float*)(p.ws + OFF_BONUS);
  const int irow = 16 * wv + i16;
  f32x2 S[8];
  if (lat) {
    const float* s0 = (dir ? opq(p.in[I_SB]) : opq(p.in[I_SF])) + ((size_t)((seq - 32) * 4 + l) * 8 + hd) * 4096 + irow * 64 + jq * 16;
#pragma unroll
    for (int q = 0; q < 4; ++q) { const f32x4 v = *(const f32x4*)(s0 + 4 * q); S[2 * q] = (f32x2){v.x, v.y}; S[2 * q + 1] = (f32x2){v.z, v.w}; }
  } else {
#pragma unroll
    for (int q = 0; q < 8; ++q) S[q] = (f32x2){0.f, 0.f};
  }
  const int mat = wv >> 1, ntc = wv & 1, cch = ntc * 32 + r, hc = hd * 64 + cch;
  bf16x8 bfrag[4];
  {
    const float* W = (mat ? opq(p.in[I_AUP]) : opq(p.in[I_WUP])) + (size_t)(l * 2 + dir) * 64 * 512 + hc;
#pragma unroll
    for (int s4 = 0; s4 < 4; ++s4) {
      float w8[8];
#pragma unroll
      for (int j = 0; j < 8; ++j) w8[j] = W[(size_t)(16 * s4 + 8 * hh + j) * 512];
      bfrag[s4] = __builtin_bit_cast(bf16x8, pack8(w8));
    }
  }
  const float bias = (mat ? opq(p.in[I_A0]) : opq(p.in[I_W0]))[(l * 2 + dir) * 512 + hc];
  const float kav = p.in[I_KA][l * 512 + hc], rkv = p.in[I_RK][l * 512 + hc];
  float* muP = (float*)(smem + 75008); float* muN = muP + 320; float* kkL = muN + 320;
  {
    const float* mup = p.in[I_MUP] + l * 1792; const float* mun = p.in[I_MUN] + l * 1792;
    for (int e = tid; e < 320; e += 256) { const int g = e >> 6, c = e & 63; const int col = (g < 3 ? g * 512 + hd * 64 : (g == 3 ? 1536 + dir * 64 : 1664 + dir * 64)) + c; muP[e] = mup[col]; muN[e] = mun[col]; }
    if (tid < 64) kkL[tid] = p.in[I_KK][l * 512 + hd * 64 + tid];
  }
  const int nch = T >> 5;
  u32x4 pre[6];
  auto prefetch = [&](int t0) {
#pragma unroll
    for (int q = 0; q < 6; ++q) {
      const int id = q * 256 + tid;
      const int row = id / 40, cc = id - row * 40, g = cc >> 3, c8 = cc & 7;
      const int t = t0 - 1 + row;
      const int col = (g < 3 ? g * 512 + hd * 64 : (g == 3 ? 1536 + dir * 64 : 1664 + dir * 64)) + c8 * 8;
      u32x4 v = (u32x4){0u, 0u, 0u, 0u};
      if (id < 1360 && t >= 0 && t < T) v = *(const u32x4*)(U + (size_t)(row0 + t) * ULD + 1696 + col);
      pre[q] = v;
    }
  };
  prefetch((dir ? nch - 1 : 0) * 32);
  for (int ci = 0; ci < nch; ++ci) {
    const int t0 = (dir ? nch - 1 - ci : ci) * 32;
#pragma unroll
    for (int q = 0; q < 6; ++q) { const int id = q * 256 + tid; if (id < 1360) *(u32x4*)(raw + id * 16) = pre[q]; }
    __syncthreads();
    if (ci + 1 < nch) prefetch((dir ? nch - 2 - ci : ci + 1) * 32);
    {
      const int tt = tid >> 3, sub = tid & 7;
#pragma unroll 1
      for (int g = 0; g < 5; ++g) {
        const int col = (g < 3 ? g * 512 + hd * 64 : (g == 3 ? 1536 + dir * 64 : 1664 + dir * 64)) + sub * 8;
        float c[8], pv[8], nx[8], x[8];
        unpack8(*(const u32x4*)(raw + (tt + 1) * 640 + (g * 8 + sub) * 16), c);
        unpack8(*(const u32x4*)(raw + tt * 640 + (g * 8 + sub) * 16), pv);
        unpack8(*(const u32x4*)(raw + (tt + 2) * 640 + (g * 8 + sub) * 16), nx);
        const f32x4 mp0 = *(const f32x4*)(muP + g * 64 + sub * 8), mp1 = *(const f32x4*)(muP + g * 64 + sub * 8 + 4), mn0 = *(const f32x4*)(muN + g * 64 + sub * 8), mn1 = *(const f32x4*)(muN + g * 64 + sub * 8 + 4);
        const float mp[8] = {mp0.x, mp0.y, mp0.z, mp0.w, mp1.x, mp1.y, mp1.z, mp1.w}, mn[8] = {mn0.x, mn0.y, mn0.z, mn0.w, mn1.x, mn1.y, mn1.z, mn1.w};
#pragma unroll
        for (int i = 0; i < 8; ++i) x[i] = c[i] + mp[i] * (pv[i] - c[i]) + mn[i] * (nx[i] - c[i]);
        const int lo = tt * 64 + sub * 8;
        if (g == 0) { *(f32x4*)(vR + lo) = (f32x4){x[0], x[1], x[2], x[3]}; *(f32x4*)(vR + lo + 4) = (f32x4){x[4], x[5], x[6], x[7]}; }
        else if (g == 1) {
          float kk[8], ss = 0.f;
          const float* kkw = kkL + sub * 8;
#pragma unroll
          for (int i = 0; i < 8; ++i) { kk[i] = x[i] * kkw[i]; ss += kk[i] * kk[i]; }
          *(f32x4*)(vK + lo) = (f32x4){x[0], x[1], x[2], x[3]}; *(f32x4*)(vK + lo + 4) = (f32x4){x[4], x[5], x[6], x[7]};
          ss += shx<1>(ss); ss += shx<2>(ss); ss += shx<4>(ss);
          const float inv = 1.0f / fmaxf(sqrtf(ss), 1e-12f);
          *(f32x4*)(vA + lo) = (f32x4){kk[0] * inv, kk[1] * inv, kk[2] * inv, kk[3] * inv}; *(f32x4*)(vA + lo + 4) = (f32x4){kk[4] * inv, kk[5] * inv, kk[6] * inv, kk[7] * inv};
        }
        else if (g == 2) { *(f32x4*)(vV + lo) = (f32x4){x[0], x[1], x[2], x[3]}; *(f32x4*)(vV + lo + 4) = (f32x4){x[4], x[5], x[6], x[7]}; }
        else if (g == 3) { float th[8]; for (int i = 0; i < 8; ++i) th[i] = tanhf(x[i]); *(u32x4*)(wdx + tt * 144 + sub * 16) = pack8(th); }
        else { *(u32x4*)(adx + tt * 144 + sub * 16) = pack8(x); }
      }
    }
    __syncthreads();
    {
      f32x16 acc;
#pragma unroll
      for (int e = 0; e < 16; ++e) acc[e] = 0.f;
      const char* xb = mat ? adx : wdx;
#pragma unroll
      for (int s4 = 0; s4 < 4; ++s4) { const bf16x8 af = *(const bf16x8*)(xb + r * 144 + (16 * s4 + 8 * hh) * 2); acc = MFMA32(af, bfrag[s4], acc); }
      if (mat == 0) {
#pragma unroll
        for (int e = 0; e < 16; ++e) vW[crow(e, hh) * 64 + cch] = __expf(-0.6065306597126334f * sigmoidf_(bias + acc[e]));
      } else {
#pragma unroll
        for (int e = 0; e < 16; ++e) {
          const int ix = crow(e, hh) * 64 + cch;
          const float ag = sigmoidf_(bias + acc[e]);
          const float kk = vA[ix], k = vK[ix], rr = vR[ix];
          const float kd = k * (1.0f + (ag - 1.0f) * kav);
          vK[ix] = kd; vA[ix] = -kk; vB[ix] = kk * ag; tmpb[ix] = rr * kd * rkv;
        }
      }
    }
    __syncthreads();
    {
      const int tt = tid >> 3, sub = tid & 7;
      const f32x4 b0 = *(const f32x4*)(tmpb + tt * 64 + sub * 8), b1 = *(const f32x4*)(tmpb + tt * 64 + sub * 8 + 4);
      float bs = (b0.x + b0.y) + (b0.z + b0.w) + (b1.x + b1.y) + (b1.z + b1.w);
      bs += shx<1>(bs); bs += shx<2>(bs); bs += shx<4>(bs);
      if (sub == 0) bonus[((size_t)(row0 + t0 + tt) * 8 + hd) * 2 + dir] = bs;
    }
    {
      f32x4 va[4], vw[4], vb[4], vk[4], vr[4]; float vi;
      int tt = dir ? 31 : 0;
      int vo = tt * 64 + jq * 16;
#pragma unroll
      for (int q = 0; q < 4; ++q) { va[q] = *(const f32x4*)(vA + vo + 4 * q); vw[q] = *(const f32x4*)(vW + vo + 4 * q); vb[q] = *(const f32x4*)(vB + vo + 4 * q); vk[q] = *(const f32x4*)(vK + vo + 4 * q); vr[q] = *(const f32x4*)(vR + vo + 4 * q); }
      vi = vV[tt * 64 + irow];
      for (int si = 0; si < 32; ++si) {
        const int ttn = dir ? (si < 31 ? 30 - si : 0) : (si < 31 ? si + 1 : 31);
        const int von = ttn * 64 + jq * 16;
        f32x2 pa2 = (f32x2){0.f, 0.f}, pa3 = (f32x2){0.f, 0.f};
#pragma unroll
        for (int q = 0; q < 4; ++q) { pa2 += S[2 * q] * (f32x2){va[q].x, va[q].y}; pa3 += S[2 * q + 1] * (f32x2){va[q].z, va[q].w}; }
#pragma unroll
        for (int q = 0; q < 4; ++q) va[q] = *(const f32x4*)(vA + von + 4 * q);
        pa2 += pa3;
        const float sa = qsum(pa2.x + pa2.y);
        const f32x2 sa2 = (f32x2){sa, sa}, vi2 = (f32x2){vi, vi};
        f32x2 py2 = (f32x2){0.f, 0.f}, py3 = (f32x2){0.f, 0.f};
#pragma unroll
        for (int q = 0; q < 4; ++q) {
          S[2 * q] = S[2 * q] * (f32x2){vw[q].x, vw[q].y} + (sa2 * (f32x2){vb[q].x, vb[q].y} + vi2 * (f32x2){vk[q].x, vk[q].y}); py2 += S[2 * q] * (f32x2){vr[q].x, vr[q].y};
          S[2 * q + 1] = S[2 * q + 1] * (f32x2){vw[q].z, vw[q].w} + (sa2 * (f32x2){vb[q].z, vb[q].w} + vi2 * (f32x2){vk[q].z, vk[q].w}); py3 += S[2 * q + 1] * (f32x2){vr[q].z, vr[q].w};
        }
        py2 += py3;
#pragma unroll
        for (int q = 0; q < 4; ++q) { vw[q] = *(const f32x4*)(vW + von + 4 * q); vb[q] = *(const f32x4*)(vB + von + 4 * q); vk[q] = *(const f32x4*)(vK + von + 4 * q); vr[q] = *(const f32x4*)(vR + von + 4 * q); }
        vi = vV[ttn * 64 + irow];
        const float py = qsum(py2.x + py2.y);
        if (jq == 0) ybuf[tt * 64 + irow] = py;
        tt = ttn;
      }
    }
    __syncthreads();
    {
      const int tt = tid >> 3, sub = tid & 7;
      float v[8];
      const f32x4 y0 = *(const f32x4*)(ybuf + tt * 64 + sub * 8), y1 = *(const f32x4*)(ybuf + tt * 64 + sub * 8 + 4);
      v[0] = y0.x; v[1] = y0.y; v[2] = y0.z; v[3] = y0.w; v[4] = y1.x; v[5] = y1.y; v[6] = y1.z; v[7] = y1.w;
      *(u32x4*)(Y + (size_t)(row0 + t0 + tt) * 512 + hd * 64 + sub * 8) = pack8(v);
    }
    __syncthreads();
  }
  if (!lat) {
    float* o = opq(p.out) + (dir ? OUT_SB : OUT_SF) + ((size_t)(seq * 4 + l) * 8 + hd) * 4096 + irow * 64 + jq * 16;
#pragma unroll
    for (int q = 0; q < 4; ++q) *(f32x4*)(o + 4 * q) = (f32x4){S[2 * q].x, S[2 * q].y, S[2 * q + 1].x, S[2 * q + 1].y};
  }
}

DI void phase_mixers(const Params& p, int l, char* smem, int part = 0) {
  const int tid = otid(), wid = __builtin_amdgcn_readfirstlane(tid >> 6);
  unsigned* cnt = (unsigned*)(p.ws + OFF_CNT) + l + 4 * part;
  int* slot = (int*)(smem + SMEM_BYTES - 16);
  bf16_t* U = (bf16_t*)(p.ws + OFF_U);
  const bf16_t* KA = (const bf16_t*)(p.ws + OFF_KA); const bf16_t* VAT = (const bf16_t*)(p.ws + OFF_VAT);
  const bf16_t* KN = (const bf16_t*)(p.ws + OFF_KN); const bf16_t* VBT = (const bf16_t*)(p.ws + OFF_VBT); const bf16_t* KRB = (const bf16_t*)(p.ws + OFF_KRB);
  const int NITEMS = 128 + 4096 + 1536;
  for (;;) {
    if (tid == 0) *slot = (int)atomicAdd(cnt, 1u);
    __syncthreads();
    const int item = __builtin_amdgcn_readfirstlane(*slot);
    __syncthreads();
    if (item >= NITEMS) break;
#ifdef PROBE_SPLIT
    { const bool isscan = item < 128 || (item >= 128 + 4096 && item < 128 + 4096 + 512); if ((part != 1) != isscan) continue; }
#endif
    int kind, seq, a, qt;
    if (item < 128) { kind = 0; seq = 32 + (item >> 4); a = (item >> 1) & 7; qt = item & 1; }
    else if (item < 128 + 2048) { const int k = item - 128; kind = 1; seq = 32 + (k >> 8); a = (k >> 7) & 1; qt = k & 127; }
    else if (item < 128 + 4096) { const int k = item - 128 - 2048; kind = 2; seq = 32 + (k >> 8); a = (k >> 5) & 7; qt = k & 31; }
    else if (item < 128 + 4096 + 512) { const int k = item - 128 - 4096; kind = 0; seq = k >> 4; a = (k >> 1) & 7; qt = k & 1; }
    else if (item < 128 + 4096 + 1024) { const int k = item - 128 - 4096 - 512; kind = 1; seq = k >> 4; a = (k >> 3) & 1; qt = k & 7; }
    else { const int k = item - 128 - 4096 - 1024; kind = 2; seq = k >> 4; a = (k >> 1) & 7; qt = k & 1; }
    const int kr0 = keyrow0(seq), Tk = seq_tk(seq);
    const int row0 = seq < 32 ? seq * 256 : NCTX + (seq - 32) * 4096;
    if (kind == 0) scan_item(p, l, seq, a, qt, smem);
    else if (kind == 1) {
      const int qh = a * 4 + wid;
      bf16_t* q = U + (size_t)(row0 + qt * 32) * ULD + qh * 64;
      attn_item<64>(q, ULD, KA + (size_t)kr0 * 128 + a * 64, 128, nullptr, 0, VAT + (size_t)128 * kr0 + (size_t)(a * 64) * Tk, Tk, Tk, q, ULD, smem);
    } else {
      bf16_t* q = U + (size_t)(row0 + qt * 128 + wid * 32) * ULD + 768 + a * 96;
      attn_item<96>(q, ULD, KN + (size_t)kr0 * 512 + a * 64, 512, KRB + (size_t)kr0 * 32, 32, VBT + (size_t)512 * kr0 + (size_t)(a * 64) * Tk, Tk, Tk, q, ULD, smem);
    }
  }
}

DI void cpost_row(const Params& p, int l, int row, int lane) {
  int seq, t; row_decode(row, seq, t);
  const int T = seq < 32 ? 256 : 4096;
  const bf16_t* YF = (const bf16_t*)(p.ws + OFF_R2); const bf16_t* YB = YF + (size_t)NT * 512;
  bf16_t* u = (bf16_t*)(p.ws + OFF_U) + (size_t)row * ULD + 1696;
  const float* bonus = (const float*)(p.ws + OFF_BONUS);
  float yf[8], yb[8], y[8];
  unpack8(*(const u32x4*)(YF + (size_t)row * 512 + lane * 8), yf);
  unpack8(*(const u32x4*)(YB + (size_t)row * 512 + lane * 8), yb);
  float s = 0.f;
#pragma unroll
  for (int i = 0; i < 8; ++i) { y[i] = yf[i] + yb[i]; s += y[i]; }
  s += shx<1>(s); s += shx<2>(s); s += shx<4>(s);
  const float mu = s * (1.0f / 64.0f);
  float q = 0.f;
#pragma unroll
  for (int i = 0; i < 8; ++i) { y[i] -= mu; q += y[i] * y[i]; }
  q += shx<1>(q); q += shx<2>(q); q += shx<4>(q);
  const float rs = rsqrtf(q * (1.0f / 64.0f) + 64e-5f);
  const int col = 1024 + lane * 8;
  float c[8], pv[8], nx[8];
  unpack8(*(const u32x4*)(u + col), c);
  if (t > 0) unpack8(*(const u32x4*)(u - ULD + col), pv); else { for (int i = 0; i < 8; ++i) pv[i] = 0.f; }
  if (t < T - 1) unpack8(*(const u32x4*)(u + ULD + col), nx); else { for (int i = 0; i < 8; ++i) nx[i] = 0.f; }
  const float* mup = p.in[I_MUP] + l * 1792 + col; const float* mun = p.in[I_MUN] + l * 1792 + col;
  const float* lw = p.in[I_LNW] + l * 512 + lane * 8; const float* lb = p.in[I_LNB] + l * 512 + lane * 8;
  const f32x2 bsv = *(const f32x2*)(bonus + ((size_t)row * 8 + (lane >> 3)) * 2);
  const float bs = bsv.x + bsv.y;
  float o[8];
#pragma unroll
  for (int i = 0; i < 8; ++i) { const float v = c[i] + mup[i] * (pv[i] - c[i]) + mun[i] * (nx[i] - c[i]); o[i] = y[i] * rs * lw[i] + lb[i] + bs * v; }
  *(u32x4*)(u + lane * 8) = pack8(o);
}
DI void phase_renorm_cpost(const Params& p, int l) {
  const int lane = otid() & 63, wid = __builtin_amdgcn_readfirstlane(otid() >> 6);
  for (int item = blockIdx.x; item < NT / 4; item += gridDim.x) { const int row = item * 4 + wid; norm_row(p, l, row, lane); cpost_row(p, l, row, lane); }
}

DI void phase_zgemm(const Params& p, char* smem) {
  const bf16_t* H = (const bf16_t*)(p.ws + OFF_R1);
  const bf16_t* W = (const bf16_t*)(p.ws + OFF_WIN) + (size_t)3584 * 1024;
  bf16_t* U = (bf16_t*)(p.ws + OFF_U);
  const int ntiles = 320 * 12;
  for (int tile = blockIdx.x; tile < ntiles; tile += gridDim.x) {
    const int mt = tile / 12, nt = tile % 12, m0 = mt * 128, n0 = nt * 128;
    f32x16 acc[2][2]; zero_acc<2>(acc);
    gemm_mainloop<2>(acc, H + (size_t)m0 * 1024, 1024, 64, W + (size_t)n0 * 1024, 1024, 1024, smem);
    const int lane = otid() & 63, wid = __builtin_amdgcn_readfirstlane(otid() >> 6), wm = wid >> 1, wn = wid & 1, r = lane & 31, hh = lane >> 5;
#pragma unroll
    for (int j = 0; j < 2; ++j) {
      const int col = n0 + wn * 64 + j * 32 + r;
      const int br = col >> 9, cc = col & 511;
      const int ucol = br == 0 ? cc : (br == 1 ? 768 + (cc >> 6) * 96 + (cc & 63) : 1696 + cc);
#pragma unroll
      for (int i = 0; i < 2; ++i) {
        bf16_t* up = U + (size_t)(m0 + wm * 64 + i * 32) * ULD;
        const int lo = 4 * hh * ULD + ucol;
        bf16_t yv[16];
#pragma unroll
        for (int e = 0; e < 16; ++e) yv[e] = (up + crowu(e) * ULD)[lo];
#pragma unroll
        for (int e = 0; e < 16; ++e) (up + crowu(e) * ULD)[lo] = f2bf(bf2f(yv[e]) * siluf_(acc[i][j][e]));
      }
    }
  }
}

DI void phase_merge(const Params& p, char* smem) {
  const bf16_t* H = (const bf16_t*)(p.ws + OFF_R1);
  const bf16_t* WG = (const bf16_t*)(p.ws + OFF_WIN) + (size_t)5120 * 1024;
  const bf16_t* WO = (const bf16_t*)(p.ws + OFF_WO);
  const bf16_t* U = (const bf16_t*)(p.ws + OFF_U);
  bf16_t* MX = (bf16_t*)(p.ws + OFF_R2);
  const int ntiles = 320 * 16;
  for (int tile = blockIdx.x; tile < ntiles; tile += gridDim.x) {
    const int mt = tile >> 4, nt = tile & 15, m0 = mt * 128, n0 = nt * 64;
    f32x16 mix[2][1]; zero_acc<1>(mix);
    f32x16 gs[2][1]; zero_acc<1>(gs);
#pragma unroll 1
    for (int step = 0; step < 6; ++step) {
      const int br = step >> 1, isT = step & 1;
      const int acol = br == 0 ? 0 : (br == 1 ? 768 : 1696);
      const bf16_t* Ap = isT ? U + (size_t)m0 * ULD + acol : H + (size_t)m0 * 1024;
      const bf16_t* Bp = isT ? WO + (size_t)(br * 1024 + n0) * 512 : WG + (size_t)(br * 1024 + n0) * 1024;
      f32x16 cur[2][1]; zero_acc<1>(cur);
      gemm_mainloop<1>(cur, Ap, isT ? ULD : 1024, (isT && br == 1) ? 96 : 64, Bp, isT ? 512 : 1024, isT ? 512 : 1024, smem);
      if (isT) {
#pragma unroll
        for (int i = 0; i < 2; ++i)
#pragma unroll
          for (int e = 0; e < 16; ++e) mix[i][0][e] += gs[i][0][e] * cur[i][0][e];
      } else {
#pragma unroll
        for (int i = 0; i < 2; ++i)
#pragma unroll
          for (int e = 0; e < 16; ++e) gs[i][0][e] = sigmoidf_(cur[i][0][e]);
      }
    }
    const int lane = otid() & 63, wid = __builtin_amdgcn_readfirstlane(otid() >> 6), wm = wid >> 1, wn = wid & 1, r = lane & 31, hh = lane >> 5;
    const int col = n0 + wn * 32 + r;
#pragma unroll
    for (int i = 0; i < 2; ++i) {
      bf16_t* mp = MX + (size_t)(m0 + wm * 64 + i * 32) * 1024;
      const int lo = 4 * hh * 1024 + col;
#pragma unroll
      for (int e = 0; e < 16; ++e) (mp + crowu(e) * 1024)[lo] = f2bf(mix[i][0][e]);
    }
  }
}

DI void phase_out(const Params& p, int l, char* smem) {
  const bf16_t* MX = (const bf16_t*)(p.ws + OFF_R2);
  const bf16_t* W = (const bf16_t*)(p.ws + OFF_WOUT);
  const int ntiles = 320 * 8;
  for (int tile = blockIdx.x; tile < ntiles; tile += gridDim.x) {
    const int mt = tile >> 3, nt = tile & 7, m0 = mt * 128, n0 = nt * 128;
    f32x16 acc[2][2]; zero_acc<2>(acc);
    gemm_mainloop<2>(acc, MX + (size_t)m0 * 1024, 1024, 64, W + (size_t)n0 * 1024, 1024, 1024, smem);
    const int lane = otid() & 63, wid = __builtin_amdgcn_readfirstlane(otid() >> 6), wm = wid >> 1, wn = wid & 1, r = lane & 31, hh = lane >> 5;
    const int jm = m0 < NCTX ? 0 : 1 + ((m0 - NCTX) >> 12);
    const float* gate = (const float*)(p.ws + OFF_MOD) + ((size_t)l * 9 + jm) * MODLD + 2048;
    const float* xsrc = x_row_ptr(p, l, m0);
#pragma unroll
    for (int j = 0; j < 2; ++j) {
      const int col = n0 + wn * 64 + j * 32 + r;
      const float gv = gate[col];
      const int lo = 4 * hh * 1024 + col;
#pragma unroll
      for (int i = 0; i < 2; ++i) {
        const float* xs = xsrc + (size_t)(wm * 64 + i * 32) * 1024;
        float* xo = p.out + (size_t)(m0 + wm * 64 + i * 32) * 1024;
        float xv[16];
#pragma unroll
        for (int e = 0; e < 16; ++e) xv[e] = (xs + crowu(e) * 1024)[lo];
#pragma unroll
        for (int e = 0; e < 16; ++e) (xo + crowu(e) * 1024)[lo] = xv[e] + gv * acc[i][j][e];
      }
    }
  }
}

DI void phase_final(const Params& p) {
  const int lane = otid() & 63, wid = __builtin_amdgcn_readfirstlane(otid() >> 6);
  const float* nw = p.in[I_FNW];
  for (int item = blockIdx.x; item < NT / 4; item += gridDim.x) {
    float* x = p.out + (size_t)(item * 4 + wid) * 1024;
    f32x4 v[4]; float ss = 0.f;
#pragma unroll
    for (int i = 0; i < 4; ++i) { v[i] = *(const f32x4*)(x + lane * 4 + 256 * i); ss += v[i].x * v[i].x + v[i].y * v[i].y + v[i].z * v[i].z + v[i].w * v[i].w; }
ss = wave_sum(ss);
    const float rs = rsqrtf(ss * (1.0f / 1024.0f) + 1e-6f);
#pragma unroll
    for (int i = 0; i < 4; ++i) { const f32x4 w = *(const f32x4*)(nw + lane * 4 + 256 * i); *(f32x4*)(x + lane * 4 + 256 * i) = (f32x4){v[i].x * rs * w.x, v[i].y * rs * w.y, v[i].z * rs * w.z, v[i].w * rs * w.w}; }
  }
}

constexpr int NPHASES = 1 + 4 * 9 + 1;
__global__ void __launch_bounds__(256, 2) fwd_kernel(Params p0) {
  __shared__ __attribute__((aligned(16))) char smem[SMEM_BYTES];
  cg::grid_group grid = cg::this_grid();
  const int ph_begin = p0.ph_begin, ph_end = p0.ph_end;
  for (int ph = ph_begin; ph < ph_end; ++ph) {
    auto kp = __builtin_amdgcn_kernarg_segment_ptr();
    asm volatile("" : "+s"(kp));
    typedef const __attribute__((address_space(4))) Params CParams;
    CParams* kpp = (CParams*)kp;
    Params p;
#pragma unroll
    for (int i = 0; i < 35; ++i) p.in[i] = kpp->in[i];
    p.out = kpp->out; p.ws = kpp->ws; p.ph_begin = ph_begin; p.ph_end = ph_end;
    if (ph == 0) phase_prologue(p, smem);
    else if (ph == NPHASES - 1) phase_final(p);
    else {
      const int l = (ph - 1) / 9, sp = (ph - 1) % 9;
#ifdef PROBE_SP
      if (sp == PROBE_SP) {
        switch (sp) {
          case 0: phase_norm_convert(p, l, smem); break;
          case 1: phase_gemm1(p, l, smem); break;
          case 3: phase_upproj(p, smem); break;
          case 5: phase_renorm_cpost(p, l); break;
          case 7: phase_merge(p, smem); break;
          default: break;
        }
        grid.sync();
      }
#endif
      switch (sp) {
        case 0: phase_norm_convert(p, l, smem); break;
        case 1: phase_gemm1(p, l, smem); break;
        case 2: phase_post(p, l); break;
        case 3: phase_upproj(p, smem); break;
#ifdef PROBE_SPLIT
        case 4:
#if PROBE_SPLIT == 2
                phase_mixers(p, l, smem, 2); grid.sync();
#endif
                phase_mixers(p, l, smem, 0); grid.sync();
                phase_mixers(p, l, smem, 1); break;
#else
        case 4: phase_mixers(p, l, smem); break;
#endif
        case 5: phase_renorm_cpost(p, l); break;
        case 6: phase_zgemm(p, smem); break;
        case 7: phase_merge(p, smem); break;
        default: phase_out(p, l, smem); break;
      }
    }
    if (ph + 1 < ph_end) grid.sync();
  }
}

extern "C" void kernel_launch(void* const* d_in, const int* in_sizes, int n_in, void* d_out, int out_size, void* d_ws, size_t ws_size, hipStream_t stream) {
  if (ws_size < WS_NEED || n_in < 35) { fprintf(stderr, "workspace too small: %zu < %zu\n", ws_size, WS_NEED); return; }
  static int grid_blocks = 0;
  if (!grid_blocks) {
    int dev = 0, cus = 0, per_cu = 0;
    hipGetDevice(&dev);
    hipDeviceGetAttribute(&cus, hipDeviceAttributeMultiprocessorCount, dev);
    hipOccupancyMaxActiveBlocksPerMultiprocessor(&per_cu, fwd_kernel, 256, 0);
    if (per_cu < 1) per_cu = 1;
    if (per_cu > 2) per_cu = 2;
    grid_blocks = cus * per_cu;
  }
  Params p{};
  for (int i = 0; i < 35; ++i) p.in[i] = (const float*)d_in[i];
  p.out = (float*)d_out; p.ws = (char*)d_ws;
#ifndef ONE_LAUNCH
  for (int ph = 0; ph < NPHASES; ++ph) {
    p.ph_begin = ph; p.ph_end = ph + 1;
    hipLaunchKernelGGL(fwd_kernel, dim3(grid_blocks), dim3(256), 0, stream, p);
  }
#else
  p.ph_begin = 0; p.ph_end = NPHASES;
  void* args[] = {&p};
  hipError_t e = hipLaunchCooperativeKernel((void*)fwd_kernel, dim3(grid_blocks), dim3(256), args, 0, stream);
  if (e != hipSuccess) fprintf(stderr, "cooperative launch failed: %s (grid %d)\n", hipGetErrorString(e), grid_blocks);
#endif
}
```

```cpp
#define ONE_LAUNCH 1
#include <hip/hip_runtime.h>
#include <hip/hip_cooperative_groups.h>
#include <stdint.h>
#include <stdio.h>
namespace cg = cooperative_groups;

typedef unsigned short bf16_t;
typedef short bf16x8 __attribute__((ext_vector_type(8)));
typedef float f32x16 __attribute__((ext_vector_type(16)));
typedef float f32x4 __attribute__((ext_vector_type(4)));
typedef float f32x2 __attribute__((ext_vector_type(2)));
typedef unsigned u32x4 __attribute__((ext_vector_type(4)));
typedef unsigned u32x2 __attribute__((ext_vector_type(2)));
#define DI __device__ __forceinline__
#define MFMA32(a, b, c) __builtin_amdgcn_mfma_f32_32x32x16_bf16((a), (b), (c), 0, 0, 0)

constexpr int NT = 40960;
constexpr int NCTX = 8192;
constexpr int NK = 45056;
constexpr int ULD = 3488;
constexpr int MODLD = 3072;
constexpr int SMEM_BYTES = 78848;

constexpr size_t OFF_WIN = 0;
constexpr size_t OFF_WO = 16777216;
constexpr size_t OFF_WOUT = 19922944;
constexpr size_t OFF_WU = 22020096;
constexpr size_t OFF_MOD = 22282240;
constexpr size_t OFF_BONUS = 22724608;
constexpr size_t OFF_CS16 = 25346048;
constexpr size_t OFF_CS8 = 25354240;
constexpr size_t OFF_CNT = 25358336;
constexpr size_t OFF_U = 25358592;
constexpr size_t OFF_R1 = 311095552;
constexpr size_t OFF_KA = OFF_R1;
constexpr size_t OFF_VAT = 513208576;
constexpr size_t OFF_KN = OFF_R1 + 23068672;
constexpr size_t OFF_VBT = OFF_R1 + 69206016;
constexpr size_t OFF_KRB = OFF_R1 + 115343360;
constexpr size_t OFF_R2 = 429322496;
constexpr size_t WS_NEED = 524742912;

constexpr size_t OUT_AK = 41943040, OUT_AV = 46137344, OUT_CKV = 50331648, OUT_KR = 54525952, OUT_SF = 55574528, OUT_SB = 59768832;

struct Params {
  const float* in[35];
  float* out;
  char* ws;
  int ph_begin, ph_end;
};

enum { I_XP = 0, I_XS, I_CAK, I_CAV, I_CCKV, I_CKR, I_SF, I_SB, I_C, I_CCTX, I_NORMW, I_WMOD, I_BMOD, I_WIN, I_QNW, I_KNW, I_KVNW,
       I_WUK, I_WUV, I_MUP, I_MUN, I_W0, I_WUP, I_A0, I_AUP, I_KK, I_KA, I_RK, I_LNW, I_LNB, I_WOA, I_WOB, I_WOC, I_WOUT, I_FNW };

DI int threadIdx_x_raw() { return __builtin_amdgcn_workitem_id_x(); }
DI int otid() { int t = threadIdx_x_raw(); asm volatile("" : "+v"(t)); return t; }
DI const float* opq(const float* q) { asm volatile("" : "+s"(q)); return q; }
DI float* opq(float* q) { asm volatile("" : "+s"(q)); return q; }
DI float bf2f(bf16_t v) { return __uint_as_float(((unsigned)v) << 16); }
typedef __bf16 hbf16x2 __attribute__((ext_vector_type(2)));
DI unsigned pack2(float a, float b) { f32x2 v = {a, b}; hbf16x2 r = __builtin_convertvector(v, hbf16x2); return __builtin_bit_cast(unsigned, r); }
DI bf16_t f2bf(float x) { return (bf16_t)(pack2(x, 0.f) & 0xffffu); }
DI float xsum16(float x) { const unsigned u = __float_as_uint(x); auto r = __builtin_amdgcn_permlane16_swap(u, u, false, false); return __uint_as_float(r[0]) + __uint_as_float(r[1]); }
DI float xsum32(float x) { const unsigned u = __float_as_uint(x); auto r = __builtin_amdgcn_permlane32_swap(u, u, false, false); return __uint_as_float(r[0]) + __uint_as_float(r[1]); }
DI float lo16(unsigned w) { return __uint_as_float(w << 16); }
DI float hi16(unsigned w) { return __uint_as_float(w & 0xffff0000u); }
DI void unpack8(u32x4 w, float* v) { v[0] = lo16(w.x); v[1] = hi16(w.x); v[2] = lo16(w.y); v[3] = hi16(w.y); v[4] = lo16(w.z); v[5] = hi16(w.z); v[6] = lo16(w.w); v[7] = hi16(w.w); }
DI u32x4 pack8(const float* v) { u32x4 w; w.x = pack2(v[0], v[1]); w.y = pack2(v[2], v[3]); w.z = pack2(v[4], v[5]); w.w = pack2(v[6], v[7]); return w; }
template <int K> DI float shx(float v) { return __int_as_float(__builtin_amdgcn_ds_swizzle(__float_as_int(v), 0x1f | (K << 10))); }
DI float wave_sum(float v) { v += shx<1>(v); v += shx<2>(v); v += shx<4>(v); v += shx<8>(v); v += shx<16>(v); return xsum32(v); }
DI float qsum(float v) {
  v += __int_as_float(__builtin_amdgcn_update_dpp(0, __float_as_int(v), 0xB1, 0xf, 0xf, true));
  v += __int_as_float(__builtin_amdgcn_update_dpp(0, __float_as_int(v), 0x4E, 0xf, 0xf, true));
  return v;
}
DI float osum(float v) {
  v = qsum(v);
  v += __int_as_float(__builtin_amdgcn_update_dpp(0, __float_as_int(v), 0x141, 0xf, 0xf, true));
  return v;
}
DI int crow(int reg, int h) { return (reg & 3) + 8 * (reg >> 2) + 4 * h; }
DI int crowu(int reg) { return (reg & 3) + 8 * (reg >> 2); }
DI int perm16(int t) { return (t & ~12) | ((t & 4) << 1) | ((t & 8) >> 1); }
DI float sigmoidf_(float x) { return 1.0f / (1.0f + __expf(-x)); }
DI float siluf_(float x) { return x / (1.0f + __expf(-x)); }

DI void row_decode(int row, int& seq, int& t) {
  if (row < NCTX) { seq = row >> 8; t = row & 255; } else { seq = 32 + ((row - NCTX) >> 12); t = (row - NCTX) & 4095; }
}
DI int keyrow0(int seq) { return seq < 32 ? seq * 256 : NCTX + (seq - 32) * 4608; }
DI int seq_tk(int seq) { return seq < 32 ? 256 : 4608; }

template <int NJ>
DI void gemm_mainloop(f32x16 (&acc)[2][NJ], const bf16_t* __restrict__ A, int lda, int ks,
                      const bf16_t* __restrict__ Bt, int ldb, int K, char* smem) {
  constexpr int A_BYTES = 128 * 128;
  constexpr int B_BYTES = 64 * NJ * 128;
  constexpr int STAGE = A_BYTES + B_BYTES;
  const int tid = otid(), lane = tid & 63, wid = __builtin_amdgcn_readfirstlane(tid >> 6), wm = wid >> 1, wn = wid & 1;
  const int r = lane & 31, hh = lane >> 5;
  const int nk = K >> 6;
  const int lrow = tid >> 3, lc = tid & 7;
  u32x4 ra[4], rb[2 * NJ];
  const bf16_t* ap = A + (size_t)lrow * lda + lc * 8;
  const bf16_t* bp = Bt + (size_t)lrow * ldb + lc * 8;
#pragma unroll
  for (int p = 0; p < 4; ++p) ra[p] = *(const u32x4*)(ap + (size_t)(32 * p) * lda);
#pragma unroll
  for (int p = 0; p < 2 * NJ; ++p) rb[p] = *(const u32x4*)(bp + (size_t)(32 * p) * ldb);
  {
    char* base = smem;
#pragma unroll
    for (int p = 0; p < 4; ++p) { const int row = lrow + 32 * p; *(u32x4*)(base + row * 128 + ((lc ^ ((row >> 1) & 7)) << 4)) = ra[p]; }
#pragma unroll
    for (int p = 0; p < 2 * NJ; ++p) { const int row = lrow + 32 * p; *(u32x4*)(base + A_BYTES + row * 128 + ((lc ^ ((row >> 1) & 7)) << 4)) = rb[p]; }
  }
  if (nk > 1) {
    const bf16_t* ap2 = ap + (size_t)ks;
    const bf16_t* bp2 = bp + (size_t)64;
#pragma unroll
    for (int p = 0; p < 4; ++p) ra[p] = *(const u32x4*)(ap2 + (size_t)(32 * p) * lda);
#pragma unroll
    for (int p = 0; p < 2 * NJ; ++p) rb[p] = *(const u32x4*)(bp2 + (size_t)(32 * p) * ldb);
  }
  __syncthreads();
  for (int kt = 0; kt < nk; ++kt) {
    const char* base = smem + (kt & 1) * STAGE;
#pragma unroll
    for (int s = 0; s < 4; ++s) {
      bf16x8 af[2], bfr[NJ];
#pragma unroll
      for (int i = 0; i < 2; ++i) { const int row = wm * 64 + i * 32 + r; af[i] = *(const bf16x8*)(base + row * 128 + (((2 * s + hh) ^ ((row >> 1) & 7)) << 4)); }
#pragma unroll
      for (int j = 0; j < NJ; ++j) { const int row = wn * (32 * NJ) + j * 32 + r; bfr[j] = *(const bf16x8*)(base + A_BYTES + row * 128 + (((2 * s + hh) ^ ((row >> 1) & 7)) << 4)); }
#pragma unroll
      for (int i = 0; i < 2; ++i)
#pragma unroll
        for (int j = 0; j < NJ; ++j) acc[i][j] = MFMA32(af[i], bfr[j], acc[i][j]);
    }
    if (kt + 1 < nk) {
      char* nb = smem + ((kt + 1) & 1) * STAGE;
#pragma unroll
      for (int p = 0; p < 4; ++p) { const int row = lrow + 32 * p; *(u32x4*)(nb + row * 128 + ((lc ^ ((row >> 1) & 7)) << 4)) = ra[p]; }
#pragma unroll
      for (int p = 0; p < 2 * NJ; ++p) { const int row = lrow + 32 * p; *(u32x4*)(nb + A_BYTES + row * 128 + ((lc ^ ((row >> 1) & 7)) << 4)) = rb[p]; }
      if (kt + 2 < nk) {
        const bf16_t* ap2 = ap + (size_t)(kt + 2) * ks;
        const bf16_t* bp2 = bp + (size_t)(kt + 2) * 64;
#pragma unroll
        for (int p = 0; p < 4; ++p) ra[p] = *(const u32x4*)(ap2 + (size_t)(32 * p) * lda);
#pragma unroll
        for (int p = 0; p < 2 * NJ; ++p) rb[p] = *(const u32x4*)(bp2 + (size_t)(32 * p) * ldb);
      }
    }
    __syncthreads();
  }
}

template <int NJ> DI void zero_acc(f32x16 (&acc)[2][NJ]) {
#pragma unroll
  for (int i = 0; i < 2; ++i)
#pragma unroll
    for (int j = 0; j < NJ; ++j)
#pragma unroll
      for (int e = 0; e < 16; ++e) acc[i][j][e] = 0.f;
}

DI void phase_prologue(const Params& p, char* smem) {
  const int tid = otid(), lane = tid & 63, wid = __builtin_amdgcn_readfirstlane(tid >> 6);
  float* mod = (float*)(p.ws + OFF_MOD);
  if (blockIdx.x == 0) {
    if (tid < 64) ((unsigned*)(p.ws + OFF_CNT))[tid] = 0u;
    float* cs16 = (float*)(p.ws + OFF_CS16);
    float* cs8 = (float*)(p.ws + OFF_CS8);
    for (int e = tid; e < 64 * 16; e += 256) { const int pos = e >> 4, i = e & 15; const float inv = expf(-9.210340371976184f * (float)i / 16.0f); const float a = (float)pos * inv; cs16[e * 2] = cosf(a); cs16[e * 2 + 1] = sinf(a); }
    for (int e = tid; e < 64 * 8; e += 256) { const int pos = e >> 3, i = e & 7; const float inv = expf(-9.210340371976184f * (float)i / 8.0f); const float a = (float)pos * inv; cs8[e * 2] = cosf(a); cs8[e * 2 + 1] = sinf(a); }
  }
  float* sl = (float*)smem;
  float* red = sl + 9 * 1024;
  for (int e = tid; e < 9 * 1024; e += 256) { const int j = e >> 10, k = e & 1023; const float* cc0 = opq(p.in[I_CCTX]); const float* cc1 = opq(p.in[I_C]); const float c = j == 0 ? cc0[k] : cc1[(j - 1) * 1024 + k]; sl[e] = siluf_(c); }
  __syncthreads();
  for (int item = blockIdx.x; item < 192; item += gridDim.x) {
    const int l = item / 48, n = (item % 48) * 64 + lane;
    const float* w = p.in[I_WMOD] + (size_t)l * 1024 * 3072 + n;
    float a[9];
#pragma unroll
    for (int j = 0; j < 9; ++j) a[j] = 0.f;
    for (int k = wid * 256; k < wid * 256 + 256; ++k) {
      const float wv = w[(size_t)k * 3072];
#pragma unroll
      for (int j = 0; j < 9; ++j) a[j] += sl[j * 1024 + k] * wv;
    }
#pragma unroll
    for (int j = 0; j < 9; ++j) red[(wid * 9 + j) * 64 + lane] = a[j];
    __syncthreads();
    for (int e = tid; e < 9 * 64; e += 256) {
      const int j = e >> 6, c = e & 63;
      const float s = red[(0 * 9 + j) * 64 + c] + red[(1 * 9 + j) * 64 + c] + red[(2 * 9 + j) * 64 + c] + red[(3 * 9 + j) * 64 + c];
      const int nn = (item % 48) * 64 + c;
      mod[((size_t)l * 9 + j) * MODLD + nn] = s + p.in[I_BMOD][l * 3072 + nn];
    }
    __syncthreads();
  }
}

DI const float* x_row_ptr(const Params& p, int l, int row) {
  const float* xp = opq(p.in[I_XP]); const float* xs = opq(p.in[I_XS]); const float* xo = opq((const float*)p.out);
  if (l == 0) return row < NCTX ? xp + (size_t)row * 1024 : xs + (size_t)(row - NCTX) * 1024;
  return xo + (size_t)row * 1024;
}
DI void norm_row(const Params& p, int l, int row, int lane) {
  const float* x = x_row_ptr(p, l, row);
  const int j = row < NCTX ? 0 : 1 + ((row - NCTX) >> 12);
  const float* mod = (const float*)(p.ws + OFF_MOD) + ((size_t)l * 9 + j) * MODLD;
  const float* nw = p.in[I_NORMW] + l * 1024;
  bf16_t* h = (bf16_t*)(p.ws + OFF_R1) + (size_t)row * 1024;
  f32x4 v[4]; float ss = 0.f;
#pragma unroll
  for (int i = 0; i < 4; ++i) { v[i] = *(const f32x4*)(x + lane * 4 + 256 * i); ss += v[i].x * v[i].x + v[i].y * v[i].y + v[i].z * v[i].z + v[i].w * v[i].w; }
ss = wave_sum(ss);
  const float rs = rsqrtf(ss * (1.0f / 1024.0f) + 1e-6f);
#pragma unroll
  for (int i = 0; i < 4; ++i) {
    const int c = lane * 4 + 256 * i;
    const f32x4 w = *(const f32x4*)(nw + c), sh = *(const f32x4*)(mod + c), sc = *(const f32x4*)(mod + 1024 + c);
    u32x2 o;
    o.x = pack2(v[i].x * rs * w.x * (1.f + sc.x) + sh.x, v[i].y * rs * w.y * (1.f + sc.y) + sh.y);
    o.y = pack2(v[i].z * rs * w.z * (1.f + sc.z) + sh.z, v[i].w * rs * w.w * (1.f + sc.w) + sh.w);
    *(u32x2*)(h + c) = o;
  }
}

DI int win_srccol(int j) {
  if (j < 768) return j;
  if (j < 1696) return j + 512;
  if (j < 3488) return j + 1024;
  if (j < 3584) return -1;
  if (j < 5120) { const int jj = j - 3584; return jj < 512 ? 768 + jj : (jj < 1024 ? 2208 + (jj - 512) : 4512 + (jj - 1024)); }
  return 5024 + (j - 5120);
}
DI void conv_tile(const float* __restrict__ src, int ld_src, bf16_t* dst, int ld_dst, int k0, int n0, int kind, int srcoff, char* smem) {
  float* tile = (float*)smem;
  const int tid = otid();
  const int n = tid & 63;
  int sc = kind == 0 ? win_srccol(n0 + n) : (n0 + n - srcoff);
#pragma unroll
  for (int i = 0; i < 16; ++i) { const int k = i * 4 + (tid >> 6); tile[k * 65 + n] = sc >= 0 ? src[(size_t)(k0 + k) * ld_src + sc] : 0.f; }
  __syncthreads();
#pragma unroll
  for (int i = 0; i < 8; ++i) { const int nn = i * 8 + (tid >> 5), kk = (tid & 31) * 2; *(unsigned*)(dst + (size_t)(n0 + nn) * ld_dst + k0 + kk) = pack2(tile[kk * 65 + nn], tile[(kk + 1) * 65 + nn]); }
  __syncthreads();
}

DI void phase_norm_convert(const Params& p, int l, char* smem) {
  const int tid = otid(), lane = tid & 63, wid = __builtin_amdgcn_readfirstlane(tid >> 6);
  bf16_t* WinT = (bf16_t*)(p.ws + OFF_WIN); bf16_t* WoT = (bf16_t*)(p.ws + OFF_WO); bf16_t* WoutT = (bf16_t*)(p.ws + OFF_WOUT); bf16_t* WuT = (bf16_t*)(p.ws + OFF_WU);
  const int NI_WIN = 128 * 16, NI_WO = 3 * 16 * 8, NI_WOUT = 16 * 16, NI_WU = 16 * 2;
  const int NI_CONV = NI_WIN + NI_WO + NI_WOUT + NI_WU;
  for (int item = blockIdx.x; item < NI_CONV; item += gridDim.x) {
    int it = item;
    if (it < NI_WIN) { conv_tile(p.in[I_WIN] + (size_t)l * 1024 * 8096, 8096, WinT, 1024, (it & 15) * 64, (it >> 4) * 64, 0, 0, smem); continue; }
    it -= NI_WIN;
    if (it < NI_WO) { const int br = it / 128, r2 = it % 128; const float* src = (br == 0 ? opq(p.in[I_WOA]) : (br == 1 ? opq(p.in[I_WOB]) : opq(p.in[I_WOC]))) + (size_t)l * 512 * 1024; conv_tile(src, 1024, WoT + (size_t)br * 1024 * 512, 512, (r2 & 7) * 64, (r2 >> 3) * 64, 1, 0, smem); continue; }
    it -= NI_WO;
    if (it < NI_WOUT) { conv_tile(p.in[I_WOUT] + (size_t)l * 1024 * 1024, 1024, WoutT, 1024, (it & 15) * 64, (it >> 4) * 64, 1, 0, smem); continue; }
    it -= NI_WOUT;
    { const int nt = it >> 1, kt = it & 1; const bool uv = nt >= 8; const float* src = (uv ? opq(p.in[I_WUV]) : opq(p.in[I_WUK])) + (size_t)l * 128 * 512; conv_tile(src, 512, WuT, 128, kt * 64, nt * 64, 1, uv ? 512 : 0, smem); }
  }
  for (int item = blockIdx.x; item < NT / 4; item += gridDim.x) norm_row(p, l, item * 4 + wid, lane);
}

DI void phase_gemm1(const Params& p, int l, char* smem) {
  const bf16_t* H = (const bf16_t*)(p.ws + OFF_R1);
  const bf16_t* W = (const bf16_t*)(p.ws + OFF_WIN);
  bf16_t* U = (bf16_t*)(p.ws + OFF_U);
  bf16_t* VAT = (bf16_t*)(p.ws + OFF_VAT);
  const int NTN = 28, ntiles = 320 * NTN;
  for (int tile = blockIdx.x; tile < ntiles; tile += gridDim.x) {
    const int mt = tile / NTN, nt = tile % NTN, m0 = mt * 128, n0 = nt * 128;
    f32x16 acc[2][2]; zero_acc<2>(acc);
    gemm_mainloop<2>(acc, H + (size_t)m0 * 1024, 1024, 64, W + (size_t)n0 * 1024, 1024, 1024, smem);
    const int lane = otid() & 63, wid = __builtin_amdgcn_readfirstlane(otid() >> 6), wm = wid >> 1, wn = wid & 1, r = lane & 31, hh = lane >> 5;
    int seq, t0; row_decode(m0, seq, t0);
#pragma unroll
    for (int j = 0; j < 2; ++j) {
      const int cb = n0 + wn * 64 + j * 32;
      if (cb >= ULD) continue;
      const int col = cb + r;
      if (cb >= 640 && cb < 768) {
        const int kvh = (col - 640) >> 6, dv = col & 63, Tk = seq_tk(seq);
        bf16_t* vt = VAT + (size_t)128 * keyrow0(seq) + (size_t)(kvh * 64 + dv) * Tk;
#pragma unroll
        for (int i = 0; i < 2; ++i) {
          const int tt = t0 + wm * 64 + i * 32;
#pragma unroll
          for (int g2 = 0; g2 < 2; ++g2) {
            float v[8];
#pragma unroll
            for (int e = 0; e < 8; ++e) v[e] = acc[i][j][g2 * 8 + e];
            *(u32x4*)(vt + tt + 16 * g2 + 8 * hh) = pack8(v);
          }
          if (seq < 32) {
            float* o = p.out + OUT_AV + ((size_t)(seq * 4 + l) * 256 + tt) * 128;
            const int lo = 4 * hh * 128 + (col - 640);
#pragma unroll
            for (int e = 0; e < 16; ++e) (o + crowu(e) * 128)[lo] = acc[i][j][e];
          }
        }
      } else {
#pragma unroll
        for (int i = 0; i < 2; ++i) {
          bf16_t* up = U + (size_t)(m0 + wm * 64 + i * 32) * ULD;
          const int lo = 4 * hh * ULD + col;
#pragma unroll
          for (int e = 0; e < 16; ++e) (up + crowu(e) * ULD)[lo] = f2bf(acc[i][j][e]);
        }
      }
    }
  }
}

DI void post_row(const Params& p, int l, int row, int lane) {
  int seq, t; row_decode(row, seq, t);
  const bool lat = row >= NCTX;
  const int krow = keyrow0(seq) + t;
  const int prow = t >> 6, pcol = t & 63;
  bf16_t* u = (bf16_t*)(p.ws + OFF_U) + (size_t)row * ULD;
  const float* cs16 = (const float*)(p.ws + OFF_CS16);
  const float* cs8 = (const float*)(p.ws + OFF_CS8);
  const float LOG2E = 1.4426950408889634f;
#pragma unroll
  for (int which = 0; which < 2; ++which) {
    const int l8 = which == 0 ? lane : (lane & 15);
    const bf16_t* src = u + (which == 0 ? 0 : 512) + l8 * 8;
    float v[8]; unpack8(*(const u32x4*)src, v);
    float ss = 0.f;
#pragma unroll
    for (int i = 0; i < 8; ++i) ss += v[i] * v[i];
    ss += shx<1>(ss); ss += shx<2>(ss); ss += shx<4>(ss);
    const float rs = rsqrtf(ss * (1.0f / 64.0f) + 1e-6f);
    const float* nw = (which == 0 ? opq(p.in[I_QNW]) : opq(p.in[I_KNW])) + l * 64 + (lane & 7) * 8;
#pragma unroll
    for (int i = 0; i < 8; ++i) v[i] = v[i] * rs * nw[i];
    float pv[8];
#pragma unroll
    for (int i = 0; i < 8; ++i) pv[i] = shx<2>(v[i]);
    if (lat) {
      const int pos = ((lane & 7) >> 2) ? pcol : prow;
      const bool lower = (lane & 2) == 0;
      const float* cs = cs16 + (pos * 16 + (lane & 1) * 8) * 2;
#pragma unroll
      for (int i = 0; i < 8; ++i) { const float c = cs[i * 2], s = cs[i * 2 + 1]; v[i] = lower ? v[i] * c - pv[i] * s : v[i] * c + pv[i] * s; }
    }
    if (which == 0) {
      const float sc = 0.125f * LOG2E;
#pragma unroll
      for (int i = 0; i < 8; ++i) v[i] *= sc;
      *(u32x4*)(u + lane * 8) = pack8(v);
    } else if (lane < 16) {
      bf16_t* KA = (bf16_t*)(p.ws + OFF_KA);
      *(u32x4*)(KA + (size_t)krow * 128 + lane * 8) = pack8(v);
      if (!lat) {
        float* o = p.out + OUT_AK + ((size_t)(seq * 4 + l) * 256 + t) * 128 + lane * 8;
        *(f32x4*)o = (f32x4){v[0], v[1], v[2], v[3]}; *(f32x4*)(o + 4) = (f32x4){v[4], v[5], v[6], v[7]};
      }
    }
  }
  {
    const float sc = 0.10206207261596577f * LOG2E;
    const int hd = lane >> 3;
    bf16_t* q = u + 768 + hd * 96;
    { float v[8]; unpack8(*(const u32x4*)(q + (lane & 7) * 8), v);
#pragma unroll
      for (int i = 0; i < 8; ++i) v[i] *= sc;
      *(u32x4*)(q + (lane & 7) * 8) = pack8(v); }
    { bf16_t* qr = q + 64 + (lane & 7) * 4;
      const u32x2 w = *(const u32x2*)qr;
      float v[4] = {lo16(w.x), hi16(w.x), lo16(w.y), hi16(w.y)}, pv[4];
#pragma unroll
      for (int i = 0; i < 4; ++i) pv[i] = shx<2>(v[i]);
      if (lat) {
        const int pos = ((lane & 7) >> 2) ? pcol : prow;
        const bool lower = (lane & 2) == 0;
        const float* cs = cs8 + (pos * 8 + (lane & 1) * 4) * 2;
#pragma unroll
        for (int i = 0; i < 4; ++i) { const float c = cs[i * 2], s = cs[i * 2 + 1]; v[i] = lower ? v[i] * c - pv[i] * s : v[i] * c + pv[i] * s; }
      }
      u32x2 o; o.x = pack2(v[0] * sc, v[1] * sc); o.y = pack2(v[2] * sc, v[3] * sc);
      *(u32x2*)qr = o; }
  }
  {
    const unsigned w = *(const unsigned*)(u + 1536 + lane * 2);
    float a = lo16(w), b = hi16(w);
    float ss = a * a + b * b;
ss = wave_sum(ss);
    const float rs = rsqrtf(ss * (1.0f / 128.0f) + 1e-6f);
    const float* nw = p.in[I_KVNW] + l * 128 + lane * 2;
    a = a * rs * nw[0]; b = b * rs * nw[1];
    bf16_t* CKVN = (bf16_t*)(p.ws + OFF_R2);
    *(unsigned*)(CKVN + (size_t)krow * 128 + lane * 2) = pack2(a, b);
    if (!lat) { float* o = p.out + OUT_CKV + ((size_t)(seq * 4 + l) * 256 + t) * 128 + lane * 2; *(f32x2*)o = (f32x2){a, b}; }
  }
  {
    float v = bf2f(u[1664 + (lane & 31)]);
    const float pv = shx<8>(v);
    if (!lat) { if (lane < 32) p.out[OUT_KR + ((size_t)(seq * 4 + l) * 256 + t) * 32 + lane] = v; }
    else {
      const int d = lane & 31; const int pos = (d >> 4) ? pcol : prow; const bool lower = (d & 8) == 0;
      const float* cs = cs8 + (pos * 8 + (d & 7)) * 2;
      v = lower ? v * cs[0] - pv * cs[1] : v * cs[0] + pv * cs[1];
    }
    if (lane < 32) ((bf16_t*)(p.ws + OFF_KRB))[(size_t)krow * 32 + lane] = f2bf(v);
  }
}
DI void post_cached_row(const Params& p, int l, int idx, int lane) {
  const int b = idx >> 9, j = idx & 511;
  const int kr0 = NCTX + b * 4608, krow = kr0 + 4096 + j;
  const size_t cb = ((size_t)(b * 4 + l) * 512 + j);
  bf16_t* KA = (bf16_t*)(p.ws + OFF_KA); bf16_t* VAT = (bf16_t*)(p.ws + OFF_VAT); bf16_t* CKVN = (bf16_t*)(p.ws + OFF_R2); bf16_t* KRB = (bf16_t*)(p.ws + OFF_KRB);
  { const f32x2 v = *(const f32x2*)(p.in[I_CAK] + cb * 128 + lane * 2); *(unsigned*)(KA + (size_t)krow * 128 + lane * 2) = pack2(v.x, v.y); }
  { const f32x2 v = *(const f32x2*)(p.in[I_CAV] + cb * 128 + lane * 2);
    bf16_t* vt = VAT + (size_t)128 * kr0 + (size_t)(lane * 2) * 4608 + perm16(4096 + j);
    vt[0] = f2bf(v.x); vt[4608] = f2bf(v.y); }
  { const f32x2 v = *(const f32x2*)(p.in[I_CCKV] + cb * 128 + lane * 2); *(unsigned*)(CKVN + (size_t)krow * 128 + lane * 2) = pack2(v.x, v.y); }
  if (lane < 32) KRB[(size_t)krow * 32 + lane] = f2bf(p.in[I_CKR][cb * 32 + lane]);
}
DI void phase_post(const Params& p, int l) {
  const int lane = otid() & 63, wid = __builtin_amdgcn_readfirstlane(otid() >> 6);
  for (int item = blockIdx.x; item < NT / 4 + 1024; item += gridDim.x) {
    if (item < NT / 4) post_row(p, l, item * 4 + wid, lane);
    else post_cached_row(p, l, (item - NT / 4) * 4 + wid, lane);
  }
}

DI void phase_upproj(const Params& p, char* smem) {
  const bf16_t* A = (const bf16_t*)(p.ws + OFF_R2);
  const bf16_t* W = (const bf16_t*)(p.ws + OFF_WU);
  bf16_t* KN = (bf16_t*)(p.ws + OFF_KN); bf16_t* VBT = (bf16_t*)(p.ws + OFF_VBT);
  const int ntiles = 352 * 8;
  for (int tile = blockIdx.x; tile < ntiles; tile += gridDim.x) {
    const int mt = tile >> 3, nt = tile & 7, m0 = mt * 128, n0 = nt * 128;
    f32x16 acc[2][2]; zero_acc<2>(acc);
    gemm_mainloop<2>(acc, A + (size_t)m0 * 128, 128, 64, W + (size_t)n0 * 128, 128, 128, smem);
    const int lane = otid() & 63, wid = __builtin_amdgcn_readfirstlane(otid() >> 6), wm = wid >> 1, wn = wid & 1, r = lane & 31, hh = lane >> 5;
    int seq, t0;
    if (m0 < NCTX) { seq = m0 >> 8; t0 = m0 & 255; } else { const int rr = m0 - NCTX; seq = 32 + rr / 4608; t0 = rr % 4608; }
#pragma unroll
    for (int j = 0; j < 2; ++j) {
      const int col = n0 + wn * 64 + j * 32 + r;
      if (n0 < 512) {
#pragma unroll
        for (int i = 0; i < 2; ++i) {
          bf16_t* kp = KN + (size_t)(m0 + wm * 64 + i * 32) * 512;
          const int lo = 4 * hh * 512 + col;
#pragma unroll
          for (int e = 0; e < 16; ++e) (kp + crowu(e) * 512)[lo] = f2bf(acc[i][j][e]);
        }
      } else {
        const int Tk = seq_tk(seq);
        bf16_t* vt = VBT + (size_t)512 * keyrow0(seq) + (size_t)(col - 512) * Tk;
#pragma unroll
        for (int i = 0; i < 2; ++i) {
          const int tt = t0 + wm * 64 + i * 32;
#pragma unroll
          for (int g2 = 0; g2 < 2; ++g2) {
            float v[8];
#pragma unroll
            for (int e = 0; e < 8; ++e) v[e] = acc[i][j][g2 * 8 + e];
            *(u32x4*)(vt + tt + 16 * g2 + 8 * hh) = pack8(v);
          }
        }
      }
    }
  }
}

template <int DQK>
DI void attn_item(const bf16_t* Qw, int q_ld, const bf16_t* K1, int k1_ld, const bf16_t* K2, int k2_ld,
                  const bf16_t* Vt, int vt_ld, int nkeys, bf16_t* Ow, int o_ld, char* smem) {
  constexpr int KS = DQK * 2 + 16;
  constexpr int KBYTES = 64 * KS;
  constexpr int VS = 144;
  constexpr int VBYTES = 64 * VS;
  constexpr int STAGE = KBYTES + VBYTES;
  constexpr int CPR = DQK / 8;
  constexpr int NKC = 64 * CPR / 256;
  constexpr int NS = DQK / 16;
  const int tid = otid(), lane = tid & 63, r = lane & 31, hh = lane >> 5;
  bf16x8 qf[NS];
#pragma unroll
  for (int s = 0; s < NS; ++s) qf[s] = *(const bf16x8*)(Qw + (size_t)r * q_ld + 16 * s + 8 * hh);
  f32x16 o[2];
#pragma unroll
  for (int n = 0; n < 2; ++n)
#pragma unroll
    for (int e = 0; e < 16; ++e) o[n][e] = 0.f;
  float m_run = -1e30f, lsum = 0.f;
  u32x4 rk[NKC], rv[2];
  int krow_[NKC], kc_[NKC];
#pragma unroll
  for (int q = 0; q < NKC; ++q) { const int id = q * 256 + tid; krow_[q] = id / CPR; kc_[q] = id % CPR; }
  const int vrow = tid >> 3, vc = tid & 7;
  auto gload = [&](int key0) {
#pragma unroll
    for (int q = 0; q < NKC; ++q) {
      const bf16_t* src = (DQK == 64 || kc_[q] < 8) ? K1 + (size_t)(key0 + krow_[q]) * k1_ld + kc_[q] * 8 : K2 + (size_t)(key0 + krow_[q]) * k2_ld + (kc_[q] - 8) * 8;
      rk[q] = *(const u32x4*)src;
    }
#pragma unroll
    for (int q = 0; q < 2; ++q) rv[q] = *(const u32x4*)(Vt + (size_t)(vrow + 32 * q) * vt_ld + key0 + vc * 8);
  };
  auto lstore = [&](int buf) {
    char* base = smem + buf * STAGE;
#pragma unroll
    for (int q = 0; q < NKC; ++q) *(u32x4*)(base + krow_[q] * KS + kc_[q] * 16) = rk[q];
#pragma unroll
    for (int q = 0; q < 2; ++q) *(u32x4*)(base + KBYTES + (vrow + 32 * q) * VS + vc * 16) = rv[q];
  };
  const int ntl = nkeys >> 6;
  gload(0); lstore(0);
  if (ntl > 1) gload(64);
  __syncthreads();
  for (int tl = 0; tl < ntl; ++tl) {
    const char* base = smem + (tl & 1) * STAGE;
    bf16x8 kf[2][NS], vf[2][2][2];
#pragma unroll
    for (int kb = 0; kb < 2; ++kb)
#pragma unroll
      for (int ks = 0; ks < NS; ++ks) kf[kb][ks] = *(const bf16x8*)(base + (kb * 32 + r) * KS + (2 * ks + hh) * 16);
    f32x16 s[2];
#pragma unroll
    for (int kb = 0; kb < 2; ++kb)
#pragma unroll
      for (int e = 0; e < 16; ++e) s[kb][e] = 0.f;
#pragma unroll
    for (int ks = 0; ks < NS; ++ks)
#pragma unroll
      for (int kb = 0; kb < 2; ++kb) s[kb] = MFMA32(kf[kb][ks], qf[ks], s[kb]);
#pragma unroll
    for (int kb = 0; kb < 2; ++kb)
#pragma unroll
      for (int s2 = 0; s2 < 2; ++s2)
#pragma unroll
        for (int n = 0; n < 2; ++n) vf[kb][s2][n] = *(const bf16x8*)(base + KBYTES + (32 * n + r) * VS + (kb * 32 + 16 * s2 + 8 * hh) * 2);
    float mx = s[0][0];
#pragma unroll
    for (int kb = 0; kb < 2; ++kb)
#pragma unroll
      for (int e = 0; e < 16; ++e) mx = fmaxf(mx, s[kb][e]);
    { const unsigned u = __float_as_uint(mx); auto sw = __builtin_amdgcn_permlane32_swap(u, u, false, false); mx = fmaxf(__uint_as_float(sw[0]), __uint_as_float(sw[1])); }
    const float m_new = fmaxf(m_run, mx);
    const float alpha = __builtin_amdgcn_exp2f(m_run - m_new);
    m_run = m_new;
    float ps = 0.f;
#pragma unroll
    for (int kb = 0; kb < 2; ++kb)
#pragma unroll
      for (int e = 0; e < 16; ++e) { const float pe = __builtin_amdgcn_exp2f(s[kb][e] - m_new); s[kb][e] = pe; ps += pe; }
    lsum = lsum * alpha + ps;
#pragma unroll
    for (int n = 0; n < 2; ++n)
#pragma unroll
      for (int e = 0; e < 16; ++e) o[n][e] *= alpha;
#pragma unroll
    for (int kb = 0; kb < 2; ++kb)
#pragma unroll
      for (int s2 = 0; s2 < 2; ++s2) {
        u32x4 pw;
        pw.x = pack2(s[kb][8 * s2 + 0], s[kb][8 * s2 + 1]); pw.y = pack2(s[kb][8 * s2 + 2], s[kb][8 * s2 + 3]);
        pw.z = pack2(s[kb][8 * s2 + 4], s[kb][8 * s2 + 5]); pw.w = pack2(s[kb][8 * s2 + 6], s[kb][8 * s2 + 7]);
        const bf16x8 pf = __builtin_bit_cast(bf16x8, pw);
#pragma unroll
        for (int n = 0; n < 2; ++n) o[n] = MFMA32(vf[kb][s2][n], pf, o[n]);
      }
    if (tl + 1 < ntl) { lstore((tl + 1) & 1); if (tl + 2 < ntl) gload((tl + 2) * 64); }
    __syncthreads();
  }
  lsum = xsum32(lsum);
  const float inv = 1.0f / lsum;
#pragma unroll
  for (int n = 0; n < 2; ++n)
#pragma unroll
    for (int g = 0; g < 4; ++g) {
      u32x2 w; w.x = pack2(o[n][4 * g] * inv, o[n][4 * g + 1] * inv); w.y = pack2(o[n][4 * g + 2] * inv, o[n][4 * g + 3] * inv);
      *(u32x2*)(Ow + (size_t)r * o_ld + 32 * n + 8 * g + 4 * hh) = w;
    }
}

DI void scan_item(const Params& p, int l, int seq, int hd, int dir, int rs, char* smem) {
  const int tid = otid(), lane = tid & 63, wv = __builtin_amdgcn_readfirstlane(tid >> 6);
  const int j8 = lane & 7, r = lane & 31, hh = lane >> 5;
  const bool lat = seq >= 32;
  const int T = lat ? 4096 : 256;
  const int row0 = lat ? NCTX + (seq - 32) * 4096 : seq * 256;
  float* vA = (float*)smem; float* vK = vA + 2048; float* vR = vK + 2048; float* vV = vR + 2048; float* vW = vV + 2048; float* vB = vW + 2048; float* ybuf = vB + 2048;
  char* raw = smem + 32768;
  char* wdx = smem + 57344; char* adx = smem + 61952;
  float* tmpb = (float*)(smem + 66816);
  const bf16_t* U = (const bf16_t*)(p.ws + OFF_U);
  bf16_t* Y = (bf16_t*)(p.ws + OFF_R2) + (dir ? (size_t)NT * 512 : 0);
  float* bonus = (float*)(p.ws + OFF_BONUS);
  const int lrow = 8 * wv + (lane >> 3), irow = rs * 32 + lrow;
  f32x2 S[4];
  if (lat) {
    const float* s0 = (dir ? opq(p.in[I_SB]) : opq(p.in[I_SF])) + ((size_t)((seq - 32) * 4 + l) * 8 + hd) * 4096 + irow * 64 + j8 * 8;
#pragma unroll
    for (int q = 0; q < 2; ++q) { const f32x4 v = *(const f32x4*)(s0 + 4 * q); S[2 * q] = (f32x2){v.x, v.y}; S[2 * q + 1] = (f32x2){v.z, v.w}; }
  } else {
#pragma unroll
    for (int q = 0; q < 4; ++q) S[q] = (f32x2){0.f, 0.f};
  }
  const int mat = wv >> 1, ntc = wv & 1, cch = ntc * 32 + r, hc = hd * 64 + cch;
  bf16x8 bfrag[4];
  {
    const float* W = (mat ? opq(p.in[I_AUP]) : opq(p.in[I_WUP])) + (size_t)(l * 2 + dir) * 64 * 512 + hc;
#pragma unroll
    for (int s4 = 0; s4 < 4; ++s4) {
      float w8[8];
#pragma unroll
      for (int j = 0; j < 8; ++j) w8[j] = W[(size_t)(16 * s4 + 8 * hh + j) * 512];
      bfrag[s4] = __builtin_bit_cast(bf16x8, pack8(w8));
    }
  }
  const float bias = (mat ? opq(p.in[I_A0]) : opq(p.in[I_W0]))[(l * 2 + dir) * 512 + hc];
  const float kav = p.in[I_KA][l * 512 + hc], rkv = p.in[I_RK][l * 512 + hc];
  float* muP = (float*)(smem + 75008); float* muN = muP + 320; float* kkL = muN + 320;
  {
    const float* mup = p.in[I_MUP] + l * 1792; const float* mun = p.in[I_MUN] + l * 1792;
    for (int e = tid; e < 320; e += 256) { const int g = e >> 6, c = e & 63; const int col = (g < 3 ? g * 512 + hd * 64 : (g == 3 ? 1536 + dir * 64 : 1664 + dir * 64)) + c; muP[e] = mup[col]; muN[e] = mun[col]; }
    if (tid < 64) kkL[tid] = p.in[I_KK][l * 512 + hd * 64 + tid];
  }
  const int nch = T >> 5;
  u32x4 pre[6];
  auto prefetch = [&](int t0) {
#pragma unroll
    for (int q = 0; q < 6; ++q) {
      const int id = q * 256 + tid;
      const int row = id / 40, cc = id - row * 40, g = cc >> 3, c8 = cc & 7;
      const int t = t0 - 1 + row;
      const int col = (g < 3 ? g * 512 + hd * 64 : (g == 3 ? 1536 + dir * 64 : 1664 + dir * 64)) + c8 * 8;
      u32x4 v = (u32x4){0u, 0u, 0u, 0u};
      if (id < 1360 && t >= 0 && t < T) v = *(const u32x4*)(U + (size_t)(row0 + t) * ULD + 1696 + col);
      pre[q] = v;
    }
  };
  prefetch((dir ? nch - 1 : 0) * 32);
  for (int ci = 0; ci < nch; ++ci) {
    const int t0 = (dir ? nch - 1 - ci : ci) * 32;
#pragma unroll
    for (int q = 0; q < 6; ++q) { const int id = q * 256 + tid; if (id < 1360) *(u32x4*)(raw + id * 16) = pre[q]; }
    __syncthreads();
    if (ci + 1 < nch) prefetch((dir ? nch - 2 - ci : ci + 1) * 32);
    {
      const int tt = tid >> 3, sub = tid & 7;
#pragma unroll 1
      for (int g = 0; g < 5; ++g) {
        const int col = (g < 3 ? g * 512 + hd * 64 : (g == 3 ? 1536 + dir * 64 : 1664 + dir * 64)) + sub * 8;
        float c[8], pv[8], nx[8], x[8];
        unpack8(*(const u32x4*)(raw + (tt + 1) * 640 + (g * 8 + sub) * 16), c);
        unpack8(*(const u32x4*)(raw + tt * 640 + (g * 8 + sub) * 16), pv);
        unpack8(*(const u32x4*)(raw + (tt + 2) * 640 + (g * 8 + sub) * 16), nx);
        const f32x4 mp0 = *(const f32x4*)(muP + g * 64 + sub * 8), mp1 = *(const f32x4*)(muP + g * 64 + sub * 8 + 4), mn0 = *(const f32x4*)(muN + g * 64 + sub * 8), mn1 = *(const f32x4*)(muN + g * 64 + sub * 8 + 4);
        const float mp[8] = {mp0.x, mp0.y, mp0.z, mp0.w, mp1.x, mp1.y, mp1.z, mp1.w}, mn[8] = {mn0.x, mn0.y, mn0.z, mn0.w, mn1.x, mn1.y, mn1.z, mn1.w};
#pragma unroll
        for (int i = 0; i < 8; ++i) x[i] = c[i] + mp[i] * (pv[i] - c[i]) + mn[i] * (nx[i] - c[i]);
        const int lo = tt * 64 + sub * 8;
        if (g == 0) { *(f32x4*)(vR + lo) = (f32x4){x[0], x[1], x[2], x[3]}; *(f32x4*)(vR + lo + 4) = (f32x4){x[4], x[5], x[6], x[7]}; }
        else if (g == 1) {
          float kk[8], ss = 0.f;
          const float* kkw = kkL + sub * 8;
#pragma unroll
          for (int i = 0; i < 8; ++i) { kk[i] = x[i] * kkw[i]; ss += kk[i] * kk[i]; }
          *(f32x4*)(vK + lo) = (f32x4){x[0], x[1], x[2], x[3]}; *(f32x4*)(vK + lo + 4) = (f32x4){x[4], x[5], x[6], x[7]};
          ss += shx<1>(ss); ss += shx<2>(ss); ss += shx<4>(ss);
          const float inv = 1.0f / fmaxf(sqrtf(ss), 1e-12f);
          *(f32x4*)(vA + lo) = (f32x4){kk[0] * inv, kk[1] * inv, kk[2] * inv, kk[3] * inv}; *(f32x4*)(vA + lo + 4) = (f32x4){kk[4] * inv, kk[5] * inv, kk[6] * inv, kk[7] * inv};
        }
        else if (g == 2) { *(f32x4*)(vV + lo) = (f32x4){x[0], x[1], x[2], x[3]}; *(f32x4*)(vV + lo + 4) = (f32x4){x[4], x[5], x[6], x[7]}; }
        else if (g == 3) { float th[8]; for (int i = 0; i < 8; ++i) th[i] = tanhf(x[i]); *(u32x4*)(wdx + tt * 144 + sub * 16) = pack8(th); }
        else { *(u32x4*)(adx + tt * 144 + sub * 16) = pack8(x); }
      }
    }
    __syncthreads();
    {
      f32x16 acc;
#pragma unroll
      for (int e = 0; e < 16; ++e) acc[e] = 0.f;
      const char* xb = mat ? adx : wdx;
#pragma unroll
      for (int s4 = 0; s4 < 4; ++s4) { const bf16x8 af = *(const bf16x8*)(xb + r * 144 + (16 * s4 + 8 * hh) * 2); acc = MFMA32(af, bfrag[s4], acc); }
      if (mat == 0) {
#pragma unroll
        for (int e = 0; e < 16; ++e) vW[crow(e, hh) * 64 + cch] = __expf(-0.6065306597126334f * sigmoidf_(bias + acc[e]));
      } else {
#pragma unroll
        for (int e = 0; e < 16; ++e) {
          const int ix = crow(e, hh) * 64 + cch;
          const float ag = sigmoidf_(bias + acc[e]);
          const float kk = vA[ix], k = vK[ix], rr = vR[ix];
          const float kd = k * (1.0f + (ag - 1.0f) * kav);
          vK[ix] = kd; vA[ix] = -kk; vB[ix] = kk * ag; tmpb[ix] = rr * kd * rkv;
        }
      }
    }
    __syncthreads();
    {
      const int tt = tid >> 3, sub = tid & 7;
      const f32x4 b0 = *(const f32x4*)(tmpb + tt * 64 + sub * 8), b1 = *(const f32x4*)(tmpb + tt * 64 + sub * 8 + 4);
      float bs = (b0.x + b0.y) + (b0.z + b0.w) + (b1.x + b1.y) + (b1.z + b1.w);
      bs += shx<1>(bs); bs += shx<2>(bs); bs += shx<4>(bs);
      if (sub == 0 && rs == 0) bonus[((size_t)(row0 + t0 + tt) * 8 + hd) * 2 + dir] = bs;
    }
    {
      f32x4 va[2], vw[2], vb[2], vk[2], vr[2]; float vi;
      int tt = dir ? 31 : 0;
      int vo = tt * 64 + j8 * 8;
#pragma unroll
      for (int q = 0; q < 2; ++q) { va[q] = *(const f32x4*)(vA + vo + 4 * q); vw[q] = *(const f32x4*)(vW + vo + 4 * q); vb[q] = *(const f32x4*)(vB + vo + 4 * q); vk[q] = *(const f32x4*)(vK + vo + 4 * q); vr[q] = *(const f32x4*)(vR + vo + 4 * q); }
      vi = vV[tt * 64 + irow];
      for (int si = 0; si < 32; ++si) {
        const int ttn = dir ? (si < 31 ? 30 - si : 0) : (si < 31 ? si + 1 : 31);
        const int von = ttn * 64 + j8 * 8;
        f32x2 pa2 = S[0] * (f32x2){va[0].x, va[0].y}, pa3 = S[1] * (f32x2){va[0].z, va[0].w};
        pa2 += S[2] * (f32x2){va[1].x, va[1].y}; pa3 += S[3] * (f32x2){va[1].z, va[1].w};
#pragma unroll
        for (int q = 0; q < 2; ++q) va[q] = *(const f32x4*)(vA + von + 4 * q);
        pa2 += pa3;
        const float sa = osum(pa2.x + pa2.y);
        const f32x2 sa2 = (f32x2){sa, sa}, vi2 = (f32x2){vi, vi};
        f32x2 py2, py3;
        S[0] = S[0] * (f32x2){vw[0].x, vw[0].y} + (sa2 * (f32x2){vb[0].x, vb[0].y} + vi2 * (f32x2){vk[0].x, vk[0].y}); py2 = S[0] * (f32x2){vr[0].x, vr[0].y};
        S[1] = S[1] * (f32x2){vw[0].z, vw[0].w} + (sa2 * (f32x2){vb[0].z, vb[0].w} + vi2 * (f32x2){vk[0].z, vk[0].w}); py3 = S[1] * (f32x2){vr[0].z, vr[0].w};
        S[2] = S[2] * (f32x2){vw[1].x, vw[1].y} + (sa2 * (f32x2){vb[1].x, vb[1].y} + vi2 * (f32x2){vk[1].x, vk[1].y}); py2 += S[2] * (f32x2){vr[1].x, vr[1].y};
        S[3] = S[3] * (f32x2){vw[1].z, vw[1].w} + (sa2 * (f32x2){vb[1].z, vb[1].w} + vi2 * (f32x2){vk[1].z, vk[1].w}); py3 += S[3] * (f32x2){vr[1].z, vr[1].w};
#pragma unroll
        for (int q = 0; q < 2; ++q) { vw[q] = *(const f32x4*)(vW + von + 4 * q); vb[q] = *(const f32x4*)(vB + von + 4 * q); vk[q] = *(const f32x4*)(vK + von + 4 * q); vr[q] = *(const f32x4*)(vR + von + 4 * q); }
        vi = vV[ttn * 64 + irow];
        py2 += py3;
        const float py = osum(py2.x + py2.y);
        if (j8 == 0) ybuf[tt * 32 + lrow] = py;
        tt = ttn;
      }
    }
    __syncthreads();
    {
      const int tt = tid >> 3, sub = tid & 7;
      const f32x4 y0 = *(const f32x4*)(ybuf + tt * 32 + sub * 4);
      u32x2 w; w.x = pack2(y0.x, y0.y); w.y = pack2(y0.z, y0.w);
      *(u32x2*)(Y + (size_t)(row0 + t0 + tt) * 512 + hd * 64 + rs * 32 + sub * 4) = w;
    }
    __syncthreads();
  }
  if (!lat) {
    float* o = opq(p.out) + (dir ? OUT_SB : OUT_SF) + ((size_t)(seq * 4 + l) * 8 + hd) * 4096 + irow * 64 + j8 * 8;
#pragma unroll
    for (int q = 0; q < 2; ++q) *(f32x4*)(o + 4 * q) = (f32x4){S[2 * q].x, S[2 * q].y, S[2 * q + 1].x, S[2 * q + 1].y};
  }
}

DI void phase_mixers(const Params& p, int l, char* smem, int part = 0) {
  const int tid = otid(), wid = __builtin_amdgcn_readfirstlane(tid >> 6);
  unsigned* cnt = (unsigned*)(p.ws + OFF_CNT) + l + 4 * part;
  int* slot = (int*)(smem + SMEM_BYTES - 16);
  bf16_t* U = (bf16_t*)(p.ws + OFF_U);
  const bf16_t* KA = (const bf16_t*)(p.ws + OFF_KA); const bf16_t* VAT = (const bf16_t*)(p.ws + OFF_VAT);
  const bf16_t* KN = (const bf16_t*)(p.ws + OFF_KN); const bf16_t* VBT = (const bf16_t*)(p.ws + OFF_VBT); const bf16_t* KRB = (const bf16_t*)(p.ws + OFF_KRB);
  const int NITEMS = 256 + 4096 + 2048;
  bool first = true;
  for (;;) {
    int item;
    if (first && part == 0 && blockIdx.x < 256) { item = blockIdx.x; }
    else {
      if (tid == 0) *slot = (int)atomicAdd(cnt, 1u) + (part == 0 ? 256 : 0);
      __syncthreads();
      item = __builtin_amdgcn_readfirstlane(*slot);
      __syncthreads();
    }
    first = false;
    if (item >= NITEMS) break;
#ifdef PROBE_SPLIT
    { const bool isscan = item < 256 || (item >= 256 + 4096 && item < 256 + 4096 + 1024); if ((part != 1) != isscan) continue; }
#endif
    int kind, seq, a, qt;
    if (item < 256) { kind = 0; seq = 32 + (item >> 5); a = (item >> 2) & 7; qt = item & 3; }
    else if (item < 256 + 2048) { const int k = item - 256; kind = 1; seq = 32 + (k >> 8); a = (k >> 7) & 1; qt = k & 127; }
    else if (item < 256 + 4096) { const int k = item - 256 - 2048; kind = 2; seq = 32 + (k >> 8); a = (k >> 5) & 7; qt = k & 31; }
    else if (item < 256 + 4096 + 1024) { const int k = item - 256 - 4096; kind = 0; seq = k >> 5; a = (k >> 2) & 7; qt = k & 3; }
    else if (item < 256 + 4096 + 1536) { const int k = item - 256 - 4096 - 1024; kind = 1; seq = k >> 4; a = (k >> 3) & 1; qt = k & 7; }
    else { const int k = item - 256 - 4096 - 1536; kind = 2; seq = k >> 4; a = (k >> 1) & 7; qt = k & 1; }
    const int kr0 = keyrow0(seq), Tk = seq_tk(seq);
    const int row0 = seq < 32 ? seq * 256 : NCTX + (seq - 32) * 4096;
    if (kind == 0) scan_item(p, l, seq, a, qt & 1, qt >> 1, smem);
    else if (kind == 1) {
      const int qh = a * 4 + wid;
      bf16_t* q = U + (size_t)(row0 + qt * 32) * ULD + qh * 64;
      attn_item<64>(q, ULD, KA + (size_t)kr0 * 128 + a * 64, 128, nullptr, 0, VAT + (size_t)128 * kr0 + (size_t)(a * 64) * Tk, Tk, Tk, q, ULD, smem);
    } else {
      bf16_t* q = U + (size_t)(row0 + qt * 128 + wid * 32) * ULD + 768 + a * 96;
      attn_item<96>(q, ULD, KN + (size_t)kr0 * 512 + a * 64, 512, KRB + (size_t)kr0 * 32, 32, VBT + (size_t)512 * kr0 + (size_t)(a * 64) * Tk, Tk, Tk, q, ULD, smem);
    }
  }
}

DI void cpost_row(const Params& p, int l, int row, int lane) {
  int seq, t; row_decode(row, seq, t);
  const int T = seq < 32 ? 256 : 4096;
  const bf16_t* YF = (const bf16_t*)(p.ws + OFF_R2); const bf16_t* YB = YF + (size_t)NT * 512;
  bf16_t* u = (bf16_t*)(p.ws + OFF_U) + (size_t)row * ULD + 1696;
  const float* bonus = (const float*)(p.ws + OFF_BONUS);
  float yf[8], yb[8], y[8];
  unpack8(*(const u32x4*)(YF + (size_t)row * 512 + lane * 8), yf);
  unpack8(*(const u32x4*)(YB + (size_t)row * 512 + lane * 8), yb);
  float s = 0.f;
#pragma unroll
  for (int i = 0; i < 8; ++i) { y[i] = yf[i] + yb[i]; s += y[i]; }
  s += shx<1>(s); s += shx<2>(s); s += shx<4>(s);
  const float mu = s * (1.0f / 64.0f);
  float q = 0.f;
#pragma unroll
  for (int i = 0; i < 8; ++i) { y[i] -= mu; q += y[i] * y[i]; }
  q += shx<1>(q); q += shx<2>(q); q += shx<4>(q);
  const float rs = rsqrtf(q * (1.0f / 64.0f) + 64e-5f);
  const int col = 1024 + lane * 8;
  float c[8], pv[8], nx[8];
  unpack8(*(const u32x4*)(u + col), c);
  if (t > 0) unpack8(*(const u32x4*)(u - ULD + col), pv); else { for (int i = 0; i < 8; ++i) pv[i] = 0.f; }
  if (t < T - 1) unpack8(*(const u32x4*)(u + ULD + col), nx); else { for (int i = 0; i < 8; ++i) nx[i] = 0.f; }
  const float* mup = p.in[I_MUP] + l * 1792 + col; const float* mun = p.in[I_MUN] + l * 1792 + col;
  const float* lw = p.in[I_LNW] + l * 512 + lane * 8; const float* lb = p.in[I_LNB] + l * 512 + lane * 8;
  const f32x2 bsv = *(const f32x2*)(bonus + ((size_t)row * 8 + (lane >> 3)) * 2);
  const float bs = bsv.x + bsv.y;
  float o[8];
#pragma unroll
  for (int i = 0; i < 8; ++i) { const float v = c[i] + mup[i] * (pv[i] - c[i]) + mun[i] * (nx[i] - c[i]); o[i] = y[i] * rs * lw[i] + lb[i] + bs * v; }
  *(u32x4*)(u + lane * 8) = pack8(o);
}
DI void phase_renorm_cpost(const Params& p, int l) {
  const int lane = otid() & 63, wid = __builtin_amdgcn_readfirstlane(otid() >> 6);
  for (int item = blockIdx.x; item < NT / 4; item += gridDim.x) { const int row = item * 4 + wid; norm_row(p, l, row, lane); cpost_row(p, l, row, lane); }
}

DI void phase_zgemm(const Params& p, char* smem) {
  const bf16_t* H = (const bf16_t*)(p.ws + OFF_R1);
  const bf16_t* W = (const bf16_t*)(p.ws + OFF_WIN) + (size_t)3584 * 1024;
  bf16_t* U = (bf16_t*)(p.ws + OFF_U);
  const int ntiles = 320 * 12;
  for (int tile = blockIdx.x; tile < ntiles; tile += gridDim.x) {
    const int mt = tile / 12, nt = tile % 12, m0 = mt * 128, n0 = nt * 128;
    f32x16 acc[2][2]; zero_acc<2>(acc);
    gemm_mainloop<2>(acc, H + (size_t)m0 * 1024, 1024, 64, W + (size_t)n0 * 1024, 1024, 1024, smem);
    const int lane = otid() & 63, wid = __builtin_amdgcn_readfirstlane(otid() >> 6), wm = wid >> 1, wn = wid & 1, r = lane & 31, hh = lane >> 5;
#pragma unroll
    for (int j = 0; j < 2; ++j) {
      const int col = n0 + wn * 64 + j * 32 + r;
      const int br = col >> 9, cc = col & 511;
      const int ucol = br == 0 ? cc : (br == 1 ? 768 + (cc >> 6) * 96 + (cc & 63) : 1696 + cc);
#pragma unroll
      for (int i = 0; i < 2; ++i) {
        bf16_t* up = U + (size_t)(m0 + wm * 64 + i * 32) * ULD;
        const int lo = 4 * hh * ULD + ucol;
        bf16_t yv[16];
#pragma unroll
        for (int e = 0; e < 16; ++e) yv[e] = (up + crowu(e) * ULD)[lo];
#pragma unroll
        for (int e = 0; e < 16; ++e) (up + crowu(e) * ULD)[lo] = f2bf(bf2f(yv[e]) * siluf_(acc[i][j][e]));
      }
    }
  }
}

DI void phase_merge(const Params& p, char* smem) {
  const bf16_t* H = (const bf16_t*)(p.ws + OFF_R1);
  const bf16_t* WG = (const bf16_t*)(p.ws + OFF_WIN) + (size_t)5120 * 1024;
  const bf16_t* WO = (const bf16_t*)(p.ws + OFF_WO);
  const bf16_t* U = (const bf16_t*)(p.ws + OFF_U);
  bf16_t* MX = (bf16_t*)(p.ws + OFF_R2);
  const int ntiles = 320 * 16;
  for (int tile = blockIdx.x; tile < ntiles; tile += gridDim.x) {
    const int mt = tile >> 4, nt = tile & 15, m0 = mt * 128, n0 = nt * 64;
    f32x16 mix[2][1]; zero_acc<1>(mix);
    f32x16 gs[2][1]; zero_acc<1>(gs);
#pragma unroll 1
    for (int step = 0; step < 6; ++step) {
      const int br = step >> 1, isT = step & 1;
      const int acol = br == 0 ? 0 : (br == 1 ? 768 : 1696);
      const bf16_t* Ap = isT ? U + (size_t)m0 * ULD + acol : H + (size_t)m0 * 1024;
      const bf16_t* Bp = isT ? WO + (size_t)(br * 1024 + n0) * 512 : WG + (size_t)(br * 1024 + n0) * 1024;
      f32x16 cur[2][1]; zero_acc<1>(cur);
      gemm_mainloop<1>(cur, Ap, isT ? ULD : 1024, (isT && br == 1) ? 96 : 64, Bp, isT ? 512 : 1024, isT ? 512 : 1024, smem);
      if (isT) {
#pragma unroll
        for (int i = 0; i < 2; ++i)
#pragma unroll
          for (int e = 0; e < 16; ++e) mix[i][0][e] += gs[i][0][e] * cur[i][0][e];
      } else {
#pragma unroll
        for (int i = 0; i < 2; ++i)
#pragma unroll
          for (int e = 0; e < 16; ++e) gs[i][0][e] = sigmoidf_(cur[i][0][e]);
      }
    }
    const int lane = otid() & 63, wid = __builtin_amdgcn_readfirstlane(otid() >> 6), wm = wid >> 1, wn = wid & 1, r = lane & 31, hh = lane >> 5;
    const int col = n0 + wn * 32 + r;
#pragma unroll
    for (int i = 0; i < 2; ++i) {
      bf16_t* mp = MX + (size_t)(m0 + wm * 64 + i * 32) * 1024;
      const int lo = 4 * hh * 1024 + col;
#pragma unroll
      for (int e = 0; e < 16; ++e) (mp + crowu(e) * 1024)[lo] = f2bf(mix[i][0][e]);
    }
  }
}

DI void phase_out(const Params& p, int l, char* smem) {
  const bf16_t* MX = (const bf16_t*)(p.ws + OFF_R2);
  const bf16_t* W = (const bf16_t*)(p.ws + OFF_WOUT);
  const int ntiles = 320 * 8;
  for (int tile = blockIdx.x; tile < ntiles; tile += gridDim.x) {
    const int mt = tile >> 3, nt = tile & 7, m0 = mt * 128, n0 = nt * 128;
    f32x16 acc[2][2]; zero_acc<2>(acc);
    gemm_mainloop<2>(acc, MX + (size_t)m0 * 1024, 1024, 64, W + (size_t)n0 * 1024, 1024, 1024, smem);
    const int lane = otid() & 63, wid = __builtin_amdgcn_readfirstlane(otid() >> 6), wm = wid >> 1, wn = wid & 1, r = lane & 31, hh = lane >> 5;
    const int jm = m0 < NCTX ? 0 : 1 + ((m0 - NCTX) >> 12);
    const float* gate = (const float*)(p.ws + OFF_MOD) + ((size_t)l * 9 + jm) * MODLD + 2048;
    const float* xsrc = x_row_ptr(p, l, m0);
#pragma unroll
    for (int j = 0; j < 2; ++j) {
      const int col = n0 + wn * 64 + j * 32 + r;
      const float gv = gate[col];
      const int lo = 4 * hh * 1024 + col;
#pragma unroll
      for (int i = 0; i < 2; ++i) {
        const float* xs = xsrc + (size_t)(wm * 64 + i * 32) * 1024;
        float* xo = p.out + (size_t)(m0 + wm * 64 + i * 32) * 1024;
        float xv[16];
#pragma unroll
        for (int e = 0; e < 16; ++e) xv[e] = (xs + crowu(e) * 1024)[lo];
#pragma unroll
        for (int e = 0; e < 16; ++e) (xo + crowu(e) * 1024)[lo] = xv[e] + gv * acc[i][j][e];
      }
    }
  }
}

DI void phase_final(const Params& p) {
  const int lane = otid() & 63, wid = __builtin_amdgcn_readfirstlane(otid() >> 6);
  const float* nw = p.in[I_FNW];
  for (int item = blockIdx.x; item < NT / 4; item += gridDim.x) {
    float* x = p.out + (size_t)(item * 4 + wid) * 1024;
    f32x4 v[4]; float ss = 0.f;
#pragma unroll
    for (int i = 0; i < 4; ++i) { v[i] = *(const f32x4*)(x + lane * 4 + 256 * i); ss += v[i].x * v[i].x + v[i].y * v[i].y + v[i].z * v[i].z + v[i].w * v[i].w; }
ss = wave_sum(ss);
    const float rs = rsqrtf(ss * (1.0f / 1024.0f) + 1e-6f);
#pragma unroll
    for (int i = 0; i < 4; ++i) { const f32x4 w = *(const f32x4*)(nw + lane * 4 + 256 * i); *(f32x4*)(x + lane * 4 + 256 * i) = (f32x4){v[i].x * rs * w.x, v[i].y * rs * w.y, v[i].z * rs * w.z, v[i].w * rs * w.w}; }
  }
}

constexpr int NPHASES = 1 + 4 * 9 + 1;
__global__ void __launch_bounds__(256, 2) fwd_kernel(Params p0) {
  __shared__ __attribute__((aligned(16))) char smem[SMEM_BYTES];
  cg::grid_group grid = cg::this_grid();
  const int ph_begin = p0.ph_begin, ph_end = p0.ph_end;
  for (int ph = ph_begin; ph < ph_end; ++ph) {
    auto kp = __builtin_amdgcn_kernarg_segment_ptr();
    asm volatile("" : "+s"(kp));
    typedef const __attribute__((address_space(4))) Params CParams;
    CParams* kpp = (CParams*)kp;
    Params p;
#pragma unroll
    for (int i = 0; i < 35; ++i) p.in[i] = kpp->in[i];
    p.out = kpp->out; p.ws = kpp->ws; p.ph_begin = ph_begin; p.ph_end = ph_end;
    if (ph == 0) phase_prologue(p, smem);
    else if (ph == NPHASES - 1) phase_final(p);
    else {
      const int l = (ph - 1) / 9, sp = (ph - 1) % 9;
#ifdef PROBE_SP
      if (sp == PROBE_SP) {
        switch (sp) {
          case 0: phase_norm_convert(p, l, smem); break;
          case 1: phase_gemm1(p, l, smem); break;
          case 3: phase_upproj(p, smem); break;
          case 5: phase_renorm_cpost(p, l); break;
          case 7: phase_merge(p, smem); break;
          default: break;
        }
        grid.sync();
      }
#endif
      switch (sp) {
        case 0: phase_norm_convert(p, l, smem); break;
        case 1: phase_gemm1(p, l, smem); break;
        case 2: phase_post(p, l); break;
        case 3: phase_upproj(p, smem); break;
#ifdef PROBE_SPLIT
        case 4:
#if PROBE_SPLIT == 2
                phase_mixers(p, l, smem, 2); grid.sync();
#endif
                phase_mixers(p, l, smem, 0); grid.sync();
                phase_mixers(p, l, smem, 1); break;
#else
        case 4: phase_mixers(p, l, smem); break;
#endif
        case 5: phase_renorm_cpost(p, l); break;
        case 6: phase_zgemm(p, smem); break;
        case 7: phase_merge(p, smem); break;
        default: phase_out(p, l, smem); break;
      }
    }
    if (ph + 1 < ph_end) grid.sync();
  }
}

extern "C" void kernel_launch(void* const* d_in, const int* in_sizes, int n_in, void* d_out, int out_size, void* d_ws, size_t ws_size, hipStream_t stream) {
  if (ws_size < WS_NEED || n_in < 35) { fprintf(stderr, "workspace too small: %zu < %zu\n", ws_size, WS_NEED); return; }
  static int grid_blocks = 0;
  if (!grid_blocks) {
    int dev = 0, cus = 0, per_cu = 0;
    hipGetDevice(&dev);
    hipDeviceGetAttribute(&cus, hipDeviceAttributeMultiprocessorCount, dev);
    hipOccupancyMaxActiveBlocksPerMultiprocessor(&per_cu, fwd_kernel, 256, 0);
    if (per_cu < 1) per_cu = 1;
    if (per_cu > 2) per_cu = 2;
    grid_blocks = cus * per_cu;
  }
  Params p{};
  for (int i = 0; i < 35; ++i) p.in[i] = (const float*)d_in[i];
  p.out = (float*)d_out; p.ws = (char*)d_ws;
#ifndef ONE_LAUNCH
  for (int ph = 0; ph < NPHASES; ++ph) {
    p.ph_begin = ph; p.ph_end = ph + 1;
    hipLaunchKernelGGL(fwd_kernel, dim3(grid_blocks), dim3(256), 0, stream, p);
  }
#else
  p.ph_begin = 0; p.ph_end = NPHASES;
  void* args[] = {&p};
  hipError_t e = hipLaunchCooperativeKernel((void*)fwd_kernel, dim3(grid_blocks), dim3(256), args, 0, stream);
  if (e != hipSuccess) fprintf(stderr, "cooperative launch failed: %s (grid %d)\n", hipGetErrorString(e), grid_blocks);
#endif
}
```

```cpp
#define ONE_LAUNCH 1
#include <hip/hip_runtime.h>
#include <hip/hip_cooperative_groups.h>
#include <stdint.h>
#include <stdio.h>
namespace cg = cooperative_groups;

typedef unsigned short bf16_t;
typedef short bf16x8 __attribute__((ext_vector_type(8)));
typedef float f32x16 __attribute__((ext_vector_type(16)));
typedef float f32x4 __attribute__((ext_vector_type(4)));
typedef float f32x2 __attribute__((ext_vector_type(2)));
typedef unsigned u32x4 __attribute__((ext_vector_type(4)));
typedef unsigned u32x2 __attribute__((ext_vector_type(2)));
#define DI __device__ __forceinline__
#define MFMA32(a, b, c) __builtin_amdgcn_mfma_f32_32x32x16_bf16((a), (b), (c), 0, 0, 0)

constexpr int NT = 40960;
constexpr int NCTX = 8192;
constexpr int NK = 45056;
constexpr int ULD = 3488;
constexpr int MODLD = 3072;
constexpr int SMEM_BYTES = 78848;

constexpr size_t OFF_WIN = 0;
constexpr size_t OFF_WO = 16777216;
constexpr size_t OFF_WOUT = 19922944;
constexpr size_t OFF_WU = 22020096;
constexpr size_t OFF_MOD = 22282240;
constexpr size_t OFF_BONUS = 22724608;
constexpr size_t OFF_CS16 = 25346048;
constexpr size_t OFF_CS8 = 25354240;
constexpr size_t OFF_CNT = 25358336;
constexpr size_t OFF_U = 25358592;
constexpr size_t OFF_R1 = 311095552;
constexpr size_t OFF_KA = OFF_R1;
constexpr size_t OFF_VAT = 513208576;
constexpr size_t OFF_KN = OFF_R1 + 23068672;
constexpr size_t OFF_VBT = OFF_R1 + 69206016;
constexpr size_t OFF_KRB = OFF_R1 + 115343360;
constexpr size_t OFF_R2 = 429322496;
constexpr size_t WS_NEED = 524742912;

constexpr size_t OUT_AK = 41943040, OUT_AV = 46137344, OUT_CKV = 50331648, OUT_KR = 54525952, OUT_SF = 55574528, OUT_SB = 59768832;

struct Params {
  const float* in[35];
  float* out;
  char* ws;
  int ph_begin, ph_end;
};

enum { I_XP = 0, I_XS, I_CAK, I_CAV, I_CCKV, I_CKR, I_SF, I_SB, I_C, I_CCTX, I_NORMW, I_WMOD, I_BMOD, I_WIN, I_QNW, I_KNW, I_KVNW,
       I_WUK, I_WUV, I_MUP, I_MUN, I_W0, I_WUP, I_A0, I_AUP, I_KK, I_KA, I_RK, I_LNW, I_LNB, I_WOA, I_WOB, I_WOC, I_WOUT, I_FNW };

DI int threadIdx_x_raw() { return __builtin_amdgcn_workitem_id_x(); }
DI int otid() { int t = threadIdx_x_raw(); asm volatile("" : "+v"(t)); return t; }
DI const float* opq(const float* q) { asm volatile("" : "+s"(q)); return q; }
DI float* opq(float* q) { asm volatile("" : "+s"(q)); return q; }
DI float bf2f(bf16_t v) { return __uint_as_float(((unsigned)v) << 16); }
typedef __bf16 hbf16x2 __attribute__((ext_vector_type(2)));
DI unsigned pack2(float a, float b) { f32x2 v = {a, b}; hbf16x2 r = __builtin_convertvector(v, hbf16x2); return __builtin_bit_cast(unsigned, r); }
DI bf16_t f2bf(float x) { return (bf16_t)(pack2(x, 0.f) & 0xffffu); }
DI float xsum16(float x) { const unsigned u = __float_as_uint(x); auto r = __builtin_amdgcn_permlane16_swap(u, u, false, false); return __uint_as_float(r[0]) + __uint_as_float(r[1]); }
DI float xsum32(float x) { const unsigned u = __float_as_uint(x); auto r = __builtin_amdgcn_permlane32_swap(u, u, false, false); return __uint_as_float(r[0]) + __uint_as_float(r[1]); }
DI float lo16(unsigned w) { return __uint_as_float(w << 16); }
DI float hi16(unsigned w) { return __uint_as_float(w & 0xffff0000u); }
DI void unpack8(u32x4 w, float* v) { v[0] = lo16(w.x); v[1] = hi16(w.x); v[2] = lo16(w.y); v[3] = hi16(w.y); v[4] = lo16(w.z); v[5] = hi16(w.z); v[6] = lo16(w.w); v[7] = hi16(w.w); }
DI u32x4 pack8(const float* v) { u32x4 w; w.x = pack2(v[0], v[1]); w.y = pack2(v[2], v[3]); w.z = pack2(v[4], v[5]); w.w = pack2(v[6], v[7]); return w; }
template <int K> DI float shx(float v) { return __int_as_float(__builtin_amdgcn_ds_swizzle(__float_as_int(v), 0x1f | (K << 10))); }
DI float wave_sum(float v) { v += shx<1>(v); v += shx<2>(v); v += shx<4>(v); v += shx<8>(v); v += shx<16>(v); return xsum32(v); }
DI float qsum(float v) {
  v += __int_as_float(__builtin_amdgcn_update_dpp(0, __float_as_int(v), 0xB1, 0xf, 0xf, true));
  v += __int_as_float(__builtin_amdgcn_update_dpp(0, __float_as_int(v), 0x4E, 0xf, 0xf, true));
  return v;
}
DI float osum(float v) {
  v = qsum(v);
  v += __int_as_float(__builtin_amdgcn_update_dpp(0, __float_as_int(v), 0x141, 0xf, 0xf, true));
  return v;
}
DI int crow(int reg, int h) { return (reg & 3) + 8 * (reg >> 2) + 4 * h; }
DI int crowu(int reg) { return (reg & 3) + 8 * (reg >> 2); }
DI int perm16(int t) { return (t & ~12) | ((t & 4) << 1) | ((t & 8) >> 1); }
DI float sigmoidf_(float x) { return 1.0f / (1.0f + __expf(-x)); }
DI float siluf_(float x) { return x / (1.0f + __expf(-x)); }

DI void row_decode(int row, int& seq, int& t) {
  if (row < NCTX) { seq = row >> 8; t = row & 255; } else { seq = 32 + ((row - NCTX) >> 12); t = (row - NCTX) & 4095; }
}
DI int keyrow0(int seq) { return seq < 32 ? seq * 256 : NCTX + (seq - 32) * 4608; }
DI int seq_tk(int seq) { return seq < 32 ? 256 : 4608; }

template <int NJ>
DI void gemm_mainloop(f32x16 (&acc)[2][NJ], const bf16_t* __restrict__ A, int lda, int ks,
                      const bf16_t* __restrict__ Bt, int ldb, int K, char* smem) {
  constexpr int A_BYTES = 128 * 128;
  constexpr int B_BYTES = 64 * NJ * 128;
  constexpr int STAGE = A_BYTES + B_BYTES;
  const int tid = otid(), lane = tid & 63, wid = __builtin_amdgcn_readfirstlane(tid >> 6), wm = wid >> 1, wn = wid & 1;
  const int r = lane & 31, hh = lane >> 5;
  const int nk = K >> 6;
  const int lrow = tid >> 3, lc = tid & 7;
  u32x4 ra[4], rb[2 * NJ];
  const bf16_t* ap = A + (size_t)lrow * lda + lc * 8;
  const bf16_t* bp = Bt + (size_t)lrow * ldb + lc * 8;
#pragma unroll
  for (int p = 0; p < 4; ++p) ra[p] = *(const u32x4*)(ap + (size_t)(32 * p) * lda);
#pragma unroll
  for (int p = 0; p < 2 * NJ; ++p) rb[p] = *(const u32x4*)(bp + (size_t)(32 * p) * ldb);
  {
    char* base = smem;
#pragma unroll
    for (int p = 0; p < 4; ++p) { const int row = lrow + 32 * p; *(u32x4*)(base + row * 128 + ((lc ^ ((row >> 1) & 7)) << 4)) = ra[p]; }
#pragma unroll
    for (int p = 0; p < 2 * NJ; ++p) { const int row = lrow + 32 * p; *(u32x4*)(base + A_BYTES + row * 128 + ((lc ^ ((row >> 1) & 7)) << 4)) = rb[p]; }
  }
  if (nk > 1) {
    const bf16_t* ap2 = ap + (size_t)ks;
    const bf16_t* bp2 = bp + (size_t)64;
#pragma unroll
    for (int p = 0; p < 4; ++p) ra[p] = *(const u32x4*)(ap2 + (size_t)(32 * p) * lda);
#pragma unroll
    for (int p = 0; p < 2 * NJ; ++p) rb[p] = *(const u32x4*)(bp2 + (size_t)(32 * p) * ldb);
  }
  __syncthreads();
  for (int kt = 0; kt < nk; ++kt) {
    const char* base = smem + (kt & 1) * STAGE;
#pragma unroll
    for (int s = 0; s < 4; ++s) {
      bf16x8 af[2], bfr[NJ];
#pragma unroll
      for (int i = 0; i < 2; ++i) { const int row = wm * 64 + i * 32 + r; af[i] = *(const bf16x8*)(base + row * 128 + (((2 * s + hh) ^ ((row >> 1) & 7)) << 4)); }
#pragma unroll
      for (int j = 0; j < NJ; ++j) { const int row = wn * (32 * NJ) + j * 32 + r; bfr[j] = *(const bf16x8*)(base + A_BYTES + row * 128 + (((2 * s + hh) ^ ((row >> 1) & 7)) << 4)); }
#pragma unroll
      for (int i = 0; i < 2; ++i)
#pragma unroll
        for (int j = 0; j < NJ; ++j) acc[i][j] = MFMA32(af[i], bfr[j], acc[i][j]);
    }
    if (kt + 1 < nk) {
      char* nb = smem + ((kt + 1) & 1) * STAGE;
#pragma unroll
      for (int p = 0; p < 4; ++p) { const int row = lrow + 32 * p; *(u32x4*)(nb + row * 128 + ((lc ^ ((row >> 1) & 7)) << 4)) = ra[p]; }
#pragma unroll
      for (int p = 0; p < 2 * NJ; ++p) { const int row = lrow + 32 * p; *(u32x4*)(nb + A_BYTES + row * 128 + ((lc ^ ((row >> 1) & 7)) << 4)) = rb[p]; }
      if (kt + 2 < nk) {
        const bf16_t* ap2 = ap + (size_t)(kt + 2) * ks;
        const bf16_t* bp2 = bp + (size_t)(kt + 2) * 64;
#pragma unroll
        for (int p = 0; p < 4; ++p) ra[p] = *(const u32x4*)(ap2 + (size_t)(32 * p) * lda);
#pragma unroll
        for (int p = 0; p < 2 * NJ; ++p) rb[p] = *(const u32x4*)(bp2 + (size_t)(32 * p) * ldb);
      }
    }
    __syncthreads();
  }
}

template <int NJ> DI void zero_acc(f32x16 (&acc)[2][NJ]) {
#pragma unroll
  for (int i = 0; i < 2; ++i)
#pragma unroll
    for (int j = 0; j < NJ; ++j)
#pragma unroll
      for (int e = 0; e < 16; ++e) acc[i][j][e] = 0.f;
}

DI void phase_prologue(const Params& p, char* smem) {
  const int tid = otid(), lane = tid & 63, wid = __builtin_amdgcn_readfirstlane(tid >> 6);
  float* mod = (float*)(p.ws + OFF_MOD);
  if (blockIdx.x == 0) {
    if (tid < 64) ((unsigned*)(p.ws + OFF_CNT))[tid] = 0u;
    float* cs16 = (float*)(p.ws + OFF_CS16);
    float* cs8 = (float*)(p.ws + OFF_CS8);
    for (int e = tid; e < 64 * 16; e += 256) { const int pos = e >> 4, i = e & 15; const float inv = expf(-9.210340371976184f * (float)i / 16.0f); const float a = (float)pos * inv; cs16[e * 2] = cosf(a); cs16[e * 2 + 1] = sinf(a); }
    for (int e = tid; e < 64 * 8; e += 256) { const int pos = e >> 3, i = e & 7; const float inv = expf(-9.210340371976184f * (float)i / 8.0f); const float a = (float)pos * inv; cs8[e * 2] = cosf(a); cs8[e * 2 + 1] = sinf(a); }
  }
  float* sl = (float*)smem;
  float* red = sl + 9 * 1024;
  for (int e = tid; e < 9 * 1024; e += 256) { const int j = e >> 10, k = e & 1023; const float* cc0 = opq(p.in[I_CCTX]); const float* cc1 = opq(p.in[I_C]); const float c = j == 0 ? cc0[k] : cc1[(j - 1) * 1024 + k]; sl[e] = siluf_(c); }
  __syncthreads();
  for (int item = blockIdx.x; item < 192; item += gridDim.x) {
    const int l = item / 48, n = (item % 48) * 64 + lane;
    const float* w = p.in[I_WMOD] + (size_t)l * 1024 * 3072 + n;
    float a[9];
#pragma unroll
    for (int j = 0; j < 9; ++j) a[j] = 0.f;
    for (int k = wid * 256; k < wid * 256 + 256; ++k) {
      const float wv = w[(size_t)k * 3072];
#pragma unroll
      for (int j = 0; j < 9; ++j) a[j] += sl[j * 1024 + k] * wv;
    }
#pragma unroll
    for (int j = 0; j < 9; ++j) red[(wid * 9 + j) * 64 + lane] = a[j];
    __syncthreads();
    for (int e = tid; e < 9 * 64; e += 256) {
      const int j = e >> 6, c = e & 63;
      const float s = red[(0 * 9 + j) * 64 + c] + red[(1 * 9 + j) * 64 + c] + red[(2 * 9 + j) * 64 + c] + red[(3 * 9 + j) * 64 + c];
      const int nn = (item % 48) * 64 + c;
      mod[((size_t)l * 9 + j) * MODLD + nn] = s + p.in[I_BMOD][l * 3072 + nn];
    }
    __syncthreads();
  }
}

DI const float* x_row_ptr(const Params& p, int l, int row) {
  const float* xp = opq(p.in[I_XP]); const float* xs = opq(p.in[I_XS]); const float* xo = opq((const float*)p.out);
  if (l == 0) return row < NCTX ? xp + (size_t)row * 1024 : xs + (size_t)(row - NCTX) * 1024;
  return xo + (size_t)row * 1024;
}
DI void norm_row(const Params& p, int l, int row, int lane) {
  const float* x = x_row_ptr(p, l, row);
  const int j = row < NCTX ? 0 : 1 + ((row - NCTX) >> 12);
  const float* mod = (const float*)(p.ws + OFF_MOD) + ((size_t)l * 9 + j) * MODLD;
  const float* nw = p.in[I_NORMW] + l * 1024;
  bf16_t* h = (bf16_t*)(p.ws + OFF_R1) + (size_t)row * 1024;
  f32x4 v[4]; float ss = 0.f;
#pragma unroll
  for (int i = 0; i < 4; ++i) { v[i] = *(const f32x4*)(x + lane * 4 + 256 * i); ss += v[i].x * v[i].x + v[i].y * v[i].y + v[i].z * v[i].z + v[i].w * v[i].w; }
ss = wave_sum(ss);
  const float rs = rsqrtf(ss * (1.0f / 1024.0f) + 1e-6f);
#pragma unroll
  for (int i = 0; i < 4; ++i) {
    const int c = lane * 4 + 256 * i;
    const f32x4 w = *(const f32x4*)(nw + c), sh = *(const f32x4*)(mod + c), sc = *(const f32x4*)(mod + 1024 + c);
    u32x2 o;
    o.x = pack2(v[i].x * rs * w.x * (1.f + sc.x) + sh.x, v[i].y * rs * w.y * (1.f + sc.y) + sh.y);
    o.y = pack2(v[i].z * rs * w.z * (1.f + sc.z) + sh.z, v[i].w * rs * w.w * (1.f + sc.w) + sh.w);
    *(u32x2*)(h + c) = o;
  }
}

DI int win_srccol(int j) {
  if (j < 768) return j;
  if (j < 1696) return j + 512;
  if (j < 3488) return j + 1024;
  if (j < 3584) return -1;
  if (j < 5120) { const int jj = j - 3584; return jj < 512 ? 768 + jj : (jj < 1024 ? 2208 + (jj - 512) : 4512 + (jj - 1024)); }
  return 5024 + (j - 5120);
}
DI void conv_tile(const float* __restrict__ src, int ld_src, bf16_t* dst, int ld_dst, int k0, int n0, int kind, int srcoff, char* smem) {
  float* tile = (float*)smem;
  const int tid = otid();
  const int n = tid & 63;
  int sc = kind == 0 ? win_srccol(n0 + n) : (n0 + n - srcoff);
#pragma unroll
  for (int i = 0; i < 16; ++i) { const int k = i * 4 + (tid >> 6); tile[k * 65 + n] = sc >= 0 ? src[(size_t)(k0 + k) * ld_src + sc] : 0.f; }
  __syncthreads();
#pragma unroll
  for (int i = 0; i < 8; ++i) { const int nn = i * 8 + (tid >> 5), kk = (tid & 31) * 2; *(unsigned*)(dst + (size_t)(n0 + nn) * ld_dst + k0 + kk) = pack2(tile[kk * 65 + nn], tile[(kk + 1) * 65 + nn]); }
  __syncthreads();
}

DI void phase_norm_convert(const Params& p, int l, char* smem) {
  const int tid = otid(), lane = tid & 63, wid = __builtin_amdgcn_readfirstlane(tid >> 6);
  bf16_t* WinT = (bf16_t*)(p.ws + OFF_WIN); bf16_t* WoT = (bf16_t*)(p.ws + OFF_WO); bf16_t* WoutT = (bf16_t*)(p.ws + OFF_WOUT); bf16_t* WuT = (bf16_t*)(p.ws + OFF_WU);
  const int NI_WIN = 128 * 16, NI_WO = 3 * 16 * 8, NI_WOUT = 16 * 16, NI_WU = 16 * 2;
  const int NI_CONV = NI_WIN + NI_WO + NI_WOUT + NI_WU;
  for (int item = blockIdx.x; item < NI_CONV; item += gridDim.x) {
    int it = item;
    if (it < NI_WIN) { conv_tile(p.in[I_WIN] + (size_t)l * 1024 * 8096, 8096, WinT, 1024, (it & 15) * 64, (it >> 4) * 64, 0, 0, smem); continue; }
    it -= NI_WIN;
    if (it < NI_WO) { const int br = it / 128, r2 = it % 128; const float* src = (br == 0 ? opq(p.in[I_WOA]) : (br == 1 ? opq(p.in[I_WOB]) : opq(p.in[I_WOC]))) + (size_t)l * 512 * 1024; conv_tile(src, 1024, WoT + (size_t)br * 1024 * 512, 512, (r2 & 7) * 64, (r2 >> 3) * 64, 1, 0, smem); continue; }
    it -= NI_WO;
    if (it < NI_WOUT) { conv_tile(p.in[I_WOUT] + (size_t)l * 1024 * 1024, 1024, WoutT, 1024, (it & 15) * 64, (it >> 4) * 64, 1, 0, smem); continue; }
    it -= NI_WOUT;
    { const int nt = it >> 1, kt = it & 1; const bool uv = nt >= 8; const float* src = (uv ? opq(p.in[I_WUV]) : opq(p.in[I_WUK])) + (size_t)l * 128 * 512; conv_tile(src, 512, WuT, 128, kt * 64, nt * 64, 1, uv ? 512 : 0, smem); }
  }
  for (int item = blockIdx.x; item < NT / 4; item += gridDim.x) norm_row(p, l, item * 4 + wid, lane);
}

DI void phase_gemm1(const Params& p, int l, char* smem) {
  const bf16_t* H = (const bf16_t*)(p.ws + OFF_R1);
  const bf16_t* W = (const bf16_t*)(p.ws + OFF_WIN);
  bf16_t* U = (bf16_t*)(p.ws + OFF_U);
  bf16_t* VAT = (bf16_t*)(p.ws + OFF_VAT);
  const int NTN = 28, ntiles = 320 * NTN;
  for (int tile = blockIdx.x; tile < ntiles; tile += gridDim.x) {
    const int mt = tile / NTN, nt = tile % NTN, m0 = mt * 128, n0 = nt * 128;
    f32x16 acc[2][2]; zero_acc<2>(acc);
    gemm_mainloop<2>(acc, H + (size_t)m0 * 1024, 1024, 64, W + (size_t)n0 * 1024, 1024, 1024, smem);
    const int lane = otid() & 63, wid = __builtin_amdgcn_readfirstlane(otid() >> 6), wm = wid >> 1, wn = wid & 1, r = lane & 31, hh = lane >> 5;
    int seq, t0; row_decode(m0, seq, t0);
#pragma unroll
    for (int j = 0; j < 2; ++j) {
      const int cb = n0 + wn * 64 + j * 32;
      if (cb >= ULD) continue;
      const int col = cb + r;
      if (cb >= 640 && cb < 768) {
        const int kvh = (col - 640) >> 6, dv = col & 63, Tk = seq_tk(seq);
        bf16_t* vt = VAT + (size_t)128 * keyrow0(seq) + (size_t)(kvh * 64 + dv) * Tk;
#pragma unroll
        for (int i = 0; i < 2; ++i) {
          const int tt = t0 + wm * 64 + i * 32;
#pragma unroll
          for (int g2 = 0; g2 < 2; ++g2) {
            float v[8];
#pragma unroll
            for (int e = 0; e < 8; ++e) v[e] = acc[i][j][g2 * 8 + e];
            *(u32x4*)(vt + tt + 16 * g2 + 8 * hh) = pack8(v);
          }
          if (seq < 32) {
            float* o = p.out + OUT_AV + ((size_t)(seq * 4 + l) * 256 + tt) * 128;
            const int lo = 4 * hh * 128 + (col - 640);
#pragma unroll
            for (int e = 0; e < 16; ++e) (o + crowu(e) * 128)[lo] = acc[i][j][e];
          }
        }
      } else {
#pragma unroll
        for (int i = 0; i < 2; ++i) {
          bf16_t* up = U + (size_t)(m0 + wm * 64 + i * 32) * ULD;
          const int lo = 4 * hh * ULD + col;
#pragma unroll
          for (int e = 0; e < 16; ++e) (up + crowu(e) * ULD)[lo] = f2bf(acc[i][j][e]);
        }
      }
    }
  }
}

DI void post_row(const Params& p, int l, int row, int lane) {
  int seq, t; row_decode(row, seq, t);
  const bool lat = row >= NCTX;
  const int krow = keyrow0(seq) + t;
  const int prow = t >> 6, pcol = t & 63;
  bf16_t* u = (bf16_t*)(p.ws + OFF_U) + (size_t)row * ULD;
  const float* cs16 = (const float*)(p.ws + OFF_CS16);
  const float* cs8 = (const float*)(p.ws + OFF_CS8);
  const float LOG2E = 1.4426950408889634f;
#pragma unroll
  for (int which = 0; which < 2; ++which) {
    const int l8 = which == 0 ? lane : (lane & 15);
    const bf16_t* src = u + (which == 0 ? 0 : 512) + l8 * 8;
    float v[8]; unpack8(*(const u32x4*)src, v);
    float ss = 0.f;
#pragma unroll
    for (int i = 0; i < 8; ++i) ss += v[i] * v[i];
    ss += shx<1>(ss); ss += shx<2>(ss); ss += shx<4>(ss);
    const float rs = rsqrtf(ss * (1.0f / 64.0f) + 1e-6f);
    const float* nw = (which == 0 ? opq(p.in[I_QNW]) : opq(p.in[I_KNW])) + l * 64 + (lane & 7) * 8;
#pragma unroll
    for (int i = 0; i < 8; ++i) v[i] = v[i] * rs * nw[i];
    float pv[8];
#pragma unroll
    for (int i = 0; i < 8; ++i) pv[i] = shx<2>(v[i]);
    if (lat) {
      const int pos = ((lane & 7) >> 2) ? pcol : prow;
      const bool lower = (lane & 2) == 0;
      const float* cs = cs16 + (pos * 16 + (lane & 1) * 8) * 2;
#pragma unroll
      for (int i = 0; i < 8; ++i) { const float c = cs[i * 2], s = cs[i * 2 + 1]; v[i] = lower ? v[i] * c - pv[i] * s : v[i] * c + pv[i] * s; }
    }
    if (which == 0) {
      const float sc = 0.125f * LOG2E;
#pragma unroll
      for (int i = 0; i < 8; ++i) v[i] *= sc;
      *(u32x4*)(u + lane * 8) = pack8(v);
    } else if (lane < 16) {
      bf16_t* KA = (bf16_t*)(p.ws + OFF_KA);
      *(u32x4*)(KA + (size_t)krow * 128 + lane * 8) = pack8(v);
      if (!lat) {
        float* o = p.out + OUT_AK + ((size_t)(seq * 4 + l) * 256 + t) * 128 + lane * 8;
        *(f32x4*)o = (f32x4){v[0], v[1], v[2], v[3]}; *(f32x4*)(o + 4) = (f32x4){v[4], v[5], v[6], v[7]};
      }
    }
  }
  {
    const float sc = 0.10206207261596577f * LOG2E;
    const int hd = lane >> 3;
    bf16_t* q = u + 768 + hd * 96;
    { float v[8]; unpack8(*(const u32x4*)(q + (lane & 7) * 8), v);
#pragma unroll
      for (int i = 0; i < 8; ++i) v[i] *= sc;
      *(u32x4*)(q + (lane & 7) * 8) = pack8(v); }
    { bf16_t* qr = q + 64 + (lane & 7) * 4;
      const u32x2 w = *(const u32x2*)qr;
      float v[4] = {lo16(w.x), hi16(w.x), lo16(w.y), hi16(w.y)}, pv[4];
#pragma unroll
      for (int i = 0; i < 4; ++i) pv[i] = shx<2>(v[i]);
      if (lat) {
        const int pos = ((lane & 7) >> 2) ? pcol : prow;
        const bool lower = (lane & 2) == 0;
        const float* cs = cs8 + (pos * 8 + (lane & 1) * 4) * 2;
#pragma unroll
        for (int i = 0; i < 4; ++i) { const float c = cs[i * 2], s = cs[i * 2 + 1]; v[i] = lower ? v[i] * c - pv[i] * s : v[i] * c + pv[i] * s; }
      }
      u32x2 o; o.x = pack2(v[0] * sc, v[1] * sc); o.y = pack2(v[2] * sc, v[3] * sc);
      *(u32x2*)qr = o; }
  }
  {
    const unsigned w = *(const unsigned*)(u + 1536 + lane * 2);
    float a = lo16(w), b = hi16(w);
    float ss = a * a + b * b;
ss = wave_sum(ss);
    const float rs = rsqrtf(ss * (1.0f / 128.0f) + 1e-6f);
    const float* nw = p.in[I_KVNW] + l * 128 + lane * 2;
    a = a * rs * nw[0]; b = b * rs * nw[1];
    bf16_t* CKVN = (bf16_t*)(p.ws + OFF_R2);
    *(unsigned*)(CKVN + (size_t)krow * 128 + lane * 2) = pack2(a, b);
    if (!lat) { float* o = p.out + OUT_CKV + ((size_t)(seq * 4 + l) * 256 + t) * 128 + lane * 2; *(f32x2*)o = (f32x2){a, b}; }
  }
  {
    float v = bf2f(u[1664 + (lane & 31)]);
    const float pv = shx<8>(v);
    if (!lat) { if (lane < 32) p.out[OUT_KR + ((size_t)(seq * 4 + l) * 256 + t) * 32 + lane] = v; }
    else {
      const int d = lane & 31; const int pos = (d >> 4) ? pcol : prow; const bool lower = (d & 8) == 0;
      const float* cs = cs8 + (pos * 8 + (d & 7)) * 2;
      v = lower ? v * cs[0] - pv * cs[1] : v * cs[0] + pv * cs[1];
    }
    if (lane < 32) ((bf16_t*)(p.ws + OFF_KRB))[(size_t)krow * 32 + lane] = f2bf(v);
  }
}
DI void post_cached_row(const Params& p, int l, int idx, int lane) {
  const int b = idx >> 9, j = idx & 511;
  const int kr0 = NCTX + b * 4608, krow = kr0 + 4096 + j;
  const size_t cb = ((size_t)(b * 4 + l) * 512 + j);
  bf16_t* KA = (bf16_t*)(p.ws + OFF_KA); bf16_t* VAT = (bf16_t*)(p.ws + OFF_VAT); bf16_t* CKVN = (bf16_t*)(p.ws + OFF_R2); bf16_t* KRB = (bf16_t*)(p.ws + OFF_KRB);
  { const f32x2 v = *(const f32x2*)(p.in[I_CAK] + cb * 128 + lane * 2); *(unsigned*)(KA + (size_t)krow * 128 + lane * 2) = pack2(v.x, v.y); }
  { const f32x2 v = *(const f32x2*)(p.in[I_CAV] + cb * 128 + lane * 2);
    bf16_t* vt = VAT + (size_t)128 * kr0 + (size_t)(lane * 2) * 4608 + perm16(4096 + j);
    vt[0] = f2bf(v.x); vt[4608] = f2bf(v.y); }
  { const f32x2 v = *(const f32x2*)(p.in[I_CCKV] + cb * 128 + lane * 2); *(unsigned*)(CKVN + (size_t)krow * 128 + lane * 2) = pack2(v.x, v.y); }
  if (lane < 32) KRB[(size_t)krow * 32 + lane] = f2bf(p.in[I_CKR][cb * 32 + lane]);
}
DI void phase_post(const Params& p, int l) {
  const int lane = otid() & 63, wid = __builtin_amdgcn_readfirstlane(otid() >> 6);
  for (int item = blockIdx.x; item < NT / 4 + 1024; item += gridDim.x) {
    if (item < NT / 4) post_row(p, l, item * 4 + wid, lane);
    else post_cached_row(p, l, (item - NT / 4) * 4 + wid, lane);
  }
}

DI void phase_upproj(const Params& p, char* smem) {
  const bf16_t* A = (const bf16_t*)(p.ws + OFF_R2);
  const bf16_t* W = (const bf16_t*)(p.ws + OFF_WU);
  bf16_t* KN = (bf16_t*)(p.ws + OFF_KN); bf16_t* VBT = (bf16_t*)(p.ws + OFF_VBT);
  const int ntiles = 352 * 8;
  for (int tile = blockIdx.x; tile < ntiles; tile += gridDim.x) {
    const int mt = tile >> 3, nt = tile & 7, m0 = mt * 128, n0 = nt * 128;
    f32x16 acc[2][2]; zero_acc<2>(acc);
    gemm_mainloop<2>(acc, A + (size_t)m0 * 128, 128, 64, W + (size_t)n0 * 128, 128, 128, smem);
    const int lane = otid() & 63, wid = __builtin_amdgcn_readfirstlane(otid() >> 6), wm = wid >> 1, wn = wid & 1, r = lane & 31, hh = lane >> 5;
    int seq, t0;
    if (m0 < NCTX) { seq = m0 >> 8; t0 = m0 & 255; } else { const int rr = m0 - NCTX; seq = 32 + rr / 4608; t0 = rr % 4608; }
#pragma unroll
    for (int j = 0; j < 2; ++j) {
      const int col = n0 + wn * 64 + j * 32 + r;
      if (n0 < 512) {
#pragma unroll
        for (int i = 0; i < 2; ++i) {
          bf16_t* kp = KN + (size_t)(m0 + wm * 64 + i * 32) * 512;
          const int lo = 4 * hh * 512 + col;
#pragma unroll
          for (int e = 0; e < 16; ++e) (kp + crowu(e) * 512)[lo] = f2bf(acc[i][j][e]);
        }
      } else {
        const int Tk = seq_tk(seq);
        bf16_t* vt = VBT + (size_t)512 * keyrow0(seq) + (size_t)(col - 512) * Tk;
#pragma unroll
        for (int i = 0; i < 2; ++i) {
          const int tt = t0 + wm * 64 + i * 32;
#pragma unroll
          for (int g2 = 0; g2 < 2; ++g2) {
            float v[8];
#pragma unroll
            for (int e = 0; e < 8; ++e) v[e] = acc[i][j][g2 * 8 + e];
            *(u32x4*)(vt + tt + 16 * g2 + 8 * hh) = pack8(v);
          }
        }
      }
    }
  }
}

template <int DQK>
DI void attn_item(const bf16_t* Qw, int q_ld, const bf16_t* K1, int k1_ld, const bf16_t* K2, int k2_ld,
                  const bf16_t* Vt, int vt_ld, int nkeys, bf16_t* Ow, int o_ld, char* smem) {
  constexpr int KS = DQK * 2 + 16;
  constexpr int KBYTES = 64 * KS;
  constexpr int VS = 144;
  constexpr int VBYTES = 64 * VS;
  constexpr int STAGE = KBYTES + VBYTES;
  constexpr int CPR = DQK / 8;
  constexpr int NKC = 64 * CPR / 256;
  constexpr int NS = DQK / 16;
  const int tid = otid(), lane = tid & 63, r = lane & 31, hh = lane >> 5;
  bf16x8 qf[NS];
#pragma unroll
  for (int s = 0; s < NS; ++s) qf[s] = *(const bf16x8*)(Qw + (size_t)r * q_ld + 16 * s + 8 * hh);
  f32x16 o[2];
#pragma unroll
  for (int n = 0; n < 2; ++n)
#pragma unroll
    for (int e = 0; e < 16; ++e) o[n][e] = 0.f;
  float m_run = -1e30f, lsum = 0.f;
  u32x4 rk[NKC], rv[2];
  int krow_[NKC], kc_[NKC];
#pragma unroll
  for (int q = 0; q < NKC; ++q) { const int id = q * 256 + tid; krow_[q] = id / CPR; kc_[q] = id % CPR; }
  const int vrow = tid >> 3, vc = tid & 7;
  auto gload = [&](int key0) {
#pragma unroll
    for (int q = 0; q < NKC; ++q) {
      const bf16_t* src = (DQK == 64 || kc_[q] < 8) ? K1 + (size_t)(key0 + krow_[q]) * k1_ld + kc_[q] * 8 : K2 + (size_t)(key0 + krow_[q]) * k2_ld + (kc_[q] - 8) * 8;
      rk[q] = *(const u32x4*)src;
    }
#pragma unroll
    for (int q = 0; q < 2; ++q) rv[q] = *(const u32x4*)(Vt + (size_t)(vrow + 32 * q) * vt_ld + key0 + vc * 8);
  };
  auto lstore = [&](int buf) {
    char* base = smem + buf * STAGE;
#pragma unroll
    for (int q = 0; q < NKC; ++q) *(u32x4*)(base + krow_[q] * KS + kc_[q] * 16) = rk[q];
#pragma unroll
    for (int q = 0; q < 2; ++q) *(u32x4*)(base + KBYTES + (vrow + 32 * q) * VS + vc * 16) = rv[q];
  };
  const int ntl = nkeys >> 6;
  gload(0); lstore(0);
  if (ntl > 1) gload(64);
  __syncthreads();
  for (int tl = 0; tl < ntl; ++tl) {
    const char* base = smem + (tl & 1) * STAGE;
    bf16x8 kf[2][NS], vf[2][2][2];
#pragma unroll
    for (int kb = 0; kb < 2; ++kb)
#pragma unroll
      for (int ks = 0; ks < NS; ++ks) kf[kb][ks] = *(const bf16x8*)(base + (kb * 32 + r) * KS + (2 * ks + hh) * 16);
    __builtin_amdgcn_sched_barrier(0);
    f32x16 s[2];
#pragma unroll
    for (int kb = 0; kb < 2; ++kb)
#pragma unroll
      for (int e = 0; e < 16; ++e) s[kb][e] = 0.f;
#pragma unroll
    for (int ks = 0; ks < NS; ++ks)
#pragma unroll
      for (int kb = 0; kb < 2; ++kb) s[kb] = MFMA32(kf[kb][ks], qf[ks], s[kb]);
#pragma unroll
    for (int kb = 0; kb < 2; ++kb)
#pragma unroll
      for (int s2 = 0; s2 < 2; ++s2)
#pragma unroll
        for (int n = 0; n < 2; ++n) vf[kb][s2][n] = *(const bf16x8*)(base + KBYTES + (32 * n + r) * VS + (kb * 32 + 16 * s2 + 8 * hh) * 2);
    __builtin_amdgcn_sched_barrier(0);
    float mx = s[0][0];
#pragma unroll
    for (int kb = 0; kb < 2; ++kb)
#pragma unroll
      for (int e = 0; e < 16; ++e) mx = fmaxf(mx, s[kb][e]);
    { const unsigned u = __float_as_uint(mx); auto sw = __builtin_amdgcn_permlane32_swap(u, u, false, false); mx = fmaxf(__uint_as_float(sw[0]), __uint_as_float(sw[1])); }
    const float m_new = fmaxf(m_run, mx);
    const float alpha = __builtin_amdgcn_exp2f(m_run - m_new);
    m_run = m_new;
    float ps = 0.f;
#pragma unroll
    for (int kb = 0; kb < 2; ++kb)
#pragma unroll
      for (int e = 0; e < 16; ++e) { const float pe = __builtin_amdgcn_exp2f(s[kb][e] - m_new); s[kb][e] = pe; ps += pe; }
    lsum = lsum * alpha + ps;
    if (__builtin_amdgcn_ballot_w64(alpha != 1.0f) != 0ull) {
#pragma unroll
      for (int n = 0; n < 2; ++n)
#pragma unroll
        for (int e = 0; e < 16; ++e) o[n][e] *= alpha;
    }
#pragma unroll
    for (int kb = 0; kb < 2; ++kb)
#pragma unroll
      for (int s2 = 0; s2 < 2; ++s2) {
        u32x4 pw;
        pw.x = pack2(s[kb][8 * s2 + 0], s[kb][8 * s2 + 1]); pw.y = pack2(s[kb][8 * s2 + 2], s[kb][8 * s2 + 3]);
        pw.z = pack2(s[kb][8 * s2 + 4], s[kb][8 * s2 + 5]); pw.w = pack2(s[kb][8 * s2 + 6], s[kb][8 * s2 + 7]);
        const bf16x8 pf = __builtin_bit_cast(bf16x8, pw);
#pragma unroll
        for (int n = 0; n < 2; ++n) o[n] = MFMA32(vf[kb][s2][n], pf, o[n]);
      }
    if (tl + 1 < ntl) { lstore((tl + 1) & 1); if (tl + 2 < ntl) gload((tl + 2) * 64); }
    __syncthreads();
  }
  lsum = xsum32(lsum);
  const float inv = 1.0f / lsum;
#pragma unroll
  for (int n = 0; n < 2; ++n)
#pragma unroll
    for (int g = 0; g < 4; ++g) {
      u32x2 w; w.x = pack2(o[n][4 * g] * inv, o[n][4 * g + 1] * inv); w.y = pack2(o[n][4 * g + 2] * inv, o[n][4 * g + 3] * inv);
      *(u32x2*)(Ow + (size_t)r * o_ld + 32 * n + 8 * g + 4 * hh) = w;
    }
}

DI void scan_item(const Params& p, int l, int seq, int hd, int dir, int rs, char* smem) {
  const int tid = otid(), lane = tid & 63, wv = __builtin_amdgcn_readfirstlane(tid >> 6);
  const int j8 = lane & 7, r = lane & 31, hh = lane >> 5;
  const bool lat = seq >= 32;
  const int T = lat ? 4096 : 256;
  const int row0 = lat ? NCTX + (seq - 32) * 4096 : seq * 256;
  float* vA = (float*)smem; float* vK = vA + 2048; float* vR = vK + 2048; float* vV = vR + 2048; float* vW = vV + 2048; float* vB = vW + 2048; float* ybuf = vB + 2048;
  char* raw = smem + 32768;
  char* wdx = smem + 57344; char* adx = smem + 61952;
  float* tmpb = (float*)(smem + 66816);
  const bf16_t* U = (const bf16_t*)(p.ws + OFF_U);
  bf16_t* Y = (bf16_t*)(p.ws + OFF_R2) + (dir ? (size_t)NT * 512 : 0);
  float* bonus = (float*)(p.ws + OFF_BONUS);
  const int lrow = 8 * wv + (lane >> 3), irow = rs * 32 + lrow;
  f32x2 S[4];
  if (lat) {
    const float* s0 = (dir ? opq(p.in[I_SB]) : opq(p.in[I_SF])) + ((size_t)((seq - 32) * 4 + l) * 8 + hd) * 4096 + irow * 64 + j8 * 8;
#pragma unroll
    for (int q = 0; q < 2; ++q) { const f32x4 v = *(const f32x4*)(s0 + 4 * q); S[2 * q] = (f32x2){v.x, v.y}; S[2 * q + 1] = (f32x2){v.z, v.w}; }
  } else {
#pragma unroll
    for (int q = 0; q < 4; ++q) S[q] = (f32x2){0.f, 0.f};
  }
  const int mat = wv >> 1, ntc = wv & 1, cch = ntc * 32 + r, hc = hd * 64 + cch;
  bf16x8 bfrag[4];
  {
    const float* W = (mat ? opq(p.in[I_AUP]) : opq(p.in[I_WUP])) + (size_t)(l * 2 + dir) * 64 * 512 + hc;
#pragma unroll
    for (int s4 = 0; s4 < 4; ++s4) {
      float w8[8];
#pragma unroll
      for (int j = 0; j < 8; ++j) w8[j] = W[(size_t)(16 * s4 + 8 * hh + j) * 512];
      bfrag[s4] = __builtin_bit_cast(bf16x8, pack8(w8));
    }
  }
  const float bias = (mat ? opq(p.in[I_A0]) : opq(p.in[I_W0]))[(l * 2 + dir) * 512 + hc];
  const float kav = p.in[I_KA][l * 512 + hc], rkv = p.in[I_RK][l * 512 + hc];
  float* muP = (float*)(smem + 75008); float* muN = muP + 320; float* kkL = muN + 320;
  {
    const float* mup = p.in[I_MUP] + l * 1792; const float* mun = p.in[I_MUN] + l * 1792;
    for (int e = tid; e < 320; e += 256) { const int g = e >> 6, c = e & 63; const int col = (g < 3 ? g * 512 + hd * 64 : (g == 3 ? 1536 + dir * 64 : 1664 + dir * 64)) + c; muP[e] = mup[col]; muN[e] = mun[col]; }
    if (tid < 64) kkL[tid] = p.in[I_KK][l * 512 + hd * 64 + tid];
  }
  const int nch = T >> 5;
  u32x4 pre[6];
  auto prefetch = [&](int t0) {
#pragma unroll
    for (int q = 0; q < 6; ++q) {
      const int id = q * 256 + tid;
      const int row = id / 40, cc = id - row * 40, g = cc >> 3, c8 = cc & 7;
      const int t = t0 - 1 + row;
      const int col = (g < 3 ? g * 512 + hd * 64 : (g == 3 ? 1536 + dir * 64 : 1664 + dir * 64)) + c8 * 8;
      u32x4 v = (u32x4){0u, 0u, 0u, 0u};
      if (id < 1360 && t >= 0 && t < T) v = *(const u32x4*)(U + (size_t)(row0 + t) * ULD + 1696 + col);
      pre[q] = v;
    }
  };
  prefetch((dir ? nch - 1 : 0) * 32);
  for (int ci = 0; ci < nch; ++ci) {
    const int t0 = (dir ? nch - 1 - ci : ci) * 32;
#pragma unroll
    for (int q = 0; q < 6; ++q) { const int id = q * 256 + tid; if (id < 1360) *(u32x4*)(raw + id * 16) = pre[q]; }
    __syncthreads();
    if (ci + 1 < nch) prefetch((dir ? nch - 2 - ci : ci + 1) * 32);
    {
      const int tt = tid >> 3, sub = tid & 7;
#pragma unroll 1
      for (int g = 0; g < 5; ++g) {
        const int col = (g < 3 ? g * 512 + hd * 64 : (g == 3 ? 1536 + dir * 64 : 1664 + dir * 64)) + sub * 8;
        float c[8], pv[8], nx[8], x[8];
        unpack8(*(const u32x4*)(raw + (tt + 1) * 640 + (g * 8 + sub) * 16), c);
        unpack8(*(const u32x4*)(raw + tt * 640 + (g * 8 + sub) * 16), pv);
        unpack8(*(const u32x4*)(raw + (tt + 2) * 640 + (g * 8 + sub) * 16), nx);
        const f32x4 mp0 = *(const f32x4*)(muP + g * 64 + sub * 8), mp1 = *(const f32x4*)(muP + g * 64 + sub * 8 + 4), mn0 = *(const f32x4*)(muN + g * 64 + sub * 8), mn1 = *(const f32x4*)(muN + g * 64 + sub * 8 + 4);
        const float mp[8] = {mp0.x, mp0.y, mp0.z, mp0.w, mp1.x, mp1.y, mp1.z, mp1.w}, mn[8] = {mn0.x, mn0.y, mn0.z, mn0.w, mn1.x, mn1.y, mn1.z, mn1.w};
#pragma unroll
        for (int i = 0; i < 8; ++i) x[i] = c[i] + mp[i] * (pv[i] - c[i]) + mn[i] * (nx[i] - c[i]);
        const int lo = tt * 64 + sub * 8;
        if (g == 0) { *(f32x4*)(vR + lo) = (f32x4){x[0], x[1], x[2], x[3]}; *(f32x4*)(vR + lo + 4) = (f32x4){x[4], x[5], x[6], x[7]}; }
        else if (g == 1) {
          float kk[8], ss = 0.f;
          const float* kkw = kkL + sub * 8;
#pragma unroll
          for (int i = 0; i < 8; ++i) { kk[i] = x[i] * kkw[i]; ss += kk[i] * kk[i]; }
          *(f32x4*)(vK + lo) = (f32x4){x[0], x[1], x[2], x[3]}; *(f32x4*)(vK + lo + 4) = (f32x4){x[4], x[5], x[6], x[7]};
          ss += shx<1>(ss); ss += shx<2>(ss); ss += shx<4>(ss);
          const float inv = 1.0f / fmaxf(sqrtf(ss), 1e-12f);
          *(f32x4*)(vA + lo) = (f32x4){kk[0] * inv, kk[1] * inv, kk[2] * inv, kk[3] * inv}; *(f32x4*)(vA + lo + 4) = (f32x4){kk[4] * inv, kk[5] * inv, kk[6] * inv, kk[7] * inv};
        }
        else if (g == 2) { *(f32x4*)(vV + lo) = (f32x4){x[0], x[1], x[2], x[3]}; *(f32x4*)(vV + lo + 4) = (f32x4){x[4], x[5], x[6], x[7]}; }
        else if (g == 3) { float th[8]; for (int i = 0; i < 8; ++i) th[i] = tanhf(x[i]); *(u32x4*)(wdx + tt * 144 + sub * 16) = pack8(th); }
        else { *(u32x4*)(adx + tt * 144 + sub * 16) = pack8(x); }
      }
    }
    __syncthreads();
    {
      f32x16 acc;
#pragma unroll
      for (int e = 0; e < 16; ++e) acc[e] = 0.f;
      const char* xb = mat ? adx : wdx;
#pragma unroll
      for (int s4 = 0; s4 < 4; ++s4) { const bf16x8 af = *(const bf16x8*)(xb + r * 144 + (16 * s4 + 8 * hh) * 2); acc = MFMA32(af, bfrag[s4], acc); }
      if (mat == 0) {
#pragma unroll
        for (int e = 0; e < 16; ++e) vW[crow(e, hh) * 64 + cch] = __expf(-0.6065306597126334f * sigmoidf_(bias + acc[e]));
      } else {
#pragma unroll
        for (int e = 0; e < 16; ++e) {
          const int ix = crow(e, hh) * 64 + cch;
          const float ag = sigmoidf_(bias + acc[e]);
          const float kk = vA[ix], k = vK[ix], rr = vR[ix];
          const float kd = k * (1.0f + (ag - 1.0f) * kav);
          vK[ix] = kd; vA[ix] = -kk; vB[ix] = kk * ag; tmpb[ix] = rr * kd * rkv;
        }
      }
    }
    __syncthreads();
    {
      const int tt = tid >> 3, sub = tid & 7;
      const f32x4 b0 = *(const f32x4*)(tmpb + tt * 64 + sub * 8), b1 = *(const f32x4*)(tmpb + tt * 64 + sub * 8 + 4);
      float bs = (b0.x + b0.y) + (b0.z + b0.w) + (b1.x + b1.y) + (b1.z + b1.w);
      bs += shx<1>(bs); bs += shx<2>(bs); bs += shx<4>(bs);
      if (sub == 0 && rs == 0) bonus[((size_t)(row0 + t0 + tt) * 8 + hd) * 2 + dir] = bs;
    }
    {
      f32x4 va[2], vw[2], vb[2], vk[2], vr[2]; float vi;
      int tt = dir ? 31 : 0;
      int vo = tt * 64 + j8 * 8;
#pragma unroll
      for (int q = 0; q < 2; ++q) { va[q] = *(const f32x4*)(vA + vo + 4 * q); vw[q] = *(const f32x4*)(vW + vo + 4 * q); vb[q] = *(const f32x4*)(vB + vo + 4 * q); vk[q] = *(const f32x4*)(vK + vo + 4 * q); vr[q] = *(const f32x4*)(vR + vo + 4 * q); }
      vi = vV[tt * 64 + irow];
      for (int si = 0; si < 32; ++si) {
        const int ttn = dir ? (si < 31 ? 30 - si : 0) : (si < 31 ? si + 1 : 31);
        const int von = ttn * 64 + j8 * 8;
        f32x2 pa2 = S[0] * (f32x2){va[0].x, va[0].y}, pa3 = S[1] * (f32x2){va[0].z, va[0].w};
        pa2 += S[2] * (f32x2){va[1].x, va[1].y}; pa3 += S[3] * (f32x2){va[1].z, va[1].w};
#pragma unroll
        for (int q = 0; q < 2; ++q) va[q] = *(const f32x4*)(vA + von + 4 * q);
        pa2 += pa3;
        const float sa = osum(pa2.x + pa2.y);
        const f32x2 sa2 = (f32x2){sa, sa}, vi2 = (f32x2){vi, vi};
        f32x2 py2, py3;
        S[0] = S[0] * (f32x2){vw[0].x, vw[0].y} + (sa2 * (f32x2){vb[0].x, vb[0].y} + vi2 * (f32x2){vk[0].x, vk[0].y}); py2 = S[0] * (f32x2){vr[0].x, vr[0].y};
        S[1] = S[1] * (f32x2){vw[0].z, vw[0].w} + (sa2 * (f32x2){vb[0].z, vb[0].w} + vi2 * (f32x2){vk[0].z, vk[0].w}); py3 = S[1] * (f32x2){vr[0].z, vr[0].w};
        S[2] = S[2] * (f32x2){vw[1].x, vw[1].y} + (sa2 * (f32x2){vb[1].x, vb[1].y} + vi2 * (f32x2){vk[1].x, vk[1].y}); py2 += S[2] * (f32x2){vr[1].x, vr[1].y};
        S[3] = S[3] * (f32x2){vw[1].z, vw[1].w} + (sa2 * (f32x2){vb[1].z, vb[1].w} + vi2 * (f32x2){vk[1].z, vk[1].w}); py3 += S[3] * (f32x2){vr[1].z, vr[1].w};
#pragma unroll
        for (int q = 0; q < 2; ++q) { vw[q] = *(const f32x4*)(vW + von + 4 * q); vb[q] = *(const f32x4*)(vB + von + 4 * q); vk[q] = *(const f32x4*)(vK + von + 4 * q); vr[q] = *(const f32x4*)(vR + von + 4 * q); }
        vi = vV[ttn * 64 + irow];
        py2 += py3;
        const float py = osum(py2.x + py2.y);
        if (j8 == 0) ybuf[tt * 32 + lrow] = py;
        tt = ttn;
      }
    }
    __syncthreads();
    {
      const int tt = tid >> 3, sub = tid & 7;
      const f32x4 y0 = *(const f32x4*)(ybuf + tt * 32 + sub * 4);
      u32x2 w; w.x = pack2(y0.x, y0.y); w.y = pack2(y0.z, y0.w);
      *(u32x2*)(Y + (size_t)(row0 + t0 + tt) * 512 + hd * 64 + rs * 32 + sub * 4) = w;
    }
    __syncthreads();
  }
  if (!lat) {
    float* o = opq(p.out) + (dir ? OUT_SB : OUT_SF) + ((size_t)(seq * 4 + l) * 8 + hd) * 4096 + irow * 64 + j8 * 8;
#pragma unroll
    for (int q = 0; q < 2; ++q) *(f32x4*)(o + 4 * q) = (f32x4){S[2 * q].x, S[2 * q].y, S[2 * q + 1].x, S[2 * q + 1].y};
  }
}

DI void phase_mixers(const Params& p, int l, char* smem, int part = 0) {
  const int tid = otid(), wid = __builtin_amdgcn_readfirstlane(tid >> 6);
  unsigned* cnt = (unsigned*)(p.ws + OFF_CNT) + l * 8;
  int* slot = (int*)(smem + SMEM_BYTES - 16);
  bf16_t* U = (bf16_t*)(p.ws + OFF_U);
  const bf16_t* KA = (const bf16_t*)(p.ws + OFF_KA); const bf16_t* VAT = (const bf16_t*)(p.ws + OFF_VAT);
  const bf16_t* KN = (const bf16_t*)(p.ws + OFF_KN); const bf16_t* VBT = (const bf16_t*)(p.ws + OFF_VBT); const bf16_t* KRB = (const bf16_t*)(p.ws + OFF_KRB);
  const int QLEN = 256 + 256 + 128 + 64 + 64;
  bool first = true;
  int xq = blockIdx.x & 7, tries = 0;
  for (;;) {
    int kind, seq, a, qt;
    if (first && blockIdx.x < 256) {
      const int item = blockIdx.x; kind = 0; seq = 32 + (item >> 5); a = (item >> 2) & 7; qt = item & 3;
      first = false;
    } else {
      first = false;
      if (tid == 0) *slot = (int)atomicAdd(cnt + xq, 1u);
      __syncthreads();
      const int i = __builtin_amdgcn_readfirstlane(*slot);
      __syncthreads();
      if (i >= QLEN) { if (++tries >= 8) break; xq = (xq + 1) & 7; continue; }
      if (i < 256) { const int g = xq + 8 * (i >> 7); kind = 1; seq = 32 + (g >> 1); a = g & 1; qt = i & 127; }
      else if (i < 512) { const int j = i - 256; const int g = xq + 8 * (j >> 5); kind = 2; seq = 32 + (g >> 3); a = g & 7; qt = j & 31; }
      else if (i < 640) { const int j = i - 512; kind = 0; seq = xq + 8 * (j >> 5); a = (j >> 2) & 7; qt = j & 3; }
      else if (i < 704) { const int j = i - 640; kind = 1; seq = xq + 8 * (j >> 4); a = (j >> 3) & 1; qt = j & 7; }
      else { const int j = i - 704; kind = 2; seq = xq + 8 * (j >> 4); a = (j >> 1) & 7; qt = j & 1; }
    }
    const int kr0 = keyrow0(seq), Tk = seq_tk(seq);
    const int row0 = seq < 32 ? seq * 256 : NCTX + (seq - 32) * 4096;
    if (kind == 0) scan_item(p, l, seq, a, qt & 1, qt >> 1, smem);
    else if (kind == 1) {
      const int qh = a * 4 + wid;
      bf16_t* q = U + (size_t)(row0 + qt * 32) * ULD + qh * 64;
      attn_item<64>(q, ULD, KA + (size_t)kr0 * 128 + a * 64, 128, nullptr, 0, VAT + (size_t)128 * kr0 + (size_t)(a * 64) * Tk, Tk, Tk, q, ULD, smem);
    } else {
      bf16_t* q = U + (size_t)(row0 + qt * 128 + wid * 32) * ULD + 768 + a * 96;
      attn_item<96>(q, ULD, KN + (size_t)kr0 * 512 + a * 64, 512, KRB + (size_t)kr0 * 32, 32, VBT + (size_t)512 * kr0 + (size_t)(a * 64) * Tk, Tk, Tk, q, ULD, smem);
    }
  }
}

DI void cpost_row(const Params& p, int l, int row, int lane) {
  int seq, t; row_decode(row, seq, t);
  const int T = seq < 32 ? 256 : 4096;
  const bf16_t* YF = (const bf16_t*)(p.ws + OFF_R2); const bf16_t* YB = YF + (size_t)NT * 512;
  bf16_t* u = (bf16_t*)(p.ws + OFF_U) + (size_t)row * ULD + 1696;
  const float* bonus = (const float*)(p.ws + OFF_BONUS);
  float yf[8], yb[8], y[8];
  unpack8(*(const u32x4*)(YF + (size_t)row * 512 + lane * 8), yf);
  unpack8(*(const u32x4*)(YB + (size_t)row * 512 + lane * 8), yb);
  float s = 0.f;
#pragma unroll
  for (int i = 0; i < 8; ++i) { y[i] = yf[i] + yb[i]; s += y[i]; }
  s += shx<1>(s); s += shx<2>(s); s += shx<4>(s);
  const float mu = s * (1.0f / 64.0f);
  float q = 0.f;
#pragma unroll
  for (int i = 0; i < 8; ++i) { y[i] -= mu; q += y[i] * y[i]; }
  q += shx<1>(q); q += shx<2>(q); q += shx<4>(q);
  const float rs = rsqrtf(q * (1.0f / 64.0f) + 64e-5f);
  const int col = 1024 + lane * 8;
  float c[8], pv[8], nx[8];
  unpack8(*(const u32x4*)(u + col), c);
  if (t > 0) unpack8(*(const u32x4*)(u - ULD + col), pv); else { for (int i = 0; i < 8; ++i) pv[i] = 0.f; }
  if (t < T - 1) unpack8(*(const u32x4*)(u + ULD + col), nx); else { for (int i = 0; i < 8; ++i) nx[i] = 0.f; }
  const float* mup = p.in[I_MUP] + l * 1792 + col; const float* mun = p.in[I_MUN] + l * 1792 + col;
  const float* lw = p.in[I_LNW] + l * 512 + lane * 8; const float* lb = p.in[I_LNB] + l * 512 + lane * 8;
  const f32x2 bsv = *(const f32x2*)(bonus + ((size_t)row * 8 + (lane >> 3)) * 2);
  const float bs = bsv.x + bsv.y;
  float o[8];
#pragma unroll
  for (int i = 0; i < 8; ++i) { const float v = c[i] + mup[i] * (pv[i] - c[i]) + mun[i] * (nx[i] - c[i]); o[i] = y[i] * rs * lw[i] + lb[i] + bs * v; }
  *(u32x4*)(u + lane * 8) = pack8(o);
}
DI void phase_renorm_cpost(const Params& p, int l) {
  const int lane = otid() & 63, wid = __builtin_amdgcn_readfirstlane(otid() >> 6);
  for (int item = blockIdx.x; item < NT / 4; item += gridDim.x) { const int row = item * 4 + wid; norm_row(p, l, row, lane); cpost_row(p, l, row, lane); }
}

DI void phase_zgemm(const Params& p, char* smem) {
  const bf16_t* H = (const bf16_t*)(p.ws + OFF_R1);
  const bf16_t* W = (const bf16_t*)(p.ws + OFF_WIN) + (size_t)3584 * 1024;
  bf16_t* U = (bf16_t*)(p.ws + OFF_U);
  const int ntiles = 320 * 12;
  for (int tile = blockIdx.x; tile < ntiles; tile += gridDim.x) {
    const int mt = tile / 12, nt = tile % 12, m0 = mt * 128, n0 = nt * 128;
    f32x16 acc[2][2]; zero_acc<2>(acc);
    gemm_mainloop<2>(acc, H + (size_t)m0 * 1024, 1024, 64, W + (size_t)n0 * 1024, 1024, 1024, smem);
    const int lane = otid() & 63, wid = __builtin_amdgcn_readfirstlane(otid() >> 6), wm = wid >> 1, wn = wid & 1, r = lane & 31, hh = lane >> 5;
#pragma unroll
    for (int j = 0; j < 2; ++j) {
      const int col = n0 + wn * 64 + j * 32 + r;
      const int br = col >> 9, cc = col & 511;
      const int ucol = br == 0 ? cc : (br == 1 ? 768 + (cc >> 6) * 96 + (cc & 63) : 1696 + cc);
#pragma unroll
      for (int i = 0; i < 2; ++i) {
        bf16_t* up = U + (size_t)(m0 + wm * 64 + i * 32) * ULD;
        const int lo = 4 * hh * ULD + ucol;
        bf16_t yv[16];
#pragma unroll
        for (int e = 0; e < 16; ++e) yv[e] = (up + crowu(e) * ULD)[lo];
#pragma unroll
        for (int e = 0; e < 16; ++e) (up + crowu(e) * ULD)[lo] = f2bf(bf2f(yv[e]) * siluf_(acc[i][j][e]));
      }
    }
  }
}

DI void phase_merge(const Params& p, char* smem) {
  const bf16_t* H = (const bf16_t*)(p.ws + OFF_R1);
  const bf16_t* WG = (const bf16_t*)(p.ws + OFF_WIN) + (size_t)5120 * 1024;
  const bf16_t* WO = (const bf16_t*)(p.ws + OFF_WO);
  const bf16_t* U = (const bf16_t*)(p.ws + OFF_U);
  bf16_t* MX = (bf16_t*)(p.ws + OFF_R2);
  const int ntiles = 320 * 8;
  for (int tile = blockIdx.x; tile < ntiles; tile += gridDim.x) {
    const int mt = tile >> 3, nt = tile & 7, m0 = mt * 128, n0 = nt * 128;
    f32x16 mix[2][2]; zero_acc<2>(mix);
    unsigned gs[2][2][8];
#pragma unroll 1
    for (int step = 0; step < 6; ++step) {
      const int br = step >> 1, isT = step & 1;
      const int acol = br == 0 ? 0 : (br == 1 ? 768 : 1696);
      const bf16_t* Ap = isT ? U + (size_t)m0 * ULD + acol : H + (size_t)m0 * 1024;
      const bf16_t* Bp = isT ? WO + (size_t)(br * 1024 + n0) * 512 : WG + (size_t)(br * 1024 + n0) * 1024;
      f32x16 cur[2][2]; zero_acc<2>(cur);
      gemm_mainloop<2>(cur, Ap, isT ? ULD : 1024, (isT && br == 1) ? 96 : 64, Bp, isT ? 512 : 1024, isT ? 512 : 1024, smem);
      if (isT) {
#pragma unroll
        for (int i = 0; i < 2; ++i)
#pragma unroll
          for (int j = 0; j < 2; ++j)
#pragma unroll
            for (int e = 0; e < 8; ++e) { mix[i][j][2 * e] += lo16(gs[i][j][e]) * cur[i][j][2 * e]; mix[i][j][2 * e + 1] += hi16(gs[i][j][e]) * cur[i][j][2 * e + 1]; }
      } else {
#pragma unroll
        for (int i = 0; i < 2; ++i)
#pragma unroll
          for (int j = 0; j < 2; ++j)
#pragma unroll
            for (int e = 0; e < 8; ++e) gs[i][j][e] = pack2(sigmoidf_(cur[i][j][2 * e]), sigmoidf_(cur[i][j][2 * e + 1]));
      }
    }
    const int lane = otid() & 63, wid = __builtin_amdgcn_readfirstlane(otid() >> 6), wm = wid >> 1, wn = wid & 1, r = lane & 31, hh = lane >> 5;
#pragma unroll
    for (int j = 0; j < 2; ++j) {
      const int col = n0 + wn * 64 + j * 32 + r;
#pragma unroll
      for (int i = 0; i < 2; ++i) {
        bf16_t* mp = MX + (size_t)(m0 + wm * 64 + i * 32) * 1024;
        const int lo = 4 * hh * 1024 + col;
#pragma unroll
        for (int e = 0; e < 16; ++e) (mp + crowu(e) * 1024)[lo] = f2bf(mix[i][j][e]);
      }
    }
  }
}

DI void phase_out(const Params& p, int l, char* smem) {
  const bf16_t* MX = (const bf16_t*)(p.ws + OFF_R2);
  const bf16_t* W = (const bf16_t*)(p.ws + OFF_WOUT);
  const int ntiles = 320 * 8;
  for (int tile = blockIdx.x; tile < ntiles; tile += gridDim.x) {
    const int mt = tile >> 3, nt = tile & 7, m0 = mt * 128, n0 = nt * 128;
    f32x16 acc[2][2]; zero_acc<2>(acc);
    gemm_mainloop<2>(acc, MX + (size_t)m0 * 1024, 1024, 64, W + (size_t)n0 * 1024, 1024, 1024, smem);
    const int lane = otid() & 63, wid = __builtin_amdgcn_readfirstlane(otid() >> 6), wm = wid >> 1, wn = wid & 1, r = lane & 31, hh = lane >> 5;
    const int jm = m0 < NCTX ? 0 : 1 + ((m0 - NCTX) >> 12);
    const float* gate = (const float*)(p.ws + OFF_MOD) + ((size_t)l * 9 + jm) * MODLD + 2048;
    const float* xsrc = x_row_ptr(p, l, m0);
#pragma unroll
    for (int j = 0; j < 2; ++j) {
      const int col = n0 + wn * 64 + j * 32 + r;
      const float gv = gate[col];
      const int lo = 4 * hh * 1024 + col;
#pragma unroll
      for (int i = 0; i < 2; ++i) {
        const float* xs = xsrc + (size_t)(wm * 64 + i * 32) * 1024;
        float* xo = p.out + (size_t)(m0 + wm * 64 + i * 32) * 1024;
        float xv[16];
#pragma unroll
        for (int e = 0; e < 16; ++e) xv[e] = (xs + crowu(e) * 1024)[lo];
#pragma unroll
        for (int e = 0; e < 16; ++e) (xo + crowu(e) * 1024)[lo] = xv[e] + gv * acc[i][j][e];
      }
    }
  }
}

DI void phase_final(const Params& p) {
  const int lane = otid() & 63, wid = __builtin_amdgcn_readfirstlane(otid() >> 6);
  const float* nw = p.in[I_FNW];
  for (int item = blockIdx.x; item < NT / 4; item += gridDim.x) {
    float* x = p.out + (size_t)(item * 4 + wid) * 1024;
    f32x4 v[4]; float ss = 0.f;
#pragma unroll
    for (int i = 0; i < 4; ++i) { v[i] = *(const f32x4*)(x + lane * 4 + 256 * i); ss += v[i].x * v[i].x + v[i].y * v[i].y + v[i].z * v[i].z + v[i].w * v[i].w; }
ss = wave_sum(ss);
    const float rs = rsqrtf(ss * (1.0f / 1024.0f) + 1e-6f);
#pragma unroll
    for (int i = 0; i < 4; ++i) { const f32x4 w = *(const f32x4*)(nw + lane * 4 + 256 * i); *(f32x4*)(x + lane * 4 + 256 * i) = (f32x4){v[i].x * rs * w.x, v[i].y * rs * w.y, v[i].z * rs * w.z, v[i].w * rs * w.w}; }
  }
}

constexpr int NPHASES = 1 + 4 * 9 + 1;
__global__ void __launch_bounds__(256, 2) fwd_kernel(Params p0) {
  __shared__ __attribute__((aligned(16))) char smem[SMEM_BYTES];
  cg::grid_group grid = cg::this_grid();
  const int ph_begin = p0.ph_begin, ph_end = p0.ph_end;
  for (int ph = ph_begin; ph < ph_end; ++ph) {
    auto kp = __builtin_amdgcn_kernarg_segment_ptr();
    asm volatile("" : "+s"(kp));
    typedef const __attribute__((address_space(4))) Params CParams;
    CParams* kpp = (CParams*)kp;
    Params p;
#pragma unroll
    for (int i = 0; i < 35; ++i) p.in[i] = kpp->in[i];
    p.out = kpp->out; p.ws = kpp->ws; p.ph_begin = ph_begin; p.ph_end = ph_end;
    if (ph == 0) phase_prologue(p, smem);
    else if (ph == NPHASES - 1) phase_final(p);
    else {
      const int l = (ph - 1) / 9, sp = (ph - 1) % 9;
#ifdef PROBE_SP
      if (sp == PROBE_SP) {
        switch (sp) {
          case 0: phase_norm_convert(p, l, smem); break;
          case 1: phase_gemm1(p, l, smem); break;
          case 3: phase_upproj(p, smem); break;
          case 5: phase_renorm_cpost(p, l); break;
          case 7: phase_merge(p, smem); break;
          default: break;
        }
        grid.sync();
      }
#endif
      switch (sp) {
        case 0: phase_norm_convert(p, l, smem); break;
        case 1: phase_gemm1(p, l, smem); break;
        case 2: phase_post(p, l); break;
        case 3: phase_upproj(p, smem); break;
        case 4: phase_mixers(p, l, smem); break;
        case 5: phase_renorm_cpost(p, l); break;
        case 6: phase_zgemm(p, smem); break;
        case 7: phase_merge(p, smem); break;
        default: phase_out(p, l, smem); break;
      }
    }
    if (ph + 1 < ph_end) grid.sync();
  }
}

extern "C" void kernel_launch(void* const* d_in, const int* in_sizes, int n_in, void* d_out, int out_size, void* d_ws, size_t ws_size, hipStream_t stream) {
  if (ws_size < WS_NEED || n_in < 35) { fprintf(stderr, "workspace too small: %zu < %zu\n", ws_size, WS_NEED); return; }
  static int grid_blocks = 0;
  if (!grid_blocks) {
    int dev = 0, cus = 0, per_cu = 0;
    hipGetDevice(&dev);
    hipDeviceGetAttribute(&cus, hipDeviceAttributeMultiprocessorCount, dev);
    hipOccupancyMaxActiveBlocksPerMultiprocessor(&per_cu, fwd_kernel, 256, 0);
    if (per_cu < 1) per_cu = 1;
    if (per_cu > 2) per_cu = 2;
    grid_blocks = cus * per_cu;
  }
  Params p{};
  for (int i = 0; i < 35; ++i) p.in[i] = (const float*)d_in[i];
  p.out = (float*)d_out; p.ws = (char*)d_ws;
#ifndef ONE_LAUNCH
  for (int ph = 0; ph < NPHASES; ++ph) {
    p.ph_begin = ph; p.ph_end = ph + 1;
    hipLaunchKernelGGL(fwd_kernel, dim3(grid_blocks), dim3(256), 0, stream, p);
  }
#else
  p.ph_begin = 0; p.ph_end = NPHASES;
  void* args[] = {&p};
  hipError_t e = hipLaunchCooperativeKernel((void*)fwd_kernel, dim3(grid_blocks), dim3(256), args, 0, stream);
  if (e != hipSuccess) fprintf(stderr, "cooperative launch failed: %s (grid %d)\n", hipGetErrorString(e), grid_blocks);
#endif
}
```

```cpp
#define ONE_LAUNCH 1
#include <hip/hip_runtime.h>
#include <hip/hip_cooperative_groups.h>
#include <stdint.h>
#include <stdio.h>
namespace cg = cooperative_groups;

typedef unsigned short bf16_t;
typedef short bf16x8 __attribute__((ext_vector_type(8)));
typedef float f32x16 __attribute__((ext_vector_type(16)));
typedef float f32x4 __attribute__((ext_vector_type(4)));
typedef float f32x2 __attribute__((ext_vector_type(2)));
typedef unsigned u32x4 __attribute__((ext_vector_type(4)));
typedef unsigned u32x2 __attribute__((ext_vector_type(2)));
#define DI __device__ __forceinline__
#define MFMA32(a, b, c) __builtin_amdgcn_mfma_f32_32x32x16_bf16((a), (b), (c), 0, 0, 0)

constexpr int NT = 40960;
constexpr int NCTX = 8192;
constexpr int NK = 45056;
constexpr int ULD = 3488;
constexpr int MODLD = 3072;
constexpr int SMEM_BYTES = 78848;

constexpr size_t OFF_WIN = 0;
constexpr size_t OFF_WO = 16777216;
constexpr size_t OFF_WOUT = 19922944;
constexpr size_t OFF_WU = 22020096;
constexpr size_t OFF_MOD = 22282240;
constexpr size_t OFF_BONUS = 22724608;
constexpr size_t OFF_CS16 = 25346048;
constexpr size_t OFF_CS8 = 25354240;
constexpr size_t OFF_CNT = 25358336;
constexpr size_t OFF_U = 25358592;
constexpr size_t OFF_R1 = 311095552;
constexpr size_t OFF_KA = OFF_R1;
constexpr size_t OFF_VAT = 513208576;
constexpr size_t OFF_KN = OFF_R1 + 23068672;
constexpr size_t OFF_VBT = OFF_R1 + 69206016;
constexpr size_t OFF_KRB = OFF_R1 + 115343360;
constexpr size_t OFF_R2 = 429322496;
constexpr size_t WS_NEED = 524742912;

constexpr size_t OUT_AK = 41943040, OUT_AV = 46137344, OUT_CKV = 50331648, OUT_KR = 54525952, OUT_SF = 55574528, OUT_SB = 59768832;

struct Params {
  const float* in[35];
  float* out;
  char* ws;
  int ph_begin, ph_end;
};

enum { I_XP = 0, I_XS, I_CAK, I_CAV, I_CCKV, I_CKR, I_SF, I_SB, I_C, I_CCTX, I_NORMW, I_WMOD, I_BMOD, I_WIN, I_QNW, I_KNW, I_KVNW,
       I_WUK, I_WUV, I_MUP, I_MUN, I_W0, I_WUP, I_A0, I_AUP, I_KK, I_KA, I_RK, I_LNW, I_LNB, I_WOA, I_WOB, I_WOC, I_WOUT, I_FNW };

DI int threadIdx_x_raw() { return __builtin_amdgcn_workitem_id_x(); }
DI int otid() { int t = threadIdx_x_raw(); asm volatile("" : "+v"(t)); return t; }
DI const float* opq(const float* q) { asm volatile("" : "+s"(q)); return q; }
DI float* opq(float* q) { asm volatile("" : "+s"(q)); return q; }
DI float bf2f(bf16_t v) { return __uint_as_float(((unsigned)v) << 16); }
typedef __bf16 hbf16x2 __attribute__((ext_vector_type(2)));
DI unsigned pack2(float a, float b) { f32x2 v = {a, b}; hbf16x2 r = __builtin_convertvector(v, hbf16x2); return __builtin_bit_cast(unsigned, r); }
DI bf16_t f2bf(float x) { return (bf16_t)(pack2(x, 0.f) & 0xffffu); }
DI float xsum16(float x) { const unsigned u = __float_as_uint(x); auto r = __builtin_amdgcn_permlane16_swap(u, u, false, false); return __uint_as_float(r[0]) + __uint_as_float(r[1]); }
DI float xsum32(float x) { const unsigned u = __float_as_uint(x); auto r = __builtin_amdgcn_permlane32_swap(u, u, false, false); return __uint_as_float(r[0]) + __uint_as_float(r[1]); }
DI float lo16(unsigned w) { return __uint_as_float(w << 16); }
DI float hi16(unsigned w) { return __uint_as_float(w & 0xffff0000u); }
DI void unpack8(u32x4 w, float* v) { v[0] = lo16(w.x); v[1] = hi16(w.x); v[2] = lo16(w.y); v[3] = hi16(w.y); v[4] = lo16(w.z); v[5] = hi16(w.z); v[6] = lo16(w.w); v[7] = hi16(w.w); }
DI u32x4 pack8(const float* v) { u32x4 w; w.x = pack2(v[0], v[1]); w.y = pack2(v[2], v[3]); w.z = pack2(v[4], v[5]); w.w = pack2(v[6], v[7]); return w; }
template <int K> DI float shx(float v) { return __int_as_float(__builtin_amdgcn_ds_swizzle(__float_as_int(v), 0x1f | (K << 10))); }
DI float wave_sum(float v) { v += shx<1>(v); v += shx<2>(v); v += shx<4>(v); v += shx<8>(v); v += shx<16>(v); return xsum32(v); }
DI float qsum(float v) {
  v += __int_as_float(__builtin_amdgcn_update_dpp(0, __float_as_int(v), 0xB1, 0xf, 0xf, true));
  v += __int_as_float(__builtin_amdgcn_update_dpp(0, __float_as_int(v), 0x4E, 0xf, 0xf, true));
  return v;
}
DI float osum(float v) {
  v = qsum(v);
  v += __int_as_float(__builtin_amdgcn_update_dpp(0, __float_as_int(v), 0x141, 0xf, 0xf, true));
  return v;
}
DI int crow(int reg, int h) { return (reg & 3) + 8 * (reg >> 2) + 4 * h; }
DI int crowu(int reg) { return (reg & 3) + 8 * (reg >> 2); }
DI int perm16(int t) { return (t & ~12) | ((t & 4) << 1) | ((t & 8) >> 1); }
DI float sigmoidf_(float x) { return 1.0f / (1.0f + __expf(-x)); }
DI float siluf_(float x) { return x / (1.0f + __expf(-x)); }

DI void row_decode(int row, int& seq, int& t) {
  if (row < NCTX) { seq = row >> 8; t = row & 255; } else { seq = 32 + ((row - NCTX) >> 12); t = (row - NCTX) & 4095; }
}
DI int keyrow0(int seq) { return seq < 32 ? seq * 256 : NCTX + (seq - 32) * 4608; }
DI int seq_tk(int seq) { return seq < 32 ? 256 : 4608; }

template <int NJ>
DI void gemm_mainloop(f32x16 (&acc)[2][NJ], const bf16_t* __restrict__ A, int lda, int ks,
                      const bf16_t* __restrict__ Bt, int ldb, int K, char* smem) {
  constexpr int A_BYTES = 128 * 128;
  constexpr int B_BYTES = 64 * NJ * 128;
  constexpr int STAGE = A_BYTES + B_BYTES;
  const int tid = otid(), lane = tid & 63, wid = __builtin_amdgcn_readfirstlane(tid >> 6), wm = wid >> 1, wn = wid & 1;
  const int r = lane & 31, hh = lane >> 5;
  const int nk = K >> 6;
  const int lrow = tid >> 3, lc = tid & 7;
  u32x4 ra[4], rb[2 * NJ];
  const bf16_t* ap = A + (size_t)lrow * lda + lc * 8;
  const bf16_t* bp = Bt + (size_t)lrow * ldb + lc * 8;
#pragma unroll
  for (int p = 0; p < 4; ++p) ra[p] = *(const u32x4*)(ap + (size_t)(32 * p) * lda);
#pragma unroll
  for (int p = 0; p < 2 * NJ; ++p) rb[p] = *(const u32x4*)(bp + (size_t)(32 * p) * ldb);
  {
    char* base = smem;
#pragma unroll
    for (int p = 0; p < 4; ++p) { const int row = lrow + 32 * p; *(u32x4*)(base + row * 128 + ((lc ^ ((row >> 1) & 7)) << 4)) = ra[p]; }
#pragma unroll
    for (int p = 0; p < 2 * NJ; ++p) { const int row = lrow + 32 * p; *(u32x4*)(base + A_BYTES + row * 128 + ((lc ^ ((row >> 1) & 7)) << 4)) = rb[p]; }
  }
  if (nk > 1) {
    const bf16_t* ap2 = ap + (size_t)ks;
    const bf16_t* bp2 = bp + (size_t)64;
#pragma unroll
    for (int p = 0; p < 4; ++p) ra[p] = *(const u32x4*)(ap2 + (size_t)(32 * p) * lda);
#pragma unroll
    for (int p = 0; p < 2 * NJ; ++p) rb[p] = *(const u32x4*)(bp2 + (size_t)(32 * p) * ldb);
  }
  __syncthreads();
  for (int kt = 0; kt < nk; ++kt) {
    const char* base = smem + (kt & 1) * STAGE;
#pragma unroll
    for (int s = 0; s < 4; ++s) {
      bf16x8 af[2], bfr[NJ];
#pragma unroll
      for (int i = 0; i < 2; ++i) { const int row = wm * 64 + i * 32 + r; af[i] = *(const bf16x8*)(base + row * 128 + (((2 * s + hh) ^ ((row >> 1) & 7)) << 4)); }
#pragma unroll
      for (int j = 0; j < NJ; ++j) { const int row = wn * (32 * NJ) + j * 32 + r; bfr[j] = *(const bf16x8*)(base + A_BYTES + row * 128 + (((2 * s + hh) ^ ((row >> 1) & 7)) << 4)); }
#pragma unroll
      for (int i = 0; i < 2; ++i)
#pragma unroll
        for (int j = 0; j < NJ; ++j) acc[i][j] = MFMA32(af[i], bfr[j], acc[i][j]);
    }
    if (kt + 1 < nk) {
      char* nb = smem + ((kt + 1) & 1) * STAGE;
#pragma unroll
      for (int p = 0; p < 4; ++p) { const int row = lrow + 32 * p; *(u32x4*)(nb + row * 128 + ((lc ^ ((row >> 1) & 7)) << 4)) = ra[p]; }
#pragma unroll
      for (int p = 0; p < 2 * NJ; ++p) { const int row = lrow + 32 * p; *(u32x4*)(nb + A_BYTES + row * 128 + ((lc ^ ((row >> 1) & 7)) << 4)) = rb[p]; }
      if (kt + 2 < nk) {
        const bf16_t* ap2 = ap + (size_t)(kt + 2) * ks;
        const bf16_t* bp2 = bp + (size_t)(kt + 2) * 64;
#pragma unroll
        for (int p = 0; p < 4; ++p) ra[p] = *(const u32x4*)(ap2 + (size_t)(32 * p) * lda);
#pragma unroll
        for (int p = 0; p < 2 * NJ; ++p) rb[p] = *(const u32x4*)(bp2 + (size_t)(32 * p) * ldb);
      }
    }
    __syncthreads();
  }
}

template <int NJ> DI void zero_acc(f32x16 (&acc)[2][NJ]) {
#pragma unroll
  for (int i = 0; i < 2; ++i)
#pragma unroll
    for (int j = 0; j < NJ; ++j)
#pragma unroll
      for (int e = 0; e < 16; ++e) acc[i][j][e] = 0.f;
}

DI void phase_prologue(const Params& p, char* smem) {
  const int tid = otid(), lane = tid & 63, wid = __builtin_amdgcn_readfirstlane(tid >> 6);
  float* mod = (float*)(p.ws + OFF_MOD);
  if (blockIdx.x == 0) {
    if (tid < 64) ((unsigned*)(p.ws + OFF_CNT))[tid] = 0u;
    float* cs16 = (float*)(p.ws + OFF_CS16);
    float* cs8 = (float*)(p.ws + OFF_CS8);
    for (int e = tid; e < 64 * 16; e += 256) { const int pos = e >> 4, i = e & 15; const float inv = expf(-9.210340371976184f * (float)i / 16.0f); const float a = (float)pos * inv; cs16[e * 2] = cosf(a); cs16[e * 2 + 1] = sinf(a); }
    for (int e = tid; e < 64 * 8; e += 256) { const int pos = e >> 3, i = e & 7; const float inv = expf(-9.210340371976184f * (float)i / 8.0f); const float a = (float)pos * inv; cs8[e * 2] = cosf(a); cs8[e * 2 + 1] = sinf(a); }
  }
  float* sl = (float*)smem;
  float* red = sl + 9 * 1024;
  for (int e = tid; e < 9 * 1024; e += 256) { const int j = e >> 10, k = e & 1023; const float* cc0 = opq(p.in[I_CCTX]); const float* cc1 = opq(p.in[I_C]); const float c = j == 0 ? cc0[k] : cc1[(j - 1) * 1024 + k]; sl[e] = siluf_(c); }
  __syncthreads();
  for (int item = blockIdx.x; item < 192; item += gridDim.x) {
    const int l = item / 48, n = (item % 48) * 64 + lane;
    const float* w = p.in[I_WMOD] + (size_t)l * 1024 * 3072 + n;
    float a[9];
#pragma unroll
    for (int j = 0; j < 9; ++j) a[j] = 0.f;
    for (int k = wid * 256; k < wid * 256 + 256; ++k) {
      const float wv = w[(size_t)k * 3072];
#pragma unroll
      for (int j = 0; j < 9; ++j) a[j] += sl[j * 1024 + k] * wv;
    }
#pragma unroll
    for (int j = 0; j < 9; ++j) red[(wid * 9 + j) * 64 + lane] = a[j];
    __syncthreads();
    for (int e = tid; e < 9 * 64; e += 256) {
      const int j = e >> 6, c = e & 63;
      const float s = red[(0 * 9 + j) * 64 + c] + red[(1 * 9 + j) * 64 + c] + red[(2 * 9 + j) * 64 + c] + red[(3 * 9 + j) * 64 + c];
      const int nn = (item % 48) * 64 + c;
      mod[((size_t)l * 9 + j) * MODLD + nn] = s + p.in[I_BMOD][l * 3072 + nn];
    }
    __syncthreads();
  }
}

DI const float* x_row_ptr(const Params& p, int l, int row) {
  const float* xp = opq(p.in[I_XP]); const float* xs = opq(p.in[I_XS]); const float* xo = opq((const float*)p.out);
  if (l == 0) return row < NCTX ? xp + (size_t)row * 1024 : xs + (size_t)(row - NCTX) * 1024;
  return xo + (size_t)row * 1024;
}
DI void norm_row(const Params& p, int l, int row, int lane) {
  const float* x = x_row_ptr(p, l, row);
  const int j = row < NCTX ? 0 : 1 + ((row - NCTX) >> 12);
  const float* mod = (const float*)(p.ws + OFF_MOD) + ((size_t)l * 9 + j) * MODLD;
  const float* nw = p.in[I_NORMW] + l * 1024;
  bf16_t* h = (bf16_t*)(p.ws + OFF_R1) + (size_t)row * 1024;
  f32x4 v[4]; float ss = 0.f;
#pragma unroll
  for (int i = 0; i < 4; ++i) { v[i] = *(const f32x4*)(x + lane * 4 + 256 * i); ss += v[i].x * v[i].x + v[i].y * v[i].y + v[i].z * v[i].z + v[i].w * v[i].w; }
ss = wave_sum(ss);
  const float rs = rsqrtf(ss * (1.0f / 1024.0f) + 1e-6f);
#pragma unroll
  for (int i = 0; i < 4; ++i) {
    const int c = lane * 4 + 256 * i;
    const f32x4 w = *(const f32x4*)(nw + c), sh = *(const f32x4*)(mod + c), sc = *(const f32x4*)(mod + 1024 + c);
    u32x2 o;
    o.x = pack2(v[i].x * rs * w.x * (1.f + sc.x) + sh.x, v[i].y * rs * w.y * (1.f + sc.y) + sh.y);
    o.y = pack2(v[i].z * rs * w.z * (1.f + sc.z) + sh.z, v[i].w * rs * w.w * (1.f + sc.w) + sh.w);
    *(u32x2*)(h + c) = o;
  }
}

DI int win_srccol(int j) {
  if (j < 768) return j;
  if (j < 1696) return j + 512;
  if (j < 3488) return j + 1024;
  if (j < 3584) return -1;
  if (j < 5120) { const int jj = j - 3584; return jj < 512 ? 768 + jj : (jj < 1024 ? 2208 + (jj - 512) : 4512 + (jj - 1024)); }
  return 5024 + (j - 5120);
}
DI void conv_tile(const float* __restrict__ src, int ld_src, bf16_t* dst, int ld_dst, int k0, int n0, int kind, int srcoff, char* smem) {
  float* tile = (float*)smem;
  const int tid = otid();
  const int n = tid & 63;
  int sc = kind == 0 ? win_srccol(n0 + n) : (n0 + n - srcoff);
#pragma unroll
  for (int i = 0; i < 16; ++i) { const int k = i * 4 + (tid >> 6); tile[k * 65 + n] = sc >= 0 ? src[(size_t)(k0 + k) * ld_src + sc] : 0.f; }
  __syncthreads();
#pragma unroll
  for (int i = 0; i < 8; ++i) { const int nn = i * 8 + (tid >> 5), kk = (tid & 31) * 2; *(unsigned*)(dst + (size_t)(n0 + nn) * ld_dst + k0 + kk) = pack2(tile[kk * 65 + nn], tile[(kk + 1) * 65 + nn]); }
  __syncthreads();
}

DI void phase_norm_convert(const Params& p, int l, char* smem) {
  const int tid = otid(), lane = tid & 63, wid = __builtin_amdgcn_readfirstlane(tid >> 6);
  bf16_t* WinT = (bf16_t*)(p.ws + OFF_WIN); bf16_t* WoT = (bf16_t*)(p.ws + OFF_WO); bf16_t* WoutT = (bf16_t*)(p.ws + OFF_WOUT); bf16_t* WuT = (bf16_t*)(p.ws + OFF_WU);
  const int NI_WIN = 128 * 16, NI_WO = 3 * 16 * 8, NI_WOUT = 16 * 16, NI_WU = 16 * 2;
  const int NI_CONV = NI_WIN + NI_WO + NI_WOUT + NI_WU;
  for (int item = blockIdx.x; item < NI_CONV; item += gridDim.x) {
    int it = item;
    if (it < NI_WIN) { conv_tile(p.in[I_WIN] + (size_t)l * 1024 * 8096, 8096, WinT, 1024, (it & 15) * 64, (it >> 4) * 64, 0, 0, smem); continue; }
    it -= NI_WIN;
    if (it < NI_WO) { const int br = it / 128, r2 = it % 128; const float* src = (br == 0 ? opq(p.in[I_WOA]) : (br == 1 ? opq(p.in[I_WOB]) : opq(p.in[I_WOC]))) + (size_t)l * 512 * 1024; conv_tile(src, 1024, WoT + (size_t)br * 1024 * 512, 512, (r2 & 7) * 64, (r2 >> 3) * 64, 1, 0, smem); continue; }
    it -= NI_WO;
    if (it < NI_WOUT) { conv_tile(p.in[I_WOUT] + (size_t)l * 1024 * 1024, 1024, WoutT, 1024, (it & 15) * 64, (it >> 4) * 64, 1, 0, smem); continue; }
    it -= NI_WOUT;
    { const int nt = it >> 1, kt = it & 1; const bool uv = nt >= 8; const float* src = (uv ? opq(p.in[I_WUV]) : opq(p.in[I_WUK])) + (size_t)l * 128 * 512; conv_tile(src, 512, WuT, 128, kt * 64, nt * 64, 1, uv ? 512 : 0, smem); }
  }
  for (int item = blockIdx.x; item < NT / 4; item += gridDim.x) norm_row(p, l, item * 4 + wid, lane);
}

DI void phase_gemm1(const Params& p, int l, char* smem) {
  const bf16_t* H = (const bf16_t*)(p.ws + OFF_R1);
  const bf16_t* W = (const bf16_t*)(p.ws + OFF_WIN);
  bf16_t* U = (bf16_t*)(p.ws + OFF_U);
  bf16_t* VAT = (bf16_t*)(p.ws + OFF_VAT);
  const int NTN = 28, ntiles = 320 * NTN;
  for (int tile = blockIdx.x; tile < ntiles; tile += gridDim.x) {
    const int mt = tile / NTN, nt = tile % NTN, m0 = mt * 128, n0 = nt * 128;
    f32x16 acc[2][2]; zero_acc<2>(acc);
    gemm_mainloop<2>(acc, H + (size_t)m0 * 1024, 1024, 64, W + (size_t)n0 * 1024, 1024, 1024, smem);
    const int lane = otid() & 63, wid = __builtin_amdgcn_readfirstlane(otid() >> 6), wm = wid >> 1, wn = wid & 1, r = lane & 31, hh = lane >> 5;
    int seq, t0; row_decode(m0, seq, t0);
#pragma unroll
    for (int j = 0; j < 2; ++j) {
      const int cb = n0 + wn * 64 + j * 32;
      if (cb >= ULD) continue;
      const int col = cb + r;
      if (cb >= 640 && cb < 768) {
        const int kvh = (col - 640) >> 6, dv = col & 63, Tk = seq_tk(seq);
        bf16_t* vt = VAT + (size_t)128 * keyrow0(seq) + (size_t)(kvh * 64 + dv) * Tk;
#pragma unroll
        for (int i = 0; i < 2; ++i) {
          const int tt = t0 + wm * 64 + i * 32;
#pragma unroll
          for (int g2 = 0; g2 < 2; ++g2) {
            float v[8];
#pragma unroll
            for (int e = 0; e < 8; ++e) v[e] = acc[i][j][g2 * 8 + e];
            *(u32x4*)(vt + tt + 16 * g2 + 8 * hh) = pack8(v);
          }
          if (seq < 32) {
            float* o = p.out + OUT_AV + ((size_t)(seq * 4 + l) * 256 + tt) * 128;
            const int lo = 4 * hh * 128 + (col - 640);
#pragma unroll
            for (int e = 0; e < 16; ++e) (o + crowu(e) * 128)[lo] = acc[i][j][e];
          }
        }
      } else {
#pragma unroll
        for (int i = 0; i < 2; ++i) {
          bf16_t* up = U + (size_t)(m0 + wm * 64 + i * 32) * ULD;
          const int lo = 4 * hh * ULD + col;
#pragma unroll
          for (int e = 0; e < 16; ++e) (up + crowu(e) * ULD)[lo] = f2bf(acc[i][j][e]);
        }
      }
    }
  }
}

DI void post_row(const Params& p, int l, int row, int lane) {
  int seq, t; row_decode(row, seq, t);
  const bool lat = row >= NCTX;
  const int krow = keyrow0(seq) + t;
  const int prow = t >> 6, pcol = t & 63;
  bf16_t* u = (bf16_t*)(p.ws + OFF_U) + (size_t)row * ULD;
  const float* cs16 = (const float*)(p.ws + OFF_CS16);
  const float* cs8 = (const float*)(p.ws + OFF_CS8);
  const float LOG2E = 1.4426950408889634f;
#pragma unroll
  for (int which = 0; which < 2; ++which) {
    const int l8 = which == 0 ? lane : (lane & 15);
    const bf16_t* src = u + (which == 0 ? 0 : 512) + l8 * 8;
    float v[8]; unpack8(*(const u32x4*)src, v);
    float ss = 0.f;
#pragma unroll
    for (int i = 0; i < 8; ++i) ss += v[i] * v[i];
    ss += shx<1>(ss); ss += shx<2>(ss); ss += shx<4>(ss);
    const float rs = rsqrtf(ss * (1.0f / 64.0f) + 1e-6f);
    const float* nw = (which == 0 ? opq(p.in[I_QNW]) : opq(p.in[I_KNW])) + l * 64 + (lane & 7) * 8;
#pragma unroll
    for (int i = 0; i < 8; ++i) v[i] = v[i] * rs * nw[i];
    float pv[8];
#pragma unroll
    for (int i = 0; i < 8; ++i) pv[i] = shx<2>(v[i]);
    if (lat) {
      const int pos = ((lane & 7) >> 2) ? pcol : prow;
      const bool lower = (lane & 2) == 0;
      const float* cs = cs16 + (pos * 16 + (lane & 1) * 8) * 2;
#pragma unroll
      for (int i = 0; i < 8; ++i) { const float c = cs[i * 2], s = cs[i * 2 + 1]; v[i] = lower ? v[i] * c - pv[i] * s : v[i] * c + pv[i] * s; }
    }
    if (which == 0) {
      const float sc = 0.125f * LOG2E;
#pragma unroll
      for (int i = 0; i < 8; ++i) v[i] *= sc;
      *(u32x4*)(u + lane * 8) = pack8(v);
    } else if (lane < 16) {
      bf16_t* KA = (bf16_t*)(p.ws + OFF_KA);
      *(u32x4*)(KA + (size_t)krow * 128 + lane * 8) = pack8(v);
      if (!lat) {
        float* o = p.out + OUT_AK + ((size_t)(seq * 4 + l) * 256 + t) * 128 + lane * 8;
        *(f32x4*)o = (f32x4){v[0], v[1], v[2], v[3]}; *(f32x4*)(o + 4) = (f32x4){v[4], v[5], v[6], v[7]};
      }
    }
  }
  {
    const float sc = 0.10206207261596577f * LOG2E;
    const int hd = lane >> 3;
    bf16_t* q = u + 768 + hd * 96;
    { float v[8]; unpack8(*(const u32x4*)(q + (lane & 7) * 8), v);
#pragma unroll
      for (int i = 0; i < 8; ++i) v[i] *= sc;
      *(u32x4*)(q + (lane & 7) * 8) = pack8(v); }
    { bf16_t* qr = q + 64 + (lane & 7) * 4;
      const u32x2 w = *(const u32x2*)qr;
      float v[4] = {lo16(w.x), hi16(w.x), lo16(w.y), hi16(w.y)}, pv[4];
#pragma unroll
      for (int i = 0; i < 4; ++i) pv[i] = shx<2>(v[i]);
      if (lat) {
        const int pos = ((lane & 7) >> 2) ? pcol : prow;
        const bool lower = (lane & 2) == 0;
        const float* cs = cs8 + (pos * 8 + (lane & 1) * 4) * 2;
#pragma unroll
        for (int i = 0; i < 4; ++i) { const float c = cs[i * 2], s = cs[i * 2 + 1]; v[i] = lower ? v[i] * c - pv[i] * s : v[i] * c + pv[i] * s; }
      }
      u32x2 o; o.x = pack2(v[0] * sc, v[1] * sc); o.y = pack2(v[2] * sc, v[3] * sc);
      *(u32x2*)qr = o; }
  }
  {
    const unsigned w = *(const unsigned*)(u + 1536 + lane * 2);
    float a = lo16(w), b = hi16(w);
    float ss = a * a + b * b;
ss = wave_sum(ss);
    const float rs = rsqrtf(ss * (1.0f / 128.0f) + 1e-6f);
    const float* nw = p.in[I_KVNW] + l * 128 + lane * 2;
    a = a * rs * nw[0]; b = b * rs * nw[1];
    bf16_t* CKVN = (bf16_t*)(p.ws + OFF_R2);
    *(unsigned*)(CKVN + (size_t)krow * 128 + lane * 2) = pack2(a, b);
    if (!lat) { float* o = p.out + OUT_CKV + ((size_t)(seq * 4 + l) * 256 + t) * 128 + lane * 2; *(f32x2*)o = (f32x2){a, b}; }
  }
  {
    float v = bf2f(u[1664 + (lane & 31)]);
    const float pv = shx<8>(v);
    if (!lat) { if (lane < 32) p.out[OUT_KR + ((size_t)(seq * 4 + l) * 256 + t) * 32 + lane] = v; }
    else {
      const int d = lane & 31; const int pos = (d >> 4) ? pcol : prow; const bool lower = (d & 8) == 0;
      const float* cs = cs8 + (pos * 8 + (d & 7)) * 2;
      v = lower ? v * cs[0] - pv * cs[1] : v * cs[0] + pv * cs[1];
    }
    if (lane < 32) ((bf16_t*)(p.ws + OFF_KRB))[(size_t)krow * 32 + lane] = f2bf(v);
  }
}
DI void post_cached_row(const Params& p, int l, int idx, int lane) {
  const int b = idx >> 9, j = idx & 511;
  const int kr0 = NCTX + b * 4608, krow = kr0 + 4096 + j;
  const size_t cb = ((size_t)(b * 4 + l) * 512 + j);
  bf16_t* KA = (bf16_t*)(p.ws + OFF_KA); bf16_t* VAT = (bf16_t*)(p.ws + OFF_VAT); bf16_t* CKVN = (bf16_t*)(p.ws + OFF_R2); bf16_t* KRB = (bf16_t*)(p.ws + OFF_KRB);
  { const f32x2 v = *(const f32x2*)(p.in[I_CAK] + cb * 128 + lane * 2); *(unsigned*)(KA + (size_t)krow * 128 + lane * 2) = pack2(v.x, v.y); }
  { const f32x2 v = *(const f32x2*)(p.in[I_CAV] + cb * 128 + lane * 2);
    bf16_t* vt = VAT + (size_t)128 * kr0 + (size_t)(lane * 2) * 4608 + perm16(4096 + j);
    vt[0] = f2bf(v.x); vt[4608] = f2bf(v.y); }
  { const f32x2 v = *(const f32x2*)(p.in[I_CCKV] + cb * 128 + lane * 2); *(unsigned*)(CKVN + (size_t)krow * 128 + lane * 2) = pack2(v.x, v.y); }
  if (lane < 32) KRB[(size_t)krow * 32 + lane] = f2bf(p.in[I_CKR][cb * 32 + lane]);
}
DI void phase_post(const Params& p, int l) {
  const int lane = otid() & 63, wid = __builtin_amdgcn_readfirstlane(otid() >> 6);
  for (int item = blockIdx.x; item < NT / 4 + 1024; item += gridDim.x) {
    if (item < NT / 4) post_row(p, l, item * 4 + wid, lane);
    else post_cached_row(p, l, (item - NT / 4) * 4 + wid, lane);
  }
}

DI void phase_upproj(const Params& p, char* smem) {
  const bf16_t* A = (const bf16_t*)(p.ws + OFF_R2);
  const bf16_t* W = (const bf16_t*)(p.ws + OFF_WU);
  bf16_t* KN = (bf16_t*)(p.ws + OFF_KN); bf16_t* VBT = (bf16_t*)(p.ws + OFF_VBT);
  const int ntiles = 352 * 8;
  for (int tile = blockIdx.x; tile < ntiles; tile += gridDim.x) {
    const int mt = tile >> 3, nt = tile & 7, m0 = mt * 128, n0 = nt * 128;
    f32x16 acc[2][2]; zero_acc<2>(acc);
    gemm_mainloop<2>(acc, A + (size_t)m0 * 128, 128, 64, W + (size_t)n0 * 128, 128, 128, smem);
    const int lane = otid() & 63, wid = __builtin_amdgcn_readfirstlane(otid() >> 6), wm = wid >> 1, wn = wid & 1, r = lane & 31, hh = lane >> 5;
    int seq, t0;
    if (m0 < NCTX) { seq = m0 >> 8; t0 = m0 & 255; } else { const int rr = m0 - NCTX; seq = 32 + rr / 4608; t0 = rr % 4608; }
#pragma unroll
    for (int j = 0; j < 2; ++j) {
      const int col = n0 + wn * 64 + j * 32 + r;
      if (n0 < 512) {
#pragma unroll
        for (int i = 0; i < 2; ++i) {
          bf16_t* kp = KN + (size_t)(m0 + wm * 64 + i * 32) * 512;
          const int lo = 4 * hh * 512 + col;
#pragma unroll
          for (int e = 0; e < 16; ++e) (kp + crowu(e) * 512)[lo] = f2bf(acc[i][j][e]);
        }
      } else {
        const int Tk = seq_tk(seq);
        bf16_t* vt = VBT + (size_t)512 * keyrow0(seq) + (size_t)(col - 512) * Tk;
#pragma unroll
        for (int i = 0; i < 2; ++i) {
          const int tt = t0 + wm * 64 + i * 32;
#pragma unroll
          for (int g2 = 0; g2 < 2; ++g2) {
            float v[8];
#pragma unroll
            for (int e = 0; e < 8; ++e) v[e] = acc[i][j][g2 * 8 + e];
            *(u32x4*)(vt + tt + 16 * g2 + 8 * hh) = pack8(v);
          }
        }
      }
    }
  }
}

template <int DQK>
DI void attn_item(const bf16_t* Qw, int q_ld, const bf16_t* K1, int k1_ld, const bf16_t* K2, int k2_ld,
                  const bf16_t* Vt, int vt_ld, int nkeys, bf16_t* Ow, int o_ld, char* smem) {
  constexpr int KS = DQK * 2 + 16;
  constexpr int KBYTES = 64 * KS;
  constexpr int VS = 144;
  constexpr int VBYTES = 64 * VS;
  constexpr int STAGE = KBYTES + VBYTES;
  constexpr int CPR = DQK / 8;
  constexpr int NKC = 64 * CPR / 256;
  constexpr int NS = DQK / 16;
  const int tid = otid(), lane = tid & 63, r = lane & 31, hh = lane >> 5;
  bf16x8 qf[NS];
#pragma unroll
  for (int s = 0; s < NS; ++s) qf[s] = *(const bf16x8*)(Qw + (size_t)r * q_ld + 16 * s + 8 * hh);
  f32x16 o[2];
#pragma unroll
  for (int n = 0; n < 2; ++n)
#pragma unroll
    for (int e = 0; e < 16; ++e) o[n][e] = 0.f;
  float m_run = -1e30f, lsum = 0.f;
  u32x4 rk[NKC], rv[2];
  int krow_[NKC], kc_[NKC];
#pragma unroll
  for (int q = 0; q < NKC; ++q) { const int id = q * 256 + tid; krow_[q] = id / CPR; kc_[q] = id % CPR; }
  const int vrow = tid >> 3, vc = tid & 7;
  auto gload = [&](int key0) {
#pragma unroll
    for (int q = 0; q < NKC; ++q) {
      const bf16_t* src = (DQK == 64 || kc_[q] < 8) ? K1 + (size_t)(key0 + krow_[q]) * k1_ld + kc_[q] * 8 : K2 + (size_t)(key0 + krow_[q]) * k2_ld + (kc_[q] - 8) * 8;
      rk[q] = *(const u32x4*)src;
    }
#pragma unroll
    for (int q = 0; q < 2; ++q) rv[q] = *(const u32x4*)(Vt + (size_t)(vrow + 32 * q) * vt_ld + key0 + vc * 8);
  };
  auto lstore = [&](int buf) {
    char* base = smem + buf * STAGE;
#pragma unroll
    for (int q = 0; q < NKC; ++q) *(u32x4*)(base + krow_[q] * KS + kc_[q] * 16) = rk[q];
#pragma unroll
    for (int q = 0; q < 2; ++q) *(u32x4*)(base + KBYTES + (vrow + 32 * q) * VS + vc * 16) = rv[q];
  };
  const int ntl = nkeys >> 6;
  gload(0); lstore(0);
  if (ntl > 1) gload(64);
  __syncthreads();
  for (int tl = 0; tl < ntl; ++tl) {
    const char* base = smem + (tl & 1) * STAGE;
    bf16x8 kf[2][NS], vf[2][2][2];
#pragma unroll
    for (int kb = 0; kb < 2; ++kb)
#pragma unroll
      for (int ks = 0; ks < NS; ++ks) kf[kb][ks] = *(const bf16x8*)(base + (kb * 32 + r) * KS + (2 * ks + hh) * 16);
    __builtin_amdgcn_sched_barrier(0);
    f32x16 s[2];
#pragma unroll
    for (int kb = 0; kb < 2; ++kb)
#pragma unroll
      for (int e = 0; e < 16; ++e) s[kb][e] = 0.f;
#pragma unroll
    for (int ks = 0; ks < NS; ++ks)
#pragma unroll
      for (int kb = 0; kb < 2; ++kb) s[kb] = MFMA32(kf[kb][ks], qf[ks], s[kb]);
#pragma unroll
    for (int kb = 0; kb < 2; ++kb)
#pragma unroll
      for (int s2 = 0; s2 < 2; ++s2)
#pragma unroll
        for (int n = 0; n < 2; ++n) vf[kb][s2][n] = *(const bf16x8*)(base + KBYTES + (32 * n + r) * VS + (kb * 32 + 16 * s2 + 8 * hh) * 2);
    __builtin_amdgcn_sched_barrier(0);
    float mx = s[0][0];
#pragma unroll
    for (int kb = 0; kb < 2; ++kb)
#pragma unroll
      for (int e = 0; e < 16; ++e) mx = fmaxf(mx, s[kb][e]);
    { const unsigned u = __float_as_uint(mx); auto sw = __builtin_amdgcn_permlane32_swap(u, u, false, false); mx = fmaxf(__uint_as_float(sw[0]), __uint_as_float(sw[1])); }
    const float m_new = fmaxf(m_run, mx);
    const float alpha = __builtin_amdgcn_exp2f(m_run - m_new);
    m_run = m_new;
    float ps = 0.f;
#pragma unroll
    for (int kb = 0; kb < 2; ++kb)
#pragma unroll
      for (int e = 0; e < 16; ++e) { const float pe = __builtin_amdgcn_exp2f(s[kb][e] - m_new); s[kb][e] = pe; ps += pe; }
    lsum = lsum * alpha + ps;
    if (__builtin_amdgcn_ballot_w64(alpha != 1.0f) != 0ull) {
#pragma unroll
      for (int n = 0; n < 2; ++n)
#pragma unroll
        for (int e = 0; e < 16; ++e) o[n][e] *= alpha;
    }
#pragma unroll
    for (int kb = 0; kb < 2; ++kb)
#pragma unroll
      for (int s2 = 0; s2 < 2; ++s2) {
        u32x4 pw;
        pw.x = pack2(s[kb][8 * s2 + 0], s[kb][8 * s2 + 1]); pw.y = pack2(s[kb][8 * s2 + 2], s[kb][8 * s2 + 3]);
        pw.z = pack2(s[kb][8 * s2 + 4], s[kb][8 * s2 + 5]); pw.w = pack2(s[kb][8 * s2 + 6], s[kb][8 * s2 + 7]);
        const bf16x8 pf = __builtin_bit_cast(bf16x8, pw);
#pragma unroll
        for (int n = 0; n < 2; ++n) o[n] = MFMA32(vf[kb][s2][n], pf, o[n]);
      }
    if (tl + 1 < ntl) { lstore((tl + 1) & 1); if (tl + 2 < ntl) gload((tl + 2) * 64); }
    __syncthreads();
  }
  lsum = xsum32(lsum);
  const float inv = 1.0f / lsum;
#pragma unroll
  for (int n = 0; n < 2; ++n)
#pragma unroll
    for (int g = 0; g < 4; ++g) {
      u32x2 w; w.x = pack2(o[n][4 * g] * inv, o[n][4 * g + 1] * inv); w.y = pack2(o[n][4 * g + 2] * inv, o[n][4 * g + 3] * inv);
      *(u32x2*)(Ow + (size_t)r * o_ld + 32 * n + 8 * g + 4 * hh) = w;
    }
}

DI void scan_item(const Params& p, int l, int seq, int hd, int dir, int rs, char* smem) {
  const int tid = otid(), lane = tid & 63, wv = __builtin_amdgcn_readfirstlane(tid >> 6);
  const int j8 = lane & 7, r = lane & 31, hh = lane >> 5;
  const bool lat = seq >= 32;
  const int T = lat ? 4096 : 256;
  const int row0 = lat ? NCTX + (seq - 32) * 4096 : seq * 256;
  float* vA = (float*)smem; float* vK = vA + 2048; float* vR = vK + 2048; float* vV = vR + 2048; float* vW = vV + 2048; float* vB = vW + 2048; float* ybuf = vB + 2048;
  char* raw = smem + 32768;
  char* wdx = smem + 57344; char* adx = smem + 61952;
  float* tmpb = (float*)(smem + 66816);
  const bf16_t* U = (const bf16_t*)(p.ws + OFF_U);
  bf16_t* Y = (bf16_t*)(p.ws + OFF_R2) + (dir ? (size_t)NT * 512 : 0);
  float* bonus = (float*)(p.ws + OFF_BONUS);
  const int lrow = 8 * wv + (lane >> 3), irow = rs * 32 + lrow;
  f32x2 S[4];
  if (lat) {
    const float* s0 = (dir ? opq(p.in[I_SB]) : opq(p.in[I_SF])) + ((size_t)((seq - 32) * 4 + l) * 8 + hd) * 4096 + irow * 64 + j8 * 8;
#pragma unroll
    for (int q = 0; q < 2; ++q) { const f32x4 v = *(const f32x4*)(s0 + 4 * q); S[2 * q] = (f32x2){v.x, v.y}; S[2 * q + 1] = (f32x2){v.z, v.w}; }
  } else {
#pragma unroll
    for (int q = 0; q < 4; ++q) S[q] = (f32x2){0.f, 0.f};
  }
  const int mat = wv >> 1, ntc = wv & 1, cch = ntc * 32 + r, hc = hd * 64 + cch;
  bf16x8 bfrag[4];
  {
    const float* W = (mat ? opq(p.in[I_AUP]) : opq(p.in[I_WUP])) + (size_t)(l * 2 + dir) * 64 * 512 + hc;
#pragma unroll
    for (int s4 = 0; s4 < 4; ++s4) {
      float w8[8];
#pragma unroll
      for (int j = 0; j < 8; ++j) w8[j] = W[(size_t)(16 * s4 + 8 * hh + j) * 512];
      bfrag[s4] = __builtin_bit_cast(bf16x8, pack8(w8));
    }
  }
  const float bias = (mat ? opq(p.in[I_A0]) : opq(p.in[I_W0]))[(l * 2 + dir) * 512 + hc];
  const float kav = p.in[I_KA][l * 512 + hc], rkv = p.in[I_RK][l * 512 + hc];
  float* muP = (float*)(smem + 75008); float* muN = muP + 320; float* kkL = muN + 320;
  {
    const float* mup = p.in[I_MUP] + l * 1792; const float* mun = p.in[I_MUN] + l * 1792;
    for (int e = tid; e < 320; e += 256) { const int g = e >> 6, c = e & 63; const int col = (g < 3 ? g * 512 + hd * 64 : (g == 3 ? 1536 + dir * 64 : 1664 + dir * 64)) + c; muP[e] = mup[col]; muN[e] = mun[col]; }
    if (tid < 64) kkL[tid] = p.in[I_KK][l * 512 + hd * 64 + tid];
  }
  const int nch = T >> 5;
  u32x4 pre[6];
  auto prefetch = [&](int t0) {
#pragma unroll
    for (int q = 0; q < 6; ++q) {
      const int id = q * 256 + tid;
      const int row = id / 40, cc = id - row * 40, g = cc >> 3, c8 = cc & 7;
      const int t = t0 - 1 + row;
      const int col = (g < 3 ? g * 512 + hd * 64 : (g == 3 ? 1536 + dir * 64 : 1664 + dir * 64)) + c8 * 8;
      u32x4 v = (u32x4){0u, 0u, 0u, 0u};
      if (id < 1360 && t >= 0 && t < T) v = *(const u32x4*)(U + (size_t)(row0 + t) * ULD + 1696 + col);
      pre[q] = v;
    }
  };
  prefetch((dir ? nch - 1 : 0) * 32);
  for (int ci = 0; ci < nch; ++ci) {
    const int t0 = (dir ? nch - 1 - ci : ci) * 32;
#pragma unroll
    for (int q = 0; q < 6; ++q) { const int id = q * 256 + tid; if (id < 1360) *(u32x4*)(raw + id * 16) = pre[q]; }
    __syncthreads();
    if (ci + 1 < nch) prefetch((dir ? nch - 2 - ci : ci + 1) * 32);
    {
      const int tt = tid >> 3, sub = tid & 7;
#pragma unroll 1
      for (int g = 0; g < 5; ++g) {
        const int col = (g < 3 ? g * 512 + hd * 64 : (g == 3 ? 1536 + dir * 64 : 1664 + dir * 64)) + sub * 8;
        float c[8], pv[8], nx[8], x[8];
        unpack8(*(const u32x4*)(raw + (tt + 1) * 640 + (g * 8 + sub) * 16), c);
        unpack8(*(const u32x4*)(raw + tt * 640 + (g * 8 + sub) * 16), pv);
        unpack8(*(const u32x4*)(raw + (tt + 2) * 640 + (g * 8 + sub) * 16), nx);
        const f32x4 mp0 = *(const f32x4*)(muP + g * 64 + sub * 8), mp1 = *(const f32x4*)(muP + g * 64 + sub * 8 + 4), mn0 = *(const f32x4*)(muN + g * 64 + sub * 8), mn1 = *(const f32x4*)(muN + g * 64 + sub * 8 + 4);
        const float mp[8] = {mp0.x, mp0.y, mp0.z, mp0.w, mp1.x, mp1.y, mp1.z, mp1.w}, mn[8] = {mn0.x, mn0.y, mn0.z, mn0.w, mn1.x, mn1.y, mn1.z, mn1.w};
#pragma unroll
        for (int i = 0; i < 8; ++i) x[i] = c[i] + mp[i] * (pv[i] - c[i]) + mn[i] * (nx[i] - c[i]);
        const int lo = tt * 64 + sub * 8;
        if (g == 0) { *(f32x4*)(vR + lo) = (f32x4){x[0], x[1], x[2], x[3]}; *(f32x4*)(vR + lo + 4) = (f32x4){x[4], x[5], x[6], x[7]}; }
        else if (g == 1) {
          float kk[8], ss = 0.f;
          const float* kkw = kkL + sub * 8;
#pragma unroll
          for (int i = 0; i < 8; ++i) { kk[i] = x[i] * kkw[i]; ss += kk[i] * kk[i]; }
          *(f32x4*)(vK + lo) = (f32x4){x[0], x[1], x[2], x[3]}; *(f32x4*)(vK + lo + 4) = (f32x4){x[4], x[5], x[6], x[7]};
          ss += shx<1>(ss); ss += shx<2>(ss); ss += shx<4>(ss);
          const float inv = 1.0f / fmaxf(sqrtf(ss), 1e-12f);
          *(f32x4*)(vA + lo) = (f32x4){kk[0] * inv, kk[1] * inv, kk[2] * inv, kk[3] * inv}; *(f32x4*)(vA + lo + 4) = (f32x4){kk[4] * inv, kk[5] * inv, kk[6] * inv, kk[7] * inv};
        }
        else if (g == 2) { *(f32x4*)(vV + lo) = (f32x4){x[0], x[1], x[2], x[3]}; *(f32x4*)(vV + lo + 4) = (f32x4){x[4], x[5], x[6], x[7]}; }
        else if (g == 3) { float th[8]; for (int i = 0; i < 8; ++i) th[i] = 1.0f - 2.0f / (1.0f + __expf(2.0f * x[i])); *(u32x4*)(wdx + tt * 144 + sub * 16) = pack8(th); }
        else { *(u32x4*)(adx + tt * 144 + sub * 16) = pack8(x); }
      }
    }
    __syncthreads();
    {
      f32x16 acc;
#pragma unroll
      for (int e = 0; e < 16; ++e) acc[e] = 0.f;
      const char* xb = mat ? adx : wdx;
#pragma unroll
      for (int s4 = 0; s4 < 4; ++s4) { const bf16x8 af = *(const bf16x8*)(xb + r * 144 + (16 * s4 + 8 * hh) * 2); acc = MFMA32(af, bfrag[s4], acc); }
      if (mat == 0) {
#pragma unroll
        for (int e = 0; e < 16; ++e) vW[crow(e, hh) * 64 + cch] = __expf(-0.6065306597126334f * sigmoidf_(bias + acc[e]));
      } else {
#pragma unroll
        for (int e = 0; e < 16; ++e) {
          const int ix = crow(e, hh) * 64 + cch;
          const float ag = sigmoidf_(bias + acc[e]);
          const float kk = vA[ix], k = vK[ix], rr = vR[ix];
          const float kd = k * (1.0f + (ag - 1.0f) * kav);
          vK[ix] = kd; vA[ix] = -kk; vB[ix] = kk * ag; tmpb[ix] = rr * kd * rkv;
        }
      }
    }
    __syncthreads();
    {
      const int tt = tid >> 3, sub = tid & 7;
      const f32x4 b0 = *(const f32x4*)(tmpb + tt * 64 + sub * 8), b1 = *(const f32x4*)(tmpb + tt * 64 + sub * 8 + 4);
      float bs = (b0.x + b0.y) + (b0.z + b0.w) + (b1.x + b1.y) + (b1.z + b1.w);
      bs += shx<1>(bs); bs += shx<2>(bs); bs += shx<4>(bs);
      if (sub == 0 && rs == 0) bonus[((size_t)(row0 + t0 + tt) * 8 + hd) * 2 + dir] = bs;
    }
    {
      f32x4 va[2], vw[2], vb[2], vk[2], vr[2]; float vi;
      int tt = dir ? 31 : 0;
      int vo = tt * 64 + j8 * 8;
#pragma unroll
      for (int q = 0; q < 2; ++q) { va[q] = *(const f32x4*)(vA + vo + 4 * q); vw[q] = *(const f32x4*)(vW + vo + 4 * q); vb[q] = *(const f32x4*)(vB + vo + 4 * q); vk[q] = *(const f32x4*)(vK + vo + 4 * q); vr[q] = *(const f32x4*)(vR + vo + 4 * q); }
      vi = vV[tt * 64 + irow];
      for (int si = 0; si < 32; ++si) {
        const int ttn = dir ? (si < 31 ? 30 - si : 0) : (si < 31 ? si + 1 : 31);
        const int von = ttn * 64 + j8 * 8;
        f32x2 pa2 = S[0] * (f32x2){va[0].x, va[0].y}, pa3 = S[1] * (f32x2){va[0].z, va[0].w};
        pa2 += S[2] * (f32x2){va[1].x, va[1].y}; pa3 += S[3] * (f32x2){va[1].z, va[1].w};
#pragma unroll
        for (int q = 0; q < 2; ++q) va[q] = *(const f32x4*)(vA + von + 4 * q);
        pa2 += pa3;
        const float sa = osum(pa2.x + pa2.y);
        const f32x2 sa2 = (f32x2){sa, sa}, vi2 = (f32x2){vi, vi};
        f32x2 py2, py3;
        S[0] = S[0] * (f32x2){vw[0].x, vw[0].y} + (sa2 * (f32x2){vb[0].x, vb[0].y} + vi2 * (f32x2){vk[0].x, vk[0].y}); py2 = S[0] * (f32x2){vr[0].x, vr[0].y};
        S[1] = S[1] * (f32x2){vw[0].z, vw[0].w} + (sa2 * (f32x2){vb[0].z, vb[0].w} + vi2 * (f32x2){vk[0].z, vk[0].w}); py3 = S[1] * (f32x2){vr[0].z, vr[0].w};
        S[2] = S[2] * (f32x2){vw[1].x, vw[1].y} + (sa2 * (f32x2){vb[1].x, vb[1].y} + vi2 * (f32x2){vk[1].x, vk[1].y}); py2 += S[2] * (f32x2){vr[1].x, vr[1].y};
        S[3] = S[3] * (f32x2){vw[1].z, vw[1].w} + (sa2 * (f32x2){vb[1].z, vb[1].w} + vi2 * (f32x2){vk[1].z, vk[1].w}); py3 += S[3] * (f32x2){vr[1].z, vr[1].w};
#pragma unroll
        for (int q = 0; q < 2; ++q) { vw[q] = *(const f32x4*)(vW + von + 4 * q); vb[q] = *(const f32x4*)(vB + von + 4 * q); vk[q] = *(const f32x4*)(vK + von + 4 * q); vr[q] = *(const f32x4*)(vR + von + 4 * q); }
        vi = vV[ttn * 64 + irow];
        py2 += py3;
        const float py = osum(py2.x + py2.y);
        if (j8 == 0) ybuf[tt * 32 + lrow] = py;
        tt = ttn;
      }
    }
    __syncthreads();
    {
      const int tt = tid >> 3, sub = tid & 7;
      const f32x4 y0 = *(const f32x4*)(ybuf + tt * 32 + sub * 4);
      u32x2 w; w.x = pack2(y0.x, y0.y); w.y = pack2(y0.z, y0.w);
      *(u32x2*)(Y + (size_t)(row0 + t0 + tt) * 512 + hd * 64 + rs * 32 + sub * 4) = w;
    }
    __syncthreads();
  }
  if (!lat) {
    float* o = opq(p.out) + (dir ? OUT_SB : OUT_SF) + ((size_t)(seq * 4 + l) * 8 + hd) * 4096 + irow * 64 + j8 * 8;
#pragma unroll
    for (int q = 0; q < 2; ++q) *(f32x4*)(o + 4 * q) = (f32x4){S[2 * q].x, S[2 * q].y, S[2 * q + 1].x, S[2 * q + 1].y};
  }
}

DI void phase_mixers(const Params& p, int l, char* smem, int part = 0) {
  const int tid = otid(), wid = __builtin_amdgcn_readfirstlane(tid >> 6);
  unsigned* cnt = (unsigned*)(p.ws + OFF_CNT) + l * 8;
  int* slot = (int*)(smem + SMEM_BYTES - 16);
  bf16_t* U = (bf16_t*)(p.ws + OFF_U);
  const bf16_t* KA = (const bf16_t*)(p.ws + OFF_KA); const bf16_t* VAT = (const bf16_t*)(p.ws + OFF_VAT);
  const bf16_t* KN = (const bf16_t*)(p.ws + OFF_KN); const bf16_t* VBT = (const bf16_t*)(p.ws + OFF_VBT); const bf16_t* KRB = (const bf16_t*)(p.ws + OFF_KRB);
  const int QLEN = 256 + 256 + 128 + 64 + 64;
  bool first = true;
  int xq = blockIdx.x & 7, tries = 0;
  for (;;) {
    int kind, seq, a, qt;
    if (first && blockIdx.x < 256) {
      const int item = blockIdx.x; kind = 0; seq = 32 + (item >> 5); a = (item >> 2) & 7; qt = item & 3;
      first = false;
    } else {
      first = false;
      if (tid == 0) *slot = (int)atomicAdd(cnt + xq, 1u);
      __syncthreads();
      const int i = __builtin_amdgcn_readfirstlane(*slot);
      __syncthreads();
      if (i >= QLEN) { if (++tries >= 8) break; xq = (xq + 1) & 7; continue; }
      if (i < 256) { const int g = xq + 8 * (i >> 7); kind = 1; seq = 32 + (g >> 1); a = g & 1; qt = i & 127; }
      else if (i < 512) { const int j = i - 256; const int g = xq + 8 * (j >> 5); kind = 2; seq = 32 + (g >> 3); a = g & 7; qt = j & 31; }
      else if (i < 640) { const int j = i - 512; kind = 0; seq = xq + 8 * (j >> 5); a = (j >> 2) & 7; qt = j & 3; }
      else if (i < 704) { const int j = i - 640; kind = 1; seq = xq + 8 * (j >> 4); a = (j >> 3) & 1; qt = j & 7; }
      else { const int j = i - 704; kind = 2; seq = xq + 8 * (j >> 4); a = (j >> 1) & 7; qt = j & 1; }
    }
    const int kr0 = keyrow0(seq), Tk = seq_tk(seq);
    const int row0 = seq < 32 ? seq * 256 : NCTX + (seq - 32) * 4096;
    if (kind == 0) scan_item(p, l, seq, a, qt & 1, qt >> 1, smem);
    else if (kind == 1) {
      const int qh = a * 4 + wid;
      bf16_t* q = U + (size_t)(row0 + qt * 32) * ULD + qh * 64;
      attn_item<64>(q, ULD, KA + (size_t)kr0 * 128 + a * 64, 128, nullptr, 0, VAT + (size_t)128 * kr0 + (size_t)(a * 64) * Tk, Tk, Tk, q, ULD, smem);
    } else {
      bf16_t* q = U + (size_t)(row0 + qt * 128 + wid * 32) * ULD + 768 + a * 96;
      attn_item<96>(q, ULD, KN + (size_t)kr0 * 512 + a * 64, 512, KRB + (size_t)kr0 * 32, 32, VBT + (size_t)512 * kr0 + (size_t)(a * 64) * Tk, Tk, Tk, q, ULD, smem);
    }
  }
}

DI void cpost_row(const Params& p, int l, int row, int lane) {
  int seq, t; row_decode(row, seq, t);
  const int T = seq < 32 ? 256 : 4096;
  const bf16_t* YF = (const bf16_t*)(p.ws + OFF_R2); const bf16_t* YB = YF + (size_t)NT * 512;
  bf16_t* u = (bf16_t*)(p.ws + OFF_U) + (size_t)row * ULD + 1696;
  const float* bonus = (const float*)(p.ws + OFF_BONUS);
  float yf[8], yb[8], y[8];
  unpack8(*(const u32x4*)(YF + (size_t)row * 512 + lane * 8), yf);
  unpack8(*(const u32x4*)(YB + (size_t)row * 512 + lane * 8), yb);
  float s = 0.f;
#pragma unroll
  for (int i = 0; i < 8; ++i) { y[i] = yf[i] + yb[i]; s += y[i]; }
  s += shx<1>(s); s += shx<2>(s); s += shx<4>(s);
  const float mu = s * (1.0f / 64.0f);
  float q = 0.f;
#pragma unroll
  for (int i = 0; i < 8; ++i) { y[i] -= mu; q += y[i] * y[i]; }
  q += shx<1>(q); q += shx<2>(q); q += shx<4>(q);
  const float rs = rsqrtf(q * (1.0f / 64.0f) + 64e-5f);
  const int col = 1024 + lane * 8;
  float c[8], pv[8], nx[8];
  unpack8(*(const u32x4*)(u + col), c);
  if (t > 0) unpack8(*(const u32x4*)(u - ULD + col), pv); else { for (int i = 0; i < 8; ++i) pv[i] = 0.f; }
  if (t < T - 1) unpack8(*(const u32x4*)(u + ULD + col), nx); else { for (int i = 0; i < 8; ++i) nx[i] = 0.f; }
  const float* mup = p.in[I_MUP] + l * 1792 + col; const float* mun = p.in[I_MUN] + l * 1792 + col;
  const float* lw = p.in[I_LNW] + l * 512 + lane * 8; const float* lb = p.in[I_LNB] + l * 512 + lane * 8;
  const f32x2 bsv = *(const f32x2*)(bonus + ((size_t)row * 8 + (lane >> 3)) * 2);
  const float bs = bsv.x + bsv.y;
  float o[8];
#pragma unroll
  for (int i = 0; i < 8; ++i) { const float v = c[i] + mup[i] * (pv[i] - c[i]) + mun[i] * (nx[i] - c[i]); o[i] = y[i] * rs * lw[i] + lb[i] + bs * v; }
  *(u32x4*)(u + lane * 8) = pack8(o);
}
DI void phase_renorm_cpost(const Params& p, int l) {
  const int lane = otid() & 63, wid = __builtin_amdgcn_readfirstlane(otid() >> 6);
  for (int item = blockIdx.x; item < NT / 4; item += gridDim.x) { const int row = item * 4 + wid; norm_row(p, l, row, lane); cpost_row(p, l, row, lane); }
}

DI void phase_zgemm(const Params& p, char* smem) {
  const bf16_t* H = (const bf16_t*)(p.ws + OFF_R1);
  const bf16_t* W = (const bf16_t*)(p.ws + OFF_WIN) + (size_t)3584 * 1024;
  bf16_t* U = (bf16_t*)(p.ws + OFF_U);
  const int ntiles = 320 * 12;
  for (int tile = blockIdx.x; tile < ntiles; tile += gridDim.x) {
    const int mt = tile / 12, nt = tile % 12, m0 = mt * 128, n0 = nt * 128;
    f32x16 acc[2][2]; zero_acc<2>(acc);
    gemm_mainloop<2>(acc, H + (size_t)m0 * 1024, 1024, 64, W + (size_t)n0 * 1024, 1024, 1024, smem);
    const int lane = otid() & 63, wid = __builtin_amdgcn_readfirstlane(otid() >> 6), wm = wid >> 1, wn = wid & 1, r = lane & 31, hh = lane >> 5;
#pragma unroll
    for (int j = 0; j < 2; ++j) {
      const int col = n0 + wn * 64 + j * 32 + r;
      const int br = col >> 9, cc = col & 511;
      const int ucol = br == 0 ? cc : (br == 1 ? 768 + (cc >> 6) * 96 + (cc & 63) : 1696 + cc);
#pragma unroll
      for (int i = 0; i < 2; ++i) {
        bf16_t* up = U + (size_t)(m0 + wm * 64 + i * 32) * ULD;
        const int lo = 4 * hh * ULD + ucol;
        bf16_t yv[16];
#pragma unroll
        for (int e = 0; e < 16; ++e) yv[e] = (up + crowu(e) * ULD)[lo];
#pragma unroll
        for (int e = 0; e < 16; ++e) (up + crowu(e) * ULD)[lo] = f2bf(bf2f(yv[e]) * siluf_(acc[i][j][e]));
      }
    }
  }
}

DI void phase_merge(const Params& p, char* smem) {
  const bf16_t* H = (const bf16_t*)(p.ws + OFF_R1);
  const bf16_t* WG = (const bf16_t*)(p.ws + OFF_WIN) + (size_t)5120 * 1024;
  const bf16_t* WO = (const bf16_t*)(p.ws + OFF_WO);
  const bf16_t* U = (const bf16_t*)(p.ws + OFF_U);
  bf16_t* MX = (bf16_t*)(p.ws + OFF_R2);
  const int ntiles = 320 * 8;
  for (int tile = blockIdx.x; tile < ntiles; tile += gridDim.x) {
    const int mt = tile >> 3, nt = tile & 7, m0 = mt * 128, n0 = nt * 128;
    f32x16 mix[2][2]; zero_acc<2>(mix);
    unsigned gs[2][2][8];
#pragma unroll 1
    for (int step = 0; step < 6; ++step) {
      const int br = step >> 1, isT = step & 1;
      const int acol = br == 0 ? 0 : (br == 1 ? 768 : 1696);
      const bf16_t* Ap = isT ? U + (size_t)m0 * ULD + acol : H + (size_t)m0 * 1024;
      const bf16_t* Bp = isT ? WO + (size_t)(br * 1024 + n0) * 512 : WG + (size_t)(br * 1024 + n0) * 1024;
      f32x16 cur[2][2]; zero_acc<2>(cur);
      gemm_mainloop<2>(cur, Ap, isT ? ULD : 1024, (isT && br == 1) ? 96 : 64, Bp, isT ? 512 : 1024, isT ? 512 : 1024, smem);
      if (isT) {
#pragma unroll
        for (int i = 0; i < 2; ++i)
#pragma unroll
          for (int j = 0; j < 2; ++j)
#pragma unroll
            for (int e = 0; e < 8; ++e) { mix[i][j][2 * e] += lo16(gs[i][j][e]) * cur[i][j][2 * e]; mix[i][j][2 * e + 1] += hi16(gs[i][j][e]) * cur[i][j][2 * e + 1]; }
      } else {
#pragma unroll
        for (int i = 0; i < 2; ++i)
#pragma unroll
          for (int j = 0; j < 2; ++j)
#pragma unroll
            for (int e = 0; e < 8; ++e) gs[i][j][e] = pack2(sigmoidf_(cur[i][j][2 * e]), sigmoidf_(cur[i][j][2 * e + 1]));
      }
    }
    const int lane = otid() & 63, wid = __builtin_amdgcn_readfirstlane(otid() >> 6), wm = wid >> 1, wn = wid & 1, r = lane & 31, hh = lane >> 5;
#pragma unroll
    for (int j = 0; j < 2; ++j) {
      const int col = n0 + wn * 64 + j * 32 + r;
#pragma unroll
      for (int i = 0; i < 2; ++i) {
        bf16_t* mp = MX + (size_t)(m0 + wm * 64 + i * 32) * 1024;
        const int lo = 4 * hh * 1024 + col;
#pragma unroll
        for (int e = 0; e < 16; ++e) (mp + crowu(e) * 1024)[lo] = f2bf(mix[i][j][e]);
      }
    }
  }
}

DI void phase_out(const Params& p, int l, char* smem) {
  const bf16_t* MX = (const bf16_t*)(p.ws + OFF_R2);
  const bf16_t* W = (const bf16_t*)(p.ws + OFF_WOUT);
  const int ntiles = 320 * 8;
  for (int tile = blockIdx.x; tile < ntiles; tile += gridDim.x) {
    const int mt = tile >> 3, nt = tile & 7, m0 = mt * 128, n0 = nt * 128;
    f32x16 acc[2][2]; zero_acc<2>(acc);
    gemm_mainloop<2>(acc, MX + (size_t)m0 * 1024, 1024, 64, W + (size_t)n0 * 1024, 1024, 1024, smem);
    const int lane = otid() & 63, wid = __builtin_amdgcn_readfirstlane(otid() >> 6), wm = wid >> 1, wn = wid & 1, r = lane & 31, hh = lane >> 5;
    const int jm = m0 < NCTX ? 0 : 1 + ((m0 - NCTX) >> 12);
    const float* gate = (const float*)(p.ws + OFF_MOD) + ((size_t)l * 9 + jm) * MODLD + 2048;
    const float* xsrc = x_row_ptr(p, l, m0);
#pragma unroll
    for (int j = 0; j < 2; ++j) {
      const int col = n0 + wn * 64 + j * 32 + r;
      const float gv = gate[col];
      const int lo = 4 * hh * 1024 + col;
#pragma unroll
      for (int i = 0; i < 2; ++i) {
        const float* xs = xsrc + (size_t)(wm * 64 + i * 32) * 1024;
        float* xo = p.out + (size_t)(m0 + wm * 64 + i * 32) * 1024;
        float xv[16];
#pragma unroll
        for (int e = 0; e < 16; ++e) xv[e] = (xs + crowu(e) * 1024)[lo];
#pragma unroll
        for (int e = 0; e < 16; ++e) (xo + crowu(e) * 1024)[lo] = xv[e] + gv * acc[i][j][e];
      }
    }
  }
}

DI void phase_final(const Params& p) {
  const int lane = otid() & 63, wid = __builtin_amdgcn_readfirstlane(otid() >> 6);
  const float* nw = p.in[I_FNW];
  for (int item = blockIdx.x; item < NT / 4; item += gridDim.x) {
    float* x = p.out + (size_t)(item * 4 + wid) * 1024;
    f32x4 v[4]; float ss = 0.f;
#pragma unroll
    for (int i = 0; i < 4; ++i) { v[i] = *(const f32x4*)(x + lane * 4 + 256 * i); ss += v[i].x * v[i].x + v[i].y * v[i].y + v[i].z * v[i].z + v[i].w * v[i].w; }
ss = wave_sum(ss);
    const float rs = rsqrtf(ss * (1.0f / 1024.0f) + 1e-6f);
#pragma unroll
    for (int i = 0; i < 4; ++i) { const f32x4 w = *(const f32x4*)(nw + lane * 4 + 256 * i); *(f32x4*)(x + lane * 4 + 256 * i) = (f32x4){v[i].x * rs * w.x, v[i].y * rs * w.y, v[i].z * rs * w.z, v[i].w * rs * w.w}; }
  }
}

constexpr int NPHASES = 1 + 4 * 9 + 1;
__global__ void __launch_bounds__(256, 2) fwd_kernel(Params p0) {
  __shared__ __attribute__((aligned(16))) char smem[SMEM_BYTES];
  cg::grid_group grid = cg::this_grid();
  const int ph_begin = p0.ph_begin, ph_end = p0.ph_end;
  for (int ph = ph_begin; ph < ph_end; ++ph) {
    auto kp = __builtin_amdgcn_kernarg_segment_ptr();
    asm volatile("" : "+s"(kp));
    typedef const __attribute__((address_space(4))) Params CParams;
    CParams* kpp = (CParams*)kp;
    Params p;
#pragma unroll
    for (int i = 0; i < 35; ++i) p.in[i] = kpp->in[i];
    p.out = kpp->out; p.ws = kpp->ws; p.ph_begin = ph_begin; p.ph_end = ph_end;
    if (ph == 0) phase_prologue(p, smem);
    else if (ph == NPHASES - 1) phase_final(p);
    else {
      const int l = (ph - 1) / 9, sp = (ph - 1) % 9;
#ifdef PROBE_SP
      if (sp == PROBE_SP) {
        switch (sp) {
          case 0: phase_norm_convert(p, l, smem); break;
          case 1: phase_gemm1(p, l, smem); break;
          case 3: phase_upproj(p, smem); break;
          case 5: phase_renorm_cpost(p, l); break;
          case 7: phase_merge(p, smem); break;
          default: break;
        }
        grid.sync();
      }
#endif
      switch (sp) {
        case 0: phase_norm_convert(p, l, smem); break;
        case 1: phase_gemm1(p, l, smem); break;
        case 2: phase_post(p, l); break;
        case 3: phase_upproj(p, smem); break;
        case 4: phase_mixers(p, l, smem); break;
        case 5: phase_renorm_cpost(p, l); break;
        case 6: phase_zgemm(p, smem); break;
        case 7: phase_merge(p, smem); break;
        default: phase_out(p, l, smem); break;
      }
    }
    if (ph + 1 < ph_end) grid.sync();
  }
}

extern "C" void kernel_launch(void* const* d_in, const int* in_sizes, int n_in, void* d_out, int out_size, void* d_ws, size_t ws_size, hipStream_t stream) {
  if (ws_size < WS_NEED || n_in < 35) { fprintf(stderr, "workspace too small: %zu < %zu\n", ws_size, WS_NEED); return; }
  static int grid_blocks = 0;
  if (!grid_blocks) {
    int dev = 0, cus = 0, per_cu = 0;
    hipGetDevice(&dev);
    hipDeviceGetAttribute(&cus, hipDeviceAttributeMultiprocessorCount, dev);
    hipOccupancyMaxActiveBlocksPerMultiprocessor(&per_cu, fwd_kernel, 256, 0);
    if (per_cu < 1) per_cu = 1;
    if (per_cu > 2) per_cu = 2;
    grid_blocks = cus * per_cu;
  }
  Params p{};
  for (int i = 0; i < 35; ++i) p.in[i] = (const float*)d_in[i];
  p.out = (float*)d_out; p.ws = (char*)d_ws;
#ifndef ONE_LAUNCH
  for (int ph = 0; ph < NPHASES; ++ph) {
    p.ph_begin = ph; p.ph_end = ph + 1;
    hipLaunchKernelGGL(fwd_kernel, dim3(grid_blocks), dim3(256), 0, stream, p);
  }
#else
  p.ph_begin = 0; p.ph_end = NPHASES;
  void* args[] = {&p};
  hipError_t e = hipLaunchCooperativeKernel((void*)fwd_kernel, dim3(grid_blocks), dim3(256), args, 0, stream);
  if (e != hipSuccess) fprintf(stderr, "cooperative launch failed: %s (grid %d)\n", hipGetErrorString(e), grid_blocks);
#endif
}
```

```cpp
#define ONE_LAUNCH 1
#include <hip/hip_runtime.h>
#include <hip/hip_cooperative_groups.h>
#include <stdint.h>
#include <stdio.h>
namespace cg = cooperative_groups;

typedef unsigned short bf16_t;
typedef short bf16x8 __attribute__((ext_vector_type(8)));
typedef float f32x16 __attribute__((ext_vector_type(16)));
typedef float f32x4 __attribute__((ext_vector_type(4)));
typedef float f32x2 __attribute__((ext_vector_type(2)));
typedef unsigned u32x4 __attribute__((ext_vector_type(4)));
typedef unsigned u32x2 __attribute__((ext_vector_type(2)));
#define DI __device__ __forceinline__
#define MFMA32(a, b, c) __builtin_amdgcn_mfma_f32_32x32x16_bf16((a), (b), (c), 0, 0, 0)

constexpr int NT = 40960;
constexpr int NCTX = 8192;
constexpr int NK = 45056;
constexpr int ULD = 3488;
constexpr int MODLD = 3072;
constexpr int SMEM_BYTES = 78848;

constexpr size_t OFF_WIN = 0;
constexpr size_t OFF_WO = 16777216;
constexpr size_t OFF_WOUT = 19922944;
constexpr size_t OFF_WU = 22020096;
constexpr size_t OFF_MOD = 22282240;
constexpr size_t OFF_BONUS = 22724608;
constexpr size_t OFF_CS16 = 25346048;
constexpr size_t OFF_CS8 = 25354240;
constexpr size_t OFF_CNT = 25358336;
constexpr size_t OFF_U = 25358592;
constexpr size_t OFF_R1 = 311095552;
constexpr size_t OFF_KA = OFF_R1;
constexpr size_t OFF_VAT = 513208576;
constexpr size_t OFF_KN = OFF_R1 + 23068672;
constexpr size_t OFF_VBT = OFF_R1 + 69206016;
constexpr size_t OFF_KRB = OFF_R1 + 115343360;
constexpr size_t OFF_R2 = 429322496;
constexpr size_t WS_NEED = 524742912;

constexpr size_t OUT_AK = 41943040, OUT_AV = 46137344, OUT_CKV = 50331648, OUT_KR = 54525952, OUT_SF = 55574528, OUT_SB = 59768832;

struct Params {
  const float* in[35];
  float* out;
  char* ws;
  int ph_begin, ph_end;
};

enum { I_XP = 0, I_XS, I_CAK, I_CAV, I_CCKV, I_CKR, I_SF, I_SB, I_C, I_CCTX, I_NORMW, I_WMOD, I_BMOD, I_WIN, I_QNW, I_KNW, I_KVNW,
       I_WUK, I_WUV, I_MUP, I_MUN, I_W0, I_WUP, I_A0, I_AUP, I_KK, I_KA, I_RK, I_LNW, I_LNB, I_WOA, I_WOB, I_WOC, I_WOUT, I_FNW };

DI int threadIdx_x_raw() { return __builtin_amdgcn_workitem_id_x(); }
DI int otid() { int t = threadIdx_x_raw(); asm volatile("" : "+v"(t)); return t; }
DI const float* opq(const float* q) { asm volatile("" : "+s"(q)); return q; }
DI float* opq(float* q) { asm volatile("" : "+s"(q)); return q; }
DI float bf2f(bf16_t v) { return __uint_as_float(((unsigned)v) << 16); }
typedef __bf16 hbf16x2 __attribute__((ext_vector_type(2)));
DI unsigned pack2(float a, float b) { f32x2 v = {a, b}; hbf16x2 r = __builtin_convertvector(v, hbf16x2); return __builtin_bit_cast(unsigned, r); }
DI bf16_t f2bf(float x) { return (bf16_t)(pack2(x, 0.f) & 0xffffu); }
DI float xsum16(float x) { const unsigned u = __float_as_uint(x); auto r = __builtin_amdgcn_permlane16_swap(u, u, false, false); return __uint_as_float(r[0]) + __uint_as_float(r[1]); }
DI float xsum32(float x) { const unsigned u = __float_as_uint(x); auto r = __builtin_amdgcn_permlane32_swap(u, u, false, false); return __uint_as_float(r[0]) + __uint_as_float(r[1]); }
DI float lo16(unsigned w) { return __uint_as_float(w << 16); }
DI float hi16(unsigned w) { return __uint_as_float(w & 0xffff0000u); }
DI void unpack8(u32x4 w, float* v) { v[0] = lo16(w.x); v[1] = hi16(w.x); v[2] = lo16(w.y); v[3] = hi16(w.y); v[4] = lo16(w.z); v[5] = hi16(w.z); v[6] = lo16(w.w); v[7] = hi16(w.w); }
DI u32x4 pack8(const float* v) { u32x4 w; w.x = pack2(v[0], v[1]); w.y = pack2(v[2], v[3]); w.z = pack2(v[4], v[5]); w.w = pack2(v[6], v[7]); return w; }
template <int K> DI float shx(float v) { return __int_as_float(__builtin_amdgcn_ds_swizzle(__float_as_int(v), 0x1f | (K << 10))); }
DI float wave_sum(float v) { v += shx<1>(v); v += shx<2>(v); v += shx<4>(v); v += shx<8>(v); v += shx<16>(v); return xsum32(v); }
DI float qsum(float v) {
  v += __int_as_float(__builtin_amdgcn_update_dpp(0, __float_as_int(v), 0xB1, 0xf, 0xf, true));
  v += __int_as_float(__builtin_amdgcn_update_dpp(0, __float_as_int(v), 0x4E, 0xf, 0xf, true));
  return v;
}
DI float osum(float v) {
  v = qsum(v);
  v += __int_as_float(__builtin_amdgcn_update_dpp(0, __float_as_int(v), 0x141, 0xf, 0xf, true));
  return v;
}
DI int crow(int reg, int h) { return (reg & 3) + 8 * (reg >> 2) + 4 * h; }
DI int crowu(int reg) { return (reg & 3) + 8 * (reg >> 2); }
DI int perm16(int t) { return (t & ~12) | ((t & 4) << 1) | ((t & 8) >> 1); }
DI float sigmoidf_(float x) { return __builtin_amdgcn_rcpf(1.0f + __expf(-x)); }
DI float siluf_(float x) { return x * __builtin_amdgcn_rcpf(1.0f + __expf(-x)); }

DI void row_decode(int row, int& seq, int& t) {
  if (row < NCTX) { seq = row >> 8; t = row & 255; } else { seq = 32 + ((row - NCTX) >> 12); t = (row - NCTX) & 4095; }
}
DI int keyrow0(int seq) { return seq < 32 ? seq * 256 : NCTX + (seq - 32) * 4608; }
DI int seq_tk(int seq) { return seq < 32 ? 256 : 4608; }

template <int NJ>
DI void gemm_mainloop(f32x16 (&acc)[2][NJ], const bf16_t* __restrict__ A, int lda, int ks,
                      const bf16_t* __restrict__ Bt, int ldb, int K, char* smem) {
  constexpr int A_BYTES = 128 * 128;
  constexpr int B_BYTES = 64 * NJ * 128;
  constexpr int STAGE = A_BYTES + B_BYTES;
  const int tid = otid(), lane = tid & 63, wid = __builtin_amdgcn_readfirstlane(tid >> 6), wm = wid >> 1, wn = wid & 1;
  const int r = lane & 31, hh = lane >> 5;
  const int nk = K >> 6;
  const int lrow = tid >> 3, lc = tid & 7;
  u32x4 ra[4], rb[2 * NJ];
  const bf16_t* ap = A + (size_t)lrow * lda + lc * 8;
  const bf16_t* bp = Bt + (size_t)lrow * ldb + lc * 8;
#pragma unroll
  for (int p = 0; p < 4; ++p) ra[p] = *(const u32x4*)(ap + (size_t)(32 * p) * lda);
#pragma unroll
  for (int p = 0; p < 2 * NJ; ++p) rb[p] = *(const u32x4*)(bp + (size_t)(32 * p) * ldb);
  {
    char* base = smem;
#pragma unroll
    for (int p = 0; p < 4; ++p) { const int row = lrow + 32 * p; *(u32x4*)(base + row * 128 + ((lc ^ ((row >> 1) & 7)) << 4)) = ra[p]; }
#pragma unroll
    for (int p = 0; p < 2 * NJ; ++p) { const int row = lrow + 32 * p; *(u32x4*)(base + A_BYTES + row * 128 + ((lc ^ ((row >> 1) & 7)) << 4)) = rb[p]; }
  }
  if (nk > 1) {
    const bf16_t* ap2 = ap + (size_t)ks;
    const bf16_t* bp2 = bp + (size_t)64;
#pragma unroll
    for (int p = 0; p < 4; ++p) ra[p] = *(const u32x4*)(ap2 + (size_t)(32 * p) * lda);
#pragma unroll
    for (int p = 0; p < 2 * NJ; ++p) rb[p] = *(const u32x4*)(bp2 + (size_t)(32 * p) * ldb);
  }
  __syncthreads();
  for (int kt = 0; kt < nk; ++kt) {
    const char* base = smem + (kt & 1) * STAGE;
#pragma unroll
    for (int s = 0; s < 4; ++s) {
      bf16x8 af[2], bfr[NJ];
#pragma unroll
      for (int i = 0; i < 2; ++i) { const int row = wm * 64 + i * 32 + r; af[i] = *(const bf16x8*)(base + row * 128 + (((2 * s + hh) ^ ((row >> 1) & 7)) << 4)); }
#pragma unroll
      for (int j = 0; j < NJ; ++j) { const int row = wn * (32 * NJ) + j * 32 + r; bfr[j] = *(const bf16x8*)(base + A_BYTES + row * 128 + (((2 * s + hh) ^ ((row >> 1) & 7)) << 4)); }
#pragma unroll
      for (int i = 0; i < 2; ++i)
#pragma unroll
        for (int j = 0; j < NJ; ++j) acc[i][j] = MFMA32(af[i], bfr[j], acc[i][j]);
    }
    if (kt + 1 < nk) {
      char* nb = smem + ((kt + 1) & 1) * STAGE;
#pragma unroll
      for (int p = 0; p < 4; ++p) { const int row = lrow + 32 * p; *(u32x4*)(nb + row * 128 + ((lc ^ ((row >> 1) & 7)) << 4)) = ra[p]; }
#pragma unroll
      for (int p = 0; p < 2 * NJ; ++p) { const int row = lrow + 32 * p; *(u32x4*)(nb + A_BYTES + row * 128 + ((lc ^ ((row >> 1) & 7)) << 4)) = rb[p]; }
      if (kt + 2 < nk) {
        const bf16_t* ap2 = ap + (size_t)(kt + 2) * ks;
        const bf16_t* bp2 = bp + (size_t)(kt + 2) * 64;
#pragma unroll
        for (int p = 0; p < 4; ++p) ra[p] = *(const u32x4*)(ap2 + (size_t)(32 * p) * lda);
#pragma unroll
        for (int p = 0; p < 2 * NJ; ++p) rb[p] = *(const u32x4*)(bp2 + (size_t)(32 * p) * ldb);
      }
    }
    __syncthreads();
  }
}

template <int NJ> DI void zero_acc(f32x16 (&acc)[2][NJ]) {
#pragma unroll
  for (int i = 0; i < 2; ++i)
#pragma unroll
    for (int j = 0; j < NJ; ++j)
#pragma unroll
      for (int e = 0; e < 16; ++e) acc[i][j][e] = 0.f;
}

DI void phase_prologue(const Params& p, char* smem) {
  const int tid = otid(), lane = tid & 63, wid = __builtin_amdgcn_readfirstlane(tid >> 6);
  float* mod = (float*)(p.ws + OFF_MOD);
  if (blockIdx.x == 0) {
    if (tid < 64) ((unsigned*)(p.ws + OFF_CNT))[tid] = 0u;
    float* cs16 = (float*)(p.ws + OFF_CS16);
    float* cs8 = (float*)(p.ws + OFF_CS8);
    for (int e = tid; e < 64 * 16; e += 256) { const int pos = e >> 4, i = e & 15; const float inv = expf(-9.210340371976184f * (float)i / 16.0f); const float a = (float)pos * inv; cs16[e * 2] = cosf(a); cs16[e * 2 + 1] = sinf(a); }
    for (int e = tid; e < 64 * 8; e += 256) { const int pos = e >> 3, i = e & 7; const float inv = expf(-9.210340371976184f * (float)i / 8.0f); const float a = (float)pos * inv; cs8[e * 2] = cosf(a); cs8[e * 2 + 1] = sinf(a); }
  }
  float* sl = (float*)smem;
  float* red = sl + 9 * 1024;
  for (int e = tid; e < 9 * 1024; e += 256) { const int j = e >> 10, k = e & 1023; const float* cc0 = opq(p.in[I_CCTX]); const float* cc1 = opq(p.in[I_C]); const float c = j == 0 ? cc0[k] : cc1[(j - 1) * 1024 + k]; sl[e] = siluf_(c); }
  __syncthreads();
  for (int item = blockIdx.x; item < 192; item += gridDim.x) {
    const int l = item / 48, n = (item % 48) * 64 + lane;
    const float* w = p.in[I_WMOD] + (size_t)l * 1024 * 3072 + n;
    float a[9];
#pragma unroll
    for (int j = 0; j < 9; ++j) a[j] = 0.f;
    for (int k = wid * 256; k < wid * 256 + 256; ++k) {
      const float wv = w[(size_t)k * 3072];
#pragma unroll
      for (int j = 0; j < 9; ++j) a[j] += sl[j * 1024 + k] * wv;
    }
#pragma unroll
    for (int j = 0; j < 9; ++j) red[(wid * 9 + j) * 64 + lane] = a[j];
    __syncthreads();
    for (int e = tid; e < 9 * 64; e += 256) {
      const int j = e >> 6, c = e & 63;
      const float s = red[(0 * 9 + j) * 64 + c] + red[(1 * 9 + j) * 64 + c] + red[(2 * 9 + j) * 64 + c] + red[(3 * 9 + j) * 64 + c];
      const int nn = (item % 48) * 64 + c;
      mod[((size_t)l * 9 + j) * MODLD + nn] = s + p.in[I_BMOD][l * 3072 + nn];
    }
    __syncthreads();
  }
}

DI const float* x_row_ptr(const Params& p, int l, int row) {
  const float* xp = opq(p.in[I_XP]); const float* xs = opq(p.in[I_XS]); const float* xo = opq((const float*)p.out);
  if (l == 0) return row < NCTX ? xp + (size_t)row * 1024 : xs + (size_t)(row - NCTX) * 1024;
  return xo + (size_t)row * 1024;
}
DI void norm_row(const Params& p, int l, int row, int lane) {
  const float* x = x_row_ptr(p, l, row);
  const int j = row < NCTX ? 0 : 1 + ((row - NCTX) >> 12);
  const float* mod = (const float*)(p.ws + OFF_MOD) + ((size_t)l * 9 + j) * MODLD;
  const float* nw = p.in[I_NORMW] + l * 1024;
  bf16_t* h = (bf16_t*)(p.ws + OFF_R1) + (size_t)row * 1024;
  f32x4 v[4]; float ss = 0.f;
#pragma unroll
  for (int i = 0; i < 4; ++i) { v[i] = *(const f32x4*)(x + lane * 4 + 256 * i); ss += v[i].x * v[i].x + v[i].y * v[i].y + v[i].z * v[i].z + v[i].w * v[i].w; }
ss = wave_sum(ss);
  const float rs = rsqrtf(ss * (1.0f / 1024.0f) + 1e-6f);
#pragma unroll
  for (int i = 0; i < 4; ++i) {
    const int c = lane * 4 + 256 * i;
    const f32x4 w = *(const f32x4*)(nw + c), sh = *(const f32x4*)(mod + c), sc = *(const f32x4*)(mod + 1024 + c);
    u32x2 o;
    o.x = pack2(v[i].x * rs * w.x * (1.f + sc.x) + sh.x, v[i].y * rs * w.y * (1.f + sc.y) + sh.y);
    o.y = pack2(v[i].z * rs * w.z * (1.f + sc.z) + sh.z, v[i].w * rs * w.w * (1.f + sc.w) + sh.w);
    *(u32x2*)(h + c) = o;
  }
}

DI int win_srccol(int j) {
  if (j < 768) return j;
  if (j < 1696) return j + 512;
  if (j < 3488) return j + 1024;
  if (j < 3584) return -1;
  if (j < 5120) { const int jj = j - 3584; return jj < 512 ? 768 + jj : (jj < 1024 ? 2208 + (jj - 512) : 4512 + (jj - 1024)); }
  return 5024 + (j - 5120);
}
DI void conv_tile(const float* __restrict__ src, int ld_src, bf16_t* dst, int ld_dst, int k0, int n0, int kind, int srcoff, char* smem) {
  float* tile = (float*)smem;
  const int tid = otid();
  const int n = tid & 63;
  int sc = kind == 0 ? win_srccol(n0 + n) : (n0 + n - srcoff);
#pragma unroll
  for (int i = 0; i < 16; ++i) { const int k = i * 4 + (tid >> 6); tile[k * 65 + n] = sc >= 0 ? src[(size_t)(k0 + k) * ld_src + sc] : 0.f; }
  __syncthreads();
#pragma unroll
  for (int i = 0; i < 8; ++i) { const int nn = i * 8 + (tid >> 5), kk = (tid & 31) * 2; *(unsigned*)(dst + (size_t)(n0 + nn) * ld_dst + k0 + kk) = pack2(tile[kk * 65 + nn], tile[(kk + 1) * 65 + nn]); }
  __syncthreads();
}

DI void phase_norm_convert(const Params& p, int l, char* smem) {
  const int tid = otid(), lane = tid & 63, wid = __builtin_amdgcn_readfirstlane(tid >> 6);
  bf16_t* WinT = (bf16_t*)(p.ws + OFF_WIN); bf16_t* WoT = (bf16_t*)(p.ws + OFF_WO); bf16_t* WoutT = (bf16_t*)(p.ws + OFF_WOUT); bf16_t* WuT = (bf16_t*)(p.ws + OFF_WU);
  const int NI_WIN = 128 * 16, NI_WO = 3 * 16 * 8, NI_WOUT = 16 * 16, NI_WU = 16 * 2;
  const int NI_CONV = NI_WIN + NI_WO + NI_WOUT + NI_WU;
  for (int item = blockIdx.x; item < NI_CONV; item += gridDim.x) {
    int it = item;
    if (it < NI_WIN) { conv_tile(p.in[I_WIN] + (size_t)l * 1024 * 8096, 8096, WinT, 1024, (it & 15) * 64, (it >> 4) * 64, 0, 0, smem); continue; }
    it -= NI_WIN;
    if (it < NI_WO) { const int br = it / 128, r2 = it % 128; const float* src = (br == 0 ? opq(p.in[I_WOA]) : (br == 1 ? opq(p.in[I_WOB]) : opq(p.in[I_WOC]))) + (size_t)l * 512 * 1024; conv_tile(src, 1024, WoT + (size_t)br * 1024 * 512, 512, (r2 & 7) * 64, (r2 >> 3) * 64, 1, 0, smem); continue; }
    it -= NI_WO;
    if (it < NI_WOUT) { conv_tile(p.in[I_WOUT] + (size_t)l * 1024 * 1024, 1024, WoutT, 1024, (it & 15) * 64, (it >> 4) * 64, 1, 0, smem); continue; }
    it -= NI_WOUT;
    { const int nt = it >> 1, kt = it & 1; const bool uv = nt >= 8; const float* src = (uv ? opq(p.in[I_WUV]) : opq(p.in[I_WUK])) + (size_t)l * 128 * 512; conv_tile(src, 512, WuT, 128, kt * 64, nt * 64, 1, uv ? 512 : 0, smem); }
  }
  for (int item = blockIdx.x; item < NT / 4; item += gridDim.x) norm_row(p, l, item * 4 + wid, lane);
}

DI void phase_gemm1(const Params& p, int l, char* smem) {
  const bf16_t* H = (const bf16_t*)(p.ws + OFF_R1);
  const bf16_t* W = (const bf16_t*)(p.ws + OFF_WIN);
  bf16_t* U = (bf16_t*)(p.ws + OFF_U);
  bf16_t* VAT = (bf16_t*)(p.ws + OFF_VAT);
  const int NTN = 28, ntiles = 320 * NTN;
  for (int tile = blockIdx.x; tile < ntiles; tile += gridDim.x) {
    const int mt = tile / NTN, nt = tile % NTN, m0 = mt * 128, n0 = nt * 128;
    f32x16 acc[2][2]; zero_acc<2>(acc);
    gemm_mainloop<2>(acc, H + (size_t)m0 * 1024, 1024, 64, W + (size_t)n0 * 1024, 1024, 1024, smem);
    const int lane = otid() & 63, wid = __builtin_amdgcn_readfirstlane(otid() >> 6), wm = wid >> 1, wn = wid & 1, r = lane & 31, hh = lane >> 5;
    int seq, t0; row_decode(m0, seq, t0);
#pragma unroll
    for (int j = 0; j < 2; ++j) {
      const int cb = n0 + wn * 64 + j * 32;
      if (cb >= ULD) continue;
      const int col = cb + r;
      if (cb >= 640 && cb < 768) {
        const int kvh = (col - 640) >> 6, dv = col & 63, Tk = seq_tk(seq);
        bf16_t* vt = VAT + (size_t)128 * keyrow0(seq) + (size_t)(kvh * 64 + dv) * Tk;
#pragma unroll
        for (int i = 0; i < 2; ++i) {
          const int tt = t0 + wm * 64 + i * 32;
#pragma unroll
          for (int g2 = 0; g2 < 2; ++g2) {
            float v[8];
#pragma unroll
            for (int e = 0; e < 8; ++e) v[e] = acc[i][j][g2 * 8 + e];
            *(u32x4*)(vt + tt + 16 * g2 + 8 * hh) = pack8(v);
          }
          if (seq < 32) {
            float* o = p.out + OUT_AV + ((size_t)(seq * 4 + l) * 256 + tt) * 128;
            const int lo = 4 * hh * 128 + (col - 640);
#pragma unroll
            for (int e = 0; e < 16; ++e) (o + crowu(e) * 128)[lo] = acc[i][j][e];
          }
        }
      } else {
#pragma unroll
        for (int i = 0; i < 2; ++i) {
          bf16_t* up = U + (size_t)(m0 + wm * 64 + i * 32) * ULD;
          const int lo = 4 * hh * ULD + col;
#pragma unroll
          for (int e = 0; e < 16; ++e) (up + crowu(e) * ULD)[lo] = f2bf(acc[i][j][e]);
        }
      }
    }
  }
}

DI void post_row(const Params& p, int l, int row, int lane) {
  int seq, t; row_decode(row, seq, t);
  const bool lat = row >= NCTX;
  const int krow = keyrow0(seq) + t;
  const int prow = t >> 6, pcol = t & 63;
  bf16_t* u = (bf16_t*)(p.ws + OFF_U) + (size_t)row * ULD;
  const float* cs16 = (const float*)(p.ws + OFF_CS16);
  const float* cs8 = (const float*)(p.ws + OFF_CS8);
  const float LOG2E = 1.4426950408889634f;
#pragma unroll
  for (int which = 0; which < 2; ++which) {
    const int l8 = which == 0 ? lane : (lane & 15);
    const bf16_t* src = u + (which == 0 ? 0 : 512) + l8 * 8;
    float v[8]; unpack8(*(const u32x4*)src, v);
    float ss = 0.f;
#pragma unroll
    for (int i = 0; i < 8; ++i) ss += v[i] * v[i];
    ss += shx<1>(ss); ss += shx<2>(ss); ss += shx<4>(ss);
    const float rs = rsqrtf(ss * (1.0f / 64.0f) + 1e-6f);
    const float* nw = (which == 0 ? opq(p.in[I_QNW]) : opq(p.in[I_KNW])) + l * 64 + (lane & 7) * 8;
#pragma unroll
    for (int i = 0; i < 8; ++i) v[i] = v[i] * rs * nw[i];
    float pv[8];
#pragma unroll
    for (int i = 0; i < 8; ++i) pv[i] = shx<2>(v[i]);
    if (lat) {
      const int pos = ((lane & 7) >> 2) ? pcol : prow;
      const bool lower = (lane & 2) == 0;
      const float* cs = cs16 + (pos * 16 + (lane & 1) * 8) * 2;
#pragma unroll
      for (int i = 0; i < 8; ++i) { const float c = cs[i * 2], s = cs[i * 2 + 1]; v[i] = lower ? v[i] * c - pv[i] * s : v[i] * c + pv[i] * s; }
    }
    if (which == 0) {
      const float sc = 0.125f * LOG2E;
#pragma unroll
      for (int i = 0; i < 8; ++i) v[i] *= sc;
      *(u32x4*)(u + lane * 8) = pack8(v);
    } else if (lane < 16) {
      bf16_t* KA = (bf16_t*)(p.ws + OFF_KA);
      *(u32x4*)(KA + (size_t)krow * 128 + lane * 8) = pack8(v);
      if (!lat) {
        float* o = p.out + OUT_AK + ((size_t)(seq * 4 + l) * 256 + t) * 128 + lane * 8;
        *(f32x4*)o = (f32x4){v[0], v[1], v[2], v[3]}; *(f32x4*)(o + 4) = (f32x4){v[4], v[5], v[6], v[7]};
      }
    }
  }
  {
    const float sc = 0.10206207261596577f * LOG2E;
    const int hd = lane >> 3;
    bf16_t* q = u + 768 + hd * 96;
    { float v[8]; unpack8(*(const u32x4*)(q + (lane & 7) * 8), v);
#pragma unroll
      for (int i = 0; i < 8; ++i) v[i] *= sc;
      *(u32x4*)(q + (lane & 7) * 8) = pack8(v); }
    { bf16_t* qr = q + 64 + (lane & 7) * 4;
      const u32x2 w = *(const u32x2*)qr;
      float v[4] = {lo16(w.x), hi16(w.x), lo16(w.y), hi16(w.y)}, pv[4];
#pragma unroll
      for (int i = 0; i < 4; ++i) pv[i] = shx<2>(v[i]);
      if (lat) {
        const int pos = ((lane & 7) >> 2) ? pcol : prow;
        const bool lower = (lane & 2) == 0;
        const float* cs = cs8 + (pos * 8 + (lane & 1) * 4) * 2;
#pragma unroll
        for (int i = 0; i < 4; ++i) { const float c = cs[i * 2], s = cs[i * 2 + 1]; v[i] = lower ? v[i] * c - pv[i] * s : v[i] * c + pv[i] * s; }
      }
      u32x2 o; o.x = pack2(v[0] * sc, v[1] * sc); o.y = pack2(v[2] * sc, v[3] * sc);
      *(u32x2*)qr = o; }
  }
  {
    const unsigned w = *(const unsigned*)(u + 1536 + lane * 2);
    float a = lo16(w), b = hi16(w);
    float ss = a * a + b * b;
ss = wave_sum(ss);
    const float rs = rsqrtf(ss * (1.0f / 128.0f) + 1e-6f);
    const float* nw = p.in[I_KVNW] + l * 128 + lane * 2;
    a = a * rs * nw[0]; b = b * rs * nw[1];
    bf16_t* CKVN = (bf16_t*)(p.ws + OFF_R2);
    *(unsigned*)(CKVN + (size_t)krow * 128 + lane * 2) = pack2(a, b);
    if (!lat) { float* o = p.out + OUT_CKV + ((size_t)(seq * 4 + l) * 256 + t) * 128 + lane * 2; *(f32x2*)o = (f32x2){a, b}; }
  }
  {
    float v = bf2f(u[1664 + (lane & 31)]);
    const float pv = shx<8>(v);
    if (!lat) { if (lane < 32) p.out[OUT_KR + ((size_t)(seq * 4 + l) * 256 + t) * 32 + lane] = v; }
    else {
      const int d = lane & 31; const int pos = (d >> 4) ? pcol : prow; const bool lower = (d & 8) == 0;
      const float* cs = cs8 + (pos * 8 + (d & 7)) * 2;
      v = lower ? v * cs[0] - pv * cs[1] : v * cs[0] + pv * cs[1];
    }
    if (lane < 32) ((bf16_t*)(p.ws + OFF_KRB))[(size_t)krow * 32 + lane] = f2bf(v);
  }
}
DI void post_cached_row(const Params& p, int l, int idx, int lane) {
  const int b = idx >> 9, j = idx & 511;
  const int kr0 = NCTX + b * 4608, krow = kr0 + 4096 + j;
  const size_t cb = ((size_t)(b * 4 + l) * 512 + j);
  bf16_t* KA = (bf16_t*)(p.ws + OFF_KA); bf16_t* VAT = (bf16_t*)(p.ws + OFF_VAT); bf16_t* CKVN = (bf16_t*)(p.ws + OFF_R2); bf16_t* KRB = (bf16_t*)(p.ws + OFF_KRB);
  { const f32x2 v = *(const f32x2*)(p.in[I_CAK] + cb * 128 + lane * 2); *(unsigned*)(KA + (size_t)krow * 128 + lane * 2) = pack2(v.x, v.y); }
  { const f32x2 v = *(const f32x2*)(p.in[I_CAV] + cb * 128 + lane * 2);
    bf16_t* vt = VAT + (size_t)128 * kr0 + (size_t)(lane * 2) * 4608 + perm16(4096 + j);
    vt[0] = f2bf(v.x); vt[4608] = f2bf(v.y); }
  { const f32x2 v = *(const f32x2*)(p.in[I_CCKV] + cb * 128 + lane * 2); *(unsigned*)(CKVN + (size_t)krow * 128 + lane * 2) = pack2(v.x, v.y); }
  if (lane < 32) KRB[(size_t)krow * 32 + lane] = f2bf(p.in[I_CKR][cb * 32 + lane]);
}
DI void phase_post(const Params& p, int l) {
  const int lane = otid() & 63, wid = __builtin_amdgcn_readfirstlane(otid() >> 6);
  for (int item = blockIdx.x; item < NT / 4 + 1024; item += gridDim.x) {
    if (item < NT / 4) post_row(p, l, item * 4 + wid, lane);
    else post_cached_row(p, l, (item - NT / 4) * 4 + wid, lane);
  }
}

DI void phase_upproj(const Params& p, char* smem) {
  const bf16_t* A = (const bf16_t*)(p.ws + OFF_R2);
  const bf16_t* W = (const bf16_t*)(p.ws + OFF_WU);
  bf16_t* KN = (bf16_t*)(p.ws + OFF_KN); bf16_t* VBT = (bf16_t*)(p.ws + OFF_VBT);
  const int ntiles = 352 * 8;
  for (int tile = blockIdx.x; tile < ntiles; tile += gridDim.x) {
    const int mt = tile >> 3, nt = tile & 7, m0 = mt * 128, n0 = nt * 128;
    f32x16 acc[2][2]; zero_acc<2>(acc);
    gemm_mainloop<2>(acc, A + (size_t)m0 * 128, 128, 64, W + (size_t)n0 * 128, 128, 128, smem);
    const int lane = otid() & 63, wid = __builtin_amdgcn_readfirstlane(otid() >> 6), wm = wid >> 1, wn = wid & 1, r = lane & 31, hh = lane >> 5;
    int seq, t0;
    if (m0 < NCTX) { seq = m0 >> 8; t0 = m0 & 255; } else { const int rr = m0 - NCTX; seq = 32 + rr / 4608; t0 = rr % 4608; }
#pragma unroll
    for (int j = 0; j < 2; ++j) {
      const int col = n0 + wn * 64 + j * 32 + r;
      if (n0 < 512) {
#pragma unroll
        for (int i = 0; i < 2; ++i) {
          bf16_t* kp = KN + (size_t)(m0 + wm * 64 + i * 32) * 512;
          const int lo = 4 * hh * 512 + col;
#pragma unroll
          for (int e = 0; e < 16; ++e) (kp + crowu(e) * 512)[lo] = f2bf(acc[i][j][e]);
        }
      } else {
        const int Tk = seq_tk(seq);
        bf16_t* vt = VBT + (size_t)512 * keyrow0(seq) + (size_t)(col - 512) * Tk;
#pragma unroll
        for (int i = 0; i < 2; ++i) {
          const int tt = t0 + wm * 64 + i * 32;
#pragma unroll
          for (int g2 = 0; g2 < 2; ++g2) {
            float v[8];
#pragma unroll
            for (int e = 0; e < 8; ++e) v[e] = acc[i][j][g2 * 8 + e];
            *(u32x4*)(vt + tt + 16 * g2 + 8 * hh) = pack8(v);
          }
        }
      }
    }
  }
}

template <int DQK>
DI void attn_item(const bf16_t* Qw, int q_ld, const bf16_t* K1, int k1_ld, const bf16_t* K2, int k2_ld,
                  const bf16_t* Vt, int vt_ld, int nkeys, bf16_t* Ow, int o_ld, char* smem) {
  constexpr int KS = DQK * 2 + 16;
  constexpr int KBYTES = 64 * KS;
  constexpr int VS = 144;
  constexpr int VBYTES = 64 * VS;
  constexpr int STAGE = KBYTES + VBYTES;
  constexpr int CPR = DQK / 8;
  constexpr int NKC = 64 * CPR / 256;
  constexpr int NS = DQK / 16;
  const int tid = otid(), lane = tid & 63, r = lane & 31, hh = lane >> 5;
  bf16x8 qf[NS];
#pragma unroll
  for (int s = 0; s < NS; ++s) qf[s] = *(const bf16x8*)(Qw + (size_t)r * q_ld + 16 * s + 8 * hh);
  f32x16 o[2];
#pragma unroll
  for (int n = 0; n < 2; ++n)
#pragma unroll
    for (int e = 0; e < 16; ++e) o[n][e] = 0.f;
  float m_run = -1e30f, lsum = 0.f;
  u32x4 rk0[NKC], rv0[2], rk1[NKC], rv1[2];
  int krow_[NKC], kc_[NKC];
#pragma unroll
  for (int q = 0; q < NKC; ++q) { const int id = q * 256 + tid; krow_[q] = id / CPR; kc_[q] = id % CPR; }
  const int vrow = tid >> 3, vc = tid & 7;
  auto gload = [&](int key0, u32x4 (&rk)[NKC], u32x4 (&rv)[2]) {
#pragma unroll
    for (int q = 0; q < NKC; ++q) {
      const bf16_t* src = (DQK == 64 || kc_[q] < 8) ? K1 + (size_t)(key0 + krow_[q]) * k1_ld + kc_[q] * 8 : K2 + (size_t)(key0 + krow_[q]) * k2_ld + (kc_[q] - 8) * 8;
      rk[q] = *(const u32x4*)src;
    }
#pragma unroll
    for (int q = 0; q < 2; ++q) rv[q] = *(const u32x4*)(Vt + (size_t)(vrow + 32 * q) * vt_ld + key0 + vc * 8);
  };
  auto lstore = [&](int buf, u32x4 (&rk)[NKC], u32x4 (&rv)[2]) {
    char* base = smem + buf * STAGE;
#pragma unroll
    for (int q = 0; q < NKC; ++q) *(u32x4*)(base + krow_[q] * KS + kc_[q] * 16) = rk[q];
#pragma unroll
    for (int q = 0; q < 2; ++q) *(u32x4*)(base + KBYTES + (vrow + 32 * q) * VS + vc * 16) = rv[q];
  };
  const int ntl = nkeys >> 6;
  gload(0, rk0, rv0); lstore(0, rk0, rv0);
  gload(64, rk1, rv1);
  if (ntl > 2) gload(128, rk0, rv0);
  __syncthreads();
  auto tile_body = [&](int tl, u32x4 (&rkn)[NKC], u32x4 (&rvn)[2]) {
    const char* base = smem + (tl & 1) * STAGE;
    bf16x8 kf[2][NS], vf[2][2][2];
#pragma unroll
    for (int kb = 0; kb < 2; ++kb)
#pragma unroll
      for (int ks = 0; ks < NS; ++ks) kf[kb][ks] = *(const bf16x8*)(base + (kb * 32 + r) * KS + (2 * ks + hh) * 16);
    __builtin_amdgcn_sched_barrier(0);
    f32x16 s[2];
#pragma unroll
    for (int kb = 0; kb < 2; ++kb)
#pragma unroll
      for (int e = 0; e < 16; ++e) s[kb][e] = 0.f;
#pragma unroll
    for (int ks = 0; ks < NS; ++ks)
#pragma unroll
      for (int kb = 0; kb < 2; ++kb) s[kb] = MFMA32(kf[kb][ks], qf[ks], s[kb]);
#pragma unroll
    for (int kb = 0; kb < 2; ++kb)
#pragma unroll
      for (int s2 = 0; s2 < 2; ++s2)
#pragma unroll
        for (int n = 0; n < 2; ++n) vf[kb][s2][n] = *(const bf16x8*)(base + KBYTES + (32 * n + r) * VS + (kb * 32 + 16 * s2 + 8 * hh) * 2);
    __builtin_amdgcn_sched_barrier(0);
    float mx = s[0][0];
#pragma unroll
    for (int kb = 0; kb < 2; ++kb)
#pragma unroll
      for (int e = 0; e < 16; ++e) mx = fmaxf(mx, s[kb][e]);
    { const unsigned u = __float_as_uint(mx); auto sw = __builtin_amdgcn_permlane32_swap(u, u, false, false); mx = fmaxf(__uint_as_float(sw[0]), __uint_as_float(sw[1])); }
    const float m_new = fmaxf(m_run, mx);
    const float alpha = __builtin_amdgcn_exp2f(m_run - m_new);
    m_run = m_new;
    float ps = 0.f;
#pragma unroll
    for (int kb = 0; kb < 2; ++kb)
#pragma unroll
      for (int e = 0; e < 16; ++e) { const float pe = __builtin_amdgcn_exp2f(s[kb][e] - m_new); s[kb][e] = pe; ps += pe; }
    lsum = lsum * alpha + ps;
    if (__builtin_amdgcn_ballot_w64(alpha != 1.0f) != 0ull) {
#pragma unroll
      for (int n = 0; n < 2; ++n)
#pragma unroll
        for (int e = 0; e < 16; ++e) o[n][e] *= alpha;
    }
#pragma unroll
    for (int kb = 0; kb < 2; ++kb)
#pragma unroll
      for (int s2 = 0; s2 < 2; ++s2) {
        u32x4 pw;
        pw.x = pack2(s[kb][8 * s2 + 0], s[kb][8 * s2 + 1]); pw.y = pack2(s[kb][8 * s2 + 2], s[kb][8 * s2 + 3]);
        pw.z = pack2(s[kb][8 * s2 + 4], s[kb][8 * s2 + 5]); pw.w = pack2(s[kb][8 * s2 + 6], s[kb][8 * s2 + 7]);
        const bf16x8 pf = __builtin_bit_cast(bf16x8, pw);
#pragma unroll
        for (int n = 0; n < 2; ++n) o[n] = MFMA32(vf[kb][s2][n], pf, o[n]);
      }
    if (tl + 1 < ntl) { lstore((tl + 1) & 1, rkn, rvn); if (tl + 3 < ntl) gload((tl + 3) * 64, rkn, rvn); }
    __syncthreads();
  };
  for (int tl = 0; tl < ntl; tl += 2) { tile_body(tl, rk1, rv1); tile_body(tl + 1, rk0, rv0); }
  lsum = xsum32(lsum);
  const float inv = 1.0f / lsum;
#pragma unroll
  for (int n = 0; n < 2; ++n)
#pragma unroll
    for (int g = 0; g < 4; ++g) {
      u32x2 w; w.x = pack2(o[n][4 * g] * inv, o[n][4 * g + 1] * inv); w.y = pack2(o[n][4 * g + 2] * inv, o[n][4 * g + 3] * inv);
      *(u32x2*)(Ow + (size_t)r * o_ld + 32 * n + 8 * g + 4 * hh) = w;
    }
}

DI void scan_item(const Params& p, int l, int seq, int hd, int dir, int rs, char* smem) {
  const int tid = otid(), lane = tid & 63, wv = __builtin_amdgcn_readfirstlane(tid >> 6);
  const int j8 = lane & 7, r = lane & 31, hh = lane >> 5;
  const bool lat = seq >= 32;
  const int T = lat ? 4096 : 256;
  const int row0 = lat ? NCTX + (seq - 32) * 4096 : seq * 256;
  float* vA = (float*)smem; float* vK = vA + 2048; float* vR = vK + 2048; float* vV = vR + 2048; float* vW = vV + 2048; float* vB = vW + 2048; float* ybuf = vB + 2048;
  char* raw = smem + 32768;
  char* wdx = smem + 57344; char* adx = smem + 61952;
  float* tmpb = (float*)(smem + 66816);
  const bf16_t* U = (const bf16_t*)(p.ws + OFF_U);
  bf16_t* Y = (bf16_t*)(p.ws + OFF_R2) + (dir ? (size_t)NT * 512 : 0);
  float* bonus = (float*)(p.ws + OFF_BONUS);
  const int lrow = 8 * wv + (lane >> 3), irow = rs * 32 + lrow;
  f32x2 S[4];
  if (lat) {
    const float* s0 = (dir ? opq(p.in[I_SB]) : opq(p.in[I_SF])) + ((size_t)((seq - 32) * 4 + l) * 8 + hd) * 4096 + irow * 64 + j8 * 8;
#pragma unroll
    for (int q = 0; q < 2; ++q) { const f32x4 v = *(const f32x4*)(s0 + 4 * q); S[2 * q] = (f32x2){v.x, v.y}; S[2 * q + 1] = (f32x2){v.z, v.w}; }
  } else {
#pragma unroll
    for (int q = 0; q < 4; ++q) S[q] = (f32x2){0.f, 0.f};
  }
  const int mat = wv >> 1, ntc = wv & 1, cch = ntc * 32 + r, hc = hd * 64 + cch;
  bf16x8 bfrag[4];
  {
    const float* W = (mat ? opq(p.in[I_AUP]) : opq(p.in[I_WUP])) + (size_t)(l * 2 + dir) * 64 * 512 + hc;
#pragma unroll
    for (int s4 = 0; s4 < 4; ++s4) {
      float w8[8];
#pragma unroll
      for (int j = 0; j < 8; ++j) w8[j] = W[(size_t)(16 * s4 + 8 * hh + j) * 512];
      bfrag[s4] = __builtin_bit_cast(bf16x8, pack8(w8));
    }
  }
  const float bias = (mat ? opq(p.in[I_A0]) : opq(p.in[I_W0]))[(l * 2 + dir) * 512 + hc];
  const float kav = p.in[I_KA][l * 512 + hc], rkv = p.in[I_RK][l * 512 + hc];
  float* muP = (float*)(smem + 75008); float* muN = muP + 320; float* kkL = muN + 320;
  {
    const float* mup = p.in[I_MUP] + l * 1792; const float* mun = p.in[I_MUN] + l * 1792;
    for (int e = tid; e < 320; e += 256) { const int g = e >> 6, c = e & 63; const int col = (g < 3 ? g * 512 + hd * 64 : (g == 3 ? 1536 + dir * 64 : 1664 + dir * 64)) + c; muP[e] = mup[col]; muN[e] = mun[col]; }
    if (tid < 64) kkL[tid] = p.in[I_KK][l * 512 + hd * 64 + tid];
  }
  const int nch = T >> 5;
  u32x4 pre[6];
  auto prefetch = [&](int t0) {
#pragma unroll
    for (int q = 0; q < 6; ++q) {
      const int id = q * 256 + tid;
      const int row = id / 40, cc = id - row * 40, g = cc >> 3, c8 = cc & 7;
      const int t = t0 - 1 + row;
      const int col = (g < 3 ? g * 512 + hd * 64 : (g == 3 ? 1536 + dir * 64 : 1664 + dir * 64)) + c8 * 8;
      u32x4 v = (u32x4){0u, 0u, 0u, 0u};
      if (id < 1360 && t >= 0 && t < T) v = *(const u32x4*)(U + (size_t)(row0 + t) * ULD + 1696 + col);
      pre[q] = v;
    }
  };
  prefetch((dir ? nch - 1 : 0) * 32);
  for (int ci = 0; ci < nch; ++ci) {
    const int t0 = (dir ? nch - 1 - ci : ci) * 32;
#pragma unroll
    for (int q = 0; q < 6; ++q) { const int id = q * 256 + tid; if (id < 1360) *(u32x4*)(raw + id * 16) = pre[q]; }
    __syncthreads();
    if (ci + 1 < nch) prefetch((dir ? nch - 2 - ci : ci + 1) * 32);
    {
      const int tt = tid >> 3, sub = tid & 7;
#pragma unroll 1
      for (int g = 0; g < 5; ++g) {
        const int col = (g < 3 ? g * 512 + hd * 64 : (g == 3 ? 1536 + dir * 64 : 1664 + dir * 64)) + sub * 8;
        float c[8], pv[8], nx[8], x[8];
        unpack8(*(const u32x4*)(raw + (tt + 1) * 640 + (g * 8 + sub) * 16), c);
        unpack8(*(const u32x4*)(raw + tt * 640 + (g * 8 + sub) * 16), pv);
        unpack8(*(const u32x4*)(raw + (tt + 2) * 640 + (g * 8 + sub) * 16), nx);
        const f32x4 mp0 = *(const f32x4*)(muP + g * 64 + sub * 8), mp1 = *(const f32x4*)(muP + g * 64 + sub * 8 + 4), mn0 = *(const f32x4*)(muN + g * 64 + sub * 8), mn1 = *(const f32x4*)(muN + g * 64 + sub * 8 + 4);
        const float mp[8] = {mp0.x, mp0.y, mp0.z, mp0.w, mp1.x, mp1.y, mp1.z, mp1.w}, mn[8] = {mn0.x, mn0.y, mn0.z, mn0.w, mn1.x, mn1.y, mn1.z, mn1.w};
#pragma unroll
        for (int i = 0; i < 8; ++i) x[i] = c[i] + mp[i] * (pv[i] - c[i]) + mn[i] * (nx[i] - c[i]);
        const int lo = tt * 64 + sub * 8;
        if (g == 0) { *(f32x4*)(vR + lo) = (f32x4){x[0], x[1], x[2], x[3]}; *(f32x4*)(vR + lo + 4) = (f32x4){x[4], x[5], x[6], x[7]}; }
        else if (g == 1) {
          float kk[8], ss = 0.f;
          const float* kkw = kkL + sub * 8;
#pragma unroll
          for (int i = 0; i < 8; ++i) { kk[i] = x[i] * kkw[i]; ss += kk[i] * kk[i]; }
          *(f32x4*)(vK + lo) = (f32x4){x[0], x[1], x[2], x[3]}; *(f32x4*)(vK + lo + 4) = (f32x4){x[4], x[5], x[6], x[7]};
          ss += shx<1>(ss); ss += shx<2>(ss); ss += shx<4>(ss);
          const float inv = 1.0f / fmaxf(sqrtf(ss), 1e-12f);
          *(f32x4*)(vA + lo) = (f32x4){kk[0] * inv, kk[1] * inv, kk[2] * inv, kk[3] * inv}; *(f32x4*)(vA + lo + 4) = (f32x4){kk[4] * inv, kk[5] * inv, kk[6] * inv, kk[7] * inv};
        }
        else if (g == 2) { *(f32x4*)(vV + lo) = (f32x4){x[0], x[1], x[2], x[3]}; *(f32x4*)(vV + lo + 4) = (f32x4){x[4], x[5], x[6], x[7]}; }
        else if (g == 3) { float th[8]; for (int i = 0; i < 8; ++i) th[i] = 1.0f - 2.0f * __builtin_amdgcn_rcpf(1.0f + __expf(2.0f * x[i])); *(u32x4*)(wdx + tt * 144 + sub * 16) = pack8(th); }
        else { *(u32x4*)(adx + tt * 144 + sub * 16) = pack8(x); }
      }
    }
    __syncthreads();
    {
      f32x16 acc;
#pragma unroll
      for (int e = 0; e < 16; ++e) acc[e] = 0.f;
      const char* xb = mat ? adx : wdx;
#pragma unroll
      for (int s4 = 0; s4 < 4; ++s4) { const bf16x8 af = *(const bf16x8*)(xb + r * 144 + (16 * s4 + 8 * hh) * 2); acc = MFMA32(af, bfrag[s4], acc); }
      if (mat == 0) {
#pragma unroll
        for (int e = 0; e < 16; ++e) vW[crow(e, hh) * 64 + cch] = __expf(-0.6065306597126334f * sigmoidf_(bias + acc[e]));
      } else {
#pragma unroll
        for (int e = 0; e < 16; ++e) {
          const int ix = crow(e, hh) * 64 + cch;
          const float ag = sigmoidf_(bias + acc[e]);
          const float kk = vA[ix], k = vK[ix], rr = vR[ix];
          const float kd = k * (1.0f + (ag - 1.0f) * kav);
          vK[ix] = kd; vA[ix] = -kk; vB[ix] = kk * ag; tmpb[ix] = rr * kd * rkv;
        }
      }
    }
    __syncthreads();
    {
      const int tt = tid >> 3, sub = tid & 7;
      const f32x4 b0 = *(const f32x4*)(tmpb + tt * 64 + sub * 8), b1 = *(const f32x4*)(tmpb + tt * 64 + sub * 8 + 4);
      float bs = (b0.x + b0.y) + (b0.z + b0.w) + (b1.x + b1.y) + (b1.z + b1.w);
      bs += shx<1>(bs); bs += shx<2>(bs); bs += shx<4>(bs);
      if (sub == 0 && rs == 0) bonus[((size_t)(row0 + t0 + tt) * 8 + hd) * 2 + dir] = bs;
    }
    {
      f32x4 va[2], vw[2], vb[2], vk[2], vr[2]; float vi;
      int tt = dir ? 31 : 0;
      int vo = tt * 64 + j8 * 8;
#pragma unroll
      for (int q = 0; q < 2; ++q) { va[q] = *(const f32x4*)(vA + vo + 4 * q); vw[q] = *(const f32x4*)(vW + vo + 4 * q); vb[q] = *(const f32x4*)(vB + vo + 4 * q); vk[q] = *(const f32x4*)(vK + vo + 4 * q); vr[q] = *(const f32x4*)(vR + vo + 4 * q); }
      vi = vV[tt * 64 + irow];
      for (int si = 0; si < 32; ++si) {
        const int ttn = dir ? (si < 31 ? 30 - si : 0) : (si < 31 ? si + 1 : 31);
        const int von = ttn * 64 + j8 * 8;
        f32x2 pa2 = S[0] * (f32x2){va[0].x, va[0].y}, pa3 = S[1] * (f32x2){va[0].z, va[0].w};
        pa2 += S[2] * (f32x2){va[1].x, va[1].y}; pa3 += S[3] * (f32x2){va[1].z, va[1].w};
#pragma unroll
        for (int q = 0; q < 2; ++q) va[q] = *(const f32x4*)(vA + von + 4 * q);
        pa2 += pa3;
        const float sa = osum(pa2.x + pa2.y);
        const f32x2 sa2 = (f32x2){sa, sa}, vi2 = (f32x2){vi, vi};
        f32x2 py2, py3;
        S[0] = S[0] * (f32x2){vw[0].x, vw[0].y} + (sa2 * (f32x2){vb[0].x, vb[0].y} + vi2 * (f32x2){vk[0].x, vk[0].y}); py2 = S[0] * (f32x2){vr[0].x, vr[0].y};
        S[1] = S[1] * (f32x2){vw[0].z, vw[0].w} + (sa2 * (f32x2){vb[0].z, vb[0].w} + vi2 * (f32x2){vk[0].z, vk[0].w}); py3 = S[1] * (f32x2){vr[0].z, vr[0].w};
        S[2] = S[2] * (f32x2){vw[1].x, vw[1].y} + (sa2 * (f32x2){vb[1].x, vb[1].y} + vi2 * (f32x2){vk[1].x, vk[1].y}); py2 += S[2] * (f32x2){vr[1].x, vr[1].y};
        S[3] = S[3] * (f32x2){vw[1].z, vw[1].w} + (sa2 * (f32x2){vb[1].z, vb[1].w} + vi2 * (f32x2){vk[1].z, vk[1].w}); py3 += S[3] * (f32x2){vr[1].z, vr[1].w};
#pragma unroll
        for (int q = 0; q < 2; ++q) { vw[q] = *(const f32x4*)(vW + von + 4 * q); vb[q] = *(const f32x4*)(vB + von + 4 * q); vk[q] = *(const f32x4*)(vK + von + 4 * q); vr[q] = *(const f32x4*)(vR + von + 4 * q); }
        vi = vV[ttn * 64 + irow];
        py2 += py3;
        const float py = osum(py2.x + py2.y);
        if (j8 == 0) ybuf[tt * 32 + lrow] = py;
        tt = ttn;
      }
    }
    __syncthreads();
    {
      const int tt = tid >> 3, sub = tid & 7;
      const f32x4 y0 = *(const f32x4*)(ybuf + tt * 32 + sub * 4);
      u32x2 w; w.x = pack2(y0.x, y0.y); w.y = pack2(y0.z, y0.w);
      *(u32x2*)(Y + (size_t)(row0 + t0 + tt) * 512 + hd * 64 + rs * 32 + sub * 4) = w;
    }
    __syncthreads();
  }
  if (!lat) {
    float* o = opq(p.out) + (dir ? OUT_SB : OUT_SF) + ((size_t)(seq * 4 + l) * 8 + hd) * 4096 + irow * 64 + j8 * 8;
#pragma unroll
    for (int q = 0; q < 2; ++q) *(f32x4*)(o + 4 * q) = (f32x4){S[2 * q].x, S[2 * q].y, S[2 * q + 1].x, S[2 * q + 1].y};
  }
}

DI void phase_mixers(const Params& p, int l, char* smem, int part = 0) {
  const int tid = otid(), wid = __builtin_amdgcn_readfirstlane(tid >> 6);
  unsigned* cnt = (unsigned*)(p.ws + OFF_CNT) + l * 8;
  int* slot = (int*)(smem + SMEM_BYTES - 16);
  bf16_t* U = (bf16_t*)(p.ws + OFF_U);
  const bf16_t* KA = (const bf16_t*)(p.ws + OFF_KA); const bf16_t* VAT = (const bf16_t*)(p.ws + OFF_VAT);
  const bf16_t* KN = (const bf16_t*)(p.ws + OFF_KN); const bf16_t* VBT = (const bf16_t*)(p.ws + OFF_VBT); const bf16_t* KRB = (const bf16_t*)(p.ws + OFF_KRB);
  const int QLEN = 256 + 256 + 128 + 64 + 64;
  bool first = true;
  int xq = blockIdx.x & 7, tries = 0;
  for (;;) {
    int kind, seq, a, qt;
    if (first && blockIdx.x < 256) {
      const int item = blockIdx.x; kind = 0; seq = 32 + (item >> 5); a = (item >> 2) & 7; qt = item & 3;
      first = false;
    } else {
      first = false;
      if (tid == 0) *slot = (int)atomicAdd(cnt + xq, 1u);
      __syncthreads();
      const int i = __builtin_amdgcn_readfirstlane(*slot);
      __syncthreads();
      if (i >= QLEN) { if (++tries >= 8) break; xq = (xq + 1) & 7; continue; }
      if (i < 256) { const int g = xq + 8 * (i >> 7); kind = 1; seq = 32 + (g >> 1); a = g & 1; qt = i & 127; }
      else if (i < 512) { const int j = i - 256; const int g = xq + 8 * (j >> 5); kind = 2; seq = 32 + (g >> 3); a = g & 7; qt = j & 31; }
      else if (i < 640) { const int j = i - 512; kind = 0; seq = xq + 8 * (j >> 5); a = (j >> 2) & 7; qt = j & 3; }
      else if (i < 704) { const int j = i - 640; kind = 1; seq = xq + 8 * (j >> 4); a = (j >> 3) & 1; qt = j & 7; }
      else { const int j = i - 704; kind = 2; seq = xq + 8 * (j >> 4); a = (j >> 1) & 7; qt = j & 1; }
    }
    const int kr0 = keyrow0(seq), Tk = seq_tk(seq);
    const int row0 = seq < 32 ? seq * 256 : NCTX + (seq - 32) * 4096;
    if (kind == 0) scan_item(p, l, seq, a, qt & 1, qt >> 1, smem);
    else if (kind == 1) {
      const int qh = a * 4 + wid;
      bf16_t* q = U + (size_t)(row0 + qt * 32) * ULD + qh * 64;
      attn_item<64>(q, ULD, KA + (size_t)kr0 * 128 + a * 64, 128, nullptr, 0, VAT + (size_t)128 * kr0 + (size_t)(a * 64) * Tk, Tk, Tk, q, ULD, smem);
    } else {
      bf16_t* q = U + (size_t)(row0 + qt * 128 + wid * 32) * ULD + 768 + a * 96;
      attn_item<96>(q, ULD, KN + (size_t)kr0 * 512 + a * 64, 512, KRB + (size_t)kr0 * 32, 32, VBT + (size_t)512 * kr0 + (size_t)(a * 64) * Tk, Tk, Tk, q, ULD, smem);
    }
  }
}

DI void cpost_row(const Params& p, int l, int row, int lane) {
  int seq, t; row_decode(row, seq, t);
  const int T = seq < 32 ? 256 : 4096;
  const bf16_t* YF = (const bf16_t*)(p.ws + OFF_R2); const bf16_t* YB = YF + (size_t)NT * 512;
  bf16_t* u = (bf16_t*)(p.ws + OFF_U) + (size_t)row * ULD + 1696;
  const float* bonus = (const float*)(p.ws + OFF_BONUS);
  float yf[8], yb[8], y[8];
  unpack8(*(const u32x4*)(YF + (size_t)row * 512 + lane * 8), yf);
  unpack8(*(const u32x4*)(YB + (size_t)row * 512 + lane * 8), yb);
  float s = 0.f;
#pragma unroll
  for (int i = 0; i < 8; ++i) { y[i] = yf[i] + yb[i]; s += y[i]; }
  s += shx<1>(s); s += shx<2>(s); s += shx<4>(s);
  const float mu = s * (1.0f / 64.0f);
  float q = 0.f;
#pragma unroll
  for (int i = 0; i < 8; ++i) { y[i] -= mu; q += y[i] * y[i]; }
  q += shx<1>(q); q += shx<2>(q); q += shx<4>(q);
  const float rs = rsqrtf(q * (1.0f / 64.0f) + 64e-5f);
  const int col = 1024 + lane * 8;
  float c[8], pv[8], nx[8];
  unpack8(*(const u32x4*)(u + col), c);
  if (t > 0) unpack8(*(const u32x4*)(u - ULD + col), pv); else { for (int i = 0; i < 8; ++i) pv[i] = 0.f; }
  if (t < T - 1) unpack8(*(const u32x4*)(u + ULD + col), nx); else { for (int i = 0; i < 8; ++i) nx[i] = 0.f; }
  const float* mup = p.in[I_MUP] + l * 1792 + col; const float* mun = p.in[I_MUN] + l * 1792 + col;
  const float* lw = p.in[I_LNW] + l * 512 + lane * 8; const float* lb = p.in[I_LNB] + l * 512 + lane * 8;
  const f32x2 bsv = *(const f32x2*)(bonus + ((size_t)row * 8 + (lane >> 3)) * 2);
  const float bs = bsv.x + bsv.y;
  float o[8];
#pragma unroll
  for (int i = 0; i < 8; ++i) { const float v = c[i] + mup[i] * (pv[i] - c[i]) + mun[i] * (nx[i] - c[i]); o[i] = y[i] * rs * lw[i] + lb[i] + bs * v; }
  *(u32x4*)(u + lane * 8) = pack8(o);
}
DI void phase_renorm_cpost(const Params& p, int l) {
  const int lane = otid() & 63, wid = __builtin_amdgcn_readfirstlane(otid() >> 6);
  for (int item = blockIdx.x; item < NT / 4; item += gridDim.x) { const int row = item * 4 + wid; norm_row(p, l, row, lane); cpost_row(p, l, row, lane); }
}

DI void phase_zgemm(const Params& p, char* smem) {
  const bf16_t* H = (const bf16_t*)(p.ws + OFF_R1);
  const bf16_t* W = (const bf16_t*)(p.ws + OFF_WIN) + (size_t)3584 * 1024;
  bf16_t* U = (bf16_t*)(p.ws + OFF_U);
  const int ntiles = 320 * 12;
  for (int tile = blockIdx.x; tile < ntiles; tile += gridDim.x) {
    const int mt = tile / 12, nt = tile % 12, m0 = mt * 128, n0 = nt * 128;
    f32x16 acc[2][2]; zero_acc<2>(acc);
    gemm_mainloop<2>(acc, H + (size_t)m0 * 1024, 1024, 64, W + (size_t)n0 * 1024, 1024, 1024, smem);
    const int lane = otid() & 63, wid = __builtin_amdgcn_readfirstlane(otid() >> 6), wm = wid >> 1, wn = wid & 1, r = lane & 31, hh = lane >> 5;
#pragma unroll
    for (int j = 0; j < 2; ++j) {
      const int col = n0 + wn * 64 + j * 32 + r;
      const int br = col >> 9, cc = col & 511;
      const int ucol = br == 0 ? cc : (br == 1 ? 768 + (cc >> 6) * 96 + (cc & 63) : 1696 + cc);
#pragma unroll
      for (int i = 0; i < 2; ++i) {
        bf16_t* up = U + (size_t)(m0 + wm * 64 + i * 32) * ULD;
        const int lo = 4 * hh * ULD + ucol;
        bf16_t yv[16];
#pragma unroll
        for (int e = 0; e < 16; ++e) yv[e] = (up + crowu(e) * ULD)[lo];
#pragma unroll
        for (int e = 0; e < 16; ++e) (up + crowu(e) * ULD)[lo] = f2bf(bf2f(yv[e]) * siluf_(acc[i][j][e]));
      }
    }
  }
}

DI void phase_merge(const Params& p, char* smem) {
  const bf16_t* H = (const bf16_t*)(p.ws + OFF_R1);
  const bf16_t* WG = (const bf16_t*)(p.ws + OFF_WIN) + (size_t)5120 * 1024;
  const bf16_t* WO = (const bf16_t*)(p.ws + OFF_WO);
  const bf16_t* U = (const bf16_t*)(p.ws + OFF_U);
  bf16_t* MX = (bf16_t*)(p.ws + OFF_R2);
  const int ntiles = 320 * 8;
  for (int tile = blockIdx.x; tile < ntiles; tile += gridDim.x) {
    const int mt = tile >> 3, nt = tile & 7, m0 = mt * 128, n0 = nt * 128;
    f32x16 mix[2][2]; zero_acc<2>(mix);
    unsigned gs[2][2][8];
#pragma unroll 1
    for (int step = 0; step < 6; ++step) {
      const int br = step >> 1, isT = step & 1;
      const int acol = br == 0 ? 0 : (br == 1 ? 768 : 1696);
      const bf16_t* Ap = isT ? U + (size_t)m0 * ULD + acol : H + (size_t)m0 * 1024;
      const bf16_t* Bp = isT ? WO + (size_t)(br * 1024 + n0) * 512 : WG + (size_t)(br * 1024 + n0) * 1024;
      f32x16 cur[2][2]; zero_acc<2>(cur);
      gemm_mainloop<2>(cur, Ap, isT ? ULD : 1024, (isT && br == 1) ? 96 : 64, Bp, isT ? 512 : 1024, isT ? 512 : 1024, smem);
      if (isT) {
#pragma unroll
        for (int i = 0; i < 2; ++i)
#pragma unroll
          for (int j = 0; j < 2; ++j)
#pragma unroll
            for (int e = 0; e < 8; ++e) { mix[i][j][2 * e] += lo16(gs[i][j][e]) * cur[i][j][2 * e]; mix[i][j][2 * e + 1] += hi16(gs[i][j][e]) * cur[i][j][2 * e + 1]; }
      } else {
#pragma unroll
        for (int i = 0; i < 2; ++i)
#pragma unroll
          for (int j = 0; j < 2; ++j)
#pragma unroll
            for (int e = 0; e < 8; ++e) gs[i][j][e] = pack2(sigmoidf_(cur[i][j][2 * e]), sigmoidf_(cur[i][j][2 * e + 1]));
      }
    }
    const int lane = otid() & 63, wid = __builtin_amdgcn_readfirstlane(otid() >> 6), wm = wid >> 1, wn = wid & 1, r = lane & 31, hh = lane >> 5;
#pragma unroll
    for (int j = 0; j < 2; ++j) {
      const int col = n0 + wn * 64 + j * 32 + r;
#pragma unroll
      for (int i = 0; i < 2; ++i) {
        bf16_t* mp = MX + (size_t)(m0 + wm * 64 + i * 32) * 1024;
        const int lo = 4 * hh * 1024 + col;
#pragma unroll
        for (int e = 0; e < 16; ++e) (mp + crowu(e) * 1024)[lo] = f2bf(mix[i][j][e]);
      }
    }
  }
}

DI void phase_out(const Params& p, int l, char* smem) {
  const bf16_t* MX = (const bf16_t*)(p.ws + OFF_R2);
  const bf16_t* W = (const bf16_t*)(p.ws + OFF_WOUT);
  const int ntiles = 320 * 8;
  for (int tile = blockIdx.x; tile < ntiles; tile += gridDim.x) {
    const int mt = tile >> 3, nt = tile & 7, m0 = mt * 128, n0 = nt * 128;
    f32x16 acc[2][2]; zero_acc<2>(acc);
    gemm_mainloop<2>(acc, MX + (size_t)m0 * 1024, 1024, 64, W + (size_t)n0 * 1024, 1024, 1024, smem);
    const int lane = otid() & 63, wid = __builtin_amdgcn_readfirstlane(otid() >> 6), wm = wid >> 1, wn = wid & 1, r = lane & 31, hh = lane >> 5;
    const int jm = m0 < NCTX ? 0 : 1 + ((m0 - NCTX) >> 12);
    const float* gate = (const float*)(p.ws + OFF_MOD) + ((size_t)l * 9 + jm) * MODLD + 2048;
    const float* xsrc = x_row_ptr(p, l, m0);
#pragma unroll
    for (int j = 0; j < 2; ++j) {
      const int col = n0 + wn * 64 + j * 32 + r;
      const float gv = gate[col];
      const int lo = 4 * hh * 1024 + col;
#pragma unroll
      for (int i = 0; i < 2; ++i) {
        const float* xs = xsrc + (size_t)(wm * 64 + i * 32) * 1024;
        float* xo = p.out + (size_t)(m0 + wm * 64 + i * 32) * 1024;
        float xv[16];
#pragma unroll
        for (int e = 0; e < 16; ++e) xv[e] = (xs + crowu(e) * 1024)[lo];
#pragma unroll
        for (int e = 0; e < 16; ++e) (xo + crowu(e) * 1024)[lo] = xv[e] + gv * acc[i][j][e];
      }
    }
  }
}

DI void phase_final(const Params& p) {
  const int lane = otid() & 63, wid = __builtin_amdgcn_readfirstlane(otid() >> 6);
  const float* nw = p.in[I_FNW];
  for (int item = blockIdx.x; item < NT / 4; item += gridDim.x) {
    float* x = p.out + (size_t)(item * 4 + wid) * 1024;
    f32x4 v[4]; float ss = 0.f;
#pragma unroll
    for (int i = 0; i < 4; ++i) { v[i] = *(const f32x4*)(x + lane * 4 + 256 * i); ss += v[i].x * v[i].x + v[i].y * v[i].y + v[i].z * v[i].z + v[i].w * v[i].w; }
ss = wave_sum(ss);
    const float rs = rsqrtf(ss * (1.0f / 1024.0f) + 1e-6f);
#pragma unroll
    for (int i = 0; i < 4; ++i) { const f32x4 w = *(const f32x4*)(nw + lane * 4 + 256 * i); *(f32x4*)(x + lane * 4 + 256 * i) = (f32x4){v[i].x * rs * w.x, v[i].y * rs * w.y, v[i].z * rs * w.z, v[i].w * rs * w.w}; }
  }
}

constexpr int NPHASES = 1 + 4 * 9 + 1;
__global__ void __launch_bounds__(256, 2) fwd_kernel(Params p0) {
  __shared__ __attribute__((aligned(16))) char smem[SMEM_BYTES];
  cg::grid_group grid = cg::this_grid();
  const int ph_begin = p0.ph_begin, ph_end = p0.ph_end;
  for (int ph = ph_begin; ph < ph_end; ++ph) {
    auto kp = __builtin_amdgcn_kernarg_segment_ptr();
    asm volatile("" : "+s"(kp));
    typedef const __attribute__((address_space(4))) Params CParams;
    CParams* kpp = (CParams*)kp;
    Params p;
#pragma unroll
    for (int i = 0; i < 35; ++i) p.in[i] = kpp->in[i];
    p.out = kpp->out; p.ws = kpp->ws; p.ph_begin = ph_begin; p.ph_end = ph_end;
    if (ph == 0) phase_prologue(p, smem);
    else if (ph == NPHASES - 1) phase_final(p);
    else {
      const int l = (ph - 1) / 9, sp = (ph - 1) % 9;
#ifdef PROBE_SP
      if (sp == PROBE_SP) {
        switch (sp) {
          case 0: phase_norm_convert(p, l, smem); break;
          case 1: phase_gemm1(p, l, smem); break;
          case 3: phase_upproj(p, smem); break;
          case 5: phase_renorm_cpost(p, l); break;
          case 7: phase_merge(p, smem); break;
          default: break;
        }
        grid.sync();
      }
#endif
      switch (sp) {
        case 0: phase_norm_convert(p, l, smem); break;
        case 1: phase_gemm1(p, l, smem); break;
        case 2: phase_post(p, l); break;
        case 3: phase_upproj(p, smem); break;
        case 4: phase_mixers(p, l, smem); break;
        case 5: phase_renorm_cpost(p, l); break;
        case 6: phase_zgemm(p, smem); break;
        case 7: phase_merge(p, smem); break;
        default: phase_out(p, l, smem); break;
      }
    }
    if (ph + 1 < ph_end) grid.sync();
  }
}

extern "C" void kernel_launch(void* const* d_in, const int* in_sizes, int n_in, void* d_out, int out_size, void* d_ws, size_t ws_size, hipStream_t stream) {
  if (ws_size < WS_NEED || n_in < 35) { fprintf(stderr, "workspace too small: %zu < %zu\n", ws_size, WS_NEED); return; }
  static int grid_blocks = 0;
  if (!grid_blocks) {
    int dev = 0, cus = 0, per_cu = 0;
    hipGetDevice(&dev);
    hipDeviceGetAttribute(&cus, hipDeviceAttributeMultiprocessorCount, dev);
    hipOccupancyMaxActiveBlocksPerMultiprocessor(&per_cu, fwd_kernel, 256, 0);
    if (per_cu < 1) per_cu = 1;
    if (per_cu > 2) per_cu = 2;
    grid_blocks = cus * per_cu;
  }
  Params p{};
  for (int i = 0; i < 35; ++i) p.in[i] = (const float*)d_in[i];
  p.out = (float*)d_out; p.ws = (char*)d_ws;
#ifndef ONE_LAUNCH
  for (int ph = 0; ph < NPHASES; ++ph) {
    p.ph_begin = ph; p.ph_end = ph + 1;
    hipLaunchKernelGGL(fwd_kernel, dim3(grid_blocks), dim3(256), 0, stream, p);
  }
#else
  p.ph_begin = 0; p.ph_end = NPHASES;
  void* args[] = {&p};
  hipError_t e = hipLaunchCooperativeKernel((void*)fwd_kernel, dim3(grid_blocks), dim3(256), args, 0, stream);
  if (e != hipSuccess) fprintf(stderr, "cooperative launch failed: %s (grid %d)\n", hipGetErrorString(e), grid_blocks);
#endif
}
```

```cpp
#define ONE_LAUNCH 1
#include <hip/hip_runtime.h>
#include <hip/hip_cooperative_groups.h>
#include <stdint.h>
#include <stdio.h>
namespace cg = cooperative_groups;

typedef unsigned short bf16_t;
typedef short bf16x8 __attribute__((ext_vector_type(8)));
typedef float f32x16 __attribute__((ext_vector_type(16)));
typedef float f32x4 __attribute__((ext_vector_type(4)));
typedef float f32x2 __attribute__((ext_vector_type(2)));
typedef unsigned u32x4 __attribute__((ext_vector_type(4)));
typedef unsigned u32x2 __attribute__((ext_vector_type(2)));
#define DI __device__ __forceinline__
#define MFMA32(a, b, c) __builtin_amdgcn_mfma_f32_32x32x16_bf16((a), (b), (c), 0, 0, 0)

constexpr int NT = 40960;
constexpr int NCTX = 8192;
constexpr int NK = 45056;
constexpr int ULD = 3488;
constexpr int MODLD = 3072;
constexpr int SMEM_BYTES = 78848;

constexpr size_t OFF_WIN = 0;
constexpr size_t OFF_WO = 16777216;
constexpr size_t OFF_WOUT = 19922944;
constexpr size_t OFF_WU = 22020096;
constexpr size_t OFF_MOD = 22282240;
constexpr size_t OFF_BONUS = 22724608;
constexpr size_t OFF_CS16 = 25346048;
constexpr size_t OFF_CS8 = 25354240;
constexpr size_t OFF_CNT = 25358336;
constexpr size_t OFF_BAR = 524742912;
constexpr size_t OFF_U = 25358592;
constexpr size_t OFF_R1 = 311095552;
constexpr size_t OFF_KA = OFF_R1;
constexpr size_t OFF_VAT = 513208576;
constexpr size_t OFF_KN = OFF_R1 + 23068672;
constexpr size_t OFF_VBT = OFF_R1 + 69206016;
constexpr size_t OFF_KRB = OFF_R1 + 115343360;
constexpr size_t OFF_R2 = 429322496;
constexpr size_t WS_NEED = 524742912 + 4096;

constexpr size_t OUT_AK = 41943040, OUT_AV = 46137344, OUT_CKV = 50331648, OUT_KR = 54525952, OUT_SF = 55574528, OUT_SB = 59768832;

struct Params {
  const float* in[35];
  float* out;
  char* ws;
  int ph_begin, ph_end;
};

enum { I_XP = 0, I_XS, I_CAK, I_CAV, I_CCKV, I_CKR, I_SF, I_SB, I_C, I_CCTX, I_NORMW, I_WMOD, I_BMOD, I_WIN, I_QNW, I_KNW, I_KVNW,
       I_WUK, I_WUV, I_MUP, I_MUN, I_W0, I_WUP, I_A0, I_AUP, I_KK, I_KA, I_RK, I_LNW, I_LNB, I_WOA, I_WOB, I_WOC, I_WOUT, I_FNW };

DI int threadIdx_x_raw() { return __builtin_amdgcn_workitem_id_x(); }
DI int otid() { int t = threadIdx_x_raw(); asm volatile("" : "+v"(t)); return t; }
DI const float* opq(const float* q) { asm volatile("" : "+s"(q)); return q; }
DI float* opq(float* q) { asm volatile("" : "+s"(q)); return q; }
DI float bf2f(bf16_t v) { return __uint_as_float(((unsigned)v) << 16); }
typedef __bf16 hbf16x2 __attribute__((ext_vector_type(2)));
DI unsigned pack2(float a, float b) { f32x2 v = {a, b}; hbf16x2 r = __builtin_convertvector(v, hbf16x2); return __builtin_bit_cast(unsigned, r); }
DI bf16_t f2bf(float x) { return (bf16_t)(pack2(x, 0.f) & 0xffffu); }
DI float xsum16(float x) { const unsigned u = __float_as_uint(x); auto r = __builtin_amdgcn_permlane16_swap(u, u, false, false); return __uint_as_float(r[0]) + __uint_as_float(r[1]); }
DI float xsum32(float x) { const unsigned u = __float_as_uint(x); auto r = __builtin_amdgcn_permlane32_swap(u, u, false, false); return __uint_as_float(r[0]) + __uint_as_float(r[1]); }
DI float lo16(unsigned w) { return __uint_as_float(w << 16); }
DI float hi16(unsigned w) { return __uint_as_float(w & 0xffff0000u); }
DI void unpack8(u32x4 w, float* v) { v[0] = lo16(w.x); v[1] = hi16(w.x); v[2] = lo16(w.y); v[3] = hi16(w.y); v[4] = lo16(w.z); v[5] = hi16(w.z); v[6] = lo16(w.w); v[7] = hi16(w.w); }
DI u32x4 pack8(const float* v) { u32x4 w; w.x = pack2(v[0], v[1]); w.y = pack2(v[2], v[3]); w.z = pack2(v[4], v[5]); w.w = pack2(v[6], v[7]); return w; }
template <int K> DI float shx(float v) { return __int_as_float(__builtin_amdgcn_ds_swizzle(__float_as_int(v), 0x1f | (K << 10))); }
DI float wave_sum(float v) { v += shx<1>(v); v += shx<2>(v); v += shx<4>(v); v += shx<8>(v); v += shx<16>(v); return xsum32(v); }
DI float qsum(float v) {
  v += __int_as_float(__builtin_amdgcn_update_dpp(0, __float_as_int(v), 0xB1, 0xf, 0xf, true));
  v += __int_as_float(__builtin_amdgcn_update_dpp(0, __float_as_int(v), 0x4E, 0xf, 0xf, true));
  return v;
}
DI float osum(float v) {
  v = qsum(v);
  v += __int_as_float(__builtin_amdgcn_update_dpp(0, __float_as_int(v), 0x141, 0xf, 0xf, true));
  return v;
}
DI int crow(int reg, int h) { return (reg & 3) + 8 * (reg >> 2) + 4 * h; }
DI int crowu(int reg) { return (reg & 3) + 8 * (reg >> 2); }
DI int perm16(int t) { return (t & ~12) | ((t & 4) << 1) | ((t & 8) >> 1); }
DI float sigmoidf_(float x) { return __builtin_amdgcn_rcpf(1.0f + __expf(-x)); }
DI float siluf_(float x) { return x * __builtin_amdgcn_rcpf(1.0f + __expf(-x)); }

DI void row_decode(int row, int& seq, int& t) {
  if (row < NCTX) { seq = row >> 8; t = row & 255; } else { seq = 32 + ((row - NCTX) >> 12); t = (row - NCTX) & 4095; }
}
DI int keyrow0(int seq) { return seq < 32 ? seq * 256 : NCTX + (seq - 32) * 4608; }
DI int seq_tk(int seq) { return seq < 32 ? 256 : 4608; }

template <int NJ>
DI void gemm_mainloop(f32x16 (&acc)[2][NJ], const bf16_t* __restrict__ A, int lda, int ks,
                      const bf16_t* __restrict__ Bt, int ldb, int K, char* smem) {
  constexpr int A_BYTES = 128 * 128;
  constexpr int B_BYTES = 64 * NJ * 128;
  constexpr int STAGE = A_BYTES + B_BYTES;
  const int tid = otid(), lane = tid & 63, wid = __builtin_amdgcn_readfirstlane(tid >> 6), wm = wid >> 1, wn = wid & 1;
  const int r = lane & 31, hh = lane >> 5;
  const int nk = K >> 6;
  const int lrow = tid >> 3, lc = tid & 7;
  u32x4 ra[4], rb[2 * NJ];
  const bf16_t* ap = A + (size_t)lrow * lda + lc * 8;
  const bf16_t* bp = Bt + (size_t)lrow * ldb + lc * 8;
#pragma unroll
  for (int p = 0; p < 4; ++p) ra[p] = *(const u32x4*)(ap + (size_t)(32 * p) * lda);
#pragma unroll
  for (int p = 0; p < 2 * NJ; ++p) rb[p] = *(const u32x4*)(bp + (size_t)(32 * p) * ldb);
  {
    char* base = smem;
#pragma unroll
    for (int p = 0; p < 4; ++p) { const int row = lrow + 32 * p; *(u32x4*)(base + row * 128 + ((lc ^ ((row >> 1) & 7)) << 4)) = ra[p]; }
#pragma unroll
    for (int p = 0; p < 2 * NJ; ++p) { const int row = lrow + 32 * p; *(u32x4*)(base + A_BYTES + row * 128 + ((lc ^ ((row >> 1) & 7)) << 4)) = rb[p]; }
  }
  if (nk > 1) {
    const bf16_t* ap2 = ap + (size_t)ks;
    const bf16_t* bp2 = bp + (size_t)64;
#pragma unroll
    for (int p = 0; p < 4; ++p) ra[p] = *(const u32x4*)(ap2 + (size_t)(32 * p) * lda);
#pragma unroll
    for (int p = 0; p < 2 * NJ; ++p) rb[p] = *(const u32x4*)(bp2 + (size_t)(32 * p) * ldb);
  }
  __syncthreads();
  for (int kt = 0; kt < nk; ++kt) {
    const char* base = smem + (kt & 1) * STAGE;
#pragma unroll
    for (int s = 0; s < 4; ++s) {
      bf16x8 af[2], bfr[NJ];
#pragma unroll
      for (int i = 0; i < 2; ++i) { const int row = wm * 64 + i * 32 + r; af[i] = *(const bf16x8*)(base + row * 128 + (((2 * s + hh) ^ ((row >> 1) & 7)) << 4)); }
#pragma unroll
      for (int j = 0; j < NJ; ++j) { const int row = wn * (32 * NJ) + j * 32 + r; bfr[j] = *(const bf16x8*)(base + A_BYTES + row * 128 + (((2 * s + hh) ^ ((row >> 1) & 7)) << 4)); }
#pragma unroll
      for (int i = 0; i < 2; ++i)
#pragma unroll
        for (int j = 0; j < NJ; ++j) acc[i][j] = MFMA32(af[i], bfr[j], acc[i][j]);
    }
    if (kt + 1 < nk) {
      char* nb = smem + ((kt + 1) & 1) * STAGE;
#pragma unroll
      for (int p = 0; p < 4; ++p) { const int row = lrow + 32 * p; *(u32x4*)(nb + row * 128 + ((lc ^ ((row >> 1) & 7)) << 4)) = ra[p]; }
#pragma unroll
      for (int p = 0; p < 2 * NJ; ++p) { const int row = lrow + 32 * p; *(u32x4*)(nb + A_BYTES + row * 128 + ((lc ^ ((row >> 1) & 7)) << 4)) = rb[p]; }
      if (kt + 2 < nk) {
        const bf16_t* ap2 = ap + (size_t)(kt + 2) * ks;
        const bf16_t* bp2 = bp + (size_t)(kt + 2) * 64;
#pragma unroll
        for (int p = 0; p < 4; ++p) ra[p] = *(const u32x4*)(ap2 + (size_t)(32 * p) * lda);
#pragma unroll
        for (int p = 0; p < 2 * NJ; ++p) rb[p] = *(const u32x4*)(bp2 + (size_t)(32 * p) * ldb);
      }
    }
    __syncthreads();
  }
}

template <int NJ> DI void zero_acc(f32x16 (&acc)[2][NJ]) {
#pragma unroll
  for (int i = 0; i < 2; ++i)
#pragma unroll
    for (int j = 0; j < NJ; ++j)
#pragma unroll
      for (int e = 0; e < 16; ++e) acc[i][j][e] = 0.f;
}

DI void phase_prologue(const Params& p, char* smem) {
  const int tid = otid(), lane = tid & 63, wid = __builtin_amdgcn_readfirstlane(tid >> 6);
  float* mod = (float*)(p.ws + OFF_MOD);
  if (blockIdx.x == 0) {
    if (tid < 32) ((unsigned*)(p.ws + OFF_CNT))[tid] = 0u;
    float* cs16 = (float*)(p.ws + OFF_CS16);
    float* cs8 = (float*)(p.ws + OFF_CS8);
    for (int e = tid; e < 64 * 16; e += 256) { const int pos = e >> 4, i = e & 15; const float inv = expf(-9.210340371976184f * (float)i / 16.0f); const float a = (float)pos * inv; cs16[e * 2] = cosf(a); cs16[e * 2 + 1] = sinf(a); }
    for (int e = tid; e < 64 * 8; e += 256) { const int pos = e >> 3, i = e & 7; const float inv = expf(-9.210340371976184f * (float)i / 8.0f); const float a = (float)pos * inv; cs8[e * 2] = cosf(a); cs8[e * 2 + 1] = sinf(a); }
  }
  float* sl = (float*)smem;
  float* red = sl + 9 * 1024;
  for (int e = tid; e < 9 * 1024; e += 256) { const int j = e >> 10, k = e & 1023; const float* cc0 = opq(p.in[I_CCTX]); const float* cc1 = opq(p.in[I_C]); const float c = j == 0 ? cc0[k] : cc1[(j - 1) * 1024 + k]; sl[e] = siluf_(c); }
  __syncthreads();
  for (int item = blockIdx.x; item < 192; item += gridDim.x) {
    const int l = item / 48, n = (item % 48) * 64 + lane;
    const float* w = p.in[I_WMOD] + (size_t)l * 1024 * 3072 + n;
    float a[9];
#pragma unroll
    for (int j = 0; j < 9; ++j) a[j] = 0.f;
    for (int k = wid * 256; k < wid * 256 + 256; ++k) {
      const float wv = w[(size_t)k * 3072];
#pragma unroll
      for (int j = 0; j < 9; ++j) a[j] += sl[j * 1024 + k] * wv;
    }
#pragma unroll
    for (int j = 0; j < 9; ++j) red[(wid * 9 + j) * 64 + lane] = a[j];
    __syncthreads();
    for (int e = tid; e < 9 * 64; e += 256) {
      const int j = e >> 6, c = e & 63;
      const float s = red[(0 * 9 + j) * 64 + c] + red[(1 * 9 + j) * 64 + c] + red[(2 * 9 + j) * 64 + c] + red[(3 * 9 + j) * 64 + c];
      const int nn = (item % 48) * 64 + c;
      mod[((size_t)l * 9 + j) * MODLD + nn] = s + p.in[I_BMOD][l * 3072 + nn];
    }
    __syncthreads();
  }
}

DI const float* x_row_ptr(const Params& p, int l, int row) {
  const float* xp = opq(p.in[I_XP]); const float* xs = opq(p.in[I_XS]); const float* xo = opq((const float*)p.out);
  if (l == 0) return row < NCTX ? xp + (size_t)row * 1024 : xs + (size_t)(row - NCTX) * 1024;
  return xo + (size_t)row * 1024;
}
DI void norm_row(const Params& p, int l, int row, int lane) {
  const float* x = x_row_ptr(p, l, row);
  const int j = row < NCTX ? 0 : 1 + ((row - NCTX) >> 12);
  const float* mod = (const float*)(p.ws + OFF_MOD) + ((size_t)l * 9 + j) * MODLD;
  const float* nw = p.in[I_NORMW] + l * 1024;
  bf16_t* h = (bf16_t*)(p.ws + OFF_R1) + (size_t)row * 1024;
  f32x4 v[4]; float ss = 0.f;
#pragma unroll
  for (int i = 0; i < 4; ++i) { v[i] = *(const f32x4*)(x + lane * 4 + 256 * i); ss += v[i].x * v[i].x + v[i].y * v[i].y + v[i].z * v[i].z + v[i].w * v[i].w; }
ss = wave_sum(ss);
  const float rs = rsqrtf(ss * (1.0f / 1024.0f) + 1e-6f);
#pragma unroll
  for (int i = 0; i < 4; ++i) {
    const int c = lane * 4 + 256 * i;
    const f32x4 w = *(const f32x4*)(nw + c), sh = *(const f32x4*)(mod + c), sc = *(const f32x4*)(mod + 1024 + c);
    u32x2 o;
    o.x = pack2(v[i].x * rs * w.x * (1.f + sc.x) + sh.x, v[i].y * rs * w.y * (1.f + sc.y) + sh.y);
    o.y = pack2(v[i].z * rs * w.z * (1.f + sc.z) + sh.z, v[i].w * rs * w.w * (1.f + sc.w) + sh.w);
    *(u32x2*)(h + c) = o;
  }
}

DI int win_srccol(int j) {
  if (j < 768) return j;
  if (j < 1696) return j + 512;
  if (j < 3488) return j + 1024;
  if (j < 3584) return -1;
  if (j < 5120) { const int jj = j - 3584; return jj < 512 ? 768 + jj : (jj < 1024 ? 2208 + (jj - 512) : 4512 + (jj - 1024)); }
  return 5024 + (j - 5120);
}
DI void conv_tile(const float* __restrict__ src, int ld_src, bf16_t* dst, int ld_dst, int k0, int n0, int kind, int srcoff, char* smem) {
  float* tile = (float*)smem;
  const int tid = otid();
  const int n = tid & 63;
  int sc = kind == 0 ? win_srccol(n0 + n) : (n0 + n - srcoff);
#pragma unroll
  for (int i = 0; i < 16; ++i) { const int k = i * 4 + (tid >> 6); tile[k * 65 + n] = sc >= 0 ? src[(size_t)(k0 + k) * ld_src + sc] : 0.f; }
  __syncthreads();
#pragma unroll
  for (int i = 0; i < 8; ++i) { const int nn = i * 8 + (tid >> 5), kk = (tid & 31) * 2; *(unsigned*)(dst + (size_t)(n0 + nn) * ld_dst + k0 + kk) = pack2(tile[kk * 65 + nn], tile[(kk + 1) * 65 + nn]); }
  __syncthreads();
}

DI void phase_norm_convert(const Params& p, int l, char* smem) {
  const int tid = otid(), lane = tid & 63, wid = __builtin_amdgcn_readfirstlane(tid >> 6);
  bf16_t* WinT = (bf16_t*)(p.ws + OFF_WIN); bf16_t* WoT = (bf16_t*)(p.ws + OFF_WO); bf16_t* WoutT = (bf16_t*)(p.ws + OFF_WOUT); bf16_t* WuT = (bf16_t*)(p.ws + OFF_WU);
  const int NI_WIN = 128 * 16, NI_WO = 3 * 16 * 8, NI_WOUT = 16 * 16, NI_WU = 16 * 2;
  const int NI_CONV = NI_WIN + NI_WO + NI_WOUT + NI_WU;
  for (int item = blockIdx.x; item < NI_CONV; item += gridDim.x) {
    int it = item;
    if (it < NI_WIN) { conv_tile(p.in[I_WIN] + (size_t)l * 1024 * 8096, 8096, WinT, 1024, (it & 15) * 64, (it >> 4) * 64, 0, 0, smem); continue; }
    it -= NI_WIN;
    if (it < NI_WO) { const int br = it / 128, r2 = it % 128; const float* src = (br == 0 ? opq(p.in[I_WOA]) : (br == 1 ? opq(p.in[I_WOB]) : opq(p.in[I_WOC]))) + (size_t)l * 512 * 1024; conv_tile(src, 1024, WoT + (size_t)br * 1024 * 512, 512, (r2 & 7) * 64, (r2 >> 3) * 64, 1, 0, smem); continue; }
    it -= NI_WO;
    if (it < NI_WOUT) { conv_tile(p.in[I_WOUT] + (size_t)l * 1024 * 1024, 1024, WoutT, 1024, (it & 15) * 64, (it >> 4) * 64, 1, 0, smem); continue; }
    it -= NI_WOUT;
    { const int nt = it >> 1, kt = it & 1; const bool uv = nt >= 8; const float* src = (uv ? opq(p.in[I_WUV]) : opq(p.in[I_WUK])) + (size_t)l * 128 * 512; conv_tile(src, 512, WuT, 128, kt * 64, nt * 64, 1, uv ? 512 : 0, smem); }
  }
  for (int item = blockIdx.x; item < NT / 4; item += gridDim.x) norm_row(p, l, item * 4 + wid, lane);
}

DI void phase_gemm1(const Params& p, int l, char* smem) {
  const bf16_t* H = (const bf16_t*)(p.ws + OFF_R1);
  const bf16_t* W = (const bf16_t*)(p.ws + OFF_WIN);
  bf16_t* U = (bf16_t*)(p.ws + OFF_U);
  bf16_t* VAT = (bf16_t*)(p.ws + OFF_VAT);
  const int NTN = 28, ntiles = 320 * NTN;
  for (int tile = blockIdx.x; tile < ntiles; tile += gridDim.x) {
    const int mt = tile / NTN, nt = tile % NTN, m0 = mt * 128, n0 = nt * 128;
    f32x16 acc[2][2]; zero_acc<2>(acc);
    gemm_mainloop<2>(acc, H + (size_t)m0 * 1024, 1024, 64, W + (size_t)n0 * 1024, 1024, 1024, smem);
    const int lane = otid() & 63, wid = __builtin_amdgcn_readfirstlane(otid() >> 6), wm = wid >> 1, wn = wid & 1, r = lane & 31, hh = lane >> 5;
    int seq, t0; row_decode(m0, seq, t0);
#pragma unroll
    for (int j = 0; j < 2; ++j) {
      const int cb = n0 + wn * 64 + j * 32;
      if (cb >= ULD) continue;
      const int col = cb + r;
      if (cb >= 640 && cb < 768) {
        const int kvh = (col - 640) >> 6, dv = col & 63, Tk = seq_tk(seq);
        bf16_t* vt = VAT + (size_t)128 * keyrow0(seq) + (size_t)(kvh * 64 + dv) * Tk;
#pragma unroll
        for (int i = 0; i < 2; ++i) {
          const int tt = t0 + wm * 64 + i * 32;
#pragma unroll
          for (int g2 = 0; g2 < 2; ++g2) {
            float v[8];
#pragma unroll
            for (int e = 0; e < 8; ++e) v[e] = acc[i][j][g2 * 8 + e];
            *(u32x4*)(vt + tt + 16 * g2 + 8 * hh) = pack8(v);
          }
          if (seq < 32) {
            float* o = p.out + OUT_AV + ((size_t)(seq * 4 + l) * 256 + tt) * 128;
            const int lo = 4 * hh * 128 + (col - 640);
#pragma unroll
            for (int e = 0; e < 16; ++e) (o + crowu(e) * 128)[lo] = acc[i][j][e];
          }
        }
      } else {
#pragma unroll
        for (int i = 0; i < 2; ++i) {
          bf16_t* up = U + (size_t)(m0 + wm * 64 + i * 32) * ULD;
          const int lo = 4 * hh * ULD + col;
#pragma unroll
          for (int e = 0; e < 16; ++e) (up + crowu(e) * ULD)[lo] = f2bf(acc[i][j][e]);
        }
      }
    }
  }
}

DI void post_row(const Params& p, int l, int row, int lane) {
  int seq, t; row_decode(row, seq, t);
  const bool lat = row >= NCTX;
  const int krow = keyrow0(seq) + t;
  const int prow = t >> 6, pcol = t & 63;
  bf16_t* u = (bf16_t*)(p.ws + OFF_U) + (size_t)row * ULD;
  const float* cs16 = (const float*)(p.ws + OFF_CS16);
  const float* cs8 = (const float*)(p.ws + OFF_CS8);
  const float LOG2E = 1.4426950408889634f;
#pragma unroll
  for (int which = 0; which < 2; ++which) {
    const int l8 = which == 0 ? lane : (lane & 15);
    const bf16_t* src = u + (which == 0 ? 0 : 512) + l8 * 8;
    float v[8]; unpack8(*(const u32x4*)src, v);
    float ss = 0.f;
#pragma unroll
    for (int i = 0; i < 8; ++i) ss += v[i] * v[i];
    ss += shx<1>(ss); ss += shx<2>(ss); ss += shx<4>(ss);
    const float rs = rsqrtf(ss * (1.0f / 64.0f) + 1e-6f);
    const float* nw = (which == 0 ? opq(p.in[I_QNW]) : opq(p.in[I_KNW])) + l * 64 + (lane & 7) * 8;
#pragma unroll
    for (int i = 0; i < 8; ++i) v[i] = v[i] * rs * nw[i];
    float pv[8];
#pragma unroll
    for (int i = 0; i < 8; ++i) pv[i] = shx<2>(v[i]);
    if (lat) {
      const int pos = ((lane & 7) >> 2) ? pcol : prow;
      const bool lower = (lane & 2) == 0;
      const float* cs = cs16 + (pos * 16 + (lane & 1) * 8) * 2;
#pragma unroll
      for (int i = 0; i < 8; ++i) { const float c = cs[i * 2], s = cs[i * 2 + 1]; v[i] = lower ? v[i] * c - pv[i] * s : v[i] * c + pv[i] * s; }
    }
    if (which == 0) {
      const float sc = 0.125f * LOG2E;
#pragma unroll
      for (int i = 0; i < 8; ++i) v[i] *= sc;
      *(u32x4*)(u + lane * 8) = pack8(v);
    } else if (lane < 16) {
      bf16_t* KA = (bf16_t*)(p.ws + OFF_KA);
      *(u32x4*)(KA + (size_t)krow * 128 + lane * 8) = pack8(v);
      if (!lat) {
        float* o = p.out + OUT_AK + ((size_t)(seq * 4 + l) * 256 + t) * 128 + lane * 8;
        *(f32x4*)o = (f32x4){v[0], v[1], v[2], v[3]}; *(f32x4*)(o + 4) = (f32x4){v[4], v[5], v[6], v[7]};
      }
    }
  }
  {
    const float sc = 0.10206207261596577f * LOG2E;
    const int hd = lane >> 3;
    bf16_t* q = u + 768 + hd * 96;
    { float v[8]; unpack8(*(const u32x4*)(q + (lane & 7) * 8), v);
#pragma unroll
      for (int i = 0; i < 8; ++i) v[i] *= sc;
      *(u32x4*)(q + (lane & 7) * 8) = pack8(v); }
    { bf16_t* qr = q + 64 + (lane & 7) * 4;
      const u32x2 w = *(const u32x2*)qr;
      float v[4] = {lo16(w.x), hi16(w.x), lo16(w.y), hi16(w.y)}, pv[4];
#pragma unroll
      for (int i = 0; i < 4; ++i) pv[i] = shx<2>(v[i]);
      if (lat) {
        const int pos = ((lane & 7) >> 2) ? pcol : prow;
        const bool lower = (lane & 2) == 0;
        const float* cs = cs8 + (pos * 8 + (lane & 1) * 4) * 2;
#pragma unroll
        for (int i = 0; i < 4; ++i) { const float c = cs[i * 2], s = cs[i * 2 + 1]; v[i] = lower ? v[i] * c - pv[i] * s : v[i] * c + pv[i] * s; }
      }
      u32x2 o; o.x = pack2(v[0] * sc, v[1] * sc); o.y = pack2(v[2] * sc, v[3] * sc);
      *(u32x2*)qr = o; }
  }
  {
    const unsigned w = *(const unsigned*)(u + 1536 + lane * 2);
    float a = lo16(w), b = hi16(w);
    float ss = a * a + b * b;
ss = wave_sum(ss);
    const float rs = rsqrtf(ss * (1.0f / 128.0f) + 1e-6f);
    const float* nw = p.in[I_KVNW] + l * 128 + lane * 2;
    a = a * rs * nw[0]; b = b * rs * nw[1];
    bf16_t* CKVN = (bf16_t*)(p.ws + OFF_R2);
    *(unsigned*)(CKVN + (size_t)krow * 128 + lane * 2) = pack2(a, b);
    if (!lat) { float* o = p.out + OUT_CKV + ((size_t)(seq * 4 + l) * 256 + t) * 128 + lane * 2; *(f32x2*)o = (f32x2){a, b}; }
  }
  {
    float v = bf2f(u[1664 + (lane & 31)]);
    const float pv = shx<8>(v);
    if (!lat) { if (lane < 32) p.out[OUT_KR + ((size_t)(seq * 4 + l) * 256 + t) * 32 + lane] = v; }
    else {
      const int d = lane & 31; const int pos = (d >> 4) ? pcol : prow; const bool lower = (d & 8) == 0;
      const float* cs = cs8 + (pos * 8 + (d & 7)) * 2;
      v = lower ? v * cs[0] - pv * cs[1] : v * cs[0] + pv * cs[1];
    }
    if (lane < 32) ((bf16_t*)(p.ws + OFF_KRB))[(size_t)krow * 32 + lane] = f2bf(v);
  }
}
DI void post_cached_row(const Params& p, int l, int idx, int lane) {
  const int b = idx >> 9, j = idx & 511;
  const int kr0 = NCTX + b * 4608, krow = kr0 + 4096 + j;
  const size_t cb = ((size_t)(b * 4 + l) * 512 + j);
  bf16_t* KA = (bf16_t*)(p.ws + OFF_KA); bf16_t* VAT = (bf16_t*)(p.ws + OFF_VAT); bf16_t* CKVN = (bf16_t*)(p.ws + OFF_R2); bf16_t* KRB = (bf16_t*)(p.ws + OFF_KRB);
  { const f32x2 v = *(const f32x2*)(p.in[I_CAK] + cb * 128 + lane * 2); *(unsigned*)(KA + (size_t)krow * 128 + lane * 2) = pack2(v.x, v.y); }
  { const f32x2 v = *(const f32x2*)(p.in[I_CAV] + cb * 128 + lane * 2);
    bf16_t* vt = VAT + (size_t)128 * kr0 + (size_t)(lane * 2) * 4608 + perm16(4096 + j);
    vt[0] = f2bf(v.x); vt[4608] = f2bf(v.y); }
  { const f32x2 v = *(const f32x2*)(p.in[I_CCKV] + cb * 128 + lane * 2); *(unsigned*)(CKVN + (size_t)krow * 128 + lane * 2) = pack2(v.x, v.y); }
  if (lane < 32) KRB[(size_t)krow * 32 + lane] = f2bf(p.in[I_CKR][cb * 32 + lane]);
}
DI void phase_post(const Params& p, int l) {
  const int lane = otid() & 63, wid = __builtin_amdgcn_readfirstlane(otid() >> 6);
  for (int item = blockIdx.x; item < NT / 4 + 1024; item += gridDim.x) {
    if (item < NT / 4) post_row(p, l, item * 4 + wid, lane);
    else post_cached_row(p, l, (item - NT / 4) * 4 + wid, lane);
  }
}

DI void phase_upproj(const Params& p, char* smem) {
  const bf16_t* A = (const bf16_t*)(p.ws + OFF_R2);
  const bf16_t* W = (const bf16_t*)(p.ws + OFF_WU);
  bf16_t* KN = (bf16_t*)(p.ws + OFF_KN); bf16_t* VBT = (bf16_t*)(p.ws + OFF_VBT);
  const int ntiles = 352 * 8;
  for (int tile = blockIdx.x; tile < ntiles; tile += gridDim.x) {
    const int mt = tile >> 3, nt = tile & 7, m0 = mt * 128, n0 = nt * 128;
    f32x16 acc[2][2]; zero_acc<2>(acc);
    gemm_mainloop<2>(acc, A + (size_t)m0 * 128, 128, 64, W + (size_t)n0 * 128, 128, 128, smem);
    const int lane = otid() & 63, wid = __builtin_amdgcn_readfirstlane(otid() >> 6), wm = wid >> 1, wn = wid & 1, r = lane & 31, hh = lane >> 5;
    int seq, t0;
    if (m0 < NCTX) { seq = m0 >> 8; t0 = m0 & 255; } else { const int rr = m0 - NCTX; seq = 32 + rr / 4608; t0 = rr % 4608; }
#pragma unroll
    for (int j = 0; j < 2; ++j) {
      const int col = n0 + wn * 64 + j * 32 + r;
      if (n0 < 512) {
#pragma unroll
        for (int i = 0; i < 2; ++i) {
          bf16_t* kp = KN + (size_t)(m0 + wm * 64 + i * 32) * 512;
          const int lo = 4 * hh * 512 + col;
#pragma unroll
          for (int e = 0; e < 16; ++e) (kp + crowu(e) * 512)[lo] = f2bf(acc[i][j][e]);
        }
      } else {
        const int Tk = seq_tk(seq);
        bf16_t* vt = VBT + (size_t)512 * keyrow0(seq) + (size_t)(col - 512) * Tk;
#pragma unroll
        for (int i = 0; i < 2; ++i) {
          const int tt = t0 + wm * 64 + i * 32;
#pragma unroll
          for (int g2 = 0; g2 < 2; ++g2) {
            float v[8];
#pragma unroll
            for (int e = 0; e < 8; ++e) v[e] = acc[i][j][g2 * 8 + e];
            *(u32x4*)(vt + tt + 16 * g2 + 8 * hh) = pack8(v);
          }
        }
      }
    }
  }
}

template <int DQK>
DI void attn_item(const bf16_t* Qw, int q_ld, const bf16_t* K1, int k1_ld, const bf16_t* K2, int k2_ld,
                  const bf16_t* Vt, int vt_ld, int nkeys, bf16_t* Ow, int o_ld, char* smem) {
  constexpr int KS = DQK * 2 + 16;
  constexpr int KBYTES = 64 * KS;
  constexpr int VS = 144;
  constexpr int VBYTES = 64 * VS;
  constexpr int STAGE = KBYTES + VBYTES;
  constexpr int CPR = DQK / 8;
  constexpr int NKC = 64 * CPR / 256;
  constexpr int NS = DQK / 16;
  const int tid = otid(), lane = tid & 63, r = lane & 31, hh = lane >> 5;
  bf16x8 qf[NS];
#pragma unroll
  for (int s = 0; s < NS; ++s) qf[s] = *(const bf16x8*)(Qw + (size_t)r * q_ld + 16 * s + 8 * hh);
  f32x16 o[2];
#pragma unroll
  for (int n = 0; n < 2; ++n)
#pragma unroll
    for (int e = 0; e < 16; ++e) o[n][e] = 0.f;
  float m_run = -1e30f, lsum = 0.f;
  u32x4 rk0[NKC], rv0[2], rk1[NKC], rv1[2];
  int krow_[NKC], kc_[NKC];
#pragma unroll
  for (int q = 0; q < NKC; ++q) { const int id = q * 256 + tid; krow_[q] = id / CPR; kc_[q] = id % CPR; }
  const int vrow = tid >> 3, vc = tid & 7;
  auto gload = [&](int key0, u32x4 (&rk)[NKC], u32x4 (&rv)[2]) {
#pragma unroll
    for (int q = 0; q < NKC; ++q) {
      const bf16_t* src = (DQK == 64 || kc_[q] < 8) ? K1 + (size_t)(key0 + krow_[q]) * k1_ld + kc_[q] * 8 : K2 + (size_t)(key0 + krow_[q]) * k2_ld + (kc_[q] - 8) * 8;
      rk[q] = *(const u32x4*)src;
    }
#pragma unroll
    for (int q = 0; q < 2; ++q) rv[q] = *(const u32x4*)(Vt + (size_t)(vrow + 32 * q) * vt_ld + key0 + vc * 8);
  };
  auto lstore = [&](int buf, u32x4 (&rk)[NKC], u32x4 (&rv)[2]) {
    char* base = smem + buf * STAGE;
#pragma unroll
    for (int q = 0; q < NKC; ++q) *(u32x4*)(base + krow_[q] * KS + kc_[q] * 16) = rk[q];
#pragma unroll
    for (int q = 0; q < 2; ++q) *(u32x4*)(base + KBYTES + (vrow + 32 * q) * VS + vc * 16) = rv[q];
  };
  const int ntl = nkeys >> 6;
  gload(0, rk0, rv0); lstore(0, rk0, rv0);
  gload(64, rk1, rv1);
  if (ntl > 2) gload(128, rk0, rv0);
  __syncthreads();
  auto tile_body = [&](int tl, u32x4 (&rkn)[NKC], u32x4 (&rvn)[2]) {
    const char* base = smem + (tl & 1) * STAGE;
    bf16x8 kf[2][NS], vf[2][2][2];
#pragma unroll
    for (int kb = 0; kb < 2; ++kb)
#pragma unroll
      for (int ks = 0; ks < NS; ++ks) kf[kb][ks] = *(const bf16x8*)(base + (kb * 32 + r) * KS + (2 * ks + hh) * 16);
    __builtin_amdgcn_sched_barrier(0);
    f32x16 s[2];
#pragma unroll
    for (int kb = 0; kb < 2; ++kb)
#pragma unroll
      for (int e = 0; e < 16; ++e) s[kb][e] = 0.f;
#pragma unroll
    for (int ks = 0; ks < NS; ++ks)
#pragma unroll
      for (int kb = 0; kb < 2; ++kb) s[kb] = MFMA32(kf[kb][ks], qf[ks], s[kb]);
#pragma unroll
    for (int kb = 0; kb < 2; ++kb)
#pragma unroll
      for (int s2 = 0; s2 < 2; ++s2)
#pragma unroll
        for (int n = 0; n < 2; ++n) vf[kb][s2][n] = *(const bf16x8*)(base + KBYTES + (32 * n + r) * VS + (kb * 32 + 16 * s2 + 8 * hh) * 2);
    __builtin_amdgcn_sched_barrier(0);
    float mx = s[0][0];
#pragma unroll
    for (int kb = 0; kb < 2; ++kb)
#pragma unroll
      for (int e = 0; e < 16; ++e) mx = fmaxf(mx, s[kb][e]);
    { const unsigned u = __float_as_uint(mx); auto sw = __builtin_amdgcn_permlane32_swap(u, u, false, false); mx = fmaxf(__uint_as_float(sw[0]), __uint_as_float(sw[1])); }
    const float m_new = fmaxf(m_run, mx);
    const float alpha = __builtin_amdgcn_exp2f(m_run - m_new);
    m_run = m_new;
    float ps = 0.f;
#pragma unroll
    for (int kb = 0; kb < 2; ++kb)
#pragma unroll
      for (int e = 0; e < 16; ++e) { const float pe = __builtin_amdgcn_exp2f(s[kb][e] - m_new); s[kb][e] = pe; ps += pe; }
    lsum = lsum * alpha + ps;
    if (__builtin_amdgcn_ballot_w64(alpha != 1.0f) != 0ull) {
#pragma unroll
      for (int n = 0; n < 2; ++n)
#pragma unroll
        for (int e = 0; e < 16; ++e) o[n][e] *= alpha;
    }
#pragma unroll
    for (int kb = 0; kb < 2; ++kb)
#pragma unroll
      for (int s2 = 0; s2 < 2; ++s2) {
        u32x4 pw;
        pw.x = pack2(s[kb][8 * s2 + 0], s[kb][8 * s2 + 1]); pw.y = pack2(s[kb][8 * s2 + 2], s[kb][8 * s2 + 3]);
        pw.z = pack2(s[kb][8 * s2 + 4], s[kb][8 * s2 + 5]); pw.w = pack2(s[kb][8 * s2 + 6], s[kb][8 * s2 + 7]);
        const bf16x8 pf = __builtin_bit_cast(bf16x8, pw);
#pragma unroll
        for (int n = 0; n < 2; ++n) o[n] = MFMA32(vf[kb][s2][n], pf, o[n]);
      }
    if (tl + 1 < ntl) { lstore((tl + 1) & 1, rkn, rvn); if (tl + 3 < ntl) gload((tl + 3) * 64, rkn, rvn); }
    __syncthreads();
  };
  for (int tl = 0; tl < ntl; tl += 2) { tile_body(tl, rk1, rv1); tile_body(tl + 1, rk0, rv0); }
  lsum = xsum32(lsum);
  const float inv = 1.0f / lsum;
#pragma unroll
  for (int n = 0; n < 2; ++n)
#pragma unroll
    for (int g = 0; g < 4; ++g) {
      u32x2 w; w.x = pack2(o[n][4 * g] * inv, o[n][4 * g + 1] * inv); w.y = pack2(o[n][4 * g + 2] * inv, o[n][4 * g + 3] * inv);
      *(u32x2*)(Ow + (size_t)r * o_ld + 32 * n + 8 * g + 4 * hh) = w;
    }
}

DI void scan_item(const Params& p, int l, int seq, int hd, int dir, int rs, char* smem) {
  const int tid = otid(), lane = tid & 63, wv = __builtin_amdgcn_readfirstlane(tid >> 6);
  const int j8 = lane & 7, r = lane & 31, hh = lane >> 5;
  const bool lat = seq >= 32;
  const int T = lat ? 4096 : 256;
  const int row0 = lat ? NCTX + (seq - 32) * 4096 : seq * 256;
  float* vA = (float*)smem; float* vK = vA + 2048; float* vR = vK + 2048; float* vV = vR + 2048; float* vW = vV + 2048; float* vB = vW + 2048; float* ybuf = vB + 2048;
  char* raw = smem + 32768;
  char* wdx = smem + 57344; char* adx = smem + 61952;
  float* tmpb = (float*)(smem + 66816);
  const bf16_t* U = (const bf16_t*)(p.ws + OFF_U);
  bf16_t* Y = (bf16_t*)(p.ws + OFF_R2) + (dir ? (size_t)NT * 512 : 0);
  float* bonus = (float*)(p.ws + OFF_BONUS);
  const int lrow = 8 * wv + (lane >> 3), irow = rs * 32 + lrow;
  f32x2 S[4];
  if (lat) {
    const float* s0 = (dir ? opq(p.in[I_SB]) : opq(p.in[I_SF])) + ((size_t)((seq - 32) * 4 + l) * 8 + hd) * 4096 + irow * 64 + j8 * 8;
#pragma unroll
    for (int q = 0; q < 2; ++q) { const f32x4 v = *(const f32x4*)(s0 + 4 * q); S[2 * q] = (f32x2){v.x, v.y}; S[2 * q + 1] = (f32x2){v.z, v.w}; }
  } else {
#pragma unroll
    for (int q = 0; q < 4; ++q) S[q] = (f32x2){0.f, 0.f};
  }
  const int mat = wv >> 1, ntc = wv & 1, cch = ntc * 32 + r, hc = hd * 64 + cch;
  bf16x8 bfrag[4];
  {
    const float* W = (mat ? opq(p.in[I_AUP]) : opq(p.in[I_WUP])) + (size_t)(l * 2 + dir) * 64 * 512 + hc;
#pragma unroll
    for (int s4 = 0; s4 < 4; ++s4) {
      float w8[8];
#pragma unroll
      for (int j = 0; j < 8; ++j) w8[j] = W[(size_t)(16 * s4 + 8 * hh + j) * 512];
      bfrag[s4] = __builtin_bit_cast(bf16x8, pack8(w8));
    }
  }
  const float bias = (mat ? opq(p.in[I_A0]) : opq(p.in[I_W0]))[(l * 2 + dir) * 512 + hc];
  const float kav = p.in[I_KA][l * 512 + hc], rkv = p.in[I_RK][l * 512 + hc];
  float* muP = (float*)(smem + 75008); float* muN = muP + 320; float* kkL = muN + 320;
  {
    const float* mup = p.in[I_MUP] + l * 1792; const float* mun = p.in[I_MUN] + l * 1792;
    for (int e = tid; e < 320; e += 256) { const int g = e >> 6, c = e & 63; const int col = (g < 3 ? g * 512 + hd * 64 : (g == 3 ? 1536 + dir * 64 : 1664 + dir * 64)) + c; muP[e] = mup[col]; muN[e] = mun[col]; }
    if (tid < 64) kkL[tid] = p.in[I_KK][l * 512 + hd * 64 + tid];
  }
  const int nch = T >> 5;
  u32x4 pre[6];
  auto prefetch = [&](int t0) {
#pragma unroll
    for (int q = 0; q < 6; ++q) {
      const int id = q * 256 + tid;
      const int row = id / 40, cc = id - row * 40, g = cc >> 3, c8 = cc & 7;
      const int t = t0 - 1 + row;
      const int col = (g < 3 ? g * 512 + hd * 64 : (g == 3 ? 1536 + dir * 64 : 1664 + dir * 64)) + c8 * 8;
      u32x4 v = (u32x4){0u, 0u, 0u, 0u};
      if (id < 1360 && t >= 0 && t < T) v = *(const u32x4*)(U + (size_t)(row0 + t) * ULD + 1696 + col);
      pre[q] = v;
    }
  };
  prefetch((dir ? nch - 1 : 0) * 32);
  for (int ci = 0; ci < nch; ++ci) {
    const int t0 = (dir ? nch - 1 - ci : ci) * 32;
#pragma unroll
    for (int q = 0; q < 6; ++q) { const int id = q * 256 + tid; if (id < 1360) *(u32x4*)(raw + id * 16) = pre[q]; }
    __syncthreads();
    if (ci + 1 < nch) prefetch((dir ? nch - 2 - ci : ci + 1) * 32);
    {
      const int tt = tid >> 3, sub = tid & 7;
#pragma unroll 1
      for (int g = 0; g < 5; ++g) {
        const int col = (g < 3 ? g * 512 + hd * 64 : (g == 3 ? 1536 + dir * 64 : 1664 + dir * 64)) + sub * 8;
        float c[8], pv[8], nx[8], x[8];
        unpack8(*(const u32x4*)(raw + (tt + 1) * 640 + (g * 8 + sub) * 16), c);
        unpack8(*(const u32x4*)(raw + tt * 640 + (g * 8 + sub) * 16), pv);
        unpack8(*(const u32x4*)(raw + (tt + 2) * 640 + (g * 8 + sub) * 16), nx);
        const f32x4 mp0 = *(const f32x4*)(muP + g * 64 + sub * 8), mp1 = *(const f32x4*)(muP + g * 64 + sub * 8 + 4), mn0 = *(const f32x4*)(muN + g * 64 + sub * 8), mn1 = *(const f32x4*)(muN + g * 64 + sub * 8 + 4);
        const float mp[8] = {mp0.x, mp0.y, mp0.z, mp0.w, mp1.x, mp1.y, mp1.z, mp1.w}, mn[8] = {mn0.x, mn0.y, mn0.z, mn0.w, mn1.x, mn1.y, mn1.z, mn1.w};
#pragma unroll
        for (int i = 0; i < 8; ++i) x[i] = c[i] + mp[i] * (pv[i] - c[i]) + mn[i] * (nx[i] - c[i]);
        const int lo = tt * 64 + sub * 8;
        if (g == 0) { *(f32x4*)(vR + lo) = (f32x4){x[0], x[1], x[2], x[3]}; *(f32x4*)(vR + lo + 4) = (f32x4){x[4], x[5], x[6], x[7]}; }
        else if (g == 1) {
          float kk[8], ss = 0.f;
          const float* kkw = kkL + sub * 8;
#pragma unroll
          for (int i = 0; i < 8; ++i) { kk[i] = x[i] * kkw[i]; ss += kk[i] * kk[i]; }
          *(f32x4*)(vK + lo) = (f32x4){x[0], x[1], x[2], x[3]}; *(f32x4*)(vK + lo + 4) = (f32x4){x[4], x[5], x[6], x[7]};
          ss += shx<1>(ss); ss += shx<2>(ss); ss += shx<4>(ss);
          const float inv = 1.0f / fmaxf(sqrtf(ss), 1e-12f);
          *(f32x4*)(vA + lo) = (f32x4){kk[0] * inv, kk[1] * inv, kk[2] * inv, kk[3] * inv}; *(f32x4*)(vA + lo + 4) = (f32x4){kk[4] * inv, kk[5] * inv, kk[6] * inv, kk[7] * inv};
        }
        else if (g == 2) { *(f32x4*)(vV + lo) = (f32x4){x[0], x[1], x[2], x[3]}; *(f32x4*)(vV + lo + 4) = (f32x4){x[4], x[5], x[6], x[7]}; }
        else if (g == 3) { float th[8]; for (int i = 0; i < 8; ++i) th[i] = 1.0f - 2.0f * __builtin_amdgcn_rcpf(1.0f + __expf(2.0f * x[i])); *(u32x4*)(wdx + tt * 144 + sub * 16) = pack8(th); }
        else { *(u32x4*)(adx + tt * 144 + sub * 16) = pack8(x); }
      }
    }
    __syncthreads();
    {
      f32x16 acc;
#pragma unroll
      for (int e = 0; e < 16; ++e) acc[e] = 0.f;
      const char* xb = mat ? adx : wdx;
#pragma unroll
      for (int s4 = 0; s4 < 4; ++s4) { const bf16x8 af = *(const bf16x8*)(xb + r * 144 + (16 * s4 + 8 * hh) * 2); acc = MFMA32(af, bfrag[s4], acc); }
      if (mat == 0) {
#pragma unroll
        for (int e = 0; e < 16; ++e) vW[crow(e, hh) * 64 + cch] = __expf(-0.6065306597126334f * sigmoidf_(bias + acc[e]));
      } else {
#pragma unroll
        for (int e = 0; e < 16; ++e) {
          const int ix = crow(e, hh) * 64 + cch;
          const float ag = sigmoidf_(bias + acc[e]);
          const float kk = vA[ix], k = vK[ix], rr = vR[ix];
          const float kd = k * (1.0f + (ag - 1.0f) * kav);
          vK[ix] = kd; vA[ix] = -kk; vB[ix] = kk * ag; tmpb[ix] = rr * kd * rkv;
        }
      }
    }
    __syncthreads();
    {
      const int tt = tid >> 3, sub = tid & 7;
      const f32x4 b0 = *(const f32x4*)(tmpb + tt * 64 + sub * 8), b1 = *(const f32x4*)(tmpb + tt * 64 + sub * 8 + 4);
      float bs = (b0.x + b0.y) + (b0.z + b0.w) + (b1.x + b1.y) + (b1.z + b1.w);
      bs += shx<1>(bs); bs += shx<2>(bs); bs += shx<4>(bs);
      if (sub == 0 && rs == 0) bonus[((size_t)(row0 + t0 + tt) * 8 + hd) * 2 + dir] = bs;
    }
    {
      f32x4 va[2], vw[2], vb[2], vk[2], vr[2]; float vi;
      int tt = dir ? 31 : 0;
      int vo = tt * 64 + j8 * 8;
#pragma unroll
      for (int q = 0; q < 2; ++q) { va[q] = *(const f32x4*)(vA + vo + 4 * q); vw[q] = *(const f32x4*)(vW + vo + 4 * q); vb[q] = *(const f32x4*)(vB + vo + 4 * q); vk[q] = *(const f32x4*)(vK + vo + 4 * q); vr[q] = *(const f32x4*)(vR + vo + 4 * q); }
      vi = vV[tt * 64 + irow];
      for (int si = 0; si < 32; ++si) {
        const int ttn = dir ? (si < 31 ? 30 - si : 0) : (si < 31 ? si + 1 : 31);
        const int von = ttn * 64 + j8 * 8;
        f32x2 pa2 = S[0] * (f32x2){va[0].x, va[0].y}, pa3 = S[1] * (f32x2){va[0].z, va[0].w};
        pa2 += S[2] * (f32x2){va[1].x, va[1].y}; pa3 += S[3] * (f32x2){va[1].z, va[1].w};
#pragma unroll
        for (int q = 0; q < 2; ++q) va[q] = *(const f32x4*)(vA + von + 4 * q);
        pa2 += pa3;
        const float sa = osum(pa2.x + pa2.y);
        const f32x2 sa2 = (f32x2){sa, sa}, vi2 = (f32x2){vi, vi};
        f32x2 py2, py3;
        S[0] = S[0] * (f32x2){vw[0].x, vw[0].y} + (sa2 * (f32x2){vb[0].x, vb[0].y} + vi2 * (f32x2){vk[0].x, vk[0].y}); py2 = S[0] * (f32x2){vr[0].x, vr[0].y};
        S[1] = S[1] * (f32x2){vw[0].z, vw[0].w} + (sa2 * (f32x2){vb[0].z, vb[0].w} + vi2 * (f32x2){vk[0].z, vk[0].w}); py3 = S[1] * (f32x2){vr[0].z, vr[0].w};
        S[2] = S[2] * (f32x2){vw[1].x, vw[1].y} + (sa2 * (f32x2){vb[1].x, vb[1].y} + vi2 * (f32x2){vk[1].x, vk[1].y}); py2 += S[2] * (f32x2){vr[1].x, vr[1].y};
        S[3] = S[3] * (f32x2){vw[1].z, vw[1].w} + (sa2 * (f32x2){vb[1].z, vb[1].w} + vi2 * (f32x2){vk[1].z, vk[1].w}); py3 += S[3] * (f32x2){vr[1].z, vr[1].w};
#pragma unroll
        for (int q = 0; q < 2; ++q) { vw[q] = *(const f32x4*)(vW + von + 4 * q); vb[q] = *(const f32x4*)(vB + von + 4 * q); vk[q] = *(const f32x4*)(vK + von + 4 * q); vr[q] = *(const f32x4*)(vR + von + 4 * q); }
        vi = vV[ttn * 64 + irow];
        py2 += py3;
        const float py = osum(py2.x + py2.y);
        if (j8 == 0) ybuf[tt * 32 + lrow] = py;
        tt = ttn;
      }
    }
    __syncthreads();
    {
      const int tt = tid >> 3, sub = tid & 7;
      const f32x4 y0 = *(const f32x4*)(ybuf + tt * 32 + sub * 4);
      u32x2 w; w.x = pack2(y0.x, y0.y); w.y = pack2(y0.z, y0.w);
      *(u32x2*)(Y + (size_t)(row0 + t0 + tt) * 512 + hd * 64 + rs * 32 + sub * 4) = w;
    }
    __syncthreads();
  }
  if (!lat) {
    float* o = opq(p.out) + (dir ? OUT_SB : OUT_SF) + ((size_t)(seq * 4 + l) * 8 + hd) * 4096 + irow * 64 + j8 * 8;
#pragma unroll
    for (int q = 0; q < 2; ++q) *(f32x4*)(o + 4 * q) = (f32x4){S[2 * q].x, S[2 * q].y, S[2 * q + 1].x, S[2 * q + 1].y};
  }
}

DI void phase_mixers(const Params& p, int l, char* smem, int part = 0) {
  const int tid = otid(), wid = __builtin_amdgcn_readfirstlane(tid >> 6);
  unsigned* cnt = (unsigned*)(p.ws + OFF_CNT) + l * 8;
  int* slot = (int*)(smem + SMEM_BYTES - 16);
  bf16_t* U = (bf16_t*)(p.ws + OFF_U);
  const bf16_t* KA = (const bf16_t*)(p.ws + OFF_KA); const bf16_t* VAT = (const bf16_t*)(p.ws + OFF_VAT);
  const bf16_t* KN = (const bf16_t*)(p.ws + OFF_KN); const bf16_t* VBT = (const bf16_t*)(p.ws + OFF_VBT); const bf16_t* KRB = (const bf16_t*)(p.ws + OFF_KRB);
  const int QLEN = 256 + 256 + 128 + 64 + 64;
  bool first = true;
  int xq = blockIdx.x & 7, tries = 0;
  for (;;) {
    int kind, seq, a, qt;
    if (first && blockIdx.x < 256) {
      const int item = blockIdx.x; kind = 0; seq = 32 + (item >> 5); a = (item >> 2) & 7; qt = item & 3;
      first = false;
    } else {
      first = false;
      if (tid == 0) *slot = (int)atomicAdd(cnt + xq, 1u);
      __syncthreads();
      const int i = __builtin_amdgcn_readfirstlane(*slot);
      __syncthreads();
      if (i >= QLEN) { if (++tries >= 8) break; xq = (xq + 1) & 7; continue; }
      if (i < 256) { const int g = xq + 8 * (i >> 7); kind = 1; seq = 32 + (g >> 1); a = g & 1; qt = i & 127; }
      else if (i < 512) { const int j = i - 256; const int g = xq + 8 * (j >> 5); kind = 2; seq = 32 + (g >> 3); a = g & 7; qt = j & 31; }
      else if (i < 640) { const int j = i - 512; kind = 0; seq = xq + 8 * (j >> 5); a = (j >> 2) & 7; qt = j & 3; }
      else if (i < 704) { const int j = i - 640; kind = 1; seq = xq + 8 * (j >> 4); a = (j >> 3) & 1; qt = j & 7; }
      else { const int j = i - 704; kind = 2; seq = xq + 8 * (j >> 4); a = (j >> 1) & 7; qt = j & 1; }
    }
    const int kr0 = keyrow0(seq), Tk = seq_tk(seq);
    const int row0 = seq < 32 ? seq * 256 : NCTX + (seq - 32) * 4096;
    if (kind == 0) scan_item(p, l, seq, a, qt & 1, qt >> 1, smem);
    else if (kind == 1) {
      const int qh = a * 4 + wid;
      bf16_t* q = U + (size_t)(row0 + qt * 32) * ULD + qh * 64;
      attn_item<64>(q, ULD, KA + (size_t)kr0 * 128 + a * 64, 128, nullptr, 0, VAT + (size_t)128 * kr0 + (size_t)(a * 64) * Tk, Tk, Tk, q, ULD, smem);
    } else {
      bf16_t* q = U + (size_t)(row0 + qt * 128 + wid * 32) * ULD + 768 + a * 96;
      attn_item<96>(q, ULD, KN + (size_t)kr0 * 512 + a * 64, 512, KRB + (size_t)kr0 * 32, 32, VBT + (size_t)512 * kr0 + (size_t)(a * 64) * Tk, Tk, Tk, q, ULD, smem);
    }
  }
}

DI void cpost_row(const Params& p, int l, int row, int lane) {
  int seq, t; row_decode(row, seq, t);
  const int T = seq < 32 ? 256 : 4096;
  const bf16_t* YF = (const bf16_t*)(p.ws + OFF_R2); const bf16_t* YB = YF + (size_t)NT * 512;
  bf16_t* u = (bf16_t*)(p.ws + OFF_U) + (size_t)row * ULD + 1696;
  const float* bonus = (const float*)(p.ws + OFF_BONUS);
  float yf[8], yb[8], y[8];
  unpack8(*(const u32x4*)(YF + (size_t)row * 512 + lane * 8), yf);
  unpack8(*(const u32x4*)(YB + (size_t)row * 512 + lane * 8), yb);
  float s = 0.f;
#pragma unroll
  for (int i = 0; i < 8; ++i) { y[i] = yf[i] + yb[i]; s += y[i]; }
  s += shx<1>(s); s += shx<2>(s); s += shx<4>(s);
  const float mu = s * (1.0f / 64.0f);
  float q = 0.f;
#pragma unroll
  for (int i = 0; i < 8; ++i) { y[i] -= mu; q += y[i] * y[i]; }
  q += shx<1>(q); q += shx<2>(q); q += shx<4>(q);
  const float rs = rsqrtf(q * (1.0f / 64.0f) + 64e-5f);
  const int col = 1024 + lane * 8;
  float c[8], pv[8], nx[8];
  unpack8(*(const u32x4*)(u + col), c);
  if (t > 0) unpack8(*(const u32x4*)(u - ULD + col), pv); else { for (int i = 0; i < 8; ++i) pv[i] = 0.f; }
  if (t < T - 1) unpack8(*(const u32x4*)(u + ULD + col), nx); else { for (int i = 0; i < 8; ++i) nx[i] = 0.f; }
  const float* mup = p.in[I_MUP] + l * 1792 + col; const float* mun = p.in[I_MUN] + l * 1792 + col;
  const float* lw = p.in[I_LNW] + l * 512 + lane * 8; const float* lb = p.in[I_LNB] + l * 512 + lane * 8;
  const f32x2 bsv = *(const f32x2*)(bonus + ((size_t)row * 8 + (lane >> 3)) * 2);
  const float bs = bsv.x + bsv.y;
  float o[8];
#pragma unroll
  for (int i = 0; i < 8; ++i) { const float v = c[i] + mup[i] * (pv[i] - c[i]) + mun[i] * (nx[i] - c[i]); o[i] = y[i] * rs * lw[i] + lb[i] + bs * v; }
  *(u32x4*)(u + lane * 8) = pack8(o);
}
DI void phase_renorm_cpost(const Params& p, int l) {
  const int lane = otid() & 63, wid = __builtin_amdgcn_readfirstlane(otid() >> 6);
  for (int item = blockIdx.x; item < NT / 4; item += gridDim.x) { const int row = item * 4 + wid; norm_row(p, l, row, lane); cpost_row(p, l, row, lane); }
}

DI void phase_zgemm(const Params& p, char* smem) {
  const bf16_t* H = (const bf16_t*)(p.ws + OFF_R1);
  const bf16_t* W = (const bf16_t*)(p.ws + OFF_WIN) + (size_t)3584 * 1024;
  bf16_t* U = (bf16_t*)(p.ws + OFF_U);
  const int ntiles = 320 * 12;
  for (int tile = blockIdx.x; tile < ntiles; tile += gridDim.x) {
    const int mt = tile / 12, nt = tile % 12, m0 = mt * 128, n0 = nt * 128;
    f32x16 acc[2][2]; zero_acc<2>(acc);
    gemm_mainloop<2>(acc, H + (size_t)m0 * 1024, 1024, 64, W + (size_t)n0 * 1024, 1024, 1024, smem);
    const int lane = otid() & 63, wid = __builtin_amdgcn_readfirstlane(otid() >> 6), wm = wid >> 1, wn = wid & 1, r = lane & 31, hh = lane >> 5;
#pragma unroll
    for (int j = 0; j < 2; ++j) {
      const int col = n0 + wn * 64 + j * 32 + r;
      const int br = col >> 9, cc = col & 511;
      const int ucol = br == 0 ? cc : (br == 1 ? 768 + (cc >> 6) * 96 + (cc & 63) : 1696 + cc);
#pragma unroll
      for (int i = 0; i < 2; ++i) {
        bf16_t* up = U + (size_t)(m0 + wm * 64 + i * 32) * ULD;
        const int lo = 4 * hh * ULD + ucol;
        bf16_t yv[16];
#pragma unroll
        for (int e = 0; e < 16; ++e) yv[e] = (up + crowu(e) * ULD)[lo];
#pragma unroll
        for (int e = 0; e < 16; ++e) (up + crowu(e) * ULD)[lo] = f2bf(bf2f(yv[e]) * siluf_(acc[i][j][e]));
      }
    }
  }
}

DI void phase_merge(const Params& p, char* smem) {
  const bf16_t* H = (const bf16_t*)(p.ws + OFF_R1);
  const bf16_t* WG = (const bf16_t*)(p.ws + OFF_WIN) + (size_t)5120 * 1024;
  const bf16_t* WO = (const bf16_t*)(p.ws + OFF_WO);
  const bf16_t* U = (const bf16_t*)(p.ws + OFF_U);
  bf16_t* MX = (bf16_t*)(p.ws + OFF_R2);
  const int ntiles = 320 * 8;
  for (int tile = blockIdx.x; tile < ntiles; tile += gridDim.x) {
    const int mt = tile >> 3, nt = tile & 7, m0 = mt * 128, n0 = nt * 128;
    f32x16 mix[2][2]; zero_acc<2>(mix);
    unsigned gs[2][2][8];
#pragma unroll 1
    for (int step = 0; step < 6; ++step) {
      const int br = step >> 1, isT = step & 1;
      const int acol = br == 0 ? 0 : (br == 1 ? 768 : 1696);
      const bf16_t* Ap = isT ? U + (size_t)m0 * ULD + acol : H + (size_t)m0 * 1024;
      const bf16_t* Bp = isT ? WO + (size_t)(br * 1024 + n0) * 512 : WG + (size_t)(br * 1024 + n0) * 1024;
      f32x16 cur[2][2]; zero_acc<2>(cur);
      gemm_mainloop<2>(cur, Ap, isT ? ULD : 1024, (isT && br == 1) ? 96 : 64, Bp, isT ? 512 : 1024, isT ? 512 : 1024, smem);
      if (isT) {
#pragma unroll
        for (int i = 0; i < 2; ++i)
#pragma unroll
          for (int j = 0; j < 2; ++j)
#pragma unroll
            for (int e = 0; e < 8; ++e) { mix[i][j][2 * e] += lo16(gs[i][j][e]) * cur[i][j][2 * e]; mix[i][j][2 * e + 1] += hi16(gs[i][j][e]) * cur[i][j][2 * e + 1]; }
      } else {
#pragma unroll
        for (int i = 0; i < 2; ++i)
#pragma unroll
          for (int j = 0; j < 2; ++j)
#pragma unroll
            for (int e = 0; e < 8; ++e) gs[i][j][e] = pack2(sigmoidf_(cur[i][j][2 * e]), sigmoidf_(cur[i][j][2 * e + 1]));
      }
    }
    const int lane = otid() & 63, wid = __builtin_amdgcn_readfirstlane(otid() >> 6), wm = wid >> 1, wn = wid & 1, r = lane & 31, hh = lane >> 5;
#pragma unroll
    for (int j = 0; j < 2; ++j) {
      const int col = n0 + wn * 64 + j * 32 + r;
#pragma unroll
      for (int i = 0; i < 2; ++i) {
        bf16_t* mp = MX + (size_t)(m0 + wm * 64 + i * 32) * 1024;
        const int lo = 4 * hh * 1024 + col;
#pragma unroll
        for (int e = 0; e < 16; ++e) (mp + crowu(e) * 1024)[lo] = f2bf(mix[i][j][e]);
      }
    }
  }
}

DI void phase_out(const Params& p, int l, char* smem) {
  const bf16_t* MX = (const bf16_t*)(p.ws + OFF_R2);
  const bf16_t* W = (const bf16_t*)(p.ws + OFF_WOUT);
  const int ntiles = 320 * 8;
  for (int tile = blockIdx.x; tile < ntiles; tile += gridDim.x) {
    const int mt = tile >> 3, nt = tile & 7, m0 = mt * 128, n0 = nt * 128;
    f32x16 acc[2][2]; zero_acc<2>(acc);
    gemm_mainloop<2>(acc, MX + (size_t)m0 * 1024, 1024, 64, W + (size_t)n0 * 1024, 1024, 1024, smem);
    const int lane = otid() & 63, wid = __builtin_amdgcn_readfirstlane(otid() >> 6), wm = wid >> 1, wn = wid & 1, r = lane & 31, hh = lane >> 5;
    const int jm = m0 < NCTX ? 0 : 1 + ((m0 - NCTX) >> 12);
    const float* gate = (const float*)(p.ws + OFF_MOD) + ((size_t)l * 9 + jm) * MODLD + 2048;
    const float* xsrc = x_row_ptr(p, l, m0);
#pragma unroll
    for (int j = 0; j < 2; ++j) {
      const int col = n0 + wn * 64 + j * 32 + r;
      const float gv = gate[col];
      const int lo = 4 * hh * 1024 + col;
#pragma unroll
      for (int i = 0; i < 2; ++i) {
        const float* xs = xsrc + (size_t)(wm * 64 + i * 32) * 1024;
        float* xo = p.out + (size_t)(m0 + wm * 64 + i * 32) * 1024;
        float xv[16];
#pragma unroll
        for (int e = 0; e < 16; ++e) xv[e] = (xs + crowu(e) * 1024)[lo];
#pragma unroll
        for (int e = 0; e < 16; ++e) (xo + crowu(e) * 1024)[lo] = xv[e] + gv * acc[i][j][e];
      }
    }
  }
}

DI void phase_final(const Params& p) {
  const int lane = otid() & 63, wid = __builtin_amdgcn_readfirstlane(otid() >> 6);
  const float* nw = p.in[I_FNW];
  for (int item = blockIdx.x; item < NT / 4; item += gridDim.x) {
    float* x = p.out + (size_t)(item * 4 + wid) * 1024;
    f32x4 v[4]; float ss = 0.f;
#pragma unroll
    for (int i = 0; i < 4; ++i) { v[i] = *(const f32x4*)(x + lane * 4 + 256 * i); ss += v[i].x * v[i].x + v[i].y * v[i].y + v[i].z * v[i].z + v[i].w * v[i].w; }
ss = wave_sum(ss);
    const float rs = rsqrtf(ss * (1.0f / 1024.0f) + 1e-6f);
#pragma unroll
    for (int i = 0; i < 4; ++i) { const f32x4 w = *(const f32x4*)(nw + lane * 4 + 256 * i); *(f32x4*)(x + lane * 4 + 256 * i) = (f32x4){v[i].x * rs * w.x, v[i].y * rs * w.y, v[i].z * rs * w.z, v[i].w * rs * w.w}; }
  }
}

DI void grid_barrier(unsigned* bar, unsigned& epoch) {
  epoch += 1u;
  __syncthreads();
  if (otid() == 0) {
    const unsigned grp = blockIdx.x & 7u, per = gridDim.x >> 3;
    __builtin_amdgcn_fence(__ATOMIC_RELEASE, "agent");
    const unsigned old = __hip_atomic_fetch_add(bar + grp * 32, 1u, __ATOMIC_RELAXED, __HIP_MEMORY_SCOPE_AGENT);
    if (old + 1u == epoch * per) __hip_atomic_fetch_add(bar + 8 * 32, 1u, __ATOMIC_RELAXED, __HIP_MEMORY_SCOPE_AGENT);
    while (__hip_atomic_load(bar + 8 * 32, __ATOMIC_RELAXED, __HIP_MEMORY_SCOPE_AGENT) < epoch * 8u) __builtin_amdgcn_s_sleep(1);
    __builtin_amdgcn_fence(__ATOMIC_ACQUIRE, "agent");
  }
  __syncthreads();
}

constexpr int NPHASES = 1 + 4 * 9 + 1;
__global__ void __launch_bounds__(256, 2) fwd_kernel(Params p0) {
  __shared__ __attribute__((aligned(16))) char smem[SMEM_BYTES];
  cg::grid_group grid = cg::this_grid();
  const int ph_begin = p0.ph_begin, ph_end = p0.ph_end;
  unsigned* bar = (unsigned*)(p0.ws + OFF_BAR);
  unsigned epoch = 0u;
  for (int ph = ph_begin; ph < ph_end; ++ph) {
    auto kp = __builtin_amdgcn_kernarg_segment_ptr();
    asm volatile("" : "+s"(kp));
    typedef const __attribute__((address_space(4))) Params CParams;
    CParams* kpp = (CParams*)kp;
    Params p;
#pragma unroll
    for (int i = 0; i < 35; ++i) p.in[i] = kpp->in[i];
    p.out = kpp->out; p.ws = kpp->ws; p.ph_begin = ph_begin; p.ph_end = ph_end;
    if (ph == 0) phase_prologue(p, smem);
    else if (ph == NPHASES - 1) phase_final(p);
    else {
      const int l = (ph - 1) / 9, sp = (ph - 1) % 9;
#ifdef PROBE_SP
      if (sp == PROBE_SP) {
        switch (sp) {
          case 0: phase_norm_convert(p, l, smem); break;
          case 1: phase_gemm1(p, l, smem); break;
          case 3: phase_upproj(p, smem); break;
          case 5: phase_renorm_cpost(p, l); break;
          case 7: phase_merge(p, smem); break;
          default: break;
        }
        grid.sync();
      }
#endif
      switch (sp) {
        case 0: phase_norm_convert(p, l, smem); break;
        case 1: phase_gemm1(p, l, smem); break;
        case 2: phase_post(p, l); break;
        case 3: phase_upproj(p, smem); break;
        case 4: phase_mixers(p, l, smem); break;
        case 5: phase_renorm_cpost(p, l); break;
        case 6: phase_zgemm(p, smem); break;
        case 7: phase_merge(p, smem); break;
        default: phase_out(p, l, smem); break;
      }
    }
    if (ph + 1 < ph_end) { if (ph == 0) grid.sync(); else grid_barrier(bar, epoch); }
  }
}

extern "C" void kernel_launch(void* const* d_in, const int* in_sizes, int n_in, void* d_out, int out_size, void* d_ws, size_t ws_size, hipStream_t stream) {
  if (ws_size < WS_NEED || n_in < 35) { fprintf(stderr, "workspace too small: %zu < %zu\n", ws_size, WS_NEED); return; }
  static int grid_blocks = 0;
  if (!grid_blocks) {
    int dev = 0, cus = 0, per_cu = 0;
    hipGetDevice(&dev);
    hipDeviceGetAttribute(&cus, hipDeviceAttributeMultiprocessorCount, dev);
    hipOccupancyMaxActiveBlocksPerMultiprocessor(&per_cu, fwd_kernel, 256, 0);
    if (per_cu < 1) per_cu = 1;
    if (per_cu > 2) per_cu = 2;
    grid_blocks = cus * per_cu;
  }
  Params p{};
  for (int i = 0; i < 35; ++i) p.in[i] = (const float*)d_in[i];
  p.out = (float*)d_out; p.ws = (char*)d_ws;
#ifndef ONE_LAUNCH
  for (int ph = 0; ph < NPHASES; ++ph) {
    p.ph_begin = ph; p.ph_end = ph + 1;
    hipLaunchKernelGGL(fwd_kernel, dim3(grid_blocks), dim3(256), 0, stream, p);
  }
#else
  p.ph_begin = 0; p.ph_end = NPHASES;
  hipMemsetAsync((char*)d_ws + OFF_BAR, 0, 4096, stream);
  void* args[] = {&p};
  hipError_t e = hipLaunchCooperativeKernel((void*)fwd_kernel, dim3(grid_blocks), dim3(256), args, 0, stream);
  if (e != hipSuccess) fprintf(stderr, "cooperative launch failed: %s (grid %d)\n", hipGetErrorString(e), grid_blocks);
#endif
}
```

```cpp
#define ONE_LAUNCH 1
#include <hip/hip_runtime.h>
#include <hip/hip_cooperative_groups.h>
#include <stdint.h>
#include <stdio.h>
namespace cg = cooperative_groups;

typedef unsigned short bf16_t;
typedef short bf16x8 __attribute__((ext_vector_type(8)));
typedef float f32x16 __attribute__((ext_vector_type(16)));
typedef float f32x4 __attribute__((ext_vector_type(4)));
typedef float f32x2 __attribute__((ext_vector_type(2)));
typedef unsigned u32x4 __attribute__((ext_vector_type(4)));
typedef unsigned u32x2 __attribute__((ext_vector_type(2)));
#define DI __device__ __forceinline__
#define MFMA32(a, b, c) __builtin_amdgcn_mfma_f32_32x32x16_bf16((a), (b), (c), 0, 0, 0)

constexpr int NT = 40960;
constexpr int NCTX = 8192;
constexpr int NK = 45056;
constexpr int ULD = 3488;
constexpr int MODLD = 3072;
constexpr int SMEM_BYTES = 78848;

constexpr size_t OFF_WIN = 0;
constexpr size_t OFF_WO = 16777216;
constexpr size_t OFF_WOUT = 19922944;
constexpr size_t OFF_WU = 22020096;
constexpr size_t OFF_MOD = 22282240;
constexpr size_t OFF_BONUS = 22724608;
constexpr size_t OFF_CS16 = 25346048;
constexpr size_t OFF_CS8 = 25354240;
constexpr size_t OFF_CNT = 25358336;
constexpr size_t OFF_BAR = 524742912;
constexpr size_t OFF_U = 25358592;
constexpr size_t OFF_R1 = 311095552;
constexpr size_t OFF_KA = OFF_R1;
constexpr size_t OFF_VAT = 513208576;
constexpr size_t OFF_KN = OFF_R1 + 23068672;
constexpr size_t OFF_VBT = OFF_R1 + 69206016;
constexpr size_t OFF_KRB = OFF_R1 + 115343360;
constexpr size_t OFF_R2 = 429322496;
constexpr size_t WS_NEED = 524742912 + 4096;

constexpr size_t OUT_AK = 41943040, OUT_AV = 46137344, OUT_CKV = 50331648, OUT_KR = 54525952, OUT_SF = 55574528, OUT_SB = 59768832;

struct Params {
  const float* in[35];
  float* out;
  char* ws;
  int ph_begin, ph_end;
};

enum { I_XP = 0, I_XS, I_CAK, I_CAV, I_CCKV, I_CKR, I_SF, I_SB, I_C, I_CCTX, I_NORMW, I_WMOD, I_BMOD, I_WIN, I_QNW, I_KNW, I_KVNW,
       I_WUK, I_WUV, I_MUP, I_MUN, I_W0, I_WUP, I_A0, I_AUP, I_KK, I_KA, I_RK, I_LNW, I_LNB, I_WOA, I_WOB, I_WOC, I_WOUT, I_FNW };

DI int threadIdx_x_raw() { return __builtin_amdgcn_workitem_id_x(); }
DI int otid() { int t = threadIdx_x_raw(); asm volatile("" : "+v"(t)); return t; }
DI const float* opq(const float* q) { asm volatile("" : "+s"(q)); return q; }
DI float* opq(float* q) { asm volatile("" : "+s"(q)); return q; }
DI float bf2f(bf16_t v) { return __uint_as_float(((unsigned)v) << 16); }
typedef __bf16 hbf16x2 __attribute__((ext_vector_type(2)));
DI unsigned pack2(float a, float b) { f32x2 v = {a, b}; hbf16x2 r = __builtin_convertvector(v, hbf16x2); return __builtin_bit_cast(unsigned, r); }
DI bf16_t f2bf(float x) { return (bf16_t)(pack2(x, 0.f) & 0xffffu); }
DI float xsum16(float x) { const unsigned u = __float_as_uint(x); auto r = __builtin_amdgcn_permlane16_swap(u, u, false, false); return __uint_as_float(r[0]) + __uint_as_float(r[1]); }
DI float xsum32(float x) { const unsigned u = __float_as_uint(x); auto r = __builtin_amdgcn_permlane32_swap(u, u, false, false); return __uint_as_float(r[0]) + __uint_as_float(r[1]); }
DI float lo16(unsigned w) { return __uint_as_float(w << 16); }
DI float hi16(unsigned w) { return __uint_as_float(w & 0xffff0000u); }
DI void unpack8(u32x4 w, float* v) { v[0] = lo16(w.x); v[1] = hi16(w.x); v[2] = lo16(w.y); v[3] = hi16(w.y); v[4] = lo16(w.z); v[5] = hi16(w.z); v[6] = lo16(w.w); v[7] = hi16(w.w); }
DI u32x4 pack8(const float* v) { u32x4 w; w.x = pack2(v[0], v[1]); w.y = pack2(v[2], v[3]); w.z = pack2(v[4], v[5]); w.w = pack2(v[6], v[7]); return w; }
template <int K> DI float shx(float v) { return __int_as_float(__builtin_amdgcn_ds_swizzle(__float_as_int(v), 0x1f | (K << 10))); }
DI float wave_sum(float v) { v += shx<1>(v); v += shx<2>(v); v += shx<4>(v); v += shx<8>(v); v += shx<16>(v); return xsum32(v); }
DI float qsum(float v) {
  v += __int_as_float(__builtin_amdgcn_update_dpp(0, __float_as_int(v), 0xB1, 0xf, 0xf, true));
  v += __int_as_float(__builtin_amdgcn_update_dpp(0, __float_as_int(v), 0x4E, 0xf, 0xf, true));
  return v;
}
DI float osum(float v) {
  v = qsum(v);
  v += __int_as_float(__builtin_amdgcn_update_dpp(0, __float_as_int(v), 0x141, 0xf, 0xf, true));
  return v;
}
DI int crow(int reg, int h) { return (reg & 3) + 8 * (reg >> 2) + 4 * h; }
DI int crowu(int reg) { return (reg & 3) + 8 * (reg >> 2); }
DI int perm16(int t) { return (t & ~12) | ((t & 4) << 1) | ((t & 8) >> 1); }
DI float sigmoidf_(float x) { return __builtin_amdgcn_rcpf(1.0f + __expf(-x)); }
DI float siluf_(float x) { return x * __builtin_amdgcn_rcpf(1.0f + __expf(-x)); }

DI void row_decode(int row, int& seq, int& t) {
  if (row < NCTX) { seq = row >> 8; t = row & 255; } else { seq = 32 + ((row - NCTX) >> 12); t = (row - NCTX) & 4095; }
}
DI int keyrow0(int seq) { return seq < 32 ? seq * 256 : NCTX + (seq - 32) * 4608; }
DI int seq_tk(int seq) { return seq < 32 ? 256 : 4608; }

typedef __attribute__((address_space(3))) unsigned lds_u32;
template <int NJ>
DI void gemm_mainloop(f32x16 (&acc)[2][NJ], const bf16_t* __restrict__ A, int lda, int ks,
                      const bf16_t* __restrict__ Bt, int ldb, int K, char* smem) {
  constexpr int A_BYTES = 128 * 128;
  constexpr int B_BYTES = 64 * NJ * 128;
  constexpr int STAGE = A_BYTES + B_BYTES;
  const int tid = otid(), lane = tid & 63, wid = __builtin_amdgcn_readfirstlane(tid >> 6), wm = wid >> 1, wn = wid & 1;
  const int r = lane & 31, hh = lane >> 5;
  const int nk = K >> 6;
  const int lrow = tid >> 3, lc = tid & 7;
  const int gc = (lc ^ ((lrow >> 1) & 7)) * 8;
  const bf16_t* ap = A + (size_t)lrow * lda + gc;
  const bf16_t* bp = Bt + (size_t)lrow * ldb + gc;
  auto issue = [&](int kt, int buf) {
    char* base = smem + buf * STAGE + tid * 16;
    const bf16_t* ap2 = ap + (size_t)kt * ks;
    const bf16_t* bp2 = bp + (size_t)kt * 64;
#pragma unroll
    for (int p = 0; p < 4; ++p) __builtin_amdgcn_global_load_lds((const unsigned*)(ap2 + (size_t)(32 * p) * lda), (lds_u32*)(base + p * 4096), 16, 0, 0);
#pragma unroll
    for (int p = 0; p < 2 * NJ; ++p) __builtin_amdgcn_global_load_lds((const unsigned*)(bp2 + (size_t)(32 * p) * ldb), (lds_u32*)(base + A_BYTES + p * 4096), 16, 0, 0);
  };
  issue(0, 0);
  __syncthreads();
#pragma unroll 1
  for (int kt = 0; kt < nk; ++kt) {
    if (kt + 1 < nk) issue(kt + 1, (kt + 1) & 1);
    const char* base = smem + (kt & 1) * STAGE;
#pragma unroll
    for (int s = 0; s < 4; ++s) {
      bf16x8 af[2], bfr[NJ];
#pragma unroll
      for (int i = 0; i < 2; ++i) { const int row = wm * 64 + i * 32 + r; af[i] = *(const bf16x8*)(base + row * 128 + (((2 * s + hh) ^ ((row >> 1) & 7)) << 4)); }
#pragma unroll
      for (int j = 0; j < NJ; ++j) { const int row = wn * (32 * NJ) + j * 32 + r; bfr[j] = *(const bf16x8*)(base + A_BYTES + row * 128 + (((2 * s + hh) ^ ((row >> 1) & 7)) << 4)); }
#pragma unroll
      for (int i = 0; i < 2; ++i)
#pragma unroll
        for (int j = 0; j < NJ; ++j) acc[i][j] = MFMA32(af[i], bfr[j], acc[i][j]);
    }
    __syncthreads();
  }
}

template <int NJ> DI void zero_acc(f32x16 (&acc)[2][NJ]) {
#pragma unroll
  for (int i = 0; i < 2; ++i)
#pragma unroll
    for (int j = 0; j < NJ; ++j)
#pragma unroll
      for (int e = 0; e < 16; ++e) acc[i][j][e] = 0.f;
}

DI void phase_prologue(const Params& p, char* smem) {
  const int tid = otid(), lane = tid & 63, wid = __builtin_amdgcn_readfirstlane(tid >> 6);
  float* mod = (float*)(p.ws + OFF_MOD);
  if (blockIdx.x == 0) {
    if (tid < 32) ((unsigned*)(p.ws + OFF_CNT))[tid] = 0u;
    float* cs16 = (float*)(p.ws + OFF_CS16);
    float* cs8 = (float*)(p.ws + OFF_CS8);
    for (int e = tid; e < 64 * 16; e += 256) { const int pos = e >> 4, i = e & 15; const float inv = expf(-9.210340371976184f * (float)i / 16.0f); const float a = (float)pos * inv; cs16[e * 2] = cosf(a); cs16[e * 2 + 1] = sinf(a); }
    for (int e = tid; e < 64 * 8; e += 256) { const int pos = e >> 3, i = e & 7; const float inv = expf(-9.210340371976184f * (float)i / 8.0f); const float a = (float)pos * inv; cs8[e * 2] = cosf(a); cs8[e * 2 + 1] = sinf(a); }
  }
  float* sl = (float*)smem;
  float* red = sl + 9 * 1024;
  for (int e = tid; e < 9 * 1024; e += 256) { const int j = e >> 10, k = e & 1023; const float* cc0 = opq(p.in[I_CCTX]); const float* cc1 = opq(p.in[I_C]); const float c = j == 0 ? cc0[k] : cc1[(j - 1) * 1024 + k]; sl[e] = siluf_(c); }
  __syncthreads();
  for (int item = blockIdx.x; item < 192; item += gridDim.x) {
    const int l = item / 48, n = (item % 48) * 64 + lane;
    const float* w = p.in[I_WMOD] + (size_t)l * 1024 * 3072 + n;
    float a[9];
#pragma unroll
    for (int j = 0; j < 9; ++j) a[j] = 0.f;
    for (int k = wid * 256; k < wid * 256 + 256; ++k) {
      const float wv = w[(size_t)k * 3072];
#pragma unroll
      for (int j = 0; j < 9; ++j) a[j] += sl[j * 1024 + k] * wv;
    }
#pragma unroll
    for (int j = 0; j < 9; ++j) red[(wid * 9 + j) * 64 + lane] = a[j];
    __syncthreads();
    for (int e = tid; e < 9 * 64; e += 256) {
      const int j = e >> 6, c = e & 63;
      const float s = red[(0 * 9 + j) * 64 + c] + red[(1 * 9 + j) * 64 + c] + red[(2 * 9 + j) * 64 + c] + red[(3 * 9 + j) * 64 + c];
      const int nn = (item % 48) * 64 + c;
      mod[((size_t)l * 9 + j) * MODLD + nn] = s + p.in[I_BMOD][l * 3072 + nn];
    }
    __syncthreads();
  }
}

DI const float* x_row_ptr(const Params& p, int l, int row) {
  const float* xp = opq(p.in[I_XP]); const float* xs = opq(p.in[I_XS]); const float* xo = opq((const float*)p.out);
  if (l == 0) return row < NCTX ? xp + (size_t)row * 1024 : xs + (size_t)(row - NCTX) * 1024;
  return xo + (size_t)row * 1024;
}
DI void norm_row(const Params& p, int l, int row, int lane) {
  const float* x = x_row_ptr(p, l, row);
  const int j = row < NCTX ? 0 : 1 + ((row - NCTX) >> 12);
  const float* mod = (const float*)(p.ws + OFF_MOD) + ((size_t)l * 9 + j) * MODLD;
  const float* nw = p.in[I_NORMW] + l * 1024;
  bf16_t* h = (bf16_t*)(p.ws + OFF_R1) + (size_t)row * 1024;
  f32x4 v[4]; float ss = 0.f;
#pragma unroll
  for (int i = 0; i < 4; ++i) { v[i] = *(const f32x4*)(x + lane * 4 + 256 * i); ss += v[i].x * v[i].x + v[i].y * v[i].y + v[i].z * v[i].z + v[i].w * v[i].w; }
ss = wave_sum(ss);
  const float rs = rsqrtf(ss * (1.0f / 1024.0f) + 1e-6f);
#pragma unroll
  for (int i = 0; i < 4; ++i) {
    const int c = lane * 4 + 256 * i;
    const f32x4 w = *(const f32x4*)(nw + c), sh = *(const f32x4*)(mod + c), sc = *(const f32x4*)(mod + 1024 + c);
    u32x2 o;
    o.x = pack2(v[i].x * rs * w.x * (1.f + sc.x) + sh.x, v[i].y * rs * w.y * (1.f + sc.y) + sh.y);
    o.y = pack2(v[i].z * rs * w.z * (1.f + sc.z) + sh.z, v[i].w * rs * w.w * (1.f + sc.w) + sh.w);
    *(u32x2*)(h + c) = o;
  }
}

DI int win_srccol(int j) {
  if (j < 768) return j;
  if (j < 1696) return j + 512;
  if (j < 3488) return j + 1024;
  if (j < 3584) return -1;
  if (j < 5120) { const int jj = j - 3584; return jj < 512 ? 768 + jj : (jj < 1024 ? 2208 + (jj - 512) : 4512 + (jj - 1024)); }
  return 5024 + (j - 5120);
}
DI void conv_tile(const float* __restrict__ src, int ld_src, bf16_t* dst, int ld_dst, int k0, int n0, int kind, int srcoff, char* smem) {
  float* tile = (float*)smem;
  const int tid = otid();
  const int n = tid & 63;
  int sc = kind == 0 ? win_srccol(n0 + n) : (n0 + n - srcoff);
#pragma unroll
  for (int i = 0; i < 16; ++i) { const int k = i * 4 + (tid >> 6); tile[k * 65 + n] = sc >= 0 ? src[(size_t)(k0 + k) * ld_src + sc] : 0.f; }
  __syncthreads();
#pragma unroll
  for (int i = 0; i < 8; ++i) { const int nn = i * 8 + (tid >> 5), kk = (tid & 31) * 2; *(unsigned*)(dst + (size_t)(n0 + nn) * ld_dst + k0 + kk) = pack2(tile[kk * 65 + nn], tile[(kk + 1) * 65 + nn]); }
  __syncthreads();
}

DI void phase_norm_convert(const Params& p, int l, char* smem) {
  const int tid = otid(), lane = tid & 63, wid = __builtin_amdgcn_readfirstlane(tid >> 6);
  bf16_t* WinT = (bf16_t*)(p.ws + OFF_WIN); bf16_t* WoT = (bf16_t*)(p.ws + OFF_WO); bf16_t* WoutT = (bf16_t*)(p.ws + OFF_WOUT); bf16_t* WuT = (bf16_t*)(p.ws + OFF_WU);
  const int NI_WIN = 128 * 16, NI_WO = 3 * 16 * 8, NI_WOUT = 16 * 16, NI_WU = 16 * 2;
  const int NI_CONV = NI_WIN + NI_WO + NI_WOUT + NI_WU;
  for (int item = blockIdx.x; item < NI_CONV; item += gridDim.x) {
    int it = item;
    if (it < NI_WIN) { conv_tile(p.in[I_WIN] + (size_t)l * 1024 * 8096, 8096, WinT, 1024, (it & 15) * 64, (it >> 4) * 64, 0, 0, smem); continue; }
    it -= NI_WIN;
    if (it < NI_WO) { const int br = it / 128, r2 = it % 128; const float* src = (br == 0 ? opq(p.in[I_WOA]) : (br == 1 ? opq(p.in[I_WOB]) : opq(p.in[I_WOC]))) + (size_t)l * 512 * 1024; conv_tile(src, 1024, WoT + (size_t)br * 1024 * 512, 512, (r2 & 7) * 64, (r2 >> 3) * 64, 1, 0, smem); continue; }
    it -= NI_WO;
    if (it < NI_WOUT) { conv_tile(p.in[I_WOUT] + (size_t)l * 1024 * 1024, 1024, WoutT, 1024, (it & 15) * 64, (it >> 4) * 64, 1, 0, smem); continue; }
    it -= NI_WOUT;
    { const int nt = it >> 1, kt = it & 1; const bool uv = nt >= 8; const float* src = (uv ? opq(p.in[I_WUV]) : opq(p.in[I_WUK])) + (size_t)l * 128 * 512; conv_tile(src, 512, WuT, 128, kt * 64, nt * 64, 1, uv ? 512 : 0, smem); }
  }
  for (int item = blockIdx.x; item < NT / 4; item += gridDim.x) norm_row(p, l, item * 4 + wid, lane);
}

DI void phase_gemm1(const Params& p, int l, char* smem) {
  const bf16_t* H = (const bf16_t*)(p.ws + OFF_R1);
  const bf16_t* W = (const bf16_t*)(p.ws + OFF_WIN);
  bf16_t* U = (bf16_t*)(p.ws + OFF_U);
  bf16_t* VAT = (bf16_t*)(p.ws + OFF_VAT);
  const int NTN = 28, ntiles = 320 * NTN;
  for (int tile = blockIdx.x; tile < ntiles; tile += gridDim.x) {
    const int mt = tile / NTN, nt = tile % NTN, m0 = mt * 128, n0 = nt * 128;
    f32x16 acc[2][2]; zero_acc<2>(acc);
    gemm_mainloop<2>(acc, H + (size_t)m0 * 1024, 1024, 64, W + (size_t)n0 * 1024, 1024, 1024, smem);
    const int lane = otid() & 63, wid = __builtin_amdgcn_readfirstlane(otid() >> 6), wm = wid >> 1, wn = wid & 1, r = lane & 31, hh = lane >> 5;
    int seq, t0; row_decode(m0, seq, t0);
#pragma unroll
    for (int j = 0; j < 2; ++j) {
      const int cb = n0 + wn * 64 + j * 32;
      if (cb >= ULD) continue;
      const int col = cb + r;
      if (cb >= 640 && cb < 768) {
        const int kvh = (col - 640) >> 6, dv = col & 63, Tk = seq_tk(seq);
        bf16_t* vt = VAT + (size_t)128 * keyrow0(seq) + (size_t)(kvh * 64 + dv) * Tk;
#pragma unroll
        for (int i = 0; i < 2; ++i) {
          const int tt = t0 + wm * 64 + i * 32;
#pragma unroll
          for (int g2 = 0; g2 < 2; ++g2) {
            float v[8];
#pragma unroll
            for (int e = 0; e < 8; ++e) v[e] = acc[i][j][g2 * 8 + e];
            *(u32x4*)(vt + tt + 16 * g2 + 8 * hh) = pack8(v);
          }
          if (seq < 32) {
            float* o = p.out + OUT_AV + ((size_t)(seq * 4 + l) * 256 + tt) * 128;
            const int lo = 4 * hh * 128 + (col - 640);
#pragma unroll
            for (int e = 0; e < 16; ++e) (o + crowu(e) * 128)[lo] = acc[i][j][e];
          }
        }
      } else {
#pragma unroll
        for (int i = 0; i < 2; ++i) {
          bf16_t* up = U + (size_t)(m0 + wm * 64 + i * 32) * ULD;
          const int lo = 4 * hh * ULD + col;
#pragma unroll
          for (int e = 0; e < 16; ++e) (up + crowu(e) * ULD)[lo] = f2bf(acc[i][j][e]);
        }
      }
    }
  }
}

DI void post_row(const Params& p, int l, int row, int lane) {
  int seq, t; row_decode(row, seq, t);
  const bool lat = row >= NCTX;
  const int krow = keyrow0(seq) + t;
  const int prow = t >> 6, pcol = t & 63;
  bf16_t* u = (bf16_t*)(p.ws + OFF_U) + (size_t)row * ULD;
  const float* cs16 = (const float*)(p.ws + OFF_CS16);
  const float* cs8 = (const float*)(p.ws + OFF_CS8);
  const float LOG2E = 1.4426950408889634f;
#pragma unroll
  for (int which = 0; which < 2; ++which) {
    const int l8 = which == 0 ? lane : (lane & 15);
    const bf16_t* src = u + (which == 0 ? 0 : 512) + l8 * 8;
    float v[8]; unpack8(*(const u32x4*)src, v);
    float ss = 0.f;
#pragma unroll
    for (int i = 0; i < 8; ++i) ss += v[i] * v[i];
    ss += shx<1>(ss); ss += shx<2>(ss); ss += shx<4>(ss);
    const float rs = rsqrtf(ss * (1.0f / 64.0f) + 1e-6f);
    const float* nw = (which == 0 ? opq(p.in[I_QNW]) : opq(p.in[I_KNW])) + l * 64 + (lane & 7) * 8;
#pragma unroll
    for (int i = 0; i < 8; ++i) v[i] = v[i] * rs * nw[i];
    float pv[8];
#pragma unroll
    for (int i = 0; i < 8; ++i) pv[i] = shx<2>(v[i]);
    if (lat) {
      const int pos = ((lane & 7) >> 2) ? pcol : prow;
      const bool lower = (lane & 2) == 0;
      const float* cs = cs16 + (pos * 16 + (lane & 1) * 8) * 2;
#pragma unroll
      for (int i = 0; i < 8; ++i) { const float c = cs[i * 2], s = cs[i * 2 + 1]; v[i] = lower ? v[i] * c - pv[i] * s : v[i] * c + pv[i] * s; }
    }
    if (which == 0) {
      const float sc = 0.125f * LOG2E;
#pragma unroll
      for (int i = 0; i < 8; ++i) v[i] *= sc;
      *(u32x4*)(u + lane * 8) = pack8(v);
    } else if (lane < 16) {
      bf16_t* KA = (bf16_t*)(p.ws + OFF_KA);
      *(u32x4*)(KA + (size_t)krow * 128 + lane * 8) = pack8(v);
      if (!lat) {
        float* o = p.out + OUT_AK + ((size_t)(seq * 4 + l) * 256 + t) * 128 + lane * 8;
        *(f32x4*)o = (f32x4){v[0], v[1], v[2], v[3]}; *(f32x4*)(o + 4) = (f32x4){v[4], v[5], v[6], v[7]};
      }
    }
  }
  {
    const float sc = 0.10206207261596577f * LOG2E;
    const int hd = lane >> 3;
    bf16_t* q = u + 768 + hd * 96;
    { float v[8]; unpack8(*(const u32x4*)(q + (lane & 7) * 8), v);
#pragma unroll
      for (int i = 0; i < 8; ++i) v[i] *= sc;
      *(u32x4*)(q + (lane & 7) * 8) = pack8(v); }
    { bf16_t* qr = q + 64 + (lane & 7) * 4;
      const u32x2 w = *(const u32x2*)qr;
      float v[4] = {lo16(w.x), hi16(w.x), lo16(w.y), hi16(w.y)}, pv[4];
#pragma unroll
      for (int i = 0; i < 4; ++i) pv[i] = shx<2>(v[i]);
      if (lat) {
        const int pos = ((lane & 7) >> 2) ? pcol : prow;
        const bool lower = (lane & 2) == 0;
        const float* cs = cs8 + (pos * 8 + (lane & 1) * 4) * 2;
#pragma unroll
        for (int i = 0; i < 4; ++i) { const float c = cs[i * 2], s = cs[i * 2 + 1]; v[i] = lower ? v[i] * c - pv[i] * s : v[i] * c + pv[i] * s; }
      }
      u32x2 o; o.x = pack2(v[0] * sc, v[1] * sc); o.y = pack2(v[2] * sc, v[3] * sc);
      *(u32x2*)qr = o; }
  }
  {
    const unsigned w = *(const unsigned*)(u + 1536 + lane * 2);
    float a = lo16(w), b = hi16(w);
    float ss = a * a + b * b;
ss = wave_sum(ss);
    const float rs = rsqrtf(ss * (1.0f / 128.0f) + 1e-6f);
    const float* nw = p.in[I_KVNW] + l * 128 + lane * 2;
    a = a * rs * nw[0]; b = b * rs * nw[1];
    bf16_t* CKVN = (bf16_t*)(p.ws + OFF_R2);
    *(unsigned*)(CKVN + (size_t)krow * 128 + lane * 2) = pack2(a, b);
    if (!lat) { float* o = p.out + OUT_CKV + ((size_t)(seq * 4 + l) * 256 + t) * 128 + lane * 2; *(f32x2*)o = (f32x2){a, b}; }
  }
  {
    float v = bf2f(u[1664 + (lane & 31)]);
    const float pv = shx<8>(v);
    if (!lat) { if (lane < 32) p.out[OUT_KR + ((size_t)(seq * 4 + l) * 256 + t) * 32 + lane] = v; }
    else {
      const int d = lane & 31; const int pos = (d >> 4) ? pcol : prow; const bool lower = (d & 8) == 0;
      const float* cs = cs8 + (pos * 8 + (d & 7)) * 2;
      v = lower ? v * cs[0] - pv * cs[1] : v * cs[0] + pv * cs[1];
    }
    if (lane < 32) ((bf16_t*)(p.ws + OFF_KRB))[(size_t)krow * 32 + lane] = f2bf(v);
  }
}
DI void post_cached_row(const Params& p, int l, int idx, int lane) {
  const int b = idx >> 9, j = idx & 511;
  const int kr0 = NCTX + b * 4608, krow = kr0 + 4096 + j;
  const size_t cb = ((size_t)(b * 4 + l) * 512 + j);
  bf16_t* KA = (bf16_t*)(p.ws + OFF_KA); bf16_t* VAT = (bf16_t*)(p.ws + OFF_VAT); bf16_t* CKVN = (bf16_t*)(p.ws + OFF_R2); bf16_t* KRB = (bf16_t*)(p.ws + OFF_KRB);
  { const f32x2 v = *(const f32x2*)(p.in[I_CAK] + cb * 128 + lane * 2); *(unsigned*)(KA + (size_t)krow * 128 + lane * 2) = pack2(v.x, v.y); }
  { const f32x2 v = *(const f32x2*)(p.in[I_CAV] + cb * 128 + lane * 2);
    bf16_t* vt = VAT + (size_t)128 * kr0 + (size_t)(lane * 2) * 4608 + perm16(4096 + j);
    vt[0] = f2bf(v.x); vt[4608] = f2bf(v.y); }
  { const f32x2 v = *(const f32x2*)(p.in[I_CCKV] + cb * 128 + lane * 2); *(unsigned*)(CKVN + (size_t)krow * 128 + lane * 2) = pack2(v.x, v.y); }
  if (lane < 32) KRB[(size_t)krow * 32 + lane] = f2bf(p.in[I_CKR][cb * 32 + lane]);
}
DI void phase_post(const Params& p, int l) {
  const int lane = otid() & 63, wid = __builtin_amdgcn_readfirstlane(otid() >> 6);
  for (int item = blockIdx.x; item < NT / 4 + 1024; item += gridDim.x) {
    if (item < NT / 4) post_row(p, l, item * 4 + wid, lane);
    else post_cached_row(p, l, (item - NT / 4) * 4 + wid, lane);
  }
}

DI void phase_upproj(const Params& p, char* smem) {
  const bf16_t* A = (const bf16_t*)(p.ws + OFF_R2);
  const bf16_t* W = (const bf16_t*)(p.ws + OFF_WU);
  bf16_t* KN = (bf16_t*)(p.ws + OFF_KN); bf16_t* VBT = (bf16_t*)(p.ws + OFF_VBT);
  const int ntiles = 352 * 8;
  for (int tile = blockIdx.x; tile < ntiles; tile += gridDim.x) {
    const int mt = tile >> 3, nt = tile & 7, m0 = mt * 128, n0 = nt * 128;
    f32x16 acc[2][2]; zero_acc<2>(acc);
    gemm_mainloop<2>(acc, A + (size_t)m0 * 128, 128, 64, W + (size_t)n0 * 128, 128, 128, smem);
    const int lane = otid() & 63, wid = __builtin_amdgcn_readfirstlane(otid() >> 6), wm = wid >> 1, wn = wid & 1, r = lane & 31, hh = lane >> 5;
    int seq, t0;
    if (m0 < NCTX) { seq = m0 >> 8; t0 = m0 & 255; } else { const int rr = m0 - NCTX; seq = 32 + rr / 4608; t0 = rr % 4608; }
#pragma unroll
    for (int j = 0; j < 2; ++j) {
      const int col = n0 + wn * 64 + j * 32 + r;
      if (n0 < 512) {
#pragma unroll
        for (int i = 0; i < 2; ++i) {
          bf16_t* kp = KN + (size_t)(m0 + wm * 64 + i * 32) * 512;
          const int lo = 4 * hh * 512 + col;
#pragma unroll
          for (int e = 0; e < 16; ++e) (kp + crowu(e) * 512)[lo] = f2bf(acc[i][j][e]);
        }
      } else {
        const int Tk = seq_tk(seq);
        bf16_t* vt = VBT + (size_t)512 * keyrow0(seq) + (size_t)(col - 512) * Tk;
#pragma unroll
        for (int i = 0; i < 2; ++i) {
          const int tt = t0 + wm * 64 + i * 32;
#pragma unroll
          for (int g2 = 0; g2 < 2; ++g2) {
            float v[8];
#pragma unroll
            for (int e = 0; e < 8; ++e) v[e] = acc[i][j][g2 * 8 + e];
            *(u32x4*)(vt + tt + 16 * g2 + 8 * hh) = pack8(v);
          }
        }
      }
    }
  }
}

template <int DQK>
DI void attn_item(const bf16_t* Qw, int q_ld, const bf16_t* K1, int k1_ld, const bf16_t* K2, int k2_ld,
                  const bf16_t* Vt, int vt_ld, int nkeys, bf16_t* Ow, int o_ld, char* smem) {
  constexpr int KS = DQK * 2 + 16;
  constexpr int KBYTES = 64 * KS;
  constexpr int VS = 144;
  constexpr int VBYTES = 64 * VS;
  constexpr int STAGE = KBYTES + VBYTES;
  constexpr int CPR = DQK / 8;
  constexpr int NKC = 64 * CPR / 256;
  constexpr int NS = DQK / 16;
  const int tid = otid(), lane = tid & 63, r = lane & 31, hh = lane >> 5;
  bf16x8 qf[NS];
#pragma unroll
  for (int s = 0; s < NS; ++s) qf[s] = *(const bf16x8*)(Qw + (size_t)r * q_ld + 16 * s + 8 * hh);
  f32x16 o[2];
#pragma unroll
  for (int n = 0; n < 2; ++n)
#pragma unroll
    for (int e = 0; e < 16; ++e) o[n][e] = 0.f;
  float m_run = -1e30f, lsum = 0.f;
  u32x4 rk0[NKC], rv0[2], rk1[NKC], rv1[2];
  int krow_[NKC], kc_[NKC];
#pragma unroll
  for (int q = 0; q < NKC; ++q) { const int id = q * 256 + tid; krow_[q] = id / CPR; kc_[q] = id % CPR; }
  const int vrow = tid >> 3, vc = tid & 7;
  auto gload = [&](int key0, u32x4 (&rk)[NKC], u32x4 (&rv)[2]) {
#pragma unroll
    for (int q = 0; q < NKC; ++q) {
      const bf16_t* src = (DQK == 64 || kc_[q] < 8) ? K1 + (size_t)(key0 + krow_[q]) * k1_ld + kc_[q] * 8 : K2 + (size_t)(key0 + krow_[q]) * k2_ld + (kc_[q] - 8) * 8;
      rk[q] = *(const u32x4*)src;
    }
#pragma unroll
    for (int q = 0; q < 2; ++q) rv[q] = *(const u32x4*)(Vt + (size_t)(vrow + 32 * q) * vt_ld + key0 + vc * 8);
  };
  auto lstore = [&](int buf, u32x4 (&rk)[NKC], u32x4 (&rv)[2]) {
    char* base = smem + buf * STAGE;
#pragma unroll
    for (int q = 0; q < NKC; ++q) *(u32x4*)(base + krow_[q] * KS + kc_[q] * 16) = rk[q];
#pragma unroll
    for (int q = 0; q < 2; ++q) *(u32x4*)(base + KBYTES + (vrow + 32 * q) * VS + vc * 16) = rv[q];
  };
  const int ntl = nkeys >> 6;
  gload(0, rk0, rv0); lstore(0, rk0, rv0);
  gload(64, rk1, rv1);
  if (ntl > 2) gload(128, rk0, rv0);
  __syncthreads();
  auto tile_body = [&](int tl, u32x4 (&rkn)[NKC], u32x4 (&rvn)[2]) {
    const char* base = smem + (tl & 1) * STAGE;
    bf16x8 kf[2][NS], vf[2][2][2];
#pragma unroll
    for (int kb = 0; kb < 2; ++kb)
#pragma unroll
      for (int ks = 0; ks < NS; ++ks) kf[kb][ks] = *(const bf16x8*)(base + (kb * 32 + r) * KS + (2 * ks + hh) * 16);
    __builtin_amdgcn_sched_barrier(0);
    f32x16 s[2];
#pragma unroll
    for (int kb = 0; kb < 2; ++kb)
#pragma unroll
      for (int e = 0; e < 16; ++e) s[kb][e] = 0.f;
#pragma unroll
    for (int ks = 0; ks < NS; ++ks)
#pragma unroll
      for (int kb = 0; kb < 2; ++kb) s[kb] = MFMA32(kf[kb][ks], qf[ks], s[kb]);
#pragma unroll
    for (int kb = 0; kb < 2; ++kb)
#pragma unroll
      for (int s2 = 0; s2 < 2; ++s2)
#pragma unroll
        for (int n = 0; n < 2; ++n) vf[kb][s2][n] = *(const bf16x8*)(base + KBYTES + (32 * n + r) * VS + (kb * 32 + 16 * s2 + 8 * hh) * 2);
    __builtin_amdgcn_sched_barrier(0);
    float mx = s[0][0];
#pragma unroll
    for (int kb = 0; kb < 2; ++kb)
#pragma unroll
      for (int e = 0; e < 16; ++e) mx = fmaxf(mx, s[kb][e]);
    { const unsigned u = __float_as_uint(mx); auto sw = __builtin_amdgcn_permlane32_swap(u, u, false, false); mx = fmaxf(__uint_as_float(sw[0]), __uint_as_float(sw[1])); }
    const float m_new = fmaxf(m_run, mx);
    const float alpha = __builtin_amdgcn_exp2f(m_run - m_new);
    m_run = m_new;
    float ps = 0.f;
#pragma unroll
    for (int kb = 0; kb < 2; ++kb)
#pragma unroll
      for (int e = 0; e < 16; ++e) { const float pe = __builtin_amdgcn_exp2f(s[kb][e] - m_new); s[kb][e] = pe; ps += pe; }
    lsum = lsum * alpha + ps;
    if (__builtin_amdgcn_ballot_w64(alpha != 1.0f) != 0ull) {
#pragma unroll
      for (int n = 0; n < 2; ++n)
#pragma unroll
        for (int e = 0; e < 16; ++e) o[n][e] *= alpha;
    }
#pragma unroll
    for (int kb = 0; kb < 2; ++kb)
#pragma unroll
      for (int s2 = 0; s2 < 2; ++s2) {
        u32x4 pw;
        pw.x = pack2(s[kb][8 * s2 + 0], s[kb][8 * s2 + 1]); pw.y = pack2(s[kb][8 * s2 + 2], s[kb][8 * s2 + 3]);
        pw.z = pack2(s[kb][8 * s2 + 4], s[kb][8 * s2 + 5]); pw.w = pack2(s[kb][8 * s2 + 6], s[kb][8 * s2 + 7]);
        const bf16x8 pf = __builtin_bit_cast(bf16x8, pw);
#pragma unroll
        for (int n = 0; n < 2; ++n) o[n] = MFMA32(vf[kb][s2][n], pf, o[n]);
      }
    if (tl + 1 < ntl) { lstore((tl + 1) & 1, rkn, rvn); if (tl + 3 < ntl) gload((tl + 3) * 64, rkn, rvn); }
    __syncthreads();
  };
  for (int tl = 0; tl < ntl; tl += 2) { tile_body(tl, rk1, rv1); tile_body(tl + 1, rk0, rv0); }
  lsum = xsum32(lsum);
  const float inv = 1.0f / lsum;
#pragma unroll
  for (int n = 0; n < 2; ++n)
#pragma unroll
    for (int g = 0; g < 4; ++g) {
      u32x2 w; w.x = pack2(o[n][4 * g] * inv, o[n][4 * g + 1] * inv); w.y = pack2(o[n][4 * g + 2] * inv, o[n][4 * g + 3] * inv);
      *(u32x2*)(Ow + (size_t)r * o_ld + 32 * n + 8 * g + 4 * hh) = w;
    }
}

DI void scan_item(const Params& p, int l, int seq, int hd, int dir, int rs, char* smem) {
  const int tid = otid(), lane = tid & 63, wv = __builtin_amdgcn_readfirstlane(tid >> 6);
  const int j8 = lane & 7, r = lane & 31, hh = lane >> 5;
  const bool lat = seq >= 32;
  const int T = lat ? 4096 : 256;
  const int row0 = lat ? NCTX + (seq - 32) * 4096 : seq * 256;
  float* vA = (float*)smem; float* vK = vA + 2048; float* vR = vK + 2048; float* vV = vR + 2048; float* vW = vV + 2048; float* vB = vW + 2048; float* ybuf = vB + 2048;
  char* raw = smem + 32768;
  char* wdx = smem + 57344; char* adx = smem + 61952;
  float* tmpb = (float*)(smem + 66816);
  const bf16_t* U = (const bf16_t*)(p.ws + OFF_U);
  bf16_t* Y = (bf16_t*)(p.ws + OFF_R2) + (dir ? (size_t)NT * 512 : 0);
  float* bonus = (float*)(p.ws + OFF_BONUS);
  const int lrow = 8 * wv + (lane >> 3), irow = rs * 32 + lrow;
  f32x2 S[4];
  if (lat) {
    const float* s0 = (dir ? opq(p.in[I_SB]) : opq(p.in[I_SF])) + ((size_t)((seq - 32) * 4 + l) * 8 + hd) * 4096 + irow * 64 + j8 * 8;
#pragma unroll
    for (int q = 0; q < 2; ++q) { const f32x4 v = *(const f32x4*)(s0 + 4 * q); S[2 * q] = (f32x2){v.x, v.y}; S[2 * q + 1] = (f32x2){v.z, v.w}; }
  } else {
#pragma unroll
    for (int q = 0; q < 4; ++q) S[q] = (f32x2){0.f, 0.f};
  }
  const int mat = wv >> 1, ntc = wv & 1, cch = ntc * 32 + r, hc = hd * 64 + cch;
  bf16x8 bfrag[4];
  {
    const float* W = (mat ? opq(p.in[I_AUP]) : opq(p.in[I_WUP])) + (size_t)(l * 2 + dir) * 64 * 512 + hc;
#pragma unroll
    for (int s4 = 0; s4 < 4; ++s4) {
      float w8[8];
#pragma unroll
      for (int j = 0; j < 8; ++j) w8[j] = W[(size_t)(16 * s4 + 8 * hh + j) * 512];
      bfrag[s4] = __builtin_bit_cast(bf16x8, pack8(w8));
    }
  }
  const float bias = (mat ? opq(p.in[I_A0]) : opq(p.in[I_W0]))[(l * 2 + dir) * 512 + hc];
  const float kav = p.in[I_KA][l * 512 + hc], rkv = p.in[I_RK][l * 512 + hc];
  float* muP = (float*)(smem + 75008); float* muN = muP + 320; float* kkL = muN + 320;
  {
    const float* mup = p.in[I_MUP] + l * 1792; const float* mun = p.in[I_MUN] + l * 1792;
    for (int e = tid; e < 320; e += 256) { const int g = e >> 6, c = e & 63; const int col = (g < 3 ? g * 512 + hd * 64 : (g == 3 ? 1536 + dir * 64 : 1664 + dir * 64)) + c; muP[e] = mup[col]; muN[e] = mun[col]; }
    if (tid < 64) kkL[tid] = p.in[I_KK][l * 512 + hd * 64 + tid];
  }
  const int nch = T >> 5;
  u32x4 pre[6];
  auto prefetch = [&](int t0) {
#pragma unroll
    for (int q = 0; q < 6; ++q) {
      const int id = q * 256 + tid;
      const int row = id / 40, cc = id - row * 40, g = cc >> 3, c8 = cc & 7;
      const int t = t0 - 1 + row;
      const int col = (g < 3 ? g * 512 + hd * 64 : (g == 3 ? 1536 + dir * 64 : 1664 + dir * 64)) + c8 * 8;
      u32x4 v = (u32x4){0u, 0u, 0u, 0u};
      if (id < 1360 && t >= 0 && t < T) v = *(const u32x4*)(U + (size_t)(row0 + t) * ULD + 1696 + col);
      pre[q] = v;
    }
  };
  prefetch((dir ? nch - 1 : 0) * 32);
  for (int ci = 0; ci < nch; ++ci) {
    const int t0 = (dir ? nch - 1 - ci : ci) * 32;
#pragma unroll
    for (int q = 0; q < 6; ++q) { const int id = q * 256 + tid; if (id < 1360) *(u32x4*)(raw + id * 16) = pre[q]; }
    __syncthreads();
    if (ci + 1 < nch) prefetch((dir ? nch - 2 - ci : ci + 1) * 32);
    {
      const int tt = tid >> 3, sub = tid & 7;
#pragma unroll 1
      for (int g = 0; g < 5; ++g) {
        const int col = (g < 3 ? g * 512 + hd * 64 : (g == 3 ? 1536 + dir * 64 : 1664 + dir * 64)) + sub * 8;
        float c[8], pv[8], nx[8], x[8];
        unpack8(*(const u32x4*)(raw + (tt + 1) * 640 + (g * 8 + sub) * 16), c);
        unpack8(*(const u32x4*)(raw + tt * 640 + (g * 8 + sub) * 16), pv);
        unpack8(*(const u32x4*)(raw + (tt + 2) * 640 + (g * 8 + sub) * 16), nx);
        const f32x4 mp0 = *(const f32x4*)(muP + g * 64 + sub * 8), mp1 = *(const f32x4*)(muP + g * 64 + sub * 8 + 4), mn0 = *(const f32x4*)(muN + g * 64 + sub * 8), mn1 = *(const f32x4*)(muN + g * 64 + sub * 8 + 4);
        const float mp[8] = {mp0.x, mp0.y, mp0.z, mp0.w, mp1.x, mp1.y, mp1.z, mp1.w}, mn[8] = {mn0.x, mn0.y, mn0.z, mn0.w, mn1.x, mn1.y, mn1.z, mn1.w};
#pragma unroll
        for (int i = 0; i < 8; ++i) x[i] = c[i] + mp[i] * (pv[i] - c[i]) + mn[i] * (nx[i] - c[i]);
        const int lo = tt * 64 + sub * 8;
        if (g == 0) { *(f32x4*)(vR + lo) = (f32x4){x[0], x[1], x[2], x[3]}; *(f32x4*)(vR + lo + 4) = (f32x4){x[4], x[5], x[6], x[7]}; }
        else if (g == 1) {
          float kk[8], ss = 0.f;
          const float* kkw = kkL + sub * 8;
#pragma unroll
          for (int i = 0; i < 8; ++i) { kk[i] = x[i] * kkw[i]; ss += kk[i] * kk[i]; }
          *(f32x4*)(vK + lo) = (f32x4){x[0], x[1], x[2], x[3]}; *(f32x4*)(vK + lo + 4) = (f32x4){x[4], x[5], x[6], x[7]};
          ss += shx<1>(ss); ss += shx<2>(ss); ss += shx<4>(ss);
          const float inv = 1.0f / fmaxf(sqrtf(ss), 1e-12f);
          *(f32x4*)(vA + lo) = (f32x4){kk[0] * inv, kk[1] * inv, kk[2] * inv, kk[3] * inv}; *(f32x4*)(vA + lo + 4) = (f32x4){kk[4] * inv, kk[5] * inv, kk[6] * inv, kk[7] * inv};
        }
        else if (g == 2) { *(f32x4*)(vV + lo) = (f32x4){x[0], x[1], x[2], x[3]}; *(f32x4*)(vV + lo + 4) = (f32x4){x[4], x[5], x[6], x[7]}; }
        else if (g == 3) { float th[8]; for (int i = 0; i < 8; ++i) th[i] = 1.0f - 2.0f * __builtin_amdgcn_rcpf(1.0f + __expf(2.0f * x[i])); *(u32x4*)(wdx + tt * 144 + sub * 16) = pack8(th); }
        else { *(u32x4*)(adx + tt * 144 + sub * 16) = pack8(x); }
      }
    }
    __syncthreads();
    {
      f32x16 acc;
#pragma unroll
      for (int e = 0; e < 16; ++e) acc[e] = 0.f;
      const char* xb = mat ? adx : wdx;
#pragma unroll
      for (int s4 = 0; s4 < 4; ++s4) { const bf16x8 af = *(const bf16x8*)(xb + r * 144 + (16 * s4 + 8 * hh) * 2); acc = MFMA32(af, bfrag[s4], acc); }
      if (mat == 0) {
#pragma unroll
        for (int e = 0; e < 16; ++e) vW[crow(e, hh) * 64 + cch] = __expf(-0.6065306597126334f * sigmoidf_(bias + acc[e]));
      } else {
#pragma unroll
        for (int e = 0; e < 16; ++e) {
          const int ix = crow(e, hh) * 64 + cch;
          const float ag = sigmoidf_(bias + acc[e]);
          const float kk = vA[ix], k = vK[ix], rr = vR[ix];
          const float kd = k * (1.0f + (ag - 1.0f) * kav);
          vK[ix] = kd; vA[ix] = -kk; vB[ix] = kk * ag; tmpb[ix] = rr * kd * rkv;
        }
      }
    }
    __syncthreads();
    {
      const int tt = tid >> 3, sub = tid & 7;
      const f32x4 b0 = *(const f32x4*)(tmpb + tt * 64 + sub * 8), b1 = *(const f32x4*)(tmpb + tt * 64 + sub * 8 + 4);
      float bs = (b0.x + b0.y) + (b0.z + b0.w) + (b1.x + b1.y) + (b1.z + b1.w);
      bs += shx<1>(bs); bs += shx<2>(bs); bs += shx<4>(bs);
      if (sub == 0 && rs == 0) bonus[((size_t)(row0 + t0 + tt) * 8 + hd) * 2 + dir] = bs;
    }
    {
      f32x4 va[2], vw[2], vb[2], vk[2], vr[2]; float vi;
      int tt = dir ? 31 : 0;
      int vo = tt * 64 + j8 * 8;
#pragma unroll
      for (int q = 0; q < 2; ++q) { va[q] = *(const f32x4*)(vA + vo + 4 * q); vw[q] = *(const f32x4*)(vW + vo + 4 * q); vb[q] = *(const f32x4*)(vB + vo + 4 * q); vk[q] = *(const f32x4*)(vK + vo + 4 * q); vr[q] = *(const f32x4*)(vR + vo + 4 * q); }
      vi = vV[tt * 64 + irow];
      for (int si = 0; si < 32; ++si) {
        const int ttn = dir ? (si < 31 ? 30 - si : 0) : (si < 31 ? si + 1 : 31);
        const int von = ttn * 64 + j8 * 8;
        f32x2 pa2 = S[0] * (f32x2){va[0].x, va[0].y}, pa3 = S[1] * (f32x2){va[0].z, va[0].w};
        pa2 += S[2] * (f32x2){va[1].x, va[1].y}; pa3 += S[3] * (f32x2){va[1].z, va[1].w};
#pragma unroll
        for (int q = 0; q < 2; ++q) va[q] = *(const f32x4*)(vA + von + 4 * q);
        pa2 += pa3;
        const float sa = osum(pa2.x + pa2.y);
        const f32x2 sa2 = (f32x2){sa, sa}, vi2 = (f32x2){vi, vi};
        f32x2 py2, py3;
        S[0] = S[0] * (f32x2){vw[0].x, vw[0].y} + (sa2 * (f32x2){vb[0].x, vb[0].y} + vi2 * (f32x2){vk[0].x, vk[0].y}); py2 = S[0] * (f32x2){vr[0].x, vr[0].y};
        S[1] = S[1] * (f32x2){vw[0].z, vw[0].w} + (sa2 * (f32x2){vb[0].z, vb[0].w} + vi2 * (f32x2){vk[0].z, vk[0].w}); py3 = S[1] * (f32x2){vr[0].z, vr[0].w};
        S[2] = S[2] * (f32x2){vw[1].x, vw[1].y} + (sa2 * (f32x2){vb[1].x, vb[1].y} + vi2 * (f32x2){vk[1].x, vk[1].y}); py2 += S[2] * (f32x2){vr[1].x, vr[1].y};
        S[3] = S[3] * (f32x2){vw[1].z, vw[1].w} + (sa2 * (f32x2){vb[1].z, vb[1].w} + vi2 * (f32x2){vk[1].z, vk[1].w}); py3 += S[3] * (f32x2){vr[1].z, vr[1].w};
#pragma unroll
        for (int q = 0; q < 2; ++q) { vw[q] = *(const f32x4*)(vW + von + 4 * q); vb[q] = *(const f32x4*)(vB + von + 4 * q); vk[q] = *(const f32x4*)(vK + von + 4 * q); vr[q] = *(const f32x4*)(vR + von + 4 * q); }
        vi = vV[ttn * 64 + irow];
        py2 += py3;
        const float py = osum(py2.x + py2.y);
        if (j8 == 0) ybuf[tt * 32 + lrow] = py;
        tt = ttn;
      }
    }
    __syncthreads();
    {
      const int tt = tid >> 3, sub = tid & 7;
      const f32x4 y0 = *(const f32x4*)(ybuf + tt * 32 + sub * 4);
      u32x2 w; w.x = pack2(y0.x, y0.y); w.y = pack2(y0.z, y0.w);
      *(u32x2*)(Y + (size_t)(row0 + t0 + tt) * 512 + hd * 64 + rs * 32 + sub * 4) = w;
    }
    __syncthreads();
  }
  if (!lat) {
    float* o = opq(p.out) + (dir ? OUT_SB : OUT_SF) + ((size_t)(seq * 4 + l) * 8 + hd) * 4096 + irow * 64 + j8 * 8;
#pragma unroll
    for (int q = 0; q < 2; ++q) *(f32x4*)(o + 4 * q) = (f32x4){S[2 * q].x, S[2 * q].y, S[2 * q + 1].x, S[2 * q + 1].y};
  }
}

DI void phase_mixers(const Params& p, int l, char* smem, int part = 0) {
  const int tid = otid(), wid = __builtin_amdgcn_readfirstlane(tid >> 6);
  unsigned* cnt = (unsigned*)(p.ws + OFF_CNT) + l * 8;
  int* slot = (int*)(smem + SMEM_BYTES - 16);
  bf16_t* U = (bf16_t*)(p.ws + OFF_U);
  const bf16_t* KA = (const bf16_t*)(p.ws + OFF_KA); const bf16_t* VAT = (const bf16_t*)(p.ws + OFF_VAT);
  const bf16_t* KN = (const bf16_t*)(p.ws + OFF_KN); const bf16_t* VBT = (const bf16_t*)(p.ws + OFF_VBT); const bf16_t* KRB = (const bf16_t*)(p.ws + OFF_KRB);
  const int QLEN = 256 + 256 + 128 + 64 + 64;
  bool first = true;
  int xq = blockIdx.x & 7, tries = 0;
  for (;;) {
    int kind, seq, a, qt;
    if (first && blockIdx.x < 256) {
      const int item = blockIdx.x; kind = 0; seq = 32 + (item >> 5); a = (item >> 2) & 7; qt = item & 3;
      first = false;
    } else {
      first = false;
      if (tid == 0) *slot = (int)atomicAdd(cnt + xq, 1u);
      __syncthreads();
      const int i = __builtin_amdgcn_readfirstlane(*slot);
      __syncthreads();
      if (i >= QLEN) { if (++tries >= 8) break; xq = (xq + 1) & 7; continue; }
      if (i < 256) { const int g = xq + 8 * (i >> 7); kind = 1; seq = 32 + (g >> 1); a = g & 1; qt = i & 127; }
      else if (i < 512) { const int j = i - 256; const int g = xq + 8 * (j >> 5); kind = 2; seq = 32 + (g >> 3); a = g & 7; qt = j & 31; }
      else if (i < 640) { const int j = i - 512; kind = 0; seq = xq + 8 * (j >> 5); a = (j >> 2) & 7; qt = j & 3; }
      else if (i < 704) { const int j = i - 640; kind = 1; seq = xq + 8 * (j >> 4); a = (j >> 3) & 1; qt = j & 7; }
      else { const int j = i - 704; kind = 2; seq = xq + 8 * (j >> 4); a = (j >> 1) & 7; qt = j & 1; }
    }
    const int kr0 = keyrow0(seq), Tk = seq_tk(seq);
    const int row0 = seq < 32 ? seq * 256 : NCTX + (seq - 32) * 4096;
    if (kind == 0) scan_item(p, l, seq, a, qt & 1, qt >> 1, smem);
    else if (kind == 1) {
      const int qh = a * 4 + wid;
      bf16_t* q = U + (size_t)(row0 + qt * 32) * ULD + qh * 64;
      attn_item<64>(q, ULD, KA + (size_t)kr0 * 128 + a * 64, 128, nullptr, 0, VAT + (size_t)128 * kr0 + (size_t)(a * 64) * Tk, Tk, Tk, q, ULD, smem);
    } else {
      bf16_t* q = U + (size_t)(row0 + qt * 128 + wid * 32) * ULD + 768 + a * 96;
      attn_item<96>(q, ULD, KN + (size_t)kr0 * 512 + a * 64, 512, KRB + (size_t)kr0 * 32, 32, VBT + (size_t)512 * kr0 + (size_t)(a * 64) * Tk, Tk, Tk, q, ULD, smem);
    }
  }
}

DI void cpost_row(const Params& p, int l, int row, int lane) {
  int seq, t; row_decode(row, seq, t);
  const int T = seq < 32 ? 256 : 4096;
  const bf16_t* YF = (const bf16_t*)(p.ws + OFF_R2); const bf16_t* YB = YF + (size_t)NT * 512;
  bf16_t* u = (bf16_t*)(p.ws + OFF_U) + (size_t)row * ULD + 1696;
  const float* bonus = (const float*)(p.ws + OFF_BONUS);
  float yf[8], yb[8], y[8];
  unpack8(*(const u32x4*)(YF + (size_t)row * 512 + lane * 8), yf);
  unpack8(*(const u32x4*)(YB + (size_t)row * 512 + lane * 8), yb);
  float s = 0.f;
#pragma unroll
  for (int i = 0; i < 8; ++i) { y[i] = yf[i] + yb[i]; s += y[i]; }
  s += shx<1>(s); s += shx<2>(s); s += shx<4>(s);
  const float mu = s * (1.0f / 64.0f);
  float q = 0.f;
#pragma unroll
  for (int i = 0; i < 8; ++i) { y[i] -= mu; q += y[i] * y[i]; }
  q += shx<1>(q); q += shx<2>(q); q += shx<4>(q);
  const float rs = rsqrtf(q * (1.0f / 64.0f) + 64e-5f);
  const int col = 1024 + lane * 8;
  float c[8], pv[8], nx[8];
  unpack8(*(const u32x4*)(u + col), c);
  if (t > 0) unpack8(*(const u32x4*)(u - ULD + col), pv); else { for (int i = 0; i < 8; ++i) pv[i] = 0.f; }
  if (t < T - 1) unpack8(*(const u32x4*)(u + ULD + col), nx); else { for (int i = 0; i < 8; ++i) nx[i] = 0.f; }
  const float* mup = p.in[I_MUP] + l * 1792 + col; const float* mun = p.in[I_MUN] + l * 1792 + col;
  const float* lw = p.in[I_LNW] + l * 512 + lane * 8; const float* lb = p.in[I_LNB] + l * 512 + lane * 8;
  const f32x2 bsv = *(const f32x2*)(bonus + ((size_t)row * 8 + (lane >> 3)) * 2);
  const float bs = bsv.x + bsv.y;
  float o[8];
#pragma unroll
  for (int i = 0; i < 8; ++i) { const float v = c[i] + mup[i] * (pv[i] - c[i]) + mun[i] * (nx[i] - c[i]); o[i] = y[i] * rs * lw[i] + lb[i] + bs * v; }
  *(u32x4*)(u + lane * 8) = pack8(o);
}
DI void phase_renorm_cpost(const Params& p, int l) {
  const int lane = otid() & 63, wid = __builtin_amdgcn_readfirstlane(otid() >> 6);
  for (int item = blockIdx.x; item < NT / 4; item += gridDim.x) { const int row = item * 4 + wid; norm_row(p, l, row, lane); cpost_row(p, l, row, lane); }
}

DI void phase_zgemm(const Params& p, char* smem) {
  const bf16_t* H = (const bf16_t*)(p.ws + OFF_R1);
  const bf16_t* W = (const bf16_t*)(p.ws + OFF_WIN) + (size_t)3584 * 1024;
  bf16_t* U = (bf16_t*)(p.ws + OFF_U);
  const int ntiles = 320 * 12;
  for (int tile = blockIdx.x; tile < ntiles; tile += gridDim.x) {
    const int mt = tile / 12, nt = tile % 12, m0 = mt * 128, n0 = nt * 128;
    f32x16 acc[2][2]; zero_acc<2>(acc);
    gemm_mainloop<2>(acc, H + (size_t)m0 * 1024, 1024, 64, W + (size_t)n0 * 1024, 1024, 1024, smem);
    const int lane = otid() & 63, wid = __builtin_amdgcn_readfirstlane(otid() >> 6), wm = wid >> 1, wn = wid & 1, r = lane & 31, hh = lane >> 5;
#pragma unroll
    for (int j = 0; j < 2; ++j) {
      const int col = n0 + wn * 64 + j * 32 + r;
      const int br = col >> 9, cc = col & 511;
      const int ucol = br == 0 ? cc : (br == 1 ? 768 + (cc >> 6) * 96 + (cc & 63) : 1696 + cc);
#pragma unroll
      for (int i = 0; i < 2; ++i) {
        bf16_t* up = U + (size_t)(m0 + wm * 64 + i * 32) * ULD;
        const int lo = 4 * hh * ULD + ucol;
        bf16_t yv[16];
#pragma unroll
        for (int e = 0; e < 16; ++e) yv[e] = (up + crowu(e) * ULD)[lo];
#pragma unroll
        for (int e = 0; e < 16; ++e) (up + crowu(e) * ULD)[lo] = f2bf(bf2f(yv[e]) * siluf_(acc[i][j][e]));
      }
    }
  }
}

DI void phase_merge(const Params& p, char* smem) {
  const bf16_t* H = (const bf16_t*)(p.ws + OFF_R1);
  const bf16_t* WG = (const bf16_t*)(p.ws + OFF_WIN) + (size_t)5120 * 1024;
  const bf16_t* WO = (const bf16_t*)(p.ws + OFF_WO);
  const bf16_t* U = (const bf16_t*)(p.ws + OFF_U);
  bf16_t* MX = (bf16_t*)(p.ws + OFF_R2);
  const int ntiles = 320 * 8;
  for (int tile = blockIdx.x; tile < ntiles; tile += gridDim.x) {
    const int mt = tile >> 3, nt = tile & 7, m0 = mt * 128, n0 = nt * 128;
    f32x16 mix[2][2]; zero_acc<2>(mix);
    unsigned gs[2][2][8];
#pragma unroll 1
    for (int step = 0; step < 6; ++step) {
      const int br = step >> 1, isT = step & 1;
      const int acol = br == 0 ? 0 : (br == 1 ? 768 : 1696);
      const bf16_t* Ap = isT ? U + (size_t)m0 * ULD + acol : H + (size_t)m0 * 1024;
      const bf16_t* Bp = isT ? WO + (size_t)(br * 1024 + n0) * 512 : WG + (size_t)(br * 1024 + n0) * 1024;
      f32x16 cur[2][2]; zero_acc<2>(cur);
      gemm_mainloop<2>(cur, Ap, isT ? ULD : 1024, (isT && br == 1) ? 96 : 64, Bp, isT ? 512 : 1024, isT ? 512 : 1024, smem);
      if (isT) {
#pragma unroll
        for (int i = 0; i < 2; ++i)
#pragma unroll
          for (int j = 0; j < 2; ++j)
#pragma unroll
            for (int e = 0; e < 8; ++e) { mix[i][j][2 * e] += lo16(gs[i][j][e]) * cur[i][j][2 * e]; mix[i][j][2 * e + 1] += hi16(gs[i][j][e]) * cur[i][j][2 * e + 1]; }
      } else {
#pragma unroll
        for (int i = 0; i < 2; ++i)
#pragma unroll
          for (int j = 0; j < 2; ++j)
#pragma unroll
            for (int e = 0; e < 8; ++e) gs[i][j][e] = pack2(sigmoidf_(cur[i][j][2 * e]), sigmoidf_(cur[i][j][2 * e + 1]));
      }
    }
    const int lane = otid() & 63, wid = __builtin_amdgcn_readfirstlane(otid() >> 6), wm = wid >> 1, wn = wid & 1, r = lane & 31, hh = lane >> 5;
#pragma unroll
    for (int j = 0; j < 2; ++j) {
      const int col = n0 + wn * 64 + j * 32 + r;
#pragma unroll
      for (int i = 0; i < 2; ++i) {
        bf16_t* mp = MX + (size_t)(m0 + wm * 64 + i * 32) * 1024;
        const int lo = 4 * hh * 1024 + col;
#pragma unroll
        for (int e = 0; e < 16; ++e) (mp + crowu(e) * 1024)[lo] = f2bf(mix[i][j][e]);
      }
    }
  }
}

DI void phase_out(const Params& p, int l, char* smem) {
  const bf16_t* MX = (const bf16_t*)(p.ws + OFF_R2);
  const bf16_t* W = (const bf16_t*)(p.ws + OFF_WOUT);
  const int ntiles = 320 * 8;
  for (int tile = blockIdx.x; tile < ntiles; tile += gridDim.x) {
    const int mt = tile >> 3, nt = tile & 7, m0 = mt * 128, n0 = nt * 128;
    f32x16 acc[2][2]; zero_acc<2>(acc);
    gemm_mainloop<2>(acc, MX + (size_t)m0 * 1024, 1024, 64, W + (size_t)n0 * 1024, 1024, 1024, smem);
    const int lane = otid() & 63, wid = __builtin_amdgcn_readfirstlane(otid() >> 6), wm = wid >> 1, wn = wid & 1, r = lane & 31, hh = lane >> 5;
    const int jm = m0 < NCTX ? 0 : 1 + ((m0 - NCTX) >> 12);
    const float* gate = (const float*)(p.ws + OFF_MOD) + ((size_t)l * 9 + jm) * MODLD + 2048;
    const float* xsrc = x_row_ptr(p, l, m0);
#pragma unroll
    for (int j = 0; j < 2; ++j) {
      const int col = n0 + wn * 64 + j * 32 + r;
      const float gv = gate[col];
      const int lo = 4 * hh * 1024 + col;
#pragma unroll
      for (int i = 0; i < 2; ++i) {
        const float* xs = xsrc + (size_t)(wm * 64 + i * 32) * 1024;
        float* xo = p.out + (size_t)(m0 + wm * 64 + i * 32) * 1024;
        float xv[16];
#pragma unroll
        for (int e = 0; e < 16; ++e) xv[e] = (xs + crowu(e) * 1024)[lo];
#pragma unroll
        for (int e = 0; e < 16; ++e) (xo + crowu(e) * 1024)[lo] = xv[e] + gv * acc[i][j][e];
      }
    }
  }
}

DI void phase_final(const Params& p) {
  const int lane = otid() & 63, wid = __builtin_amdgcn_readfirstlane(otid() >> 6);
  const float* nw = p.in[I_FNW];
  for (int item = blockIdx.x; item < NT / 4; item += gridDim.x) {
    float* x = p.out + (size_t)(item * 4 + wid) * 1024;
    f32x4 v[4]; float ss = 0.f;
#pragma unroll
    for (int i = 0; i < 4; ++i) { v[i] = *(const f32x4*)(x + lane * 4 + 256 * i); ss += v[i].x * v[i].x + v[i].y * v[i].y + v[i].z * v[i].z + v[i].w * v[i].w; }
ss = wave_sum(ss);
    const float rs = rsqrtf(ss * (1.0f / 1024.0f) + 1e-6f);
#pragma unroll
    for (int i = 0; i < 4; ++i) { const f32x4 w = *(const f32x4*)(nw + lane * 4 + 256 * i); *(f32x4*)(x + lane * 4 + 256 * i) = (f32x4){v[i].x * rs * w.x, v[i].y * rs * w.y, v[i].z * rs * w.z, v[i].w * rs * w.w}; }
  }
}

DI void grid_barrier(unsigned* bar, unsigned& epoch) {
  epoch += 1u;
  __syncthreads();
  if (otid() == 0) {
    const unsigned grp = blockIdx.x & 7u, per = gridDim.x >> 3;
    __builtin_amdgcn_fence(__ATOMIC_RELEASE, "agent");
    const unsigned old = __hip_atomic_fetch_add(bar + grp * 32, 1u, __ATOMIC_RELAXED, __HIP_MEMORY_SCOPE_AGENT);
    if (old + 1u == epoch * per) __hip_atomic_fetch_add(bar + 8 * 32, 1u, __ATOMIC_RELAXED, __HIP_MEMORY_SCOPE_AGENT);
    while (__hip_atomic_load(bar + 8 * 32, __ATOMIC_RELAXED, __HIP_MEMORY_SCOPE_AGENT) < epoch * 8u) __builtin_amdgcn_s_sleep(1);
    __builtin_amdgcn_fence(__ATOMIC_ACQUIRE, "agent");
  }
  __syncthreads();
}

constexpr int NPHASES = 1 + 4 * 9 + 1;
__global__ void __launch_bounds__(256, 2) fwd_kernel(Params p0) {
  __shared__ __attribute__((aligned(16))) char smem[SMEM_BYTES];
  cg::grid_group grid = cg::this_grid();
  const int ph_begin = p0.ph_begin, ph_end = p0.ph_end;
  unsigned* bar = (unsigned*)(p0.ws + OFF_BAR);
  unsigned epoch = 0u;
  for (int ph = ph_begin; ph < ph_end; ++ph) {
    auto kp = __builtin_amdgcn_kernarg_segment_ptr();
    asm volatile("" : "+s"(kp));
    typedef const __attribute__((address_space(4))) Params CParams;
    CParams* kpp = (CParams*)kp;
    Params p;
#pragma unroll
    for (int i = 0; i < 35; ++i) p.in[i] = kpp->in[i];
    p.out = kpp->out; p.ws = kpp->ws; p.ph_begin = ph_begin; p.ph_end = ph_end;
    if (ph == 0) phase_prologue(p, smem);
    else if (ph == NPHASES - 1) phase_final(p);
    else {
      const int l = (ph - 1) / 9, sp = (ph - 1) % 9;
#ifdef PROBE_SP
      if (sp == PROBE_SP) {
        switch (sp) {
          case 0: phase_norm_convert(p, l, smem); break;
          case 1: phase_gemm1(p, l, smem); break;
          case 3: phase_upproj(p, smem); break;
          case 5: phase_renorm_cpost(p, l); break;
          case 7: phase_merge(p, smem); break;
          default: break;
        }
        grid.sync();
      }
#endif
      switch (sp) {
        case 0: phase_norm_convert(p, l, smem); break;
        case 1: phase_gemm1(p, l, smem); break;
        case 2: phase_post(p, l); break;
        case 3: phase_upproj(p, smem); break;
        case 4: phase_mixers(p, l, smem); break;
        case 5: phase_renorm_cpost(p, l); break;
        case 6: phase_zgemm(p, smem); break;
        case 7: phase_merge(p, smem); break;
        default: phase_out(p, l, smem); break;
      }
    }
    if (ph + 1 < ph_end) { if (ph == 0) grid.sync(); else grid_barrier(bar, epoch); }
  }
}

extern "C" void kernel_launch(void* const* d_in, const int* in_sizes, int n_in, void* d_out, int out_size, void* d_ws, size_t ws_size, hipStream_t stream) {
  if (ws_size < WS_NEED || n_in < 35) { fprintf(stderr, "workspace too small: %zu < %zu\n", ws_size, WS_NEED); return; }
  static int grid_blocks = 0;
  if (!grid_blocks) {
    int dev = 0, cus = 0, per_cu = 0;
    hipGetDevice(&dev);
    hipDeviceGetAttribute(&cus, hipDeviceAttributeMultiprocessorCount, dev);
    hipOccupancyMaxActiveBlocksPerMultiprocessor(&per_cu, fwd_kernel, 256, 0);
    if (per_cu < 1) per_cu = 1;
    if (per_cu > 2) per_cu = 2;
    grid_blocks = cus * per_cu;
  }
  Params p{};
  for (int i = 0; i < 35; ++i) p.in[i] = (const float*)d_in[i];
  p.out = (float*)d_out; p.ws = (char*)d_ws;
#ifndef ONE_LAUNCH
  for (int ph = 0; ph < NPHASES; ++ph) {
    p.ph_begin = ph; p.ph_end = ph + 1;
    hipLaunchKernelGGL(fwd_kernel, dim3(grid_blocks), dim3(256), 0, stream, p);
  }
#else
  p.ph_begin = 0; p.ph_end = NPHASES;
  hipMemsetAsync((char*)d_ws + OFF_BAR, 0, 4096, stream);
  void* args[] = {&p};
  hipError_t e = hipLaunchCooperativeKernel((void*)fwd_kernel, dim3(grid_blocks), dim3(256), args, 0, stream);
  if (e != hipSuccess) fprintf(stderr, "cooperative launch failed: %s (grid %d)\n", hipGetErrorString(e), grid_blocks);
#endif
}
```

```cpp
#define ONE_LAUNCH 1
#include <hip/hip_runtime.h>
#include <hip/hip_cooperative_groups.h>
#include <stdint.h>
#include <stdio.h>
namespace cg = cooperative_groups;

typedef unsigned short bf16_t;
typedef short bf16x8 __attribute__((ext_vector_type(8)));
typedef float f32x16 __attribute__((ext_vector_type(16)));
typedef float f32x4 __attribute__((ext_vector_type(4)));
typedef float f32x2 __attribute__((ext_vector_type(2)));
typedef unsigned u32x4 __attribute__((ext_vector_type(4)));
typedef unsigned u32x2 __attribute__((ext_vector_type(2)));
#define DI __device__ __forceinline__
#define MFMA32(a, b, c) __builtin_amdgcn_mfma_f32_32x32x16_bf16((a), (b), (c), 0, 0, 0)

constexpr int NT = 40960;
constexpr int NCTX = 8192;
constexpr int NK = 45056;
constexpr int ULD = 3488;
constexpr int MODLD = 3072;
constexpr int SMEM_BYTES = 78848;

constexpr size_t OFF_WIN = 0;
constexpr size_t OFF_WO = 16777216;
constexpr size_t OFF_WOUT = 19922944;
constexpr size_t OFF_WU = 22020096;
constexpr size_t OFF_MOD = 22282240;
constexpr size_t OFF_BONUS = 22724608;
constexpr size_t OFF_CS16 = 25346048;
constexpr size_t OFF_CS8 = 25354240;
constexpr size_t OFF_CNT = 25358336;
constexpr size_t OFF_BAR = 524742912;
constexpr size_t OFF_U = 25358592;
constexpr size_t OFF_R1 = 311095552;
constexpr size_t OFF_KA = OFF_R1;
constexpr size_t OFF_VAT = 513208576;
constexpr size_t OFF_KN = OFF_R1 + 23068672;
constexpr size_t OFF_VBT = OFF_R1 + 69206016;
constexpr size_t OFF_KRB = OFF_R1 + 115343360;
constexpr size_t OFF_R2 = 429322496;
constexpr size_t WS_NEED = 524742912 + 4096;

constexpr size_t OUT_AK = 41943040, OUT_AV = 46137344, OUT_CKV = 50331648, OUT_KR = 54525952, OUT_SF = 55574528, OUT_SB = 59768832;

struct Params {
  const float* in[35];
  float* out;
  char* ws;
  int ph_begin, ph_end;
};

enum { I_XP = 0, I_XS, I_CAK, I_CAV, I_CCKV, I_CKR, I_SF, I_SB, I_C, I_CCTX, I_NORMW, I_WMOD, I_BMOD, I_WIN, I_QNW, I_KNW, I_KVNW,
       I_WUK, I_WUV, I_MUP, I_MUN, I_W0, I_WUP, I_A0, I_AUP, I_KK, I_KA, I_RK, I_LNW, I_LNB, I_WOA, I_WOB, I_WOC, I_WOUT, I_FNW };

DI int threadIdx_x_raw() { return __builtin_amdgcn_workitem_id_x(); }
DI int otid() { int t = threadIdx_x_raw(); asm volatile("" : "+v"(t)); return t; }
DI const float* opq(const float* q) { asm volatile("" : "+s"(q)); return q; }
DI float* opq(float* q) { asm volatile("" : "+s"(q)); return q; }
DI float bf2f(bf16_t v) { return __uint_as_float(((unsigned)v) << 16); }
typedef __bf16 hbf16x2 __attribute__((ext_vector_type(2)));
DI unsigned pack2(float a, float b) { f32x2 v = {a, b}; hbf16x2 r = __builtin_convertvector(v, hbf16x2); return __builtin_bit_cast(unsigned, r); }
DI bf16_t f2bf(float x) { return (bf16_t)(pack2(x, 0.f) & 0xffffu); }
DI float xsum16(float x) { const unsigned u = __float_as_uint(x); auto r = __builtin_amdgcn_permlane16_swap(u, u, false, false); return __uint_as_float(r[0]) + __uint_as_float(r[1]); }
DI float xsum32(float x) { const unsigned u = __float_as_uint(x); auto r = __builtin_amdgcn_permlane32_swap(u, u, false, false); return __uint_as_float(r[0]) + __uint_as_float(r[1]); }
DI float lo16(unsigned w) { return __uint_as_float(w << 16); }
DI float hi16(unsigned w) { return __uint_as_float(w & 0xffff0000u); }
DI void unpack8(u32x4 w, float* v) { v[0] = lo16(w.x); v[1] = hi16(w.x); v[2] = lo16(w.y); v[3] = hi16(w.y); v[4] = lo16(w.z); v[5] = hi16(w.z); v[6] = lo16(w.w); v[7] = hi16(w.w); }
DI u32x4 pack8(const float* v) { u32x4 w; w.x = pack2(v[0], v[1]); w.y = pack2(v[2], v[3]); w.z = pack2(v[4], v[5]); w.w = pack2(v[6], v[7]); return w; }
template <int K> DI float shx(float v) { return __int_as_float(__builtin_amdgcn_ds_swizzle(__float_as_int(v), 0x1f | (K << 10))); }
DI float wave_sum(float v) { v += shx<1>(v); v += shx<2>(v); v += shx<4>(v); v += shx<8>(v); v += shx<16>(v); return xsum32(v); }
DI float qsum(float v) {
  v += __int_as_float(__builtin_amdgcn_update_dpp(0, __float_as_int(v), 0xB1, 0xf, 0xf, true));
  v += __int_as_float(__builtin_amdgcn_update_dpp(0, __float_as_int(v), 0x4E, 0xf, 0xf, true));
  return v;
}
DI float osum(float v) {
  v = qsum(v);
  v += __int_as_float(__builtin_amdgcn_update_dpp(0, __float_as_int(v), 0x141, 0xf, 0xf, true));
  return v;
}
DI int crow(int reg, int h) { return (reg & 3) + 8 * (reg >> 2) + 4 * h; }
DI int crowu(int reg) { return (reg & 3) + 8 * (reg >> 2); }
DI int perm16(int t) { return (t & ~12) | ((t & 4) << 1) | ((t & 8) >> 1); }
DI float sigmoidf_(float x) { return __builtin_amdgcn_rcpf(1.0f + __expf(-x)); }
DI float siluf_(float x) { return x * __builtin_amdgcn_rcpf(1.0f + __expf(-x)); }

DI void row_decode(int row, int& seq, int& t) {
  if (row < NCTX) { seq = row >> 8; t = row & 255; } else { seq = 32 + ((row - NCTX) >> 12); t = (row - NCTX) & 4095; }
}
DI int keyrow0(int seq) { return seq < 32 ? seq * 256 : NCTX + (seq - 32) * 4608; }
DI int seq_tk(int seq) { return seq < 32 ? 256 : 4608; }

typedef __attribute__((address_space(3))) unsigned lds_u32;
template <int NJ>
DI void gemm_mainloop(f32x16 (&acc)[2][NJ], const bf16_t* __restrict__ A, int lda, int ks,
                      const bf16_t* __restrict__ Bt, int ldb, int K, char* smem) {
  constexpr int A_BYTES = 128 * 128;
  constexpr int B_BYTES = 64 * NJ * 128;
  constexpr int STAGE = A_BYTES + B_BYTES;
  const int tid = otid(), lane = tid & 63, wid = __builtin_amdgcn_readfirstlane(tid >> 6), wm = wid >> 1, wn = wid & 1;
  const int r = lane & 31, hh = lane >> 5;
  const int nk = K >> 6;
  const int lrow = tid >> 3, lc = tid & 7;
  const int gc = (lc ^ ((lrow >> 1) & 7)) * 8;
  const bf16_t* ap = A + (size_t)lrow * lda + gc;
  const bf16_t* bp = Bt + (size_t)lrow * ldb + gc;
  auto issue = [&](int kt, int buf) {
    char* base = smem + buf * STAGE + tid * 16;
    const bf16_t* ap2 = ap + (size_t)kt * ks;
    const bf16_t* bp2 = bp + (size_t)kt * 64;
#pragma unroll
    for (int p = 0; p < 4; ++p) __builtin_amdgcn_global_load_lds((const unsigned*)(ap2 + (size_t)(32 * p) * lda), (lds_u32*)(base + p * 4096), 16, 0, 0);
#pragma unroll
    for (int p = 0; p < 2 * NJ; ++p) __builtin_amdgcn_global_load_lds((const unsigned*)(bp2 + (size_t)(32 * p) * ldb), (lds_u32*)(base + A_BYTES + p * 4096), 16, 0, 0);
  };
  issue(0, 0);
  __syncthreads();
#pragma unroll 1
  for (int kt = 0; kt < nk; ++kt) {
    if (kt + 1 < nk) issue(kt + 1, (kt + 1) & 1);
    const char* base = smem + (kt & 1) * STAGE;
#pragma unroll
    for (int s = 0; s < 4; ++s) {
      bf16x8 af[2], bfr[NJ];
#pragma unroll
      for (int i = 0; i < 2; ++i) { const int row = wm * 64 + i * 32 + r; af[i] = *(const bf16x8*)(base + row * 128 + (((2 * s + hh) ^ ((row >> 1) & 7)) << 4)); }
#pragma unroll
      for (int j = 0; j < NJ; ++j) { const int row = wn * (32 * NJ) + j * 32 + r; bfr[j] = *(const bf16x8*)(base + A_BYTES + row * 128 + (((2 * s + hh) ^ ((row >> 1) & 7)) << 4)); }
#pragma unroll
      for (int i = 0; i < 2; ++i)
#pragma unroll
        for (int j = 0; j < NJ; ++j) acc[i][j] = MFMA32(af[i], bfr[j], acc[i][j]);
    }
    __syncthreads();
  }
}

template <int NJ> DI void zero_acc(f32x16 (&acc)[2][NJ]) {
#pragma unroll
  for (int i = 0; i < 2; ++i)
#pragma unroll
    for (int j = 0; j < NJ; ++j)
#pragma unroll
      for (int e = 0; e < 16; ++e) acc[i][j][e] = 0.f;
}

DI void phase_prologue(const Params& p, char* smem) {
  const int tid = otid(), lane = tid & 63, wid = __builtin_amdgcn_readfirstlane(tid >> 6);
  float* mod = (float*)(p.ws + OFF_MOD);
  if (blockIdx.x == 0) {
    if (tid < 32) ((unsigned*)(p.ws + OFF_CNT))[tid] = 0u;
    float* cs16 = (float*)(p.ws + OFF_CS16);
    float* cs8 = (float*)(p.ws + OFF_CS8);
    for (int e = tid; e < 64 * 16; e += 256) { const int pos = e >> 4, i = e & 15; const float inv = expf(-9.210340371976184f * (float)i / 16.0f); const float a = (float)pos * inv; cs16[e * 2] = cosf(a); cs16[e * 2 + 1] = sinf(a); }
    for (int e = tid; e < 64 * 8; e += 256) { const int pos = e >> 3, i = e & 7; const float inv = expf(-9.210340371976184f * (float)i / 8.0f); const float a = (float)pos * inv; cs8[e * 2] = cosf(a); cs8[e * 2 + 1] = sinf(a); }
  }
  float* sl = (float*)smem;
  float* red = sl + 9 * 1024;
  for (int e = tid; e < 9 * 1024; e += 256) { const int j = e >> 10, k = e & 1023; const float* cc0 = opq(p.in[I_CCTX]); const float* cc1 = opq(p.in[I_C]); const float c = j == 0 ? cc0[k] : cc1[(j - 1) * 1024 + k]; sl[e] = siluf_(c); }
  __syncthreads();
  for (int item = blockIdx.x; item < 192; item += gridDim.x) {
    const int l = item / 48, n = (item % 48) * 64 + lane;
    const float* w = p.in[I_WMOD] + (size_t)l * 1024 * 3072 + n;
    float a[9];
#pragma unroll
    for (int j = 0; j < 9; ++j) a[j] = 0.f;
    for (int k = wid * 256; k < wid * 256 + 256; ++k) {
      const float wv = w[(size_t)k * 3072];
#pragma unroll
      for (int j = 0; j < 9; ++j) a[j] += sl[j * 1024 + k] * wv;
    }
#pragma unroll
    for (int j = 0; j < 9; ++j) red[(wid * 9 + j) * 64 + lane] = a[j];
    __syncthreads();
    for (int e = tid; e < 9 * 64; e += 256) {
      const int j = e >> 6, c = e & 63;
      const float s = red[(0 * 9 + j) * 64 + c] + red[(1 * 9 + j) * 64 + c] + red[(2 * 9 + j) * 64 + c] + red[(3 * 9 + j) * 64 + c];
      const int nn = (item % 48) * 64 + c;
      mod[((size_t)l * 9 + j) * MODLD + nn] = s + p.in[I_BMOD][l * 3072 + nn];
    }
    __syncthreads();
  }
}

DI const float* x_row_ptr(const Params& p, int l, int row) {
  const float* xp = opq(p.in[I_XP]); const float* xs = opq(p.in[I_XS]); const float* xo = opq((const float*)p.out);
  if (l == 0) return row < NCTX ? xp + (size_t)row * 1024 : xs + (size_t)(row - NCTX) * 1024;
  return xo + (size_t)row * 1024;
}
DI void norm_row(const Params& p, int l, int row, int lane) {
  const float* x = x_row_ptr(p, l, row);
  const int j = row < NCTX ? 0 : 1 + ((row - NCTX) >> 12);
  const float* mod = (const float*)(p.ws + OFF_MOD) + ((size_t)l * 9 + j) * MODLD;
  const float* nw = p.in[I_NORMW] + l * 1024;
  bf16_t* h = (bf16_t*)(p.ws + OFF_R1) + (size_t)row * 1024;
  f32x4 v[4]; float ss = 0.f;
#pragma unroll
  for (int i = 0; i < 4; ++i) { v[i] = *(const f32x4*)(x + lane * 4 + 256 * i); ss += v[i].x * v[i].x + v[i].y * v[i].y + v[i].z * v[i].z + v[i].w * v[i].w; }
ss = wave_sum(ss);
  const float rs = rsqrtf(ss * (1.0f / 1024.0f) + 1e-6f);
#pragma unroll
  for (int i = 0; i < 4; ++i) {
    const int c = lane * 4 + 256 * i;
    const f32x4 w = *(const f32x4*)(nw + c), sh = *(const f32x4*)(mod + c), sc = *(const f32x4*)(mod + 1024 + c);
    u32x2 o;
    o.x = pack2(v[i].x * rs * w.x * (1.f + sc.x) + sh.x, v[i].y * rs * w.y * (1.f + sc.y) + sh.y);
    o.y = pack2(v[i].z * rs * w.z * (1.f + sc.z) + sh.z, v[i].w * rs * w.w * (1.f + sc.w) + sh.w);
    *(u32x2*)(h + c) = o;
  }
}

DI int win_srccol(int j) {
  if (j < 768) return j;
  if (j < 1696) return j + 512;
  if (j < 3488) return j + 1024;
  if (j < 3584) return -1;
  if (j < 5120) { const int jj = j - 3584; return jj < 512 ? 768 + jj : (jj < 1024 ? 2208 + (jj - 512) : 4512 + (jj - 1024)); }
  return 5024 + (j - 5120);
}
DI void conv_tile(const float* __restrict__ src, int ld_src, bf16_t* dst, int ld_dst, int k0, int n0, int kind, int srcoff, char* smem) {
  float* tile = (float*)smem;
  const int tid = otid();
  const int n = tid & 63;
  int sc = kind == 0 ? win_srccol(n0 + n) : (n0 + n - srcoff);
#pragma unroll
  for (int i = 0; i < 16; ++i) { const int k = i * 4 + (tid >> 6); tile[k * 65 + n] = sc >= 0 ? src[(size_t)(k0 + k) * ld_src + sc] : 0.f; }
  __syncthreads();
#pragma unroll
  for (int i = 0; i < 8; ++i) { const int nn = i * 8 + (tid >> 5), kk = (tid & 31) * 2; *(unsigned*)(dst + (size_t)(n0 + nn) * ld_dst + k0 + kk) = pack2(tile[kk * 65 + nn], tile[(kk + 1) * 65 + nn]); }
  __syncthreads();
}

DI void phase_norm_convert(const Params& p, int l, char* smem) {
  const int tid = otid(), lane = tid & 63, wid = __builtin_amdgcn_readfirstlane(tid >> 6);
  bf16_t* WinT = (bf16_t*)(p.ws + OFF_WIN); bf16_t* WoT = (bf16_t*)(p.ws + OFF_WO); bf16_t* WoutT = (bf16_t*)(p.ws + OFF_WOUT); bf16_t* WuT = (bf16_t*)(p.ws + OFF_WU);
  const int NI_WIN = 128 * 16, NI_WO = 3 * 16 * 8, NI_WOUT = 16 * 16, NI_WU = 16 * 2;
  const int NI_CONV = NI_WIN + NI_WO + NI_WOUT + NI_WU;
  for (int item = blockIdx.x; item < NI_CONV; item += gridDim.x) {
    int it = item;
    if (it < NI_WIN) { conv_tile(p.in[I_WIN] + (size_t)l * 1024 * 8096, 8096, WinT, 1024, (it & 15) * 64, (it >> 4) * 64, 0, 0, smem); continue; }
    it -= NI_WIN;
    if (it < NI_WO) { const int br = it / 128, r2 = it % 128; const float* src = (br == 0 ? opq(p.in[I_WOA]) : (br == 1 ? opq(p.in[I_WOB]) : opq(p.in[I_WOC]))) + (size_t)l * 512 * 1024; conv_tile(src, 1024, WoT + (size_t)br * 1024 * 512, 512, (r2 & 7) * 64, (r2 >> 3) * 64, 1, 0, smem); continue; }
    it -= NI_WO;
    if (it < NI_WOUT) { conv_tile(p.in[I_WOUT] + (size_t)l * 1024 * 1024, 1024, WoutT, 1024, (it & 15) * 64, (it >> 4) * 64, 1, 0, smem); continue; }
    it -= NI_WOUT;
    { const int nt = it >> 1, kt = it & 1; const bool uv = nt >= 8; const float* src = (uv ? opq(p.in[I_WUV]) : opq(p.in[I_WUK])) + (size_t)l * 128 * 512; conv_tile(src, 512, WuT, 128, kt * 64, nt * 64, 1, uv ? 512 : 0, smem); }
  }
  for (int item = blockIdx.x; item < NT / 4; item += gridDim.x) norm_row(p, l, item * 4 + wid, lane);
}

DI void phase_gemm1(const Params& p, int l, char* smem) {
  const bf16_t* H = (const bf16_t*)(p.ws + OFF_R1);
  const bf16_t* W = (const bf16_t*)(p.ws + OFF_WIN);
  bf16_t* U = (bf16_t*)(p.ws + OFF_U);
  bf16_t* VAT = (bf16_t*)(p.ws + OFF_VAT);
  const int NTN = 28, ntiles = 320 * NTN;
  for (int tile = blockIdx.x; tile < ntiles; tile += gridDim.x) {
    const int mt = tile / NTN, nt = tile % NTN, m0 = mt * 128, n0 = nt * 128;
    f32x16 acc[2][2]; zero_acc<2>(acc);
    gemm_mainloop<2>(acc, H + (size_t)m0 * 1024, 1024, 64, W + (size_t)n0 * 1024, 1024, 1024, smem);
    const int lane = otid() & 63, wid = __builtin_amdgcn_readfirstlane(otid() >> 6), wm = wid >> 1, wn = wid & 1, r = lane & 31, hh = lane >> 5;
    int seq, t0; row_decode(m0, seq, t0);
#pragma unroll
    for (int j = 0; j < 2; ++j) {
      const int cb = n0 + wn * 64 + j * 32;
      if (cb >= ULD) continue;
      const int col = cb + r;
      if (cb >= 640 && cb < 768) {
        const int kvh = (col - 640) >> 6, dv = col & 63, Tk = seq_tk(seq);
        bf16_t* vt = VAT + (size_t)128 * keyrow0(seq) + (size_t)(kvh * 64 + dv) * Tk;
#pragma unroll
        for (int i = 0; i < 2; ++i) {
          const int tt = t0 + wm * 64 + i * 32;
#pragma unroll
          for (int g2 = 0; g2 < 2; ++g2) {
            float v[8];
#pragma unroll
            for (int e = 0; e < 8; ++e) v[e] = acc[i][j][g2 * 8 + e];
            *(u32x4*)(vt + tt + 16 * g2 + 8 * hh) = pack8(v);
          }
          if (seq < 32) {
            float* o = p.out + OUT_AV + ((size_t)(seq * 4 + l) * 256 + tt) * 128;
            const int lo = 4 * hh * 128 + (col - 640);
#pragma unroll
            for (int e = 0; e < 16; ++e) (o + crowu(e) * 128)[lo] = acc[i][j][e];
          }
        }
      } else {
#pragma unroll
        for (int i = 0; i < 2; ++i) {
          bf16_t* up = U + (size_t)(m0 + wm * 64 + i * 32) * ULD;
          const int lo = 4 * hh * ULD + col;
#pragma unroll
          for (int e = 0; e < 16; ++e) (up + crowu(e) * ULD)[lo] = f2bf(acc[i][j][e]);
        }
      }
    }
  }
}

DI void post_row(const Params& p, int l, int row, int lane) {
  int seq, t; row_decode(row, seq, t);
  const bool lat = row >= NCTX;
  const int krow = keyrow0(seq) + t;
  const int prow = t >> 6, pcol = t & 63;
  bf16_t* u = (bf16_t*)(p.ws + OFF_U) + (size_t)row * ULD;
  const float* cs16 = (const float*)(p.ws + OFF_CS16);
  const float* cs8 = (const float*)(p.ws + OFF_CS8);
  const float LOG2E = 1.4426950408889634f;
#pragma unroll
  for (int which = 0; which < 2; ++which) {
    const int l8 = which == 0 ? lane : (lane & 15);
    const bf16_t* src = u + (which == 0 ? 0 : 512) + l8 * 8;
    float v[8]; unpack8(*(const u32x4*)src, v);
    float ss = 0.f;
#pragma unroll
    for (int i = 0; i < 8; ++i) ss += v[i] * v[i];
    ss += shx<1>(ss); ss += shx<2>(ss); ss += shx<4>(ss);
    const float rs = rsqrtf(ss * (1.0f / 64.0f) + 1e-6f);
    const float* nw = (which == 0 ? opq(p.in[I_QNW]) : opq(p.in[I_KNW])) + l * 64 + (lane & 7) * 8;
#pragma unroll
    for (int i = 0; i < 8; ++i) v[i] = v[i] * rs * nw[i];
    float pv[8];
#pragma unroll
    for (int i = 0; i < 8; ++i) pv[i] = shx<2>(v[i]);
    if (lat) {
      const int pos = ((lane & 7) >> 2) ? pcol : prow;
      const bool lower = (lane & 2) == 0;
      const float* cs = cs16 + (pos * 16 + (lane & 1) * 8) * 2;
#pragma unroll
      for (int i = 0; i < 8; ++i) { const float c = cs[i * 2], s = cs[i * 2 + 1]; v[i] = lower ? v[i] * c - pv[i] * s : v[i] * c + pv[i] * s; }
    }
    if (which == 0) {
      const float sc = 0.125f * LOG2E;
#pragma unroll
      for (int i = 0; i < 8; ++i) v[i] *= sc;
      *(u32x4*)(u + lane * 8) = pack8(v);
    } else if (lane < 16) {
      bf16_t* KA = (bf16_t*)(p.ws + OFF_KA);
      *(u32x4*)(KA + (size_t)krow * 128 + lane * 8) = pack8(v);
      if (!lat) {
        float* o = p.out + OUT_AK + ((size_t)(seq * 4 + l) * 256 + t) * 128 + lane * 8;
        *(f32x4*)o = (f32x4){v[0], v[1], v[2], v[3]}; *(f32x4*)(o + 4) = (f32x4){v[4], v[5], v[6], v[7]};
      }
    }
  }
  {
    const float sc = 0.10206207261596577f * LOG2E;
    const int hd = lane >> 3;
    bf16_t* q = u + 768 + hd * 96;
    { float v[8]; unpack8(*(const u32x4*)(q + (lane & 7) * 8), v);
#pragma unroll
      for (int i = 0; i < 8; ++i) v[i] *= sc;
      *(u32x4*)(q + (lane & 7) * 8) = pack8(v); }
    { bf16_t* qr = q + 64 + (lane & 7) * 4;
      const u32x2 w = *(const u32x2*)qr;
      float v[4] = {lo16(w.x), hi16(w.x), lo16(w.y), hi16(w.y)}, pv[4];
#pragma unroll
      for (int i = 0; i < 4; ++i) pv[i] = shx<2>(v[i]);
      if (lat) {
        const int pos = ((lane & 7) >> 2) ? pcol : prow;
        const bool lower = (lane & 2) == 0;
        const float* cs = cs8 + (pos * 8 + (lane & 1) * 4) * 2;
#pragma unroll
        for (int i = 0; i < 4; ++i) { const float c = cs[i * 2], s = cs[i * 2 + 1]; v[i] = lower ? v[i] * c - pv[i] * s : v[i] * c + pv[i] * s; }
      }
      u32x2 o; o.x = pack2(v[0] * sc, v[1] * sc); o.y = pack2(v[2] * sc, v[3] * sc);
      *(u32x2*)qr = o; }
  }
  {
    const unsigned w = *(const unsigned*)(u + 1536 + lane * 2);
    float a = lo16(w), b = hi16(w);
    float ss = a * a + b * b;
ss = wave_sum(ss);
    const float rs = rsqrtf(ss * (1.0f / 128.0f) + 1e-6f);
    const float* nw = p.in[I_KVNW] + l * 128 + lane * 2;
    a = a * rs * nw[0]; b = b * rs * nw[1];
    bf16_t* CKVN = (bf16_t*)(p.ws + OFF_R2);
    *(unsigned*)(CKVN + (size_t)krow * 128 + lane * 2) = pack2(a, b);
    if (!lat) { float* o = p.out + OUT_CKV + ((size_t)(seq * 4 + l) * 256 + t) * 128 + lane * 2; *(f32x2*)o = (f32x2){a, b}; }
  }
  {
    float v = bf2f(u[1664 + (lane & 31)]);
    const float pv = shx<8>(v);
    if (!lat) { if (lane < 32) p.out[OUT_KR + ((size_t)(seq * 4 + l) * 256 + t) * 32 + lane] = v; }
    else {
      const int d = lane & 31; const int pos = (d >> 4) ? pcol : prow; const bool lower = (d & 8) == 0;
      const float* cs = cs8 + (pos * 8 + (d & 7)) * 2;
      v = lower ? v * cs[0] - pv * cs[1] : v * cs[0] + pv * cs[1];
    }
    if (lane < 32) ((bf16_t*)(p.ws + OFF_KRB))[(size_t)krow * 32 + lane] = f2bf(v);
  }
}
DI void post_cached_row(const Params& p, int l, int idx, int lane) {
  const int b = idx >> 9, j = idx & 511;
  const int kr0 = NCTX + b * 4608, krow = kr0 + 4096 + j;
  const size_t cb = ((size_t)(b * 4 + l) * 512 + j);
  bf16_t* KA = (bf16_t*)(p.ws + OFF_KA); bf16_t* VAT = (bf16_t*)(p.ws + OFF_VAT); bf16_t* CKVN = (bf16_t*)(p.ws + OFF_R2); bf16_t* KRB = (bf16_t*)(p.ws + OFF_KRB);
  { const f32x2 v = *(const f32x2*)(p.in[I_CAK] + cb * 128 + lane * 2); *(unsigned*)(KA + (size_t)krow * 128 + lane * 2) = pack2(v.x, v.y); }
  { const f32x2 v = *(const f32x2*)(p.in[I_CAV] + cb * 128 + lane * 2);
    bf16_t* vt = VAT + (size_t)128 * kr0 + (size_t)(lane * 2) * 4608 + perm16(4096 + j);
    vt[0] = f2bf(v.x); vt[4608] = f2bf(v.y); }
  { const f32x2 v = *(const f32x2*)(p.in[I_CCKV] + cb * 128 + lane * 2); *(unsigned*)(CKVN + (size_t)krow * 128 + lane * 2) = pack2(v.x, v.y); }
  if (lane < 32) KRB[(size_t)krow * 32 + lane] = f2bf(p.in[I_CKR][cb * 32 + lane]);
}
DI void phase_post(const Params& p, int l) {
  const int lane = otid() & 63, wid = __builtin_amdgcn_readfirstlane(otid() >> 6);
  for (int item = blockIdx.x; item < NT / 4 + 1024; item += gridDim.x) {
    if (item < NT / 4) post_row(p, l, item * 4 + wid, lane);
    else post_cached_row(p, l, (item - NT / 4) * 4 + wid, lane);
  }
}

DI void phase_upproj(const Params& p, char* smem) {
  const bf16_t* A = (const bf16_t*)(p.ws + OFF_R2);
  const bf16_t* W = (const bf16_t*)(p.ws + OFF_WU);
  bf16_t* KN = (bf16_t*)(p.ws + OFF_KN); bf16_t* VBT = (bf16_t*)(p.ws + OFF_VBT);
  const int ntiles = 352 * 8;
  for (int tile = blockIdx.x; tile < ntiles; tile += gridDim.x) {
    const int mt = tile >> 3, nt = tile & 7, m0 = mt * 128, n0 = nt * 128;
    f32x16 acc[2][2]; zero_acc<2>(acc);
    gemm_mainloop<2>(acc, A + (size_t)m0 * 128, 128, 64, W + (size_t)n0 * 128, 128, 128, smem);
    const int lane = otid() & 63, wid = __builtin_amdgcn_readfirstlane(otid() >> 6), wm = wid >> 1, wn = wid & 1, r = lane & 31, hh = lane >> 5;
    int seq, t0;
    if (m0 < NCTX) { seq = m0 >> 8; t0 = m0 & 255; } else { const int rr = m0 - NCTX; seq = 32 + rr / 4608; t0 = rr % 4608; }
#pragma unroll
    for (int j = 0; j < 2; ++j) {
      const int col = n0 + wn * 64 + j * 32 + r;
      if (n0 < 512) {
#pragma unroll
        for (int i = 0; i < 2; ++i) {
          bf16_t* kp = KN + (size_t)(m0 + wm * 64 + i * 32) * 512;
          const int lo = 4 * hh * 512 + col;
#pragma unroll
          for (int e = 0; e < 16; ++e) (kp + crowu(e) * 512)[lo] = f2bf(acc[i][j][e]);
        }
      } else {
        const int Tk = seq_tk(seq);
        bf16_t* vt = VBT + (size_t)512 * keyrow0(seq) + (size_t)(col - 512) * Tk;
#pragma unroll
        for (int i = 0; i < 2; ++i) {
          const int tt = t0 + wm * 64 + i * 32;
#pragma unroll
          for (int g2 = 0; g2 < 2; ++g2) {
            float v[8];
#pragma unroll
            for (int e = 0; e < 8; ++e) v[e] = acc[i][j][g2 * 8 + e];
            *(u32x4*)(vt + tt + 16 * g2 + 8 * hh) = pack8(v);
          }
        }
      }
    }
  }
}

template <int DQK>
DI void attn_item(const bf16_t* Qw, int q_ld, const bf16_t* K1, int k1_ld, const bf16_t* K2, int k2_ld,
                  const bf16_t* Vt, int vt_ld, int nkeys, bf16_t* Ow, int o_ld, char* smem) {
  constexpr int KS = DQK * 2 + 16;
  constexpr int KBYTES = 64 * KS;
  constexpr int VS = 144;
  constexpr int VBYTES = 64 * VS;
  constexpr int STAGE = KBYTES + VBYTES;
  constexpr int CPR = DQK / 8;
  constexpr int NKC = 64 * CPR / 256;
  constexpr int NS = DQK / 16;
  const int tid = otid(), lane = tid & 63, r = lane & 31, hh = lane >> 5;
  bf16x8 qf[NS];
#pragma unroll
  for (int s = 0; s < NS; ++s) qf[s] = *(const bf16x8*)(Qw + (size_t)r * q_ld + 16 * s + 8 * hh);
  f32x16 o[2];
#pragma unroll
  for (int n = 0; n < 2; ++n)
#pragma unroll
    for (int e = 0; e < 16; ++e) o[n][e] = 0.f;
  float m_run = 0.f, lsum = 0.f;
  u32x4 rk0[NKC], rv0[2], rk1[NKC], rv1[2];
  int krow_[NKC], kc_[NKC];
#pragma unroll
  for (int q = 0; q < NKC; ++q) { const int id = q * 256 + tid; krow_[q] = id / CPR; kc_[q] = id % CPR; }
  const int vrow = tid >> 3, vc = tid & 7;
  auto gload = [&](int key0, u32x4 (&rk)[NKC], u32x4 (&rv)[2]) {
#pragma unroll
    for (int q = 0; q < NKC; ++q) {
      const bf16_t* src = (DQK == 64 || kc_[q] < 8) ? K1 + (size_t)(key0 + krow_[q]) * k1_ld + kc_[q] * 8 : K2 + (size_t)(key0 + krow_[q]) * k2_ld + (kc_[q] - 8) * 8;
      rk[q] = *(const u32x4*)src;
    }
#pragma unroll
    for (int q = 0; q < 2; ++q) rv[q] = *(const u32x4*)(Vt + (size_t)(vrow + 32 * q) * vt_ld + key0 + vc * 8);
  };
  auto lstore = [&](int buf, u32x4 (&rk)[NKC], u32x4 (&rv)[2]) {
    char* base = smem + buf * STAGE;
#pragma unroll
    for (int q = 0; q < NKC; ++q) *(u32x4*)(base + krow_[q] * KS + kc_[q] * 16) = rk[q];
#pragma unroll
    for (int q = 0; q < 2; ++q) *(u32x4*)(base + KBYTES + (vrow + 32 * q) * VS + vc * 16) = rv[q];
  };
  const int ntl = nkeys >> 6;
  gload(0, rk0, rv0); lstore(0, rk0, rv0);
  gload(64, rk1, rv1);
  if (ntl > 2) gload(128, rk0, rv0);
  __syncthreads();
  auto tile_body = [&](int tl, u32x4 (&rkn)[NKC], u32x4 (&rvn)[2]) {
    const char* base = smem + (tl & 1) * STAGE;
    bf16x8 kf[2][NS], vf[2][2][2];
#pragma unroll
    for (int kb = 0; kb < 2; ++kb)
#pragma unroll
      for (int ks = 0; ks < NS; ++ks) kf[kb][ks] = *(const bf16x8*)(base + (kb * 32 + r) * KS + (2 * ks + hh) * 16);
    __builtin_amdgcn_sched_barrier(0);
    f32x16 s[2];
    const float ninit = -m_run;
#pragma unroll
    for (int kb = 0; kb < 2; ++kb)
#pragma unroll
      for (int e = 0; e < 16; ++e) s[kb][e] = ninit;
#pragma unroll
    for (int ks = 0; ks < NS; ++ks)
#pragma unroll
      for (int kb = 0; kb < 2; ++kb) s[kb] = MFMA32(kf[kb][ks], qf[ks], s[kb]);
#pragma unroll
    for (int kb = 0; kb < 2; ++kb)
#pragma unroll
      for (int s2 = 0; s2 < 2; ++s2)
#pragma unroll
        for (int n = 0; n < 2; ++n) vf[kb][s2][n] = *(const bf16x8*)(base + KBYTES + (32 * n + r) * VS + (kb * 32 + 16 * s2 + 8 * hh) * 2);
    __builtin_amdgcn_sched_barrier(0);
    float mx = s[0][0];
#pragma unroll
    for (int kb = 0; kb < 2; ++kb)
#pragma unroll
      for (int e = 0; e < 16; ++e) mx = fmaxf(mx, s[kb][e]);
    { const unsigned u = __float_as_uint(mx); auto sw = __builtin_amdgcn_permlane32_swap(u, u, false, false); mx = fmaxf(__uint_as_float(sw[0]), __uint_as_float(sw[1])); }
    const bool move = (mx > 4.0f) || (mx < -20.0f);
    if (__builtin_amdgcn_ballot_w64(move) != 0ull) {
      const float dlt = move ? mx : 0.f;
      const float alpha = __builtin_amdgcn_exp2f(-dlt);
      m_run += dlt;
      lsum *= alpha;
#pragma unroll
      for (int kb = 0; kb < 2; ++kb)
#pragma unroll
        for (int e = 0; e < 16; ++e) s[kb][e] -= dlt;
#pragma unroll
      for (int n = 0; n < 2; ++n)
#pragma unroll
        for (int e = 0; e < 16; ++e) o[n][e] *= alpha;
    }
    float ps = 0.f;
#pragma unroll
    for (int kb = 0; kb < 2; ++kb)
#pragma unroll
      for (int e = 0; e < 16; ++e) { const float pe = __builtin_amdgcn_exp2f(s[kb][e]); s[kb][e] = pe; ps += pe; }
    lsum += ps;
#pragma unroll
    for (int kb = 0; kb < 2; ++kb)
#pragma unroll
      for (int s2 = 0; s2 < 2; ++s2) {
        u32x4 pw;
        pw.x = pack2(s[kb][8 * s2 + 0], s[kb][8 * s2 + 1]); pw.y = pack2(s[kb][8 * s2 + 2], s[kb][8 * s2 + 3]);
        pw.z = pack2(s[kb][8 * s2 + 4], s[kb][8 * s2 + 5]); pw.w = pack2(s[kb][8 * s2 + 6], s[kb][8 * s2 + 7]);
        const bf16x8 pf = __builtin_bit_cast(bf16x8, pw);
#pragma unroll
        for (int n = 0; n < 2; ++n) o[n] = MFMA32(vf[kb][s2][n], pf, o[n]);
      }
    if (tl + 1 < ntl) { lstore((tl + 1) & 1, rkn, rvn); if (tl + 3 < ntl) gload((tl + 3) * 64, rkn, rvn); }
    __syncthreads();
  };
  for (int tl = 0; tl < ntl; tl += 2) { tile_body(tl, rk1, rv1); tile_body(tl + 1, rk0, rv0); }
  lsum = xsum32(lsum);
  const float inv = 1.0f / lsum;
#pragma unroll
  for (int n = 0; n < 2; ++n)
#pragma unroll
    for (int g = 0; g < 4; ++g) {
      u32x2 w; w.x = pack2(o[n][4 * g] * inv, o[n][4 * g + 1] * inv); w.y = pack2(o[n][4 * g + 2] * inv, o[n][4 * g + 3] * inv);
      *(u32x2*)(Ow + (size_t)r * o_ld + 32 * n + 8 * g + 4 * hh) = w;
    }
}

DI void scan_item(const Params& p, int l, int seq, int hd, int dir, int rs, char* smem) {
  const int tid = otid(), lane = tid & 63, wv = __builtin_amdgcn_readfirstlane(tid >> 6);
  const int j8 = lane & 7, r = lane & 31, hh = lane >> 5;
  const bool lat = seq >= 32;
  const int T = lat ? 4096 : 256;
  const int row0 = lat ? NCTX + (seq - 32) * 4096 : seq * 256;
  float* vA = (float*)smem; float* vK = vA + 2048; float* vR = vK + 2048; float* vV = vR + 2048; float* vW = vV + 2048; float* vB = vW + 2048; float* ybuf = vB + 2048;
  char* raw = smem + 32768;
  char* wdx = smem + 57344; char* adx = smem + 61952;
  float* tmpb = (float*)(smem + 66816);
  const bf16_t* U = (const bf16_t*)(p.ws + OFF_U);
  bf16_t* Y = (bf16_t*)(p.ws + OFF_R2) + (dir ? (size_t)NT * 512 : 0);
  float* bonus = (float*)(p.ws + OFF_BONUS);
  const int lrow = 8 * wv + (lane >> 3), irow = rs * 32 + lrow;
  f32x2 S[4];
  if (lat) {
    const float* s0 = (dir ? opq(p.in[I_SB]) : opq(p.in[I_SF])) + ((size_t)((seq - 32) * 4 + l) * 8 + hd) * 4096 + irow * 64 + j8 * 8;
#pragma unroll
    for (int q = 0; q < 2; ++q) { const f32x4 v = *(const f32x4*)(s0 + 4 * q); S[2 * q] = (f32x2){v.x, v.y}; S[2 * q + 1] = (f32x2){v.z, v.w}; }
  } else {
#pragma unroll
    for (int q = 0; q < 4; ++q) S[q] = (f32x2){0.f, 0.f};
  }
  const int mat = wv >> 1, ntc = wv & 1, cch = ntc * 32 + r, hc = hd * 64 + cch;
  bf16x8 bfrag[4];
  {
    const float* W = (mat ? opq(p.in[I_AUP]) : opq(p.in[I_WUP])) + (size_t)(l * 2 + dir) * 64 * 512 + hc;
#pragma unroll
    for (int s4 = 0; s4 < 4; ++s4) {
      float w8[8];
#pragma unroll
      for (int j = 0; j < 8; ++j) w8[j] = W[(size_t)(16 * s4 + 8 * hh + j) * 512];
      bfrag[s4] = __builtin_bit_cast(bf16x8, pack8(w8));
    }
  }
  const float bias = (mat ? opq(p.in[I_A0]) : opq(p.in[I_W0]))[(l * 2 + dir) * 512 + hc];
  const float kav = p.in[I_KA][l * 512 + hc], rkv = p.in[I_RK][l * 512 + hc];
  float* muP = (float*)(smem + 75008); float* muN = muP + 320; float* kkL = muN + 320;
  {
    const float* mup = p.in[I_MUP] + l * 1792; const float* mun = p.in[I_MUN] + l * 1792;
    for (int e = tid; e < 320; e += 256) { const int g = e >> 6, c = e & 63; const int col = (g < 3 ? g * 512 + hd * 64 : (g == 3 ? 1536 + dir * 64 : 1664 + dir * 64)) + c; muP[e] = mup[col]; muN[e] = mun[col]; }
    if (tid < 64) kkL[tid] = p.in[I_KK][l * 512 + hd * 64 + tid];
  }
  const int nch = T >> 5;
  u32x4 pre[6];
  auto prefetch = [&](int t0) {
#pragma unroll
    for (int q = 0; q < 6; ++q) {
      const int id = q * 256 + tid;
      const int row = id / 40, cc = id - row * 40, g = cc >> 3, c8 = cc & 7;
      const int t = t0 - 1 + row;
      const int col = (g < 3 ? g * 512 + hd * 64 : (g == 3 ? 1536 + dir * 64 : 1664 + dir * 64)) + c8 * 8;
      u32x4 v = (u32x4){0u, 0u, 0u, 0u};
      if (id < 1360 && t >= 0 && t < T) v = *(const u32x4*)(U + (size_t)(row0 + t) * ULD + 1696 + col);
      pre[q] = v;
    }
  };
  prefetch((dir ? nch - 1 : 0) * 32);
  for (int ci = 0; ci < nch; ++ci) {
    const int t0 = (dir ? nch - 1 - ci : ci) * 32;
#pragma unroll
    for (int q = 0; q < 6; ++q) { const int id = q * 256 + tid; if (id < 1360) *(u32x4*)(raw + id * 16) = pre[q]; }
    __syncthreads();
    if (ci + 1 < nch) prefetch((dir ? nch - 2 - ci : ci + 1) * 32);
    {
      const int tt = tid >> 3, sub = tid & 7;
#pragma unroll 1
      for (int g = 0; g < 5; ++g) {
        const int col = (g < 3 ? g * 512 + hd * 64 : (g == 3 ? 1536 + dir * 64 : 1664 + dir * 64)) + sub * 8;
        float c[8], pv[8], nx[8], x[8];
        unpack8(*(const u32x4*)(raw + (tt + 1) * 640 + (g * 8 + sub) * 16), c);
        unpack8(*(const u32x4*)(raw + tt * 640 + (g * 8 + sub) * 16), pv);
        unpack8(*(const u32x4*)(raw + (tt + 2) * 640 + (g * 8 + sub) * 16), nx);
        const f32x4 mp0 = *(const f32x4*)(muP + g * 64 + sub * 8), mp1 = *(const f32x4*)(muP + g * 64 + sub * 8 + 4), mn0 = *(const f32x4*)(muN + g * 64 + sub * 8), mn1 = *(const f32x4*)(muN + g * 64 + sub * 8 + 4);
        const float mp[8] = {mp0.x, mp0.y, mp0.z, mp0.w, mp1.x, mp1.y, mp1.z, mp1.w}, mn[8] = {mn0.x, mn0.y, mn0.z, mn0.w, mn1.x, mn1.y, mn1.z, mn1.w};
#pragma unroll
        for (int i = 0; i < 8; ++i) x[i] = c[i] + mp[i] * (pv[i] - c[i]) + mn[i] * (nx[i] - c[i]);
        const int lo = tt * 64 + sub * 8;
        if (g == 0) { *(f32x4*)(vR + lo) = (f32x4){x[0], x[1], x[2], x[3]}; *(f32x4*)(vR + lo + 4) = (f32x4){x[4], x[5], x[6], x[7]}; }
        else if (g == 1) {
          float kk[8], ss = 0.f;
          const float* kkw = kkL + sub * 8;
#pragma unroll
          for (int i = 0; i < 8; ++i) { kk[i] = x[i] * kkw[i]; ss += kk[i] * kk[i]; }
          *(f32x4*)(vK + lo) = (f32x4){x[0], x[1], x[2], x[3]}; *(f32x4*)(vK + lo + 4) = (f32x4){x[4], x[5], x[6], x[7]};
          ss += shx<1>(ss); ss += shx<2>(ss); ss += shx<4>(ss);
          const float inv = 1.0f / fmaxf(sqrtf(ss), 1e-12f);
          *(f32x4*)(vA + lo) = (f32x4){kk[0] * inv, kk[1] * inv, kk[2] * inv, kk[3] * inv}; *(f32x4*)(vA + lo + 4) = (f32x4){kk[4] * inv, kk[5] * inv, kk[6] * inv, kk[7] * inv};
        }
        else if (g == 2) { *(f32x4*)(vV + lo) = (f32x4){x[0], x[1], x[2], x[3]}; *(f32x4*)(vV + lo + 4) = (f32x4){x[4], x[5], x[6], x[7]}; }
        else if (g == 3) { float th[8]; for (int i = 0; i < 8; ++i) th[i] = 1.0f - 2.0f * __builtin_amdgcn_rcpf(1.0f + __expf(2.0f * x[i])); *(u32x4*)(wdx + tt * 144 + sub * 16) = pack8(th); }
        else { *(u32x4*)(adx + tt * 144 + sub * 16) = pack8(x); }
      }
    }
    __syncthreads();
    {
      f32x16 acc;
#pragma unroll
      for (int e = 0; e < 16; ++e) acc[e] = 0.f;
      const char* xb = mat ? adx : wdx;
#pragma unroll
      for (int s4 = 0; s4 < 4; ++s4) { const bf16x8 af = *(const bf16x8*)(xb + r * 144 + (16 * s4 + 8 * hh) * 2); acc = MFMA32(af, bfrag[s4], acc); }
      if (mat == 0) {
#pragma unroll
        for (int e = 0; e < 16; ++e) vW[crow(e, hh) * 64 + cch] = __expf(-0.6065306597126334f * sigmoidf_(bias + acc[e]));
      } else {
#pragma unroll
        for (int e = 0; e < 16; ++e) {
          const int ix = crow(e, hh) * 64 + cch;
          const float ag = sigmoidf_(bias + acc[e]);
          const float kk = vA[ix], k = vK[ix], rr = vR[ix];
          const float kd = k * (1.0f + (ag - 1.0f) * kav);
          vK[ix] = kd; vA[ix] = -kk; vB[ix] = kk * ag; tmpb[ix] = rr * kd * rkv;
        }
      }
    }
    __syncthreads();
    {
      const int tt = tid >> 3, sub = tid & 7;
      const f32x4 b0 = *(const f32x4*)(tmpb + tt * 64 + sub * 8), b1 = *(const f32x4*)(tmpb + tt * 64 + sub * 8 + 4);
      float bs = (b0.x + b0.y) + (b0.z + b0.w) + (b1.x + b1.y) + (b1.z + b1.w);
      bs += shx<1>(bs); bs += shx<2>(bs); bs += shx<4>(bs);
      if (sub == 0 && rs == 0) bonus[((size_t)(row0 + t0 + tt) * 8 + hd) * 2 + dir] = bs;
    }
    {
      f32x4 va[2], vw[2], vb[2], vk[2], vr[2]; float vi;
      int tt = dir ? 31 : 0;
      int vo = tt * 64 + j8 * 8;
#pragma unroll
      for (int q = 0; q < 2; ++q) { va[q] = *(const f32x4*)(vA + vo + 4 * q); vw[q] = *(const f32x4*)(vW + vo + 4 * q); vb[q] = *(const f32x4*)(vB + vo + 4 * q); vk[q] = *(const f32x4*)(vK + vo + 4 * q); vr[q] = *(const f32x4*)(vR + vo + 4 * q); }
      vi = vV[tt * 64 + irow];
      for (int si = 0; si < 32; ++si) {
        const int ttn = dir ? (si < 31 ? 30 - si : 0) : (si < 31 ? si + 1 : 31);
        const int von = ttn * 64 + j8 * 8;
        f32x2 pa2 = S[0] * (f32x2){va[0].x, va[0].y}, pa3 = S[1] * (f32x2){va[0].z, va[0].w};
        pa2 += S[2] * (f32x2){va[1].x, va[1].y}; pa3 += S[3] * (f32x2){va[1].z, va[1].w};
#pragma unroll
        for (int q = 0; q < 2; ++q) va[q] = *(const f32x4*)(vA + von + 4 * q);
        pa2 += pa3;
        const float sa = osum(pa2.x + pa2.y);
        const f32x2 sa2 = (f32x2){sa, sa}, vi2 = (f32x2){vi, vi};
        f32x2 py2, py3;
        S[0] = S[0] * (f32x2){vw[0].x, vw[0].y} + (sa2 * (f32x2){vb[0].x, vb[0].y} + vi2 * (f32x2){vk[0].x, vk[0].y}); py2 = S[0] * (f32x2){vr[0].x, vr[0].y};
        S[1] = S[1] * (f32x2){vw[0].z, vw[0].w} + (sa2 * (f32x2){vb[0].z, vb[0].w} + vi2 * (f32x2){vk[0].z, vk[0].w}); py3 = S[1] * (f32x2){vr[0].z, vr[0].w};
        S[2] = S[2] * (f32x2){vw[1].x, vw[1].y} + (sa2 * (f32x2){vb[1].x, vb[1].y} + vi2 * (f32x2){vk[1].x, vk[1].y}); py2 += S[2] * (f32x2){vr[1].x, vr[1].y};
        S[3] = S[3] * (f32x2){vw[1].z, vw[1].w} + (sa2 * (f32x2){vb[1].z, vb[1].w} + vi2 * (f32x2){vk[1].z, vk[1].w}); py3 += S[3] * (f32x2){vr[1].z, vr[1].w};
#pragma unroll
        for (int q = 0; q < 2; ++q) { vw[q] = *(const f32x4*)(vW + von + 4 * q); vb[q] = *(const f32x4*)(vB + von + 4 * q); vk[q] = *(const f32x4*)(vK + von + 4 * q); vr[q] = *(const f32x4*)(vR + von + 4 * q); }
        vi = vV[ttn * 64 + irow];
        py2 += py3;
        const float py = osum(py2.x + py2.y);
        if (j8 == 0) ybuf[tt * 32 + lrow] = py;
        tt = ttn;
      }
    }
    __syncthreads();
    {
      const int tt = tid >> 3, sub = tid & 7;
      const f32x4 y0 = *(const f32x4*)(ybuf + tt * 32 + sub * 4);
      u32x2 w; w.x = pack2(y0.x, y0.y); w.y = pack2(y0.z, y0.w);
      *(u32x2*)(Y + (size_t)(row0 + t0 + tt) * 512 + hd * 64 + rs * 32 + sub * 4) = w;
    }
    __syncthreads();
  }
  if (!lat) {
    float* o = opq(p.out) + (dir ? OUT_SB : OUT_SF) + ((size_t)(seq * 4 + l) * 8 + hd) * 4096 + irow * 64 + j8 * 8;
#pragma unroll
    for (int q = 0; q < 2; ++q) *(f32x4*)(o + 4 * q) = (f32x4){S[2 * q].x, S[2 * q].y, S[2 * q + 1].x, S[2 * q + 1].y};
  }
}

DI void phase_mixers(const Params& p, int l, char* smem, int part = 0) {
  const int tid = otid(), wid = __builtin_amdgcn_readfirstlane(tid >> 6);
  unsigned* cnt = (unsigned*)(p.ws + OFF_CNT) + l * 8;
  int* slot = (int*)(smem + SMEM_BYTES - 16);
  bf16_t* U = (bf16_t*)(p.ws + OFF_U);
  const bf16_t* KA = (const bf16_t*)(p.ws + OFF_KA); const bf16_t* VAT = (const bf16_t*)(p.ws + OFF_VAT);
  const bf16_t* KN = (const bf16_t*)(p.ws + OFF_KN); const bf16_t* VBT = (const bf16_t*)(p.ws + OFF_VBT); const bf16_t* KRB = (const bf16_t*)(p.ws + OFF_KRB);
  const int QLEN = 256 + 256 + 128 + 64 + 64;
  bool first = true;
  int xq = blockIdx.x & 7, tries = 0;
  for (;;) {
    int kind, seq, a, qt;
    if (first && blockIdx.x < 256) {
      const int item = blockIdx.x; kind = 0; seq = 32 + (item >> 5); a = (item >> 2) & 7; qt = item & 3;
      first = false;
    } else {
      first = false;
      if (tid == 0) *slot = (int)atomicAdd(cnt + xq, 1u);
      __syncthreads();
      const int i = __builtin_amdgcn_readfirstlane(*slot);
      __syncthreads();
      if (i >= QLEN) { if (++tries >= 8) break; xq = (xq + 1) & 7; continue; }
      if (i < 256) { const int g = xq + 8 * (i >> 7); kind = 1; seq = 32 + (g >> 1); a = g & 1; qt = i & 127; }
      else if (i < 512) { const int j = i - 256; const int g = xq + 8 * (j >> 5); kind = 2; seq = 32 + (g >> 3); a = g & 7; qt = j & 31; }
      else if (i < 640) { const int j = i - 512; kind = 0; seq = xq + 8 * (j >> 5); a = (j >> 2) & 7; qt = j & 3; }
      else if (i < 704) { const int j = i - 640; kind = 1; seq = xq + 8 * (j >> 4); a = (j >> 3) & 1; qt = j & 7; }
      else { const int j = i - 704; kind = 2; seq = xq + 8 * (j >> 4); a = (j >> 1) & 7; qt = j & 1; }
    }
    const int kr0 = keyrow0(seq), Tk = seq_tk(seq);
    const int row0 = seq < 32 ? seq * 256 : NCTX + (seq - 32) * 4096;
    if (kind == 0) scan_item(p, l, seq, a, qt & 1, qt >> 1, smem);
    else if (kind == 1) {
      const int qh = a * 4 + wid;
      bf16_t* q = U + (size_t)(row0 + qt * 32) * ULD + qh * 64;
      attn_item<64>(q, ULD, KA + (size_t)kr0 * 128 + a * 64, 128, nullptr, 0, VAT + (size_t)128 * kr0 + (size_t)(a * 64) * Tk, Tk, Tk, q, ULD, smem);
    } else {
      bf16_t* q = U + (size_t)(row0 + qt * 128 + wid * 32) * ULD + 768 + a * 96;
      attn_item<96>(q, ULD, KN + (size_t)kr0 * 512 + a * 64, 512, KRB + (size_t)kr0 * 32, 32, VBT + (size_t)512 * kr0 + (size_t)(a * 64) * Tk, Tk, Tk, q, ULD, smem);
    }
  }
}

DI void cpost_row(const Params& p, int l, int row, int lane) {
  int seq, t; row_decode(row, seq, t);
  const int T = seq < 32 ? 256 : 4096;
  const bf16_t* YF = (const bf16_t*)(p.ws + OFF_R2); const bf16_t* YB = YF + (size_t)NT * 512;
  bf16_t* u = (bf16_t*)(p.ws + OFF_U) + (size_t)row * ULD + 1696;
  const float* bonus = (const float*)(p.ws + OFF_BONUS);
  float yf[8], yb[8], y[8];
  unpack8(*(const u32x4*)(YF + (size_t)row * 512 + lane * 8), yf);
  unpack8(*(const u32x4*)(YB + (size_t)row * 512 + lane * 8), yb);
  float s = 0.f;
#pragma unroll
  for (int i = 0; i < 8; ++i) { y[i] = yf[i] + yb[i]; s += y[i]; }
  s += shx<1>(s); s += shx<2>(s); s += shx<4>(s);
  const float mu = s * (1.0f / 64.0f);
  float q = 0.f;
#pragma unroll
  for (int i = 0; i < 8; ++i) { y[i] -= mu; q += y[i] * y[i]; }
  q += shx<1>(q); q += shx<2>(q); q += shx<4>(q);
  const float rs = rsqrtf(q * (1.0f / 64.0f) + 64e-5f);
  const int col = 1024 + lane * 8;
  float c[8], pv[8], nx[8];
  unpack8(*(const u32x4*)(u + col), c);
  if (t > 0) unpack8(*(const u32x4*)(u - ULD + col), pv); else { for (int i = 0; i < 8; ++i) pv[i] = 0.f; }
  if (t < T - 1) unpack8(*(const u32x4*)(u + ULD + col), nx); else { for (int i = 0; i < 8; ++i) nx[i] = 0.f; }
  const float* mup = p.in[I_MUP] + l * 1792 + col; const float* mun = p.in[I_MUN] + l * 1792 + col;
  const float* lw = p.in[I_LNW] + l * 512 + lane * 8; const float* lb = p.in[I_LNB] + l * 512 + lane * 8;
  const f32x2 bsv = *(const f32x2*)(bonus + ((size_t)row * 8 + (lane >> 3)) * 2);
  const float bs = bsv.x + bsv.y;
  float o[8];
#pragma unroll
  for (int i = 0; i < 8; ++i) { const float v = c[i] + mup[i] * (pv[i] - c[i]) + mun[i] * (nx[i] - c[i]); o[i] = y[i] * rs * lw[i] + lb[i] + bs * v; }
  *(u32x4*)(u + lane * 8) = pack8(o);
}
DI void phase_renorm_cpost(const Params& p, int l) {
  const int lane = otid() & 63, wid = __builtin_amdgcn_readfirstlane(otid() >> 6);
  for (int item = blockIdx.x; item < NT / 4; item += gridDim.x) { const int row = item * 4 + wid; norm_row(p, l, row, lane); cpost_row(p, l, row, lane); }
}

DI void phase_zgemm(const Params& p, char* smem) {
  const bf16_t* H = (const bf16_t*)(p.ws + OFF_R1);
  const bf16_t* W = (const bf16_t*)(p.ws + OFF_WIN) + (size_t)3584 * 1024;
  bf16_t* U = (bf16_t*)(p.ws + OFF_U);
  const int ntiles = 320 * 12;
  for (int tile = blockIdx.x; tile < ntiles; tile += gridDim.x) {
    const int mt = tile / 12, nt = tile % 12, m0 = mt * 128, n0 = nt * 128;
    f32x16 acc[2][2]; zero_acc<2>(acc);
    gemm_mainloop<2>(acc, H + (size_t)m0 * 1024, 1024, 64, W + (size_t)n0 * 1024, 1024, 1024, smem);
    const int lane = otid() & 63, wid = __builtin_amdgcn_readfirstlane(otid() >> 6), wm = wid >> 1, wn = wid & 1, r = lane & 31, hh = lane >> 5;
#pragma unroll
    for (int j = 0; j < 2; ++j) {
      const int col = n0 + wn * 64 + j * 32 + r;
      const int br = col >> 9, cc = col & 511;
      const int ucol = br == 0 ? cc : (br == 1 ? 768 + (cc >> 6) * 96 + (cc & 63) : 1696 + cc);
#pragma unroll
      for (int i = 0; i < 2; ++i) {
        bf16_t* up = U + (size_t)(m0 + wm * 64 + i * 32) * ULD;
        const int lo = 4 * hh * ULD + ucol;
        bf16_t yv[16];
#pragma unroll
        for (int e = 0; e < 16; ++e) yv[e] = (up + crowu(e) * ULD)[lo];
#pragma unroll
        for (int e = 0; e < 16; ++e) (up + crowu(e) * ULD)[lo] = f2bf(bf2f(yv[e]) * siluf_(acc[i][j][e]));
      }
    }
  }
}

DI void phase_merge(const Params& p, char* smem) {
  const bf16_t* H = (const bf16_t*)(p.ws + OFF_R1);
  const bf16_t* WG = (const bf16_t*)(p.ws + OFF_WIN) + (size_t)5120 * 1024;
  const bf16_t* WO = (const bf16_t*)(p.ws + OFF_WO);
  const bf16_t* U = (const bf16_t*)(p.ws + OFF_U);
  bf16_t* MX = (bf16_t*)(p.ws + OFF_R2);
  const int ntiles = 320 * 8;
  for (int tile = blockIdx.x; tile < ntiles; tile += gridDim.x) {
    const int mt = tile >> 3, nt = tile & 7, m0 = mt * 128, n0 = nt * 128;
    f32x16 mix[2][2]; zero_acc<2>(mix);
    unsigned gs[2][2][8];
#pragma unroll 1
    for (int step = 0; step < 6; ++step) {
      const int br = step >> 1, isT = step & 1;
      const int acol = br == 0 ? 0 : (br == 1 ? 768 : 1696);
      const bf16_t* Ap = isT ? U + (size_t)m0 * ULD + acol : H + (size_t)m0 * 1024;
      const bf16_t* Bp = isT ? WO + (size_t)(br * 1024 + n0) * 512 : WG + (size_t)(br * 1024 + n0) * 1024;
      f32x16 cur[2][2]; zero_acc<2>(cur);
      gemm_mainloop<2>(cur, Ap, isT ? ULD : 1024, (isT && br == 1) ? 96 : 64, Bp, isT ? 512 : 1024, isT ? 512 : 1024, smem);
      if (isT) {
#pragma unroll
        for (int i = 0; i < 2; ++i)
#pragma unroll
          for (int j = 0; j < 2; ++j)
#pragma unroll
            for (int e = 0; e < 8; ++e) { mix[i][j][2 * e] += lo16(gs[i][j][e]) * cur[i][j][2 * e]; mix[i][j][2 * e + 1] += hi16(gs[i][j][e]) * cur[i][j][2 * e + 1]; }
      } else {
#pragma unroll
        for (int i = 0; i < 2; ++i)
#pragma unroll
          for (int j = 0; j < 2; ++j)
#pragma unroll
            for (int e = 0; e < 8; ++e) gs[i][j][e] = pack2(sigmoidf_(cur[i][j][2 * e]), sigmoidf_(cur[i][j][2 * e + 1]));
      }
    }
    const int lane = otid() & 63, wid = __builtin_amdgcn_readfirstlane(otid() >> 6), wm = wid >> 1, wn = wid & 1, r = lane & 31, hh = lane >> 5;
#pragma unroll
    for (int j = 0; j < 2; ++j) {
      const int col = n0 + wn * 64 + j * 32 + r;
#pragma unroll
      for (int i = 0; i < 2; ++i) {
        bf16_t* mp = MX + (size_t)(m0 + wm * 64 + i * 32) * 1024;
        const int lo = 4 * hh * 1024 + col;
#pragma unroll
        for (int e = 0; e < 16; ++e) (mp + crowu(e) * 1024)[lo] = f2bf(mix[i][j][e]);
      }
    }
  }
}

DI void phase_out(const Params& p, int l, char* smem) {
  const bf16_t* MX = (const bf16_t*)(p.ws + OFF_R2);
  const bf16_t* W = (const bf16_t*)(p.ws + OFF_WOUT);
  const int ntiles = 320 * 8;
  for (int tile = blockIdx.x; tile < ntiles; tile += gridDim.x) {
    const int mt = tile >> 3, nt = tile & 7, m0 = mt * 128, n0 = nt * 128;
    f32x16 acc[2][2]; zero_acc<2>(acc);
    gemm_mainloop<2>(acc, MX + (size_t)m0 * 1024, 1024, 64, W + (size_t)n0 * 1024, 1024, 1024, smem);
    const int lane = otid() & 63, wid = __builtin_amdgcn_readfirstlane(otid() >> 6), wm = wid >> 1, wn = wid & 1, r = lane & 31, hh = lane >> 5;
    const int jm = m0 < NCTX ? 0 : 1 + ((m0 - NCTX) >> 12);
    const float* gate = (const float*)(p.ws + OFF_MOD) + ((size_t)l * 9 + jm) * MODLD + 2048;
    const float* xsrc = x_row_ptr(p, l, m0);
#pragma unroll
    for (int j = 0; j < 2; ++j) {
      const int col = n0 + wn * 64 + j * 32 + r;
      const float gv = gate[col];
      const int lo = 4 * hh * 1024 + col;
#pragma unroll
      for (int i = 0; i < 2; ++i) {
        const float* xs = xsrc + (size_t)(wm * 64 + i * 32) * 1024;
        float* xo = p.out + (size_t)(m0 + wm * 64 + i * 32) * 1024;
        float xv[16];
#pragma unroll
        for (int e = 0; e < 16; ++e) xv[e] = (xs + crowu(e) * 1024)[lo];
#pragma unroll
        for (int e = 0; e < 16; ++e) (xo + crowu(e) * 1024)[lo] = xv[e] + gv * acc[i][j][e];
      }
    }
  }
}

DI void phase_final(const Params& p) {
  const int lane = otid() & 63, wid = __builtin_amdgcn_readfirstlane(otid() >> 6);
  const float* nw = p.in[I_FNW];
  for (int item = blockIdx.x; item < NT / 4; item += gridDim.x) {
    float* x = p.out + (size_t)(item * 4 + wid) * 1024;
    f32x4 v[4]; float ss = 0.f;
#pragma unroll
    for (int i = 0; i < 4; ++i) { v[i] = *(const f32x4*)(x + lane * 4 + 256 * i); ss += v[i].x * v[i].x + v[i].y * v[i].y + v[i].z * v[i].z + v[i].w * v[i].w; }
ss = wave_sum(ss);
    const float rs = rsqrtf(ss * (1.0f / 1024.0f) + 1e-6f);
#pragma unroll
    for (int i = 0; i < 4; ++i) { const f32x4 w = *(const f32x4*)(nw + lane * 4 + 256 * i); *(f32x4*)(x + lane * 4 + 256 * i) = (f32x4){v[i].x * rs * w.x, v[i].y * rs * w.y, v[i].z * rs * w.z, v[i].w * rs * w.w}; }
  }
}

DI void grid_barrier(unsigned* bar, unsigned& epoch) {
  epoch += 1u;
  __syncthreads();
  if (otid() == 0) {
    const unsigned grp = blockIdx.x & 7u, per = gridDim.x >> 3;
    __builtin_amdgcn_fence(__ATOMIC_RELEASE, "agent");
    const unsigned old = __hip_atomic_fetch_add(bar + grp * 32, 1u, __ATOMIC_RELAXED, __HIP_MEMORY_SCOPE_AGENT);
    if (old + 1u == epoch * per) __hip_atomic_fetch_add(bar + 8 * 32, 1u, __ATOMIC_RELAXED, __HIP_MEMORY_SCOPE_AGENT);
    while (__hip_atomic_load(bar + 8 * 32, __ATOMIC_RELAXED, __HIP_MEMORY_SCOPE_AGENT) < epoch * 8u) __builtin_amdgcn_s_sleep(1);
    __builtin_amdgcn_fence(__ATOMIC_ACQUIRE, "agent");
  }
  __syncthreads();
}

constexpr int NPHASES = 1 + 4 * 9 + 1;
__global__ void __launch_bounds__(256, 2) fwd_kernel(Params p0) {
  __shared__ __attribute__((aligned(16))) char smem[SMEM_BYTES];
  cg::grid_group grid = cg::this_grid();
  const int ph_begin = p0.ph_begin, ph_end = p0.ph_end;
  unsigned* bar = (unsigned*)(p0.ws + OFF_BAR);
  unsigned epoch = 0u;
  for (int ph = ph_begin; ph < ph_end; ++ph) {
    auto kp = __builtin_amdgcn_kernarg_segment_ptr();
    asm volatile("" : "+s"(kp));
    typedef const __attribute__((address_space(4))) Params CParams;
    CParams* kpp = (CParams*)kp;
    Params p;
#pragma unroll
    for (int i = 0; i < 35; ++i) p.in[i] = kpp->in[i];
    p.out = kpp->out; p.ws = kpp->ws; p.ph_begin = ph_begin; p.ph_end = ph_end;
    if (ph == 0) phase_prologue(p, smem);
    else if (ph == NPHASES - 1) phase_final(p);
    else {
      const int l = (ph - 1) / 9, sp = (ph - 1) % 9;
#ifdef PROBE_SP
      if (sp == PROBE_SP) {
        switch (sp) {
          case 0: phase_norm_convert(p, l, smem); break;
          case 1: phase_gemm1(p, l, smem); break;
          case 3: phase_upproj(p, smem); break;
          case 5: phase_renorm_cpost(p, l); break;
          case 7: phase_merge(p, smem); break;
          default: break;
        }
        grid.sync();
      }
#endif
      switch (sp) {
        case 0: phase_norm_convert(p, l, smem); break;
        case 1: phase_gemm1(p, l, smem); break;
        case 2: phase_post(p, l); break;
        case 3: phase_upproj(p, smem); break;
        case 4: phase_mixers(p, l, smem); break;
        case 5: phase_renorm_cpost(p, l); break;
        case 6: phase_zgemm(p, smem); break;
        case 7: phase_merge(p, smem); break;
        default: phase_out(p, l, smem); break;
      }
    }
    if (ph + 1 < ph_end) { if (ph == 0) grid.sync(); else grid_barrier(bar, epoch); }
  }
}

extern "C" void kernel_launch(void* const* d_in, const int* in_sizes, int n_in, void* d_out, int out_size, void* d_ws, size_t ws_size, hipStream_t stream) {
  if (ws_size < WS_NEED || n_in < 35) { fprintf(stderr, "workspace too small: %zu < %zu\n", ws_size, WS_NEED); return; }
  static int grid_blocks = 0;
  if (!grid_blocks) {
    int dev = 0, cus = 0, per_cu = 0;
    hipGetDevice(&dev);
    hipDeviceGetAttribute(&cus, hipDeviceAttributeMultiprocessorCount, dev);
    hipOccupancyMaxActiveBlocksPerMultiprocessor(&per_cu, fwd_kernel, 256, 0);
    if (per_cu < 1) per_cu = 1;
    if (per_cu > 2) per_cu = 2;
    grid_blocks = cus * per_cu;
  }
  Params p{};
  for (int i = 0; i < 35; ++i) p.in[i] = (const float*)d_in[i];
  p.out = (float*)d_out; p.ws = (char*)d_ws;
#ifndef ONE_LAUNCH
  for (int ph = 0; ph < NPHASES; ++ph) {
    p.ph_begin = ph; p.ph_end = ph + 1;
    hipLaunchKernelGGL(fwd_kernel, dim3(grid_blocks), dim3(256), 0, stream, p);
  }
#else
  p.ph_begin = 0; p.ph_end = NPHASES;
  hipMemsetAsync((char*)d_ws + OFF_BAR, 0, 4096, stream);
  void* args[] = {&p};
  hipError_t e = hipLaunchCooperativeKernel((void*)fwd_kernel, dim3(grid_blocks), dim3(256), args, 0, stream);
  if (e != hipSuccess) fprintf(stderr, "cooperative launch failed: %s (grid %d)\n", hipGetErrorString(e), grid_blocks);
#endif
}
```

```cpp
#define ONE_LAUNCH 1
#include <hip/hip_runtime.h>
#include <hip/hip_cooperative_groups.h>
#include <stdint.h>
#include <stdio.h>
namespace cg = cooperative_groups;

typedef unsigned short bf16_t;
typedef short bf16x8 __attribute__((ext_vector_type(8)));
typedef float f32x16 __attribute__((ext_vector_type(16)));
typedef float f32x4 __attribute__((ext_vector_type(4)));
typedef float f32x2 __attribute__((ext_vector_type(2)));
typedef unsigned u32x4 __attribute__((ext_vector_type(4)));
typedef unsigned u32x2 __attribute__((ext_vector_type(2)));
#define DI __device__ __forceinline__
#define MFMA32(a, b, c) __builtin_amdgcn_mfma_f32_32x32x16_bf16((a), (b), (c), 0, 0, 0)

constexpr int NT = 40960;
constexpr int NCTX = 8192;
constexpr int NK = 45056;
constexpr int ULD = 3488;
constexpr int MODLD = 3072;
constexpr int SMEM_BYTES = 78848;

constexpr size_t OFF_WIN = 0;
constexpr size_t OFF_WO = 16777216;
constexpr size_t OFF_WOUT = 19922944;
constexpr size_t OFF_WU = 22020096;
constexpr size_t OFF_MOD = 22282240;
constexpr size_t OFF_BONUS = 22724608;
constexpr size_t OFF_CS16 = 25346048;
constexpr size_t OFF_CS8 = 25354240;
constexpr size_t OFF_CNT = 25358336;
constexpr size_t OFF_BAR = 524742912;
constexpr size_t OFF_U = 25358592;
constexpr size_t OFF_R1 = 311095552;
constexpr size_t OFF_KA = OFF_R1;
constexpr size_t OFF_VAT = 513208576;
constexpr size_t OFF_KN = OFF_R1 + 23068672;
constexpr size_t OFF_VBT = OFF_R1 + 69206016;
constexpr size_t OFF_KRB = OFF_R1 + 115343360;
constexpr size_t OFF_R2 = 429322496;
constexpr size_t WS_NEED = 524742912 + 4096;

constexpr size_t OUT_AK = 41943040, OUT_AV = 46137344, OUT_CKV = 50331648, OUT_KR = 54525952, OUT_SF = 55574528, OUT_SB = 59768832;

struct Params {
  const float* in[35];
  float* out;
  char* ws;
  int ph_begin, ph_end;
};

enum { I_XP = 0, I_XS, I_CAK, I_CAV, I_CCKV, I_CKR, I_SF, I_SB, I_C, I_CCTX, I_NORMW, I_WMOD, I_BMOD, I_WIN, I_QNW, I_KNW, I_KVNW,
       I_WUK, I_WUV, I_MUP, I_MUN, I_W0, I_WUP, I_A0, I_AUP, I_KK, I_KA, I_RK, I_LNW, I_LNB, I_WOA, I_WOB, I_WOC, I_WOUT, I_FNW };

DI int threadIdx_x_raw() { return __builtin_amdgcn_workitem_id_x(); }
DI int otid() { int t = threadIdx_x_raw(); asm volatile("" : "+v"(t)); return t; }
DI const float* opq(const float* q) { asm volatile("" : "+s"(q)); return q; }
DI float* opq(float* q) { asm volatile("" : "+s"(q)); return q; }
DI float bf2f(bf16_t v) { return __uint_as_float(((unsigned)v) << 16); }
typedef __bf16 hbf16x2 __attribute__((ext_vector_type(2)));
DI unsigned pack2(float a, float b) { f32x2 v = {a, b}; hbf16x2 r = __builtin_convertvector(v, hbf16x2); return __builtin_bit_cast(unsigned, r); }
DI bf16_t f2bf(float x) { return (bf16_t)(pack2(x, 0.f) & 0xffffu); }
DI float xsum16(float x) { const unsigned u = __float_as_uint(x); auto r = __builtin_amdgcn_permlane16_swap(u, u, false, false); return __uint_as_float(r[0]) + __uint_as_float(r[1]); }
DI float xsum32(float x) { const unsigned u = __float_as_uint(x); auto r = __builtin_amdgcn_permlane32_swap(u, u, false, false); return __uint_as_float(r[0]) + __uint_as_float(r[1]); }
DI float lo16(unsigned w) { return __uint_as_float(w << 16); }
DI float hi16(unsigned w) { return __uint_as_float(w & 0xffff0000u); }
DI void unpack8(u32x4 w, float* v) { v[0] = lo16(w.x); v[1] = hi16(w.x); v[2] = lo16(w.y); v[3] = hi16(w.y); v[4] = lo16(w.z); v[5] = hi16(w.z); v[6] = lo16(w.w); v[7] = hi16(w.w); }
DI u32x4 pack8(const float* v) { u32x4 w; w.x = pack2(v[0], v[1]); w.y = pack2(v[2], v[3]); w.z = pack2(v[4], v[5]); w.w = pack2(v[6], v[7]); return w; }
template <int K> DI float shx(float v) { return __int_as_float(__builtin_amdgcn_ds_swizzle(__float_as_int(v), 0x1f | (K << 10))); }
DI float wave_sum(float v) { v += shx<1>(v); v += shx<2>(v); v += shx<4>(v); v += shx<8>(v); v += shx<16>(v); return xsum32(v); }
DI float qsum(float v) {
  v += __int_as_float(__builtin_amdgcn_update_dpp(0, __float_as_int(v), 0xB1, 0xf, 0xf, true));
  v += __int_as_float(__builtin_amdgcn_update_dpp(0, __float_as_int(v), 0x4E, 0xf, 0xf, true));
  return v;
}
DI float osum(float v) {
  v = qsum(v);
  v += __int_as_float(__builtin_amdgcn_update_dpp(0, __float_as_int(v), 0x141, 0xf, 0xf, true));
  return v;
}
DI int crow(int reg, int h) { return (reg & 3) + 8 * (reg >> 2) + 4 * h; }
DI int crowu(int reg) { return (reg & 3) + 8 * (reg >> 2); }
DI int perm16(int t) { return (t & ~12) | ((t & 4) << 1) | ((t & 8) >> 1); }
DI float sigmoidf_(float x) { return __builtin_amdgcn_rcpf(1.0f + __expf(-x)); }
DI float siluf_(float x) { return x * __builtin_amdgcn_rcpf(1.0f + __expf(-x)); }

DI void row_decode(int row, int& seq, int& t) {
  if (row < NCTX) { seq = row >> 8; t = row & 255; } else { seq = 32 + ((row - NCTX) >> 12); t = (row - NCTX) & 4095; }
}
DI int keyrow0(int seq) { return seq < 32 ? seq * 256 : NCTX + (seq - 32) * 4608; }
DI int seq_tk(int seq) { return seq < 32 ? 256 : 4608; }

typedef __attribute__((address_space(3))) unsigned lds_u32;
template <int NJ>
DI void gemm_mainloop(f32x16 (&acc)[2][NJ], const bf16_t* __restrict__ A, int lda, int ks,
                      const bf16_t* __restrict__ Bt, int ldb, int K, char* smem) {
  constexpr int A_BYTES = 128 * 128;
  constexpr int B_BYTES = 64 * NJ * 128;
  constexpr int STAGE = A_BYTES + B_BYTES;
  const int tid = otid(), lane = tid & 63, wid = __builtin_amdgcn_readfirstlane(tid >> 6), wm = wid >> 1, wn = wid & 1;
  const int r = lane & 31, hh = lane >> 5;
  const int nk = K >> 6;
  const int lrow = tid >> 3, lc = tid & 7;
  const int gc = (lc ^ ((lrow >> 1) & 7)) * 8;
  const bf16_t* ap = A + (size_t)lrow * lda + gc;
  const bf16_t* bp = Bt + (size_t)lrow * ldb + gc;
  auto issue = [&](int kt, int buf) {
    char* base = smem + buf * STAGE + tid * 16;
    const bf16_t* ap2 = ap + (size_t)kt * ks;
    const bf16_t* bp2 = bp + (size_t)kt * 64;
#pragma unroll
    for (int p = 0; p < 4; ++p) __builtin_amdgcn_global_load_lds((const unsigned*)(ap2 + (size_t)(32 * p) * lda), (lds_u32*)(base + p * 4096), 16, 0, 0);
#pragma unroll
    for (int p = 0; p < 2 * NJ; ++p) __builtin_amdgcn_global_load_lds((const unsigned*)(bp2 + (size_t)(32 * p) * ldb), (lds_u32*)(base + A_BYTES + p * 4096), 16, 0, 0);
  };
  issue(0, 0);
  __syncthreads();
#pragma unroll 1
  for (int kt = 0; kt < nk; ++kt) {
    if (kt + 1 < nk) issue(kt + 1, (kt + 1) & 1);
    const char* base = smem + (kt & 1) * STAGE;
#pragma unroll
    for (int s = 0; s < 4; ++s) {
      bf16x8 af[2], bfr[NJ];
#pragma unroll
      for (int i = 0; i < 2; ++i) { const int row = wm * 64 + i * 32 + r; af[i] = *(const bf16x8*)(base + row * 128 + (((2 * s + hh) ^ ((row >> 1) & 7)) << 4)); }
#pragma unroll
      for (int j = 0; j < NJ; ++j) { const int row = wn * (32 * NJ) + j * 32 + r; bfr[j] = *(const bf16x8*)(base + A_BYTES + row * 128 + (((2 * s + hh) ^ ((row >> 1) & 7)) << 4)); }
#pragma unroll
      for (int i = 0; i < 2; ++i)
#pragma unroll
        for (int j = 0; j < NJ; ++j) acc[i][j] = MFMA32(af[i], bfr[j], acc[i][j]);
    }
    __syncthreads();
  }
}

template <int NJ> DI void zero_acc(f32x16 (&acc)[2][NJ]) {
#pragma unroll
  for (int i = 0; i < 2; ++i)
#pragma unroll
    for (int j = 0; j < NJ; ++j)
#pragma unroll
      for (int e = 0; e < 16; ++e) acc[i][j][e] = 0.f;
}

DI void phase_prologue(const Params& p, char* smem) {
  const int tid = otid(), lane = tid & 63, wid = __builtin_amdgcn_readfirstlane(tid >> 6);
  float* mod = (float*)(p.ws + OFF_MOD);
  if (blockIdx.x == 0) {
    if (tid < 32) ((unsigned*)(p.ws + OFF_CNT))[tid] = 0u;
    float* cs16 = (float*)(p.ws + OFF_CS16);
    float* cs8 = (float*)(p.ws + OFF_CS8);
    for (int e = tid; e < 64 * 16; e += 256) { const int pos = e >> 4, i = e & 15; const float inv = expf(-9.210340371976184f * (float)i / 16.0f); const float a = (float)pos * inv; cs16[e * 2] = cosf(a); cs16[e * 2 + 1] = sinf(a); }
    for (int e = tid; e < 64 * 8; e += 256) { const int pos = e >> 3, i = e & 7; const float inv = expf(-9.210340371976184f * (float)i / 8.0f); const float a = (float)pos * inv; cs8[e * 2] = cosf(a); cs8[e * 2 + 1] = sinf(a); }
  }
  float* sl = (float*)smem;
  float* red = sl + 9 * 1024;
  for (int e = tid; e < 9 * 1024; e += 256) { const int j = e >> 10, k = e & 1023; const float* cc0 = opq(p.in[I_CCTX]); const float* cc1 = opq(p.in[I_C]); const float c = j == 0 ? cc0[k] : cc1[(j - 1) * 1024 + k]; sl[e] = siluf_(c); }
  __syncthreads();
  for (int item = blockIdx.x; item < 192; item += gridDim.x) {
    const int l = item / 48, n = (item % 48) * 64 + lane;
    const float* w = p.in[I_WMOD] + (size_t)l * 1024 * 3072 + n;
    float a[9];
#pragma unroll
    for (int j = 0; j < 9; ++j) a[j] = 0.f;
    for (int k = wid * 256; k < wid * 256 + 256; ++k) {
      const float wv = w[(size_t)k * 3072];
#pragma unroll
      for (int j = 0; j < 9; ++j) a[j] += sl[j * 1024 + k] * wv;
    }
#pragma unroll
    for (int j = 0; j < 9; ++j) red[(wid * 9 + j) * 64 + lane] = a[j];
    __syncthreads();
    for (int e = tid; e < 9 * 64; e += 256) {
      const int j = e >> 6, c = e & 63;
      const float s = red[(0 * 9 + j) * 64 + c] + red[(1 * 9 + j) * 64 + c] + red[(2 * 9 + j) * 64 + c] + red[(3 * 9 + j) * 64 + c];
      const int nn = (item % 48) * 64 + c;
      mod[((size_t)l * 9 + j) * MODLD + nn] = s + p.in[I_BMOD][l * 3072 + nn];
    }
    __syncthreads();
  }
}

DI const float* x_row_ptr(const Params& p, int l, int row) {
  const float* xp = opq(p.in[I_XP]); const float* xs = opq(p.in[I_XS]); const float* xo = opq((const float*)p.out);
  if (l == 0) return row < NCTX ? xp + (size_t)row * 1024 : xs + (size_t)(row - NCTX) * 1024;
  return xo + (size_t)row * 1024;
}
DI void norm_row(const Params& p, int l, int row, int lane) {
  const float* x = x_row_ptr(p, l, row);
  const int j = row < NCTX ? 0 : 1 + ((row - NCTX) >> 12);
  const float* mod = (const float*)(p.ws + OFF_MOD) + ((size_t)l * 9 + j) * MODLD;
  const float* nw = p.in[I_NORMW] + l * 1024;
  bf16_t* h = (bf16_t*)(p.ws + OFF_R1) + (size_t)row * 1024;
  f32x4 v[4]; float ss = 0.f;
#pragma unroll
  for (int i = 0; i < 4; ++i) { v[i] = *(const f32x4*)(x + lane * 4 + 256 * i); ss += v[i].x * v[i].x + v[i].y * v[i].y + v[i].z * v[i].z + v[i].w * v[i].w; }
ss = wave_sum(ss);
  const float rs = rsqrtf(ss * (1.0f / 1024.0f) + 1e-6f);
#pragma unroll
  for (int i = 0; i < 4; ++i) {
    const int c = lane * 4 + 256 * i;
    const f32x4 w = *(const f32x4*)(nw + c), sh = *(const f32x4*)(mod + c), sc = *(const f32x4*)(mod + 1024 + c);
    u32x2 o;
    o.x = pack2(v[i].x * rs * w.x * (1.f + sc.x) + sh.x, v[i].y * rs * w.y * (1.f + sc.y) + sh.y);
    o.y = pack2(v[i].z * rs * w.z * (1.f + sc.z) + sh.z, v[i].w * rs * w.w * (1.f + sc.w) + sh.w);
    *(u32x2*)(h + c) = o;
  }
}

DI int win_srccol(int j) {
  if (j < 768) return j;
  if (j < 1696) return j + 512;
  if (j < 3488) return j + 1024;
  if (j < 3584) return -1;
  if (j < 5120) { const int jj = j - 3584; return jj < 512 ? 768 + jj : (jj < 1024 ? 2208 + (jj - 512) : 4512 + (jj - 1024)); }
  return 5024 + (j - 5120);
}
DI void conv_tile(const float* __restrict__ src, int ld_src, bf16_t* dst, int ld_dst, int k0, int n0, int kind, int srcoff, char* smem) {
  float* tile = (float*)smem;
  const int tid = otid();
  const int n = tid & 63;
  int sc = kind == 0 ? win_srccol(n0 + n) : (n0 + n - srcoff);
#pragma unroll
  for (int i = 0; i < 16; ++i) { const int k = i * 4 + (tid >> 6); tile[k * 65 + n] = sc >= 0 ? src[(size_t)(k0 + k) * ld_src + sc] : 0.f; }
  __syncthreads();
#pragma unroll
  for (int i = 0; i < 8; ++i) { const int nn = i * 8 + (tid >> 5), kk = (tid & 31) * 2; *(unsigned*)(dst + (size_t)(n0 + nn) * ld_dst + k0 + kk) = pack2(tile[kk * 65 + nn], tile[(kk + 1) * 65 + nn]); }
  __syncthreads();
}

DI void phase_norm_convert(const Params& p, int l, char* smem) {
  const int tid = otid(), lane = tid & 63, wid = __builtin_amdgcn_readfirstlane(tid >> 6);
  bf16_t* WinT = (bf16_t*)(p.ws + OFF_WIN); bf16_t* WoT = (bf16_t*)(p.ws + OFF_WO); bf16_t* WoutT = (bf16_t*)(p.ws + OFF_WOUT); bf16_t* WuT = (bf16_t*)(p.ws + OFF_WU);
  const int NI_WIN = 128 * 16, NI_WO = 3 * 16 * 8, NI_WOUT = 16 * 16, NI_WU = 16 * 2;
  const int NI_CONV = NI_WIN + NI_WO + NI_WOUT + NI_WU;
  for (int item = blockIdx.x; item < NI_CONV; item += gridDim.x) {
    int it = item;
    if (it < NI_WIN) { conv_tile(p.in[I_WIN] + (size_t)l * 1024 * 8096, 8096, WinT, 1024, (it & 15) * 64, (it >> 4) * 64, 0, 0, smem); continue; }
    it -= NI_WIN;
    if (it < NI_WO) { const int br = it / 128, r2 = it % 128; const float* src = (br == 0 ? opq(p.in[I_WOA]) : (br == 1 ? opq(p.in[I_WOB]) : opq(p.in[I_WOC]))) + (size_t)l * 512 * 1024; conv_tile(src, 1024, WoT + (size_t)br * 1024 * 512, 512, (r2 & 7) * 64, (r2 >> 3) * 64, 1, 0, smem); continue; }
    it -= NI_WO;
    if (it < NI_WOUT) { conv_tile(p.in[I_WOUT] + (size_t)l * 1024 * 1024, 1024, WoutT, 1024, (it & 15) * 64, (it >> 4) * 64, 1, 0, smem); continue; }
    it -= NI_WOUT;
    { const int nt = it >> 1, kt = it & 1; const bool uv = nt >= 8; const float* src = (uv ? opq(p.in[I_WUV]) : opq(p.in[I_WUK])) + (size_t)l * 128 * 512; conv_tile(src, 512, WuT, 128, kt * 64, nt * 64, 1, uv ? 512 : 0, smem); }
  }
  for (int item = blockIdx.x; item < NT / 4; item += gridDim.x) norm_row(p, l, item * 4 + wid, lane);
}

DI void phase_gemm1(const Params& p, int l, char* smem) {
  const bf16_t* H = (const bf16_t*)(p.ws + OFF_R1);
  const bf16_t* W = (const bf16_t*)(p.ws + OFF_WIN);
  bf16_t* U = (bf16_t*)(p.ws + OFF_U);
  bf16_t* VAT = (bf16_t*)(p.ws + OFF_VAT);
  const int NTN = 28, ntiles = 320 * NTN;
  for (int tile = blockIdx.x; tile < ntiles; tile += gridDim.x) {
    const int mt = tile / NTN, nt = tile % NTN, m0 = mt * 128, n0 = nt * 128;
    f32x16 acc[2][2]; zero_acc<2>(acc);
    gemm_mainloop<2>(acc, H + (size_t)m0 * 1024, 1024, 64, W + (size_t)n0 * 1024, 1024, 1024, smem);
    const int lane = otid() & 63, wid = __builtin_amdgcn_readfirstlane(otid() >> 6), wm = wid >> 1, wn = wid & 1, r = lane & 31, hh = lane >> 5;
    int seq, t0; row_decode(m0, seq, t0);
#pragma unroll
    for (int j = 0; j < 2; ++j) {
      const int cb = n0 + wn * 64 + j * 32;
      if (cb >= ULD) continue;
      const int col = cb + r;
      if (cb >= 640 && cb < 768) {
        const int kvh = (col - 640) >> 6, dv = col & 63, Tk = seq_tk(seq);
        bf16_t* vt = VAT + (size_t)128 * keyrow0(seq) + (size_t)(kvh * 64 + dv) * Tk;
#pragma unroll
        for (int i = 0; i < 2; ++i) {
          const int tt = t0 + wm * 64 + i * 32;
#pragma unroll
          for (int g2 = 0; g2 < 2; ++g2) {
            float v[8];
#pragma unroll
            for (int e = 0; e < 8; ++e) v[e] = acc[i][j][g2 * 8 + e];
            *(u32x4*)(vt + tt + 16 * g2 + 8 * hh) = pack8(v);
          }
          if (seq < 32) {
            float* o = p.out + OUT_AV + ((size_t)(seq * 4 + l) * 256 + tt) * 128;
            const int lo = 4 * hh * 128 + (col - 640);
#pragma unroll
            for (int e = 0; e < 16; ++e) (o + crowu(e) * 128)[lo] = acc[i][j][e];
          }
        }
      } else {
#pragma unroll
        for (int i = 0; i < 2; ++i) {
          bf16_t* up = U + (size_t)(m0 + wm * 64 + i * 32) * ULD;
          const int lo = 4 * hh * ULD + col;
#pragma unroll
          for (int e = 0; e < 16; ++e) (up + crowu(e) * ULD)[lo] = f2bf(acc[i][j][e]);
        }
      }
    }
  }
}

DI void post_row(const Params& p, int l, int row, int lane) {
  int seq, t; row_decode(row, seq, t);
  const bool lat = row >= NCTX;
  const int krow = keyrow0(seq) + t;
  const int prow = t >> 6, pcol = t & 63;
  bf16_t* u = (bf16_t*)(p.ws + OFF_U) + (size_t)row * ULD;
  const float* cs16 = (const float*)(p.ws + OFF_CS16);
  const float* cs8 = (const float*)(p.ws + OFF_CS8);
  const float LOG2E = 1.4426950408889634f;
#pragma unroll
  for (int which = 0; which < 2; ++which) {
    const int l8 = which == 0 ? lane : (lane & 15);
    const bf16_t* src = u + (which == 0 ? 0 : 512) + l8 * 8;
    float v[8]; unpack8(*(const u32x4*)src, v);
    float ss = 0.f;
#pragma unroll
    for (int i = 0; i < 8; ++i) ss += v[i] * v[i];
    ss += shx<1>(ss); ss += shx<2>(ss); ss += shx<4>(ss);
    const float rs = rsqrtf(ss * (1.0f / 64.0f) + 1e-6f);
    const float* nw = (which == 0 ? opq(p.in[I_QNW]) : opq(p.in[I_KNW])) + l * 64 + (lane & 7) * 8;
#pragma unroll
    for (int i = 0; i < 8; ++i) v[i] = v[i] * rs * nw[i];
    float pv[8];
#pragma unroll
    for (int i = 0; i < 8; ++i) pv[i] = shx<2>(v[i]);
    if (lat) {
      const int pos = ((lane & 7) >> 2) ? pcol : prow;
      const bool lower = (lane & 2) == 0;
      const float* cs = cs16 + (pos * 16 + (lane & 1) * 8) * 2;
#pragma unroll
      for (int i = 0; i < 8; ++i) { const float c = cs[i * 2], s = cs[i * 2 + 1]; v[i] = lower ? v[i] * c - pv[i] * s : v[i] * c + pv[i] * s; }
    }
    if (which == 0) {
      const float sc = 0.125f * LOG2E;
#pragma unroll
      for (int i = 0; i < 8; ++i) v[i] *= sc;
      *(u32x4*)(u + lane * 8) = pack8(v);
    } else if (lane < 16) {
      bf16_t* KA = (bf16_t*)(p.ws + OFF_KA);
      *(u32x4*)(KA + (size_t)krow * 128 + lane * 8) = pack8(v);
      if (!lat) {
        float* o = p.out + OUT_AK + ((size_t)(seq * 4 + l) * 256 + t) * 128 + lane * 8;
        *(f32x4*)o = (f32x4){v[0], v[1], v[2], v[3]}; *(f32x4*)(o + 4) = (f32x4){v[4], v[5], v[6], v[7]};
      }
    }
  }
  {
    const float sc = 0.10206207261596577f * LOG2E;
    const int hd = lane >> 3;
    bf16_t* q = u + 768 + hd * 96;
    { float v[8]; unpack8(*(const u32x4*)(q + (lane & 7) * 8), v);
#pragma unroll
      for (int i = 0; i < 8; ++i) v[i] *= sc;
      *(u32x4*)(q + (lane & 7) * 8) = pack8(v); }
    { bf16_t* qr = q + 64 + (lane & 7) * 4;
      const u32x2 w = *(const u32x2*)qr;
      float v[4] = {lo16(w.x), hi16(w.x), lo16(w.y), hi16(w.y)}, pv[4];
#pragma unroll
      for (int i = 0; i < 4; ++i) pv[i] = shx<2>(v[i]);
      if (lat) {
        const int pos = ((lane & 7) >> 2) ? pcol : prow;
        const bool lower = (lane & 2) == 0;
        const float* cs = cs8 + (pos * 8 + (lane & 1) * 4) * 2;
#pragma unroll
        for (int i = 0; i < 4; ++i) { const float c = cs[i * 2], s = cs[i * 2 + 1]; v[i] = lower ? v[i] * c - pv[i] * s : v[i] * c + pv[i] * s; }
      }
      u32x2 o; o.x = pack2(v[0] * sc, v[1] * sc); o.y = pack2(v[2] * sc, v[3] * sc);
      *(u32x2*)qr = o; }
  }
  {
    const unsigned w = *(const unsigned*)(u + 1536 + lane * 2);
    float a = lo16(w), b = hi16(w);
    float ss = a * a + b * b;
ss = wave_sum(ss);
    const float rs = rsqrtf(ss * (1.0f / 128.0f) + 1e-6f);
    const float* nw = p.in[I_KVNW] + l * 128 + lane * 2;
    a = a * rs * nw[0]; b = b * rs * nw[1];
    bf16_t* CKVN = (bf16_t*)(p.ws + OFF_R2);
    *(unsigned*)(CKVN + (size_t)krow * 128 + lane * 2) = pack2(a, b);
    if (!lat) { float* o = p.out + OUT_CKV + ((size_t)(seq * 4 + l) * 256 + t) * 128 + lane * 2; *(f32x2*)o = (f32x2){a, b}; }
  }
  {
    float v = bf2f(u[1664 + (lane & 31)]);
    const float pv = shx<8>(v);
    if (!lat) { if (lane < 32) p.out[OUT_KR + ((size_t)(seq * 4 + l) * 256 + t) * 32 + lane] = v; }
    else {
      const int d = lane & 31; const int pos = (d >> 4) ? pcol : prow; const bool lower = (d & 8) == 0;
      const float* cs = cs8 + (pos * 8 + (d & 7)) * 2;
      v = lower ? v * cs[0] - pv * cs[1] : v * cs[0] + pv * cs[1];
    }
    if (lane < 32) ((bf16_t*)(p.ws + OFF_KRB))[(size_t)krow * 32 + lane] = f2bf(v);
  }
}
DI void post_cached_row(const Params& p, int l, int idx, int lane) {
  const int b = idx >> 9, j = idx & 511;
  const int kr0 = NCTX + b * 4608, krow = kr0 + 4096 + j;
  const size_t cb = ((size_t)(b * 4 + l) * 512 + j);
  bf16_t* KA = (bf16_t*)(p.ws + OFF_KA); bf16_t* VAT = (bf16_t*)(p.ws + OFF_VAT); bf16_t* CKVN = (bf16_t*)(p.ws + OFF_R2); bf16_t* KRB = (bf16_t*)(p.ws + OFF_KRB);
  { const f32x2 v = *(const f32x2*)(p.in[I_CAK] + cb * 128 + lane * 2); *(unsigned*)(KA + (size_t)krow * 128 + lane * 2) = pack2(v.x, v.y); }
  { const f32x2 v = *(const f32x2*)(p.in[I_CAV] + cb * 128 + lane * 2);
    bf16_t* vt = VAT + (size_t)128 * kr0 + (size_t)(lane * 2) * 4608 + perm16(4096 + j);
    vt[0] = f2bf(v.x); vt[4608] = f2bf(v.y); }
  { const f32x2 v = *(const f32x2*)(p.in[I_CCKV] + cb * 128 + lane * 2); *(unsigned*)(CKVN + (size_t)krow * 128 + lane * 2) = pack2(v.x, v.y); }
  if (lane < 32) KRB[(size_t)krow * 32 + lane] = f2bf(p.in[I_CKR][cb * 32 + lane]);
}
DI void phase_post(const Params& p, int l) {
  const int lane = otid() & 63, wid = __builtin_amdgcn_readfirstlane(otid() >> 6);
  for (int item = blockIdx.x; item < NT / 4 + 1024; item += gridDim.x) {
    if (item < NT / 4) post_row(p, l, item * 4 + wid, lane);
    else post_cached_row(p, l, (item - NT / 4) * 4 + wid, lane);
  }
}

DI void phase_upproj(const Params& p, char* smem) {
  const bf16_t* A = (const bf16_t*)(p.ws + OFF_R2);
  const bf16_t* W = (const bf16_t*)(p.ws + OFF_WU);
  bf16_t* KN = (bf16_t*)(p.ws + OFF_KN); bf16_t* VBT = (bf16_t*)(p.ws + OFF_VBT);
  const int ntiles = 352 * 8;
  for (int tile = blockIdx.x; tile < ntiles; tile += gridDim.x) {
    const int mt = tile >> 3, nt = tile & 7, m0 = mt * 128, n0 = nt * 128;
    f32x16 acc[2][2]; zero_acc<2>(acc);
    gemm_mainloop<2>(acc, A + (size_t)m0 * 128, 128, 64, W + (size_t)n0 * 128, 128, 128, smem);
    const int lane = otid() & 63, wid = __builtin_amdgcn_readfirstlane(otid() >> 6), wm = wid >> 1, wn = wid & 1, r = lane & 31, hh = lane >> 5;
    int seq, t0;
    if (m0 < NCTX) { seq = m0 >> 8; t0 = m0 & 255; } else { const int rr = m0 - NCTX; seq = 32 + rr / 4608; t0 = rr % 4608; }
#pragma unroll
    for (int j = 0; j < 2; ++j) {
      const int col = n0 + wn * 64 + j * 32 + r;
      if (n0 < 512) {
#pragma unroll
        for (int i = 0; i < 2; ++i) {
          bf16_t* kp = KN + (size_t)(m0 + wm * 64 + i * 32) * 512;
          const int lo = 4 * hh * 512 + col;
#pragma unroll
          for (int e = 0; e < 16; ++e) (kp + crowu(e) * 512)[lo] = f2bf(acc[i][j][e]);
        }
      } else {
        const int Tk = seq_tk(seq);
        bf16_t* vt = VBT + (size_t)512 * keyrow0(seq) + (size_t)(col - 512) * Tk;
#pragma unroll
        for (int i = 0; i < 2; ++i) {
          const int tt = t0 + wm * 64 + i * 32;
#pragma unroll
          for (int g2 = 0; g2 < 2; ++g2) {
            float v[8];
#pragma unroll
            for (int e = 0; e < 8; ++e) v[e] = acc[i][j][g2 * 8 + e];
            *(u32x4*)(vt + tt + 16 * g2 + 8 * hh) = pack8(v);
          }
        }
      }
    }
  }
}

template <int DQK>
DI void attn_item(const bf16_t* Qw, int q_ld, const bf16_t* K1, int k1_ld, const bf16_t* K2, int k2_ld,
                  const bf16_t* Vt, int vt_ld, int nkeys, bf16_t* Ow, int o_ld, char* smem) {
  constexpr int KS = DQK * 2 + 16;
  constexpr int KBYTES = 64 * KS;
  constexpr int VS = 144;
  constexpr int VBYTES = 64 * VS;
  constexpr int STAGE = KBYTES + VBYTES;
  constexpr int CPR = DQK / 8;
  constexpr int NKC = 64 * CPR / 256;
  constexpr int NS = DQK / 16;
  const int tid = otid(), lane = tid & 63, r = lane & 31, hh = lane >> 5;
  bf16x8 qf[NS];
#pragma unroll
  for (int s = 0; s < NS; ++s) qf[s] = *(const bf16x8*)(Qw + (size_t)r * q_ld + 16 * s + 8 * hh);
  f32x16 o[2];
#pragma unroll
  for (int n = 0; n < 2; ++n)
#pragma unroll
    for (int e = 0; e < 16; ++e) o[n][e] = 0.f;
  float m_run = 0.f, lsum = 0.f;
  u32x4 rk0[NKC], rv0[2], rk1[NKC], rv1[2];
  int krow_[NKC], kc_[NKC];
#pragma unroll
  for (int q = 0; q < NKC; ++q) { const int id = q * 256 + tid; krow_[q] = id / CPR; kc_[q] = id % CPR; }
  const int vrow = tid >> 3, vc = tid & 7;
  auto gload = [&](int key0, u32x4 (&rk)[NKC], u32x4 (&rv)[2]) {
#pragma unroll
    for (int q = 0; q < NKC; ++q) {
      const bf16_t* src = (DQK == 64 || kc_[q] < 8) ? K1 + (size_t)(key0 + krow_[q]) * k1_ld + kc_[q] * 8 : K2 + (size_t)(key0 + krow_[q]) * k2_ld + (kc_[q] - 8) * 8;
      rk[q] = *(const u32x4*)src;
    }
#pragma unroll
    for (int q = 0; q < 2; ++q) rv[q] = *(const u32x4*)(Vt + (size_t)(vrow + 32 * q) * vt_ld + key0 + vc * 8);
  };
  auto lstore = [&](int buf, u32x4 (&rk)[NKC], u32x4 (&rv)[2]) {
    char* base = smem + buf * STAGE;
#pragma unroll
    for (int q = 0; q < NKC; ++q) *(u32x4*)(base + krow_[q] * KS + kc_[q] * 16) = rk[q];
#pragma unroll
    for (int q = 0; q < 2; ++q) *(u32x4*)(base + KBYTES + (vrow + 32 * q) * VS + vc * 16) = rv[q];
  };
  const int ntl = nkeys >> 6;
  gload(0, rk0, rv0); lstore(0, rk0, rv0);
  gload(64, rk1, rv1);
  if (ntl > 2) gload(128, rk0, rv0);
  __syncthreads();
  auto tile_body = [&](int tl, u32x4 (&rkn)[NKC], u32x4 (&rvn)[2]) {
    const char* base = smem + (tl & 1) * STAGE;
    bf16x8 kf[2][NS], vf[2][2][2];
#pragma unroll
    for (int kb = 0; kb < 2; ++kb)
#pragma unroll
      for (int ks = 0; ks < NS; ++ks) kf[kb][ks] = *(const bf16x8*)(base + (kb * 32 + r) * KS + (2 * ks + hh) * 16);
    __builtin_amdgcn_sched_barrier(0);
    f32x16 s[2];
    const float ninit = -m_run;
#pragma unroll
    for (int kb = 0; kb < 2; ++kb)
#pragma unroll
      for (int e = 0; e < 16; ++e) s[kb][e] = ninit;
#pragma unroll
    for (int ks = 0; ks < NS; ++ks)
#pragma unroll
      for (int kb = 0; kb < 2; ++kb) s[kb] = MFMA32(kf[kb][ks], qf[ks], s[kb]);
#pragma unroll
    for (int kb = 0; kb < 2; ++kb)
#pragma unroll
      for (int s2 = 0; s2 < 2; ++s2)
#pragma unroll
        for (int n = 0; n < 2; ++n) vf[kb][s2][n] = *(const bf16x8*)(base + KBYTES + (32 * n + r) * VS + (kb * 32 + 16 * s2 + 8 * hh) * 2);
    __builtin_amdgcn_sched_barrier(0);
    float mx = s[0][0];
#pragma unroll
    for (int kb = 0; kb < 2; ++kb)
#pragma unroll
      for (int e = 0; e < 16; ++e) mx = fmaxf(mx, s[kb][e]);
    { const unsigned u = __float_as_uint(mx); auto sw = __builtin_amdgcn_permlane32_swap(u, u, false, false); mx = fmaxf(__uint_as_float(sw[0]), __uint_as_float(sw[1])); }
    const bool move = (mx > 4.0f) || (mx < -20.0f);
    if (__builtin_amdgcn_ballot_w64(move) != 0ull) {
      const float dlt = move ? mx : 0.f;
      const float alpha = __builtin_amdgcn_exp2f(-dlt);
      m_run += dlt;
      lsum *= alpha;
#pragma unroll
      for (int kb = 0; kb < 2; ++kb)
#pragma unroll
        for (int e = 0; e < 16; ++e) s[kb][e] -= dlt;
#pragma unroll
      for (int n = 0; n < 2; ++n)
#pragma unroll
        for (int e = 0; e < 16; ++e) o[n][e] *= alpha;
    }
    float ps = 0.f;
#pragma unroll
    for (int kb = 0; kb < 2; ++kb)
#pragma unroll
      for (int e = 0; e < 16; ++e) { const float pe = __builtin_amdgcn_exp2f(s[kb][e]); s[kb][e] = pe; ps += pe; }
    lsum += ps;
#pragma unroll
    for (int kb = 0; kb < 2; ++kb)
#pragma unroll
      for (int s2 = 0; s2 < 2; ++s2) {
        u32x4 pw;
        pw.x = pack2(s[kb][8 * s2 + 0], s[kb][8 * s2 + 1]); pw.y = pack2(s[kb][8 * s2 + 2], s[kb][8 * s2 + 3]);
        pw.z = pack2(s[kb][8 * s2 + 4], s[kb][8 * s2 + 5]); pw.w = pack2(s[kb][8 * s2 + 6], s[kb][8 * s2 + 7]);
        const bf16x8 pf = __builtin_bit_cast(bf16x8, pw);
#pragma unroll
        for (int n = 0; n < 2; ++n) o[n] = MFMA32(vf[kb][s2][n], pf, o[n]);
      }
    if (tl + 1 < ntl) { lstore((tl + 1) & 1, rkn, rvn); if (tl + 3 < ntl) gload((tl + 3) * 64, rkn, rvn); }
    __syncthreads();
  };
  for (int tl = 0; tl < ntl; tl += 2) { tile_body(tl, rk1, rv1); tile_body(tl + 1, rk0, rv0); }
  lsum = xsum32(lsum);
  const float inv = 1.0f / lsum;
#pragma unroll
  for (int n = 0; n < 2; ++n)
#pragma unroll
    for (int g = 0; g < 4; ++g) {
      u32x2 w; w.x = pack2(o[n][4 * g] * inv, o[n][4 * g + 1] * inv); w.y = pack2(o[n][4 * g + 2] * inv, o[n][4 * g + 3] * inv);
      *(u32x2*)(Ow + (size_t)r * o_ld + 32 * n + 8 * g + 4 * hh) = w;
    }
}

DI void scan_item(const Params& p, int l, int seq, int hd, int dir, int rs, char* smem) {
  const int tid = otid(), lane = tid & 63, wv = __builtin_amdgcn_readfirstlane(tid >> 6);
  const int j8 = lane & 7, r = lane & 31, hh = lane >> 5;
  const bool lat = seq >= 32;
  const int T = lat ? 4096 : 256;
  const int row0 = lat ? NCTX + (seq - 32) * 4096 : seq * 256;
  float* vA = (float*)smem; float* vK = vA + 2048; float* vR = vK + 2048; float* vV = vR + 2048; float* vW = vV + 2048; float* vB = vW + 2048; float* ybuf = vB + 2048;
  char* raw = smem + 32768;
  char* wdx = smem + 57344; char* adx = smem + 61952;
  float* tmpb = (float*)(smem + 66816);
  const bf16_t* U = (const bf16_t*)(p.ws + OFF_U);
  bf16_t* Y = (bf16_t*)(p.ws + OFF_R2) + (dir ? (size_t)NT * 512 : 0);
  float* bonus = (float*)(p.ws + OFF_BONUS);
  const int lrow = 8 * wv + (lane >> 3), irow = rs * 32 + lrow;
  f32x2 S[4];
  if (lat) {
    const float* s0 = (dir ? opq(p.in[I_SB]) : opq(p.in[I_SF])) + ((size_t)((seq - 32) * 4 + l) * 8 + hd) * 4096 + irow * 64 + j8 * 8;
#pragma unroll
    for (int q = 0; q < 2; ++q) { const f32x4 v = *(const f32x4*)(s0 + 4 * q); S[2 * q] = (f32x2){v.x, v.y}; S[2 * q + 1] = (f32x2){v.z, v.w}; }
  } else {
#pragma unroll
    for (int q = 0; q < 4; ++q) S[q] = (f32x2){0.f, 0.f};
  }
  const int mat = wv >> 1, ntc = wv & 1, cch = ntc * 32 + r, hc = hd * 64 + cch;
  bf16x8 bfrag[4];
  {
    const float* W = (mat ? opq(p.in[I_AUP]) : opq(p.in[I_WUP])) + (size_t)(l * 2 + dir) * 64 * 512 + hc;
#pragma unroll
    for (int s4 = 0; s4 < 4; ++s4) {
      float w8[8];
#pragma unroll
      for (int j = 0; j < 8; ++j) w8[j] = W[(size_t)(16 * s4 + 8 * hh + j) * 512];
      bfrag[s4] = __builtin_bit_cast(bf16x8, pack8(w8));
    }
  }
  const float bias = (mat ? opq(p.in[I_A0]) : opq(p.in[I_W0]))[(l * 2 + dir) * 512 + hc];
  const float kav = p.in[I_KA][l * 512 + hc], rkv = p.in[I_RK][l * 512 + hc];
  float* muP = (float*)(smem + 75008); float* muN = muP + 320; float* kkL = muN + 320;
  {
    const float* mup = p.in[I_MUP] + l * 1792; const float* mun = p.in[I_MUN] + l * 1792;
    for (int e = tid; e < 320; e += 256) { const int g = e >> 6, c = e & 63; const int col = (g < 3 ? g * 512 + hd * 64 : (g == 3 ? 1536 + dir * 64 : 1664 + dir * 64)) + c; muP[e] = mup[col]; muN[e] = mun[col]; }
    if (tid < 64) kkL[tid] = p.in[I_KK][l * 512 + hd * 64 + tid];
  }
  const int nch = T >> 5;
  u32x4 pre[6];
  auto prefetch = [&](int t0) {
#pragma unroll
    for (int q = 0; q < 6; ++q) {
      const int id = q * 256 + tid;
      const int row = id / 40, cc = id - row * 40, g = cc >> 3, c8 = cc & 7;
      const int t = t0 - 1 + row;
      const int col = (g < 3 ? g * 512 + hd * 64 : (g == 3 ? 1536 + dir * 64 : 1664 + dir * 64)) + c8 * 8;
      u32x4 v = (u32x4){0u, 0u, 0u, 0u};
      if (id < 1360 && t >= 0 && t < T) v = *(const u32x4*)(U + (size_t)(row0 + t) * ULD + 1696 + col);
      pre[q] = v;
    }
  };
  prefetch((dir ? nch - 1 : 0) * 32);
  for (int ci = 0; ci < nch; ++ci) {
    const int t0 = (dir ? nch - 1 - ci : ci) * 32;
#pragma unroll
    for (int q = 0; q < 6; ++q) { const int id = q * 256 + tid; if (id < 1360) *(u32x4*)(raw + id * 16) = pre[q]; }
    __syncthreads();
    if (ci + 1 < nch) prefetch((dir ? nch - 2 - ci : ci + 1) * 32);
    {
      const int tt = tid >> 3, sub = tid & 7;
#pragma unroll 1
      for (int g = 0; g < 5; ++g) {
        const int col = (g < 3 ? g * 512 + hd * 64 : (g == 3 ? 1536 + dir * 64 : 1664 + dir * 64)) + sub * 8;
        float c[8], pv[8], nx[8], x[8];
        unpack8(*(const u32x4*)(raw + (tt + 1) * 640 + (g * 8 + sub) * 16), c);
        unpack8(*(const u32x4*)(raw + tt * 640 + (g * 8 + sub) * 16), pv);
        unpack8(*(const u32x4*)(raw + (tt + 2) * 640 + (g * 8 + sub) * 16), nx);
        const f32x4 mp0 = *(const f32x4*)(muP + g * 64 + sub * 8), mp1 = *(const f32x4*)(muP + g * 64 + sub * 8 + 4), mn0 = *(const f32x4*)(muN + g * 64 + sub * 8), mn1 = *(const f32x4*)(muN + g * 64 + sub * 8 + 4);
        const float mp[8] = {mp0.x, mp0.y, mp0.z, mp0.w, mp1.x, mp1.y, mp1.z, mp1.w}, mn[8] = {mn0.x, mn0.y, mn0.z, mn0.w, mn1.x, mn1.y, mn1.z, mn1.w};
#pragma unroll
        for (int i = 0; i < 8; ++i) x[i] = c[i] + mp[i] * (pv[i] - c[i]) + mn[i] * (nx[i] - c[i]);
        const int lo = tt * 64 + sub * 8;
        if (g == 0) { *(f32x4*)(vR + lo) = (f32x4){x[0], x[1], x[2], x[3]}; *(f32x4*)(vR + lo + 4) = (f32x4){x[4], x[5], x[6], x[7]}; }
        else if (g == 1) {
          float kk[8], ss = 0.f;
          const float* kkw = kkL + sub * 8;
#pragma unroll
          for (int i = 0; i < 8; ++i) { kk[i] = x[i] * kkw[i]; ss += kk[i] * kk[i]; }
          *(f32x4*)(vK + lo) = (f32x4){x[0], x[1], x[2], x[3]}; *(f32x4*)(vK + lo + 4) = (f32x4){x[4], x[5], x[6], x[7]};
          ss += shx<1>(ss); ss += shx<2>(ss); ss += shx<4>(ss);
          const float inv = 1.0f / fmaxf(sqrtf(ss), 1e-12f);
          *(f32x4*)(vA + lo) = (f32x4){kk[0] * inv, kk[1] * inv, kk[2] * inv, kk[3] * inv}; *(f32x4*)(vA + lo + 4) = (f32x4){kk[4] * inv, kk[5] * inv, kk[6] * inv, kk[7] * inv};
        }
        else if (g == 2) { *(f32x4*)(vV + lo) = (f32x4){x[0], x[1], x[2], x[3]}; *(f32x4*)(vV + lo + 4) = (f32x4){x[4], x[5], x[6], x[7]}; }
        else if (g == 3) { float th[8]; for (int i = 0; i < 8; ++i) th[i] = 1.0f - 2.0f * __builtin_amdgcn_rcpf(1.0f + __expf(2.0f * x[i])); *(u32x4*)(wdx + tt * 144 + sub * 16) = pack8(th); }
        else { *(u32x4*)(adx + tt * 144 + sub * 16) = pack8(x); }
      }
    }
    __syncthreads();
    {
      f32x16 acc;
#pragma unroll
      for (int e = 0; e < 16; ++e) acc[e] = 0.f;
      const char* xb = mat ? adx : wdx;
#pragma unroll
      for (int s4 = 0; s4 < 4; ++s4) { const bf16x8 af = *(const bf16x8*)(xb + r * 144 + (16 * s4 + 8 * hh) * 2); acc = MFMA32(af, bfrag[s4], acc); }
      if (mat == 0) {
#pragma unroll
        for (int e = 0; e < 16; ++e) vW[crow(e, hh) * 64 + cch] = __expf(-0.6065306597126334f * sigmoidf_(bias + acc[e]));
      } else {
#pragma unroll
        for (int e = 0; e < 16; ++e) {
          const int ix = crow(e, hh) * 64 + cch;
          const float ag = sigmoidf_(bias + acc[e]);
          const float kk = vA[ix], k = vK[ix], rr = vR[ix];
          const float kd = k * (1.0f + (ag - 1.0f) * kav);
          vK[ix] = kd; vA[ix] = -kk; vB[ix] = kk * ag; tmpb[ix] = rr * kd * rkv;
        }
      }
    }
    __syncthreads();
    {
      const int tt = tid >> 3, sub = tid & 7;
      const f32x4 b0 = *(const f32x4*)(tmpb + tt * 64 + sub * 8), b1 = *(const f32x4*)(tmpb + tt * 64 + sub * 8 + 4);
      float bs = (b0.x + b0.y) + (b0.z + b0.w) + (b1.x + b1.y) + (b1.z + b1.w);
      bs += shx<1>(bs); bs += shx<2>(bs); bs += shx<4>(bs);
      if (sub == 0 && rs == 0) bonus[((size_t)(row0 + t0 + tt) * 8 + hd) * 2 + dir] = bs;
    }
    {
      f32x4 va[2], vw[2], vb[2], vk[2], vr[2]; float vi;
      int tt = dir ? 31 : 0;
      int vo = tt * 64 + j8 * 8;
#pragma unroll
      for (int q = 0; q < 2; ++q) { va[q] = *(const f32x4*)(vA + vo + 4 * q); vw[q] = *(const f32x4*)(vW + vo + 4 * q); vb[q] = *(const f32x4*)(vB + vo + 4 * q); vk[q] = *(const f32x4*)(vK + vo + 4 * q); vr[q] = *(const f32x4*)(vR + vo + 4 * q); }
      vi = vV[tt * 64 + irow];
      for (int si = 0; si < 32; ++si) {
        const int ttn = dir ? (si < 31 ? 30 - si : 0) : (si < 31 ? si + 1 : 31);
        const int von = ttn * 64 + j8 * 8;
        f32x2 pa2 = S[0] * (f32x2){va[0].x, va[0].y}, pa3 = S[1] * (f32x2){va[0].z, va[0].w};
        pa2 += S[2] * (f32x2){va[1].x, va[1].y}; pa3 += S[3] * (f32x2){va[1].z, va[1].w};
#pragma unroll
        for (int q = 0; q < 2; ++q) va[q] = *(const f32x4*)(vA + von + 4 * q);
        pa2 += pa3;
        const float sa = osum(pa2.x + pa2.y);
        const f32x2 sa2 = (f32x2){sa, sa}, vi2 = (f32x2){vi, vi};
        f32x2 py2, py3;
        S[0] = S[0] * (f32x2){vw[0].x, vw[0].y} + (sa2 * (f32x2){vb[0].x, vb[0].y} + vi2 * (f32x2){vk[0].x, vk[0].y}); py2 = S[0] * (f32x2){vr[0].x, vr[0].y};
        S[1] = S[1] * (f32x2){vw[0].z, vw[0].w} + (sa2 * (f32x2){vb[0].z, vb[0].w} + vi2 * (f32x2){vk[0].z, vk[0].w}); py3 = S[1] * (f32x2){vr[0].z, vr[0].w};
        S[2] = S[2] * (f32x2){vw[1].x, vw[1].y} + (sa2 * (f32x2){vb[1].x, vb[1].y} + vi2 * (f32x2){vk[1].x, vk[1].y}); py2 += S[2] * (f32x2){vr[1].x, vr[1].y};
        S[3] = S[3] * (f32x2){vw[1].z, vw[1].w} + (sa2 * (f32x2){vb[1].z, vb[1].w} + vi2 * (f32x2){vk[1].z, vk[1].w}); py3 += S[3] * (f32x2){vr[1].z, vr[1].w};
#pragma unroll
        for (int q = 0; q < 2; ++q) { vw[q] = *(const f32x4*)(vW + von + 4 * q); vb[q] = *(const f32x4*)(vB + von + 4 * q); vk[q] = *(const f32x4*)(vK + von + 4 * q); vr[q] = *(const f32x4*)(vR + von + 4 * q); }
        vi = vV[ttn * 64 + irow];
        py2 += py3;
        const float py = osum(py2.x + py2.y);
        ybuf[tt * 32 + lrow] = py;
        tt = ttn;
      }
    }
    __syncthreads();
    {
      const int tt = tid >> 3, sub = tid & 7;
      const f32x4 y0 = *(const f32x4*)(ybuf + tt * 32 + sub * 4);
      u32x2 w; w.x = pack2(y0.x, y0.y); w.y = pack2(y0.z, y0.w);
      *(u32x2*)(Y + (size_t)(row0 + t0 + tt) * 512 + hd * 64 + rs * 32 + sub * 4) = w;
    }
    __syncthreads();
  }
  if (!lat) {
    float* o = opq(p.out) + (dir ? OUT_SB : OUT_SF) + ((size_t)(seq * 4 + l) * 8 + hd) * 4096 + irow * 64 + j8 * 8;
#pragma unroll
    for (int q = 0; q < 2; ++q) *(f32x4*)(o + 4 * q) = (f32x4){S[2 * q].x, S[2 * q].y, S[2 * q + 1].x, S[2 * q + 1].y};
  }
}

DI void phase_mixers(const Params& p, int l, char* smem, int part = 0) {
  const int tid = otid(), wid = __builtin_amdgcn_readfirstlane(tid >> 6);
  unsigned* cnt = (unsigned*)(p.ws + OFF_CNT) + l * 8;
  int* slot = (int*)(smem + SMEM_BYTES - 16);
  bf16_t* U = (bf16_t*)(p.ws + OFF_U);
  const bf16_t* KA = (const bf16_t*)(p.ws + OFF_KA); const bf16_t* VAT = (const bf16_t*)(p.ws + OFF_VAT);
  const bf16_t* KN = (const bf16_t*)(p.ws + OFF_KN); const bf16_t* VBT = (const bf16_t*)(p.ws + OFF_VBT); const bf16_t* KRB = (const bf16_t*)(p.ws + OFF_KRB);
  const int QLEN = 256 + 256 + 128 + 64 + 64;
  bool first = true;
  int xq = blockIdx.x & 7, tries = 0;
  for (;;) {
    int kind, seq, a, qt;
    if (first && blockIdx.x < 256) {
      const int item = blockIdx.x; kind = 0; seq = 32 + (item >> 5); a = (item >> 2) & 7; qt = item & 3;
      first = false;
    } else {
      first = false;
      if (tid == 0) *slot = (int)atomicAdd(cnt + xq, 1u);
      __syncthreads();
      const int i = __builtin_amdgcn_readfirstlane(*slot);
      __syncthreads();
      if (i >= QLEN) { if (++tries >= 8) break; xq = (xq + 1) & 7; continue; }
      if (i < 256) { const int g = xq + 8 * (i >> 7); kind = 1; seq = 32 + (g >> 1); a = g & 1; qt = i & 127; }
      else if (i < 512) { const int j = i - 256; const int g = xq + 8 * (j >> 5); kind = 2; seq = 32 + (g >> 3); a = g & 7; qt = j & 31; }
      else if (i < 640) { const int j = i - 512; kind = 0; seq = xq + 8 * (j >> 5); a = (j >> 2) & 7; qt = j & 3; }
      else if (i < 704) { const int j = i - 640; kind = 1; seq = xq + 8 * (j >> 4); a = (j >> 3) & 1; qt = j & 7; }
      else { const int j = i - 704; kind = 2; seq = xq + 8 * (j >> 4); a = (j >> 1) & 7; qt = j & 1; }
    }
    const int kr0 = keyrow0(seq), Tk = seq_tk(seq);
    const int row0 = seq < 32 ? seq * 256 : NCTX + (seq - 32) * 4096;
    if (kind == 0) scan_item(p, l, seq, a, qt & 1, qt >> 1, smem);
    else if (kind == 1) {
      const int qh = a * 4 + wid;
      bf16_t* q = U + (size_t)(row0 + qt * 32) * ULD + qh * 64;
      attn_item<64>(q, ULD, KA + (size_t)kr0 * 128 + a * 64, 128, nullptr, 0, VAT + (size_t)128 * kr0 + (size_t)(a * 64) * Tk, Tk, Tk, q, ULD, smem);
    } else {
      bf16_t* q = U + (size_t)(row0 + qt * 128 + wid * 32) * ULD + 768 + a * 96;
      attn_item<96>(q, ULD, KN + (size_t)kr0 * 512 + a * 64, 512, KRB + (size_t)kr0 * 32, 32, VBT + (size_t)512 * kr0 + (size_t)(a * 64) * Tk, Tk, Tk, q, ULD, smem);
    }
  }
}

DI void cpost_row(const Params& p, int l, int row, int lane) {
  int seq, t; row_decode(row, seq, t);
  const int T = seq < 32 ? 256 : 4096;
  const bf16_t* YF = (const bf16_t*)(p.ws + OFF_R2); const bf16_t* YB = YF + (size_t)NT * 512;
  bf16_t* u = (bf16_t*)(p.ws + OFF_U) + (size_t)row * ULD + 1696;
  const float* bonus = (const float*)(p.ws + OFF_BONUS);
  float yf[8], yb[8], y[8];
  unpack8(*(const u32x4*)(YF + (size_t)row * 512 + lane * 8), yf);
  unpack8(*(const u32x4*)(YB + (size_t)row * 512 + lane * 8), yb);
  float s = 0.f;
#pragma unroll
  for (int i = 0; i < 8; ++i) { y[i] = yf[i] + yb[i]; s += y[i]; }
  s += shx<1>(s); s += shx<2>(s); s += shx<4>(s);
  const float mu = s * (1.0f / 64.0f);
  float q = 0.f;
#pragma unroll
  for (int i = 0; i < 8; ++i) { y[i] -= mu; q += y[i] * y[i]; }
  q += shx<1>(q); q += shx<2>(q); q += shx<4>(q);
  const float rs = rsqrtf(q * (1.0f / 64.0f) + 64e-5f);
  const int col = 1024 + lane * 8;
  float c[8], pv[8], nx[8];
  unpack8(*(const u32x4*)(u + col), c);
  if (t > 0) unpack8(*(const u32x4*)(u - ULD + col), pv); else { for (int i = 0; i < 8; ++i) pv[i] = 0.f; }
  if (t < T - 1) unpack8(*(const u32x4*)(u + ULD + col), nx); else { for (int i = 0; i < 8; ++i) nx[i] = 0.f; }
  const float* mup = p.in[I_MUP] + l * 1792 + col; const float* mun = p.in[I_MUN] + l * 1792 + col;
  const float* lw = p.in[I_LNW] + l * 512 + lane * 8; const float* lb = p.in[I_LNB] + l * 512 + lane * 8;
  const f32x2 bsv = *(const f32x2*)(bonus + ((size_t)row * 8 + (lane >> 3)) * 2);
  const float bs = bsv.x + bsv.y;
  float o[8];
#pragma unroll
  for (int i = 0; i < 8; ++i) { const float v = c[i] + mup[i] * (pv[i] - c[i]) + mun[i] * (nx[i] - c[i]); o[i] = y[i] * rs * lw[i] + lb[i] + bs * v; }
  *(u32x4*)(u + lane * 8) = pack8(o);
}
DI void phase_renorm_cpost(const Params& p, int l) {
  const int lane = otid() & 63, wid = __builtin_amdgcn_readfirstlane(otid() >> 6);
  for (int item = blockIdx.x; item < NT / 4; item += gridDim.x) { const int row = item * 4 + wid; norm_row(p, l, row, lane); cpost_row(p, l, row, lane); }
}

DI void phase_zgemm(const Params& p, char* smem) {
  const bf16_t* H = (const bf16_t*)(p.ws + OFF_R1);
  const bf16_t* W = (const bf16_t*)(p.ws + OFF_WIN) + (size_t)3584 * 1024;
  bf16_t* U = (bf16_t*)(p.ws + OFF_U);
  const int ntiles = 320 * 12;
  for (int tile = blockIdx.x; tile < ntiles; tile += gridDim.x) {
    const int mt = tile / 12, nt = tile % 12, m0 = mt * 128, n0 = nt * 128;
    f32x16 acc[2][2]; zero_acc<2>(acc);
    gemm_mainloop<2>(acc, H + (size_t)m0 * 1024, 1024, 64, W + (size_t)n0 * 1024, 1024, 1024, smem);
    const int lane = otid() & 63, wid = __builtin_amdgcn_readfirstlane(otid() >> 6), wm = wid >> 1, wn = wid & 1, r = lane & 31, hh = lane >> 5;
#pragma unroll
    for (int j = 0; j < 2; ++j) {
      const int col = n0 + wn * 64 + j * 32 + r;
      const int br = col >> 9, cc = col & 511;
      const int ucol = br == 0 ? cc : (br == 1 ? 768 + (cc >> 6) * 96 + (cc & 63) : 1696 + cc);
#pragma unroll
      for (int i = 0; i < 2; ++i) {
        bf16_t* up = U + (size_t)(m0 + wm * 64 + i * 32) * ULD;
        const int lo = 4 * hh * ULD + ucol;
        bf16_t yv[16];
#pragma unroll
        for (int e = 0; e < 16; ++e) yv[e] = (up + crowu(e) * ULD)[lo];
#pragma unroll
        for (int e = 0; e < 16; ++e) (up + crowu(e) * ULD)[lo] = f2bf(bf2f(yv[e]) * siluf_(acc[i][j][e]));
      }
    }
  }
}

DI void phase_merge(const Params& p, char* smem) {
  const bf16_t* H = (const bf16_t*)(p.ws + OFF_R1);
  const bf16_t* WG = (const bf16_t*)(p.ws + OFF_WIN) + (size_t)5120 * 1024;
  const bf16_t* WO = (const bf16_t*)(p.ws + OFF_WO);
  const bf16_t* U = (const bf16_t*)(p.ws + OFF_U);
  bf16_t* MX = (bf16_t*)(p.ws + OFF_R2);
  const int ntiles = 320 * 8;
  for (int tile = blockIdx.x; tile < ntiles; tile += gridDim.x) {
    const int mt = tile >> 3, nt = tile & 7, m0 = mt * 128, n0 = nt * 128;
    f32x16 mix[2][2]; zero_acc<2>(mix);
    unsigned gs[2][2][8];
#pragma unroll 1
    for (int step = 0; step < 6; ++step) {
      const int br = step >> 1, isT = step & 1;
      const int acol = br == 0 ? 0 : (br == 1 ? 768 : 1696);
      const bf16_t* Ap = isT ? U + (size_t)m0 * ULD + acol : H + (size_t)m0 * 1024;
      const bf16_t* Bp = isT ? WO + (size_t)(br * 1024 + n0) * 512 : WG + (size_t)(br * 1024 + n0) * 1024;
      f32x16 cur[2][2]; zero_acc<2>(cur);
      gemm_mainloop<2>(cur, Ap, isT ? ULD : 1024, (isT && br == 1) ? 96 : 64, Bp, isT ? 512 : 1024, isT ? 512 : 1024, smem);
      if (isT) {
#pragma unroll
        for (int i = 0; i < 2; ++i)
#pragma unroll
          for (int j = 0; j < 2; ++j)
#pragma unroll
            for (int e = 0; e < 8; ++e) { mix[i][j][2 * e] += lo16(gs[i][j][e]) * cur[i][j][2 * e]; mix[i][j][2 * e + 1] += hi16(gs[i][j][e]) * cur[i][j][2 * e + 1]; }
      } else {
#pragma unroll
        for (int i = 0; i < 2; ++i)
#pragma unroll
          for (int j = 0; j < 2; ++j)
#pragma unroll
            for (int e = 0; e < 8; ++e) gs[i][j][e] = pack2(sigmoidf_(cur[i][j][2 * e]), sigmoidf_(cur[i][j][2 * e + 1]));
      }
    }
    const int lane = otid() & 63, wid = __builtin_amdgcn_readfirstlane(otid() >> 6), wm = wid >> 1, wn = wid & 1, r = lane & 31, hh = lane >> 5;
#pragma unroll
    for (int j = 0; j < 2; ++j) {
      const int col = n0 + wn * 64 + j * 32 + r;
#pragma unroll
      for (int i = 0; i < 2; ++i) {
        bf16_t* mp = MX + (size_t)(m0 + wm * 64 + i * 32) * 1024;
        const int lo = 4 * hh * 1024 + col;
#pragma unroll
        for (int e = 0; e < 16; ++e) (mp + crowu(e) * 1024)[lo] = f2bf(mix[i][j][e]);
      }
    }
  }
}

DI void phase_out(const Params& p, int l, char* smem) {
  const bf16_t* MX = (const bf16_t*)(p.ws + OFF_R2);
  const bf16_t* W = (const bf16_t*)(p.ws + OFF_WOUT);
  const int ntiles = 320 * 8;
  for (int tile = blockIdx.x; tile < ntiles; tile += gridDim.x) {
    const int mt = tile >> 3, nt = tile & 7, m0 = mt * 128, n0 = nt * 128;
    f32x16 acc[2][2]; zero_acc<2>(acc);
    gemm_mainloop<2>(acc, MX + (size_t)m0 * 1024, 1024, 64, W + (size_t)n0 * 1024, 1024, 1024, smem);
    const int lane = otid() & 63, wid = __builtin_amdgcn_readfirstlane(otid() >> 6), wm = wid >> 1, wn = wid & 1, r = lane & 31, hh = lane >> 5;
    const int jm = m0 < NCTX ? 0 : 1 + ((m0 - NCTX) >> 12);
    const float* gate = (const float*)(p.ws + OFF_MOD) + ((size_t)l * 9 + jm) * MODLD + 2048;
    const float* xsrc = x_row_ptr(p, l, m0);
#pragma unroll
    for (int j = 0; j < 2; ++j) {
      const int col = n0 + wn * 64 + j * 32 + r;
      const float gv = gate[col];
      const int lo = 4 * hh * 1024 + col;
#pragma unroll
      for (int i = 0; i < 2; ++i) {
        const float* xs = xsrc + (size_t)(wm * 64 + i * 32) * 1024;
        float* xo = p.out + (size_t)(m0 + wm * 64 + i * 32) * 1024;
        float xv[16];
#pragma unroll
        for (int e = 0; e < 16; ++e) xv[e] = (xs + crowu(e) * 1024)[lo];
#pragma unroll
        for (int e = 0; e < 16; ++e) (xo + crowu(e) * 1024)[lo] = xv[e] + gv * acc[i][j][e];
      }
    }
  }
}

DI void phase_final(const Params& p) {
  const int lane = otid() & 63, wid = __builtin_amdgcn_readfirstlane(otid() >> 6);
  const float* nw = p.in[I_FNW];
  for (int item = blockIdx.x; item < NT / 4; item += gridDim.x) {
    float* x = p.out + (size_t)(item * 4 + wid) * 1024;
    f32x4 v[4]; float ss = 0.f;
#pragma unroll
    for (int i = 0; i < 4; ++i) { v[i] = *(const f32x4*)(x + lane * 4 + 256 * i); ss += v[i].x * v[i].x + v[i].y * v[i].y + v[i].z * v[i].z + v[i].w * v[i].w; }
ss = wave_sum(ss);
    const float rs = rsqrtf(ss * (1.0f / 1024.0f) + 1e-6f);
#pragma unroll
    for (int i = 0; i < 4; ++i) { const f32x4 w = *(const f32x4*)(nw + lane * 4 + 256 * i); *(f32x4*)(x + lane * 4 + 256 * i) = (f32x4){v[i].x * rs * w.x, v[i].y * rs * w.y, v[i].z * rs * w.z, v[i].w * rs * w.w}; }
  }
}

DI void grid_barrier(unsigned* bar, unsigned& epoch) {
  epoch += 1u;
  __syncthreads();
  if (otid() == 0) {
    const unsigned grp = blockIdx.x & 7u, per = gridDim.x >> 3;
    __builtin_amdgcn_fence(__ATOMIC_RELEASE, "agent");
    const unsigned old = __hip_atomic_fetch_add(bar + grp * 32, 1u, __ATOMIC_RELAXED, __HIP_MEMORY_SCOPE_AGENT);
    if (old + 1u == epoch * per) __hip_atomic_fetch_add(bar + 8 * 32, 1u, __ATOMIC_RELAXED, __HIP_MEMORY_SCOPE_AGENT);
    while (__hip_atomic_load(bar + 8 * 32, __ATOMIC_RELAXED, __HIP_MEMORY_SCOPE_AGENT) < epoch * 8u) __builtin_amdgcn_s_sleep(1);
    __builtin_amdgcn_fence(__ATOMIC_ACQUIRE, "agent");
  }
  __syncthreads();
}

constexpr int NPHASES = 1 + 4 * 9 + 1;
__global__ void __launch_bounds__(256, 2) fwd_kernel(Params p0) {
  __shared__ __attribute__((aligned(16))) char smem[SMEM_BYTES];
  cg::grid_group grid = cg::this_grid();
  const int ph_begin = p0.ph_begin, ph_end = p0.ph_end;
  unsigned* bar = (unsigned*)(p0.ws + OFF_BAR);
  unsigned epoch = 0u;
  for (int ph = ph_begin; ph < ph_end; ++ph) {
    auto kp = __builtin_amdgcn_kernarg_segment_ptr();
    asm volatile("" : "+s"(kp));
    typedef const __attribute__((address_space(4))) Params CParams;
    CParams* kpp = (CParams*)kp;
    Params p;
#pragma unroll
    for (int i = 0; i < 35; ++i) p.in[i] = kpp->in[i];
    p.out = kpp->out; p.ws = kpp->ws; p.ph_begin = ph_begin; p.ph_end = ph_end;
    if (ph == 0) phase_prologue(p, smem);
    else if (ph == NPHASES - 1) phase_final(p);
    else {
      const int l = (ph - 1) / 9, sp = (ph - 1) % 9;
#ifdef PROBE_SP
      if (sp == PROBE_SP) {
        switch (sp) {
          case 0: phase_norm_convert(p, l, smem); break;
          case 1: phase_gemm1(p, l, smem); break;
          case 3: phase_upproj(p, smem); break;
          case 5: phase_renorm_cpost(p, l); break;
          case 7: phase_merge(p, smem); break;
          default: break;
        }
        grid.sync();
      }
#endif
      switch (sp) {
        case 0: phase_norm_convert(p, l, smem); break;
        case 1: phase_gemm1(p, l, smem); break;
        case 2: phase_post(p, l); break;
        case 3: phase_upproj(p, smem); break;
        case 4: phase_mixers(p, l, smem); break;
        case 5: phase_renorm_cpost(p, l); break;
        case 6: phase_zgemm(p, smem); break;
        case 7: phase_merge(p, smem); break;
        default: phase_out(p, l, smem); break;
      }
    }
    if (ph + 1 < ph_end) { if (ph == 0) grid.sync(); else grid_barrier(bar, epoch); }
  }
}

extern "C" void kernel_launch(void* const* d_in, const int* in_sizes, int n_in, void* d_out, int out_size, void* d_ws, size_t ws_size, hipStream_t stream) {
  if (ws_size < WS_NEED || n_in < 35) { fprintf(stderr, "workspace too small: %zu < %zu\n", ws_size, WS_NEED); return; }
  static int grid_blocks = 0;
  if (!grid_blocks) {
    int dev = 0, cus = 0, per_cu = 0;
    hipGetDevice(&dev);
    hipDeviceGetAttribute(&cus, hipDeviceAttributeMultiprocessorCount, dev);
    hipOccupancyMaxActiveBlocksPerMultiprocessor(&per_cu, fwd_kernel, 256, 0);
    if (per_cu < 1) per_cu = 1;
    if (per_cu > 2) per_cu = 2;
    grid_blocks = cus * per_cu;
  }
  Params p{};
  for (int i = 0; i < 35; ++i) p.in[i] = (const float*)d_in[i];
  p.out = (float*)d_out; p.ws = (char*)d_ws;
#ifndef ONE_LAUNCH
  for (int ph = 0; ph < NPHASES; ++ph) {
    p.ph_begin = ph; p.ph_end = ph + 1;
    hipLaunchKernelGGL(fwd_kernel, dim3(grid_blocks), dim3(256), 0, stream, p);
  }
#else
  p.ph_begin = 0; p.ph_end = NPHASES;
  hipMemsetAsync((char*)d_ws + OFF_BAR, 0, 4096, stream);
  void* args[] = {&p};
  hipError_t e = hipLaunchCooperativeKernel((void*)fwd_kernel, dim3(grid_blocks), dim3(256), args, 0, stream);
  if (e != hipSuccess) fprintf(stderr, "cooperative launch failed: %s (grid %d)\n", hipGetErrorString(e), grid_blocks);
#endif
}
```

```cpp
#define ONE_LAUNCH 1
#include <hip/hip_runtime.h>
#include <hip/hip_cooperative_groups.h>
#include <stdint.h>
#include <stdio.h>
namespace cg = cooperative_groups;

typedef unsigned short bf16_t;
typedef short bf16x8 __attribute__((ext_vector_type(8)));
typedef float f32x16 __attribute__((ext_vector_type(16)));
typedef float f32x4 __attribute__((ext_vector_type(4)));
typedef float f32x2 __attribute__((ext_vector_type(2)));
typedef unsigned u32x4 __attribute__((ext_vector_type(4)));
typedef unsigned u32x2 __attribute__((ext_vector_type(2)));
#define DI __device__ __forceinline__
#define MFMA32(a, b, c) __builtin_amdgcn_mfma_f32_32x32x16_bf16((a), (b), (c), 0, 0, 0)

constexpr int NT = 40960;
constexpr int NCTX = 8192;
constexpr int NK = 45056;
constexpr int ULD = 3488;
constexpr int MODLD = 3072;
constexpr int SMEM_BYTES = 78848;

constexpr size_t OFF_WIN = 0;
constexpr size_t OFF_WO = 16777216;
constexpr size_t OFF_WOUT = 19922944;
constexpr size_t OFF_WU = 22020096;
constexpr size_t OFF_MOD = 22282240;
constexpr size_t OFF_BONUS = 22724608;
constexpr size_t OFF_CS16 = 25346048;
constexpr size_t OFF_CS8 = 25354240;
constexpr size_t OFF_CNT = 25358336;
constexpr size_t OFF_BAR = 524742912;
constexpr size_t OFF_U = 25358592;
constexpr size_t OFF_R1 = 311095552;
constexpr size_t OFF_KA = OFF_R1;
constexpr size_t OFF_VAT = 513208576;
constexpr size_t OFF_KN = OFF_R1 + 23068672;
constexpr size_t OFF_VBT = OFF_R1 + 69206016;
constexpr size_t OFF_KRB = OFF_R1 + 115343360;
constexpr size_t OFF_R2 = 429322496;
constexpr size_t WS_NEED = 524742912 + 4096;

constexpr size_t OUT_AK = 41943040, OUT_AV = 46137344, OUT_CKV = 50331648, OUT_KR = 54525952, OUT_SF = 55574528, OUT_SB = 59768832;

struct Params {
  const float* in[35];
  float* out;
  char* ws;
  int ph_begin, ph_end;
};

enum { I_XP = 0, I_XS, I_CAK, I_CAV, I_CCKV, I_CKR, I_SF, I_SB, I_C, I_CCTX, I_NORMW, I_WMOD, I_BMOD, I_WIN, I_QNW, I_KNW, I_KVNW,
       I_WUK, I_WUV, I_MUP, I_MUN, I_W0, I_WUP, I_A0, I_AUP, I_KK, I_KA, I_RK, I_LNW, I_LNB, I_WOA, I_WOB, I_WOC, I_WOUT, I_FNW };

DI int threadIdx_x_raw() { return __builtin_amdgcn_workitem_id_x(); }
DI int otid() { int t = threadIdx_x_raw(); asm volatile("" : "+v"(t)); return t; }
DI const float* opq(const float* q) { asm volatile("" : "+s"(q)); return q; }
DI float* opq(float* q) { asm volatile("" : "+s"(q)); return q; }
DI float bf2f(bf16_t v) { return __uint_as_float(((unsigned)v) << 16); }
typedef __bf16 hbf16x2 __attribute__((ext_vector_type(2)));
DI unsigned pack2(float a, float b) { f32x2 v = {a, b}; hbf16x2 r = __builtin_convertvector(v, hbf16x2); return __builtin_bit_cast(unsigned, r); }
DI bf16_t f2bf(float x) { return (bf16_t)(pack2(x, 0.f) & 0xffffu); }
DI float xsum16(float x) { const unsigned u = __float_as_uint(x); auto r = __builtin_amdgcn_permlane16_swap(u, u, false, false); return __uint_as_float(r[0]) + __uint_as_float(r[1]); }
DI float xsum32(float x) { const unsigned u = __float_as_uint(x); auto r = __builtin_amdgcn_permlane32_swap(u, u, false, false); return __uint_as_float(r[0]) + __uint_as_float(r[1]); }
DI float lo16(unsigned w) { return __uint_as_float(w << 16); }
DI float hi16(unsigned w) { return __uint_as_float(w & 0xffff0000u); }
DI void unpack8(u32x4 w, float* v) { v[0] = lo16(w.x); v[1] = hi16(w.x); v[2] = lo16(w.y); v[3] = hi16(w.y); v[4] = lo16(w.z); v[5] = hi16(w.z); v[6] = lo16(w.w); v[7] = hi16(w.w); }
DI u32x4 pack8(const float* v) { u32x4 w; w.x = pack2(v[0], v[1]); w.y = pack2(v[2], v[3]); w.z = pack2(v[4], v[5]); w.w = pack2(v[6], v[7]); return w; }
template <int K> DI float shx(float v) { return __int_as_float(__builtin_amdgcn_ds_swizzle(__float_as_int(v), 0x1f | (K << 10))); }
DI float wave_sum(float v) { v += shx<1>(v); v += shx<2>(v); v += shx<4>(v); v += shx<8>(v); v += shx<16>(v); return xsum32(v); }
DI float qsum(float v) {
  v += __int_as_float(__builtin_amdgcn_update_dpp(0, __float_as_int(v), 0xB1, 0xf, 0xf, true));
  v += __int_as_float(__builtin_amdgcn_update_dpp(0, __float_as_int(v), 0x4E, 0xf, 0xf, true));
  return v;
}
DI float osum(float v) {
  v = qsum(v);
  v += __int_as_float(__builtin_amdgcn_update_dpp(0, __float_as_int(v), 0x141, 0xf, 0xf, true));
  return v;
}
DI int crow(int reg, int h) { return (reg & 3) + 8 * (reg >> 2) + 4 * h; }
DI int crowu(int reg) { return (reg & 3) + 8 * (reg >> 2); }
DI int perm16(int t) { return (t & ~12) | ((t & 4) << 1) | ((t & 8) >> 1); }
DI float sigmoidf_(float x) { return __builtin_amdgcn_rcpf(1.0f + __expf(-x)); }
DI float siluf_(float x) { return x * __builtin_amdgcn_rcpf(1.0f + __expf(-x)); }

DI void row_decode(int row, int& seq, int& t) {
  if (row < NCTX) { seq = row >> 8; t = row & 255; } else { seq = 32 + ((row - NCTX) >> 12); t = (row - NCTX) & 4095; }
}
DI int keyrow0(int seq) { return seq < 32 ? seq * 256 : NCTX + (seq - 32) * 4608; }
DI int seq_tk(int seq) { return seq < 32 ? 256 : 4608; }

typedef __attribute__((address_space(3))) unsigned lds_u32;
template <int NJ>
DI void gemm_mainloop(f32x16 (&acc)[2][NJ], const bf16_t* __restrict__ A, int lda, int ks,
                      const bf16_t* __restrict__ Bt, int ldb, int K, char* smem) {
  constexpr int A_BYTES = 128 * 128;
  constexpr int B_BYTES = 64 * NJ * 128;
  constexpr int STAGE = A_BYTES + B_BYTES;
  const int tid = otid(), lane = tid & 63, wid = __builtin_amdgcn_readfirstlane(tid >> 6), wm = wid >> 1, wn = wid & 1;
  const int r = lane & 31, hh = lane >> 5;
  const int nk = K >> 6;
  const int lrow = tid >> 3, lc = tid & 7;
  const int gc = (lc ^ ((lrow >> 1) & 7)) * 8;
  const bf16_t* ap = A + (size_t)lrow * lda + gc;
  const bf16_t* bp = Bt + (size_t)lrow * ldb + gc;
  auto issue = [&](int kt, int buf) {
    char* base = smem + buf * STAGE + tid * 16;
    const bf16_t* ap2 = ap + (size_t)kt * ks;
    const bf16_t* bp2 = bp + (size_t)kt * 64;
#pragma unroll
    for (int p = 0; p < 4; ++p) __builtin_amdgcn_global_load_lds((const unsigned*)(ap2 + (size_t)(32 * p) * lda), (lds_u32*)(base + p * 4096), 16, 0, 0);
#pragma unroll
    for (int p = 0; p < 2 * NJ; ++p) __builtin_amdgcn_global_load_lds((const unsigned*)(bp2 + (size_t)(32 * p) * ldb), (lds_u32*)(base + A_BYTES + p * 4096), 16, 0, 0);
  };
  issue(0, 0);
  __syncthreads();
#pragma unroll 1
  for (int kt = 0; kt < nk; ++kt) {
    if (kt + 1 < nk) issue(kt + 1, (kt + 1) & 1);
    const char* base = smem + (kt & 1) * STAGE;
#pragma unroll
    for (int s = 0; s < 4; ++s) {
      bf16x8 af[2], bfr[NJ];
#pragma unroll
      for (int i = 0; i < 2; ++i) { const int row = wm * 64 + i * 32 + r; af[i] = *(const bf16x8*)(base + row * 128 + (((2 * s + hh) ^ ((row >> 1) & 7)) << 4)); }
#pragma unroll
      for (int j = 0; j < NJ; ++j) { const int row = wn * (32 * NJ) + j * 32 + r; bfr[j] = *(const bf16x8*)(base + A_BYTES + row * 128 + (((2 * s + hh) ^ ((row >> 1) & 7)) << 4)); }
#pragma unroll
      for (int i = 0; i < 2; ++i)
#pragma unroll
        for (int j = 0; j < NJ; ++j) acc[i][j] = MFMA32(af[i], bfr[j], acc[i][j]);
    }
    __syncthreads();
  }
}

template <int NJ> DI void zero_acc(f32x16 (&acc)[2][NJ]) {
#pragma unroll
  for (int i = 0; i < 2; ++i)
#pragma unroll
    for (int j = 0; j < NJ; ++j)
#pragma unroll
      for (int e = 0; e < 16; ++e) acc[i][j][e] = 0.f;
}

DI void phase_prologue(const Params& p, char* smem) {
  const int tid = otid(), lane = tid & 63, wid = __builtin_amdgcn_readfirstlane(tid >> 6);
  float* mod = (float*)(p.ws + OFF_MOD);
  if (blockIdx.x == 0) {
    if (tid < 32) ((unsigned*)(p.ws + OFF_CNT))[tid] = 0u;
    float* cs16 = (float*)(p.ws + OFF_CS16);
    float* cs8 = (float*)(p.ws + OFF_CS8);
    for (int e = tid; e < 64 * 16; e += 256) { const int pos = e >> 4, i = e & 15; const float inv = expf(-9.210340371976184f * (float)i / 16.0f); const float a = (float)pos * inv; cs16[e * 2] = cosf(a); cs16[e * 2 + 1] = sinf(a); }
    for (int e = tid; e < 64 * 8; e += 256) { const int pos = e >> 3, i = e & 7; const float inv = expf(-9.210340371976184f * (float)i / 8.0f); const float a = (float)pos * inv; cs8[e * 2] = cosf(a); cs8[e * 2 + 1] = sinf(a); }
  }
  float* sl = (float*)smem;
  float* red = sl + 9 * 1024;
  for (int e = tid; e < 9 * 1024; e += 256) { const int j = e >> 10, k = e & 1023; const float* cc0 = opq(p.in[I_CCTX]); const float* cc1 = opq(p.in[I_C]); const float c = j == 0 ? cc0[k] : cc1[(j - 1) * 1024 + k]; sl[e] = siluf_(c); }
  __syncthreads();
  for (int item = blockIdx.x; item < 192; item += gridDim.x) {
    const int l = item / 48, n = (item % 48) * 64 + lane;
    const float* w = p.in[I_WMOD] + (size_t)l * 1024 * 3072 + n;
    float a[9];
#pragma unroll
    for (int j = 0; j < 9; ++j) a[j] = 0.f;
    for (int k = wid * 256; k < wid * 256 + 256; ++k) {
      const float wv = w[(size_t)k * 3072];
#pragma unroll
      for (int j = 0; j < 9; ++j) a[j] += sl[j * 1024 + k] * wv;
    }
#pragma unroll
    for (int j = 0; j < 9; ++j) red[(wid * 9 + j) * 64 + lane] = a[j];
    __syncthreads();
    for (int e = tid; e < 9 * 64; e += 256) {
      const int j = e >> 6, c = e & 63;
      const float s = red[(0 * 9 + j) * 64 + c] + red[(1 * 9 + j) * 64 + c] + red[(2 * 9 + j) * 64 + c] + red[(3 * 9 + j) * 64 + c];
      const int nn = (item % 48) * 64 + c;
      mod[((size_t)l * 9 + j) * MODLD + nn] = s + p.in[I_BMOD][l * 3072 + nn];
    }
    __syncthreads();
  }
}

DI const float* x_row_ptr(const Params& p, int l, int row) {
  const float* xp = opq(p.in[I_XP]); const float* xs = opq(p.in[I_XS]); const float* xo = opq((const float*)p.out);
  if (l == 0) return row < NCTX ? xp + (size_t)row * 1024 : xs + (size_t)(row - NCTX) * 1024;
  return xo + (size_t)row * 1024;
}
DI void norm_row(const Params& p, int l, int row, int lane) {
  const float* x = x_row_ptr(p, l, row);
  const int j = row < NCTX ? 0 : 1 + ((row - NCTX) >> 12);
  const float* mod = (const float*)(p.ws + OFF_MOD) + ((size_t)l * 9 + j) * MODLD;
  const float* nw = p.in[I_NORMW] + l * 1024;
  bf16_t* h = (bf16_t*)(p.ws + OFF_R1) + (size_t)row * 1024;
  f32x4 v[4]; float ss = 0.f;
#pragma unroll
  for (int i = 0; i < 4; ++i) { v[i] = *(const f32x4*)(x + lane * 4 + 256 * i); ss += v[i].x * v[i].x + v[i].y * v[i].y + v[i].z * v[i].z + v[i].w * v[i].w; }
ss = wave_sum(ss);
  const float rs = rsqrtf(ss * (1.0f / 1024.0f) + 1e-6f);
#pragma unroll
  for (int i = 0; i < 4; ++i) {
    const int c = lane * 4 + 256 * i;
    const f32x4 w = *(const f32x4*)(nw + c), sh = *(const f32x4*)(mod + c), sc = *(const f32x4*)(mod + 1024 + c);
    u32x2 o;
    o.x = pack2(v[i].x * rs * w.x * (1.f + sc.x) + sh.x, v[i].y * rs * w.y * (1.f + sc.y) + sh.y);
    o.y = pack2(v[i].z * rs * w.z * (1.f + sc.z) + sh.z, v[i].w * rs * w.w * (1.f + sc.w) + sh.w);
    *(u32x2*)(h + c) = o;
  }
}

DI int win_srccol(int j) {
  if (j < 768) return j;
  if (j < 1696) return j + 512;
  if (j < 3488) return j + 1024;
  if (j < 3584) return -1;
  if (j < 5120) { const int jj = j - 3584; return jj < 512 ? 768 + jj : (jj < 1024 ? 2208 + (jj - 512) : 4512 + (jj - 1024)); }
  return 5024 + (j - 5120);
}
DI void conv_tile(const float* __restrict__ src, int ld_src, bf16_t* dst, int ld_dst, int k0, int n0, int kind, int srcoff, char* smem) {
  float* tile = (float*)smem;
  const int tid = otid();
  const int n = tid & 63;
  int sc = kind == 0 ? win_srccol(n0 + n) : (n0 + n - srcoff);
#pragma unroll
  for (int i = 0; i < 16; ++i) { const int k = i * 4 + (tid >> 6); tile[k * 65 + n] = sc >= 0 ? src[(size_t)(k0 + k) * ld_src + sc] : 0.f; }
  __syncthreads();
#pragma unroll
  for (int i = 0; i < 8; ++i) { const int nn = i * 8 + (tid >> 5), kk = (tid & 31) * 2; *(unsigned*)(dst + (size_t)(n0 + nn) * ld_dst + k0 + kk) = pack2(tile[kk * 65 + nn], tile[(kk + 1) * 65 + nn]); }
  __syncthreads();
}

DI void phase_norm_convert(const Params& p, int l, char* smem) {
  const int tid = otid(), lane = tid & 63, wid = __builtin_amdgcn_readfirstlane(tid >> 6);
  bf16_t* WinT = (bf16_t*)(p.ws + OFF_WIN); bf16_t* WoT = (bf16_t*)(p.ws + OFF_WO); bf16_t* WoutT = (bf16_t*)(p.ws + OFF_WOUT); bf16_t* WuT = (bf16_t*)(p.ws + OFF_WU);
  const int NI_WIN = 128 * 16, NI_WO = 3 * 16 * 8, NI_WOUT = 16 * 16, NI_WU = 16 * 2;
  const int NI_CONV = NI_WIN + NI_WO + NI_WOUT + NI_WU;
  for (int item = blockIdx.x; item < NI_CONV; item += gridDim.x) {
    int it = item;
    if (it < NI_WIN) { conv_tile(p.in[I_WIN] + (size_t)l * 1024 * 8096, 8096, WinT, 1024, (it & 15) * 64, (it >> 4) * 64, 0, 0, smem); continue; }
    it -= NI_WIN;
    if (it < NI_WO) { const int br = it / 128, r2 = it % 128; const float* src = (br == 0 ? opq(p.in[I_WOA]) : (br == 1 ? opq(p.in[I_WOB]) : opq(p.in[I_WOC]))) + (size_t)l * 512 * 1024; conv_tile(src, 1024, WoT + (size_t)br * 1024 * 512, 512, (r2 & 7) * 64, (r2 >> 3) * 64, 1, 0, smem); continue; }
    it -= NI_WO;
    if (it < NI_WOUT) { conv_tile(p.in[I_WOUT] + (size_t)l * 1024 * 1024, 1024, WoutT, 1024, (it & 15) * 64, (it >> 4) * 64, 1, 0, smem); continue; }
    it -= NI_WOUT;
    { const int nt = it >> 1, kt = it & 1; const bool uv = nt >= 8; const float* src = (uv ? opq(p.in[I_WUV]) : opq(p.in[I_WUK])) + (size_t)l * 128 * 512; conv_tile(src, 512, WuT, 128, kt * 64, nt * 64, 1, uv ? 512 : 0, smem); }
  }
  for (int item = blockIdx.x; item < NT / 4; item += gridDim.x) norm_row(p, l, item * 4 + wid, lane);
}

DI bool next_tile(int it, int NTN, int GN, int& mt, int& nt) {
  if (gridDim.x == 512) {
    const int x = blockIdx.x & 7, local = blockIdx.x >> 3;
    const int q = it * 64 + local;
    if (q >= 40 * NTN) return false;
    const int gsz = 8 * GN, g = q / gsz, w = q - g * gsz, ngroups = NTN / GN;
    const int mgi = g / ngroups, ngi = g - mgi * ngroups;
    mt = x * 40 + mgi * 8 + w / GN; nt = ngi * GN + (w % GN);
    return true;
  }
  const int tile = blockIdx.x + it * gridDim.x;
  if (tile >= 320 * NTN) return false;
  mt = tile / NTN; nt = tile % NTN;
  return true;
}

DI void phase_gemm1(const Params& p, int l, char* smem) {
  const bf16_t* H = (const bf16_t*)(p.ws + OFF_R1);
  const bf16_t* W = (const bf16_t*)(p.ws + OFF_WIN);
  bf16_t* U = (bf16_t*)(p.ws + OFF_U);
  bf16_t* VAT = (bf16_t*)(p.ws + OFF_VAT);
  const int NTN = 28, ntiles = 320 * NTN;
  for (int it = 0;; ++it) {
    int mt, nt; if (!next_tile(it, NTN, 7, mt, nt)) break;
    const int m0 = mt * 128, n0 = nt * 128;
    f32x16 acc[2][2]; zero_acc<2>(acc);
    gemm_mainloop<2>(acc, H + (size_t)m0 * 1024, 1024, 64, W + (size_t)n0 * 1024, 1024, 1024, smem);
    const int lane = otid() & 63, wid = __builtin_amdgcn_readfirstlane(otid() >> 6), wm = wid >> 1, wn = wid & 1, r = lane & 31, hh = lane >> 5;
    int seq, t0; row_decode(m0, seq, t0);
#pragma unroll
    for (int j = 0; j < 2; ++j) {
      const int cb = n0 + wn * 64 + j * 32;
      if (cb >= ULD) continue;
      const int col = cb + r;
      if (cb >= 640 && cb < 768) {
        const int kvh = (col - 640) >> 6, dv = col & 63, Tk = seq_tk(seq);
        bf16_t* vt = VAT + (size_t)128 * keyrow0(seq) + (size_t)(kvh * 64 + dv) * Tk;
#pragma unroll
        for (int i = 0; i < 2; ++i) {
          const int tt = t0 + wm * 64 + i * 32;
#pragma unroll
          for (int g2 = 0; g2 < 2; ++g2) {
            float v[8];
#pragma unroll
            for (int e = 0; e < 8; ++e) v[e] = acc[i][j][g2 * 8 + e];
            *(u32x4*)(vt + tt + 16 * g2 + 8 * hh) = pack8(v);
          }
          if (seq < 32) {
            float* o = p.out + OUT_AV + ((size_t)(seq * 4 + l) * 256 + tt) * 128;
            const int lo = 4 * hh * 128 + (col - 640);
#pragma unroll
            for (int e = 0; e < 16; ++e) (o + crowu(e) * 128)[lo] = acc[i][j][e];
          }
        }
      } else {
#pragma unroll
        for (int i = 0; i < 2; ++i) {
          bf16_t* up = U + (size_t)(m0 + wm * 64 + i * 32) * ULD;
          const int lo = 4 * hh * ULD + col;
#pragma unroll
          for (int e = 0; e < 16; ++e) (up + crowu(e) * ULD)[lo] = f2bf(acc[i][j][e]);
        }
      }
    }
  }
}

DI void post_row(const Params& p, int l, int row, int lane) {
  int seq, t; row_decode(row, seq, t);
  const bool lat = row >= NCTX;
  const int krow = keyrow0(seq) + t;
  const int prow = t >> 6, pcol = t & 63;
  bf16_t* u = (bf16_t*)(p.ws + OFF_U) + (size_t)row * ULD;
  const float* cs16 = (const float*)(p.ws + OFF_CS16);
  const float* cs8 = (const float*)(p.ws + OFF_CS8);
  const float LOG2E = 1.4426950408889634f;
#pragma unroll
  for (int which = 0; which < 2; ++which) {
    const int l8 = which == 0 ? lane : (lane & 15);
    const bf16_t* src = u + (which == 0 ? 0 : 512) + l8 * 8;
    float v[8]; unpack8(*(const u32x4*)src, v);
    float ss = 0.f;
#pragma unroll
    for (int i = 0; i < 8; ++i) ss += v[i] * v[i];
    ss += shx<1>(ss); ss += shx<2>(ss); ss += shx<4>(ss);
    const float rs = rsqrtf(ss * (1.0f / 64.0f) + 1e-6f);
    const float* nw = (which == 0 ? opq(p.in[I_QNW]) : opq(p.in[I_KNW])) + l * 64 + (lane & 7) * 8;
#pragma unroll
    for (int i = 0; i < 8; ++i) v[i] = v[i] * rs * nw[i];
    float pv[8];
#pragma unroll
    for (int i = 0; i < 8; ++i) pv[i] = shx<2>(v[i]);
    if (lat) {
      const int pos = ((lane & 7) >> 2) ? pcol : prow;
      const bool lower = (lane & 2) == 0;
      const float* cs = cs16 + (pos * 16 + (lane & 1) * 8) * 2;
#pragma unroll
      for (int i = 0; i < 8; ++i) { const float c = cs[i * 2], s = cs[i * 2 + 1]; v[i] = lower ? v[i] * c - pv[i] * s : v[i] * c + pv[i] * s; }
    }
    if (which == 0) {
      const float sc = 0.125f * LOG2E;
#pragma unroll
      for (int i = 0; i < 8; ++i) v[i] *= sc;
      *(u32x4*)(u + lane * 8) = pack8(v);
    } else if (lane < 16) {
      bf16_t* KA = (bf16_t*)(p.ws + OFF_KA);
      *(u32x4*)(KA + (size_t)krow * 128 + lane * 8) = pack8(v);
      if (!lat) {
        float* o = p.out + OUT_AK + ((size_t)(seq * 4 + l) * 256 + t) * 128 + lane * 8;
        *(f32x4*)o = (f32x4){v[0], v[1], v[2], v[3]}; *(f32x4*)(o + 4) = (f32x4){v[4], v[5], v[6], v[7]};
      }
    }
  }
  {
    const float sc = 0.10206207261596577f * LOG2E;
    const int hd = lane >> 3;
    bf16_t* q = u + 768 + hd * 96;
    { float v[8]; unpack8(*(const u32x4*)(q + (lane & 7) * 8), v);
#pragma unroll
      for (int i = 0; i < 8; ++i) v[i] *= sc;
      *(u32x4*)(q + (lane & 7) * 8) = pack8(v); }
    { bf16_t* qr = q + 64 + (lane & 7) * 4;
      const u32x2 w = *(const u32x2*)qr;
      float v[4] = {lo16(w.x), hi16(w.x), lo16(w.y), hi16(w.y)}, pv[4];
#pragma unroll
      for (int i = 0; i < 4; ++i) pv[i] = shx<2>(v[i]);
      if (lat) {
        const int pos = ((lane & 7) >> 2) ? pcol : prow;
        const bool lower = (lane & 2) == 0;
        const float* cs = cs8 + (pos * 8 + (lane & 1) * 4) * 2;
#pragma unroll
        for (int i = 0; i < 4; ++i) { const float c = cs[i * 2], s = cs[i * 2 + 1]; v[i] = lower ? v[i] * c - pv[i] * s : v[i] * c + pv[i] * s; }
      }
      u32x2 o; o.x = pack2(v[0] * sc, v[1] * sc); o.y = pack2(v[2] * sc, v[3] * sc);
      *(u32x2*)qr = o; }
  }
  {
    const unsigned w = *(const unsigned*)(u + 1536 + lane * 2);
    float a = lo16(w), b = hi16(w);
    float ss = a * a + b * b;
ss = wave_sum(ss);
    const float rs = rsqrtf(ss * (1.0f / 128.0f) + 1e-6f);
    const float* nw = p.in[I_KVNW] + l * 128 + lane * 2;
    a = a * rs * nw[0]; b = b * rs * nw[1];
    bf16_t* CKVN = (bf16_t*)(p.ws + OFF_R2);
    *(unsigned*)(CKVN + (size_t)krow * 128 + lane * 2) = pack2(a, b);
    if (!lat) { float* o = p.out + OUT_CKV + ((size_t)(seq * 4 + l) * 256 + t) * 128 + lane * 2; *(f32x2*)o = (f32x2){a, b}; }
  }
  {
    float v = bf2f(u[1664 + (lane & 31)]);
    const float pv = shx<8>(v);
    if (!lat) { if (lane < 32) p.out[OUT_KR + ((size_t)(seq * 4 + l) * 256 + t) * 32 + lane] = v; }
    else {
      const int d = lane & 31; const int pos = (d >> 4) ? pcol : prow; const bool lower = (d & 8) == 0;
      const float* cs = cs8 + (pos * 8 + (d & 7)) * 2;
      v = lower ? v * cs[0] - pv * cs[1] : v * cs[0] + pv * cs[1];
    }
    if (lane < 32) ((bf16_t*)(p.ws + OFF_KRB))[(size_t)krow * 32 + lane] = f2bf(v);
  }
}
DI void post_cached_row(const Params& p, int l, int idx, int lane) {
  const int b = idx >> 9, j = idx & 511;
  const int kr0 = NCTX + b * 4608, krow = kr0 + 4096 + j;
  const size_t cb = ((size_t)(b * 4 + l) * 512 + j);
  bf16_t* KA = (bf16_t*)(p.ws + OFF_KA); bf16_t* VAT = (bf16_t*)(p.ws + OFF_VAT); bf16_t* CKVN = (bf16_t*)(p.ws + OFF_R2); bf16_t* KRB = (bf16_t*)(p.ws + OFF_KRB);
  { const f32x2 v = *(const f32x2*)(p.in[I_CAK] + cb * 128 + lane * 2); *(unsigned*)(KA + (size_t)krow * 128 + lane * 2) = pack2(v.x, v.y); }
  { const f32x2 v = *(const f32x2*)(p.in[I_CAV] + cb * 128 + lane * 2);
    bf16_t* vt = VAT + (size_t)128 * kr0 + (size_t)(lane * 2) * 4608 + perm16(4096 + j);
    vt[0] = f2bf(v.x); vt[4608] = f2bf(v.y); }
  { const f32x2 v = *(const f32x2*)(p.in[I_CCKV] + cb * 128 + lane * 2); *(unsigned*)(CKVN + (size_t)krow * 128 + lane * 2) = pack2(v.x, v.y); }
  if (lane < 32) KRB[(size_t)krow * 32 + lane] = f2bf(p.in[I_CKR][cb * 32 + lane]);
}
DI void phase_post(const Params& p, int l) {
  const int lane = otid() & 63, wid = __builtin_amdgcn_readfirstlane(otid() >> 6);
  for (int item = blockIdx.x; item < NT / 4 + 1024; item += gridDim.x) {
    if (item < NT / 4) post_row(p, l, item * 4 + wid, lane);
    else post_cached_row(p, l, (item - NT / 4) * 4 + wid, lane);
  }
}

DI void phase_upproj(const Params& p, char* smem) {
  const bf16_t* A = (const bf16_t*)(p.ws + OFF_R2);
  const bf16_t* W = (const bf16_t*)(p.ws + OFF_WU);
  bf16_t* KN = (bf16_t*)(p.ws + OFF_KN); bf16_t* VBT = (bf16_t*)(p.ws + OFF_VBT);
  const int ntiles = 352 * 8;
  for (int tile = blockIdx.x; tile < ntiles; tile += gridDim.x) {
    const int mt = tile >> 3, nt = tile & 7, m0 = mt * 128, n0 = nt * 128;
    f32x16 acc[2][2]; zero_acc<2>(acc);
    gemm_mainloop<2>(acc, A + (size_t)m0 * 128, 128, 64, W + (size_t)n0 * 128, 128, 128, smem);
    const int lane = otid() & 63, wid = __builtin_amdgcn_readfirstlane(otid() >> 6), wm = wid >> 1, wn = wid & 1, r = lane & 31, hh = lane >> 5;
    int seq, t0;
    if (m0 < NCTX) { seq = m0 >> 8; t0 = m0 & 255; } else { const int rr = m0 - NCTX; seq = 32 + rr / 4608; t0 = rr % 4608; }
#pragma unroll
    for (int j = 0; j < 2; ++j) {
      const int col = n0 + wn * 64 + j * 32 + r;
      if (n0 < 512) {
#pragma unroll
        for (int i = 0; i < 2; ++i) {
          bf16_t* kp = KN + (size_t)(m0 + wm * 64 + i * 32) * 512;
          const int lo = 4 * hh * 512 + col;
#pragma unroll
          for (int e = 0; e < 16; ++e) (kp + crowu(e) * 512)[lo] = f2bf(acc[i][j][e]);
        }
      } else {
        const int Tk = seq_tk(seq);
        bf16_t* vt = VBT + (size_t)512 * keyrow0(seq) + (size_t)(col - 512) * Tk;
#pragma unroll
        for (int i = 0; i < 2; ++i) {
          const int tt = t0 + wm * 64 + i * 32;
#pragma unroll
          for (int g2 = 0; g2 < 2; ++g2) {
            float v[8];
#pragma unroll
            for (int e = 0; e < 8; ++e) v[e] = acc[i][j][g2 * 8 + e];
            *(u32x4*)(vt + tt + 16 * g2 + 8 * hh) = pack8(v);
          }
        }
      }
    }
  }
}

template <int DQK>
DI void attn_item(const bf16_t* Qw, int q_ld, const bf16_t* K1, int k1_ld, const bf16_t* K2, int k2_ld,
                  const bf16_t* Vt, int vt_ld, int nkeys, bf16_t* Ow, int o_ld, char* smem) {
  constexpr int KS = DQK * 2 + 16;
  constexpr int KBYTES = 64 * KS;
  constexpr int VS = 144;
  constexpr int VBYTES = 64 * VS;
  constexpr int STAGE = KBYTES + VBYTES;
  constexpr int CPR = DQK / 8;
  constexpr int NKC = 64 * CPR / 256;
  constexpr int NS = DQK / 16;
  const int tid = otid(), lane = tid & 63, r = lane & 31, hh = lane >> 5;
  bf16x8 qf[NS];
#pragma unroll
  for (int s = 0; s < NS; ++s) qf[s] = *(const bf16x8*)(Qw + (size_t)r * q_ld + 16 * s + 8 * hh);
  f32x16 o[2];
#pragma unroll
  for (int n = 0; n < 2; ++n)
#pragma unroll
    for (int e = 0; e < 16; ++e) o[n][e] = 0.f;
  float m_run = 0.f, lsum = 0.f;
  u32x4 rk0[NKC], rv0[2], rk1[NKC], rv1[2];
  int krow_[NKC], kc_[NKC];
#pragma unroll
  for (int q = 0; q < NKC; ++q) { const int id = q * 256 + tid; krow_[q] = id / CPR; kc_[q] = id % CPR; }
  const int vrow = tid >> 3, vc = tid & 7;
  auto gload = [&](int key0, u32x4 (&rk)[NKC], u32x4 (&rv)[2]) {
#pragma unroll
    for (int q = 0; q < NKC; ++q) {
      const bf16_t* src = (DQK == 64 || kc_[q] < 8) ? K1 + (size_t)(key0 + krow_[q]) * k1_ld + kc_[q] * 8 : K2 + (size_t)(key0 + krow_[q]) * k2_ld + (kc_[q] - 8) * 8;
      rk[q] = *(const u32x4*)src;
    }
#pragma unroll
    for (int q = 0; q < 2; ++q) rv[q] = *(const u32x4*)(Vt + (size_t)(vrow + 32 * q) * vt_ld + key0 + vc * 8);
  };
  auto lstore = [&](int buf, u32x4 (&rk)[NKC], u32x4 (&rv)[2]) {
    char* base = smem + buf * STAGE;
#pragma unroll
    for (int q = 0; q < NKC; ++q) *(u32x4*)(base + krow_[q] * KS + kc_[q] * 16) = rk[q];
#pragma unroll
    for (int q = 0; q < 2; ++q) *(u32x4*)(base + KBYTES + (vrow + 32 * q) * VS + vc * 16) = rv[q];
  };
  const int ntl = nkeys >> 6;
  gload(0, rk0, rv0); lstore(0, rk0, rv0);
  gload(64, rk1, rv1);
  if (ntl > 2) gload(128, rk0, rv0);
  __syncthreads();
  auto tile_body = [&](int tl, u32x4 (&rkn)[NKC], u32x4 (&rvn)[2]) {
    const char* base = smem + (tl & 1) * STAGE;
    bf16x8 kf[2][NS], vf[2][2][2];
#pragma unroll
    for (int kb = 0; kb < 2; ++kb)
#pragma unroll
      for (int ks = 0; ks < NS; ++ks) kf[kb][ks] = *(const bf16x8*)(base + (kb * 32 + r) * KS + (2 * ks + hh) * 16);
    __builtin_amdgcn_sched_barrier(0);
    f32x16 s[2];
    const float ninit = -m_run;
#pragma unroll
    for (int kb = 0; kb < 2; ++kb)
#pragma unroll
      for (int e = 0; e < 16; ++e) s[kb][e] = ninit;
#pragma unroll
    for (int ks = 0; ks < NS; ++ks)
#pragma unroll
      for (int kb = 0; kb < 2; ++kb) s[kb] = MFMA32(kf[kb][ks], qf[ks], s[kb]);
#pragma unroll
    for (int kb = 0; kb < 2; ++kb)
#pragma unroll
      for (int s2 = 0; s2 < 2; ++s2)
#pragma unroll
        for (int n = 0; n < 2; ++n) vf[kb][s2][n] = *(const bf16x8*)(base + KBYTES + (32 * n + r) * VS + (kb * 32 + 16 * s2 + 8 * hh) * 2);
    __builtin_amdgcn_sched_barrier(0);
    float mx = s[0][0];
#pragma unroll
    for (int kb = 0; kb < 2; ++kb)
#pragma unroll
      for (int e = 0; e < 16; ++e) mx = fmaxf(mx, s[kb][e]);
    { const unsigned u = __float_as_uint(mx); auto sw = __builtin_amdgcn_permlane32_swap(u, u, false, false); mx = fmaxf(__uint_as_float(sw[0]), __uint_as_float(sw[1])); }
    const bool move = (mx > 4.0f) || (mx < -20.0f);
    if (__builtin_amdgcn_ballot_w64(move) != 0ull) {
      const float dlt = move ? mx : 0.f;
      const float alpha = __builtin_amdgcn_exp2f(-dlt);
      m_run += dlt;
      lsum *= alpha;
#pragma unroll
      for (int kb = 0; kb < 2; ++kb)
#pragma unroll
        for (int e = 0; e < 16; ++e) s[kb][e] -= dlt;
#pragma unroll
      for (int n = 0; n < 2; ++n)
#pragma unroll
        for (int e = 0; e < 16; ++e) o[n][e] *= alpha;
    }
    float ps = 0.f;
#pragma unroll
    for (int kb = 0; kb < 2; ++kb)
#pragma unroll
      for (int e = 0; e < 16; ++e) { const float pe = __builtin_amdgcn_exp2f(s[kb][e]); s[kb][e] = pe; ps += pe; }
    lsum += ps;
#pragma unroll
    for (int kb = 0; kb < 2; ++kb)
#pragma unroll
      for (int s2 = 0; s2 < 2; ++s2) {
        u32x4 pw;
        pw.x = pack2(s[kb][8 * s2 + 0], s[kb][8 * s2 + 1]); pw.y = pack2(s[kb][8 * s2 + 2], s[kb][8 * s2 + 3]);
        pw.z = pack2(s[kb][8 * s2 + 4], s[kb][8 * s2 + 5]); pw.w = pack2(s[kb][8 * s2 + 6], s[kb][8 * s2 + 7]);
        const bf16x8 pf = __builtin_bit_cast(bf16x8, pw);
#pragma unroll
        for (int n = 0; n < 2; ++n) o[n] = MFMA32(vf[kb][s2][n], pf, o[n]);
      }
    if (tl + 1 < ntl) { lstore((tl + 1) & 1, rkn, rvn); if (tl + 3 < ntl) gload((tl + 3) * 64, rkn, rvn); }
    __syncthreads();
  };
  for (int tl = 0; tl < ntl; tl += 2) { tile_body(tl, rk1, rv1); tile_body(tl + 1, rk0, rv0); }
  lsum = xsum32(lsum);
  const float inv = 1.0f / lsum;
#pragma unroll
  for (int n = 0; n < 2; ++n)
#pragma unroll
    for (int g = 0; g < 4; ++g) {
      u32x2 w; w.x = pack2(o[n][4 * g] * inv, o[n][4 * g + 1] * inv); w.y = pack2(o[n][4 * g + 2] * inv, o[n][4 * g + 3] * inv);
      *(u32x2*)(Ow + (size_t)r * o_ld + 32 * n + 8 * g + 4 * hh) = w;
    }
}

DI void scan_item(const Params& p, int l, int seq, int hd, int dir, int rs, char* smem) {
  const int tid = otid(), lane = tid & 63, wv = __builtin_amdgcn_readfirstlane(tid >> 6);
  const int j8 = lane & 7, r = lane & 31, hh = lane >> 5;
  const bool lat = seq >= 32;
  const int T = lat ? 4096 : 256;
  const int row0 = lat ? NCTX + (seq - 32) * 4096 : seq * 256;
  float* vA = (float*)smem; float* vK = vA + 2048; float* vR = vK + 2048; float* vV = vR + 2048; float* vW = vV + 2048; float* vB = vW + 2048; float* ybuf = vB + 2048;
  char* raw = smem + 32768;
  char* wdx = smem + 57344; char* adx = smem + 61952;
  float* tmpb = (float*)(smem + 66816);
  const bf16_t* U = (const bf16_t*)(p.ws + OFF_U);
  bf16_t* Y = (bf16_t*)(p.ws + OFF_R2) + (dir ? (size_t)NT * 512 : 0);
  float* bonus = (float*)(p.ws + OFF_BONUS);
  const int lrow = 8 * wv + (lane >> 3), irow = rs * 32 + lrow;
  f32x2 S[4];
  if (lat) {
    const float* s0 = (dir ? opq(p.in[I_SB]) : opq(p.in[I_SF])) + ((size_t)((seq - 32) * 4 + l) * 8 + hd) * 4096 + irow * 64 + j8 * 8;
#pragma unroll
    for (int q = 0; q < 2; ++q) { const f32x4 v = *(const f32x4*)(s0 + 4 * q); S[2 * q] = (f32x2){v.x, v.y}; S[2 * q + 1] = (f32x2){v.z, v.w}; }
  } else {
#pragma unroll
    for (int q = 0; q < 4; ++q) S[q] = (f32x2){0.f, 0.f};
  }
  const int mat = wv >> 1, ntc = wv & 1, cch = ntc * 32 + r, hc = hd * 64 + cch;
  bf16x8 bfrag[4];
  {
    const float* W = (mat ? opq(p.in[I_AUP]) : opq(p.in[I_WUP])) + (size_t)(l * 2 + dir) * 64 * 512 + hc;
#pragma unroll
    for (int s4 = 0; s4 < 4; ++s4) {
      float w8[8];
#pragma unroll
      for (int j = 0; j < 8; ++j) w8[j] = W[(size_t)(16 * s4 + 8 * hh + j) * 512];
      bfrag[s4] = __builtin_bit_cast(bf16x8, pack8(w8));
    }
  }
  const float bias = (mat ? opq(p.in[I_A0]) : opq(p.in[I_W0]))[(l * 2 + dir) * 512 + hc];
  const float kav = p.in[I_KA][l * 512 + hc], rkv = p.in[I_RK][l * 512 + hc];
  float* muP = (float*)(smem + 75008); float* muN = muP + 320; float* kkL = muN + 320;
  {
    const float* mup = p.in[I_MUP] + l * 1792; const float* mun = p.in[I_MUN] + l * 1792;
    for (int e = tid; e < 320; e += 256) { const int g = e >> 6, c = e & 63; const int col = (g < 3 ? g * 512 + hd * 64 : (g == 3 ? 1536 + dir * 64 : 1664 + dir * 64)) + c; muP[e] = mup[col]; muN[e] = mun[col]; }
    if (tid < 64) kkL[tid] = p.in[I_KK][l * 512 + hd * 64 + tid];
  }
  const int nch = T >> 5;
  u32x4 pre[6];
  auto prefetch = [&](int t0) {
#pragma unroll
    for (int q = 0; q < 6; ++q) {
      const int id = q * 256 + tid;
      const int row = id / 40, cc = id - row * 40, g = cc >> 3, c8 = cc & 7;
      const int t = t0 - 1 + row;
      const int col = (g < 3 ? g * 512 + hd * 64 : (g == 3 ? 1536 + dir * 64 : 1664 + dir * 64)) + c8 * 8;
      u32x4 v = (u32x4){0u, 0u, 0u, 0u};
      if (id < 1360 && t >= 0 && t < T) v = *(const u32x4*)(U + (size_t)(row0 + t) * ULD + 1696 + col);
      pre[q] = v;
    }
  };
  prefetch((dir ? nch - 1 : 0) * 32);
  for (int ci = 0; ci < nch; ++ci) {
    const int t0 = (dir ? nch - 1 - ci : ci) * 32;
#pragma unroll
    for (int q = 0; q < 6; ++q) { const int id = q * 256 + tid; if (id < 1360) *(u32x4*)(raw + id * 16) = pre[q]; }
    __syncthreads();
    if (ci + 1 < nch) prefetch((dir ? nch - 2 - ci : ci + 1) * 32);
    {
      const int tt = tid >> 3, sub = tid & 7;
#pragma unroll 1
      for (int g = 0; g < 5; ++g) {
        const int col = (g < 3 ? g * 512 + hd * 64 : (g == 3 ? 1536 + dir * 64 : 1664 + dir * 64)) + sub * 8;
        float c[8], pv[8], nx[8], x[8];
        unpack8(*(const u32x4*)(raw + (tt + 1) * 640 + (g * 8 + sub) * 16), c);
        unpack8(*(const u32x4*)(raw + tt * 640 + (g * 8 + sub) * 16), pv);
        unpack8(*(const u32x4*)(raw + (tt + 2) * 640 + (g * 8 + sub) * 16), nx);
        const f32x4 mp0 = *(const f32x4*)(muP + g * 64 + sub * 8), mp1 = *(const f32x4*)(muP + g * 64 + sub * 8 + 4), mn0 = *(const f32x4*)(muN + g * 64 + sub * 8), mn1 = *(const f32x4*)(muN + g * 64 + sub * 8 + 4);
        const float mp[8] = {mp0.x, mp0.y, mp0.z, mp0.w, mp1.x, mp1.y, mp1.z, mp1.w}, mn[8] = {mn0.x, mn0.y, mn0.z, mn0.w, mn1.x, mn1.y, mn1.z, mn1.w};
#pragma unroll
        for (int i = 0; i < 8; ++i) x[i] = c[i] + mp[i] * (pv[i] - c[i]) + mn[i] * (nx[i] - c[i]);
        const int lo = tt * 64 + sub * 8;
        if (g == 0) { *(f32x4*)(vR + lo) = (f32x4){x[0], x[1], x[2], x[3]}; *(f32x4*)(vR + lo + 4) = (f32x4){x[4], x[5], x[6], x[7]}; }
        else if (g == 1) {
          float kk[8], ss = 0.f;
          const float* kkw = kkL + sub * 8;
#pragma unroll
          for (int i = 0; i < 8; ++i) { kk[i] = x[i] * kkw[i]; ss += kk[i] * kk[i]; }
          *(f32x4*)(vK + lo) = (f32x4){x[0], x[1], x[2], x[3]}; *(f32x4*)(vK + lo + 4) = (f32x4){x[4], x[5], x[6], x[7]};
          ss += shx<1>(ss); ss += shx<2>(ss); ss += shx<4>(ss);
          const float inv = 1.0f / fmaxf(sqrtf(ss), 1e-12f);
          *(f32x4*)(vA + lo) = (f32x4){kk[0] * inv, kk[1] * inv, kk[2] * inv, kk[3] * inv}; *(f32x4*)(vA + lo + 4) = (f32x4){kk[4] * inv, kk[5] * inv, kk[6] * inv, kk[7] * inv};
        }
        else if (g == 2) { *(f32x4*)(vV + lo) = (f32x4){x[0], x[1], x[2], x[3]}; *(f32x4*)(vV + lo + 4) = (f32x4){x[4], x[5], x[6], x[7]}; }
        else if (g == 3) { float th[8]; for (int i = 0; i < 8; ++i) th[i] = 1.0f - 2.0f * __builtin_amdgcn_rcpf(1.0f + __expf(2.0f * x[i])); *(u32x4*)(wdx + tt * 144 + sub * 16) = pack8(th); }
        else { *(u32x4*)(adx + tt * 144 + sub * 16) = pack8(x); }
      }
    }
    __syncthreads();
    {
      f32x16 acc;
#pragma unroll
      for (int e = 0; e < 16; ++e) acc[e] = 0.f;
      const char* xb = mat ? adx : wdx;
#pragma unroll
      for (int s4 = 0; s4 < 4; ++s4) { const bf16x8 af = *(const bf16x8*)(xb + r * 144 + (16 * s4 + 8 * hh) * 2); acc = MFMA32(af, bfrag[s4], acc); }
      if (mat == 0) {
#pragma unroll
        for (int e = 0; e < 16; ++e) vW[crow(e, hh) * 64 + cch] = __expf(-0.6065306597126334f * sigmoidf_(bias + acc[e]));
      } else {
#pragma unroll
        for (int e = 0; e < 16; ++e) {
          const int ix = crow(e, hh) * 64 + cch;
          const float ag = sigmoidf_(bias + acc[e]);
          const float kk = vA[ix], k = vK[ix], rr = vR[ix];
          const float kd = k * (1.0f + (ag - 1.0f) * kav);
          vK[ix] = kd; vA[ix] = -kk; vB[ix] = kk * ag; tmpb[ix] = rr * kd * rkv;
        }
      }
    }
    __syncthreads();
    {
      const int tt = tid >> 3, sub = tid & 7;
      const f32x4 b0 = *(const f32x4*)(tmpb + tt * 64 + sub * 8), b1 = *(const f32x4*)(tmpb + tt * 64 + sub * 8 + 4);
      float bs = (b0.x + b0.y) + (b0.z + b0.w) + (b1.x + b1.y) + (b1.z + b1.w);
      bs += shx<1>(bs); bs += shx<2>(bs); bs += shx<4>(bs);
      if (sub == 0 && rs == 0) bonus[((size_t)(row0 + t0 + tt) * 8 + hd) * 2 + dir] = bs;
    }
    {
      f32x4 va[2], vw[2], vb[2], vk[2], vr[2]; float vi;
      int tt = dir ? 31 : 0;
      int vo = tt * 64 + j8 * 8;
#pragma unroll
      for (int q = 0; q < 2; ++q) { va[q] = *(const f32x4*)(vA + vo + 4 * q); vw[q] = *(const f32x4*)(vW + vo + 4 * q); vb[q] = *(const f32x4*)(vB + vo + 4 * q); vk[q] = *(const f32x4*)(vK + vo + 4 * q); vr[q] = *(const f32x4*)(vR + vo + 4 * q); }
      vi = vV[tt * 64 + irow];
      for (int si = 0; si < 32; ++si) {
        const int ttn = dir ? (si < 31 ? 30 - si : 0) : (si < 31 ? si + 1 : 31);
        const int von = ttn * 64 + j8 * 8;
        f32x2 pa2 = S[0] * (f32x2){va[0].x, va[0].y}, pa3 = S[1] * (f32x2){va[0].z, va[0].w};
        pa2 += S[2] * (f32x2){va[1].x, va[1].y}; pa3 += S[3] * (f32x2){va[1].z, va[1].w};
#pragma unroll
        for (int q = 0; q < 2; ++q) va[q] = *(const f32x4*)(vA + von + 4 * q);
        pa2 += pa3;
        const float sa = osum(pa2.x + pa2.y);
        const f32x2 sa2 = (f32x2){sa, sa}, vi2 = (f32x2){vi, vi};
        f32x2 py2, py3;
        S[0] = S[0] * (f32x2){vw[0].x, vw[0].y} + (sa2 * (f32x2){vb[0].x, vb[0].y} + vi2 * (f32x2){vk[0].x, vk[0].y}); py2 = S[0] * (f32x2){vr[0].x, vr[0].y};
        S[1] = S[1] * (f32x2){vw[0].z, vw[0].w} + (sa2 * (f32x2){vb[0].z, vb[0].w} + vi2 * (f32x2){vk[0].z, vk[0].w}); py3 = S[1] * (f32x2){vr[0].z, vr[0].w};
        S[2] = S[2] * (f32x2){vw[1].x, vw[1].y} + (sa2 * (f32x2){vb[1].x, vb[1].y} + vi2 * (f32x2){vk[1].x, vk[1].y}); py2 += S[2] * (f32x2){vr[1].x, vr[1].y};
        S[3] = S[3] * (f32x2){vw[1].z, vw[1].w} + (sa2 * (f32x2){vb[1].z, vb[1].w} + vi2 * (f32x2){vk[1].z, vk[1].w}); py3 += S[3] * (f32x2){vr[1].z, vr[1].w};
#pragma unroll
        for (int q = 0; q < 2; ++q) { vw[q] = *(const f32x4*)(vW + von + 4 * q); vb[q] = *(const f32x4*)(vB + von + 4 * q); vk[q] = *(const f32x4*)(vK + von + 4 * q); vr[q] = *(const f32x4*)(vR + von + 4 * q); }
        vi = vV[ttn * 64 + irow];
        py2 += py3;
        const float py = osum(py2.x + py2.y);
        ybuf[tt * 32 + lrow] = py;
        tt = ttn;
      }
    }
    __syncthreads();
    {
      const int tt = tid >> 3, sub = tid & 7;
      const f32x4 y0 = *(const f32x4*)(ybuf + tt * 32 + sub * 4);
      u32x2 w; w.x = pack2(y0.x, y0.y); w.y = pack2(y0.z, y0.w);
      *(u32x2*)(Y + (size_t)(row0 + t0 + tt) * 512 + hd * 64 + rs * 32 + sub * 4) = w;
    }
    __syncthreads();
  }
  if (!lat) {
    float* o = opq(p.out) + (dir ? OUT_SB : OUT_SF) + ((size_t)(seq * 4 + l) * 8 + hd) * 4096 + irow * 64 + j8 * 8;
#pragma unroll
    for (int q = 0; q < 2; ++q) *(f32x4*)(o + 4 * q) = (f32x4){S[2 * q].x, S[2 * q].y, S[2 * q + 1].x, S[2 * q + 1].y};
  }
}

DI void phase_mixers(const Params& p, int l, char* smem, int part = 0) {
  const int tid = otid(), wid = __builtin_amdgcn_readfirstlane(tid >> 6);
  unsigned* cnt = (unsigned*)(p.ws + OFF_CNT) + l * 8;
  int* slot = (int*)(smem + SMEM_BYTES - 16);
  bf16_t* U = (bf16_t*)(p.ws + OFF_U);
  const bf16_t* KA = (const bf16_t*)(p.ws + OFF_KA); const bf16_t* VAT = (const bf16_t*)(p.ws + OFF_VAT);
  const bf16_t* KN = (const bf16_t*)(p.ws + OFF_KN); const bf16_t* VBT = (const bf16_t*)(p.ws + OFF_VBT); const bf16_t* KRB = (const bf16_t*)(p.ws + OFF_KRB);
  const int QLEN = 256 + 256 + 128 + 64 + 64;
  bool first = true;
  int xq = blockIdx.x & 7, tries = 0;
  for (;;) {
    int kind, seq, a, qt;
    if (first && blockIdx.x < 256) {
      const int item = blockIdx.x; kind = 0; seq = 32 + (item >> 5); a = (item >> 2) & 7; qt = item & 3;
      first = false;
    } else {
      first = false;
      if (tid == 0) *slot = (int)atomicAdd(cnt + xq, 1u);
      __syncthreads();
      const int i = __builtin_amdgcn_readfirstlane(*slot);
      __syncthreads();
      if (i >= QLEN) { if (++tries >= 8) break; xq = (xq + 1) & 7; continue; }
      if (i < 256) { const int g = xq + 8 * (i >> 7); kind = 1; seq = 32 + (g >> 1); a = g & 1; qt = i & 127; }
      else if (i < 512) { const int j = i - 256; const int g = xq + 8 * (j >> 5); kind = 2; seq = 32 + (g >> 3); a = g & 7; qt = j & 31; }
      else if (i < 640) { const int j = i - 512; kind = 0; seq = xq + 8 * (j >> 5); a = (j >> 2) & 7; qt = j & 3; }
      else if (i < 704) { const int j = i - 640; kind = 1; seq = xq + 8 * (j >> 4); a = (j >> 3) & 1; qt = j & 7; }
      else { const int j = i - 704; kind = 2; seq = xq + 8 * (j >> 4); a = (j >> 1) & 7; qt = j & 1; }
    }
    const int kr0 = keyrow0(seq), Tk = seq_tk(seq);
    const int row0 = seq < 32 ? seq * 256 : NCTX + (seq - 32) * 4096;
    if (kind == 0) scan_item(p, l, seq, a, qt & 1, qt >> 1, smem);
    else if (kind == 1) {
      const int qh = a * 4 + wid;
      bf16_t* q = U + (size_t)(row0 + qt * 32) * ULD + qh * 64;
      attn_item<64>(q, ULD, KA + (size_t)kr0 * 128 + a * 64, 128, nullptr, 0, VAT + (size_t)128 * kr0 + (size_t)(a * 64) * Tk, Tk, Tk, q, ULD, smem);
    } else {
      bf16_t* q = U + (size_t)(row0 + qt * 128 + wid * 32) * ULD + 768 + a * 96;
      attn_item<96>(q, ULD, KN + (size_t)kr0 * 512 + a * 64, 512, KRB + (size_t)kr0 * 32, 32, VBT + (size_t)512 * kr0 + (size_t)(a * 64) * Tk, Tk, Tk, q, ULD, smem);
    }
  }
}

DI void cpost_row(const Params& p, int l, int row, int lane) {
  int seq, t; row_decode(row, seq, t);
  const int T = seq < 32 ? 256 : 4096;
  const bf16_t* YF = (const bf16_t*)(p.ws + OFF_R2); const bf16_t* YB = YF + (size_t)NT * 512;
  bf16_t* u = (bf16_t*)(p.ws + OFF_U) + (size_t)row * ULD + 1696;
  const float* bonus = (const float*)(p.ws + OFF_BONUS);
  float yf[8], yb[8], y[8];
  unpack8(*(const u32x4*)(YF + (size_t)row * 512 + lane * 8), yf);
  unpack8(*(const u32x4*)(YB + (size_t)row * 512 + lane * 8), yb);
  float s = 0.f;
#pragma unroll
  for (int i = 0; i < 8; ++i) { y[i] = yf[i] + yb[i]; s += y[i]; }
  s += shx<1>(s); s += shx<2>(s); s += shx<4>(s);
  const float mu = s * (1.0f / 64.0f);
  float q = 0.f;
#pragma unroll
  for (int i = 0; i < 8; ++i) { y[i] -= mu; q += y[i] * y[i]; }
  q += shx<1>(q); q += shx<2>(q); q += shx<4>(q);
  const float rs = rsqrtf(q * (1.0f / 64.0f) + 64e-5f);
  const int col = 1024 + lane * 8;
  float c[8], pv[8], nx[8];
  unpack8(*(const u32x4*)(u + col), c);
  if (t > 0) unpack8(*(const u32x4*)(u - ULD + col), pv); else { for (int i = 0; i < 8; ++i) pv[i] = 0.f; }
  if (t < T - 1) unpack8(*(const u32x4*)(u + ULD + col), nx); else { for (int i = 0; i < 8; ++i) nx[i] = 0.f; }
  const float* mup = p.in[I_MUP] + l * 1792 + col; const float* mun = p.in[I_MUN] + l * 1792 + col;
  const float* lw = p.in[I_LNW] + l * 512 + lane * 8; const float* lb = p.in[I_LNB] + l * 512 + lane * 8;
  const f32x2 bsv = *(const f32x2*)(bonus + ((size_t)row * 8 + (lane >> 3)) * 2);
  const float bs = bsv.x + bsv.y;
  float o[8];
#pragma unroll
  for (int i = 0; i < 8; ++i) { const float v = c[i] + mup[i] * (pv[i] - c[i]) + mun[i] * (nx[i] - c[i]); o[i] = y[i] * rs * lw[i] + lb[i] + bs * v; }
  *(u32x4*)(u + lane * 8) = pack8(o);
}
DI void phase_renorm_cpost(const Params& p, int l) {
  const int lane = otid() & 63, wid = __builtin_amdgcn_readfirstlane(otid() >> 6);
  for (int item = blockIdx.x; item < NT / 4; item += gridDim.x) { const int row = item * 4 + wid; norm_row(p, l, row, lane); cpost_row(p, l, row, lane); }
}

DI void phase_zgemm(const Params& p, char* smem) {
  const bf16_t* H = (const bf16_t*)(p.ws + OFF_R1);
  const bf16_t* W = (const bf16_t*)(p.ws + OFF_WIN) + (size_t)3584 * 1024;
  bf16_t* U = (bf16_t*)(p.ws + OFF_U);
  const int ntiles = 320 * 12;
  for (int it = 0;; ++it) {
    int mt, nt; if (!next_tile(it, 12, 6, mt, nt)) break;
    const int m0 = mt * 128, n0 = nt * 128;
    f32x16 acc[2][2]; zero_acc<2>(acc);
    gemm_mainloop<2>(acc, H + (size_t)m0 * 1024, 1024, 64, W + (size_t)n0 * 1024, 1024, 1024, smem);
    const int lane = otid() & 63, wid = __builtin_amdgcn_readfirstlane(otid() >> 6), wm = wid >> 1, wn = wid & 1, r = lane & 31, hh = lane >> 5;
#pragma unroll
    for (int j = 0; j < 2; ++j) {
      const int col = n0 + wn * 64 + j * 32 + r;
      const int br = col >> 9, cc = col & 511;
      const int ucol = br == 0 ? cc : (br == 1 ? 768 + (cc >> 6) * 96 + (cc & 63) : 1696 + cc);
#pragma unroll
      for (int i = 0; i < 2; ++i) {
        bf16_t* up = U + (size_t)(m0 + wm * 64 + i * 32) * ULD;
        const int lo = 4 * hh * ULD + ucol;
        bf16_t yv[16];
#pragma unroll
        for (int e = 0; e < 16; ++e) yv[e] = (up + crowu(e) * ULD)[lo];
#pragma unroll
        for (int e = 0; e < 16; ++e) (up + crowu(e) * ULD)[lo] = f2bf(bf2f(yv[e]) * siluf_(acc[i][j][e]));
      }
    }
  }
}

DI void phase_merge(const Params& p, char* smem) {
  const bf16_t* H = (const bf16_t*)(p.ws + OFF_R1);
  const bf16_t* WG = (const bf16_t*)(p.ws + OFF_WIN) + (size_t)5120 * 1024;
  const bf16_t* WO = (const bf16_t*)(p.ws + OFF_WO);
  const bf16_t* U = (const bf16_t*)(p.ws + OFF_U);
  bf16_t* MX = (bf16_t*)(p.ws + OFF_R2);
  const int ntiles = 320 * 8;
  for (int it = 0;; ++it) {
    int mt, nt; if (!next_tile(it, 8, 8, mt, nt)) break;
    const int m0 = mt * 128, n0 = nt * 128;
    f32x16 mix[2][2]; zero_acc<2>(mix);
    unsigned gs[2][2][8];
#pragma unroll 1
    for (int step = 0; step < 6; ++step) {
      const int br = step >> 1, isT = step & 1;
      const int acol = br == 0 ? 0 : (br == 1 ? 768 : 1696);
      const bf16_t* Ap = isT ? U + (size_t)m0 * ULD + acol : H + (size_t)m0 * 1024;
      const bf16_t* Bp = isT ? WO + (size_t)(br * 1024 + n0) * 512 : WG + (size_t)(br * 1024 + n0) * 1024;
      f32x16 cur[2][2]; zero_acc<2>(cur);
      gemm_mainloop<2>(cur, Ap, isT ? ULD : 1024, (isT && br == 1) ? 96 : 64, Bp, isT ? 512 : 1024, isT ? 512 : 1024, smem);
      if (isT) {
#pragma unroll
        for (int i = 0; i < 2; ++i)
#pragma unroll
          for (int j = 0; j < 2; ++j)
#pragma unroll
            for (int e = 0; e < 8; ++e) { mix[i][j][2 * e] += lo16(gs[i][j][e]) * cur[i][j][2 * e]; mix[i][j][2 * e + 1] += hi16(gs[i][j][e]) * cur[i][j][2 * e + 1]; }
      } else {
#pragma unroll
        for (int i = 0; i < 2; ++i)
#pragma unroll
          for (int j = 0; j < 2; ++j)
#pragma unroll
            for (int e = 0; e < 8; ++e) gs[i][j][e] = pack2(sigmoidf_(cur[i][j][2 * e]), sigmoidf_(cur[i][j][2 * e + 1]));
      }
    }
    const int lane = otid() & 63, wid = __builtin_amdgcn_readfirstlane(otid() >> 6), wm = wid >> 1, wn = wid & 1, r = lane & 31, hh = lane >> 5;
#pragma unroll
    for (int j = 0; j < 2; ++j) {
      const int col = n0 + wn * 64 + j * 32 + r;
#pragma unroll
      for (int i = 0; i < 2; ++i) {
        bf16_t* mp = MX + (size_t)(m0 + wm * 64 + i * 32) * 1024;
        const int lo = 4 * hh * 1024 + col;
#pragma unroll
        for (int e = 0; e < 16; ++e) (mp + crowu(e) * 1024)[lo] = f2bf(mix[i][j][e]);
      }
    }
  }
}

DI void phase_out(const Params& p, int l, char* smem) {
  const bf16_t* MX = (const bf16_t*)(p.ws + OFF_R2);
  const bf16_t* W = (const bf16_t*)(p.ws + OFF_WOUT);
  const int ntiles = 320 * 8;
  for (int it = 0;; ++it) {
    int mt, nt; if (!next_tile(it, 8, 8, mt, nt)) break;
    const int m0 = mt * 128, n0 = nt * 128;
    f32x16 acc[2][2]; zero_acc<2>(acc);
    gemm_mainloop<2>(acc, MX + (size_t)m0 * 1024, 1024, 64, W + (size_t)n0 * 1024, 1024, 1024, smem);
    const int lane = otid() & 63, wid = __builtin_amdgcn_readfirstlane(otid() >> 6), wm = wid >> 1, wn = wid & 1, r = lane & 31, hh = lane >> 5;
    const int jm = m0 < NCTX ? 0 : 1 + ((m0 - NCTX) >> 12);
    const float* gate = (const float*)(p.ws + OFF_MOD) + ((size_t)l * 9 + jm) * MODLD + 2048;
    const float* xsrc = x_row_ptr(p, l, m0);
#pragma unroll
    for (int j = 0; j < 2; ++j) {
      const int col = n0 + wn * 64 + j * 32 + r;
      const float gv = gate[col];
      const int lo = 4 * hh * 1024 + col;
#pragma unroll
      for (int i = 0; i < 2; ++i) {
        const float* xs = xsrc + (size_t)(wm * 64 + i * 32) * 1024;
        float* xo = p.out + (size_t)(m0 + wm * 64 + i * 32) * 1024;
        float xv[16];
#pragma unroll
        for (int e = 0; e < 16; ++e) xv[e] = (xs + crowu(e) * 1024)[lo];
#pragma unroll
        for (int e = 0; e < 16; ++e) (xo + crowu(e) * 1024)[lo] = xv[e] + gv * acc[i][j][e];
      }
    }
  }
}

DI void phase_final(const Params& p) {
  const int lane = otid() & 63, wid = __builtin_amdgcn_readfirstlane(otid() >> 6);
  const float* nw = p.in[I_FNW];
  for (int item = blockIdx.x; item < NT / 4; item += gridDim.x) {
    float* x = p.out + (size_t)(item * 4 + wid) * 1024;
    f32x4 v[4]; float ss = 0.f;
#pragma unroll
    for (int i = 0; i < 4; ++i) { v[i] = *(const f32x4*)(x + lane * 4 + 256 * i); ss += v[i].x * v[i].x + v[i].y * v[i].y + v[i].z * v[i].z + v[i].w * v[i].w; }
ss = wave_sum(ss);
    const float rs = rsqrtf(ss * (1.0f / 1024.0f) + 1e-6f);
#pragma unroll
    for (int i = 0; i < 4; ++i) { const f32x4 w = *(const f32x4*)(nw + lane * 4 + 256 * i); *(f32x4*)(x + lane * 4 + 256 * i) = (f32x4){v[i].x * rs * w.x, v[i].y * rs * w.y, v[i].z * rs * w.z, v[i].w * rs * w.w}; }
  }
}

DI void grid_barrier(unsigned* bar, unsigned& epoch) {
  epoch += 1u;
  __syncthreads();
  if (otid() == 0) {
    const unsigned grp = blockIdx.x & 7u, per = gridDim.x >> 3;
    __builtin_amdgcn_fence(__ATOMIC_RELEASE, "agent");
    const unsigned old = __hip_atomic_fetch_add(bar + grp * 32, 1u, __ATOMIC_RELAXED, __HIP_MEMORY_SCOPE_AGENT);
    if (old + 1u == epoch * per) __hip_atomic_fetch_add(bar + 8 * 32, 1u, __ATOMIC_RELAXED, __HIP_MEMORY_SCOPE_AGENT);
    while (__hip_atomic_load(bar + 8 * 32, __ATOMIC_RELAXED, __HIP_MEMORY_SCOPE_AGENT) < epoch * 8u) __builtin_amdgcn_s_sleep(1);
    __builtin_amdgcn_fence(__ATOMIC_ACQUIRE, "agent");
  }
  __syncthreads();
}

constexpr int NPHASES = 1 + 4 * 9 + 1;
__global__ void __launch_bounds__(256, 2) fwd_kernel(Params p0) {
  __shared__ __attribute__((aligned(16))) char smem[SMEM_BYTES];
  cg::grid_group grid = cg::this_grid();
  const int ph_begin = p0.ph_begin, ph_end = p0.ph_end;
  unsigned* bar = (unsigned*)(p0.ws + OFF_BAR);
  unsigned epoch = 0u;
  for (int ph = ph_begin; ph < ph_end; ++ph) {
    auto kp = __builtin_amdgcn_kernarg_segment_ptr();
    asm volatile("" : "+s"(kp));
    typedef const __attribute__((address_space(4))) Params CParams;
    CParams* kpp = (CParams*)kp;
    Params p;
#pragma unroll
    for (int i = 0; i < 35; ++i) p.in[i] = kpp->in[i];
    p.out = kpp->out; p.ws = kpp->ws; p.ph_begin = ph_begin; p.ph_end = ph_end;
    if (ph == 0) phase_prologue(p, smem);
    else if (ph == NPHASES - 1) phase_final(p);
    else {
      const int l = (ph - 1) / 9, sp = (ph - 1) % 9;
#ifdef PROBE_SP
      if (sp == PROBE_SP) {
        switch (sp) {
          case 0: phase_norm_convert(p, l, smem); break;
          case 1: phase_gemm1(p, l, smem); break;
          case 3: phase_upproj(p, smem); break;
          case 5: phase_renorm_cpost(p, l); break;
          case 7: phase_merge(p, smem); break;
          default: break;
        }
        grid.sync();
      }
#endif
      switch (sp) {
        case 0: phase_norm_convert(p, l, smem); break;
        case 1: phase_gemm1(p, l, smem); break;
        case 2: phase_post(p, l); break;
        case 3: phase_upproj(p, smem); break;
        case 4: phase_mixers(p, l, smem); break;
        case 5: phase_renorm_cpost(p, l); break;
        case 6: phase_zgemm(p, smem); break;
        case 7: phase_merge(p, smem); break;
        default: phase_out(p, l, smem); break;
      }
    }
    if (ph + 1 < ph_end) { if (ph == 0) grid.sync(); else grid_barrier(bar, epoch); }
  }
}

extern "C" void kernel_launch(void* const* d_in, const int* in_sizes, int n_in, void* d_out, int out_size, void* d_ws, size_t ws_size, hipStream_t stream) {
  if (ws_size < WS_NEED || n_in < 35) { fprintf(stderr, "workspace too small: %zu < %zu\n", ws_size, WS_NEED); return; }
  static int grid_blocks = 0;
  if (!grid_blocks) {
    int dev = 0, cus = 0, per_cu = 0;
    hipGetDevice(&dev);
    hipDeviceGetAttribute(&cus, hipDeviceAttributeMultiprocessorCount, dev);
    hipOccupancyMaxActiveBlocksPerMultiprocessor(&per_cu, fwd_kernel, 256, 0);
    if (per_cu < 1) per_cu = 1;
    if (per_cu > 2) per_cu = 2;
    grid_blocks = cus * per_cu;
  }
  Params p{};
  for (int i = 0; i < 35; ++i) p.in[i] = (const float*)d_in[i];
  p.out = (float*)d_out; p.ws = (char*)d_ws;
#ifndef ONE_LAUNCH
  for (int ph = 0; ph < NPHASES; ++ph) {
    p.ph_begin = ph; p.ph_end = ph + 1;
    hipLaunchKernelGGL(fwd_kernel, dim3(grid_blocks), dim3(256), 0, stream, p);
  }
#else
  p.ph_begin = 0; p.ph_end = NPHASES;
  hipMemsetAsync((char*)d_ws + OFF_BAR, 0, 4096, stream);
  void* args[] = {&p};
  hipError_t e = hipLaunchCooperativeKernel((void*)fwd_kernel, dim3(grid_blocks), dim3(256), args, 0, stream);
  if (e != hipSuccess) fprintf(stderr, "cooperative launch failed: %s (grid %d)\n", hipGetErrorString(e), grid_blocks);
#endif
}
```

```cpp
#define ONE_LAUNCH 1
#include <hip/hip_runtime.h>
#include <hip/hip_cooperative_groups.h>
#include <stdint.h>
#include <stdio.h>
namespace cg = cooperative_groups;

typedef unsigned short bf16_t;
typedef short bf16x8 __attribute__((ext_vector_type(8)));
typedef float f32x16 __attribute__((ext_vector_type(16)));
typedef float f32x4 __attribute__((ext_vector_type(4)));
typedef float f32x2 __attribute__((ext_vector_type(2)));
typedef unsigned u32x4 __attribute__((ext_vector_type(4)));
typedef unsigned u32x2 __attribute__((ext_vector_type(2)));
#define DI __device__ __forceinline__
#define MFMA32(a, b, c) __builtin_amdgcn_mfma_f32_32x32x16_bf16((a), (b), (c), 0, 0, 0)

constexpr int NT = 40960;
constexpr int NCTX = 8192;
constexpr int NK = 45056;
constexpr int ULD = 3488;
constexpr int MODLD = 3072;
constexpr int SMEM_BYTES = 78848;

constexpr size_t OFF_WIN = 0;
constexpr size_t OFF_WO = 16777216;
constexpr size_t OFF_WOUT = 19922944;
constexpr size_t OFF_WU = 22020096;
constexpr size_t OFF_MOD = 22282240;
constexpr size_t OFF_BONUS = 22724608;
constexpr size_t OFF_CS16 = 25346048;
constexpr size_t OFF_CS8 = 25354240;
constexpr size_t OFF_CNT = 25358336;
constexpr size_t OFF_BAR = 524742912;
constexpr size_t OFF_U = 25358592;
constexpr size_t OFF_R1 = 311095552;
constexpr size_t OFF_KA = OFF_R1;
constexpr size_t OFF_VAT = 513208576;
constexpr size_t OFF_KN = OFF_R1 + 23068672;
constexpr size_t OFF_VBT = OFF_R1 + 69206016;
constexpr size_t OFF_KRB = OFF_R1 + 115343360;
constexpr size_t OFF_R2 = 429322496;
constexpr size_t WS_NEED = 524742912 + 4096;

constexpr size_t OUT_AK = 41943040, OUT_AV = 46137344, OUT_CKV = 50331648, OUT_KR = 54525952, OUT_SF = 55574528, OUT_SB = 59768832;

struct Params {
  const float* in[35];
  float* out;
  char* ws;
  int ph_begin, ph_end;
};

enum { I_XP = 0, I_XS, I_CAK, I_CAV, I_CCKV, I_CKR, I_SF, I_SB, I_C, I_CCTX, I_NORMW, I_WMOD, I_BMOD, I_WIN, I_QNW, I_KNW, I_KVNW,
       I_WUK, I_WUV, I_MUP, I_MUN, I_W0, I_WUP, I_A0, I_AUP, I_KK, I_KA, I_RK, I_LNW, I_LNB, I_WOA, I_WOB, I_WOC, I_WOUT, I_FNW };

DI int threadIdx_x_raw() { return __builtin_amdgcn_workitem_id_x(); }
DI int otid() { int t = threadIdx_x_raw(); asm volatile("" : "+v"(t)); return t; }
DI const float* opq(const float* q) { asm volatile("" : "+s"(q)); return q; }
DI float* opq(float* q) { asm volatile("" : "+s"(q)); return q; }
DI float bf2f(bf16_t v) { return __uint_as_float(((unsigned)v) << 16); }
typedef __bf16 hbf16x2 __attribute__((ext_vector_type(2)));
DI unsigned pack2(float a, float b) { f32x2 v = {a, b}; hbf16x2 r = __builtin_convertvector(v, hbf16x2); return __builtin_bit_cast(unsigned, r); }
DI bf16_t f2bf(float x) { return (bf16_t)(pack2(x, 0.f) & 0xffffu); }
DI float xsum16(float x) { const unsigned u = __float_as_uint(x); auto r = __builtin_amdgcn_permlane16_swap(u, u, false, false); return __uint_as_float(r[0]) + __uint_as_float(r[1]); }
DI float xsum32(float x) { const unsigned u = __float_as_uint(x); auto r = __builtin_amdgcn_permlane32_swap(u, u, false, false); return __uint_as_float(r[0]) + __uint_as_float(r[1]); }
DI float lo16(unsigned w) { return __uint_as_float(w << 16); }
DI float hi16(unsigned w) { return __uint_as_float(w & 0xffff0000u); }
DI void unpack8(u32x4 w, float* v) { v[0] = lo16(w.x); v[1] = hi16(w.x); v[2] = lo16(w.y); v[3] = hi16(w.y); v[4] = lo16(w.z); v[5] = hi16(w.z); v[6] = lo16(w.w); v[7] = hi16(w.w); }
DI u32x4 pack8(const float* v) { u32x4 w; w.x = pack2(v[0], v[1]); w.y = pack2(v[2], v[3]); w.z = pack2(v[4], v[5]); w.w = pack2(v[6], v[7]); return w; }
template <int K> DI float shx(float v) { return __int_as_float(__builtin_amdgcn_ds_swizzle(__float_as_int(v), 0x1f | (K << 10))); }
DI float wave_sum(float v) { v += shx<1>(v); v += shx<2>(v); v += shx<4>(v); v += shx<8>(v); v += shx<16>(v); return xsum32(v); }
DI float qsum(float v) {
  v += __int_as_float(__builtin_amdgcn_update_dpp(0, __float_as_int(v), 0xB1, 0xf, 0xf, true));
  v += __int_as_float(__builtin_amdgcn_update_dpp(0, __float_as_int(v), 0x4E, 0xf, 0xf, true));
  return v;
}
DI float osum(float v) {
  v = qsum(v);
  v += __int_as_float(__builtin_amdgcn_update_dpp(0, __float_as_int(v), 0x141, 0xf, 0xf, true));
  return v;
}
DI int crow(int reg, int h) { return (reg & 3) + 8 * (reg >> 2) + 4 * h; }
DI int crowu(int reg) { return (reg & 3) + 8 * (reg >> 2); }
DI int perm16(int t) { return (t & ~12) | ((t & 4) << 1) | ((t & 8) >> 1); }
DI float sigmoidf_(float x) { return __builtin_amdgcn_rcpf(1.0f + __expf(-x)); }
DI float siluf_(float x) { return x * __builtin_amdgcn_rcpf(1.0f + __expf(-x)); }

DI void row_decode(int row, int& seq, int& t) {
  if (row < NCTX) { seq = row >> 8; t = row & 255; } else { seq = 32 + ((row - NCTX) >> 12); t = (row - NCTX) & 4095; }
}
DI int keyrow0(int seq) { return seq < 32 ? seq * 256 : NCTX + (seq - 32) * 4608; }
DI int seq_tk(int seq) { return seq < 32 ? 256 : 4608; }

typedef __attribute__((address_space(3))) unsigned lds_u32;
template <int NJ>
DI void gemm_mainloop(f32x16 (&acc)[2][NJ], const bf16_t* __restrict__ A, int lda, int ks,
                      const bf16_t* __restrict__ Bt, int ldb, int K, char* smem) {
  constexpr int A_BYTES = 128 * 128;
  constexpr int B_BYTES = 64 * NJ * 128;
  constexpr int STAGE = A_BYTES + B_BYTES;
  const int tid = otid(), lane = tid & 63, wid = __builtin_amdgcn_readfirstlane(tid >> 6), wm = wid >> 1, wn = wid & 1;
  const int r = lane & 31, hh = lane >> 5;
  const int nk = K >> 6;
  const int lrow = tid >> 3, lc = tid & 7;
  const int gc = (lc ^ ((lrow >> 1) & 7)) * 8;
  const bf16_t* ap = A + (size_t)lrow * lda + gc;
  const bf16_t* bp = Bt + (size_t)lrow * ldb + gc;
  auto issue = [&](int kt, int buf) {
    char* base = smem + buf * STAGE + tid * 16;
    const bf16_t* ap2 = ap + (size_t)kt * ks;
    const bf16_t* bp2 = bp + (size_t)kt * 64;
#pragma unroll
    for (int p = 0; p < 4; ++p) __builtin_amdgcn_global_load_lds((const unsigned*)(ap2 + (size_t)(32 * p) * lda), (lds_u32*)(base + p * 4096), 16, 0, 0);
#pragma unroll
    for (int p = 0; p < 2 * NJ; ++p) __builtin_amdgcn_global_load_lds((const unsigned*)(bp2 + (size_t)(32 * p) * ldb), (lds_u32*)(base + A_BYTES + p * 4096), 16, 0, 0);
  };
  issue(0, 0);
  __syncthreads();
#pragma unroll 1
  for (int kt = 0; kt < nk; ++kt) {
    if (kt + 1 < nk) issue(kt + 1, (kt + 1) & 1);
    const char* base = smem + (kt & 1) * STAGE;
#pragma unroll
    for (int s = 0; s < 4; ++s) {
      bf16x8 af[2], bfr[NJ];
#pragma unroll
      for (int i = 0; i < 2; ++i) { const int row = wm * 64 + i * 32 + r; af[i] = *(const bf16x8*)(base + row * 128 + (((2 * s + hh) ^ ((row >> 1) & 7)) << 4)); }
#pragma unroll
      for (int j = 0; j < NJ; ++j) { const int row = wn * (32 * NJ) + j * 32 + r; bfr[j] = *(const bf16x8*)(base + A_BYTES + row * 128 + (((2 * s + hh) ^ ((row >> 1) & 7)) << 4)); }
#pragma unroll
      for (int i = 0; i < 2; ++i)
#pragma unroll
        for (int j = 0; j < NJ; ++j) acc[i][j] = MFMA32(af[i], bfr[j], acc[i][j]);
    }
    __syncthreads();
  }
}

template <int NJ> DI void zero_acc(f32x16 (&acc)[2][NJ]) {
#pragma unroll
  for (int i = 0; i < 2; ++i)
#pragma unroll
    for (int j = 0; j < NJ; ++j)
#pragma unroll
      for (int e = 0; e < 16; ++e) acc[i][j][e] = 0.f;
}

DI void phase_prologue(const Params& p, char* smem) {
  const int tid = otid(), lane = tid & 63, wid = __builtin_amdgcn_readfirstlane(tid >> 6);
  float* mod = (float*)(p.ws + OFF_MOD);
  if (blockIdx.x == 0) {
    if (tid < 32) ((unsigned*)(p.ws + OFF_CNT))[tid] = 0u;
    float* cs16 = (float*)(p.ws + OFF_CS16);
    float* cs8 = (float*)(p.ws + OFF_CS8);
    for (int e = tid; e < 64 * 16; e += 256) { const int pos = e >> 4, i = e & 15; const float inv = expf(-9.210340371976184f * (float)i / 16.0f); const float a = (float)pos * inv; cs16[e * 2] = cosf(a); cs16[e * 2 + 1] = sinf(a); }
    for (int e = tid; e < 64 * 8; e += 256) { const int pos = e >> 3, i = e & 7; const float inv = expf(-9.210340371976184f * (float)i / 8.0f); const float a = (float)pos * inv; cs8[e * 2] = cosf(a); cs8[e * 2 + 1] = sinf(a); }
  }
  float* sl = (float*)smem;
  float* red = sl + 9 * 1024;
  for (int e = tid; e < 9 * 1024; e += 256) { const int j = e >> 10, k = e & 1023; const float* cc0 = opq(p.in[I_CCTX]); const float* cc1 = opq(p.in[I_C]); const float c = j == 0 ? cc0[k] : cc1[(j - 1) * 1024 + k]; sl[e] = siluf_(c); }
  __syncthreads();
  for (int item = blockIdx.x; item < 192; item += gridDim.x) {
    const int l = item / 48, n = (item % 48) * 64 + lane;
    const float* w = p.in[I_WMOD] + (size_t)l * 1024 * 3072 + n;
    float a[9];
#pragma unroll
    for (int j = 0; j < 9; ++j) a[j] = 0.f;
    for (int k = wid * 256; k < wid * 256 + 256; ++k) {
      const float wv = w[(size_t)k * 3072];
#pragma unroll
      for (int j = 0; j < 9; ++j) a[j] += sl[j * 1024 + k] * wv;
    }
#pragma unroll
    for (int j = 0; j < 9; ++j) red[(wid * 9 + j) * 64 + lane] = a[j];
    __syncthreads();
    for (int e = tid; e < 9 * 64; e += 256) {
      const int j = e >> 6, c = e & 63;
      const float s = red[(0 * 9 + j) * 64 + c] + red[(1 * 9 + j) * 64 + c] + red[(2 * 9 + j) * 64 + c] + red[(3 * 9 + j) * 64 + c];
      const int nn = (item % 48) * 64 + c;
      mod[((size_t)l * 9 + j) * MODLD + nn] = s + p.in[I_BMOD][l * 3072 + nn];
    }
    __syncthreads();
  }
}

DI const float* x_row_ptr(const Params& p, int l, int row) {
  const float* xp = opq(p.in[I_XP]); const float* xs = opq(p.in[I_XS]); const float* xo = opq((const float*)p.out);
  if (l == 0) return row < NCTX ? xp + (size_t)row * 1024 : xs + (size_t)(row - NCTX) * 1024;
  return xo + (size_t)row * 1024;
}
DI void norm_row(const Params& p, int l, int row, int lane) {
  const float* x = x_row_ptr(p, l, row);
  const int j = row < NCTX ? 0 : 1 + ((row - NCTX) >> 12);
  const float* mod = (const float*)(p.ws + OFF_MOD) + ((size_t)l * 9 + j) * MODLD;
  const float* nw = p.in[I_NORMW] + l * 1024;
  bf16_t* h = (bf16_t*)(p.ws + OFF_R1) + (size_t)row * 1024;
  f32x4 v[4]; float ss = 0.f;
#pragma unroll
  for (int i = 0; i < 4; ++i) { v[i] = *(const f32x4*)(x + lane * 4 + 256 * i); ss += v[i].x * v[i].x + v[i].y * v[i].y + v[i].z * v[i].z + v[i].w * v[i].w; }
ss = wave_sum(ss);
  const float rs = rsqrtf(ss * (1.0f / 1024.0f) + 1e-6f);
#pragma unroll
  for (int i = 0; i < 4; ++i) {
    const int c = lane * 4 + 256 * i;
    const f32x4 w = *(const f32x4*)(nw + c), sh = *(const f32x4*)(mod + c), sc = *(const f32x4*)(mod + 1024 + c);
    u32x2 o;
    o.x = pack2(v[i].x * rs * w.x * (1.f + sc.x) + sh.x, v[i].y * rs * w.y * (1.f + sc.y) + sh.y);
    o.y = pack2(v[i].z * rs * w.z * (1.f + sc.z) + sh.z, v[i].w * rs * w.w * (1.f + sc.w) + sh.w);
    *(u32x2*)(h + c) = o;
  }
}

DI int win_srccol(int j) {
  if (j < 768) return j;
  if (j < 1696) return j + 512;
  if (j < 3488) return j + 1024;
  if (j < 3584) return -1;
  if (j < 5120) { const int jj = j - 3584; return jj < 512 ? 768 + jj : (jj < 1024 ? 2208 + (jj - 512) : 4512 + (jj - 1024)); }
  return 5024 + (j - 5120);
}
DI void conv_tile(const float* __restrict__ src, int ld_src, bf16_t* dst, int ld_dst, int k0, int n0, int kind, int srcoff, char* smem) {
  float* tile = (float*)smem;
  const int tid = otid();
  const int n = tid & 63;
  int sc = kind == 0 ? win_srccol(n0 + n) : (n0 + n - srcoff);
#pragma unroll
  for (int i = 0; i < 16; ++i) { const int k = i * 4 + (tid >> 6); tile[k * 65 + n] = sc >= 0 ? src[(size_t)(k0 + k) * ld_src + sc] : 0.f; }
  __syncthreads();
#pragma unroll
  for (int i = 0; i < 8; ++i) { const int nn = i * 8 + (tid >> 5), kk = (tid & 31) * 2; *(unsigned*)(dst + (size_t)(n0 + nn) * ld_dst + k0 + kk) = pack2(tile[kk * 65 + nn], tile[(kk + 1) * 65 + nn]); }
  __syncthreads();
}

DI void phase_norm_convert(const Params& p, int l, char* smem) {
  const int tid = otid(), lane = tid & 63, wid = __builtin_amdgcn_readfirstlane(tid >> 6);
  bf16_t* WinT = (bf16_t*)(p.ws + OFF_WIN); bf16_t* WoT = (bf16_t*)(p.ws + OFF_WO); bf16_t* WoutT = (bf16_t*)(p.ws + OFF_WOUT); bf16_t* WuT = (bf16_t*)(p.ws + OFF_WU);
  const int NI_WIN = 128 * 16, NI_WO = 3 * 16 * 8, NI_WOUT = 16 * 16, NI_WU = 16 * 2;
  const int NI_CONV = NI_WIN + NI_WO + NI_WOUT + NI_WU;
  for (int item = blockIdx.x; item < NI_CONV; item += gridDim.x) {
    int it = item;
    if (it < NI_WIN) { conv_tile(p.in[I_WIN] + (size_t)l * 1024 * 8096, 8096, WinT, 1024, (it & 15) * 64, (it >> 4) * 64, 0, 0, smem); continue; }
    it -= NI_WIN;
    if (it < NI_WO) { const int br = it / 128, r2 = it % 128; const float* src = (br == 0 ? opq(p.in[I_WOA]) : (br == 1 ? opq(p.in[I_WOB]) : opq(p.in[I_WOC]))) + (size_t)l * 512 * 1024; conv_tile(src, 1024, WoT + (size_t)br * 1024 * 512, 512, (r2 & 7) * 64, (r2 >> 3) * 64, 1, 0, smem); continue; }
    it -= NI_WO;
    if (it < NI_WOUT) { conv_tile(p.in[I_WOUT] + (size_t)l * 1024 * 1024, 1024, WoutT, 1024, (it & 15) * 64, (it >> 4) * 64, 1, 0, smem); continue; }
    it -= NI_WOUT;
    { const int nt = it >> 1, kt = it & 1; const bool uv = nt >= 8; const float* src = (uv ? opq(p.in[I_WUV]) : opq(p.in[I_WUK])) + (size_t)l * 128 * 512; conv_tile(src, 512, WuT, 128, kt * 64, nt * 64, 1, uv ? 512 : 0, smem); }
  }
  for (int item = blockIdx.x; item < NT / 4; item += gridDim.x) norm_row(p, l, item * 4 + wid, lane);
}

DI bool next_tile(int it, int NTN, int GN, int& mt, int& nt, int MPX = 40, int GM = 8) {
  if (gridDim.x == 512) {
    const int x = blockIdx.x & 7, local = blockIdx.x >> 3;
    const int q = it * 64 + local;
    if (q >= MPX * NTN) return false;
    const int gsz = GM * GN, g = q / gsz, w = q - g * gsz, ngroups = NTN / GN;
    const int mgi = g / ngroups, ngi = g - mgi * ngroups;
    mt = x * MPX + mgi * GM + w / GN; nt = ngi * GN + (w % GN);
    return true;
  }
  const int tile = blockIdx.x + it * gridDim.x;
  if (tile >= 8 * MPX * NTN) return false;
  mt = tile / NTN; nt = tile % NTN;
  return true;
}

DI void phase_gemm1(const Params& p, int l, char* smem) {
  const bf16_t* H = (const bf16_t*)(p.ws + OFF_R1);
  const bf16_t* W = (const bf16_t*)(p.ws + OFF_WIN);
  bf16_t* U = (bf16_t*)(p.ws + OFF_U);
  bf16_t* VAT = (bf16_t*)(p.ws + OFF_VAT);
  const int NTN = 28, ntiles = 320 * NTN;
  for (int it = 0;; ++it) {
    int mt, nt; if (!next_tile(it, NTN, 7, mt, nt)) break;
    const int m0 = mt * 128, n0 = nt * 128;
    f32x16 acc[2][2]; zero_acc<2>(acc);
    gemm_mainloop<2>(acc, H + (size_t)m0 * 1024, 1024, 64, W + (size_t)n0 * 1024, 1024, 1024, smem);
    const int lane = otid() & 63, wid = __builtin_amdgcn_readfirstlane(otid() >> 6), wm = wid >> 1, wn = wid & 1, r = lane & 31, hh = lane >> 5;
    int seq, t0; row_decode(m0, seq, t0);
#pragma unroll
    for (int j = 0; j < 2; ++j) {
      const int cb = n0 + wn * 64 + j * 32;
      if (cb >= ULD) continue;
      const int col = cb + r;
      if (cb >= 640 && cb < 768) {
        const int kvh = (col - 640) >> 6, dv = col & 63, Tk = seq_tk(seq);
        bf16_t* vt = VAT + (size_t)128 * keyrow0(seq) + (size_t)(kvh * 64 + dv) * Tk;
#pragma unroll
        for (int i = 0; i < 2; ++i) {
          const int tt = t0 + wm * 64 + i * 32;
#pragma unroll
          for (int g2 = 0; g2 < 2; ++g2) {
            float v[8];
#pragma unroll
            for (int e = 0; e < 8; ++e) v[e] = acc[i][j][g2 * 8 + e];
            *(u32x4*)(vt + tt + 16 * g2 + 8 * hh) = pack8(v);
          }
          if (seq < 32) {
            float* o = p.out + OUT_AV + ((size_t)(seq * 4 + l) * 256 + tt) * 128;
            const int lo = 4 * hh * 128 + (col - 640);
#pragma unroll
            for (int e = 0; e < 16; ++e) (o + crowu(e) * 128)[lo] = acc[i][j][e];
          }
        }
      } else {
#pragma unroll
        for (int i = 0; i < 2; ++i) {
          bf16_t* up = U + (size_t)(m0 + wm * 64 + i * 32) * ULD;
          const int lo = 4 * hh * ULD + col;
#pragma unroll
          for (int e = 0; e < 16; ++e) (up + crowu(e) * ULD)[lo] = f2bf(acc[i][j][e]);
        }
      }
    }
  }
}

DI void post_row(const Params& p, int l, int row, int lane) {
  int seq, t; row_decode(row, seq, t);
  const bool lat = row >= NCTX;
  const int krow = keyrow0(seq) + t;
  const int prow = t >> 6, pcol = t & 63;
  bf16_t* u = (bf16_t*)(p.ws + OFF_U) + (size_t)row * ULD;
  const float* cs16 = (const float*)(p.ws + OFF_CS16);
  const float* cs8 = (const float*)(p.ws + OFF_CS8);
  const float LOG2E = 1.4426950408889634f;
#pragma unroll
  for (int which = 0; which < 2; ++which) {
    const int l8 = which == 0 ? lane : (lane & 15);
    const bf16_t* src = u + (which == 0 ? 0 : 512) + l8 * 8;
    float v[8]; unpack8(*(const u32x4*)src, v);
    float ss = 0.f;
#pragma unroll
    for (int i = 0; i < 8; ++i) ss += v[i] * v[i];
    ss += shx<1>(ss); ss += shx<2>(ss); ss += shx<4>(ss);
    const float rs = rsqrtf(ss * (1.0f / 64.0f) + 1e-6f);
    const float* nw = (which == 0 ? opq(p.in[I_QNW]) : opq(p.in[I_KNW])) + l * 64 + (lane & 7) * 8;
#pragma unroll
    for (int i = 0; i < 8; ++i) v[i] = v[i] * rs * nw[i];
    float pv[8];
#pragma unroll
    for (int i = 0; i < 8; ++i) pv[i] = shx<2>(v[i]);
    if (lat) {
      const int pos = ((lane & 7) >> 2) ? pcol : prow;
      const bool lower = (lane & 2) == 0;
      const float* cs = cs16 + (pos * 16 + (lane & 1) * 8) * 2;
#pragma unroll
      for (int i = 0; i < 8; ++i) { const float c = cs[i * 2], s = cs[i * 2 + 1]; v[i] = lower ? v[i] * c - pv[i] * s : v[i] * c + pv[i] * s; }
    }
    if (which == 0) {
      const float sc = 0.125f * LOG2E;
#pragma unroll
      for (int i = 0; i < 8; ++i) v[i] *= sc;
      *(u32x4*)(u + lane * 8) = pack8(v);
    } else if (lane < 16) {
      bf16_t* KA = (bf16_t*)(p.ws + OFF_KA);
      *(u32x4*)(KA + (size_t)krow * 128 + lane * 8) = pack8(v);
      if (!lat) {
        float* o = p.out + OUT_AK + ((size_t)(seq * 4 + l) * 256 + t) * 128 + lane * 8;
        *(f32x4*)o = (f32x4){v[0], v[1], v[2], v[3]}; *(f32x4*)(o + 4) = (f32x4){v[4], v[5], v[6], v[7]};
      }
    }
  }
  {
    const float sc = 0.10206207261596577f * LOG2E;
    const int hd = lane >> 3;
    bf16_t* q = u + 768 + hd * 96;
    { float v[8]; unpack8(*(const u32x4*)(q + (lane & 7) * 8), v);
#pragma unroll
      for (int i = 0; i < 8; ++i) v[i] *= sc;
      *(u32x4*)(q + (lane & 7) * 8) = pack8(v); }
    { bf16_t* qr = q + 64 + (lane & 7) * 4;
      const u32x2 w = *(const u32x2*)qr;
      float v[4] = {lo16(w.x), hi16(w.x), lo16(w.y), hi16(w.y)}, pv[4];
#pragma unroll
      for (int i = 0; i < 4; ++i) pv[i] = shx<2>(v[i]);
      if (lat) {
        const int pos = ((lane & 7) >> 2) ? pcol : prow;
        const bool lower = (lane & 2) == 0;
        const float* cs = cs8 + (pos * 8 + (lane & 1) * 4) * 2;
#pragma unroll
        for (int i = 0; i < 4; ++i) { const float c = cs[i * 2], s = cs[i * 2 + 1]; v[i] = lower ? v[i] * c - pv[i] * s : v[i] * c + pv[i] * s; }
      }
      u32x2 o; o.x = pack2(v[0] * sc, v[1] * sc); o.y = pack2(v[2] * sc, v[3] * sc);
      *(u32x2*)qr = o; }
  }
  {
    const unsigned w = *(const unsigned*)(u + 1536 + lane * 2);
    float a = lo16(w), b = hi16(w);
    float ss = a * a + b * b;
ss = wave_sum(ss);
    const float rs = rsqrtf(ss * (1.0f / 128.0f) + 1e-6f);
    const float* nw = p.in[I_KVNW] + l * 128 + lane * 2;
    a = a * rs * nw[0]; b = b * rs * nw[1];
    bf16_t* CKVN = (bf16_t*)(p.ws + OFF_R2);
    *(unsigned*)(CKVN + (size_t)krow * 128 + lane * 2) = pack2(a, b);
    if (!lat) { float* o = p.out + OUT_CKV + ((size_t)(seq * 4 + l) * 256 + t) * 128 + lane * 2; *(f32x2*)o = (f32x2){a, b}; }
  }
  {
    float v = bf2f(u[1664 + (lane & 31)]);
    const float pv = shx<8>(v);
    if (!lat) { if (lane < 32) p.out[OUT_KR + ((size_t)(seq * 4 + l) * 256 + t) * 32 + lane] = v; }
    else {
      const int d = lane & 31; const int pos = (d >> 4) ? pcol : prow; const bool lower = (d & 8) == 0;
      const float* cs = cs8 + (pos * 8 + (d & 7)) * 2;
      v = lower ? v * cs[0] - pv * cs[1] : v * cs[0] + pv * cs[1];
    }
    if (lane < 32) ((bf16_t*)(p.ws + OFF_KRB))[(size_t)krow * 32 + lane] = f2bf(v);
  }
}
DI void post_cached_row(const Params& p, int l, int idx, int lane) {
  const int b = idx >> 9, j = idx & 511;
  const int kr0 = NCTX + b * 4608, krow = kr0 + 4096 + j;
  const size_t cb = ((size_t)(b * 4 + l) * 512 + j);
  bf16_t* KA = (bf16_t*)(p.ws + OFF_KA); bf16_t* VAT = (bf16_t*)(p.ws + OFF_VAT); bf16_t* CKVN = (bf16_t*)(p.ws + OFF_R2); bf16_t* KRB = (bf16_t*)(p.ws + OFF_KRB);
  { const f32x2 v = *(const f32x2*)(p.in[I_CAK] + cb * 128 + lane * 2); *(unsigned*)(KA + (size_t)krow * 128 + lane * 2) = pack2(v.x, v.y); }
  { const f32x2 v = *(const f32x2*)(p.in[I_CAV] + cb * 128 + lane * 2);
    bf16_t* vt = VAT + (size_t)128 * kr0 + (size_t)(lane * 2) * 4608 + perm16(4096 + j);
    vt[0] = f2bf(v.x); vt[4608] = f2bf(v.y); }
  { const f32x2 v = *(const f32x2*)(p.in[I_CCKV] + cb * 128 + lane * 2); *(unsigned*)(CKVN + (size_t)krow * 128 + lane * 2) = pack2(v.x, v.y); }
  if (lane < 32) KRB[(size_t)krow * 32 + lane] = f2bf(p.in[I_CKR][cb * 32 + lane]);
}
DI void phase_post(const Params& p, int l) {
  const int lane = otid() & 63, wid = __builtin_amdgcn_readfirstlane(otid() >> 6);
  for (int item = blockIdx.x; item < NT / 4 + 1024; item += gridDim.x) {
    if (item < NT / 4) post_row(p, l, item * 4 + wid, lane);
    else post_cached_row(p, l, (item - NT / 4) * 4 + wid, lane);
  }
}

DI void phase_upproj(const Params& p, char* smem) {
  const bf16_t* A = (const bf16_t*)(p.ws + OFF_R2);
  const bf16_t* W = (const bf16_t*)(p.ws + OFF_WU);
  bf16_t* KN = (bf16_t*)(p.ws + OFF_KN); bf16_t* VBT = (bf16_t*)(p.ws + OFF_VBT);
  const int ntiles = 352 * 8;
  for (int it = 0;; ++it) {
    int mt, nt; if (!next_tile(it, 8, 8, mt, nt, 44, 4)) break;
    const int m0 = mt * 128, n0 = nt * 128;
    f32x16 acc[2][2]; zero_acc<2>(acc);
    gemm_mainloop<2>(acc, A + (size_t)m0 * 128, 128, 64, W + (size_t)n0 * 128, 128, 128, smem);
    const int lane = otid() & 63, wid = __builtin_amdgcn_readfirstlane(otid() >> 6), wm = wid >> 1, wn = wid & 1, r = lane & 31, hh = lane >> 5;
    int seq, t0;
    if (m0 < NCTX) { seq = m0 >> 8; t0 = m0 & 255; } else { const int rr = m0 - NCTX; seq = 32 + rr / 4608; t0 = rr % 4608; }
#pragma unroll
    for (int j = 0; j < 2; ++j) {
      const int col = n0 + wn * 64 + j * 32 + r;
      if (n0 < 512) {
#pragma unroll
        for (int i = 0; i < 2; ++i) {
          bf16_t* kp = KN + (size_t)(m0 + wm * 64 + i * 32) * 512;
          const int lo = 4 * hh * 512 + col;
#pragma unroll
          for (int e = 0; e < 16; ++e) (kp + crowu(e) * 512)[lo] = f2bf(acc[i][j][e]);
        }
      } else {
        const int Tk = seq_tk(seq);
        bf16_t* vt = VBT + (size_t)512 * keyrow0(seq) + (size_t)(col - 512) * Tk;
#pragma unroll
        for (int i = 0; i < 2; ++i) {
          const int tt = t0 + wm * 64 + i * 32;
#pragma unroll
          for (int g2 = 0; g2 < 2; ++g2) {
            float v[8];
#pragma unroll
            for (int e = 0; e < 8; ++e) v[e] = acc[i][j][g2 * 8 + e];
            *(u32x4*)(vt + tt + 16 * g2 + 8 * hh) = pack8(v);
          }
        }
      }
    }
  }
}

template <int DQK>
DI void attn_item(const bf16_t* Qw, int q_ld, const bf16_t* K1, int k1_ld, const bf16_t* K2, int k2_ld,
                  const bf16_t* Vt, int vt_ld, int nkeys, bf16_t* Ow, int o_ld, char* smem) {
  constexpr int KS = DQK * 2 + 16;
  constexpr int KBYTES = 64 * KS;
  constexpr int VS = 144;
  constexpr int VBYTES = 64 * VS;
  constexpr int STAGE = KBYTES + VBYTES;
  constexpr int CPR = DQK / 8;
  constexpr int NKC = 64 * CPR / 256;
  constexpr int NS = DQK / 16;
  const int tid = otid(), lane = tid & 63, r = lane & 31, hh = lane >> 5;
  bf16x8 qf[NS];
#pragma unroll
  for (int s = 0; s < NS; ++s) qf[s] = *(const bf16x8*)(Qw + (size_t)r * q_ld + 16 * s + 8 * hh);
  f32x16 o[2];
#pragma unroll
  for (int n = 0; n < 2; ++n)
#pragma unroll
    for (int e = 0; e < 16; ++e) o[n][e] = 0.f;
  float m_run = 0.f, lsum = 0.f;
  u32x4 rk0[NKC], rv0[2], rk1[NKC], rv1[2];
  int krow_[NKC], kc_[NKC];
#pragma unroll
  for (int q = 0; q < NKC; ++q) { const int id = q * 256 + tid; krow_[q] = id / CPR; kc_[q] = id % CPR; }
  const int vrow = tid >> 3, vc = tid & 7;
  auto gload = [&](int key0, u32x4 (&rk)[NKC], u32x4 (&rv)[2]) {
#pragma unroll
    for (int q = 0; q < NKC; ++q) {
      const bf16_t* src = (DQK == 64 || kc_[q] < 8) ? K1 + (size_t)(key0 + krow_[q]) * k1_ld + kc_[q] * 8 : K2 + (size_t)(key0 + krow_[q]) * k2_ld + (kc_[q] - 8) * 8;
      rk[q] = *(const u32x4*)src;
    }
#pragma unroll
    for (int q = 0; q < 2; ++q) rv[q] = *(const u32x4*)(Vt + (size_t)(vrow + 32 * q) * vt_ld + key0 + vc * 8);
  };
  auto lstore = [&](int buf, u32x4 (&rk)[NKC], u32x4 (&rv)[2]) {
    char* base = smem + buf * STAGE;
#pragma unroll
    for (int q = 0; q < NKC; ++q) *(u32x4*)(base + krow_[q] * KS + kc_[q] * 16) = rk[q];
#pragma unroll
    for (int q = 0; q < 2; ++q) *(u32x4*)(base + KBYTES + (vrow + 32 * q) * VS + vc * 16) = rv[q];
  };
  const int ntl = nkeys >> 6;
  gload(0, rk0, rv0); lstore(0, rk0, rv0);
  gload(64, rk1, rv1);
  if (ntl > 2) gload(128, rk0, rv0);
  __syncthreads();
  auto tile_body = [&](int tl, u32x4 (&rkn)[NKC], u32x4 (&rvn)[2]) {
    const char* base = smem + (tl & 1) * STAGE;
    bf16x8 kf[2][NS], vf[2][2][2];
#pragma unroll
    for (int kb = 0; kb < 2; ++kb)
#pragma unroll
      for (int ks = 0; ks < NS; ++ks) kf[kb][ks] = *(const bf16x8*)(base + (kb * 32 + r) * KS + (2 * ks + hh) * 16);
    __builtin_amdgcn_sched_barrier(0);
    f32x16 s[2];
    const float ninit = -m_run;
#pragma unroll
    for (int kb = 0; kb < 2; ++kb)
#pragma unroll
      for (int e = 0; e < 16; ++e) s[kb][e] = ninit;
#pragma unroll
    for (int ks = 0; ks < NS; ++ks)
#pragma unroll
      for (int kb = 0; kb < 2; ++kb) s[kb] = MFMA32(kf[kb][ks], qf[ks], s[kb]);
#pragma unroll
    for (int kb = 0; kb < 2; ++kb)
#pragma unroll
      for (int s2 = 0; s2 < 2; ++s2)
#pragma unroll
        for (int n = 0; n < 2; ++n) vf[kb][s2][n] = *(const bf16x8*)(base + KBYTES + (32 * n + r) * VS + (kb * 32 + 16 * s2 + 8 * hh) * 2);
    __builtin_amdgcn_sched_barrier(0);
    float mx = s[0][0];
#pragma unroll
    for (int kb = 0; kb < 2; ++kb)
#pragma unroll
      for (int e = 0; e < 16; ++e) mx = fmaxf(mx, s[kb][e]);
    { const unsigned u = __float_as_uint(mx); auto sw = __builtin_amdgcn_permlane32_swap(u, u, false, false); mx = fmaxf(__uint_as_float(sw[0]), __uint_as_float(sw[1])); }
    const bool move = (mx > 4.0f) || (mx < -20.0f);
    if (__builtin_amdgcn_ballot_w64(move) != 0ull) {
      const float dlt = move ? mx : 0.f;
      const float alpha = __builtin_amdgcn_exp2f(-dlt);
      m_run += dlt;
      lsum *= alpha;
#pragma unroll
      for (int kb = 0; kb < 2; ++kb)
#pragma unroll
        for (int e = 0; e < 16; ++e) s[kb][e] -= dlt;
#pragma unroll
      for (int n = 0; n < 2; ++n)
#pragma unroll
        for (int e = 0; e < 16; ++e) o[n][e] *= alpha;
    }
    float ps = 0.f;
#pragma unroll
    for (int kb = 0; kb < 2; ++kb)
#pragma unroll
      for (int e = 0; e < 16; ++e) { const float pe = __builtin_amdgcn_exp2f(s[kb][e]); s[kb][e] = pe; ps += pe; }
    lsum += ps;
#pragma unroll
    for (int kb = 0; kb < 2; ++kb)
#pragma unroll
      for (int s2 = 0; s2 < 2; ++s2) {
        u32x4 pw;
        pw.x = pack2(s[kb][8 * s2 + 0], s[kb][8 * s2 + 1]); pw.y = pack2(s[kb][8 * s2 + 2], s[kb][8 * s2 + 3]);
        pw.z = pack2(s[kb][8 * s2 + 4], s[kb][8 * s2 + 5]); pw.w = pack2(s[kb][8 * s2 + 6], s[kb][8 * s2 + 7]);
        const bf16x8 pf = __builtin_bit_cast(bf16x8, pw);
#pragma unroll
        for (int n = 0; n < 2; ++n) o[n] = MFMA32(vf[kb][s2][n], pf, o[n]);
      }
    if (tl + 1 < ntl) { lstore((tl + 1) & 1, rkn, rvn); if (tl + 3 < ntl) gload((tl + 3) * 64, rkn, rvn); }
    __syncthreads();
  };
  for (int tl = 0; tl < ntl; tl += 2) { tile_body(tl, rk1, rv1); tile_body(tl + 1, rk0, rv0); }
  lsum = xsum32(lsum);
  const float inv = 1.0f / lsum;
#pragma unroll
  for (int n = 0; n < 2; ++n)
#pragma unroll
    for (int g = 0; g < 4; ++g) {
      u32x2 w; w.x = pack2(o[n][4 * g] * inv, o[n][4 * g + 1] * inv); w.y = pack2(o[n][4 * g + 2] * inv, o[n][4 * g + 3] * inv);
      *(u32x2*)(Ow + (size_t)r * o_ld + 32 * n + 8 * g + 4 * hh) = w;
    }
}

DI void scan_item(const Params& p, int l, int seq, int hd, int dir, int rs, char* smem) {
  const int tid = otid(), lane = tid & 63, wv = __builtin_amdgcn_readfirstlane(tid >> 6);
  const int j8 = lane & 7, r = lane & 31, hh = lane >> 5;
  const bool lat = seq >= 32;
  const int T = lat ? 4096 : 256;
  const int row0 = lat ? NCTX + (seq - 32) * 4096 : seq * 256;
  float* vA = (float*)smem; float* vK = vA + 2048; float* vR = vK + 2048; float* vV = vR + 2048; float* vW = vV + 2048; float* vB = vW + 2048; float* ybuf = vB + 2048;
  char* raw = smem + 32768;
  char* wdx = smem + 57344; char* adx = smem + 61952;
  float* tmpb = (float*)(smem + 66816);
  const bf16_t* U = (const bf16_t*)(p.ws + OFF_U);
  bf16_t* Y = (bf16_t*)(p.ws + OFF_R2) + (dir ? (size_t)NT * 512 : 0);
  float* bonus = (float*)(p.ws + OFF_BONUS);
  const int lrow = 8 * wv + (lane >> 3), irow = rs * 32 + lrow;
  f32x2 S[4];
  if (lat) {
    const float* s0 = (dir ? opq(p.in[I_SB]) : opq(p.in[I_SF])) + ((size_t)((seq - 32) * 4 + l) * 8 + hd) * 4096 + irow * 64 + j8 * 8;
#pragma unroll
    for (int q = 0; q < 2; ++q) { const f32x4 v = *(const f32x4*)(s0 + 4 * q); S[2 * q] = (f32x2){v.x, v.y}; S[2 * q + 1] = (f32x2){v.z, v.w}; }
  } else {
#pragma unroll
    for (int q = 0; q < 4; ++q) S[q] = (f32x2){0.f, 0.f};
  }
  const int mat = wv >> 1, ntc = wv & 1, cch = ntc * 32 + r, hc = hd * 64 + cch;
  bf16x8 bfrag[4];
  {
    const float* W = (mat ? opq(p.in[I_AUP]) : opq(p.in[I_WUP])) + (size_t)(l * 2 + dir) * 64 * 512 + hc;
#pragma unroll
    for (int s4 = 0; s4 < 4; ++s4) {
      float w8[8];
#pragma unroll
      for (int j = 0; j < 8; ++j) w8[j] = W[(size_t)(16 * s4 + 8 * hh + j) * 512];
      bfrag[s4] = __builtin_bit_cast(bf16x8, pack8(w8));
    }
  }
  const float bias = (mat ? opq(p.in[I_A0]) : opq(p.in[I_W0]))[(l * 2 + dir) * 512 + hc];
  const float kav = p.in[I_KA][l * 512 + hc], rkv = p.in[I_RK][l * 512 + hc];
  float* muP = (float*)(smem + 75008); float* muN = muP + 320; float* kkL = muN + 320;
  {
    const float* mup = p.in[I_MUP] + l * 1792; const float* mun = p.in[I_MUN] + l * 1792;
    for (int e = tid; e < 320; e += 256) { const int g = e >> 6, c = e & 63; const int col = (g < 3 ? g * 512 + hd * 64 : (g == 3 ? 1536 + dir * 64 : 1664 + dir * 64)) + c; muP[e] = mup[col]; muN[e] = mun[col]; }
    if (tid < 64) kkL[tid] = p.in[I_KK][l * 512 + hd * 64 + tid];
  }
  const int nch = T >> 5;
  u32x4 pre[6];
  auto prefetch = [&](int t0) {
#pragma unroll
    for (int q = 0; q < 6; ++q) {
      const int id = q * 256 + tid;
      const int row = id / 40, cc = id - row * 40, g = cc >> 3, c8 = cc & 7;
      const int t = t0 - 1 + row;
      const int col = (g < 3 ? g * 512 + hd * 64 : (g == 3 ? 1536 + dir * 64 : 1664 + dir * 64)) + c8 * 8;
      u32x4 v = (u32x4){0u, 0u, 0u, 0u};
      if (id < 1360 && t >= 0 && t < T) v = *(const u32x4*)(U + (size_t)(row0 + t) * ULD + 1696 + col);
      pre[q] = v;
    }
  };
  prefetch((dir ? nch - 1 : 0) * 32);
  for (int ci = 0; ci < nch; ++ci) {
    const int t0 = (dir ? nch - 1 - ci : ci) * 32;
#pragma unroll
    for (int q = 0; q < 6; ++q) { const int id = q * 256 + tid; if (id < 1360) *(u32x4*)(raw + id * 16) = pre[q]; }
    __syncthreads();
    if (ci + 1 < nch) prefetch((dir ? nch - 2 - ci : ci + 1) * 32);
    {
      const int tt = tid >> 3, sub = tid & 7;
#pragma unroll 1
      for (int g = 0; g < 5; ++g) {
        const int col = (g < 3 ? g * 512 + hd * 64 : (g == 3 ? 1536 + dir * 64 : 1664 + dir * 64)) + sub * 8;
        float c[8], pv[8], nx[8], x[8];
        unpack8(*(const u32x4*)(raw + (tt + 1) * 640 + (g * 8 + sub) * 16), c);
        unpack8(*(const u32x4*)(raw + tt * 640 + (g * 8 + sub) * 16), pv);
        unpack8(*(const u32x4*)(raw + (tt + 2) * 640 + (g * 8 + sub) * 16), nx);
        const f32x4 mp0 = *(const f32x4*)(muP + g * 64 + sub * 8), mp1 = *(const f32x4*)(muP + g * 64 + sub * 8 + 4), mn0 = *(const f32x4*)(muN + g * 64 + sub * 8), mn1 = *(const f32x4*)(muN + g * 64 + sub * 8 + 4);
        const float mp[8] = {mp0.x, mp0.y, mp0.z, mp0.w, mp1.x, mp1.y, mp1.z, mp1.w}, mn[8] = {mn0.x, mn0.y, mn0.z, mn0.w, mn1.x, mn1.y, mn1.z, mn1.w};
#pragma unroll
        for (int i = 0; i < 8; ++i) x[i] = c[i] + mp[i] * (pv[i] - c[i]) + mn[i] * (nx[i] - c[i]);
        const int lo = tt * 64 + sub * 8;
        if (g == 0) { *(f32x4*)(vR + lo) = (f32x4){x[0], x[1], x[2], x[3]}; *(f32x4*)(vR + lo + 4) = (f32x4){x[4], x[5], x[6], x[7]}; }
        else if (g == 1) {
          float kk[8], ss = 0.f;
          const float* kkw = kkL + sub * 8;
#pragma unroll
          for (int i = 0; i < 8; ++i) { kk[i] = x[i] * kkw[i]; ss += kk[i] * kk[i]; }
          *(f32x4*)(vK + lo) = (f32x4){x[0], x[1], x[2], x[3]}; *(f32x4*)(vK + lo + 4) = (f32x4){x[4], x[5], x[6], x[7]};
          ss += shx<1>(ss); ss += shx<2>(ss); ss += shx<4>(ss);
          const float inv = 1.0f / fmaxf(sqrtf(ss), 1e-12f);
          *(f32x4*)(vA + lo) = (f32x4){kk[0] * inv, kk[1] * inv, kk[2] * inv, kk[3] * inv}; *(f32x4*)(vA + lo + 4) = (f32x4){kk[4] * inv, kk[5] * inv, kk[6] * inv, kk[7] * inv};
        }
        else if (g == 2) { *(f32x4*)(vV + lo) = (f32x4){x[0], x[1], x[2], x[3]}; *(f32x4*)(vV + lo + 4) = (f32x4){x[4], x[5], x[6], x[7]}; }
        else if (g == 3) { float th[8]; for (int i = 0; i < 8; ++i) th[i] = 1.0f - 2.0f * __builtin_amdgcn_rcpf(1.0f + __expf(2.0f * x[i])); *(u32x4*)(wdx + tt * 144 + sub * 16) = pack8(th); }
        else { *(u32x4*)(adx + tt * 144 + sub * 16) = pack8(x); }
      }
    }
    __syncthreads();
    {
      f32x16 acc;
#pragma unroll
      for (int e = 0; e < 16; ++e) acc[e] = 0.f;
      const char* xb = mat ? adx : wdx;
#pragma unroll
      for (int s4 = 0; s4 < 4; ++s4) { const bf16x8 af = *(const bf16x8*)(xb + r * 144 + (16 * s4 + 8 * hh) * 2); acc = MFMA32(af, bfrag[s4], acc); }
      if (mat == 0) {
#pragma unroll
        for (int e = 0; e < 16; ++e) vW[crow(e, hh) * 64 + cch] = __expf(-0.6065306597126334f * sigmoidf_(bias + acc[e]));
      } else {
#pragma unroll
        for (int e = 0; e < 16; ++e) {
          const int ix = crow(e, hh) * 64 + cch;
          const float ag = sigmoidf_(bias + acc[e]);
          const float kk = vA[ix], k = vK[ix], rr = vR[ix];
          const float kd = k * (1.0f + (ag - 1.0f) * kav);
          vK[ix] = kd; vA[ix] = -kk; vB[ix] = kk * ag; tmpb[ix] = rr * kd * rkv;
        }
      }
    }
    __syncthreads();
    {
      const int tt = tid >> 3, sub = tid & 7;
      const f32x4 b0 = *(const f32x4*)(tmpb + tt * 64 + sub * 8), b1 = *(const f32x4*)(tmpb + tt * 64 + sub * 8 + 4);
      float bs = (b0.x + b0.y) + (b0.z + b0.w) + (b1.x + b1.y) + (b1.z + b1.w);
      bs += shx<1>(bs); bs += shx<2>(bs); bs += shx<4>(bs);
      if (sub == 0 && rs == 0) bonus[((size_t)(row0 + t0 + tt) * 8 + hd) * 2 + dir] = bs;
    }
    {
      f32x4 va[2], vw[2], vb[2], vk[2], vr[2]; float vi;
      int tt = dir ? 31 : 0;
      int vo = tt * 64 + j8 * 8;
#pragma unroll
      for (int q = 0; q < 2; ++q) { va[q] = *(const f32x4*)(vA + vo + 4 * q); vw[q] = *(const f32x4*)(vW + vo + 4 * q); vb[q] = *(const f32x4*)(vB + vo + 4 * q); vk[q] = *(const f32x4*)(vK + vo + 4 * q); vr[q] = *(const f32x4*)(vR + vo + 4 * q); }
      vi = vV[tt * 64 + irow];
      for (int si = 0; si < 32; ++si) {
        const int ttn = dir ? (si < 31 ? 30 - si : 0) : (si < 31 ? si + 1 : 31);
        const int von = ttn * 64 + j8 * 8;
        f32x2 pa2 = S[0] * (f32x2){va[0].x, va[0].y}, pa3 = S[1] * (f32x2){va[0].z, va[0].w};
        pa2 += S[2] * (f32x2){va[1].x, va[1].y}; pa3 += S[3] * (f32x2){va[1].z, va[1].w};
#pragma unroll
        for (int q = 0; q < 2; ++q) va[q] = *(const f32x4*)(vA + von + 4 * q);
        pa2 += pa3;
        const float sa = osum(pa2.x + pa2.y);
        const f32x2 sa2 = (f32x2){sa, sa}, vi2 = (f32x2){vi, vi};
        f32x2 py2, py3;
        S[0] = S[0] * (f32x2){vw[0].x, vw[0].y} + (sa2 * (f32x2){vb[0].x, vb[0].y} + vi2 * (f32x2){vk[0].x, vk[0].y}); py2 = S[0] * (f32x2){vr[0].x, vr[0].y};
        S[1] = S[1] * (f32x2){vw[0].z, vw[0].w} + (sa2 * (f32x2){vb[0].z, vb[0].w} + vi2 * (f32x2){vk[0].z, vk[0].w}); py3 = S[1] * (f32x2){vr[0].z, vr[0].w};
        S[2] = S[2] * (f32x2){vw[1].x, vw[1].y} + (sa2 * (f32x2){vb[1].x, vb[1].y} + vi2 * (f32x2){vk[1].x, vk[1].y}); py2 += S[2] * (f32x2){vr[1].x, vr[1].y};
        S[3] = S[3] * (f32x2){vw[1].z, vw[1].w} + (sa2 * (f32x2){vb[1].z, vb[1].w} + vi2 * (f32x2){vk[1].z, vk[1].w}); py3 += S[3] * (f32x2){vr[1].z, vr[1].w};
#pragma unroll
        for (int q = 0; q < 2; ++q) { vw[q] = *(const f32x4*)(vW + von + 4 * q); vb[q] = *(const f32x4*)(vB + von + 4 * q); vk[q] = *(const f32x4*)(vK + von + 4 * q); vr[q] = *(const f32x4*)(vR + von + 4 * q); }
        vi = vV[ttn * 64 + irow];
        py2 += py3;
        const float py = osum(py2.x + py2.y);
        ybuf[tt * 32 + lrow] = py;
        tt = ttn;
      }
    }
    __syncthreads();
    {
      const int tt = tid >> 3, sub = tid & 7;
      const f32x4 y0 = *(const f32x4*)(ybuf + tt * 32 + sub * 4);
      u32x2 w; w.x = pack2(y0.x, y0.y); w.y = pack2(y0.z, y0.w);
      *(u32x2*)(Y + (size_t)(row0 + t0 + tt) * 512 + hd * 64 + rs * 32 + sub * 4) = w;
    }
    __syncthreads();
  }
  if (!lat) {
    float* o = opq(p.out) + (dir ? OUT_SB : OUT_SF) + ((size_t)(seq * 4 + l) * 8 + hd) * 4096 + irow * 64 + j8 * 8;
#pragma unroll
    for (int q = 0; q < 2; ++q) *(f32x4*)(o + 4 * q) = (f32x4){S[2 * q].x, S[2 * q].y, S[2 * q + 1].x, S[2 * q + 1].y};
  }
}

DI void phase_mixers(const Params& p, int l, char* smem, int part = 0) {
  const int tid = otid(), wid = __builtin_amdgcn_readfirstlane(tid >> 6);
  unsigned* cnt = (unsigned*)(p.ws + OFF_CNT) + l * 8;
  int* slot = (int*)(smem + SMEM_BYTES - 16);
  bf16_t* U = (bf16_t*)(p.ws + OFF_U);
  const bf16_t* KA = (const bf16_t*)(p.ws + OFF_KA); const bf16_t* VAT = (const bf16_t*)(p.ws + OFF_VAT);
  const bf16_t* KN = (const bf16_t*)(p.ws + OFF_KN); const bf16_t* VBT = (const bf16_t*)(p.ws + OFF_VBT); const bf16_t* KRB = (const bf16_t*)(p.ws + OFF_KRB);
  const int QLEN = 256 + 256 + 128 + 64 + 64;
  bool first = true;
  int xq = blockIdx.x & 7, tries = 0;
  for (;;) {
    int kind, seq, a, qt;
    if (first && blockIdx.x < 256) {
      const int item = blockIdx.x; kind = 0; seq = 32 + (item >> 5); a = (item >> 2) & 7; qt = item & 3;
      first = false;
    } else {
      first = false;
      if (tid == 0) *slot = (int)atomicAdd(cnt + xq, 1u);
      __syncthreads();
      const int i = __builtin_amdgcn_readfirstlane(*slot);
      __syncthreads();
      if (i >= QLEN) { if (++tries >= 8) break; xq = (xq + 1) & 7; continue; }
      if (i < 256) { const int g = xq + 8 * (i >> 7); kind = 1; seq = 32 + (g >> 1); a = g & 1; qt = i & 127; }
      else if (i < 512) { const int j = i - 256; const int g = xq + 8 * (j >> 5); kind = 2; seq = 32 + (g >> 3); a = g & 7; qt = j & 31; }
      else if (i < 640) { const int j = i - 512; kind = 0; seq = xq + 8 * (j >> 5); a = (j >> 2) & 7; qt = j & 3; }
      else if (i < 704) { const int j = i - 640; kind = 1; seq = xq + 8 * (j >> 4); a = (j >> 3) & 1; qt = j & 7; }
      else { const int j = i - 704; kind = 2; seq = xq + 8 * (j >> 4); a = (j >> 1) & 7; qt = j & 1; }
    }
    const int kr0 = keyrow0(seq), Tk = seq_tk(seq);
    const int row0 = seq < 32 ? seq * 256 : NCTX + (seq - 32) * 4096;
    if (kind == 0) scan_item(p, l, seq, a, qt & 1, qt >> 1, smem);
    else if (kind == 1) {
      const int qh = a * 4 + wid;
      bf16_t* q = U + (size_t)(row0 + qt * 32) * ULD + qh * 64;
      attn_item<64>(q, ULD, KA + (size_t)kr0 * 128 + a * 64, 128, nullptr, 0, VAT + (size_t)128 * kr0 + (size_t)(a * 64) * Tk, Tk, Tk, q, ULD, smem);
    } else {
      bf16_t* q = U + (size_t)(row0 + qt * 128 + wid * 32) * ULD + 768 + a * 96;
      attn_item<96>(q, ULD, KN + (size_t)kr0 * 512 + a * 64, 512, KRB + (size_t)kr0 * 32, 32, VBT + (size_t)512 * kr0 + (size_t)(a * 64) * Tk, Tk, Tk, q, ULD, smem);
    }
  }
}

DI void cpost_row(const Params& p, int l, int row, int lane) {
  int seq, t; row_decode(row, seq, t);
  const int T = seq < 32 ? 256 : 4096;
  const bf16_t* YF = (const bf16_t*)(p.ws + OFF_R2); const bf16_t* YB = YF + (size_t)NT * 512;
  bf16_t* u = (bf16_t*)(p.ws + OFF_U) + (size_t)row * ULD + 1696;
  const float* bonus = (const float*)(p.ws + OFF_BONUS);
  float yf[8], yb[8], y[8];
  unpack8(*(const u32x4*)(YF + (size_t)row * 512 + lane * 8), yf);
  unpack8(*(const u32x4*)(YB + (size_t)row * 512 + lane * 8), yb);
  float s = 0.f;
#pragma unroll
  for (int i = 0; i < 8; ++i) { y[i] = yf[i] + yb[i]; s += y[i]; }
  s += shx<1>(s); s += shx<2>(s); s += shx<4>(s);
  const float mu = s * (1.0f / 64.0f);
  float q = 0.f;
#pragma unroll
  for (int i = 0; i < 8; ++i) { y[i] -= mu; q += y[i] * y[i]; }
  q += shx<1>(q); q += shx<2>(q); q += shx<4>(q);
  const float rs = rsqrtf(q * (1.0f / 64.0f) + 64e-5f);
  const int col = 1024 + lane * 8;
  float c[8], pv[8], nx[8];
  unpack8(*(const u32x4*)(u + col), c);
  if (t > 0) unpack8(*(const u32x4*)(u - ULD + col), pv); else { for (int i = 0; i < 8; ++i) pv[i] = 0.f; }
  if (t < T - 1) unpack8(*(const u32x4*)(u + ULD + col), nx); else { for (int i = 0; i < 8; ++i) nx[i] = 0.f; }
  const float* mup = p.in[I_MUP] + l * 1792 + col; const float* mun = p.in[I_MUN] + l * 1792 + col;
  const float* lw = p.in[I_LNW] + l * 512 + lane * 8; const float* lb = p.in[I_LNB] + l * 512 + lane * 8;
  const f32x2 bsv = *(const f32x2*)(bonus + ((size_t)row * 8 + (lane >> 3)) * 2);
  const float bs = bsv.x + bsv.y;
  float o[8];
#pragma unroll
  for (int i = 0; i < 8; ++i) { const float v = c[i] + mup[i] * (pv[i] - c[i]) + mun[i] * (nx[i] - c[i]); o[i] = y[i] * rs * lw[i] + lb[i] + bs * v; }
  *(u32x4*)(u + lane * 8) = pack8(o);
}
DI void phase_renorm_cpost(const Params& p, int l) {
  const int lane = otid() & 63, wid = __builtin_amdgcn_readfirstlane(otid() >> 6);
  for (int item = blockIdx.x; item < NT / 4; item += gridDim.x) { const int row = item * 4 + wid; norm_row(p, l, row, lane); cpost_row(p, l, row, lane); }
}

DI void phase_zgemm(const Params& p, char* smem) {
  const bf16_t* H = (const bf16_t*)(p.ws + OFF_R1);
  const bf16_t* W = (const bf16_t*)(p.ws + OFF_WIN) + (size_t)3584 * 1024;
  bf16_t* U = (bf16_t*)(p.ws + OFF_U);
  const int ntiles = 320 * 12;
  for (int it = 0;; ++it) {
    int mt, nt; if (!next_tile(it, 12, 6, mt, nt)) break;
    const int m0 = mt * 128, n0 = nt * 128;
    f32x16 acc[2][2]; zero_acc<2>(acc);
    gemm_mainloop<2>(acc, H + (size_t)m0 * 1024, 1024, 64, W + (size_t)n0 * 1024, 1024, 1024, smem);
    const int lane = otid() & 63, wid = __builtin_amdgcn_readfirstlane(otid() >> 6), wm = wid >> 1, wn = wid & 1, r = lane & 31, hh = lane >> 5;
#pragma unroll
    for (int j = 0; j < 2; ++j) {
      const int col = n0 + wn * 64 + j * 32 + r;
      const int br = col >> 9, cc = col & 511;
      const int ucol = br == 0 ? cc : (br == 1 ? 768 + (cc >> 6) * 96 + (cc & 63) : 1696 + cc);
#pragma unroll
      for (int i = 0; i < 2; ++i) {
        bf16_t* up = U + (size_t)(m0 + wm * 64 + i * 32) * ULD;
        const int lo = 4 * hh * ULD + ucol;
        bf16_t yv[16];
#pragma unroll
        for (int e = 0; e < 16; ++e) yv[e] = (up + crowu(e) * ULD)[lo];
#pragma unroll
        for (int e = 0; e < 16; ++e) (up + crowu(e) * ULD)[lo] = f2bf(bf2f(yv[e]) * siluf_(acc[i][j][e]));
      }
    }
  }
}

DI void phase_merge(const Params& p, char* smem) {
  const bf16_t* H = (const bf16_t*)(p.ws + OFF_R1);
  const bf16_t* WG = (const bf16_t*)(p.ws + OFF_WIN) + (size_t)5120 * 1024;
  const bf16_t* WO = (const bf16_t*)(p.ws + OFF_WO);
  const bf16_t* U = (const bf16_t*)(p.ws + OFF_U);
  bf16_t* MX = (bf16_t*)(p.ws + OFF_R2);
  const int ntiles = 320 * 8;
  for (int it = 0;; ++it) {
    int mt, nt; if (!next_tile(it, 8, 8, mt, nt)) break;
    const int m0 = mt * 128, n0 = nt * 128;
    f32x16 mix[2][2]; zero_acc<2>(mix);
    unsigned gs[2][2][8];
#pragma unroll 1
    for (int step = 0; step < 6; ++step) {
      const int br = step >> 1, isT = step & 1;
      const int acol = br == 0 ? 0 : (br == 1 ? 768 : 1696);
      const bf16_t* Ap = isT ? U + (size_t)m0 * ULD + acol : H + (size_t)m0 * 1024;
      const bf16_t* Bp = isT ? WO + (size_t)(br * 1024 + n0) * 512 : WG + (size_t)(br * 1024 + n0) * 1024;
      f32x16 cur[2][2]; zero_acc<2>(cur);
      gemm_mainloop<2>(cur, Ap, isT ? ULD : 1024, (isT && br == 1) ? 96 : 64, Bp, isT ? 512 : 1024, isT ? 512 : 1024, smem);
      if (isT) {
#pragma unroll
        for (int i = 0; i < 2; ++i)
#pragma unroll
          for (int j = 0; j < 2; ++j)
#pragma unroll
            for (int e = 0; e < 8; ++e) { mix[i][j][2 * e] += lo16(gs[i][j][e]) * cur[i][j][2 * e]; mix[i][j][2 * e + 1] += hi16(gs[i][j][e]) * cur[i][j][2 * e + 1]; }
      } else {
#pragma unroll
        for (int i = 0; i < 2; ++i)
#pragma unroll
          for (int j = 0; j < 2; ++j)
#pragma unroll
            for (int e = 0; e < 8; ++e) gs[i][j][e] = pack2(sigmoidf_(cur[i][j][2 * e]), sigmoidf_(cur[i][j][2 * e + 1]));
      }
    }
    const int lane = otid() & 63, wid = __builtin_amdgcn_readfirstlane(otid() >> 6), wm = wid >> 1, wn = wid & 1, r = lane & 31, hh = lane >> 5;
#pragma unroll
    for (int j = 0; j < 2; ++j) {
      const int col = n0 + wn * 64 + j * 32 + r;
#pragma unroll
      for (int i = 0; i < 2; ++i) {
        bf16_t* mp = MX + (size_t)(m0 + wm * 64 + i * 32) * 1024;
        const int lo = 4 * hh * 1024 + col;
#pragma unroll
        for (int e = 0; e < 16; ++e) (mp + crowu(e) * 1024)[lo] = f2bf(mix[i][j][e]);
      }
    }
  }
}

DI void phase_out(const Params& p, int l, char* smem) {
  const bf16_t* MX = (const bf16_t*)(p.ws + OFF_R2);
  const bf16_t* W = (const bf16_t*)(p.ws + OFF_WOUT);
  const int ntiles = 320 * 8;
  for (int it = 0;; ++it) {
    int mt, nt; if (!next_tile(it, 8, 8, mt, nt)) break;
    const int m0 = mt * 128, n0 = nt * 128;
    f32x16 acc[2][2]; zero_acc<2>(acc);
    gemm_mainloop<2>(acc, MX + (size_t)m0 * 1024, 1024, 64, W + (size_t)n0 * 1024, 1024, 1024, smem);
    const int lane = otid() & 63, wid = __builtin_amdgcn_readfirstlane(otid() >> 6), wm = wid >> 1, wn = wid & 1, r = lane & 31, hh = lane >> 5;
    const int jm = m0 < NCTX ? 0 : 1 + ((m0 - NCTX) >> 12);
    const float* gate = (const float*)(p.ws + OFF_MOD) + ((size_t)l * 9 + jm) * MODLD + 2048;
    const float* xsrc = x_row_ptr(p, l, m0);
#pragma unroll
    for (int j = 0; j < 2; ++j) {
      const int col = n0 + wn * 64 + j * 32 + r;
      const float gv = gate[col];
      const int lo = 4 * hh * 1024 + col;
#pragma unroll
      for (int i = 0; i < 2; ++i) {
        const float* xs = xsrc + (size_t)(wm * 64 + i * 32) * 1024;
        float* xo = p.out + (size_t)(m0 + wm * 64 + i * 32) * 1024;
        float xv[16];
#pragma unroll
        for (int e = 0; e < 16; ++e) xv[e] = (xs + crowu(e) * 1024)[lo];
#pragma unroll
        for (int e = 0; e < 16; ++e) (xo + crowu(e) * 1024)[lo] = xv[e] + gv * acc[i][j][e];
      }
    }
  }
}

DI void phase_final(const Params& p) {
  const int lane = otid() & 63, wid = __builtin_amdgcn_readfirstlane(otid() >> 6);
  const float* nw = p.in[I_FNW];
  for (int item = blockIdx.x; item < NT / 4; item += gridDim.x) {
    float* x = p.out + (size_t)(item * 4 + wid) * 1024;
    f32x4 v[4]; float ss = 0.f;
#pragma unroll
    for (int i = 0; i < 4; ++i) { v[i] = *(const f32x4*)(x + lane * 4 + 256 * i); ss += v[i].x * v[i].x + v[i].y * v[i].y + v[i].z * v[i].z + v[i].w * v[i].w; }
ss = wave_sum(ss);
    const float rs = rsqrtf(ss * (1.0f / 1024.0f) + 1e-6f);
#pragma unroll
    for (int i = 0; i < 4; ++i) { const f32x4 w = *(const f32x4*)(nw + lane * 4 + 256 * i); *(f32x4*)(x + lane * 4 + 256 * i) = (f32x4){v[i].x * rs * w.x, v[i].y * rs * w.y, v[i].z * rs * w.z, v[i].w * rs * w.w}; }
  }
}

DI void grid_barrier(unsigned* bar, unsigned& epoch) {
  epoch += 1u;
  __syncthreads();
  if (otid() == 0) {
    const unsigned grp = blockIdx.x & 7u, per = gridDim.x >> 3;
    __builtin_amdgcn_fence(__ATOMIC_RELEASE, "agent");
    const unsigned old = __hip_atomic_fetch_add(bar + grp * 32, 1u, __ATOMIC_RELAXED, __HIP_MEMORY_SCOPE_AGENT);
    if (old + 1u == epoch * per) __hip_atomic_fetch_add(bar + 8 * 32, 1u, __ATOMIC_RELAXED, __HIP_MEMORY_SCOPE_AGENT);
    while (__hip_atomic_load(bar + 8 * 32, __ATOMIC_RELAXED, __HIP_MEMORY_SCOPE_AGENT) < epoch * 8u) __builtin_amdgcn_s_sleep(1);
    __builtin_amdgcn_fence(__ATOMIC_ACQUIRE, "agent");
  }
  __syncthreads();
}

constexpr int NPHASES = 1 + 4 * 9 + 1;
__global__ void __launch_bounds__(256, 2) fwd_kernel(Params p0) {
  __shared__ __attribute__((aligned(16))) char smem[SMEM_BYTES];
  cg::grid_group grid = cg::this_grid();
  const int ph_begin = p0.ph_begin, ph_end = p0.ph_end;
  unsigned* bar = (unsigned*)(p0.ws + OFF_BAR);
  unsigned epoch = 0u;
  for (int ph = ph_begin; ph < ph_end; ++ph) {
    auto kp = __builtin_amdgcn_kernarg_segment_ptr();
    asm volatile("" : "+s"(kp));
    typedef const __attribute__((address_space(4))) Params CParams;
    CParams* kpp = (CParams*)kp;
    Params p;
#pragma unroll
    for (int i = 0; i < 35; ++i) p.in[i] = kpp->in[i];
    p.out = kpp->out; p.ws = kpp->ws; p.ph_begin = ph_begin; p.ph_end = ph_end;
    if (ph == 0) phase_prologue(p, smem);
    else if (ph == NPHASES - 1) phase_final(p);
    else {
      const int l = (ph - 1) / 9, sp = (ph - 1) % 9;
#ifdef PROBE_SP
      if (sp == PROBE_SP) {
        switch (sp) {
          case 0: phase_norm_convert(p, l, smem); break;
          case 1: phase_gemm1(p, l, smem); break;
          case 3: phase_upproj(p, smem); break;
          case 5: phase_renorm_cpost(p, l); break;
          case 7: phase_merge(p, smem); break;
          default: break;
        }
        grid.sync();
      }
#endif
      switch (sp) {
        case 0: phase_norm_convert(p, l, smem); break;
        case 1: phase_gemm1(p, l, smem); break;
        case 2: phase_post(p, l); break;
        case 3: phase_upproj(p, smem); break;
        case 4: phase_mixers(p, l, smem); break;
        case 5: phase_renorm_cpost(p, l); break;
        case 6: phase_zgemm(p, smem); break;
        case 7: phase_merge(p, smem); break;
        default: phase_out(p, l, smem); break;
      }
    }
    if (ph + 1 < ph_end) { if (ph == 0) grid.sync(); else grid_barrier(bar, epoch); }
  }
}

extern "C" void kernel_launch(void* const* d_in, const int* in_sizes, int n_in, void* d_out, int out_size, void* d_ws, size_t ws_size, hipStream_t stream) {
  if (ws_size < WS_NEED || n_in < 35) { fprintf(stderr, "workspace too small: %zu < %zu\n", ws_size, WS_NEED); return; }
  static int grid_blocks = 0;
  if (!grid_blocks) {
    int dev = 0, cus = 0, per_cu = 0;
    hipGetDevice(&dev);
    hipDeviceGetAttribute(&cus, hipDeviceAttributeMultiprocessorCount, dev);
    hipOccupancyMaxActiveBlocksPerMultiprocessor(&per_cu, fwd_kernel, 256, 0);
    if (per_cu < 1) per_cu = 1;
    if (per_cu > 2) per_cu = 2;
    grid_blocks = cus * per_cu;
  }
  Params p{};
  for (int i = 0; i < 35; ++i) p.in[i] = (const float*)d_in[i];
  p.out = (float*)d_out; p.ws = (char*)d_ws;
#ifndef ONE_LAUNCH
  for (int ph = 0; ph < NPHASES; ++ph) {
    p.ph_begin = ph; p.ph_end = ph + 1;
    hipLaunchKernelGGL(fwd_kernel, dim3(grid_blocks), dim3(256), 0, stream, p);
  }
#else
  p.ph_begin = 0; p.ph_end = NPHASES;
  hipMemsetAsync((char*)d_ws + OFF_BAR, 0, 4096, stream);
  void* args[] = {&p};
  hipError_t e = hipLaunchCooperativeKernel((void*)fwd_kernel, dim3(grid_blocks), dim3(256), args, 0, stream);
  if (e != hipSuccess) fprintf(stderr, "cooperative launch failed: %s (grid %d)\n", hipGetErrorString(e), grid_blocks);
#endif
}
```

```cpp
#define ONE_LAUNCH 1
#include <hip/hip_runtime.h>
#include <hip/hip_cooperative_groups.h>
#include <stdint.h>
#include <stdio.h>
namespace cg = cooperative_groups;

typedef unsigned short bf16_t;
typedef short bf16x8 __attribute__((ext_vector_type(8)));
typedef float f32x16 __attribute__((ext_vector_type(16)));
typedef float f32x4 __attribute__((ext_vector_type(4)));
typedef float f32x2 __attribute__((ext_vector_type(2)));
typedef unsigned u32x4 __attribute__((ext_vector_type(4)));
typedef unsigned u32x2 __attribute__((ext_vector_type(2)));
#define DI __device__ __forceinline__
#define MFMA32(a, b, c) __builtin_amdgcn_mfma_f32_32x32x16_bf16((a), (b), (c), 0, 0, 0)

constexpr int NT = 40960;
constexpr int NCTX = 8192;
constexpr int NK = 45056;
constexpr int ULD = 3488;
constexpr int MODLD = 3072;
constexpr int SMEM_BYTES = 78848;

constexpr size_t OFF_WIN = 0;
constexpr size_t OFF_WO = 16777216;
constexpr size_t OFF_WOUT = 19922944;
constexpr size_t OFF_WU = 22020096;
constexpr size_t OFF_MOD = 22282240;
constexpr size_t OFF_BONUS = 22724608;
constexpr size_t OFF_CS16 = 25346048;
constexpr size_t OFF_CS8 = 25354240;
constexpr size_t OFF_CNT = 25358336;
constexpr size_t OFF_BAR = 524742912;
constexpr size_t OFF_U = 25358592;
constexpr size_t OFF_R1 = 311095552;
constexpr size_t OFF_KA = OFF_R1;
constexpr size_t OFF_VAT = 513208576;
constexpr size_t OFF_KN = OFF_R1 + 23068672;
constexpr size_t OFF_VBT = OFF_R1 + 69206016;
constexpr size_t OFF_KRB = OFF_R1 + 115343360;
constexpr size_t OFF_R2 = 429322496;
constexpr size_t WS_NEED = 524742912 + 4096;

constexpr size_t OUT_AK = 41943040, OUT_AV = 46137344, OUT_CKV = 50331648, OUT_KR = 54525952, OUT_SF = 55574528, OUT_SB = 59768832;

struct Params {
  const float* in[35];
  float* out;
  char* ws;
  int ph_begin, ph_end;
};

enum { I_XP = 0, I_XS, I_CAK, I_CAV, I_CCKV, I_CKR, I_SF, I_SB, I_C, I_CCTX, I_NORMW, I_WMOD, I_BMOD, I_WIN, I_QNW, I_KNW, I_KVNW,
       I_WUK, I_WUV, I_MUP, I_MUN, I_W0, I_WUP, I_A0, I_AUP, I_KK, I_KA, I_RK, I_LNW, I_LNB, I_WOA, I_WOB, I_WOC, I_WOUT, I_FNW };

DI int threadIdx_x_raw() { return __builtin_amdgcn_workitem_id_x(); }
DI int otid() { int t = threadIdx_x_raw(); asm volatile("" : "+v"(t)); return t; }
DI const float* opq(const float* q) { asm volatile("" : "+s"(q)); return q; }
DI float* opq(float* q) { asm volatile("" : "+s"(q)); return q; }
DI float bf2f(bf16_t v) { return __uint_as_float(((unsigned)v) << 16); }
typedef __bf16 hbf16x2 __attribute__((ext_vector_type(2)));
DI unsigned pack2(float a, float b) { f32x2 v = {a, b}; hbf16x2 r = __builtin_convertvector(v, hbf16x2); return __builtin_bit_cast(unsigned, r); }
DI bf16_t f2bf(float x) { return (bf16_t)(pack2(x, 0.f) & 0xffffu); }
DI float xsum16(float x) { const unsigned u = __float_as_uint(x); auto r = __builtin_amdgcn_permlane16_swap(u, u, false, false); return __uint_as_float(r[0]) + __uint_as_float(r[1]); }
DI float xsum32(float x) { const unsigned u = __float_as_uint(x); auto r = __builtin_amdgcn_permlane32_swap(u, u, false, false); return __uint_as_float(r[0]) + __uint_as_float(r[1]); }
DI float lo16(unsigned w) { return __uint_as_float(w << 16); }
DI float hi16(unsigned w) { return __uint_as_float(w & 0xffff0000u); }
DI void unpack8(u32x4 w, float* v) { v[0] = lo16(w.x); v[1] = hi16(w.x); v[2] = lo16(w.y); v[3] = hi16(w.y); v[4] = lo16(w.z); v[5] = hi16(w.z); v[6] = lo16(w.w); v[7] = hi16(w.w); }
DI u32x4 pack8(const float* v) { u32x4 w; w.x = pack2(v[0], v[1]); w.y = pack2(v[2], v[3]); w.z = pack2(v[4], v[5]); w.w = pack2(v[6], v[7]); return w; }
template <int K> DI float shx(float v) { return __int_as_float(__builtin_amdgcn_ds_swizzle(__float_as_int(v), 0x1f | (K << 10))); }
DI float wave_sum(float v) { v += shx<1>(v); v += shx<2>(v); v += shx<4>(v); v += shx<8>(v); v += shx<16>(v); return xsum32(v); }
DI float qsum(float v) {
  v += __int_as_float(__builtin_amdgcn_update_dpp(0, __float_as_int(v), 0xB1, 0xf, 0xf, true));
  v += __int_as_float(__builtin_amdgcn_update_dpp(0, __float_as_int(v), 0x4E, 0xf, 0xf, true));
  return v;
}
DI float osum(float v) {
  v = qsum(v);
  v += __int_as_float(__builtin_amdgcn_update_dpp(0, __float_as_int(v), 0x141, 0xf, 0xf, true));
  return v;
}
DI int crow(int reg, int h) { return (reg & 3) + 8 * (reg >> 2) + 4 * h; }
DI int crowu(int reg) { return (reg & 3) + 8 * (reg >> 2); }
DI int perm16(int t) { return (t & ~12) | ((t & 4) << 1) | ((t & 8) >> 1); }
DI float sigmoidf_(float x) { return __builtin_amdgcn_rcpf(1.0f + __expf(-x)); }
DI float siluf_(float x) { return x * __builtin_amdgcn_rcpf(1.0f + __expf(-x)); }

DI void row_decode(int row, int& seq, int& t) {
  if (row < NCTX) { seq = row >> 8; t = row & 255; } else { seq = 32 + ((row - NCTX) >> 12); t = (row - NCTX) & 4095; }
}
DI int keyrow0(int seq) { return seq < 32 ? seq * 256 : NCTX + (seq - 32) * 4608; }
DI int seq_tk(int seq) { return seq < 32 ? 256 : 4608; }

typedef __attribute__((address_space(3))) unsigned lds_u32;
template <int NJ>
DI void gemm_mainloop(f32x16 (&acc)[2][NJ], const bf16_t* __restrict__ A, int lda, int ks,
                      const bf16_t* __restrict__ Bt, int ldb, int K, char* smem) {
  constexpr int A_BYTES = 128 * 128;
  constexpr int B_BYTES = 64 * NJ * 128;
  constexpr int STAGE = A_BYTES + B_BYTES;
  const int tid = otid(), lane = tid & 63, wid = __builtin_amdgcn_readfirstlane(tid >> 6), wm = wid >> 1, wn = wid & 1;
  const int r = lane & 31, hh = lane >> 5;
  const int nk = K >> 6;
  const int lrow = tid >> 3, lc = tid & 7;
  const int gc = (lc ^ ((lrow >> 1) & 7)) * 8;
  const bf16_t* ap = A + (size_t)lrow * lda + gc;
  const bf16_t* bp = Bt + (size_t)lrow * ldb + gc;
  auto issue = [&](int kt, int buf) {
    char* base = smem + buf * STAGE + tid * 16;
    const bf16_t* ap2 = ap + (size_t)kt * ks;
    const bf16_t* bp2 = bp + (size_t)kt * 64;
#pragma unroll
    for (int p = 0; p < 4; ++p) __builtin_amdgcn_global_load_lds((const unsigned*)(ap2 + (size_t)(32 * p) * lda), (lds_u32*)(base + p * 4096), 16, 0, 0);
#pragma unroll
    for (int p = 0; p < 2 * NJ; ++p) __builtin_amdgcn_global_load_lds((const unsigned*)(bp2 + (size_t)(32 * p) * ldb), (lds_u32*)(base + A_BYTES + p * 4096), 16, 0, 0);
  };
  issue(0, 0);
  __syncthreads();
#pragma unroll 1
  for (int kt = 0; kt < nk; ++kt) {
    if (kt + 1 < nk) issue(kt + 1, (kt + 1) & 1);
    const char* base = smem + (kt & 1) * STAGE;
#pragma unroll
    for (int s = 0; s < 4; ++s) {
      bf16x8 af[2], bfr[NJ];
#pragma unroll
      for (int i = 0; i < 2; ++i) { const int row = wm * 64 + i * 32 + r; af[i] = *(const bf16x8*)(base + row * 128 + (((2 * s + hh) ^ ((row >> 1) & 7)) << 4)); }
#pragma unroll
      for (int j = 0; j < NJ; ++j) { const int row = wn * (32 * NJ) + j * 32 + r; bfr[j] = *(const bf16x8*)(base + A_BYTES + row * 128 + (((2 * s + hh) ^ ((row >> 1) & 7)) << 4)); }
#pragma unroll
      for (int i = 0; i < 2; ++i)
#pragma unroll
        for (int j = 0; j < NJ; ++j) acc[i][j] = MFMA32(af[i], bfr[j], acc[i][j]);
    }
    __syncthreads();
  }
}

template <int NJ> DI void zero_acc(f32x16 (&acc)[2][NJ]) {
#pragma unroll
  for (int i = 0; i < 2; ++i)
#pragma unroll
    for (int j = 0; j < NJ; ++j)
#pragma unroll
      for (int e = 0; e < 16; ++e) acc[i][j][e] = 0.f;
}

DI void phase_prologue(const Params& p, char* smem) {
  const int tid = otid(), lane = tid & 63, wid = __builtin_amdgcn_readfirstlane(tid >> 6);
  float* mod = (float*)(p.ws + OFF_MOD);
  if (blockIdx.x == 0) {
    if (tid < 32) ((unsigned*)(p.ws + OFF_CNT))[tid] = 0u;
    float* cs16 = (float*)(p.ws + OFF_CS16);
    float* cs8 = (float*)(p.ws + OFF_CS8);
    for (int e = tid; e < 64 * 16; e += 256) { const int pos = e >> 4, i = e & 15; const float inv = expf(-9.210340371976184f * (float)i / 16.0f); const float a = (float)pos * inv; cs16[e * 2] = cosf(a); cs16[e * 2 + 1] = sinf(a); }
    for (int e = tid; e < 64 * 8; e += 256) { const int pos = e >> 3, i = e & 7; const float inv = expf(-9.210340371976184f * (float)i / 8.0f); const float a = (float)pos * inv; cs8[e * 2] = cosf(a); cs8[e * 2 + 1] = sinf(a); }
  }
  float* sl = (float*)smem;
  float* red = sl + 9 * 1024;
  for (int e = tid; e < 9 * 1024; e += 256) { const int j = e >> 10, k = e & 1023; const float* cc0 = opq(p.in[I_CCTX]); const float* cc1 = opq(p.in[I_C]); const float c = j == 0 ? cc0[k] : cc1[(j - 1) * 1024 + k]; sl[e] = siluf_(c); }
  __syncthreads();
  for (int item = blockIdx.x; item < 192; item += gridDim.x) {
    const int l = item / 48, n = (item % 48) * 64 + lane;
    const float* w = p.in[I_WMOD] + (size_t)l * 1024 * 3072 + n;
    float a[9];
#pragma unroll
    for (int j = 0; j < 9; ++j) a[j] = 0.f;
    for (int k = wid * 256; k < wid * 256 + 256; ++k) {
      const float wv = w[(size_t)k * 3072];
#pragma unroll
      for (int j = 0; j < 9; ++j) a[j] += sl[j * 1024 + k] * wv;
    }
#pragma unroll
    for (int j = 0; j < 9; ++j) red[(wid * 9 + j) * 64 + lane] = a[j];
    __syncthreads();
    for (int e = tid; e < 9 * 64; e += 256) {
      const int j = e >> 6, c = e & 63;
      const float s = red[(0 * 9 + j) * 64 + c] + red[(1 * 9 + j) * 64 + c] + red[(2 * 9 + j) * 64 + c] + red[(3 * 9 + j) * 64 + c];
      const int nn = (item % 48) * 64 + c;
      mod[((size_t)l * 9 + j) * MODLD + nn] = s + p.in[I_BMOD][l * 3072 + nn];
    }
    __syncthreads();
  }
}

DI const float* x_row_ptr(const Params& p, int l, int row) {
  const float* xp = opq(p.in[I_XP]); const float* xs = opq(p.in[I_XS]); const float* xo = opq((const float*)p.out);
  if (l == 0) return row < NCTX ? xp + (size_t)row * 1024 : xs + (size_t)(row - NCTX) * 1024;
  return xo + (size_t)row * 1024;
}
DI void norm_row(const Params& p, int l, int row, int lane) {
  const float* x = x_row_ptr(p, l, row);
  const int j = row < NCTX ? 0 : 1 + ((row - NCTX) >> 12);
  const float* mod = (const float*)(p.ws + OFF_MOD) + ((size_t)l * 9 + j) * MODLD;
  const float* nw = p.in[I_NORMW] + l * 1024;
  bf16_t* h = (bf16_t*)(p.ws + OFF_R1) + (size_t)row * 1024;
  f32x4 v[4]; float ss = 0.f;
#pragma unroll
  for (int i = 0; i < 4; ++i) { v[i] = *(const f32x4*)(x + lane * 4 + 256 * i); ss += v[i].x * v[i].x + v[i].y * v[i].y + v[i].z * v[i].z + v[i].w * v[i].w; }
ss = wave_sum(ss);
  const float rs = rsqrtf(ss * (1.0f / 1024.0f) + 1e-6f);
#pragma unroll
  for (int i = 0; i < 4; ++i) {
    const int c = lane * 4 + 256 * i;
    const f32x4 w = *(const f32x4*)(nw + c), sh = *(const f32x4*)(mod + c), sc = *(const f32x4*)(mod + 1024 + c);
    u32x2 o;
    o.x = pack2(v[i].x * rs * w.x * (1.f + sc.x) + sh.x, v[i].y * rs * w.y * (1.f + sc.y) + sh.y);
    o.y = pack2(v[i].z * rs * w.z * (1.f + sc.z) + sh.z, v[i].w * rs * w.w * (1.f + sc.w) + sh.w);
    *(u32x2*)(h + c) = o;
  }
}

DI void norm_rows2(const Params& p, int l, int rowa, int rowb, int lane) {
  const float* xa = x_row_ptr(p, l, rowa); const float* xb = x_row_ptr(p, l, rowb);
  f32x4 va[4], vb[4];
#pragma unroll
  for (int i = 0; i < 4; ++i) va[i] = *(const f32x4*)(xa + lane * 4 + 256 * i);
#pragma unroll
  for (int i = 0; i < 4; ++i) vb[i] = *(const f32x4*)(xb + lane * 4 + 256 * i);
  const float* nw = p.in[I_NORMW] + l * 1024;
#pragma unroll
  for (int rr = 0; rr < 2; ++rr) {
    const int row = rr ? rowb : rowa;
    f32x4 (&v)[4] = rr ? vb : va;
    const int j = row < NCTX ? 0 : 1 + ((row - NCTX) >> 12);
    const float* mod = (const float*)(p.ws + OFF_MOD) + ((size_t)l * 9 + j) * MODLD;
    bf16_t* h = (bf16_t*)(p.ws + OFF_R1) + (size_t)row * 1024;
    float ss = 0.f;
#pragma unroll
    for (int i = 0; i < 4; ++i) ss += v[i].x * v[i].x + v[i].y * v[i].y + v[i].z * v[i].z + v[i].w * v[i].w;
    ss = wave_sum(ss);
    const float rs = rsqrtf(ss * (1.0f / 1024.0f) + 1e-6f);
#pragma unroll
    for (int i = 0; i < 4; ++i) {
      const int c = lane * 4 + 256 * i;
      const f32x4 w = *(const f32x4*)(nw + c), sh = *(const f32x4*)(mod + c), sc = *(const f32x4*)(mod + 1024 + c);
      u32x2 o;
      o.x = pack2(v[i].x * rs * w.x * (1.f + sc.x) + sh.x, v[i].y * rs * w.y * (1.f + sc.y) + sh.y);
      o.y = pack2(v[i].z * rs * w.z * (1.f + sc.z) + sh.z, v[i].w * rs * w.w * (1.f + sc.w) + sh.w);
      *(u32x2*)(h + c) = o;
    }
  }
}

DI int win_srccol(int j) {
  if (j < 768) return j;
  if (j < 1696) return j + 512;
  if (j < 3488) return j + 1024;
  if (j < 3584) return -1;
  if (j < 5120) { const int jj = j - 3584; return jj < 512 ? 768 + jj : (jj < 1024 ? 2208 + (jj - 512) : 4512 + (jj - 1024)); }
  return 5024 + (j - 5120);
}
DI void conv_tile(const float* __restrict__ src, int ld_src, bf16_t* dst, int ld_dst, int k0, int n0, int kind, int srcoff, char* smem) {
  float* tile = (float*)smem;
  const int tid = otid();
  const int n = tid & 63;
  int sc = kind == 0 ? win_srccol(n0 + n) : (n0 + n - srcoff);
#pragma unroll
  for (int i = 0; i < 16; ++i) { const int k = i * 4 + (tid >> 6); tile[k * 65 + n] = sc >= 0 ? src[(size_t)(k0 + k) * ld_src + sc] : 0.f; }
  __syncthreads();
#pragma unroll
  for (int i = 0; i < 8; ++i) { const int nn = i * 8 + (tid >> 5), kk = (tid & 31) * 2; *(unsigned*)(dst + (size_t)(n0 + nn) * ld_dst + k0 + kk) = pack2(tile[kk * 65 + nn], tile[(kk + 1) * 65 + nn]); }
  __syncthreads();
}

DI void phase_norm_convert(const Params& p, int l, char* smem) {
  const int tid = otid(), lane = tid & 63, wid = __builtin_amdgcn_readfirstlane(tid >> 6);
  bf16_t* WinT = (bf16_t*)(p.ws + OFF_WIN); bf16_t* WoT = (bf16_t*)(p.ws + OFF_WO); bf16_t* WoutT = (bf16_t*)(p.ws + OFF_WOUT); bf16_t* WuT = (bf16_t*)(p.ws + OFF_WU);
  const int NI_WIN = 128 * 16, NI_WO = 3 * 16 * 8, NI_WOUT = 16 * 16, NI_WU = 16 * 2;
  const int NI_CONV = NI_WIN + NI_WO + NI_WOUT + NI_WU;
  for (int item = blockIdx.x; item < NI_CONV; item += gridDim.x) {
    int it = item;
    if (it < NI_WIN) { conv_tile(p.in[I_WIN] + (size_t)l * 1024 * 8096, 8096, WinT, 1024, (it & 15) * 64, (it >> 4) * 64, 0, 0, smem); continue; }
    it -= NI_WIN;
    if (it < NI_WO) { const int br = it / 128, r2 = it % 128; const float* src = (br == 0 ? opq(p.in[I_WOA]) : (br == 1 ? opq(p.in[I_WOB]) : opq(p.in[I_WOC]))) + (size_t)l * 512 * 1024; conv_tile(src, 1024, WoT + (size_t)br * 1024 * 512, 512, (r2 & 7) * 64, (r2 >> 3) * 64, 1, 0, smem); continue; }
    it -= NI_WO;
    if (it < NI_WOUT) { conv_tile(p.in[I_WOUT] + (size_t)l * 1024 * 1024, 1024, WoutT, 1024, (it & 15) * 64, (it >> 4) * 64, 1, 0, smem); continue; }
    it -= NI_WOUT;
    { const int nt = it >> 1, kt = it & 1; const bool uv = nt >= 8; const float* src = (uv ? opq(p.in[I_WUV]) : opq(p.in[I_WUK])) + (size_t)l * 128 * 512; conv_tile(src, 512, WuT, 128, kt * 64, nt * 64, 1, uv ? 512 : 0, smem); }
  }
  for (int item = blockIdx.x; item < NT / 8; item += gridDim.x) norm_rows2(p, l, item * 8 + wid, item * 8 + 4 + wid, lane);
}

DI bool next_tile(int it, int NTN, int GN, int& mt, int& nt, int MPX = 40, int GM = 8) {
  if (gridDim.x == 512) {
    const int x = blockIdx.x & 7, local = blockIdx.x >> 3;
    const int q = it * 64 + local;
    if (q >= MPX * NTN) return false;
    const int gsz = GM * GN, g = q / gsz, w = q - g * gsz, ngroups = NTN / GN;
    const int mgi = g / ngroups, ngi = g - mgi * ngroups;
    mt = x * MPX + mgi * GM + w / GN; nt = ngi * GN + (w % GN);
    return true;
  }
  const int tile = blockIdx.x + it * gridDim.x;
  if (tile >= 8 * MPX * NTN) return false;
  mt = tile / NTN; nt = tile % NTN;
  return true;
}

DI void phase_gemm1(const Params& p, int l, char* smem) {
  const bf16_t* H = (const bf16_t*)(p.ws + OFF_R1);
  const bf16_t* W = (const bf16_t*)(p.ws + OFF_WIN);
  bf16_t* U = (bf16_t*)(p.ws + OFF_U);
  bf16_t* VAT = (bf16_t*)(p.ws + OFF_VAT);
  const int NTN = 28, ntiles = 320 * NTN;
  for (int it = 0;; ++it) {
    int mt, nt; if (!next_tile(it, NTN, 7, mt, nt)) break;
    const int m0 = mt * 128, n0 = nt * 128;
    f32x16 acc[2][2]; zero_acc<2>(acc);
    gemm_mainloop<2>(acc, H + (size_t)m0 * 1024, 1024, 64, W + (size_t)n0 * 1024, 1024, 1024, smem);
    const int lane = otid() & 63, wid = __builtin_amdgcn_readfirstlane(otid() >> 6), wm = wid >> 1, wn = wid & 1, r = lane & 31, hh = lane >> 5;
    int seq, t0; row_decode(m0, seq, t0);
#pragma unroll
    for (int j = 0; j < 2; ++j) {
      const int cb = n0 + wn * 64 + j * 32;
      if (cb >= ULD) continue;
      const int col = cb + r;
      if (cb >= 640 && cb < 768) {
        const int kvh = (col - 640) >> 6, dv = col & 63, Tk = seq_tk(seq);
        bf16_t* vt = VAT + (size_t)128 * keyrow0(seq) + (size_t)(kvh * 64 + dv) * Tk;
#pragma unroll
        for (int i = 0; i < 2; ++i) {
          const int tt = t0 + wm * 64 + i * 32;
#pragma unroll
          for (int g2 = 0; g2 < 2; ++g2) {
            float v[8];
#pragma unroll
            for (int e = 0; e < 8; ++e) v[e] = acc[i][j][g2 * 8 + e];
            *(u32x4*)(vt + tt + 16 * g2 + 8 * hh) = pack8(v);
          }
          if (seq < 32) {
            float* o = p.out + OUT_AV + ((size_t)(seq * 4 + l) * 256 + tt) * 128;
            const int lo = 4 * hh * 128 + (col - 640);
#pragma unroll
            for (int e = 0; e < 16; ++e) (o + crowu(e) * 128)[lo] = acc[i][j][e];
          }
        }
      } else {
#pragma unroll
        for (int i = 0; i < 2; ++i) {
          bf16_t* up = U + (size_t)(m0 + wm * 64 + i * 32) * ULD;
          const int lo = 4 * hh * ULD + col;
#pragma unroll
          for (int e = 0; e < 16; ++e) (up + crowu(e) * ULD)[lo] = f2bf(acc[i][j][e]);
        }
      }
    }
  }
}

DI void post_row(const Params& p, int l, int row, int lane) {
  int seq, t; row_decode(row, seq, t);
  const bool lat = row >= NCTX;
  const int krow = keyrow0(seq) + t;
  const int prow = t >> 6, pcol = t & 63;
  bf16_t* u = (bf16_t*)(p.ws + OFF_U) + (size_t)row * ULD;
  const float* cs16 = (const float*)(p.ws + OFF_CS16);
  const float* cs8 = (const float*)(p.ws + OFF_CS8);
  const float LOG2E = 1.4426950408889634f;
#pragma unroll
  for (int which = 0; which < 2; ++which) {
    const int l8 = which == 0 ? lane : (lane & 15);
    const bf16_t* src = u + (which == 0 ? 0 : 512) + l8 * 8;
    float v[8]; unpack8(*(const u32x4*)src, v);
    float ss = 0.f;
#pragma unroll
    for (int i = 0; i < 8; ++i) ss += v[i] * v[i];
    ss += shx<1>(ss); ss += shx<2>(ss); ss += shx<4>(ss);
    const float rs = rsqrtf(ss * (1.0f / 64.0f) + 1e-6f);
    const float* nw = (which == 0 ? opq(p.in[I_QNW]) : opq(p.in[I_KNW])) + l * 64 + (lane & 7) * 8;
#pragma unroll
    for (int i = 0; i < 8; ++i) v[i] = v[i] * rs * nw[i];
    float pv[8];
#pragma unroll
    for (int i = 0; i < 8; ++i) pv[i] = shx<2>(v[i]);
    if (lat) {
      const int pos = ((lane & 7) >> 2) ? pcol : prow;
      const bool lower = (lane & 2) == 0;
      const float* cs = cs16 + (pos * 16 + (lane & 1) * 8) * 2;
#pragma unroll
      for (int i = 0; i < 8; ++i) { const float c = cs[i * 2], s = cs[i * 2 + 1]; v[i] = lower ? v[i] * c - pv[i] * s : v[i] * c + pv[i] * s; }
    }
    if (which == 0) {
      const float sc = 0.125f * LOG2E;
#pragma unroll
      for (int i = 0; i < 8; ++i) v[i] *= sc;
      *(u32x4*)(u + lane * 8) = pack8(v);
    } else if (lane < 16) {
      bf16_t* KA = (bf16_t*)(p.ws + OFF_KA);
      *(u32x4*)(KA + (size_t)krow * 128 + lane * 8) = pack8(v);
      if (!lat) {
        float* o = p.out + OUT_AK + ((size_t)(seq * 4 + l) * 256 + t) * 128 + lane * 8;
        *(f32x4*)o = (f32x4){v[0], v[1], v[2], v[3]}; *(f32x4*)(o + 4) = (f32x4){v[4], v[5], v[6], v[7]};
      }
    }
  }
  {
    const float sc = 0.10206207261596577f * LOG2E;
    const int hd = lane >> 3;
    bf16_t* q = u + 768 + hd * 96;
    { float v[8]; unpack8(*(const u32x4*)(q + (lane & 7) * 8), v);
#pragma unroll
      for (int i = 0; i < 8; ++i) v[i] *= sc;
      *(u32x4*)(q + (lane & 7) * 8) = pack8(v); }
    { bf16_t* qr = q + 64 + (lane & 7) * 4;
      const u32x2 w = *(const u32x2*)qr;
      float v[4] = {lo16(w.x), hi16(w.x), lo16(w.y), hi16(w.y)}, pv[4];
#pragma unroll
      for (int i = 0; i < 4; ++i) pv[i] = shx<2>(v[i]);
      if (lat) {
        const int pos = ((lane & 7) >> 2) ? pcol : prow;
        const bool lower = (lane & 2) == 0;
        const float* cs = cs8 + (pos * 8 + (lane & 1) * 4) * 2;
#pragma unroll
        for (int i = 0; i < 4; ++i) { const float c = cs[i * 2], s = cs[i * 2 + 1]; v[i] = lower ? v[i] * c - pv[i] * s : v[i] * c + pv[i] * s; }
      }
      u32x2 o; o.x = pack2(v[0] * sc, v[1] * sc); o.y = pack2(v[2] * sc, v[3] * sc);
      *(u32x2*)qr = o; }
  }
  {
    const unsigned w = *(const unsigned*)(u + 1536 + lane * 2);
    float a = lo16(w), b = hi16(w);
    float ss = a * a + b * b;
ss = wave_sum(ss);
    const float rs = rsqrtf(ss * (1.0f / 128.0f) + 1e-6f);
    const float* nw = p.in[I_KVNW] + l * 128 + lane * 2;
    a = a * rs * nw[0]; b = b * rs * nw[1];
    bf16_t* CKVN = (bf16_t*)(p.ws + OFF_R2);
    *(unsigned*)(CKVN + (size_t)krow * 128 + lane * 2) = pack2(a, b);
    if (!lat) { float* o = p.out + OUT_CKV + ((size_t)(seq * 4 + l) * 256 + t) * 128 + lane * 2; *(f32x2*)o = (f32x2){a, b}; }
  }
  {
    float v = bf2f(u[1664 + (lane & 31)]);
    const float pv = shx<8>(v);
    if (!lat) { if (lane < 32) p.out[OUT_KR + ((size_t)(seq * 4 + l) * 256 + t) * 32 + lane] = v; }
    else {
      const int d = lane & 31; const int pos = (d >> 4) ? pcol : prow; const bool lower = (d & 8) == 0;
      const float* cs = cs8 + (pos * 8 + (d & 7)) * 2;
      v = lower ? v * cs[0] - pv * cs[1] : v * cs[0] + pv * cs[1];
    }
    if (lane < 32) ((bf16_t*)(p.ws + OFF_KRB))[(size_t)krow * 32 + lane] = f2bf(v);
  }
}
DI void post_cached_row(const Params& p, int l, int idx, int lane) {
  const int b = idx >> 9, j = idx & 511;
  const int kr0 = NCTX + b * 4608, krow = kr0 + 4096 + j;
  const size_t cb = ((size_t)(b * 4 + l) * 512 + j);
  bf16_t* KA = (bf16_t*)(p.ws + OFF_KA); bf16_t* VAT = (bf16_t*)(p.ws + OFF_VAT); bf16_t* CKVN = (bf16_t*)(p.ws + OFF_R2); bf16_t* KRB = (bf16_t*)(p.ws + OFF_KRB);
  { const f32x2 v = *(const f32x2*)(p.in[I_CAK] + cb * 128 + lane * 2); *(unsigned*)(KA + (size_t)krow * 128 + lane * 2) = pack2(v.x, v.y); }
  { const f32x2 v = *(const f32x2*)(p.in[I_CAV] + cb * 128 + lane * 2);
    bf16_t* vt = VAT + (size_t)128 * kr0 + (size_t)(lane * 2) * 4608 + perm16(4096 + j);
    vt[0] = f2bf(v.x); vt[4608] = f2bf(v.y); }
  { const f32x2 v = *(const f32x2*)(p.in[I_CCKV] + cb * 128 + lane * 2); *(unsigned*)(CKVN + (size_t)krow * 128 + lane * 2) = pack2(v.x, v.y); }
  if (lane < 32) KRB[(size_t)krow * 32 + lane] = f2bf(p.in[I_CKR][cb * 32 + lane]);
}
DI void phase_post(const Params& p, int l) {
  const int lane = otid() & 63, wid = __builtin_amdgcn_readfirstlane(otid() >> 6);
  for (int item = blockIdx.x; item < NT / 4 + 1024; item += gridDim.x) {
    if (item < NT / 4) post_row(p, l, item * 4 + wid, lane);
    else post_cached_row(p, l, (item - NT / 4) * 4 + wid, lane);
  }
}

DI void phase_upproj(const Params& p, char* smem) {
  const bf16_t* A = (const bf16_t*)(p.ws + OFF_R2);
  const bf16_t* W = (const bf16_t*)(p.ws + OFF_WU);
  bf16_t* KN = (bf16_t*)(p.ws + OFF_KN); bf16_t* VBT = (bf16_t*)(p.ws + OFF_VBT);
  const int ntiles = 352 * 8;
  for (int it = 0;; ++it) {
    int mt, nt; if (!next_tile(it, 8, 8, mt, nt, 44, 4)) break;
    const int m0 = mt * 128, n0 = nt * 128;
    f32x16 acc[2][2]; zero_acc<2>(acc);
    gemm_mainloop<2>(acc, A + (size_t)m0 * 128, 128, 64, W + (size_t)n0 * 128, 128, 128, smem);
    const int lane = otid() & 63, wid = __builtin_amdgcn_readfirstlane(otid() >> 6), wm = wid >> 1, wn = wid & 1, r = lane & 31, hh = lane >> 5;
    int seq, t0;
    if (m0 < NCTX) { seq = m0 >> 8; t0 = m0 & 255; } else { const int rr = m0 - NCTX; seq = 32 + rr / 4608; t0 = rr % 4608; }
#pragma unroll
    for (int j = 0; j < 2; ++j) {
      const int col = n0 + wn * 64 + j * 32 + r;
      if (n0 < 512) {
#pragma unroll
        for (int i = 0; i < 2; ++i) {
          bf16_t* kp = KN + (size_t)(m0 + wm * 64 + i * 32) * 512;
          const int lo = 4 * hh * 512 + col;
#pragma unroll
          for (int e = 0; e < 16; ++e) (kp + crowu(e) * 512)[lo] = f2bf(acc[i][j][e]);
        }
      } else {
        const int Tk = seq_tk(seq);
        bf16_t* vt = VBT + (size_t)512 * keyrow0(seq) + (size_t)(col - 512) * Tk;
#pragma unroll
        for (int i = 0; i < 2; ++i) {
          const int tt = t0 + wm * 64 + i * 32;
#pragma unroll
          for (int g2 = 0; g2 < 2; ++g2) {
            float v[8];
#pragma unroll
            for (int e = 0; e < 8; ++e) v[e] = acc[i][j][g2 * 8 + e];
            *(u32x4*)(vt + tt + 16 * g2 + 8 * hh) = pack8(v);
          }
        }
      }
    }
  }
}

template <int DQK>
DI void attn_item(const bf16_t* Qw, int q_ld, const bf16_t* K1, int k1_ld, const bf16_t* K2, int k2_ld,
                  const bf16_t* Vt, int vt_ld, int nkeys, bf16_t* Ow, int o_ld, char* smem) {
  constexpr int KS = DQK * 2 + 16;
  constexpr int KBYTES = 64 * KS;
  constexpr int VS = 144;
  constexpr int VBYTES = 64 * VS;
  constexpr int STAGE = KBYTES + VBYTES;
  constexpr int CPR = DQK / 8;
  constexpr int NKC = 64 * CPR / 256;
  constexpr int NS = DQK / 16;
  const int tid = otid(), lane = tid & 63, r = lane & 31, hh = lane >> 5;
  bf16x8 qf[NS];
#pragma unroll
  for (int s = 0; s < NS; ++s) qf[s] = *(const bf16x8*)(Qw + (size_t)r * q_ld + 16 * s + 8 * hh);
  f32x16 o[2];
#pragma unroll
  for (int n = 0; n < 2; ++n)
#pragma unroll
    for (int e = 0; e < 16; ++e) o[n][e] = 0.f;
  float m_run = 0.f, lsum = 0.f;
  u32x4 rk0[NKC], rv0[2], rk1[NKC], rv1[2];
  int krow_[NKC], kc_[NKC];
#pragma unroll
  for (int q = 0; q < NKC; ++q) { const int id = q * 256 + tid; krow_[q] = id / CPR; kc_[q] = id % CPR; }
  const int vrow = tid >> 3, vc = tid & 7;
  auto gload = [&](int key0, u32x4 (&rk)[NKC], u32x4 (&rv)[2]) {
#pragma unroll
    for (int q = 0; q < NKC; ++q) {
      const bf16_t* src = (DQK == 64 || kc_[q] < 8) ? K1 + (size_t)(key0 + krow_[q]) * k1_ld + kc_[q] * 8 : K2 + (size_t)(key0 + krow_[q]) * k2_ld + (kc_[q] - 8) * 8;
      rk[q] = *(const u32x4*)src;
    }
#pragma unroll
    for (int q = 0; q < 2; ++q) rv[q] = *(const u32x4*)(Vt + (size_t)(vrow + 32 * q) * vt_ld + key0 + vc * 8);
  };
  auto lstore = [&](int buf, u32x4 (&rk)[NKC], u32x4 (&rv)[2]) {
    char* base = smem + buf * STAGE;
#pragma unroll
    for (int q = 0; q < NKC; ++q) *(u32x4*)(base + krow_[q] * KS + kc_[q] * 16) = rk[q];
#pragma unroll
    for (int q = 0; q < 2; ++q) *(u32x4*)(base + KBYTES + (vrow + 32 * q) * VS + vc * 16) = rv[q];
  };
  const int ntl = nkeys >> 6;
  gload(0, rk0, rv0); lstore(0, rk0, rv0);
  gload(64, rk1, rv1);
  if (ntl > 2) gload(128, rk0, rv0);
  __syncthreads();
  auto tile_body = [&](int tl, u32x4 (&rkn)[NKC], u32x4 (&rvn)[2]) {
    const char* base = smem + (tl & 1) * STAGE;
    bf16x8 kf[2][NS], vf[2][2][2];
#pragma unroll
    for (int kb = 0; kb < 2; ++kb)
#pragma unroll
      for (int ks = 0; ks < NS; ++ks) kf[kb][ks] = *(const bf16x8*)(base + (kb * 32 + r) * KS + (2 * ks + hh) * 16);
    __builtin_amdgcn_sched_barrier(0);
    f32x16 s[2];
    const float ninit = -m_run;
#pragma unroll
    for (int kb = 0; kb < 2; ++kb)
#pragma unroll
      for (int e = 0; e < 16; ++e) s[kb][e] = ninit;
#pragma unroll
    for (int ks = 0; ks < NS; ++ks)
#pragma unroll
      for (int kb = 0; kb < 2; ++kb) s[kb] = MFMA32(kf[kb][ks], qf[ks], s[kb]);
#pragma unroll
    for (int kb = 0; kb < 2; ++kb)
#pragma unroll
      for (int s2 = 0; s2 < 2; ++s2)
#pragma unroll
        for (int n = 0; n < 2; ++n) vf[kb][s2][n] = *(const bf16x8*)(base + KBYTES + (32 * n + r) * VS + (kb * 32 + 16 * s2 + 8 * hh) * 2);
    __builtin_amdgcn_sched_barrier(0);
    float mx = s[0][0];
#pragma unroll
    for (int kb = 0; kb < 2; ++kb)
#pragma unroll
      for (int e = 0; e < 16; ++e) mx = fmaxf(mx, s[kb][e]);
    { const unsigned u = __float_as_uint(mx); auto sw = __builtin_amdgcn_permlane32_swap(u, u, false, false); mx = fmaxf(__uint_as_float(sw[0]), __uint_as_float(sw[1])); }
    const bool move = (mx > 4.0f) || (mx < -20.0f);
    if (__builtin_amdgcn_ballot_w64(move) != 0ull) {
      const float dlt = move ? mx : 0.f;
      const float alpha = __builtin_amdgcn_exp2f(-dlt);
      m_run += dlt;
      lsum *= alpha;
#pragma unroll
      for (int kb = 0; kb < 2; ++kb)
#pragma unroll
        for (int e = 0; e < 16; ++e) s[kb][e] -= dlt;
#pragma unroll
      for (int n = 0; n < 2; ++n)
#pragma unroll
        for (int e = 0; e < 16; ++e) o[n][e] *= alpha;
    }
    float ps = 0.f;
#pragma unroll
    for (int kb = 0; kb < 2; ++kb)
#pragma unroll
      for (int e = 0; e < 16; ++e) { const float pe = __builtin_amdgcn_exp2f(s[kb][e]); s[kb][e] = pe; ps += pe; }
    lsum += ps;
#pragma unroll
    for (int kb = 0; kb < 2; ++kb)
#pragma unroll
      for (int s2 = 0; s2 < 2; ++s2) {
        u32x4 pw;
        pw.x = pack2(s[kb][8 * s2 + 0], s[kb][8 * s2 + 1]); pw.y = pack2(s[kb][8 * s2 + 2], s[kb][8 * s2 + 3]);
        pw.z = pack2(s[kb][8 * s2 + 4], s[kb][8 * s2 + 5]); pw.w = pack2(s[kb][8 * s2 + 6], s[kb][8 * s2 + 7]);
        const bf16x8 pf = __builtin_bit_cast(bf16x8, pw);
#pragma unroll
        for (int n = 0; n < 2; ++n) o[n] = MFMA32(vf[kb][s2][n], pf, o[n]);
      }
    if (tl + 1 < ntl) { lstore((tl + 1) & 1, rkn, rvn); if (tl + 3 < ntl) gload((tl + 3) * 64, rkn, rvn); }
    __syncthreads();
  };
  for (int tl = 0; tl < ntl; tl += 2) { tile_body(tl, rk1, rv1); tile_body(tl + 1, rk0, rv0); }
  lsum = xsum32(lsum);
  const float inv = 1.0f / lsum;
#pragma unroll
  for (int n = 0; n < 2; ++n)
#pragma unroll
    for (int g = 0; g < 4; ++g) {
      u32x2 w; w.x = pack2(o[n][4 * g] * inv, o[n][4 * g + 1] * inv); w.y = pack2(o[n][4 * g + 2] * inv, o[n][4 * g + 3] * inv);
      *(u32x2*)(Ow + (size_t)r * o_ld + 32 * n + 8 * g + 4 * hh) = w;
    }
}

DI void scan_item(const Params& p, int l, int seq, int hd, int dir, int rs, char* smem) {
  const int tid = otid(), lane = tid & 63, wv = __builtin_amdgcn_readfirstlane(tid >> 6);
  const int j8 = lane & 7, r = lane & 31, hh = lane >> 5;
  const bool lat = seq >= 32;
  const int T = lat ? 4096 : 256;
  const int row0 = lat ? NCTX + (seq - 32) * 4096 : seq * 256;
  float* vA = (float*)smem; float* vK = vA + 2048; float* vR = vK + 2048; float* vV = vR + 2048; float* vW = vV + 2048; float* vB = vW + 2048; float* ybuf = vB + 2048;
  char* raw = smem + 32768;
  char* wdx = smem + 57344; char* adx = smem + 61952;
  float* tmpb = (float*)(smem + 66816);
  const bf16_t* U = (const bf16_t*)(p.ws + OFF_U);
  bf16_t* Y = (bf16_t*)(p.ws + OFF_R2) + (dir ? (size_t)NT * 512 : 0);
  float* bonus = (float*)(p.ws + OFF_BONUS);
  const int lrow = 8 * wv + (lane >> 3), irow = rs * 32 + lrow;
  f32x2 S[4];
  if (lat) {
    const float* s0 = (dir ? opq(p.in[I_SB]) : opq(p.in[I_SF])) + ((size_t)((seq - 32) * 4 + l) * 8 + hd) * 4096 + irow * 64 + j8 * 8;
#pragma unroll
    for (int q = 0; q < 2; ++q) { const f32x4 v = *(const f32x4*)(s0 + 4 * q); S[2 * q] = (f32x2){v.x, v.y}; S[2 * q + 1] = (f32x2){v.z, v.w}; }
  } else {
#pragma unroll
    for (int q = 0; q < 4; ++q) S[q] = (f32x2){0.f, 0.f};
  }
  const int mat = wv >> 1, ntc = wv & 1, cch = ntc * 32 + r, hc = hd * 64 + cch;
  bf16x8 bfrag[4];
  {
    const float* W = (mat ? opq(p.in[I_AUP]) : opq(p.in[I_WUP])) + (size_t)(l * 2 + dir) * 64 * 512 + hc;
#pragma unroll
    for (int s4 = 0; s4 < 4; ++s4) {
      float w8[8];
#pragma unroll
      for (int j = 0; j < 8; ++j) w8[j] = W[(size_t)(16 * s4 + 8 * hh + j) * 512];
      bfrag[s4] = __builtin_bit_cast(bf16x8, pack8(w8));
    }
  }
  const float bias = (mat ? opq(p.in[I_A0]) : opq(p.in[I_W0]))[(l * 2 + dir) * 512 + hc];
  const float kav = p.in[I_KA][l * 512 + hc], rkv = p.in[I_RK][l * 512 + hc];
  float* muP = (float*)(smem + 75008); float* muN = muP + 320; float* kkL = muN + 320;
  {
    const float* mup = p.in[I_MUP] + l * 1792; const float* mun = p.in[I_MUN] + l * 1792;
    for (int e = tid; e < 320; e += 256) { const int g = e >> 6, c = e & 63; const int col = (g < 3 ? g * 512 + hd * 64 : (g == 3 ? 1536 + dir * 64 : 1664 + dir * 64)) + c; muP[e] = mup[col]; muN[e] = mun[col]; }
    if (tid < 64) kkL[tid] = p.in[I_KK][l * 512 + hd * 64 + tid];
  }
  const int nch = T >> 5;
  u32x4 pre[6];
  auto prefetch = [&](int t0) {
#pragma unroll
    for (int q = 0; q < 6; ++q) {
      const int id = q * 256 + tid;
      const int row = id / 40, cc = id - row * 40, g = cc >> 3, c8 = cc & 7;
      const int t = t0 - 1 + row;
      const int col = (g < 3 ? g * 512 + hd * 64 : (g == 3 ? 1536 + dir * 64 : 1664 + dir * 64)) + c8 * 8;
      u32x4 v = (u32x4){0u, 0u, 0u, 0u};
      if (id < 1360 && t >= 0 && t < T) v = *(const u32x4*)(U + (size_t)(row0 + t) * ULD + 1696 + col);
      pre[q] = v;
    }
  };
  prefetch((dir ? nch - 1 : 0) * 32);
  for (int ci = 0; ci < nch; ++ci) {
    const int t0 = (dir ? nch - 1 - ci : ci) * 32;
#pragma unroll
    for (int q = 0; q < 6; ++q) { const int id = q * 256 + tid; if (id < 1360) *(u32x4*)(raw + id * 16) = pre[q]; }
    __syncthreads();
    if (ci + 1 < nch) prefetch((dir ? nch - 2 - ci : ci + 1) * 32);
    {
      const int tt = tid >> 3, sub = tid & 7;
#pragma unroll 1
      for (int g = 0; g < 5; ++g) {
        const int col = (g < 3 ? g * 512 + hd * 64 : (g == 3 ? 1536 + dir * 64 : 1664 + dir * 64)) + sub * 8;
        float c[8], pv[8], nx[8], x[8];
        unpack8(*(const u32x4*)(raw + (tt + 1) * 640 + (g * 8 + sub) * 16), c);
        unpack8(*(const u32x4*)(raw + tt * 640 + (g * 8 + sub) * 16), pv);
        unpack8(*(const u32x4*)(raw + (tt + 2) * 640 + (g * 8 + sub) * 16), nx);
        const f32x4 mp0 = *(const f32x4*)(muP + g * 64 + sub * 8), mp1 = *(const f32x4*)(muP + g * 64 + sub * 8 + 4), mn0 = *(const f32x4*)(muN + g * 64 + sub * 8), mn1 = *(const f32x4*)(muN + g * 64 + sub * 8 + 4);
        const float mp[8] = {mp0.x, mp0.y, mp0.z, mp0.w, mp1.x, mp1.y, mp1.z, mp1.w}, mn[8] = {mn0.x, mn0.y, mn0.z, mn0.w, mn1.x, mn1.y, mn1.z, mn1.w};
#pragma unroll
        for (int i = 0; i < 8; ++i) x[i] = c[i] + mp[i] * (pv[i] - c[i]) + mn[i] * (nx[i] - c[i]);
        const int lo = tt * 64 + sub * 8;
        if (g == 0) { *(f32x4*)(vR + lo) = (f32x4){x[0], x[1], x[2], x[3]}; *(f32x4*)(vR + lo + 4) = (f32x4){x[4], x[5], x[6], x[7]}; }
        else if (g == 1) {
          float kk[8], ss = 0.f;
          const float* kkw = kkL + sub * 8;
#pragma unroll
          for (int i = 0; i < 8; ++i) { kk[i] = x[i] * kkw[i]; ss += kk[i] * kk[i]; }
          *(f32x4*)(vK + lo) = (f32x4){x[0], x[1], x[2], x[3]}; *(f32x4*)(vK + lo + 4) = (f32x4){x[4], x[5], x[6], x[7]};
          ss += shx<1>(ss); ss += shx<2>(ss); ss += shx<4>(ss);
          const float inv = 1.0f / fmaxf(sqrtf(ss), 1e-12f);
          *(f32x4*)(vA + lo) = (f32x4){kk[0] * inv, kk[1] * inv, kk[2] * inv, kk[3] * inv}; *(f32x4*)(vA + lo + 4) = (f32x4){kk[4] * inv, kk[5] * inv, kk[6] * inv, kk[7] * inv};
        }
        else if (g == 2) { *(f32x4*)(vV + lo) = (f32x4){x[0], x[1], x[2], x[3]}; *(f32x4*)(vV + lo + 4) = (f32x4){x[4], x[5], x[6], x[7]}; }
        else if (g == 3) { float th[8]; for (int i = 0; i < 8; ++i) th[i] = 1.0f - 2.0f * __builtin_amdgcn_rcpf(1.0f + __expf(2.0f * x[i])); *(u32x4*)(wdx + tt * 144 + sub * 16) = pack8(th); }
        else { *(u32x4*)(adx + tt * 144 + sub * 16) = pack8(x); }
      }
    }
    __syncthreads();
    {
      f32x16 acc;
#pragma unroll
      for (int e = 0; e < 16; ++e) acc[e] = 0.f;
      const char* xb = mat ? adx : wdx;
#pragma unroll
      for (int s4 = 0; s4 < 4; ++s4) { const bf16x8 af = *(const bf16x8*)(xb + r * 144 + (16 * s4 + 8 * hh) * 2); acc = MFMA32(af, bfrag[s4], acc); }
      if (mat == 0) {
#pragma unroll
        for (int e = 0; e < 16; ++e) vW[crow(e, hh) * 64 + cch] = __expf(-0.6065306597126334f * sigmoidf_(bias + acc[e]));
      } else {
#pragma unroll
        for (int e = 0; e < 16; ++e) {
          const int ix = crow(e, hh) * 64 + cch;
          const float ag = sigmoidf_(bias + acc[e]);
          const float kk = vA[ix], k = vK[ix], rr = vR[ix];
          const float kd = k * (1.0f + (ag - 1.0f) * kav);
          vK[ix] = kd; vA[ix] = -kk; vB[ix] = kk * ag; tmpb[ix] = rr * kd * rkv;
        }
      }
    }
    __syncthreads();
    {
      const int tt = tid >> 3, sub = tid & 7;
      const f32x4 b0 = *(const f32x4*)(tmpb + tt * 64 + sub * 8), b1 = *(const f32x4*)(tmpb + tt * 64 + sub * 8 + 4);
      float bs = (b0.x + b0.y) + (b0.z + b0.w) + (b1.x + b1.y) + (b1.z + b1.w);
      bs += shx<1>(bs); bs += shx<2>(bs); bs += shx<4>(bs);
      if (sub == 0 && rs == 0) bonus[((size_t)(row0 + t0 + tt) * 8 + hd) * 2 + dir] = bs;
    }
    {
      f32x4 va[2], vw[2], vb[2], vk[2], vr[2]; float vi;
      int tt = dir ? 31 : 0;
      int vo = tt * 64 + j8 * 8;
#pragma unroll
      for (int q = 0; q < 2; ++q) { va[q] = *(const f32x4*)(vA + vo + 4 * q); vw[q] = *(const f32x4*)(vW + vo + 4 * q); vb[q] = *(const f32x4*)(vB + vo + 4 * q); vk[q] = *(const f32x4*)(vK + vo + 4 * q); vr[q] = *(const f32x4*)(vR + vo + 4 * q); }
      vi = vV[tt * 64 + irow];
      for (int si = 0; si < 32; ++si) {
        const int ttn = dir ? (si < 31 ? 30 - si : 0) : (si < 31 ? si + 1 : 31);
        const int von = ttn * 64 + j8 * 8;
        f32x2 pa2 = S[0] * (f32x2){va[0].x, va[0].y}, pa3 = S[1] * (f32x2){va[0].z, va[0].w};
        pa2 += S[2] * (f32x2){va[1].x, va[1].y}; pa3 += S[3] * (f32x2){va[1].z, va[1].w};
#pragma unroll
        for (int q = 0; q < 2; ++q) va[q] = *(const f32x4*)(vA + von + 4 * q);
        pa2 += pa3;
        const float sa = osum(pa2.x + pa2.y);
        const f32x2 sa2 = (f32x2){sa, sa}, vi2 = (f32x2){vi, vi};
        f32x2 py2, py3;
        S[0] = S[0] * (f32x2){vw[0].x, vw[0].y} + (sa2 * (f32x2){vb[0].x, vb[0].y} + vi2 * (f32x2){vk[0].x, vk[0].y}); py2 = S[0] * (f32x2){vr[0].x, vr[0].y};
        S[1] = S[1] * (f32x2){vw[0].z, vw[0].w} + (sa2 * (f32x2){vb[0].z, vb[0].w} + vi2 * (f32x2){vk[0].z, vk[0].w}); py3 = S[1] * (f32x2){vr[0].z, vr[0].w};
        S[2] = S[2] * (f32x2){vw[1].x, vw[1].y} + (sa2 * (f32x2){vb[1].x, vb[1].y} + vi2 * (f32x2){vk[1].x, vk[1].y}); py2 += S[2] * (f32x2){vr[1].x, vr[1].y};
        S[3] = S[3] * (f32x2){vw[1].z, vw[1].w} + (sa2 * (f32x2){vb[1].z, vb[1].w} + vi2 * (f32x2){vk[1].z, vk[1].w}); py3 += S[3] * (f32x2){vr[1].z, vr[1].w};
#pragma unroll
        for (int q = 0; q < 2; ++q) { vw[q] = *(const f32x4*)(vW + von + 4 * q); vb[q] = *(const f32x4*)(vB + von + 4 * q); vk[q] = *(const f32x4*)(vK + von + 4 * q); vr[q] = *(const f32x4*)(vR + von + 4 * q); }
        vi = vV[ttn * 64 + irow];
        py2 += py3;
        const float py = osum(py2.x + py2.y);
        ybuf[tt * 32 + lrow] = py;
        tt = ttn;
      }
    }
    __syncthreads();
    {
      const int tt = tid >> 3, sub = tid & 7;
      const f32x4 y0 = *(const f32x4*)(ybuf + tt * 32 + sub * 4);
      u32x2 w; w.x = pack2(y0.x, y0.y); w.y = pack2(y0.z, y0.w);
      *(u32x2*)(Y + (size_t)(row0 + t0 + tt) * 512 + hd * 64 + rs * 32 + sub * 4) = w;
    }
    __syncthreads();
  }
  if (!lat) {
    float* o = opq(p.out) + (dir ? OUT_SB : OUT_SF) + ((size_t)(seq * 4 + l) * 8 + hd) * 4096 + irow * 64 + j8 * 8;
#pragma unroll
    for (int q = 0; q < 2; ++q) *(f32x4*)(o + 4 * q) = (f32x4){S[2 * q].x, S[2 * q].y, S[2 * q + 1].x, S[2 * q + 1].y};
  }
}

DI void phase_mixers(const Params& p, int l, char* smem, int part = 0) {
  const int tid = otid(), wid = __builtin_amdgcn_readfirstlane(tid >> 6);
  unsigned* cnt = (unsigned*)(p.ws + OFF_CNT) + l * 8;
  int* slot = (int*)(smem + SMEM_BYTES - 16);
  bf16_t* U = (bf16_t*)(p.ws + OFF_U);
  const bf16_t* KA = (const bf16_t*)(p.ws + OFF_KA); const bf16_t* VAT = (const bf16_t*)(p.ws + OFF_VAT);
  const bf16_t* KN = (const bf16_t*)(p.ws + OFF_KN); const bf16_t* VBT = (const bf16_t*)(p.ws + OFF_VBT); const bf16_t* KRB = (const bf16_t*)(p.ws + OFF_KRB);
  const int QLEN = 256 + 256 + 128 + 64 + 64;
  bool first = true;
  int xq = blockIdx.x & 7, tries = 0;
  for (;;) {
    int kind, seq, a, qt;
    if (first && blockIdx.x < 256) {
      const int item = blockIdx.x; kind = 0; seq = 32 + (item >> 5); a = (item >> 2) & 7; qt = item & 3;
      first = false;
    } else {
      first = false;
      if (tid == 0) *slot = (int)atomicAdd(cnt + xq, 1u);
      __syncthreads();
      const int i = __builtin_amdgcn_readfirstlane(*slot);
      __syncthreads();
      if (i >= QLEN) { if (++tries >= 8) break; xq = (xq + 1) & 7; continue; }
      if (i < 256) { const int g = xq + 8 * (i >> 7); kind = 1; seq = 32 + (g >> 1); a = g & 1; qt = i & 127; }
      else if (i < 512) { const int j = i - 256; const int g = xq + 8 * (j >> 5); kind = 2; seq = 32 + (g >> 3); a = g & 7; qt = j & 31; }
      else if (i < 640) { const int j = i - 512; kind = 0; seq = xq + 8 * (j >> 5); a = (j >> 2) & 7; qt = j & 3; }
      else if (i < 704) { const int j = i - 640; kind = 1; seq = xq + 8 * (j >> 4); a = (j >> 3) & 1; qt = j & 7; }
      else { const int j = i - 704; kind = 2; seq = xq + 8 * (j >> 4); a = (j >> 1) & 7; qt = j & 1; }
    }
    const int kr0 = keyrow0(seq), Tk = seq_tk(seq);
    const int row0 = seq < 32 ? seq * 256 : NCTX + (seq - 32) * 4096;
    if (kind == 0) scan_item(p, l, seq, a, qt & 1, qt >> 1, smem);
    else if (kind == 1) {
      const int qh = a * 4 + wid;
      bf16_t* q = U + (size_t)(row0 + qt * 32) * ULD + qh * 64;
      attn_item<64>(q, ULD, KA + (size_t)kr0 * 128 + a * 64, 128, nullptr, 0, VAT + (size_t)128 * kr0 + (size_t)(a * 64) * Tk, Tk, Tk, q, ULD, smem);
    } else {
      bf16_t* q = U + (size_t)(row0 + qt * 128 + wid * 32) * ULD + 768 + a * 96;
      attn_item<96>(q, ULD, KN + (size_t)kr0 * 512 + a * 64, 512, KRB + (size_t)kr0 * 32, 32, VBT + (size_t)512 * kr0 + (size_t)(a * 64) * Tk, Tk, Tk, q, ULD, smem);
    }
  }
}

DI void cpost_row(const Params& p, int l, int row, int lane) {
  int seq, t; row_decode(row, seq, t);
  const int T = seq < 32 ? 256 : 4096;
  const bf16_t* YF = (const bf16_t*)(p.ws + OFF_R2); const bf16_t* YB = YF + (size_t)NT * 512;
  bf16_t* u = (bf16_t*)(p.ws + OFF_U) + (size_t)row * ULD + 1696;
  const float* bonus = (const float*)(p.ws + OFF_BONUS);
  float yf[8], yb[8], y[8];
  unpack8(*(const u32x4*)(YF + (size_t)row * 512 + lane * 8), yf);
  unpack8(*(const u32x4*)(YB + (size_t)row * 512 + lane * 8), yb);
  float s = 0.f;
#pragma unroll
  for (int i = 0; i < 8; ++i) { y[i] = yf[i] + yb[i]; s += y[i]; }
  s += shx<1>(s); s += shx<2>(s); s += shx<4>(s);
  const float mu = s * (1.0f / 64.0f);
  float q = 0.f;
#pragma unroll
  for (int i = 0; i < 8; ++i) { y[i] -= mu; q += y[i] * y[i]; }
  q += shx<1>(q); q += shx<2>(q); q += shx<4>(q);
  const float rs = rsqrtf(q * (1.0f / 64.0f) + 64e-5f);
  const int col = 1024 + lane * 8;
  float c[8], pv[8], nx[8];
  unpack8(*(const u32x4*)(u + col), c);
  if (t > 0) unpack8(*(const u32x4*)(u - ULD + col), pv); else { for (int i = 0; i < 8; ++i) pv[i] = 0.f; }
  if (t < T - 1) unpack8(*(const u32x4*)(u + ULD + col), nx); else { for (int i = 0; i < 8; ++i) nx[i] = 0.f; }
  const float* mup = p.in[I_MUP] + l * 1792 + col; const float* mun = p.in[I_MUN] + l * 1792 + col;
  const float* lw = p.in[I_LNW] + l * 512 + lane * 8; const float* lb = p.in[I_LNB] + l * 512 + lane * 8;
  const f32x2 bsv = *(const f32x2*)(bonus + ((size_t)row * 8 + (lane >> 3)) * 2);
  const float bs = bsv.x + bsv.y;
  float o[8];
#pragma unroll
  for (int i = 0; i < 8; ++i) { const float v = c[i] + mup[i] * (pv[i] - c[i]) + mun[i] * (nx[i] - c[i]); o[i] = y[i] * rs * lw[i] + lb[i] + bs * v; }
  *(u32x4*)(u + lane * 8) = pack8(o);
}
DI void phase_renorm_cpost(const Params& p, int l) {
  const int lane = otid() & 63, wid = __builtin_amdgcn_readfirstlane(otid() >> 6);
  for (int item = blockIdx.x; item < NT / 8; item += gridDim.x) { const int ra = item * 8 + wid, rb = ra + 4; norm_rows2(p, l, ra, rb, lane); cpost_row(p, l, ra, lane); cpost_row(p, l, rb, lane); }
}

DI void phase_zgemm(const Params& p, char* smem) {
  const bf16_t* H = (const bf16_t*)(p.ws + OFF_R1);
  const bf16_t* W = (const bf16_t*)(p.ws + OFF_WIN) + (size_t)3584 * 1024;
  bf16_t* U = (bf16_t*)(p.ws + OFF_U);
  const int ntiles = 320 * 12;
  for (int it = 0;; ++it) {
    int mt, nt; if (!next_tile(it, 12, 6, mt, nt)) break;
    const int m0 = mt * 128, n0 = nt * 128;
    f32x16 acc[2][2]; zero_acc<2>(acc);
    gemm_mainloop<2>(acc, H + (size_t)m0 * 1024, 1024, 64, W + (size_t)n0 * 1024, 1024, 1024, smem);
    const int lane = otid() & 63, wid = __builtin_amdgcn_readfirstlane(otid() >> 6), wm = wid >> 1, wn = wid & 1, r = lane & 31, hh = lane >> 5;
#pragma unroll
    for (int j = 0; j < 2; ++j) {
      const int col = n0 + wn * 64 + j * 32 + r;
      const int br = col >> 9, cc = col & 511;
      const int ucol = br == 0 ? cc : (br == 1 ? 768 + (cc >> 6) * 96 + (cc & 63) : 1696 + cc);
#pragma unroll
      for (int i = 0; i < 2; ++i) {
        bf16_t* up = U + (size_t)(m0 + wm * 64 + i * 32) * ULD;
        const int lo = 4 * hh * ULD + ucol;
        bf16_t yv[16];
#pragma unroll
        for (int e = 0; e < 16; ++e) yv[e] = (up + crowu(e) * ULD)[lo];
#pragma unroll
        for (int e = 0; e < 16; ++e) (up + crowu(e) * ULD)[lo] = f2bf(bf2f(yv[e]) * siluf_(acc[i][j][e]));
      }
    }
  }
}

DI void phase_merge(const Params& p, char* smem) {
  const bf16_t* H = (const bf16_t*)(p.ws + OFF_R1);
  const bf16_t* WG = (const bf16_t*)(p.ws + OFF_WIN) + (size_t)5120 * 1024;
  const bf16_t* WO = (const bf16_t*)(p.ws + OFF_WO);
  const bf16_t* U = (const bf16_t*)(p.ws + OFF_U);
  bf16_t* MX = (bf16_t*)(p.ws + OFF_R2);
  const int ntiles = 320 * 8;
  for (int it = 0;; ++it) {
    int mt, nt; if (!next_tile(it, 8, 8, mt, nt)) break;
    const int m0 = mt * 128, n0 = nt * 128;
    f32x16 mix[2][2]; zero_acc<2>(mix);
    unsigned gs[2][2][8];
#pragma unroll 1
    for (int step = 0; step < 6; ++step) {
      const int br = step >> 1, isT = step & 1;
      const int acol = br == 0 ? 0 : (br == 1 ? 768 : 1696);
      const bf16_t* Ap = isT ? U + (size_t)m0 * ULD + acol : H + (size_t)m0 * 1024;
      const bf16_t* Bp = isT ? WO + (size_t)(br * 1024 + n0) * 512 : WG + (size_t)(br * 1024 + n0) * 1024;
      f32x16 cur[2][2]; zero_acc<2>(cur);
      gemm_mainloop<2>(cur, Ap, isT ? ULD : 1024, (isT && br == 1) ? 96 : 64, Bp, isT ? 512 : 1024, isT ? 512 : 1024, smem);
      if (isT) {
#pragma unroll
        for (int i = 0; i < 2; ++i)
#pragma unroll
          for (int j = 0; j < 2; ++j)
#pragma unroll
            for (int e = 0; e < 8; ++e) { mix[i][j][2 * e] += lo16(gs[i][j][e]) * cur[i][j][2 * e]; mix[i][j][2 * e + 1] += hi16(gs[i][j][e]) * cur[i][j][2 * e + 1]; }
      } else {
#pragma unroll
        for (int i = 0; i < 2; ++i)
#pragma unroll
          for (int j = 0; j < 2; ++j)
#pragma unroll
            for (int e = 0; e < 8; ++e) gs[i][j][e] = pack2(sigmoidf_(cur[i][j][2 * e]), sigmoidf_(cur[i][j][2 * e + 1]));
      }
    }
    const int lane = otid() & 63, wid = __builtin_amdgcn_readfirstlane(otid() >> 6), wm = wid >> 1, wn = wid & 1, r = lane & 31, hh = lane >> 5;
#pragma unroll
    for (int j = 0; j < 2; ++j) {
      const int col = n0 + wn * 64 + j * 32 + r;
#pragma unroll
      for (int i = 0; i < 2; ++i) {
        bf16_t* mp = MX + (size_t)(m0 + wm * 64 + i * 32) * 1024;
        const int lo = 4 * hh * 1024 + col;
#pragma unroll
        for (int e = 0; e < 16; ++e) (mp + crowu(e) * 1024)[lo] = f2bf(mix[i][j][e]);
      }
    }
  }
}

DI void phase_out(const Params& p, int l, char* smem) {
  const bf16_t* MX = (const bf16_t*)(p.ws + OFF_R2);
  const bf16_t* W = (const bf16_t*)(p.ws + OFF_WOUT);
  const int ntiles = 320 * 8;
  for (int it = 0;; ++it) {
    int mt, nt; if (!next_tile(it, 8, 8, mt, nt)) break;
    const int m0 = mt * 128, n0 = nt * 128;
    f32x16 acc[2][2]; zero_acc<2>(acc);
    gemm_mainloop<2>(acc, MX + (size_t)m0 * 1024, 1024, 64, W + (size_t)n0 * 1024, 1024, 1024, smem);
    const int lane = otid() & 63, wid = __builtin_amdgcn_readfirstlane(otid() >> 6), wm = wid >> 1, wn = wid & 1, r = lane & 31, hh = lane >> 5;
    const int jm = m0 < NCTX ? 0 : 1 + ((m0 - NCTX) >> 12);
    const float* gate = (const float*)(p.ws + OFF_MOD) + ((size_t)l * 9 + jm) * MODLD + 2048;
    const float* xsrc = x_row_ptr(p, l, m0);
#pragma unroll
    for (int j = 0; j < 2; ++j) {
      const int col = n0 + wn * 64 + j * 32 + r;
      const float gv = gate[col];
      const int lo = 4 * hh * 1024 + col;
#pragma unroll
      for (int i = 0; i < 2; ++i) {
        const float* xs = xsrc + (size_t)(wm * 64 + i * 32) * 1024;
        float* xo = p.out + (size_t)(m0 + wm * 64 + i * 32) * 1024;
        float xv[16];
#pragma unroll
        for (int e = 0; e < 16; ++e) xv[e] = (xs + crowu(e) * 1024)[lo];
#pragma unroll
        for (int e = 0; e < 16; ++e) (xo + crowu(e) * 1024)[lo] = xv[e] + gv * acc[i][j][e];
      }
    }
  }
}

DI void phase_final(const Params& p) {
  const int lane = otid() & 63, wid = __builtin_amdgcn_readfirstlane(otid() >> 6);
  const float* nw = p.in[I_FNW];
  for (int item = blockIdx.x; item < NT / 4; item += gridDim.x) {
    float* x = p.out + (size_t)(item * 4 + wid) * 1024;
    f32x4 v[4]; float ss = 0.f;
#pragma unroll
    for (int i = 0; i < 4; ++i) { v[i] = *(const f32x4*)(x + lane * 4 + 256 * i); ss += v[i].x * v[i].x + v[i].y * v[i].y + v[i].z * v[i].z + v[i].w * v[i].w; }
ss = wave_sum(ss);
    const float rs = rsqrtf(ss * (1.0f / 1024.0f) + 1e-6f);
#pragma unroll
    for (int i = 0; i < 4; ++i) { const f32x4 w = *(const f32x4*)(nw + lane * 4 + 256 * i); *(f32x4*)(x + lane * 4 + 256 * i) = (f32x4){v[i].x * rs * w.x, v[i].y * rs * w.y, v[i].z * rs * w.z, v[i].w * rs * w.w}; }
  }
}

DI void grid_barrier(unsigned* bar, unsigned& epoch) {
  epoch += 1u;
  __syncthreads();
  if (otid() == 0) {
    const unsigned grp = blockIdx.x & 7u, per = gridDim.x >> 3;
    __builtin_amdgcn_fence(__ATOMIC_RELEASE, "agent");
    const unsigned old = __hip_atomic_fetch_add(bar + grp * 32, 1u, __ATOMIC_RELAXED, __HIP_MEMORY_SCOPE_AGENT);
    if (old + 1u == epoch * per) __hip_atomic_fetch_add(bar + 8 * 32, 1u, __ATOMIC_RELAXED, __HIP_MEMORY_SCOPE_AGENT);
    while (__hip_atomic_load(bar + 8 * 32, __ATOMIC_RELAXED, __HIP_MEMORY_SCOPE_AGENT) < epoch * 8u) __builtin_amdgcn_s_sleep(1);
    __builtin_amdgcn_fence(__ATOMIC_ACQUIRE, "agent");
  }
  __syncthreads();
}

constexpr int NPHASES = 1 + 4 * 9 + 1;
__global__ void __launch_bounds__(256, 2) fwd_kernel(Params p0) {
  __shared__ __attribute__((aligned(16))) char smem[SMEM_BYTES];
  cg::grid_group grid = cg::this_grid();
  const int ph_begin = p0.ph_begin, ph_end = p0.ph_end;
  unsigned* bar = (unsigned*)(p0.ws + OFF_BAR);
  unsigned epoch = 0u;
  for (int ph = ph_begin; ph < ph_end; ++ph) {
    auto kp = __builtin_amdgcn_kernarg_segment_ptr();
    asm volatile("" : "+s"(kp));
    typedef const __attribute__((address_space(4))) Params CParams;
    CParams* kpp = (CParams*)kp;
    Params p;
#pragma unroll
    for (int i = 0; i < 35; ++i) p.in[i] = kpp->in[i];
    p.out = kpp->out; p.ws = kpp->ws; p.ph_begin = ph_begin; p.ph_end = ph_end;
    if (ph == 0) phase_prologue(p, smem);
    else if (ph == NPHASES - 1) phase_final(p);
    else {
      const int l = (ph - 1) / 9, sp = (ph - 1) % 9;
#ifdef PROBE_SP
      if (sp == PROBE_SP) {
        switch (sp) {
          case 0: phase_norm_convert(p, l, smem); break;
          case 1: phase_gemm1(p, l, smem); break;
          case 3: phase_upproj(p, smem); break;
          case 5: phase_renorm_cpost(p, l); break;
          case 7: phase_merge(p, smem); break;
          default: break;
        }
        grid.sync();
      }
#endif
      switch (sp) {
        case 0: phase_norm_convert(p, l, smem); break;
        case 1: phase_gemm1(p, l, smem); break;
        case 2: phase_post(p, l); break;
        case 3: phase_upproj(p, smem); break;
        case 4: phase_mixers(p, l, smem); break;
        case 5: phase_renorm_cpost(p, l); break;
        case 6: phase_zgemm(p, smem); break;
        case 7: phase_merge(p, smem); break;
        default: phase_out(p, l, smem); break;
      }
    }
    if (ph + 1 < ph_end) { if (ph == 0) grid.sync(); else grid_barrier(bar, epoch); }
  }
}

extern "C" void kernel_launch(void* const* d_in, const int* in_sizes, int n_in, void* d_out, int out_size, void* d_ws, size_t ws_size, hipStream_t stream) {
  if (ws_size < WS_NEED || n_in < 35) { fprintf(stderr, "workspace too small: %zu < %zu\n", ws_size, WS_NEED); return; }
  static int grid_blocks = 0;
  if (!grid_blocks) {
    int dev = 0, cus = 0, per_cu = 0;
    hipGetDevice(&dev);
    hipDeviceGetAttribute(&cus, hipDeviceAttributeMultiprocessorCount, dev);
    hipOccupancyMaxActiveBlocksPerMultiprocessor(&per_cu, fwd_kernel, 256, 0);
    if (per_cu < 1) per_cu = 1;
    if (per_cu > 2) per_cu = 2;
    grid_blocks = cus * per_cu;
  }
  Params p{};
  for (int i = 0; i < 35; ++i) p.in[i] = (const float*)d_in[i];
  p.out = (float*)d_out; p.ws = (char*)d_ws;
#ifndef ONE_LAUNCH
  for (int ph = 0; ph < NPHASES; ++ph) {
    p.ph_begin = ph; p.ph_end = ph + 1;
    hipLaunchKernelGGL(fwd_kernel, dim3(grid_blocks), dim3(256), 0, stream, p);
  }
#else
  p.ph_begin = 0; p.ph_end = NPHASES;
  hipMemsetAsync((char*)d_ws + OFF_BAR, 0, 4096, stream);
  void* args[] = {&p};
  hipError_t e = hipLaunchCooperativeKernel((void*)fwd_kernel, dim3(grid_blocks), dim3(256), args, 0, stream);
  if (e != hipSuccess) fprintf(stderr, "cooperative launch failed: %s (grid %d)\n", hipGetErrorString(e), grid_blocks);
#endif
}
```

```cpp
#define ONE_LAUNCH 1
#include <hip/hip_runtime.h>
#include <hip/hip_cooperative_groups.h>
#include <stdint.h>
#include <stdio.h>
namespace cg = cooperative_groups;

typedef unsigned short bf16_t;
typedef short bf16x8 __attribute__((ext_vector_type(8)));
typedef float f32x16 __attribute__((ext_vector_type(16)));
typedef float f32x4 __attribute__((ext_vector_type(4)));
typedef float f32x2 __attribute__((ext_vector_type(2)));
typedef unsigned u32x4 __attribute__((ext_vector_type(4)));
typedef unsigned u32x2 __attribute__((ext_vector_type(2)));
#define DI __device__ __forceinline__
#define MFMA32(a, b, c) __builtin_amdgcn_mfma_f32_32x32x16_bf16((a), (b), (c), 0, 0, 0)

constexpr int NT = 40960;
constexpr int NCTX = 8192;
constexpr int NK = 45056;
constexpr int ULD = 3488;
constexpr int MODLD = 3072;
constexpr int SMEM_BYTES = 78848;

constexpr size_t OFF_WIN = 0;
constexpr size_t OFF_WO = 16777216;
constexpr size_t OFF_WOUT = 19922944;
constexpr size_t OFF_WU = 22020096;
constexpr size_t OFF_MOD = 22282240;
constexpr size_t OFF_BONUS = 22724608;
constexpr size_t OFF_CS16 = 25346048;
constexpr size_t OFF_CS8 = 25354240;
constexpr size_t OFF_CNT = 25358336;
constexpr size_t OFF_BAR = 524742912;
constexpr size_t OFF_U = 25358592;
constexpr size_t OFF_R1 = 311095552;
constexpr size_t OFF_KA = OFF_R1;
constexpr size_t OFF_VAT = 513208576;
constexpr size_t OFF_KN = OFF_R1 + 23068672;
constexpr size_t OFF_VBT = OFF_R1 + 69206016;
constexpr size_t OFF_KRB = OFF_R1 + 115343360;
constexpr size_t OFF_R2 = 429322496;
constexpr size_t WS_NEED = 524742912 + 4096;

constexpr size_t OUT_AK = 41943040, OUT_AV = 46137344, OUT_CKV = 50331648, OUT_KR = 54525952, OUT_SF = 55574528, OUT_SB = 59768832;

struct Params {
  const float* in[35];
  float* out;
  char* ws;
  int ph_begin, ph_end;
};

enum { I_XP = 0, I_XS, I_CAK, I_CAV, I_CCKV, I_CKR, I_SF, I_SB, I_C, I_CCTX, I_NORMW, I_WMOD, I_BMOD, I_WIN, I_QNW, I_KNW, I_KVNW,
       I_WUK, I_WUV, I_MUP, I_MUN, I_W0, I_WUP, I_A0, I_AUP, I_KK, I_KA, I_RK, I_LNW, I_LNB, I_WOA, I_WOB, I_WOC, I_WOUT, I_FNW };

DI int threadIdx_x_raw() { return __builtin_amdgcn_workitem_id_x(); }
DI int otid() { int t = threadIdx_x_raw(); asm volatile("" : "+v"(t)); return t; }
DI const float* opq(const float* q) { asm volatile("" : "+s"(q)); return q; }
DI float* opq(float* q) { asm volatile("" : "+s"(q)); return q; }
DI float bf2f(bf16_t v) { return __uint_as_float(((unsigned)v) << 16); }
typedef __bf16 hbf16x2 __attribute__((ext_vector_type(2)));
DI unsigned pack2(float a, float b) { f32x2 v = {a, b}; hbf16x2 r = __builtin_convertvector(v, hbf16x2); return __builtin_bit_cast(unsigned, r); }
DI bf16_t f2bf(float x) { return (bf16_t)(pack2(x, 0.f) & 0xffffu); }
DI float xsum16(float x) { const unsigned u = __float_as_uint(x); auto r = __builtin_amdgcn_permlane16_swap(u, u, false, false); return __uint_as_float(r[0]) + __uint_as_float(r[1]); }
DI float xsum32(float x) { const unsigned u = __float_as_uint(x); auto r = __builtin_amdgcn_permlane32_swap(u, u, false, false); return __uint_as_float(r[0]) + __uint_as_float(r[1]); }
DI float lo16(unsigned w) { return __uint_as_float(w << 16); }
DI float hi16(unsigned w) { return __uint_as_float(w & 0xffff0000u); }
DI void unpack8(u32x4 w, float* v) { v[0] = lo16(w.x); v[1] = hi16(w.x); v[2] = lo16(w.y); v[3] = hi16(w.y); v[4] = lo16(w.z); v[5] = hi16(w.z); v[6] = lo16(w.w); v[7] = hi16(w.w); }
DI u32x4 pack8(const float* v) { u32x4 w; w.x = pack2(v[0], v[1]); w.y = pack2(v[2], v[3]); w.z = pack2(v[4], v[5]); w.w = pack2(v[6], v[7]); return w; }
template <int K> DI float shx(float v) { return __int_as_float(__builtin_amdgcn_ds_swizzle(__float_as_int(v), 0x1f | (K << 10))); }
DI float wave_sum(float v) { v += shx<1>(v); v += shx<2>(v); v += shx<4>(v); v += shx<8>(v); v += shx<16>(v); return xsum32(v); }
DI float qsum(float v) {
  v += __int_as_float(__builtin_amdgcn_update_dpp(0, __float_as_int(v), 0xB1, 0xf, 0xf, true));
  v += __int_as_float(__builtin_amdgcn_update_dpp(0, __float_as_int(v), 0x4E, 0xf, 0xf, true));
  return v;
}
DI float osum(float v) {
  v = qsum(v);
  v += __int_as_float(__builtin_amdgcn_update_dpp(0, __float_as_int(v), 0x141, 0xf, 0xf, true));
  return v;
}
DI int crow(int reg, int h) { return (reg & 3) + 8 * (reg >> 2) + 4 * h; }
DI int crowu(int reg) { return (reg & 3) + 8 * (reg >> 2); }
DI int perm16(int t) { return (t & ~12) | ((t & 4) << 1) | ((t & 8) >> 1); }
DI float sigmoidf_(float x) { return __builtin_amdgcn_rcpf(1.0f + __expf(-x)); }
DI float siluf_(float x) { return x * __builtin_amdgcn_rcpf(1.0f + __expf(-x)); }

DI void row_decode(int row, int& seq, int& t) {
  if (row < NCTX) { seq = row >> 8; t = row & 255; } else { seq = 32 + ((row - NCTX) >> 12); t = (row - NCTX) & 4095; }
}
DI int keyrow0(int seq) { return seq < 32 ? seq * 256 : NCTX + (seq - 32) * 4608; }
DI int seq_tk(int seq) { return seq < 32 ? 256 : 4608; }

typedef __attribute__((address_space(3))) unsigned lds_u32;
template <int NJ>
DI void gemm_mainloop(f32x16 (&acc)[2][NJ], const bf16_t* __restrict__ A, int lda, int ks,
                      const bf16_t* __restrict__ Bt, int ldb, int K, char* smem) {
  constexpr int A_BYTES = 128 * 128;
  constexpr int B_BYTES = 64 * NJ * 128;
  constexpr int STAGE = A_BYTES + B_BYTES;
  const int tid = otid(), lane = tid & 63, wid = __builtin_amdgcn_readfirstlane(tid >> 6), wm = wid >> 1, wn = wid & 1;
  const int r = lane & 31, hh = lane >> 5;
  const int nk = K >> 6;
  const int lrow = tid >> 3, lc = tid & 7;
  const int gc = (lc ^ ((lrow >> 1) & 7)) * 8;
  const bf16_t* ap = A + (size_t)lrow * lda + gc;
  const bf16_t* bp = Bt + (size_t)lrow * ldb + gc;
  auto issue = [&](int kt, int buf) {
    char* base = smem + buf * STAGE + tid * 16;
    const bf16_t* ap2 = ap + (size_t)kt * ks;
    const bf16_t* bp2 = bp + (size_t)kt * 64;
#pragma unroll
    for (int p = 0; p < 4; ++p) __builtin_amdgcn_global_load_lds((const unsigned*)(ap2 + (size_t)(32 * p) * lda), (lds_u32*)(base + p * 4096), 16, 0, 0);
#pragma unroll
    for (int p = 0; p < 2 * NJ; ++p) __builtin_amdgcn_global_load_lds((const unsigned*)(bp2 + (size_t)(32 * p) * ldb), (lds_u32*)(base + A_BYTES + p * 4096), 16, 0, 0);
  };
  issue(0, 0);
  __syncthreads();
#pragma unroll 1
  for (int kt = 0; kt < nk; ++kt) {
    if (kt + 1 < nk) issue(kt + 1, (kt + 1) & 1);
    const char* base = smem + (kt & 1) * STAGE;
#pragma unroll
    for (int s = 0; s < 4; ++s) {
      bf16x8 af[2], bfr[NJ];
#pragma unroll
      for (int i = 0; i < 2; ++i) { const int row = wm * 64 + i * 32 + r; af[i] = *(const bf16x8*)(base + row * 128 + (((2 * s + hh) ^ ((row >> 1) & 7)) << 4)); }
#pragma unroll
      for (int j = 0; j < NJ; ++j) { const int row = wn * (32 * NJ) + j * 32 + r; bfr[j] = *(const bf16x8*)(base + A_BYTES + row * 128 + (((2 * s + hh) ^ ((row >> 1) & 7)) << 4)); }
#pragma unroll
      for (int i = 0; i < 2; ++i)
#pragma unroll
        for (int j = 0; j < NJ; ++j) acc[i][j] = MFMA32(af[i], bfr[j], acc[i][j]);
    }
    __syncthreads();
  }
}

template <int NJ> DI void zero_acc(f32x16 (&acc)[2][NJ]) {
#pragma unroll
  for (int i = 0; i < 2; ++i)
#pragma unroll
    for (int j = 0; j < NJ; ++j)
#pragma unroll
      for (int e = 0; e < 16; ++e) acc[i][j][e] = 0.f;
}

DI void phase_prologue(const Params& p, char* smem) {
  const int tid = otid(), lane = tid & 63, wid = __builtin_amdgcn_readfirstlane(tid >> 6);
  float* mod = (float*)(p.ws + OFF_MOD);
  if (blockIdx.x == 0) {
    if (tid < 32) ((unsigned*)(p.ws + OFF_CNT))[tid] = 0u;
    float* cs16 = (float*)(p.ws + OFF_CS16);
    float* cs8 = (float*)(p.ws + OFF_CS8);
    for (int e = tid; e < 64 * 16; e += 256) { const int pos = e >> 4, i = e & 15; const float inv = expf(-9.210340371976184f * (float)i / 16.0f); const float a = (float)pos * inv; cs16[e * 2] = cosf(a); cs16[e * 2 + 1] = sinf(a); }
    for (int e = tid; e < 64 * 8; e += 256) { const int pos = e >> 3, i = e & 7; const float inv = expf(-9.210340371976184f * (float)i / 8.0f); const float a = (float)pos * inv; cs8[e * 2] = cosf(a); cs8[e * 2 + 1] = sinf(a); }
  }
  float* sl = (float*)smem;
  float* red = sl + 9 * 1024;
  for (int e = tid; e < 9 * 1024; e += 256) { const int j = e >> 10, k = e & 1023; const float* cc0 = opq(p.in[I_CCTX]); const float* cc1 = opq(p.in[I_C]); const float c = j == 0 ? cc0[k] : cc1[(j - 1) * 1024 + k]; sl[e] = siluf_(c); }
  __syncthreads();
  for (int item = blockIdx.x; item < 192; item += gridDim.x) {
    const int l = item / 48, n = (item % 48) * 64 + lane;
    const float* w = p.in[I_WMOD] + (size_t)l * 1024 * 3072 + n;
    float a[9];
#pragma unroll
    for (int j = 0; j < 9; ++j) a[j] = 0.f;
    for (int k = wid * 256; k < wid * 256 + 256; ++k) {
      const float wv = w[(size_t)k * 3072];
#pragma unroll
      for (int j = 0; j < 9; ++j) a[j] += sl[j * 1024 + k] * wv;
    }
#pragma unroll
    for (int j = 0; j < 9; ++j) red[(wid * 9 + j) * 64 + lane] = a[j];
    __syncthreads();
    for (int e = tid; e < 9 * 64; e += 256) {
      const int j = e >> 6, c = e & 63;
      const float s = red[(0 * 9 + j) * 64 + c] + red[(1 * 9 + j) * 64 + c] + red[(2 * 9 + j) * 64 + c] + red[(3 * 9 + j) * 64 + c];
      const int nn = (item % 48) * 64 + c;
      mod[((size_t)l * 9 + j) * MODLD + nn] = s + p.in[I_BMOD][l * 3072 + nn];
    }
    __syncthreads();
  }
}

DI const float* x_row_ptr(const Params& p, int l, int row) {
  const float* xp = opq(p.in[I_XP]); const float* xs = opq(p.in[I_XS]); const float* xo = opq((const float*)p.out);
  if (l == 0) return row < NCTX ? xp + (size_t)row * 1024 : xs + (size_t)(row - NCTX) * 1024;
  return xo + (size_t)row * 1024;
}
DI void norm_row(const Params& p, int l, int row, int lane) {
  const float* x = x_row_ptr(p, l, row);
  const int j = row < NCTX ? 0 : 1 + ((row - NCTX) >> 12);
  const float* mod = (const float*)(p.ws + OFF_MOD) + ((size_t)l * 9 + j) * MODLD;
  const float* nw = p.in[I_NORMW] + l * 1024;
  bf16_t* h = (bf16_t*)(p.ws + OFF_R1) + (size_t)row * 1024;
  f32x4 v[4]; float ss = 0.f;
#pragma unroll
  for (int i = 0; i < 4; ++i) { v[i] = *(const f32x4*)(x + lane * 4 + 256 * i); ss += v[i].x * v[i].x + v[i].y * v[i].y + v[i].z * v[i].z + v[i].w * v[i].w; }
ss = wave_sum(ss);
  const float rs = rsqrtf(ss * (1.0f / 1024.0f) + 1e-6f);
#pragma unroll
  for (int i = 0; i < 4; ++i) {
    const int c = lane * 4 + 256 * i;
    const f32x4 w = *(const f32x4*)(nw + c), sh = *(const f32x4*)(mod + c), sc = *(const f32x4*)(mod + 1024 + c);
    u32x2 o;
    o.x = pack2(v[i].x * rs * w.x * (1.f + sc.x) + sh.x, v[i].y * rs * w.y * (1.f + sc.y) + sh.y);
    o.y = pack2(v[i].z * rs * w.z * (1.f + sc.z) + sh.z, v[i].w * rs * w.w * (1.f + sc.w) + sh.w);
    *(u32x2*)(h + c) = o;
  }
}

DI void norm_rows2(const Params& p, int l, int rowa, int rowb, int lane) {
  const float* xa = x_row_ptr(p, l, rowa); const float* xb = x_row_ptr(p, l, rowb);
  f32x4 va[4], vb[4];
#pragma unroll
  for (int i = 0; i < 4; ++i) va[i] = *(const f32x4*)(xa + lane * 4 + 256 * i);
#pragma unroll
  for (int i = 0; i < 4; ++i) vb[i] = *(const f32x4*)(xb + lane * 4 + 256 * i);
  const float* nw = p.in[I_NORMW] + l * 1024;
#pragma unroll
  for (int rr = 0; rr < 2; ++rr) {
    const int row = rr ? rowb : rowa;
    f32x4 (&v)[4] = rr ? vb : va;
    const int j = row < NCTX ? 0 : 1 + ((row - NCTX) >> 12);
    const float* mod = (const float*)(p.ws + OFF_MOD) + ((size_t)l * 9 + j) * MODLD;
    bf16_t* h = (bf16_t*)(p.ws + OFF_R1) + (size_t)row * 1024;
    float ss = 0.f;
#pragma unroll
    for (int i = 0; i < 4; ++i) ss += v[i].x * v[i].x + v[i].y * v[i].y + v[i].z * v[i].z + v[i].w * v[i].w;
    ss = wave_sum(ss);
    const float rs = rsqrtf(ss * (1.0f / 1024.0f) + 1e-6f);
#pragma unroll
    for (int i = 0; i < 4; ++i) {
      const int c = lane * 4 + 256 * i;
      const f32x4 w = *(const f32x4*)(nw + c), sh = *(const f32x4*)(mod + c), sc = *(const f32x4*)(mod + 1024 + c);
      u32x2 o;
      o.x = pack2(v[i].x * rs * w.x * (1.f + sc.x) + sh.x, v[i].y * rs * w.y * (1.f + sc.y) + sh.y);
      o.y = pack2(v[i].z * rs * w.z * (1.f + sc.z) + sh.z, v[i].w * rs * w.w * (1.f + sc.w) + sh.w);
      *(u32x2*)(h + c) = o;
    }
  }
}

DI int win_srccol(int j) {
  if (j < 768) return j;
  if (j < 1696) return j + 512;
  if (j < 3488) return j + 1024;
  if (j < 3584) return -1;
  if (j < 5120) { const int jj = j - 3584; return jj < 512 ? 768 + jj : (jj < 1024 ? 2208 + (jj - 512) : 4512 + (jj - 1024)); }
  return 5024 + (j - 5120);
}
DI void conv_tile(const float* __restrict__ src, int ld_src, bf16_t* dst, int ld_dst, int k0, int n0, int kind, int srcoff, char* smem) {
  float* tile = (float*)smem;
  const int tid = otid();
  const int n = tid & 63;
  int sc = kind == 0 ? win_srccol(n0 + n) : (n0 + n - srcoff);
#pragma unroll
  for (int i = 0; i < 16; ++i) { const int k = i * 4 + (tid >> 6); tile[k * 65 + n] = sc >= 0 ? src[(size_t)(k0 + k) * ld_src + sc] : 0.f; }
  __syncthreads();
#pragma unroll
  for (int i = 0; i < 8; ++i) { const int nn = i * 8 + (tid >> 5), kk = (tid & 31) * 2; *(unsigned*)(dst + (size_t)(n0 + nn) * ld_dst + k0 + kk) = pack2(tile[kk * 65 + nn], tile[(kk + 1) * 65 + nn]); }
  __syncthreads();
}

DI void phase_norm_convert(const Params& p, int l, char* smem) {
  const int tid = otid(), lane = tid & 63, wid = __builtin_amdgcn_readfirstlane(tid >> 6);
  bf16_t* WinT = (bf16_t*)(p.ws + OFF_WIN); bf16_t* WoT = (bf16_t*)(p.ws + OFF_WO); bf16_t* WoutT = (bf16_t*)(p.ws + OFF_WOUT); bf16_t* WuT = (bf16_t*)(p.ws + OFF_WU);
  const int NI_WIN = 128 * 16, NI_WO = 3 * 16 * 8, NI_WOUT = 16 * 16, NI_WU = 16 * 2;
  const int NI_CONV = NI_WIN + NI_WO + NI_WOUT + NI_WU;
  for (int item = blockIdx.x; item < NI_CONV; item += gridDim.x) {
    int it = item;
    if (it < NI_WIN) { conv_tile(p.in[I_WIN] + (size_t)l * 1024 * 8096, 8096, WinT, 1024, (it & 15) * 64, (it >> 4) * 64, 0, 0, smem); continue; }
    it -= NI_WIN;
    if (it < NI_WO) { const int br = it / 128, r2 = it % 128; const float* src = (br == 0 ? opq(p.in[I_WOA]) : (br == 1 ? opq(p.in[I_WOB]) : opq(p.in[I_WOC]))) + (size_t)l * 512 * 1024; conv_tile(src, 1024, WoT + (size_t)br * 1024 * 512, 512, (r2 & 7) * 64, (r2 >> 3) * 64, 1, 0, smem); continue; }
    it -= NI_WO;
    if (it < NI_WOUT) { conv_tile(p.in[I_WOUT] + (size_t)l * 1024 * 1024, 1024, WoutT, 1024, (it & 15) * 64, (it >> 4) * 64, 1, 0, smem); continue; }
    it -= NI_WOUT;
    { const int nt = it >> 1, kt = it & 1; const bool uv = nt >= 8; const float* src = (uv ? opq(p.in[I_WUV]) : opq(p.in[I_WUK])) + (size_t)l * 128 * 512; conv_tile(src, 512, WuT, 128, kt * 64, nt * 64, 1, uv ? 512 : 0, smem); }
  }
  for (int item = blockIdx.x; item < NT / 8; item += gridDim.x) norm_rows2(p, l, item * 8 + wid, item * 8 + 4 + wid, lane);
}

DI bool next_tile(int it, int NTN, int GN, int& mt, int& nt, int MPX = 40, int GM = 8) {
  if (gridDim.x == 512) {
    const int x = blockIdx.x & 7, local = blockIdx.x >> 3;
    const int q = it * 64 + local;
    if (q >= MPX * NTN) return false;
    const int gsz = GM * GN, g = q / gsz, w = q - g * gsz, ngroups = NTN / GN;
    const int mgi = g / ngroups, ngi = g - mgi * ngroups;
    mt = x * MPX + mgi * GM + w / GN; nt = ngi * GN + (w % GN);
    return true;
  }
  const int tile = blockIdx.x + it * gridDim.x;
  if (tile >= 8 * MPX * NTN) return false;
  mt = tile / NTN; nt = tile % NTN;
  return true;
}

DI void phase_gemm1(const Params& p, int l, char* smem) {
  const bf16_t* H = (const bf16_t*)(p.ws + OFF_R1);
  const bf16_t* W = (const bf16_t*)(p.ws + OFF_WIN);
  bf16_t* U = (bf16_t*)(p.ws + OFF_U);
  bf16_t* VAT = (bf16_t*)(p.ws + OFF_VAT);
  const int NTN = 28, ntiles = 320 * NTN;
  for (int it = 0;; ++it) {
    int mt, nt; if (!next_tile(it, NTN, 7, mt, nt)) break;
    const int m0 = mt * 128, n0 = nt * 128;
    f32x16 acc[2][2]; zero_acc<2>(acc);
    gemm_mainloop<2>(acc, H + (size_t)m0 * 1024, 1024, 64, W + (size_t)n0 * 1024, 1024, 1024, smem);
    const int lane = otid() & 63, wid = __builtin_amdgcn_readfirstlane(otid() >> 6), wm = wid >> 1, wn = wid & 1, r = lane & 31, hh = lane >> 5;
    int seq, t0; row_decode(m0, seq, t0);
#pragma unroll
    for (int j = 0; j < 2; ++j) {
      const int cb = n0 + wn * 64 + j * 32;
      if (cb >= ULD) continue;
      const int col = cb + r;
      if (cb >= 640 && cb < 768) {
        const int kvh = (col - 640) >> 6, dv = col & 63, Tk = seq_tk(seq);
        bf16_t* vt = VAT + (size_t)128 * keyrow0(seq) + (size_t)(kvh * 64 + dv) * Tk;
#pragma unroll
        for (int i = 0; i < 2; ++i) {
          const int tt = t0 + wm * 64 + i * 32;
#pragma unroll
          for (int g2 = 0; g2 < 2; ++g2) {
            float v[8];
#pragma unroll
            for (int e = 0; e < 8; ++e) v[e] = acc[i][j][g2 * 8 + e];
            *(u32x4*)(vt + tt + 16 * g2 + 8 * hh) = pack8(v);
          }
          if (seq < 32) {
            float* o = p.out + OUT_AV + ((size_t)(seq * 4 + l) * 256 + tt) * 128;
            const int lo = 4 * hh * 128 + (col - 640);
#pragma unroll
            for (int e = 0; e < 16; ++e) (o + crowu(e) * 128)[lo] = acc[i][j][e];
          }
        }
      } else {
#pragma unroll
        for (int i = 0; i < 2; ++i) {
          bf16_t* up = U + (size_t)(m0 + wm * 64 + i * 32) * ULD;
          const int lo = 4 * hh * ULD + col;
#pragma unroll
          for (int e = 0; e < 16; ++e) (up + crowu(e) * ULD)[lo] = f2bf(acc[i][j][e]);
        }
      }
    }
  }
}

DI void post_row(const Params& p, int l, int row, int lane) {
  int seq, t; row_decode(row, seq, t);
  const bool lat = row >= NCTX;
  const int krow = keyrow0(seq) + t;
  const int prow = t >> 6, pcol = t & 63;
  bf16_t* u = (bf16_t*)(p.ws + OFF_U) + (size_t)row * ULD;
  const float* cs16 = (const float*)(p.ws + OFF_CS16);
  const float* cs8 = (const float*)(p.ws + OFF_CS8);
  const float LOG2E = 1.4426950408889634f;
#pragma unroll
  for (int which = 0; which < 2; ++which) {
    const int l8 = which == 0 ? lane : (lane & 15);
    const bf16_t* src = u + (which == 0 ? 0 : 512) + l8 * 8;
    float v[8]; unpack8(*(const u32x4*)src, v);
    float ss = 0.f;
#pragma unroll
    for (int i = 0; i < 8; ++i) ss += v[i] * v[i];
    ss += shx<1>(ss); ss += shx<2>(ss); ss += shx<4>(ss);
    const float rs = rsqrtf(ss * (1.0f / 64.0f) + 1e-6f);
    const float* nw = (which == 0 ? opq(p.in[I_QNW]) : opq(p.in[I_KNW])) + l * 64 + (lane & 7) * 8;
#pragma unroll
    for (int i = 0; i < 8; ++i) v[i] = v[i] * rs * nw[i];
    float pv[8];
#pragma unroll
    for (int i = 0; i < 8; ++i) pv[i] = shx<2>(v[i]);
    if (lat) {
      const int pos = ((lane & 7) >> 2) ? pcol : prow;
      const bool lower = (lane & 2) == 0;
      const float* cs = cs16 + (pos * 16 + (lane & 1) * 8) * 2;
#pragma unroll
      for (int i = 0; i < 8; ++i) { const float c = cs[i * 2], s = cs[i * 2 + 1]; v[i] = lower ? v[i] * c - pv[i] * s : v[i] * c + pv[i] * s; }
    }
    if (which == 0) {
      const float sc = 0.125f * LOG2E;
#pragma unroll
      for (int i = 0; i < 8; ++i) v[i] *= sc;
      *(u32x4*)(u + lane * 8) = pack8(v);
    } else if (lane < 16) {
      bf16_t* KA = (bf16_t*)(p.ws + OFF_KA);
      *(u32x4*)(KA + (size_t)krow * 128 + lane * 8) = pack8(v);
      if (!lat) {
        float* o = p.out + OUT_AK + ((size_t)(seq * 4 + l) * 256 + t) * 128 + lane * 8;
        *(f32x4*)o = (f32x4){v[0], v[1], v[2], v[3]}; *(f32x4*)(o + 4) = (f32x4){v[4], v[5], v[6], v[7]};
      }
    }
  }
  {
    const float sc = 0.10206207261596577f * LOG2E;
    const int hd = lane >> 3;
    bf16_t* q = u + 768 + hd * 96;
    { float v[8]; unpack8(*(const u32x4*)(q + (lane & 7) * 8), v);
#pragma unroll
      for (int i = 0; i < 8; ++i) v[i] *= sc;
      *(u32x4*)(q + (lane & 7) * 8) = pack8(v); }
    { bf16_t* qr = q + 64 + (lane & 7) * 4;
      const u32x2 w = *(const u32x2*)qr;
      float v[4] = {lo16(w.x), hi16(w.x), lo16(w.y), hi16(w.y)}, pv[4];
#pragma unroll
      for (int i = 0; i < 4; ++i) pv[i] = shx<2>(v[i]);
      if (lat) {
        const int pos = ((lane & 7) >> 2) ? pcol : prow;
        const bool lower = (lane & 2) == 0;
        const float* cs = cs8 + (pos * 8 + (lane & 1) * 4) * 2;
#pragma unroll
        for (int i = 0; i < 4; ++i) { const float c = cs[i * 2], s = cs[i * 2 + 1]; v[i] = lower ? v[i] * c - pv[i] * s : v[i] * c + pv[i] * s; }
      }
      u32x2 o; o.x = pack2(v[0] * sc, v[1] * sc); o.y = pack2(v[2] * sc, v[3] * sc);
      *(u32x2*)qr = o; }
  }
  {
    const unsigned w = *(const unsigned*)(u + 1536 + lane * 2);
    float a = lo16(w), b = hi16(w);
    float ss = a * a + b * b;
ss = wave_sum(ss);
    const float rs = rsqrtf(ss * (1.0f / 128.0f) + 1e-6f);
    const float* nw = p.in[I_KVNW] + l * 128 + lane * 2;
    a = a * rs * nw[0]; b = b * rs * nw[1];
    bf16_t* CKVN = (bf16_t*)(p.ws + OFF_R2);
    *(unsigned*)(CKVN + (size_t)krow * 128 + lane * 2) = pack2(a, b);
    if (!lat) { float* o = p.out + OUT_CKV + ((size_t)(seq * 4 + l) * 256 + t) * 128 + lane * 2; *(f32x2*)o = (f32x2){a, b}; }
  }
  {
    float v = bf2f(u[1664 + (lane & 31)]);
    const float pv = shx<8>(v);
    if (!lat) { if (lane < 32) p.out[OUT_KR + ((size_t)(seq * 4 + l) * 256 + t) * 32 + lane] = v; }
    else {
      const int d = lane & 31; const int pos = (d >> 4) ? pcol : prow; const bool lower = (d & 8) == 0;
      const float* cs = cs8 + (pos * 8 + (d & 7)) * 2;
      v = lower ? v * cs[0] - pv * cs[1] : v * cs[0] + pv * cs[1];
    }
    if (lane < 32) ((bf16_t*)(p.ws + OFF_KRB))[(size_t)krow * 32 + lane] = f2bf(v);
  }
}
DI void post_cached_row(const Params& p, int l, int idx, int lane) {
  const int b = idx >> 9, j = idx & 511;
  const int kr0 = NCTX + b * 4608, krow = kr0 + 4096 + j;
  const size_t cb = ((size_t)(b * 4 + l) * 512 + j);
  bf16_t* KA = (bf16_t*)(p.ws + OFF_KA); bf16_t* VAT = (bf16_t*)(p.ws + OFF_VAT); bf16_t* CKVN = (bf16_t*)(p.ws + OFF_R2); bf16_t* KRB = (bf16_t*)(p.ws + OFF_KRB);
  { const f32x2 v = *(const f32x2*)(p.in[I_CAK] + cb * 128 + lane * 2); *(unsigned*)(KA + (size_t)krow * 128 + lane * 2) = pack2(v.x, v.y); }
  { const f32x2 v = *(const f32x2*)(p.in[I_CAV] + cb * 128 + lane * 2);
    bf16_t* vt = VAT + (size_t)128 * kr0 + (size_t)(lane * 2) * 4608 + perm16(4096 + j);
    vt[0] = f2bf(v.x); vt[4608] = f2bf(v.y); }
  { const f32x2 v = *(const f32x2*)(p.in[I_CCKV] + cb * 128 + lane * 2); *(unsigned*)(CKVN + (size_t)krow * 128 + lane * 2) = pack2(v.x, v.y); }
  if (lane < 32) KRB[(size_t)krow * 32 + lane] = f2bf(p.in[I_CKR][cb * 32 + lane]);
}
DI void phase_post(const Params& p, int l) {
  const int lane = otid() & 63, wid = __builtin_amdgcn_readfirstlane(otid() >> 6);
  for (int item = blockIdx.x; item < NT / 4 + 1024; item += gridDim.x) {
    if (item < NT / 4) post_row(p, l, item * 4 + wid, lane);
    else post_cached_row(p, l, (item - NT / 4) * 4 + wid, lane);
  }
}

DI void phase_upproj(const Params& p, char* smem) {
  const bf16_t* A = (const bf16_t*)(p.ws + OFF_R2);
  const bf16_t* W = (const bf16_t*)(p.ws + OFF_WU);
  bf16_t* KN = (bf16_t*)(p.ws + OFF_KN); bf16_t* VBT = (bf16_t*)(p.ws + OFF_VBT);
  const int ntiles = 352 * 8;
  for (int it = 0;; ++it) {
    int mt, nt; if (!next_tile(it, 8, 8, mt, nt, 44, 4)) break;
    const int m0 = mt * 128, n0 = nt * 128;
    f32x16 acc[2][2]; zero_acc<2>(acc);
    gemm_mainloop<2>(acc, A + (size_t)m0 * 128, 128, 64, W + (size_t)n0 * 128, 128, 128, smem);
    const int lane = otid() & 63, wid = __builtin_amdgcn_readfirstlane(otid() >> 6), wm = wid >> 1, wn = wid & 1, r = lane & 31, hh = lane >> 5;
    int seq, t0;
    if (m0 < NCTX) { seq = m0 >> 8; t0 = m0 & 255; } else { const int rr = m0 - NCTX; seq = 32 + rr / 4608; t0 = rr % 4608; }
#pragma unroll
    for (int j = 0; j < 2; ++j) {
      const int col = n0 + wn * 64 + j * 32 + r;
      if (n0 < 512) {
#pragma unroll
        for (int i = 0; i < 2; ++i) {
          bf16_t* kp = KN + (size_t)(m0 + wm * 64 + i * 32) * 512;
          const int lo = 4 * hh * 512 + col;
#pragma unroll
          for (int e = 0; e < 16; ++e) (kp + crowu(e) * 512)[lo] = f2bf(acc[i][j][e]);
        }
      } else {
        const int Tk = seq_tk(seq);
        bf16_t* vt = VBT + (size_t)512 * keyrow0(seq) + (size_t)(col - 512) * Tk;
#pragma unroll
        for (int i = 0; i < 2; ++i) {
          const int tt = t0 + wm * 64 + i * 32;
#pragma unroll
          for (int g2 = 0; g2 < 2; ++g2) {
            float v[8];
#pragma unroll
            for (int e = 0; e < 8; ++e) v[e] = acc[i][j][g2 * 8 + e];
            *(u32x4*)(vt + tt + 16 * g2 + 8 * hh) = pack8(v);
          }
        }
      }
    }
  }
}

template <int DQK>
DI void attn_item(const bf16_t* Qw, int q_ld, const bf16_t* K1, int k1_ld, const bf16_t* K2, int k2_ld,
                  const bf16_t* Vt, int vt_ld, int nkeys, bf16_t* Ow, int o_ld, char* smem) {
  constexpr int KS = DQK * 2 + 16;
  constexpr int KBYTES = 64 * KS;
  constexpr int VS = 144;
  constexpr int VBYTES = 64 * VS;
  constexpr int STAGE = KBYTES + VBYTES;
  constexpr int CPR = DQK / 8;
  constexpr int NKC = 64 * CPR / 256;
  constexpr int NS = DQK / 16;
  const int tid = otid(), lane = tid & 63, r = lane & 31, hh = lane >> 5;
  bf16x8 qf[NS];
#pragma unroll
  for (int s = 0; s < NS; ++s) qf[s] = *(const bf16x8*)(Qw + (size_t)r * q_ld + 16 * s + 8 * hh);
  f32x16 o[2];
#pragma unroll
  for (int n = 0; n < 2; ++n)
#pragma unroll
    for (int e = 0; e < 16; ++e) o[n][e] = 0.f;
  float m_run = 0.f, lsum = 0.f;
  u32x4 rk0[NKC], rv0[2], rk1[NKC], rv1[2];
  int krow_[NKC], kc_[NKC];
#pragma unroll
  for (int q = 0; q < NKC; ++q) { const int id = q * 256 + tid; krow_[q] = id / CPR; kc_[q] = id % CPR; }
  const int vrow = tid >> 3, vc = tid & 7;
  auto gload = [&](int key0, u32x4 (&rk)[NKC], u32x4 (&rv)[2]) {
#pragma unroll
    for (int q = 0; q < NKC; ++q) {
      const bf16_t* src = (DQK == 64 || kc_[q] < 8) ? K1 + (size_t)(key0 + krow_[q]) * k1_ld + kc_[q] * 8 : K2 + (size_t)(key0 + krow_[q]) * k2_ld + (kc_[q] - 8) * 8;
      rk[q] = *(const u32x4*)src;
    }
#pragma unroll
    for (int q = 0; q < 2; ++q) rv[q] = *(const u32x4*)(Vt + (size_t)(vrow + 32 * q) * vt_ld + key0 + vc * 8);
  };
  auto lstore = [&](int buf, u32x4 (&rk)[NKC], u32x4 (&rv)[2]) {
    char* base = smem + buf * STAGE;
#pragma unroll
    for (int q = 0; q < NKC; ++q) *(u32x4*)(base + krow_[q] * KS + kc_[q] * 16) = rk[q];
#pragma unroll
    for (int q = 0; q < 2; ++q) *(u32x4*)(base + KBYTES + (vrow + 32 * q) * VS + vc * 16) = rv[q];
  };
  const int ntl = nkeys >> 6;
  gload(0, rk0, rv0); lstore(0, rk0, rv0);
  gload(64, rk1, rv1);
  if (ntl > 2) gload(128, rk0, rv0);
  __syncthreads();
  auto tile_body = [&](int tl, u32x4 (&rkn)[NKC], u32x4 (&rvn)[2]) {
    const char* base = smem + (tl & 1) * STAGE;
    bf16x8 kf[2][NS], vf[2][2][2];
#pragma unroll
    for (int kb = 0; kb < 2; ++kb)
#pragma unroll
      for (int ks = 0; ks < NS; ++ks) kf[kb][ks] = *(const bf16x8*)(base + (kb * 32 + r) * KS + (2 * ks + hh) * 16);
    __builtin_amdgcn_sched_barrier(0);
    f32x16 s[2];
    const float ninit = -m_run;
#pragma unroll
    for (int kb = 0; kb < 2; ++kb)
#pragma unroll
      for (int e = 0; e < 16; ++e) s[kb][e] = ninit;
#pragma unroll
    for (int ks = 0; ks < NS; ++ks)
#pragma unroll
      for (int kb = 0; kb < 2; ++kb) s[kb] = MFMA32(kf[kb][ks], qf[ks], s[kb]);
#pragma unroll
    for (int kb = 0; kb < 2; ++kb)
#pragma unroll
      for (int s2 = 0; s2 < 2; ++s2)
#pragma unroll
        for (int n = 0; n < 2; ++n) vf[kb][s2][n] = *(const bf16x8*)(base + KBYTES + (32 * n + r) * VS + (kb * 32 + 16 * s2 + 8 * hh) * 2);
    __builtin_amdgcn_sched_barrier(0);
    float mx = s[0][0];
#pragma unroll
    for (int kb = 0; kb < 2; ++kb)
#pragma unroll
      for (int e = 0; e < 16; ++e) mx = fmaxf(mx, s[kb][e]);
    { const unsigned u = __float_as_uint(mx); auto sw = __builtin_amdgcn_permlane32_swap(u, u, false, false); mx = fmaxf(__uint_as_float(sw[0]), __uint_as_float(sw[1])); }
    const bool move = (mx > 4.0f) || (mx < -20.0f);
    if (__builtin_amdgcn_ballot_w64(move) != 0ull) {
      const float dlt = move ? mx : 0.f;
      const float alpha = __builtin_amdgcn_exp2f(-dlt);
      m_run += dlt;
      lsum *= alpha;
#pragma unroll
      for (int kb = 0; kb < 2; ++kb)
#pragma unroll
        for (int e = 0; e < 16; ++e) s[kb][e] -= dlt;
#pragma unroll
      for (int n = 0; n < 2; ++n)
#pragma unroll
        for (int e = 0; e < 16; ++e) o[n][e] *= alpha;
    }
    float ps = 0.f;
#pragma unroll
    for (int kb = 0; kb < 2; ++kb)
#pragma unroll
      for (int e = 0; e < 16; ++e) { const float pe = __builtin_amdgcn_exp2f(s[kb][e]); s[kb][e] = pe; ps += pe; }
    lsum += ps;
#pragma unroll
    for (int kb = 0; kb < 2; ++kb)
#pragma unroll
      for (int s2 = 0; s2 < 2; ++s2) {
        u32x4 pw;
        pw.x = pack2(s[kb][8 * s2 + 0], s[kb][8 * s2 + 1]); pw.y = pack2(s[kb][8 * s2 + 2], s[kb][8 * s2 + 3]);
        pw.z = pack2(s[kb][8 * s2 + 4], s[kb][8 * s2 + 5]); pw.w = pack2(s[kb][8 * s2 + 6], s[kb][8 * s2 + 7]);
        const bf16x8 pf = __builtin_bit_cast(bf16x8, pw);
#pragma unroll
        for (int n = 0; n < 2; ++n) o[n] = MFMA32(vf[kb][s2][n], pf, o[n]);
      }
    if (tl + 1 < ntl) { lstore((tl + 1) & 1, rkn, rvn); if (tl + 3 < ntl) gload((tl + 3) * 64, rkn, rvn); }
    __syncthreads();
  };
  for (int tl = 0; tl < ntl; tl += 2) { tile_body(tl, rk1, rv1); tile_body(tl + 1, rk0, rv0); }
  lsum = xsum32(lsum);
  const float inv = 1.0f / lsum;
#pragma unroll
  for (int n = 0; n < 2; ++n)
#pragma unroll
    for (int g = 0; g < 4; ++g) {
      u32x2 w; w.x = pack2(o[n][4 * g] * inv, o[n][4 * g + 1] * inv); w.y = pack2(o[n][4 * g + 2] * inv, o[n][4 * g + 3] * inv);
      *(u32x2*)(Ow + (size_t)r * o_ld + 32 * n + 8 * g + 4 * hh) = w;
    }
}

DI void scan_item(const Params& p, int l, int seq, int hd, int dir, int rs, char* smem) {
  const int tid = otid(), lane = tid & 63, wv = __builtin_amdgcn_readfirstlane(tid >> 6);
  const int j8 = lane & 7, r = lane & 31, hh = lane >> 5;
  const bool lat = seq >= 32;
  const int T = lat ? 4096 : 256;
  const int row0 = lat ? NCTX + (seq - 32) * 4096 : seq * 256;
  float* vA = (float*)smem; float* vK = vA + 2048; float* vR = vK + 2048; float* vV = vR + 2048; float* vW = vV + 2048; float* vB = vW + 2048; float* ybuf = vB + 2048;
  char* raw = smem + 32768;
  char* wdx = smem + 57344; char* adx = smem + 61952;
  float* tmpb = (float*)(smem + 66816);
  const bf16_t* U = (const bf16_t*)(p.ws + OFF_U);
  bf16_t* Y = (bf16_t*)(p.ws + OFF_R2) + (dir ? (size_t)NT * 512 : 0);
  float* bonus = (float*)(p.ws + OFF_BONUS);
  const int lrow = 8 * wv + (lane >> 3), irow = rs * 32 + lrow;
  f32x2 S[4];
  if (lat) {
    const float* s0 = (dir ? opq(p.in[I_SB]) : opq(p.in[I_SF])) + ((size_t)((seq - 32) * 4 + l) * 8 + hd) * 4096 + irow * 64 + j8 * 8;
#pragma unroll
    for (int q = 0; q < 2; ++q) { const f32x4 v = *(const f32x4*)(s0 + 4 * q); S[2 * q] = (f32x2){v.x, v.y}; S[2 * q + 1] = (f32x2){v.z, v.w}; }
  } else {
#pragma unroll
    for (int q = 0; q < 4; ++q) S[q] = (f32x2){0.f, 0.f};
  }
  const int mat = wv >> 1, ntc = wv & 1, cch = ntc * 32 + r, hc = hd * 64 + cch;
  bf16x8 bfrag[4];
  {
    const float* W = (mat ? opq(p.in[I_AUP]) : opq(p.in[I_WUP])) + (size_t)(l * 2 + dir) * 64 * 512 + hc;
#pragma unroll
    for (int s4 = 0; s4 < 4; ++s4) {
      float w8[8];
#pragma unroll
      for (int j = 0; j < 8; ++j) w8[j] = W[(size_t)(16 * s4 + 8 * hh + j) * 512];
      bfrag[s4] = __builtin_bit_cast(bf16x8, pack8(w8));
    }
  }
  const float bias = (mat ? opq(p.in[I_A0]) : opq(p.in[I_W0]))[(l * 2 + dir) * 512 + hc];
  const float kav = p.in[I_KA][l * 512 + hc], rkv = p.in[I_RK][l * 512 + hc];
  float* muP = (float*)(smem + 75008); float* muN = muP + 320; float* kkL = muN + 320;
  {
    const float* mup = p.in[I_MUP] + l * 1792; const float* mun = p.in[I_MUN] + l * 1792;
    for (int e = tid; e < 320; e += 256) { const int g = e >> 6, c = e & 63; const int col = (g < 3 ? g * 512 + hd * 64 : (g == 3 ? 1536 + dir * 64 : 1664 + dir * 64)) + c; muP[e] = mup[col]; muN[e] = mun[col]; }
    if (tid < 64) kkL[tid] = p.in[I_KK][l * 512 + hd * 64 + tid];
  }
  const int nch = T >> 5;
  u32x4 pre[6];
  auto prefetch = [&](int t0) {
#pragma unroll
    for (int q = 0; q < 6; ++q) {
      const int id = q * 256 + tid;
      const int row = id / 40, cc = id - row * 40, g = cc >> 3, c8 = cc & 7;
      const int t = t0 - 1 + row;
      const int col = (g < 3 ? g * 512 + hd * 64 : (g == 3 ? 1536 + dir * 64 : 1664 + dir * 64)) + c8 * 8;
      u32x4 v = (u32x4){0u, 0u, 0u, 0u};
      if (id < 1360 && t >= 0 && t < T) v = *(const u32x4*)(U + (size_t)(row0 + t) * ULD + 1696 + col);
      pre[q] = v;
    }
  };
  prefetch((dir ? nch - 1 : 0) * 32);
  for (int ci = 0; ci < nch; ++ci) {
    const int t0 = (dir ? nch - 1 - ci : ci) * 32;
#pragma unroll
    for (int q = 0; q < 6; ++q) { const int id = q * 256 + tid; if (id < 1360) *(u32x4*)(raw + id * 16) = pre[q]; }
    __syncthreads();
    if (ci + 1 < nch) prefetch((dir ? nch - 2 - ci : ci + 1) * 32);
    {
      const int tt = tid >> 3, sub = tid & 7;
#pragma unroll 1
      for (int g = 0; g < 5; ++g) {
        const int col = (g < 3 ? g * 512 + hd * 64 : (g == 3 ? 1536 + dir * 64 : 1664 + dir * 64)) + sub * 8;
        float c[8], pv[8], nx[8], x[8];
        unpack8(*(const u32x4*)(raw + (tt + 1) * 640 + (g * 8 + sub) * 16), c);
        unpack8(*(const u32x4*)(raw + tt * 640 + (g * 8 + sub) * 16), pv);
        unpack8(*(const u32x4*)(raw + (tt + 2) * 640 + (g * 8 + sub) * 16), nx);
        const f32x4 mp0 = *(const f32x4*)(muP + g * 64 + sub * 8), mp1 = *(const f32x4*)(muP + g * 64 + sub * 8 + 4), mn0 = *(const f32x4*)(muN + g * 64 + sub * 8), mn1 = *(const f32x4*)(muN + g * 64 + sub * 8 + 4);
        const float mp[8] = {mp0.x, mp0.y, mp0.z, mp0.w, mp1.x, mp1.y, mp1.z, mp1.w}, mn[8] = {mn0.x, mn0.y, mn0.z, mn0.w, mn1.x, mn1.y, mn1.z, mn1.w};
#pragma unroll
        for (int i = 0; i < 8; ++i) x[i] = c[i] + mp[i] * (pv[i] - c[i]) + mn[i] * (nx[i] - c[i]);
        const int lo = tt * 64 + sub * 8;
        if (g == 0) { *(f32x4*)(vR + lo) = (f32x4){x[0], x[1], x[2], x[3]}; *(f32x4*)(vR + lo + 4) = (f32x4){x[4], x[5], x[6], x[7]}; }
        else if (g == 1) {
          float kk[8], ss = 0.f;
          const float* kkw = kkL + sub * 8;
#pragma unroll
          for (int i = 0; i < 8; ++i) { kk[i] = x[i] * kkw[i]; ss += kk[i] * kk[i]; }
          *(f32x4*)(vK + lo) = (f32x4){x[0], x[1], x[2], x[3]}; *(f32x4*)(vK + lo + 4) = (f32x4){x[4], x[5], x[6], x[7]};
          ss += shx<1>(ss); ss += shx<2>(ss); ss += shx<4>(ss);
          const float inv = 1.0f / fmaxf(sqrtf(ss), 1e-12f);
          *(f32x4*)(vA + lo) = (f32x4){kk[0] * inv, kk[1] * inv, kk[2] * inv, kk[3] * inv}; *(f32x4*)(vA + lo + 4) = (f32x4){kk[4] * inv, kk[5] * inv, kk[6] * inv, kk[7] * inv};
        }
        else if (g == 2) { *(f32x4*)(vV + lo) = (f32x4){x[0], x[1], x[2], x[3]}; *(f32x4*)(vV + lo + 4) = (f32x4){x[4], x[5], x[6], x[7]}; }
        else if (g == 3) { float th[8]; for (int i = 0; i < 8; ++i) th[i] = 1.0f - 2.0f * __builtin_amdgcn_rcpf(1.0f + __expf(2.0f * x[i])); *(u32x4*)(wdx + tt * 144 + sub * 16) = pack8(th); }
        else { *(u32x4*)(adx + tt * 144 + sub * 16) = pack8(x); }
      }
    }
    __syncthreads();
    {
      f32x16 acc;
#pragma unroll
      for (int e = 0; e < 16; ++e) acc[e] = 0.f;
      const char* xb = mat ? adx : wdx;
#pragma unroll
      for (int s4 = 0; s4 < 4; ++s4) { const bf16x8 af = *(const bf16x8*)(xb + r * 144 + (16 * s4 + 8 * hh) * 2); acc = MFMA32(af, bfrag[s4], acc); }
      if (mat == 0) {
#pragma unroll
        for (int e = 0; e < 16; ++e) vW[crow(e, hh) * 64 + cch] = __expf(-0.6065306597126334f * sigmoidf_(bias + acc[e]));
      } else {
#pragma unroll
        for (int e = 0; e < 16; ++e) {
          const int ix = crow(e, hh) * 64 + cch;
          const float ag = sigmoidf_(bias + acc[e]);
          const float kk = vA[ix], k = vK[ix], rr = vR[ix];
          const float kd = k * (1.0f + (ag - 1.0f) * kav);
          vK[ix] = kd; vA[ix] = -kk; vB[ix] = kk * ag; tmpb[ix] = rr * kd * rkv;
        }
      }
    }
    __syncthreads();
    {
      const int tt = tid >> 3, sub = tid & 7;
      const f32x4 b0 = *(const f32x4*)(tmpb + tt * 64 + sub * 8), b1 = *(const f32x4*)(tmpb + tt * 64 + sub * 8 + 4);
      float bs = (b0.x + b0.y) + (b0.z + b0.w) + (b1.x + b1.y) + (b1.z + b1.w);
      bs += shx<1>(bs); bs += shx<2>(bs); bs += shx<4>(bs);
      if (sub == 0 && rs == 0) bonus[((size_t)(row0 + t0 + tt) * 8 + hd) * 2 + dir] = bs;
    }
    {
      f32x4 va[2], vw[2], vb[2], vk[2], vr[2]; float vi;
      int tt = dir ? 31 : 0;
      int vo = tt * 64 + j8 * 8;
#pragma unroll
      for (int q = 0; q < 2; ++q) { va[q] = *(const f32x4*)(vA + vo + 4 * q); vw[q] = *(const f32x4*)(vW + vo + 4 * q); vb[q] = *(const f32x4*)(vB + vo + 4 * q); vk[q] = *(const f32x4*)(vK + vo + 4 * q); vr[q] = *(const f32x4*)(vR + vo + 4 * q); }
      vi = vV[tt * 64 + irow];
      for (int si = 0; si < 32; ++si) {
        const int ttn = dir ? (si < 31 ? 30 - si : 0) : (si < 31 ? si + 1 : 31);
        const int von = ttn * 64 + j8 * 8;
        f32x2 pa2 = S[0] * (f32x2){va[0].x, va[0].y}, pa3 = S[1] * (f32x2){va[0].z, va[0].w};
        pa2 += S[2] * (f32x2){va[1].x, va[1].y}; pa3 += S[3] * (f32x2){va[1].z, va[1].w};
#pragma unroll
        for (int q = 0; q < 2; ++q) va[q] = *(const f32x4*)(vA + von + 4 * q);
        pa2 += pa3;
        const float sa = osum(pa2.x + pa2.y);
        const f32x2 sa2 = (f32x2){sa, sa}, vi2 = (f32x2){vi, vi};
        f32x2 py2, py3;
        S[0] = S[0] * (f32x2){vw[0].x, vw[0].y} + (sa2 * (f32x2){vb[0].x, vb[0].y} + vi2 * (f32x2){vk[0].x, vk[0].y}); py2 = S[0] * (f32x2){vr[0].x, vr[0].y};
        S[1] = S[1] * (f32x2){vw[0].z, vw[0].w} + (sa2 * (f32x2){vb[0].z, vb[0].w} + vi2 * (f32x2){vk[0].z, vk[0].w}); py3 = S[1] * (f32x2){vr[0].z, vr[0].w};
        S[2] = S[2] * (f32x2){vw[1].x, vw[1].y} + (sa2 * (f32x2){vb[1].x, vb[1].y} + vi2 * (f32x2){vk[1].x, vk[1].y}); py2 += S[2] * (f32x2){vr[1].x, vr[1].y};
        S[3] = S[3] * (f32x2){vw[1].z, vw[1].w} + (sa2 * (f32x2){vb[1].z, vb[1].w} + vi2 * (f32x2){vk[1].z, vk[1].w}); py3 += S[3] * (f32x2){vr[1].z, vr[1].w};
#pragma unroll
        for (int q = 0; q < 2; ++q) { vw[q] = *(const f32x4*)(vW + von + 4 * q); vb[q] = *(const f32x4*)(vB + von + 4 * q); vk[q] = *(const f32x4*)(vK + von + 4 * q); vr[q] = *(const f32x4*)(vR + von + 4 * q); }
        vi = vV[ttn * 64 + irow];
        py2 += py3;
        const float py = osum(py2.x + py2.y);
        ybuf[tt * 32 + lrow] = py;
        tt = ttn;
      }
    }
    __syncthreads();
    {
      const int tt = tid >> 3, sub = tid & 7;
      const f32x4 y0 = *(const f32x4*)(ybuf + tt * 32 + sub * 4);
      u32x2 w; w.x = pack2(y0.x, y0.y); w.y = pack2(y0.z, y0.w);
      *(u32x2*)(Y + (size_t)(row0 + t0 + tt) * 512 + hd * 64 + rs * 32 + sub * 4) = w;
    }
    __syncthreads();
  }
  if (!lat) {
    float* o = opq(p.out) + (dir ? OUT_SB : OUT_SF) + ((size_t)(seq * 4 + l) * 8 + hd) * 4096 + irow * 64 + j8 * 8;
#pragma unroll
    for (int q = 0; q < 2; ++q) *(f32x4*)(o + 4 * q) = (f32x4){S[2 * q].x, S[2 * q].y, S[2 * q + 1].x, S[2 * q + 1].y};
  }
}

DI void phase_mixers(const Params& p, int l, char* smem, int part = 0) {
  const int tid = otid(), wid = __builtin_amdgcn_readfirstlane(tid >> 6);
  unsigned* cnt = (unsigned*)(p.ws + OFF_CNT) + l * 8;
  int* slot = (int*)(smem + SMEM_BYTES - 16);
  bf16_t* U = (bf16_t*)(p.ws + OFF_U);
  const bf16_t* KA = (const bf16_t*)(p.ws + OFF_KA); const bf16_t* VAT = (const bf16_t*)(p.ws + OFF_VAT);
  const bf16_t* KN = (const bf16_t*)(p.ws + OFF_KN); const bf16_t* VBT = (const bf16_t*)(p.ws + OFF_VBT); const bf16_t* KRB = (const bf16_t*)(p.ws + OFF_KRB);
  const int QLEN = 256 + 256 + 128 + 64 + 64;
  bool first = true;
  int xq = blockIdx.x & 7, tries = 0;
  for (;;) {
    int kind, seq, a, qt;
    if (first && blockIdx.x < 256) {
      const int item = blockIdx.x; kind = 0; seq = 32 + (item >> 5); a = (item >> 2) & 7; qt = item & 3;
      first = false;
    } else {
      first = false;
      if (tid == 0) *slot = (int)atomicAdd(cnt + xq, 1u);
      __syncthreads();
      const int i = __builtin_amdgcn_readfirstlane(*slot);
      __syncthreads();
      if (i >= QLEN) { if (++tries >= 8) break; xq = (xq + 1) & 7; continue; }
      if (i < 256) { const int g = xq + 8 * (i >> 7); kind = 1; seq = 32 + (g >> 1); a = g & 1; qt = i & 127; }
      else if (i < 512) { const int j = i - 256; const int g = xq + 8 * (j >> 5); kind = 2; seq = 32 + (g >> 3); a = g & 7; qt = j & 31; }
      else if (i < 640) { const int j = i - 512; kind = 0; seq = xq + 8 * (j >> 5); a = (j >> 2) & 7; qt = j & 3; }
      else if (i < 704) { const int j = i - 640; kind = 1; seq = xq + 8 * (j >> 4); a = (j >> 3) & 1; qt = j & 7; }
      else { const int j = i - 704; kind = 2; seq = xq + 8 * (j >> 4); a = (j >> 1) & 7; qt = j & 1; }
    }
    const int kr0 = keyrow0(seq), Tk = seq_tk(seq);
    const int row0 = seq < 32 ? seq * 256 : NCTX + (seq - 32) * 4096;
    if (kind == 0) scan_item(p, l, seq, a, qt & 1, qt >> 1, smem);
    else if (kind == 1) {
      const int qh = a * 4 + wid;
      bf16_t* q = U + (size_t)(row0 + qt * 32) * ULD + qh * 64;
      attn_item<64>(q, ULD, KA + (size_t)kr0 * 128 + a * 64, 128, nullptr, 0, VAT + (size_t)128 * kr0 + (size_t)(a * 64) * Tk, Tk, Tk, q, ULD, smem);
    } else {
      bf16_t* q = U + (size_t)(row0 + qt * 128 + wid * 32) * ULD + 768 + a * 96;
      attn_item<96>(q, ULD, KN + (size_t)kr0 * 512 + a * 64, 512, KRB + (size_t)kr0 * 32, 32, VBT + (size_t)512 * kr0 + (size_t)(a * 64) * Tk, Tk, Tk, q, ULD, smem);
    }
  }
}

struct CpostIn { u32x4 yf, yb, c, pv, nx; f32x2 bs; };
DI void cpost_load(const Params& p, int row, int lane, CpostIn& in) {
  int seq, t; row_decode(row, seq, t);
  const int T = seq < 32 ? 256 : 4096;
  const bf16_t* YF = (const bf16_t*)(p.ws + OFF_R2); const bf16_t* YB = YF + (size_t)NT * 512;
  const bf16_t* u = (const bf16_t*)(p.ws + OFF_U) + (size_t)row * ULD + 1696;
  const float* bonus = (const float*)(p.ws + OFF_BONUS);
  const int col = 1024 + lane * 8;
  const u32x4 z4 = (u32x4){0u, 0u, 0u, 0u};
  in.yf = *(const u32x4*)(YF + (size_t)row * 512 + lane * 8);
  in.yb = *(const u32x4*)(YB + (size_t)row * 512 + lane * 8);
  in.c = *(const u32x4*)(u + col);
  in.pv = t > 0 ? *(const u32x4*)(u - ULD + col) : z4;
  in.nx = t < T - 1 ? *(const u32x4*)(u + ULD + col) : z4;
  in.bs = *(const f32x2*)(bonus + ((size_t)row * 8 + (lane >> 3)) * 2);
}
DI void cpost_finish(const Params& p, int l, int row, int lane, const CpostIn& in) {
  bf16_t* u = (bf16_t*)(p.ws + OFF_U) + (size_t)row * ULD + 1696;
  float yf[8], yb[8], y[8];
  unpack8(in.yf, yf); unpack8(in.yb, yb);
  float s = 0.f;
#pragma unroll
  for (int i = 0; i < 8; ++i) { y[i] = yf[i] + yb[i]; s += y[i]; }
  s += shx<1>(s); s += shx<2>(s); s += shx<4>(s);
  const float mu = s * (1.0f / 64.0f);
  float q = 0.f;
#pragma unroll
  for (int i = 0; i < 8; ++i) { y[i] -= mu; q += y[i] * y[i]; }
  q += shx<1>(q); q += shx<2>(q); q += shx<4>(q);
  const float rs = rsqrtf(q * (1.0f / 64.0f) + 64e-5f);
  const int col = 1024 + lane * 8;
  float c[8], pv[8], nx[8];
  unpack8(in.c, c); unpack8(in.pv, pv); unpack8(in.nx, nx);
  const float* mup = p.in[I_MUP] + l * 1792 + col; const float* mun = p.in[I_MUN] + l * 1792 + col;
  const float* lw = p.in[I_LNW] + l * 512 + lane * 8; const float* lb = p.in[I_LNB] + l * 512 + lane * 8;
  const float bs = in.bs.x + in.bs.y;
  float o[8];
#pragma unroll
  for (int i = 0; i < 8; ++i) { const float v = c[i] + mup[i] * (pv[i] - c[i]) + mun[i] * (nx[i] - c[i]); o[i] = y[i] * rs * lw[i] + lb[i] + bs * v; }
  *(u32x4*)(u + lane * 8) = pack8(o);
}
DI void phase_renorm_cpost(const Params& p, int l) {
  const int lane = otid() & 63, wid = __builtin_amdgcn_readfirstlane(otid() >> 6);
  for (int item = blockIdx.x; item < NT / 8; item += gridDim.x) { const int ra = item * 8 + wid, rb = ra + 4; CpostIn ia, ib; cpost_load(p, ra, lane, ia); cpost_load(p, rb, lane, ib); norm_rows2(p, l, ra, rb, lane); cpost_finish(p, l, ra, lane, ia); cpost_finish(p, l, rb, lane, ib); }
}

DI void phase_zgemm(const Params& p, char* smem) {
  const bf16_t* H = (const bf16_t*)(p.ws + OFF_R1);
  const bf16_t* W = (const bf16_t*)(p.ws + OFF_WIN) + (size_t)3584 * 1024;
  bf16_t* U = (bf16_t*)(p.ws + OFF_U);
  const int ntiles = 320 * 12;
  for (int it = 0;; ++it) {
    int mt, nt; if (!next_tile(it, 12, 6, mt, nt)) break;
    const int m0 = mt * 128, n0 = nt * 128;
    f32x16 acc[2][2]; zero_acc<2>(acc);
    gemm_mainloop<2>(acc, H + (size_t)m0 * 1024, 1024, 64, W + (size_t)n0 * 1024, 1024, 1024, smem);
    const int lane = otid() & 63, wid = __builtin_amdgcn_readfirstlane(otid() >> 6), wm = wid >> 1, wn = wid & 1, r = lane & 31, hh = lane >> 5;
#pragma unroll
    for (int j = 0; j < 2; ++j) {
      const int col = n0 + wn * 64 + j * 32 + r;
      const int br = col >> 9, cc = col & 511;
      const int ucol = br == 0 ? cc : (br == 1 ? 768 + (cc >> 6) * 96 + (cc & 63) : 1696 + cc);
#pragma unroll
      for (int i = 0; i < 2; ++i) {
        bf16_t* up = U + (size_t)(m0 + wm * 64 + i * 32) * ULD;
        const int lo = 4 * hh * ULD + ucol;
        bf16_t yv[16];
#pragma unroll
        for (int e = 0; e < 16; ++e) yv[e] = (up + crowu(e) * ULD)[lo];
#pragma unroll
        for (int e = 0; e < 16; ++e) (up + crowu(e) * ULD)[lo] = f2bf(bf2f(yv[e]) * siluf_(acc[i][j][e]));
      }
    }
  }
}

DI void phase_merge(const Params& p, char* smem) {
  const bf16_t* H = (const bf16_t*)(p.ws + OFF_R1);
  const bf16_t* WG = (const bf16_t*)(p.ws + OFF_WIN) + (size_t)5120 * 1024;
  const bf16_t* WO = (const bf16_t*)(p.ws + OFF_WO);
  const bf16_t* U = (const bf16_t*)(p.ws + OFF_U);
  bf16_t* MX = (bf16_t*)(p.ws + OFF_R2);
  const int ntiles = 320 * 8;
  for (int it = 0;; ++it) {
    int mt, nt; if (!next_tile(it, 8, 8, mt, nt)) break;
    const int m0 = mt * 128, n0 = nt * 128;
    f32x16 mix[2][2]; zero_acc<2>(mix);
    unsigned gs[2][2][8];
#pragma unroll 1
    for (int step = 0; step < 6; ++step) {
      const int br = step >> 1, isT = step & 1;
      const int acol = br == 0 ? 0 : (br == 1 ? 768 : 1696);
      const bf16_t* Ap = isT ? U + (size_t)m0 * ULD + acol : H + (size_t)m0 * 1024;
      const bf16_t* Bp = isT ? WO + (size_t)(br * 1024 + n0) * 512 : WG + (size_t)(br * 1024 + n0) * 1024;
      f32x16 cur[2][2]; zero_acc<2>(cur);
      gemm_mainloop<2>(cur, Ap, isT ? ULD : 1024, (isT && br == 1) ? 96 : 64, Bp, isT ? 512 : 1024, isT ? 512 : 1024, smem);
      if (isT) {
#pragma unroll
        for (int i = 0; i < 2; ++i)
#pragma unroll
          for (int j = 0; j < 2; ++j)
#pragma unroll
            for (int e = 0; e < 8; ++e) { mix[i][j][2 * e] += lo16(gs[i][j][e]) * cur[i][j][2 * e]; mix[i][j][2 * e + 1] += hi16(gs[i][j][e]) * cur[i][j][2 * e + 1]; }
      } else {
#pragma unroll
        for (int i = 0; i < 2; ++i)
#pragma unroll
          for (int j = 0; j < 2; ++j)
#pragma unroll
            for (int e = 0; e < 8; ++e) gs[i][j][e] = pack2(sigmoidf_(cur[i][j][2 * e]), sigmoidf_(cur[i][j][2 * e + 1]));
      }
    }
    const int lane = otid() & 63, wid = __builtin_amdgcn_readfirstlane(otid() >> 6), wm = wid >> 1, wn = wid & 1, r = lane & 31, hh = lane >> 5;
#pragma unroll
    for (int j = 0; j < 2; ++j) {
      const int col = n0 + wn * 64 + j * 32 + r;
#pragma unroll
      for (int i = 0; i < 2; ++i) {
        bf16_t* mp = MX + (size_t)(m0 + wm * 64 + i * 32) * 1024;
        const int lo = 4 * hh * 1024 + col;
#pragma unroll
        for (int e = 0; e < 16; ++e) (mp + crowu(e) * 1024)[lo] = f2bf(mix[i][j][e]);
      }
    }
  }
}

DI void phase_out(const Params& p, int l, char* smem) {
  const bf16_t* MX = (const bf16_t*)(p.ws + OFF_R2);
  const bf16_t* W = (const bf16_t*)(p.ws + OFF_WOUT);
  const int ntiles = 320 * 8;
  for (int it = 0;; ++it) {
    int mt, nt; if (!next_tile(it, 8, 8, mt, nt)) break;
    const int m0 = mt * 128, n0 = nt * 128;
    f32x16 acc[2][2]; zero_acc<2>(acc);
    gemm_mainloop<2>(acc, MX + (size_t)m0 * 1024, 1024, 64, W + (size_t)n0 * 1024, 1024, 1024, smem);
    const int lane = otid() & 63, wid = __builtin_amdgcn_readfirstlane(otid() >> 6), wm = wid >> 1, wn = wid & 1, r = lane & 31, hh = lane >> 5;
    const int jm = m0 < NCTX ? 0 : 1 + ((m0 - NCTX) >> 12);
    const float* gate = (const float*)(p.ws + OFF_MOD) + ((size_t)l * 9 + jm) * MODLD + 2048;
    const float* xsrc = x_row_ptr(p, l, m0);
#pragma unroll
    for (int j = 0; j < 2; ++j) {
      const int col = n0 + wn * 64 + j * 32 + r;
      const float gv = gate[col];
      const int lo = 4 * hh * 1024 + col;
#pragma unroll
      for (int i = 0; i < 2; ++i) {
        const float* xs = xsrc + (size_t)(wm * 64 + i * 32) * 1024;
        float* xo = p.out + (size_t)(m0 + wm * 64 + i * 32) * 1024;
        float xv[16];
#pragma unroll
        for (int e = 0; e < 16; ++e) xv[e] = (xs + crowu(e) * 1024)[lo];
#pragma unroll
        for (int e = 0; e < 16; ++e) (xo + crowu(e) * 1024)[lo] = xv[e] + gv * acc[i][j][e];
      }
    }
  }
}

DI void phase_final(const Params& p) {
  const int lane = otid() & 63, wid = __builtin_amdgcn_readfirstlane(otid() >> 6);
  const float* nw = p.in[I_FNW];
  for (int item = blockIdx.x; item < NT / 4; item += gridDim.x) {
    float* x = p.out + (size_t)(item * 4 + wid) * 1024;
    f32x4 v[4]; float ss = 0.f;
#pragma unroll
    for (int i = 0; i < 4; ++i) { v[i] = *(const f32x4*)(x + lane * 4 + 256 * i); ss += v[i].x * v[i].x + v[i].y * v[i].y + v[i].z * v[i].z + v[i].w * v[i].w; }
ss = wave_sum(ss);
    const float rs = rsqrtf(ss * (1.0f / 1024.0f) + 1e-6f);
#pragma unroll
    for (int i = 0; i < 4; ++i) { const f32x4 w = *(const f32x4*)(nw + lane * 4 + 256 * i); *(f32x4*)(x + lane * 4 + 256 * i) = (f32x4){v[i].x * rs * w.x, v[i].y * rs * w.y, v[i].z * rs * w.z, v[i].w * rs * w.w}; }
  }
}

DI void grid_barrier(unsigned* bar, unsigned& epoch) {
  epoch += 1u;
  __syncthreads();
  if (otid() == 0) {
    const unsigned grp = blockIdx.x & 7u, per = gridDim.x >> 3;
    __builtin_amdgcn_fence(__ATOMIC_RELEASE, "agent");
    const unsigned old = __hip_atomic_fetch_add(bar + grp * 32, 1u, __ATOMIC_RELAXED, __HIP_MEMORY_SCOPE_AGENT);
    if (old + 1u == epoch * per) __hip_atomic_fetch_add(bar + 8 * 32, 1u, __ATOMIC_RELAXED, __HIP_MEMORY_SCOPE_AGENT);
    while (__hip_atomic_load(bar + 8 * 32, __ATOMIC_RELAXED, __HIP_MEMORY_SCOPE_AGENT) < epoch * 8u) __builtin_amdgcn_s_sleep(1);
    __builtin_amdgcn_fence(__ATOMIC_ACQUIRE, "agent");
  }
  __syncthreads();
}

constexpr int NPHASES = 1 + 4 * 9 + 1;
__global__ void __launch_bounds__(256, 2) fwd_kernel(Params p0) {
  __shared__ __attribute__((aligned(16))) char smem[SMEM_BYTES];
  cg::grid_group grid = cg::this_grid();
  const int ph_begin = p0.ph_begin, ph_end = p0.ph_end;
  unsigned* bar = (unsigned*)(p0.ws + OFF_BAR);
  unsigned epoch = 0u;
  for (int ph = ph_begin; ph < ph_end; ++ph) {
    auto kp = __builtin_amdgcn_kernarg_segment_ptr();
    asm volatile("" : "+s"(kp));
    typedef const __attribute__((address_space(4))) Params CParams;
    CParams* kpp = (CParams*)kp;
    Params p;
#pragma unroll
    for (int i = 0; i < 35; ++i) p.in[i] = kpp->in[i];
    p.out = kpp->out; p.ws = kpp->ws; p.ph_begin = ph_begin; p.ph_end = ph_end;
    if (ph == 0) phase_prologue(p, smem);
    else if (ph == NPHASES - 1) phase_final(p);
    else {
      const int l = (ph - 1) / 9, sp = (ph - 1) % 9;
#ifdef PROBE_SP
      if (sp == PROBE_SP) {
        switch (sp) {
          case 0: phase_norm_convert(p, l, smem); break;
          case 1: phase_gemm1(p, l, smem); break;
          case 3: phase_upproj(p, smem); break;
          case 5: phase_renorm_cpost(p, l); break;
          case 7: phase_merge(p, smem); break;
          default: break;
        }
        grid.sync();
      }
#endif
      switch (sp) {
        case 0: phase_norm_convert(p, l, smem); break;
        case 1: phase_gemm1(p, l, smem); break;
        case 2: phase_post(p, l); break;
        case 3: phase_upproj(p, smem); break;
        case 4: phase_mixers(p, l, smem); break;
        case 5: phase_renorm_cpost(p, l); break;
        case 6: phase_zgemm(p, smem); break;
        case 7: phase_merge(p, smem); break;
        default: phase_out(p, l, smem); break;
      }
    }
    if (ph + 1 < ph_end) { if (ph == 0) grid.sync(); else grid_barrier(bar, epoch); }
  }
}

extern "C" void kernel_launch(void* const* d_in, const int* in_sizes, int n_in, void* d_out, int out_size, void* d_ws, size_t ws_size, hipStream_t stream) {
  if (ws_size < WS_NEED || n_in < 35) { fprintf(stderr, "workspace too small: %zu < %zu\n", ws_size, WS_NEED); return; }
  static int grid_blocks = 0;
  if (!grid_blocks) {
    int dev = 0, cus = 0, per_cu = 0;
    hipGetDevice(&dev);
    hipDeviceGetAttribute(&cus, hipDeviceAttributeMultiprocessorCount, dev);
    hipOccupancyMaxActiveBlocksPerMultiprocessor(&per_cu, fwd_kernel, 256, 0);
    if (per_cu < 1) per_cu = 1;
    if (per_cu > 2) per_cu = 2;
    grid_blocks = cus * per_cu;
  }
  Params p{};
  for (int i = 0; i < 35; ++i) p.in[i] = (const float*)d_in[i];
  p.out = (float*)d_out; p.ws = (char*)d_ws;
#ifndef ONE_LAUNCH
  for (int ph = 0; ph < NPHASES; ++ph) {
    p.ph_begin = ph; p.ph_end = ph + 1;
    hipLaunchKernelGGL(fwd_kernel, dim3(grid_blocks), dim3(256), 0, stream, p);
  }
#else
  p.ph_begin = 0; p.ph_end = NPHASES;
  hipMemsetAsync((char*)d_ws + OFF_BAR, 0, 4096, stream);
  void* args[] = {&p};
  hipError_t e = hipLaunchCooperativeKernel((void*)fwd_kernel, dim3(grid_blocks), dim3(256), args, 0, stream);
  if (e != hipSuccess) fprintf(stderr, "cooperative launch failed: %s (grid %d)\n", hipGetErrorString(e), grid_blocks);
#endif
}
```

```cpp
#define ONE_LAUNCH 1
#include <hip/hip_runtime.h>
#include <hip/hip_cooperative_groups.h>
#include <stdint.h>
#include <stdio.h>
namespace cg = cooperative_groups;

typedef unsigned short bf16_t;
typedef short bf16x8 __attribute__((ext_vector_type(8)));
typedef float f32x16 __attribute__((ext_vector_type(16)));
typedef float f32x4 __attribute__((ext_vector_type(4)));
typedef float f32x2 __attribute__((ext_vector_type(2)));
typedef unsigned u32x4 __attribute__((ext_vector_type(4)));
typedef unsigned u32x2 __attribute__((ext_vector_type(2)));
#define DI __device__ __forceinline__
#define MFMA32(a, b, c) __builtin_amdgcn_mfma_f32_32x32x16_bf16((a), (b), (c), 0, 0, 0)

constexpr int NT = 40960;
constexpr int NCTX = 8192;
constexpr int NK = 45056;
constexpr int ULD = 3488;
constexpr int MODLD = 3072;
constexpr int SMEM_BYTES = 78848;

constexpr size_t OFF_WIN = 0;
constexpr size_t OFF_WO = 16777216;
constexpr size_t OFF_WOUT = 19922944;
constexpr size_t OFF_WU = 22020096;
constexpr size_t OFF_MOD = 22282240;
constexpr size_t OFF_BONUS = 22724608;
constexpr size_t OFF_CS16 = 25346048;
constexpr size_t OFF_CS8 = 25354240;
constexpr size_t OFF_CNT = 25358336;
constexpr size_t OFF_BAR = 524742912;
constexpr size_t OFF_U = 25358592;
constexpr size_t OFF_R1 = 311095552;
constexpr size_t OFF_KA = OFF_R1;
constexpr size_t OFF_VAT = 513208576;
constexpr size_t OFF_KN = OFF_R1 + 23068672;
constexpr size_t OFF_VBT = OFF_R1 + 69206016;
constexpr size_t OFF_KRB = OFF_R1 + 115343360;
constexpr size_t OFF_R2 = 429322496;
constexpr size_t WS_NEED = 524742912 + 4096;

constexpr size_t OUT_AK = 41943040, OUT_AV = 46137344, OUT_CKV = 50331648, OUT_KR = 54525952, OUT_SF = 55574528, OUT_SB = 59768832;

struct Params {
  const float* in[35];
  float* out;
  char* ws;
  int ph_begin, ph_end;
};

enum { I_XP = 0, I_XS, I_CAK, I_CAV, I_CCKV, I_CKR, I_SF, I_SB, I_C, I_CCTX, I_NORMW, I_WMOD, I_BMOD, I_WIN, I_QNW, I_KNW, I_KVNW,
       I_WUK, I_WUV, I_MUP, I_MUN, I_W0, I_WUP, I_A0, I_AUP, I_KK, I_KA, I_RK, I_LNW, I_LNB, I_WOA, I_WOB, I_WOC, I_WOUT, I_FNW };

DI int threadIdx_x_raw() { return __builtin_amdgcn_workitem_id_x(); }
DI int otid() { int t = threadIdx_x_raw(); asm volatile("" : "+v"(t)); return t; }
DI const float* opq(const float* q) { asm volatile("" : "+s"(q)); return q; }
DI float* opq(float* q) { asm volatile("" : "+s"(q)); return q; }
DI float bf2f(bf16_t v) { return __uint_as_float(((unsigned)v) << 16); }
typedef __bf16 hbf16x2 __attribute__((ext_vector_type(2)));
DI unsigned pack2(float a, float b) { f32x2 v = {a, b}; hbf16x2 r = __builtin_convertvector(v, hbf16x2); return __builtin_bit_cast(unsigned, r); }
DI bf16_t f2bf(float x) { return (bf16_t)(pack2(x, 0.f) & 0xffffu); }
DI float xsum16(float x) { const unsigned u = __float_as_uint(x); auto r = __builtin_amdgcn_permlane16_swap(u, u, false, false); return __uint_as_float(r[0]) + __uint_as_float(r[1]); }
DI float xsum32(float x) { const unsigned u = __float_as_uint(x); auto r = __builtin_amdgcn_permlane32_swap(u, u, false, false); return __uint_as_float(r[0]) + __uint_as_float(r[1]); }
DI float lo16(unsigned w) { return __uint_as_float(w << 16); }
DI float hi16(unsigned w) { return __uint_as_float(w & 0xffff0000u); }
DI void unpack8(u32x4 w, float* v) { v[0] = lo16(w.x); v[1] = hi16(w.x); v[2] = lo16(w.y); v[3] = hi16(w.y); v[4] = lo16(w.z); v[5] = hi16(w.z); v[6] = lo16(w.w); v[7] = hi16(w.w); }
DI u32x4 pack8(const float* v) { u32x4 w; w.x = pack2(v[0], v[1]); w.y = pack2(v[2], v[3]); w.z = pack2(v[4], v[5]); w.w = pack2(v[6], v[7]); return w; }
template <int K> DI float shx(float v) { return __int_as_float(__builtin_amdgcn_ds_swizzle(__float_as_int(v), 0x1f | (K << 10))); }
DI float wave_sum(float v) { v += shx<1>(v); v += shx<2>(v); v += shx<4>(v); v += shx<8>(v); v += shx<16>(v); return xsum32(v); }
DI float qsum(float v) {
  v += __int_as_float(__builtin_amdgcn_update_dpp(0, __float_as_int(v), 0xB1, 0xf, 0xf, true));
  v += __int_as_float(__builtin_amdgcn_update_dpp(0, __float_as_int(v), 0x4E, 0xf, 0xf, true));
  return v;
}
DI float osum(float v) {
  v = qsum(v);
  v += __int_as_float(__builtin_amdgcn_update_dpp(0, __float_as_int(v), 0x141, 0xf, 0xf, true));
  return v;
}
DI int crow(int reg, int h) { return (reg & 3) + 8 * (reg >> 2) + 4 * h; }
DI int crowu(int reg) { return (reg & 3) + 8 * (reg >> 2); }
DI int perm16(int t) { return (t & ~12) | ((t & 4) << 1) | ((t & 8) >> 1); }
DI float sigmoidf_(float x) { return __builtin_amdgcn_rcpf(1.0f + __expf(-x)); }
DI float siluf_(float x) { return x * __builtin_amdgcn_rcpf(1.0f + __expf(-x)); }

DI void row_decode(int row, int& seq, int& t) {
  if (row < NCTX) { seq = row >> 8; t = row & 255; } else { seq = 32 + ((row - NCTX) >> 12); t = (row - NCTX) & 4095; }
}
DI int keyrow0(int seq) { return seq < 32 ? seq * 256 : NCTX + (seq - 32) * 4608; }
DI int seq_tk(int seq) { return seq < 32 ? 256 : 4608; }

typedef __attribute__((address_space(3))) unsigned lds_u32;
template <int NJ>
DI void gemm_mainloop(f32x16 (&acc)[2][NJ], const bf16_t* __restrict__ A, int lda, int ks,
                      const bf16_t* __restrict__ Bt, int ldb, int K, char* smem) {
  constexpr int A_BYTES = 128 * 128;
  constexpr int B_BYTES = 64 * NJ * 128;
  constexpr int STAGE = A_BYTES + B_BYTES;
  const int tid = otid(), lane = tid & 63, wid = __builtin_amdgcn_readfirstlane(tid >> 6), wm = wid >> 1, wn = wid & 1;
  const int r = lane & 31, hh = lane >> 5;
  const int nk = K >> 6;
  const int lrow = tid >> 3, lc = tid & 7;
  const int gc = (lc ^ ((lrow >> 1) & 7)) * 8;
  const bf16_t* ap = A + (size_t)lrow * lda + gc;
  const bf16_t* bp = Bt + (size_t)lrow * ldb + gc;
  auto issue = [&](int kt, int buf) {
    char* base = smem + buf * STAGE + tid * 16;
    const bf16_t* ap2 = ap + (size_t)kt * ks;
    const bf16_t* bp2 = bp + (size_t)kt * 64;
#pragma unroll
    for (int p = 0; p < 4; ++p) __builtin_amdgcn_global_load_lds((const unsigned*)(ap2 + (size_t)(32 * p) * lda), (lds_u32*)(base + p * 4096), 16, 0, 0);
#pragma unroll
    for (int p = 0; p < 2 * NJ; ++p) __builtin_amdgcn_global_load_lds((const unsigned*)(bp2 + (size_t)(32 * p) * ldb), (lds_u32*)(base + A_BYTES + p * 4096), 16, 0, 0);
  };
  issue(0, 0);
  __syncthreads();
#pragma unroll 1
  for (int kt = 0; kt < nk; ++kt) {
    if (kt + 1 < nk) issue(kt + 1, (kt + 1) & 1);
    const char* base = smem + (kt & 1) * STAGE;
#pragma unroll
    for (int s = 0; s < 4; ++s) {
      bf16x8 af[2], bfr[NJ];
#pragma unroll
      for (int i = 0; i < 2; ++i) { const int row = wm * 64 + i * 32 + r; af[i] = *(const bf16x8*)(base + row * 128 + (((2 * s + hh) ^ ((row >> 1) & 7)) << 4)); }
#pragma unroll
      for (int j = 0; j < NJ; ++j) { const int row = wn * (32 * NJ) + j * 32 + r; bfr[j] = *(const bf16x8*)(base + A_BYTES + row * 128 + (((2 * s + hh) ^ ((row >> 1) & 7)) << 4)); }
#pragma unroll
      for (int i = 0; i < 2; ++i)
#pragma unroll
        for (int j = 0; j < NJ; ++j) acc[i][j] = MFMA32(af[i], bfr[j], acc[i][j]);
    }
    __syncthreads();
  }
}

template <int NJ> DI void zero_acc(f32x16 (&acc)[2][NJ]) {
#pragma unroll
  for (int i = 0; i < 2; ++i)
#pragma unroll
    for (int j = 0; j < NJ; ++j)
#pragma unroll
      for (int e = 0; e < 16; ++e) acc[i][j][e] = 0.f;
}

DI void phase_prologue(const Params& p, char* smem) {
  const int tid = otid(), lane = tid & 63, wid = __builtin_amdgcn_readfirstlane(tid >> 6);
  float* mod = (float*)(p.ws + OFF_MOD);
  if (blockIdx.x == 0) {
    if (tid < 32) ((unsigned*)(p.ws + OFF_CNT))[tid] = 0u;
    float* cs16 = (float*)(p.ws + OFF_CS16);
    float* cs8 = (float*)(p.ws + OFF_CS8);
    for (int e = tid; e < 64 * 16; e += 256) { const int pos = e >> 4, i = e & 15; const float inv = expf(-9.210340371976184f * (float)i / 16.0f); const float a = (float)pos * inv; cs16[e * 2] = cosf(a); cs16[e * 2 + 1] = sinf(a); }
    for (int e = tid; e < 64 * 8; e += 256) { const int pos = e >> 3, i = e & 7; const float inv = expf(-9.210340371976184f * (float)i / 8.0f); const float a = (float)pos * inv; cs8[e * 2] = cosf(a); cs8[e * 2 + 1] = sinf(a); }
  }
  float* sl = (float*)smem;
  float* red = sl + 9 * 1024;
  for (int e = tid; e < 9 * 1024; e += 256) { const int j = e >> 10, k = e & 1023; const float* cc0 = opq(p.in[I_CCTX]); const float* cc1 = opq(p.in[I_C]); const float c = j == 0 ? cc0[k] : cc1[(j - 1) * 1024 + k]; sl[e] = siluf_(c); }
  __syncthreads();
  for (int item = blockIdx.x; item < 192; item += gridDim.x) {
    const int l = item / 48, n = (item % 48) * 64 + lane;
    const float* w = p.in[I_WMOD] + (size_t)l * 1024 * 3072 + n;
    float a[9];
#pragma unroll
    for (int j = 0; j < 9; ++j) a[j] = 0.f;
    for (int k = wid * 256; k < wid * 256 + 256; ++k) {
      const float wv = w[(size_t)k * 3072];
#pragma unroll
      for (int j = 0; j < 9; ++j) a[j] += sl[j * 1024 + k] * wv;
    }
#pragma unroll
    for (int j = 0; j < 9; ++j) red[(wid * 9 + j) * 64 + lane] = a[j];
    __syncthreads();
    for (int e = tid; e < 9 * 64; e += 256) {
      const int j = e >> 6, c = e & 63;
      const float s = red[(0 * 9 + j) * 64 + c] + red[(1 * 9 + j) * 64 + c] + red[(2 * 9 + j) * 64 + c] + red[(3 * 9 + j) * 64 + c];
      const int nn = (item % 48) * 64 + c;
      mod[((size_t)l * 9 + j) * MODLD + nn] = s + p.in[I_BMOD][l * 3072 + nn];
    }
    __syncthreads();
  }
}

DI const float* x_row_ptr(const Params& p, int l, int row) {
  const float* xp = opq(p.in[I_XP]); const float* xs = opq(p.in[I_XS]); const float* xo = opq((const float*)p.out);
  if (l == 0) return row < NCTX ? xp + (size_t)row * 1024 : xs + (size_t)(row - NCTX) * 1024;
  return xo + (size_t)row * 1024;
}
DI void norm_row(const Params& p, int l, int row, int lane) {
  const float* x = x_row_ptr(p, l, row);
  const int j = row < NCTX ? 0 : 1 + ((row - NCTX) >> 12);
  const float* mod = (const float*)(p.ws + OFF_MOD) + ((size_t)l * 9 + j) * MODLD;
  const float* nw = p.in[I_NORMW] + l * 1024;
  bf16_t* h = (bf16_t*)(p.ws + OFF_R1) + (size_t)row * 1024;
  f32x4 v[4]; float ss = 0.f;
#pragma unroll
  for (int i = 0; i < 4; ++i) { v[i] = *(const f32x4*)(x + lane * 4 + 256 * i); ss += v[i].x * v[i].x + v[i].y * v[i].y + v[i].z * v[i].z + v[i].w * v[i].w; }
ss = wave_sum(ss);
  const float rs = rsqrtf(ss * (1.0f / 1024.0f) + 1e-6f);
#pragma unroll
  for (int i = 0; i < 4; ++i) {
    const int c = lane * 4 + 256 * i;
    const f32x4 w = *(const f32x4*)(nw + c), sh = *(const f32x4*)(mod + c), sc = *(const f32x4*)(mod + 1024 + c);
    u32x2 o;
    o.x = pack2(v[i].x * rs * w.x * (1.f + sc.x) + sh.x, v[i].y * rs * w.y * (1.f + sc.y) + sh.y);
    o.y = pack2(v[i].z * rs * w.z * (1.f + sc.z) + sh.z, v[i].w * rs * w.w * (1.f + sc.w) + sh.w);
    *(u32x2*)(h + c) = o;
  }
}

DI void norm_rows2(const Params& p, int l, int rowa, int rowb, int lane) {
  const float* xa = x_row_ptr(p, l, rowa); const float* xb = x_row_ptr(p, l, rowb);
  f32x4 va[4], vb[4];
#pragma unroll
  for (int i = 0; i < 4; ++i) va[i] = *(const f32x4*)(xa + lane * 4 + 256 * i);
#pragma unroll
  for (int i = 0; i < 4; ++i) vb[i] = *(const f32x4*)(xb + lane * 4 + 256 * i);
  const float* nw = p.in[I_NORMW] + l * 1024;
#pragma unroll
  for (int rr = 0; rr < 2; ++rr) {
    const int row = rr ? rowb : rowa;
    f32x4 (&v)[4] = rr ? vb : va;
    const int j = row < NCTX ? 0 : 1 + ((row - NCTX) >> 12);
    const float* mod = (const float*)(p.ws + OFF_MOD) + ((size_t)l * 9 + j) * MODLD;
    bf16_t* h = (bf16_t*)(p.ws + OFF_R1) + (size_t)row * 1024;
    float ss = 0.f;
#pragma unroll
    for (int i = 0; i < 4; ++i) ss += v[i].x * v[i].x + v[i].y * v[i].y + v[i].z * v[i].z + v[i].w * v[i].w;
    ss = wave_sum(ss);
    const float rs = rsqrtf(ss * (1.0f / 1024.0f) + 1e-6f);
#pragma unroll
    for (int i = 0; i < 4; ++i) {
      const int c = lane * 4 + 256 * i;
      const f32x4 w = *(const f32x4*)(nw + c), sh = *(const f32x4*)(mod + c), sc = *(const f32x4*)(mod + 1024 + c);
      u32x2 o;
      o.x = pack2(v[i].x * rs * w.x * (1.f + sc.x) + sh.x, v[i].y * rs * w.y * (1.f + sc.y) + sh.y);
      o.y = pack2(v[i].z * rs * w.z * (1.f + sc.z) + sh.z, v[i].w * rs * w.w * (1.f + sc.w) + sh.w);
      *(u32x2*)(h + c) = o;
    }
  }
}

DI int win_srccol(int j) {
  if (j < 768) return j;
  if (j < 1696) return j + 512;
  if (j < 3488) return j + 1024;
  if (j < 3584) return -1;
  if (j < 5120) { const int jj = j - 3584; return jj < 512 ? 768 + jj : (jj < 1024 ? 2208 + (jj - 512) : 4512 + (jj - 1024)); }
  return 5024 + (j - 5120);
}
DI void conv_tile(const float* __restrict__ src, int ld_src, bf16_t* dst, int ld_dst, int k0, int n0, int kind, int srcoff, char* smem) {
  float* tile = (float*)smem;
  const int tid = otid();
  const int n = tid & 63;
  int sc = kind == 0 ? win_srccol(n0 + n) : (n0 + n - srcoff);
#pragma unroll
  for (int i = 0; i < 16; ++i) { const int k = i * 4 + (tid >> 6); tile[k * 65 + n] = sc >= 0 ? src[(size_t)(k0 + k) * ld_src + sc] : 0.f; }
  __syncthreads();
#pragma unroll
  for (int i = 0; i < 8; ++i) { const int nn = i * 8 + (tid >> 5), kk = (tid & 31) * 2; *(unsigned*)(dst + (size_t)(n0 + nn) * ld_dst + k0 + kk) = pack2(tile[kk * 65 + nn], tile[(kk + 1) * 65 + nn]); }
  __syncthreads();
}

DI void phase_norm_convert(const Params& p, int l, char* smem) {
  const int tid = otid(), lane = tid & 63, wid = __builtin_amdgcn_readfirstlane(tid >> 6);
  bf16_t* WinT = (bf16_t*)(p.ws + OFF_WIN); bf16_t* WoT = (bf16_t*)(p.ws + OFF_WO); bf16_t* WoutT = (bf16_t*)(p.ws + OFF_WOUT); bf16_t* WuT = (bf16_t*)(p.ws + OFF_WU);
  const int NI_WIN = 128 * 16, NI_WO = 3 * 16 * 8, NI_WOUT = 16 * 16, NI_WU = 16 * 2;
  const int NI_CONV = NI_WIN + NI_WO + NI_WOUT + NI_WU;
  for (int item = blockIdx.x; item < NI_CONV; item += gridDim.x) {
    int it = item;
    if (it < NI_WIN) { conv_tile(p.in[I_WIN] + (size_t)l * 1024 * 8096, 8096, WinT, 1024, (it & 15) * 64, (it >> 4) * 64, 0, 0, smem); continue; }
    it -= NI_WIN;
    if (it < NI_WO) { const int br = it / 128, r2 = it % 128; const float* src = (br == 0 ? opq(p.in[I_WOA]) : (br == 1 ? opq(p.in[I_WOB]) : opq(p.in[I_WOC]))) + (size_t)l * 512 * 1024; conv_tile(src, 1024, WoT + (size_t)br * 1024 * 512, 512, (r2 & 7) * 64, (r2 >> 3) * 64, 1, 0, smem); continue; }
    it -= NI_WO;
    if (it < NI_WOUT) { conv_tile(p.in[I_WOUT] + (size_t)l * 1024 * 1024, 1024, WoutT, 1024, (it & 15) * 64, (it >> 4) * 64, 1, 0, smem); continue; }
    it -= NI_WOUT;
    { const int nt = it >> 1, kt = it & 1; const bool uv = nt >= 8; const float* src = (uv ? opq(p.in[I_WUV]) : opq(p.in[I_WUK])) + (size_t)l * 128 * 512; conv_tile(src, 512, WuT, 128, kt * 64, nt * 64, 1, uv ? 512 : 0, smem); }
  }
  for (int item = blockIdx.x; item < NT / 8; item += gridDim.x) norm_rows2(p, l, item * 8 + wid, item * 8 + 4 + wid, lane);
}

DI bool next_tile(int it, int NTN, int GN, int& mt, int& nt, int MPX = 40, int GM = 8) {
  if (gridDim.x == 512) {
    const int x = blockIdx.x & 7, local = blockIdx.x >> 3;
    const int q = it * 64 + local;
    if (q >= MPX * NTN) return false;
    const int gsz = GM * GN, g = q / gsz, w = q - g * gsz, ngroups = NTN / GN;
    const int mgi = g / ngroups, ngi = g - mgi * ngroups;
    mt = x * MPX + mgi * GM + w / GN; nt = ngi * GN + (w % GN);
    return true;
  }
  const int tile = blockIdx.x + it * gridDim.x;
  if (tile >= 8 * MPX * NTN) return false;
  mt = tile / NTN; nt = tile % NTN;
  return true;
}

DI void phase_gemm1(const Params& p, int l, char* smem) {
  const bf16_t* H = (const bf16_t*)(p.ws + OFF_R1);
  const bf16_t* W = (const bf16_t*)(p.ws + OFF_WIN);
  bf16_t* U = (bf16_t*)(p.ws + OFF_U);
  bf16_t* VAT = (bf16_t*)(p.ws + OFF_VAT);
  const int NTN = 28, ntiles = 320 * NTN;
  for (int it = 0;; ++it) {
    int mt, nt; if (!next_tile(it, NTN, 7, mt, nt)) break;
    const int m0 = mt * 128, n0 = nt * 128;
    f32x16 acc[2][2]; zero_acc<2>(acc);
    gemm_mainloop<2>(acc, H + (size_t)m0 * 1024, 1024, 64, W + (size_t)n0 * 1024, 1024, 1024, smem);
    const int lane = otid() & 63, wid = __builtin_amdgcn_readfirstlane(otid() >> 6), wm = wid >> 1, wn = wid & 1, r = lane & 31, hh = lane >> 5;
    int seq, t0; row_decode(m0, seq, t0);
#pragma unroll
    for (int j = 0; j < 2; ++j) {
      const int cb = n0 + wn * 64 + j * 32;
      if (cb >= ULD) continue;
      const int col = cb + r;
      if (cb >= 640 && cb < 768) {
        const int kvh = (col - 640) >> 6, dv = col & 63, Tk = seq_tk(seq);
        bf16_t* vt = VAT + (size_t)128 * keyrow0(seq) + (size_t)(kvh * 64 + dv) * Tk;
#pragma unroll
        for (int i = 0; i < 2; ++i) {
          const int tt = t0 + wm * 64 + i * 32;
#pragma unroll
          for (int g2 = 0; g2 < 2; ++g2) {
            float v[8];
#pragma unroll
            for (int e = 0; e < 8; ++e) v[e] = acc[i][j][g2 * 8 + e];
            *(u32x4*)(vt + tt + 16 * g2 + 8 * hh) = pack8(v);
          }
          if (seq < 32) {
            float* o = p.out + OUT_AV + ((size_t)(seq * 4 + l) * 256 + tt) * 128;
            const int lo = 4 * hh * 128 + (col - 640);
#pragma unroll
            for (int e = 0; e < 16; ++e) (o + crowu(e) * 128)[lo] = acc[i][j][e];
          }
        }
      } else {
#pragma unroll
        for (int i = 0; i < 2; ++i) {
          bf16_t* up = U + (size_t)(m0 + wm * 64 + i * 32) * ULD;
          const int lo = 4 * hh * ULD + col;
#pragma unroll
          for (int e = 0; e < 16; ++e) (up + crowu(e) * ULD)[lo] = f2bf(acc[i][j][e]);
        }
      }
    }
  }
}

struct PostIn { u32x4 q, k, bq; u32x2 br; unsigned ckv; bf16_t kr; };
DI void post_load(const Params& p, int row, int lane, PostIn& in) {
  const bf16_t* u = (const bf16_t*)(p.ws + OFF_U) + (size_t)row * ULD;
  in.q = *(const u32x4*)(u + lane * 8);
  in.k = *(const u32x4*)(u + 512 + (lane & 15) * 8);
  in.bq = *(const u32x4*)(u + 768 + (lane >> 3) * 96 + (lane & 7) * 8);
  in.br = *(const u32x2*)(u + 768 + (lane >> 3) * 96 + 64 + (lane & 7) * 4);
  in.ckv = *(const unsigned*)(u + 1536 + lane * 2);
  in.kr = u[1664 + (lane & 31)];
}
DI void post_row(const Params& p, int l, int row, int lane, const PostIn& in) {
  int seq, t; row_decode(row, seq, t);
  const bool lat = row >= NCTX;
  const int krow = keyrow0(seq) + t;
  const int prow = t >> 6, pcol = t & 63;
  bf16_t* u = (bf16_t*)(p.ws + OFF_U) + (size_t)row * ULD;
  const float* cs16 = (const float*)(p.ws + OFF_CS16);
  const float* cs8 = (const float*)(p.ws + OFF_CS8);
  const float LOG2E = 1.4426950408889634f;
#pragma unroll
  for (int which = 0; which < 2; ++which) {
    const int l8 = which == 0 ? lane : (lane & 15);
    float v[8]; unpack8(which == 0 ? in.q : in.k, v);
    float ss = 0.f;
#pragma unroll
    for (int i = 0; i < 8; ++i) ss += v[i] * v[i];
    ss += shx<1>(ss); ss += shx<2>(ss); ss += shx<4>(ss);
    const float rs = rsqrtf(ss * (1.0f / 64.0f) + 1e-6f);
    const float* nw = (which == 0 ? opq(p.in[I_QNW]) : opq(p.in[I_KNW])) + l * 64 + (lane & 7) * 8;
#pragma unroll
    for (int i = 0; i < 8; ++i) v[i] = v[i] * rs * nw[i];
    float pv[8];
#pragma unroll
    for (int i = 0; i < 8; ++i) pv[i] = shx<2>(v[i]);
    if (lat) {
      const int pos = ((lane & 7) >> 2) ? pcol : prow;
      const bool lower = (lane & 2) == 0;
      const float* cs = cs16 + (pos * 16 + (lane & 1) * 8) * 2;
#pragma unroll
      for (int i = 0; i < 8; ++i) { const float c = cs[i * 2], s = cs[i * 2 + 1]; v[i] = lower ? v[i] * c - pv[i] * s : v[i] * c + pv[i] * s; }
    }
    if (which == 0) {
      const float sc = 0.125f * LOG2E;
#pragma unroll
      for (int i = 0; i < 8; ++i) v[i] *= sc;
      *(u32x4*)(u + lane * 8) = pack8(v);
    } else if (lane < 16) {
      bf16_t* KA = (bf16_t*)(p.ws + OFF_KA);
      *(u32x4*)(KA + (size_t)krow * 128 + lane * 8) = pack8(v);
      if (!lat) {
        float* o = p.out + OUT_AK + ((size_t)(seq * 4 + l) * 256 + t) * 128 + lane * 8;
        *(f32x4*)o = (f32x4){v[0], v[1], v[2], v[3]}; *(f32x4*)(o + 4) = (f32x4){v[4], v[5], v[6], v[7]};
      }
    }
  }
  {
    const float sc = 0.10206207261596577f * LOG2E;
    const int hd = lane >> 3;
    bf16_t* q = u + 768 + hd * 96;
    { float v[8]; unpack8(in.bq, v);
#pragma unroll
      for (int i = 0; i < 8; ++i) v[i] *= sc;
      *(u32x4*)(q + (lane & 7) * 8) = pack8(v); }
    { bf16_t* qr = q + 64 + (lane & 7) * 4;
      const u32x2 w = in.br;
      float v[4] = {lo16(w.x), hi16(w.x), lo16(w.y), hi16(w.y)}, pv[4];
#pragma unroll
      for (int i = 0; i < 4; ++i) pv[i] = shx<2>(v[i]);
      if (lat) {
        const int pos = ((lane & 7) >> 2) ? pcol : prow;
        const bool lower = (lane & 2) == 0;
        const float* cs = cs8 + (pos * 8 + (lane & 1) * 4) * 2;
#pragma unroll
        for (int i = 0; i < 4; ++i) { const float c = cs[i * 2], s = cs[i * 2 + 1]; v[i] = lower ? v[i] * c - pv[i] * s : v[i] * c + pv[i] * s; }
      }
      u32x2 o; o.x = pack2(v[0] * sc, v[1] * sc); o.y = pack2(v[2] * sc, v[3] * sc);
      *(u32x2*)qr = o; }
  }
  {
    const unsigned w = in.ckv;
    float a = lo16(w), b = hi16(w);
    float ss = a * a + b * b;
ss = wave_sum(ss);
    const float rs = rsqrtf(ss * (1.0f / 128.0f) + 1e-6f);
    const float* nw = p.in[I_KVNW] + l * 128 + lane * 2;
    a = a * rs * nw[0]; b = b * rs * nw[1];
    bf16_t* CKVN = (bf16_t*)(p.ws + OFF_R2);
    *(unsigned*)(CKVN + (size_t)krow * 128 + lane * 2) = pack2(a, b);
    if (!lat) { float* o = p.out + OUT_CKV + ((size_t)(seq * 4 + l) * 256 + t) * 128 + lane * 2; *(f32x2*)o = (f32x2){a, b}; }
  }
  {
    float v = bf2f(in.kr);
    const float pv = shx<8>(v);
    if (!lat) { if (lane < 32) p.out[OUT_KR + ((size_t)(seq * 4 + l) * 256 + t) * 32 + lane] = v; }
    else {
      const int d = lane & 31; const int pos = (d >> 4) ? pcol : prow; const bool lower = (d & 8) == 0;
      const float* cs = cs8 + (pos * 8 + (d & 7)) * 2;
      v = lower ? v * cs[0] - pv * cs[1] : v * cs[0] + pv * cs[1];
    }
    if (lane < 32) ((bf16_t*)(p.ws + OFF_KRB))[(size_t)krow * 32 + lane] = f2bf(v);
  }
}
DI void post_cached_row(const Params& p, int l, int idx, int lane) {
  const int b = idx >> 9, j = idx & 511;
  const int kr0 = NCTX + b * 4608, krow = kr0 + 4096 + j;
  const size_t cb = ((size_t)(b * 4 + l) * 512 + j);
  bf16_t* KA = (bf16_t*)(p.ws + OFF_KA); bf16_t* VAT = (bf16_t*)(p.ws + OFF_VAT); bf16_t* CKVN = (bf16_t*)(p.ws + OFF_R2); bf16_t* KRB = (bf16_t*)(p.ws + OFF_KRB);
  { const f32x2 v = *(const f32x2*)(p.in[I_CAK] + cb * 128 + lane * 2); *(unsigned*)(KA + (size_t)krow * 128 + lane * 2) = pack2(v.x, v.y); }
  { const f32x2 v = *(const f32x2*)(p.in[I_CAV] + cb * 128 + lane * 2);
    bf16_t* vt = VAT + (size_t)128 * kr0 + (size_t)(lane * 2) * 4608 + perm16(4096 + j);
    vt[0] = f2bf(v.x); vt[4608] = f2bf(v.y); }
  { const f32x2 v = *(const f32x2*)(p.in[I_CCKV] + cb * 128 + lane * 2); *(unsigned*)(CKVN + (size_t)krow * 128 + lane * 2) = pack2(v.x, v.y); }
  if (lane < 32) KRB[(size_t)krow * 32 + lane] = f2bf(p.in[I_CKR][cb * 32 + lane]);
}
DI void phase_post(const Params& p, int l) {
  const int lane = otid() & 63, wid = __builtin_amdgcn_readfirstlane(otid() >> 6);
  for (int item = blockIdx.x; item < NT / 8 + 1024; item += gridDim.x) {
    if (item < NT / 8) {
      const int ra = item * 8 + wid, rb = ra + 4;
      PostIn ia, ib; post_load(p, ra, lane, ia); post_load(p, rb, lane, ib);
      post_row(p, l, ra, lane, ia); post_row(p, l, rb, lane, ib);
    }
    else post_cached_row(p, l, (item - NT / 8) * 4 + wid, lane);
  }
}

DI void phase_upproj(const Params& p, char* smem) {
  const bf16_t* A = (const bf16_t*)(p.ws + OFF_R2);
  const bf16_t* W = (const bf16_t*)(p.ws + OFF_WU);
  bf16_t* KN = (bf16_t*)(p.ws + OFF_KN); bf16_t* VBT = (bf16_t*)(p.ws + OFF_VBT);
  const int ntiles = 352 * 8;
  for (int it = 0;; ++it) {
    int mt, nt; if (!next_tile(it, 8, 8, mt, nt, 44, 4)) break;
    const int m0 = mt * 128, n0 = nt * 128;
    f32x16 acc[2][2]; zero_acc<2>(acc);
    gemm_mainloop<2>(acc, A + (size_t)m0 * 128, 128, 64, W + (size_t)n0 * 128, 128, 128, smem);
    const int lane = otid() & 63, wid = __builtin_amdgcn_readfirstlane(otid() >> 6), wm = wid >> 1, wn = wid & 1, r = lane & 31, hh = lane >> 5;
    int seq, t0;
    if (m0 < NCTX) { seq = m0 >> 8; t0 = m0 & 255; } else { const int rr = m0 - NCTX; seq = 32 + rr / 4608; t0 = rr % 4608; }
#pragma unroll
    for (int j = 0; j < 2; ++j) {
      const int col = n0 + wn * 64 + j * 32 + r;
      if (n0 < 512) {
#pragma unroll
        for (int i = 0; i < 2; ++i) {
          bf16_t* kp = KN + (size_t)(m0 + wm * 64 + i * 32) * 512;
          const int lo = 4 * hh * 512 + col;
#pragma unroll
          for (int e = 0; e < 16; ++e) (kp + crowu(e) * 512)[lo] = f2bf(acc[i][j][e]);
        }
      } else {
        const int Tk = seq_tk(seq);
        bf16_t* vt = VBT + (size_t)512 * keyrow0(seq) + (size_t)(col - 512) * Tk;
#pragma unroll
        for (int i = 0; i < 2; ++i) {
          const int tt = t0 + wm * 64 + i * 32;
#pragma unroll
          for (int g2 = 0; g2 < 2; ++g2) {
            float v[8];
#pragma unroll
            for (int e = 0; e < 8; ++e) v[e] = acc[i][j][g2 * 8 + e];
            *(u32x4*)(vt + tt + 16 * g2 + 8 * hh) = pack8(v);
          }
        }
      }
    }
  }
}

template <int DQK>
DI void attn_item(const bf16_t* Qw, int q_ld, const bf16_t* K1, int k1_ld, const bf16_t* K2, int k2_ld,
                  const bf16_t* Vt, int vt_ld, int nkeys, bf16_t* Ow, int o_ld, char* smem) {
  constexpr int KS = DQK * 2 + 16;
  constexpr int KBYTES = 64 * KS;
  constexpr int VS = 144;
  constexpr int VBYTES = 64 * VS;
  constexpr int STAGE = KBYTES + VBYTES;
  constexpr int CPR = DQK / 8;
  constexpr int NKC = 64 * CPR / 256;
  constexpr int NS = DQK / 16;
  const int tid = otid(), lane = tid & 63, r = lane & 31, hh = lane >> 5;
  bf16x8 qf[NS];
#pragma unroll
  for (int s = 0; s < NS; ++s) qf[s] = *(const bf16x8*)(Qw + (size_t)r * q_ld + 16 * s + 8 * hh);
  f32x16 o[2];
#pragma unroll
  for (int n = 0; n < 2; ++n)
#pragma unroll
    for (int e = 0; e < 16; ++e) o[n][e] = 0.f;
  float m_run = 0.f, lsum = 0.f;
  u32x4 rk0[NKC], rv0[2], rk1[NKC], rv1[2];
  int krow_[NKC], kc_[NKC];
#pragma unroll
  for (int q = 0; q < NKC; ++q) { const int id = q * 256 + tid; krow_[q] = id / CPR; kc_[q] = id % CPR; }
  const int vrow = tid >> 3, vc = tid & 7;
  auto gload = [&](int key0, u32x4 (&rk)[NKC], u32x4 (&rv)[2]) {
#pragma unroll
    for (int q = 0; q < NKC; ++q) {
      const bf16_t* src = (DQK == 64 || kc_[q] < 8) ? K1 + (size_t)(key0 + krow_[q]) * k1_ld + kc_[q] * 8 : K2 + (size_t)(key0 + krow_[q]) * k2_ld + (kc_[q] - 8) * 8;
      rk[q] = *(const u32x4*)src;
    }
#pragma unroll
    for (int q = 0; q < 2; ++q) rv[q] = *(const u32x4*)(Vt + (size_t)(vrow + 32 * q) * vt_ld + key0 + vc * 8);
  };
  auto lstore = [&](int buf, u32x4 (&rk)[NKC], u32x4 (&rv)[2]) {
    char* base = smem + buf * STAGE;
#pragma unroll
    for (int q = 0; q < NKC; ++q) *(u32x4*)(base + krow_[q] * KS + kc_[q] * 16) = rk[q];
#pragma unroll
    for (int q = 0; q < 2; ++q) *(u32x4*)(base + KBYTES + (vrow + 32 * q) * VS + vc * 16) = rv[q];
  };
  const int ntl = nkeys >> 6;
  gload(0, rk0, rv0); lstore(0, rk0, rv0);
  gload(64, rk1, rv1);
  if (ntl > 2) gload(128, rk0, rv0);
  __syncthreads();
  auto tile_body = [&](int tl, u32x4 (&rkn)[NKC], u32x4 (&rvn)[2]) {
    const char* base = smem + (tl & 1) * STAGE;
    bf16x8 kf[2][NS], vf[2][2][2];
#pragma unroll
    for (int kb = 0; kb < 2; ++kb)
#pragma unroll
      for (int ks = 0; ks < NS; ++ks) kf[kb][ks] = *(const bf16x8*)(base + (kb * 32 + r) * KS + (2 * ks + hh) * 16);
    __builtin_amdgcn_sched_barrier(0);
    f32x16 s[2];
    const float ninit = -m_run;
#pragma unroll
    for (int kb = 0; kb < 2; ++kb)
#pragma unroll
      for (int e = 0; e < 16; ++e) s[kb][e] = ninit;
#pragma unroll
    for (int ks = 0; ks < NS; ++ks)
#pragma unroll
      for (int kb = 0; kb < 2; ++kb) s[kb] = MFMA32(kf[kb][ks], qf[ks], s[kb]);
#pragma unroll
    for (int kb = 0; kb < 2; ++kb)
#pragma unroll
      for (int s2 = 0; s2 < 2; ++s2)
#pragma unroll
        for (int n = 0; n < 2; ++n) vf[kb][s2][n] = *(const bf16x8*)(base + KBYTES + (32 * n + r) * VS + (kb * 32 + 16 * s2 + 8 * hh) * 2);
    __builtin_amdgcn_sched_barrier(0);
    float mx = s[0][0];
#pragma unroll
    for (int kb = 0; kb < 2; ++kb)
#pragma unroll
      for (int e = 0; e < 16; ++e) mx = fmaxf(mx, s[kb][e]);
    { const unsigned u = __float_as_uint(mx); auto sw = __builtin_amdgcn_permlane32_swap(u, u, false, false); mx = fmaxf(__uint_as_float(sw[0]), __uint_as_float(sw[1])); }
    const bool move = (mx > 4.0f) || (mx < -20.0f);
    if (__builtin_amdgcn_ballot_w64(move) != 0ull) {
      const float dlt = move ? mx : 0.f;
      const float alpha = __builtin_amdgcn_exp2f(-dlt);
      m_run += dlt;
      lsum *= alpha;
#pragma unroll
      for (int kb = 0; kb < 2; ++kb)
#pragma unroll
        for (int e = 0; e < 16; ++e) s[kb][e] -= dlt;
#pragma unroll
      for (int n = 0; n < 2; ++n)
#pragma unroll
        for (int e = 0; e < 16; ++e) o[n][e] *= alpha;
    }
    float ps = 0.f;
#pragma unroll
    for (int kb = 0; kb < 2; ++kb)
#pragma unroll
      for (int e = 0; e < 16; ++e) { const float pe = __builtin_amdgcn_exp2f(s[kb][e]); s[kb][e] = pe; ps += pe; }
    lsum += ps;
#pragma unroll
    for (int kb = 0; kb < 2; ++kb)
#pragma unroll
      for (int s2 = 0; s2 < 2; ++s2) {
        u32x4 pw;
        pw.x = pack2(s[kb][8 * s2 + 0], s[kb][8 * s2 + 1]); pw.y = pack2(s[kb][8 * s2 + 2], s[kb][8 * s2 + 3]);
        pw.z = pack2(s[kb][8 * s2 + 4], s[kb][8 * s2 + 5]); pw.w = pack2(s[kb][8 * s2 + 6], s[kb][8 * s2 + 7]);
        const bf16x8 pf = __builtin_bit_cast(bf16x8, pw);
#pragma unroll
        for (int n = 0; n < 2; ++n) o[n] = MFMA32(vf[kb][s2][n], pf, o[n]);
      }
    if (tl + 1 < ntl) { lstore((tl + 1) & 1, rkn, rvn); if (tl + 3 < ntl) gload((tl + 3) * 64, rkn, rvn); }
    __syncthreads();
  };
  for (int tl = 0; tl < ntl; tl += 2) { tile_body(tl, rk1, rv1); tile_body(tl + 1, rk0, rv0); }
  lsum = xsum32(lsum);
  const float inv = 1.0f / lsum;
#pragma unroll
  for (int n = 0; n < 2; ++n)
#pragma unroll
    for (int g = 0; g < 4; ++g) {
      u32x2 w; w.x = pack2(o[n][4 * g] * inv, o[n][4 * g + 1] * inv); w.y = pack2(o[n][4 * g + 2] * inv, o[n][4 * g + 3] * inv);
      *(u32x2*)(Ow + (size_t)r * o_ld + 32 * n + 8 * g + 4 * hh) = w;
    }
}

DI void scan_item(const Params& p, int l, int seq, int hd, int dir, int rs, char* smem) {
  const int tid = otid(), lane = tid & 63, wv = __builtin_amdgcn_readfirstlane(tid >> 6);
  const int j8 = lane & 7, r = lane & 31, hh = lane >> 5;
  const bool lat = seq >= 32;
  const int T = lat ? 4096 : 256;
  const int row0 = lat ? NCTX + (seq - 32) * 4096 : seq * 256;
  float* vA = (float*)smem; float* vK = vA + 2048; float* vR = vK + 2048; float* vV = vR + 2048; float* vW = vV + 2048; float* vB = vW + 2048; float* ybuf = vB + 2048;
  char* raw = smem + 32768;
  char* wdx = smem + 57344; char* adx = smem + 61952;
  float* tmpb = (float*)(smem + 66816);
  const bf16_t* U = (const bf16_t*)(p.ws + OFF_U);
  bf16_t* Y = (bf16_t*)(p.ws + OFF_R2) + (dir ? (size_t)NT * 512 : 0);
  float* bonus = (float*)(p.ws + OFF_BONUS);
  const int lrow = 8 * wv + (lane >> 3), irow = rs * 32 + lrow;
  f32x2 S[4];
  if (lat) {
    const float* s0 = (dir ? opq(p.in[I_SB]) : opq(p.in[I_SF])) + ((size_t)((seq - 32) * 4 + l) * 8 + hd) * 4096 + irow * 64 + j8 * 8;
#pragma unroll
    for (int q = 0; q < 2; ++q) { const f32x4 v = *(const f32x4*)(s0 + 4 * q); S[2 * q] = (f32x2){v.x, v.y}; S[2 * q + 1] = (f32x2){v.z, v.w}; }
  } else {
#pragma unroll
    for (int q = 0; q < 4; ++q) S[q] = (f32x2){0.f, 0.f};
  }
  const int mat = wv >> 1, ntc = wv & 1, cch = ntc * 32 + r, hc = hd * 64 + cch;
  bf16x8 bfrag[4];
  {
    const float* W = (mat ? opq(p.in[I_AUP]) : opq(p.in[I_WUP])) + (size_t)(l * 2 + dir) * 64 * 512 + hc;
#pragma unroll
    for (int s4 = 0; s4 < 4; ++s4) {
      float w8[8];
#pragma unroll
      for (int j = 0; j < 8; ++j) w8[j] = W[(size_t)(16 * s4 + 8 * hh + j) * 512];
      bfrag[s4] = __builtin_bit_cast(bf16x8, pack8(w8));
    }
  }
  const float bias = (mat ? opq(p.in[I_A0]) : opq(p.in[I_W0]))[(l * 2 + dir) * 512 + hc];
  const float kav = p.in[I_KA][l * 512 + hc], rkv = p.in[I_RK][l * 512 + hc];
  float* muP = (float*)(smem + 75008); float* muN = muP + 320; float* kkL = muN + 320;
  {
    const float* mup = p.in[I_MUP] + l * 1792; const float* mun = p.in[I_MUN] + l * 1792;
    for (int e = tid; e < 320; e += 256) { const int g = e >> 6, c = e & 63; const int col = (g < 3 ? g * 512 + hd * 64 : (g == 3 ? 1536 + dir * 64 : 1664 + dir * 64)) + c; muP[e] = mup[col]; muN[e] = mun[col]; }
    if (tid < 64) kkL[tid] = p.in[I_KK][l * 512 + hd * 64 + tid];
  }
  const int nch = T >> 5;
  u32x4 pre[6];
  auto prefetch = [&](int t0) {
#pragma unroll
    for (int q = 0; q < 6; ++q) {
      const int id = q * 256 + tid;
      const int row = id / 40, cc = id - row * 40, g = cc >> 3, c8 = cc & 7;
      const int t = t0 - 1 + row;
      const int col = (g < 3 ? g * 512 + hd * 64 : (g == 3 ? 1536 + dir * 64 : 1664 + dir * 64)) + c8 * 8;
      u32x4 v = (u32x4){0u, 0u, 0u, 0u};
      if (id < 1360 && t >= 0 && t < T) v = *(const u32x4*)(U + (size_t)(row0 + t) * ULD + 1696 + col);
      pre[q] = v;
    }
  };
  prefetch((dir ? nch - 1 : 0) * 32);
  for (int ci = 0; ci < nch; ++ci) {
    const int t0 = (dir ? nch - 1 - ci : ci) * 32;
#pragma unroll
    for (int q = 0; q < 6; ++q) { const int id = q * 256 + tid; if (id < 1360) *(u32x4*)(raw + id * 16) = pre[q]; }
    __syncthreads();
    if (ci + 1 < nch) prefetch((dir ? nch - 2 - ci : ci + 1) * 32);
    {
      const int tt = tid >> 3, sub = tid & 7;
#pragma unroll 1
      for (int g = 0; g < 5; ++g) {
        const int col = (g < 3 ? g * 512 + hd * 64 : (g == 3 ? 1536 + dir * 64 : 1664 + dir * 64)) + sub * 8;
        float c[8], pv[8], nx[8], x[8];
        unpack8(*(const u32x4*)(raw + (tt + 1) * 640 + (g * 8 + sub) * 16), c);
        unpack8(*(const u32x4*)(raw + tt * 640 + (g * 8 + sub) * 16), pv);
        unpack8(*(const u32x4*)(raw + (tt + 2) * 640 + (g * 8 + sub) * 16), nx);
        const f32x4 mp0 = *(const f32x4*)(muP + g * 64 + sub * 8), mp1 = *(const f32x4*)(muP + g * 64 + sub * 8 + 4), mn0 = *(const f32x4*)(muN + g * 64 + sub * 8), mn1 = *(const f32x4*)(muN + g * 64 + sub * 8 + 4);
        const float mp[8] = {mp0.x, mp0.y, mp0.z, mp0.w, mp1.x, mp1.y, mp1.z, mp1.w}, mn[8] = {mn0.x, mn0.y, mn0.z, mn0.w, mn1.x, mn1.y, mn1.z, mn1.w};
#pragma unroll
        for (int i = 0; i < 8; ++i) x[i] = c[i] + mp[i] * (pv[i] - c[i]) + mn[i] * (nx[i] - c[i]);
        const int lo = tt * 64 + sub * 8;
        if (g == 0) { *(f32x4*)(vR + lo) = (f32x4){x[0], x[1], x[2], x[3]}; *(f32x4*)(vR + lo + 4) = (f32x4){x[4], x[5], x[6], x[7]}; }
        else if (g == 1) {
          float kk[8], ss = 0.f;
          const float* kkw = kkL + sub * 8;
#pragma unroll
          for (int i = 0; i < 8; ++i) { kk[i] = x[i] * kkw[i]; ss += kk[i] * kk[i]; }
          *(f32x4*)(vK + lo) = (f32x4){x[0], x[1], x[2], x[3]}; *(f32x4*)(vK + lo + 4) = (f32x4){x[4], x[5], x[6], x[7]};
          ss += shx<1>(ss); ss += shx<2>(ss); ss += shx<4>(ss);
          const float inv = 1.0f / fmaxf(sqrtf(ss), 1e-12f);
          *(f32x4*)(vA + lo) = (f32x4){kk[0] * inv, kk[1] * inv, kk[2] * inv, kk[3] * inv}; *(f32x4*)(vA + lo + 4) = (f32x4){kk[4] * inv, kk[5] * inv, kk[6] * inv, kk[7] * inv};
        }
        else if (g == 2) { *(f32x4*)(vV + lo) = (f32x4){x[0], x[1], x[2], x[3]}; *(f32x4*)(vV + lo + 4) = (f32x4){x[4], x[5], x[6], x[7]}; }
        else if (g == 3) { float th[8]; for (int i = 0; i < 8; ++i) th[i] = 1.0f - 2.0f * __builtin_amdgcn_rcpf(1.0f + __expf(2.0f * x[i])); *(u32x4*)(wdx + tt * 144 + sub * 16) = pack8(th); }
        else { *(u32x4*)(adx + tt * 144 + sub * 16) = pack8(x); }
      }
    }
    __syncthreads();
    {
      f32x16 acc;
#pragma unroll
      for (int e = 0; e < 16; ++e) acc[e] = 0.f;
      const char* xb = mat ? adx : wdx;
#pragma unroll
      for (int s4 = 0; s4 < 4; ++s4) { const bf16x8 af = *(const bf16x8*)(xb + r * 144 + (16 * s4 + 8 * hh) * 2); acc = MFMA32(af, bfrag[s4], acc); }
      if (mat == 0) {
#pragma unroll
        for (int e = 0; e < 16; ++e) vW[crow(e, hh) * 64 + cch] = __expf(-0.6065306597126334f * sigmoidf_(bias + acc[e]));
      } else {
#pragma unroll
        for (int e = 0; e < 16; ++e) {
          const int ix = crow(e, hh) * 64 + cch;
          const float ag = sigmoidf_(bias + acc[e]);
          const float kk = vA[ix], k = vK[ix], rr = vR[ix];
          const float kd = k * (1.0f + (ag - 1.0f) * kav);
          vK[ix] = kd; vA[ix] = -kk; vB[ix] = kk * ag; tmpb[ix] = rr * kd * rkv;
        }
      }
    }
    __syncthreads();
    {
      const int tt = tid >> 3, sub = tid & 7;
      const f32x4 b0 = *(const f32x4*)(tmpb + tt * 64 + sub * 8), b1 = *(const f32x4*)(tmpb + tt * 64 + sub * 8 + 4);
      float bs = (b0.x + b0.y) + (b0.z + b0.w) + (b1.x + b1.y) + (b1.z + b1.w);
      bs += shx<1>(bs); bs += shx<2>(bs); bs += shx<4>(bs);
      if (sub == 0 && rs == 0) bonus[((size_t)(row0 + t0 + tt) * 8 + hd) * 2 + dir] = bs;
    }
    {
      f32x4 va[2], vw[2], vb[2], vk[2], vr[2]; float vi;
      int tt = dir ? 31 : 0;
      int vo = tt * 64 + j8 * 8;
#pragma unroll
      for (int q = 0; q < 2; ++q) { va[q] = *(const f32x4*)(vA + vo + 4 * q); vw[q] = *(const f32x4*)(vW + vo + 4 * q); vb[q] = *(const f32x4*)(vB + vo + 4 * q); vk[q] = *(const f32x4*)(vK + vo + 4 * q); vr[q] = *(const f32x4*)(vR + vo + 4 * q); }
      vi = vV[tt * 64 + irow];
      for (int si = 0; si < 32; ++si) {
        const int ttn = dir ? (si < 31 ? 30 - si : 0) : (si < 31 ? si + 1 : 31);
        const int von = ttn * 64 + j8 * 8;
        f32x2 pa2 = S[0] * (f32x2){va[0].x, va[0].y}, pa3 = S[1] * (f32x2){va[0].z, va[0].w};
        pa2 += S[2] * (f32x2){va[1].x, va[1].y}; pa3 += S[3] * (f32x2){va[1].z, va[1].w};
#pragma unroll
        for (int q = 0; q < 2; ++q) va[q] = *(const f32x4*)(vA + von + 4 * q);
        pa2 += pa3;
        const float sa = osum(pa2.x + pa2.y);
        const f32x2 sa2 = (f32x2){sa, sa}, vi2 = (f32x2){vi, vi};
        f32x2 py2, py3;
        S[0] = S[0] * (f32x2){vw[0].x, vw[0].y} + (sa2 * (f32x2){vb[0].x, vb[0].y} + vi2 * (f32x2){vk[0].x, vk[0].y}); py2 = S[0] * (f32x2){vr[0].x, vr[0].y};
        S[1] = S[1] * (f32x2){vw[0].z, vw[0].w} + (sa2 * (f32x2){vb[0].z, vb[0].w} + vi2 * (f32x2){vk[0].z, vk[0].w}); py3 = S[1] * (f32x2){vr[0].z, vr[0].w};
        S[2] = S[2] * (f32x2){vw[1].x, vw[1].y} + (sa2 * (f32x2){vb[1].x, vb[1].y} + vi2 * (f32x2){vk[1].x, vk[1].y}); py2 += S[2] * (f32x2){vr[1].x, vr[1].y};
        S[3] = S[3] * (f32x2){vw[1].z, vw[1].w} + (sa2 * (f32x2){vb[1].z, vb[1].w} + vi2 * (f32x2){vk[1].z, vk[1].w}); py3 += S[3] * (f32x2){vr[1].z, vr[1].w};
#pragma unroll
        for (int q = 0; q < 2; ++q) { vw[q] = *(const f32x4*)(vW + von + 4 * q); vb[q] = *(const f32x4*)(vB + von + 4 * q); vk[q] = *(const f32x4*)(vK + von + 4 * q); vr[q] = *(const f32x4*)(vR + von + 4 * q); }
        vi = vV[ttn * 64 + irow];
        py2 += py3;
        const float py = osum(py2.x + py2.y);
        ybuf[tt * 32 + lrow] = py;
        tt = ttn;
      }
    }
    __syncthreads();
    {
      const int tt = tid >> 3, sub = tid & 7;
      const f32x4 y0 = *(const f32x4*)(ybuf + tt * 32 + sub * 4);
      u32x2 w; w.x = pack2(y0.x, y0.y); w.y = pack2(y0.z, y0.w);
      *(u32x2*)(Y + (size_t)(row0 + t0 + tt) * 512 + hd * 64 + rs * 32 + sub * 4) = w;
    }
    __syncthreads();
  }
  if (!lat) {
    float* o = opq(p.out) + (dir ? OUT_SB : OUT_SF) + ((size_t)(seq * 4 + l) * 8 + hd) * 4096 + irow * 64 + j8 * 8;
#pragma unroll
    for (int q = 0; q < 2; ++q) *(f32x4*)(o + 4 * q) = (f32x4){S[2 * q].x, S[2 * q].y, S[2 * q + 1].x, S[2 * q + 1].y};
  }
}

DI void phase_mixers(const Params& p, int l, char* smem, int part = 0) {
  const int tid = otid(), wid = __builtin_amdgcn_readfirstlane(tid >> 6);
  unsigned* cnt = (unsigned*)(p.ws + OFF_CNT) + l * 8;
  int* slot = (int*)(smem + SMEM_BYTES - 16);
  bf16_t* U = (bf16_t*)(p.ws + OFF_U);
  const bf16_t* KA = (const bf16_t*)(p.ws + OFF_KA); const bf16_t* VAT = (const bf16_t*)(p.ws + OFF_VAT);
  const bf16_t* KN = (const bf16_t*)(p.ws + OFF_KN); const bf16_t* VBT = (const bf16_t*)(p.ws + OFF_VBT); const bf16_t* KRB = (const bf16_t*)(p.ws + OFF_KRB);
  const int QLEN = 256 + 256 + 128 + 64 + 64;
  bool first = true;
  int xq = blockIdx.x & 7, tries = 0;
  for (;;) {
    int kind, seq, a, qt;
    if (first && blockIdx.x < 256) {
      const int item = blockIdx.x; kind = 0; seq = 32 + (item >> 5); a = (item >> 2) & 7; qt = item & 3;
      first = false;
    } else {
      first = false;
      if (tid == 0) *slot = (int)atomicAdd(cnt + xq, 1u);
      __syncthreads();
      const int i = __builtin_amdgcn_readfirstlane(*slot);
      __syncthreads();
      if (i >= QLEN) { if (++tries >= 8) break; xq = (xq + 1) & 7; continue; }
      if (i < 256) { const int g = xq + 8 * (i >> 7); kind = 1; seq = 32 + (g >> 1); a = g & 1; qt = i & 127; }
      else if (i < 512) { const int j = i - 256; const int g = xq + 8 * (j >> 5); kind = 2; seq = 32 + (g >> 3); a = g & 7; qt = j & 31; }
      else if (i < 640) { const int j = i - 512; kind = 0; seq = xq + 8 * (j >> 5); a = (j >> 2) & 7; qt = j & 3; }
      else if (i < 704) { const int j = i - 640; kind = 1; seq = xq + 8 * (j >> 4); a = (j >> 3) & 1; qt = j & 7; }
      else { const int j = i - 704; kind = 2; seq = xq + 8 * (j >> 4); a = (j >> 1) & 7; qt = j & 1; }
    }
    const int kr0 = keyrow0(seq), Tk = seq_tk(seq);
    const int row0 = seq < 32 ? seq * 256 : NCTX + (seq - 32) * 4096;
    if (kind == 0) scan_item(p, l, seq, a, qt & 1, qt >> 1, smem);
    else if (kind == 1) {
      const int qh = a * 4 + wid;
      bf16_t* q = U + (size_t)(row0 + qt * 32) * ULD + qh * 64;
      attn_item<64>(q, ULD, KA + (size_t)kr0 * 128 + a * 64, 128, nullptr, 0, VAT + (size_t)128 * kr0 + (size_t)(a * 64) * Tk, Tk, Tk, q, ULD, smem);
    } else {
      bf16_t* q = U + (size_t)(row0 + qt * 128 + wid * 32) * ULD + 768 + a * 96;
      attn_item<96>(q, ULD, KN + (size_t)kr0 * 512 + a * 64, 512, KRB + (size_t)kr0 * 32, 32, VBT + (size_t)512 * kr0 + (size_t)(a * 64) * Tk, Tk, Tk, q, ULD, smem);
    }
  }
}

struct CpostIn { u32x4 yf, yb, c, pv, nx; f32x2 bs; };
DI void cpost_load(const Params& p, int row, int lane, CpostIn& in) {
  int seq, t; row_decode(row, seq, t);
  const int T = seq < 32 ? 256 : 4096;
  const bf16_t* YF = (const bf16_t*)(p.ws + OFF_R2); const bf16_t* YB = YF + (size_t)NT * 512;
  const bf16_t* u = (const bf16_t*)(p.ws + OFF_U) + (size_t)row * ULD + 1696;
  const float* bonus = (const float*)(p.ws + OFF_BONUS);
  const int col = 1024 + lane * 8;
  const u32x4 z4 = (u32x4){0u, 0u, 0u, 0u};
  in.yf = *(const u32x4*)(YF + (size_t)row * 512 + lane * 8);
  in.yb = *(const u32x4*)(YB + (size_t)row * 512 + lane * 8);
  in.c = *(const u32x4*)(u + col);
  in.pv = t > 0 ? *(const u32x4*)(u - ULD + col) : z4;
  in.nx = t < T - 1 ? *(const u32x4*)(u + ULD + col) : z4;
  in.bs = *(const f32x2*)(bonus + ((size_t)row * 8 + (lane >> 3)) * 2);
}
DI void cpost_finish(const Params& p, int l, int row, int lane, const CpostIn& in) {
  bf16_t* u = (bf16_t*)(p.ws + OFF_U) + (size_t)row * ULD + 1696;
  float yf[8], yb[8], y[8];
  unpack8(in.yf, yf); unpack8(in.yb, yb);
  float s = 0.f;
#pragma unroll
  for (int i = 0; i < 8; ++i) { y[i] = yf[i] + yb[i]; s += y[i]; }
  s += shx<1>(s); s += shx<2>(s); s += shx<4>(s);
  const float mu = s * (1.0f / 64.0f);
  float q = 0.f;
#pragma unroll
  for (int i = 0; i < 8; ++i) { y[i] -= mu; q += y[i] * y[i]; }
  q += shx<1>(q); q += shx<2>(q); q += shx<4>(q);
  const float rs = rsqrtf(q * (1.0f / 64.0f) + 64e-5f);
  const int col = 1024 + lane * 8;
  float c[8], pv[8], nx[8];
  unpack8(in.c, c); unpack8(in.pv, pv); unpack8(in.nx, nx);
  const float* mup = p.in[I_MUP] + l * 1792 + col; const float* mun = p.in[I_MUN] + l * 1792 + col;
  const float* lw = p.in[I_LNW] + l * 512 + lane * 8; const float* lb = p.in[I_LNB] + l * 512 + lane * 8;
  const float bs = in.bs.x + in.bs.y;
  float o[8];
#pragma unroll
  for (int i = 0; i < 8; ++i) { const float v = c[i] + mup[i] * (pv[i] - c[i]) + mun[i] * (nx[i] - c[i]); o[i] = y[i] * rs * lw[i] + lb[i] + bs * v; }
  *(u32x4*)(u + lane * 8) = pack8(o);
}
DI void phase_renorm_cpost(const Params& p, int l) {
  const int lane = otid() & 63, wid = __builtin_amdgcn_readfirstlane(otid() >> 6);
  for (int item = blockIdx.x; item < NT / 8; item += gridDim.x) { const int ra = item * 8 + wid, rb = ra + 4; CpostIn ia, ib; cpost_load(p, ra, lane, ia); cpost_load(p, rb, lane, ib); norm_rows2(p, l, ra, rb, lane); cpost_finish(p, l, ra, lane, ia); cpost_finish(p, l, rb, lane, ib); }
}

DI void phase_zgemm(const Params& p, char* smem) {
  const bf16_t* H = (const bf16_t*)(p.ws + OFF_R1);
  const bf16_t* W = (const bf16_t*)(p.ws + OFF_WIN) + (size_t)3584 * 1024;
  bf16_t* U = (bf16_t*)(p.ws + OFF_U);
  const int ntiles = 320 * 12;
  for (int it = 0;; ++it) {
    int mt, nt; if (!next_tile(it, 12, 6, mt, nt)) break;
    const int m0 = mt * 128, n0 = nt * 128;
    f32x16 acc[2][2]; zero_acc<2>(acc);
    gemm_mainloop<2>(acc, H + (size_t)m0 * 1024, 1024, 64, W + (size_t)n0 * 1024, 1024, 1024, smem);
    const int lane = otid() & 63, wid = __builtin_amdgcn_readfirstlane(otid() >> 6), wm = wid >> 1, wn = wid & 1, r = lane & 31, hh = lane >> 5;
#pragma unroll
    for (int j = 0; j < 2; ++j) {
      const int col = n0 + wn * 64 + j * 32 + r;
      const int br = col >> 9, cc = col & 511;
      const int ucol = br == 0 ? cc : (br == 1 ? 768 + (cc >> 6) * 96 + (cc & 63) : 1696 + cc);
#pragma unroll
      for (int i = 0; i < 2; ++i) {
        bf16_t* up = U + (size_t)(m0 + wm * 64 + i * 32) * ULD;
        const int lo = 4 * hh * ULD + ucol;
        bf16_t yv[16];
#pragma unroll
        for (int e = 0; e < 16; ++e) yv[e] = (up + crowu(e) * ULD)[lo];
#pragma unroll
        for (int e = 0; e < 16; ++e) (up + crowu(e) * ULD)[lo] = f2bf(bf2f(yv[e]) * siluf_(acc[i][j][e]));
      }
    }
  }
}

DI void phase_merge(const Params& p, char* smem) {
  const bf16_t* H = (const bf16_t*)(p.ws + OFF_R1);
  const bf16_t* WG = (const bf16_t*)(p.ws + OFF_WIN) + (size_t)5120 * 1024;
  const bf16_t* WO = (const bf16_t*)(p.ws + OFF_WO);
  const bf16_t* U = (const bf16_t*)(p.ws + OFF_U);
  bf16_t* MX = (bf16_t*)(p.ws + OFF_R2);
  const int ntiles = 320 * 8;
  for (int it = 0;; ++it) {
    int mt, nt; if (!next_tile(it, 8, 8, mt, nt)) break;
    const int m0 = mt * 128, n0 = nt * 128;
    f32x16 mix[2][2]; zero_acc<2>(mix);
    unsigned gs[2][2][8];
#pragma unroll 1
    for (int step = 0; step < 6; ++step) {
      const int br = step >> 1, isT = step & 1;
      const int acol = br == 0 ? 0 : (br == 1 ? 768 : 1696);
      const bf16_t* Ap = isT ? U + (size_t)m0 * ULD + acol : H + (size_t)m0 * 1024;
      const bf16_t* Bp = isT ? WO + (size_t)(br * 1024 + n0) * 512 : WG + (size_t)(br * 1024 + n0) * 1024;
      f32x16 cur[2][2]; zero_acc<2>(cur);
      gemm_mainloop<2>(cur, Ap, isT ? ULD : 1024, (isT && br == 1) ? 96 : 64, Bp, isT ? 512 : 1024, isT ? 512 : 1024, smem);
      if (isT) {
#pragma unroll
        for (int i = 0; i < 2; ++i)
#pragma unroll
          for (int j = 0; j < 2; ++j)
#pragma unroll
            for (int e = 0; e < 8; ++e) { mix[i][j][2 * e] += lo16(gs[i][j][e]) * cur[i][j][2 * e]; mix[i][j][2 * e + 1] += hi16(gs[i][j][e]) * cur[i][j][2 * e + 1]; }
      } else {
#pragma unroll
        for (int i = 0; i < 2; ++i)
#pragma unroll
          for (int j = 0; j < 2; ++j)
#pragma unroll
            for (int e = 0; e < 8; ++e) gs[i][j][e] = pack2(sigmoidf_(cur[i][j][2 * e]), sigmoidf_(cur[i][j][2 * e + 1]));
      }
    }
    const int lane = otid() & 63, wid = __builtin_amdgcn_readfirstlane(otid() >> 6), wm = wid >> 1, wn = wid & 1, r = lane & 31, hh = lane >> 5;
#pragma unroll
    for (int j = 0; j < 2; ++j) {
      const int col = n0 + wn * 64 + j * 32 + r;
#pragma unroll
      for (int i = 0; i < 2; ++i) {
        bf16_t* mp = MX + (size_t)(m0 + wm * 64 + i * 32) * 1024;
        const int lo = 4 * hh * 1024 + col;
#pragma unroll
        for (int e = 0; e < 16; ++e) (mp + crowu(e) * 1024)[lo] = f2bf(mix[i][j][e]);
      }
    }
  }
}

DI void phase_out(const Params& p, int l, char* smem) {
  const bf16_t* MX = (const bf16_t*)(p.ws + OFF_R2);
  const bf16_t* W = (const bf16_t*)(p.ws + OFF_WOUT);
  const int ntiles = 320 * 8;
  for (int it = 0;; ++it) {
    int mt, nt; if (!next_tile(it, 8, 8, mt, nt)) break;
    const int m0 = mt * 128, n0 = nt * 128;
    f32x16 acc[2][2]; zero_acc<2>(acc);
    gemm_mainloop<2>(acc, MX + (size_t)m0 * 1024, 1024, 64, W + (size_t)n0 * 1024, 1024, 1024, smem);
    const int lane = otid() & 63, wid = __builtin_amdgcn_readfirstlane(otid() >> 6), wm = wid >> 1, wn = wid & 1, r = lane & 31, hh = lane >> 5;
    const int jm = m0 < NCTX ? 0 : 1 + ((m0 - NCTX) >> 12);
    const float* gate = (const float*)(p.ws + OFF_MOD) + ((size_t)l * 9 + jm) * MODLD + 2048;
    const float* xsrc = x_row_ptr(p, l, m0);
#pragma unroll
    for (int j = 0; j < 2; ++j) {
      const int col = n0 + wn * 64 + j * 32 + r;
      const float gv = gate[col];
      const int lo = 4 * hh * 1024 + col;
#pragma unroll
      for (int i = 0; i < 2; ++i) {
        const float* xs = xsrc + (size_t)(wm * 64 + i * 32) * 1024;
        float* xo = p.out + (size_t)(m0 + wm * 64 + i * 32) * 1024;
        float xv[16];
#pragma unroll
        for (int e = 0; e < 16; ++e) xv[e] = (xs + crowu(e) * 1024)[lo];
#pragma unroll
        for (int e = 0; e < 16; ++e) (xo + crowu(e) * 1024)[lo] = xv[e] + gv * acc[i][j][e];
      }
    }
  }
}

DI void phase_final(const Params& p) {
  const int lane = otid() & 63, wid = __builtin_amdgcn_readfirstlane(otid() >> 6);
  const float* nw = p.in[I_FNW];
  for (int item = blockIdx.x; item < NT / 4; item += gridDim.x) {
    float* x = p.out + (size_t)(item * 4 + wid) * 1024;
    f32x4 v[4]; float ss = 0.f;
#pragma unroll
    for (int i = 0; i < 4; ++i) { v[i] = *(const f32x4*)(x + lane * 4 + 256 * i); ss += v[i].x * v[i].x + v[i].y * v[i].y + v[i].z * v[i].z + v[i].w * v[i].w; }
ss = wave_sum(ss);
    const float rs = rsqrtf(ss * (1.0f / 1024.0f) + 1e-6f);
#pragma unroll
    for (int i = 0; i < 4; ++i) { const f32x4 w = *(const f32x4*)(nw + lane * 4 + 256 * i); *(f32x4*)(x + lane * 4 + 256 * i) = (f32x4){v[i].x * rs * w.x, v[i].y * rs * w.y, v[i].z * rs * w.z, v[i].w * rs * w.w}; }
  }
}

DI void grid_barrier(unsigned* bar, unsigned& epoch) {
  epoch += 1u;
  __syncthreads();
  if (otid() == 0) {
    const unsigned grp = blockIdx.x & 7u, per = gridDim.x >> 3;
    __builtin_amdgcn_fence(__ATOMIC_RELEASE, "agent");
    const unsigned old = __hip_atomic_fetch_add(bar + grp * 32, 1u, __ATOMIC_RELAXED, __HIP_MEMORY_SCOPE_AGENT);
    if (old + 1u == epoch * per) __hip_atomic_fetch_add(bar + 8 * 32, 1u, __ATOMIC_RELAXED, __HIP_MEMORY_SCOPE_AGENT);
    while (__hip_atomic_load(bar + 8 * 32, __ATOMIC_RELAXED, __HIP_MEMORY_SCOPE_AGENT) < epoch * 8u) __builtin_amdgcn_s_sleep(1);
    __builtin_amdgcn_fence(__ATOMIC_ACQUIRE, "agent");
  }
  __syncthreads();
}

constexpr int NPHASES = 1 + 4 * 9 + 1;
__global__ void __launch_bounds__(256, 2) fwd_kernel(Params p0) {
  __shared__ __attribute__((aligned(16))) char smem[SMEM_BYTES];
  cg::grid_group grid = cg::this_grid();
  const int ph_begin = p0.ph_begin, ph_end = p0.ph_end;
  unsigned* bar = (unsigned*)(p0.ws + OFF_BAR);
  unsigned epoch = 0u;
  for (int ph = ph_begin; ph < ph_end; ++ph) {
    auto kp = __builtin_amdgcn_kernarg_segment_ptr();
    asm volatile("" : "+s"(kp));
    typedef const __attribute__((address_space(4))) Params CParams;
    CParams* kpp = (CParams*)kp;
    Params p;
#pragma unroll
    for (int i = 0; i < 35; ++i) p.in[i] = kpp->in[i];
    p.out = kpp->out; p.ws = kpp->ws; p.ph_begin = ph_begin; p.ph_end = ph_end;
    if (ph == 0) phase_prologue(p, smem);
    else if (ph == NPHASES - 1) phase_final(p);
    else {
      const int l = (ph - 1) / 9, sp = (ph - 1) % 9;
#ifdef PROBE_SP
      if (sp == PROBE_SP) {
        switch (sp) {
          case 0: phase_norm_convert(p, l, smem); break;
          case 1: phase_gemm1(p, l, smem); break;
          case 3: phase_upproj(p, smem); break;
          case 5: phase_renorm_cpost(p, l); break;
          case 7: phase_merge(p, smem); break;
          default: break;
        }
        grid.sync();
      }
#endif
      switch (sp) {
        case 0: phase_norm_convert(p, l, smem); break;
        case 1: phase_gemm1(p, l, smem); break;
        case 2: phase_post(p, l); break;
        case 3: phase_upproj(p, smem); break;
        case 4: phase_mixers(p, l, smem); break;
        case 5: phase_renorm_cpost(p, l); break;
        case 6: phase_zgemm(p, smem); break;
        case 7: phase_merge(p, smem); break;
        default: phase_out(p, l, smem); break;
      }
    }
    if (ph + 1 < ph_end) { if (ph == 0) grid.sync(); else grid_barrier(bar, epoch); }
  }
}

extern "C" void kernel_launch(void* const* d_in, const int* in_sizes, int n_in, void* d_out, int out_size, void* d_ws, size_t ws_size, hipStream_t stream) {
  if (ws_size < WS_NEED || n_in < 35) { fprintf(stderr, "workspace too small: %zu < %zu\n", ws_size, WS_NEED); return; }
  static int grid_blocks = 0;
  if (!grid_blocks) {
    int dev = 0, cus = 0, per_cu = 0;
    hipGetDevice(&dev);
    hipDeviceGetAttribute(&cus, hipDeviceAttributeMultiprocessorCount, dev);
    hipOccupancyMaxActiveBlocksPerMultiprocessor(&per_cu, fwd_kernel, 256, 0);
    if (per_cu < 1) per_cu = 1;
    if (per_cu > 2) per_cu = 2;
    grid_blocks = cus * per_cu;
  }
  Params p{};
  for (int i = 0; i < 35; ++i) p.in[i] = (const float*)d_in[i];
  p.out = (float*)d_out; p.ws = (char*)d_ws;
#ifndef ONE_LAUNCH
  for (int ph = 0; ph < NPHASES; ++ph) {
    p.ph_begin = ph; p.ph_end = ph + 1;
    hipLaunchKernelGGL(fwd_kernel, dim3(grid_blocks), dim3(256), 0, stream, p);
  }
#else
  p.ph_begin = 0; p.ph_end = NPHASES;
  hipMemsetAsync((char*)d_ws + OFF_BAR, 0, 4096, stream);
  void* args[] = {&p};
  hipError_t e = hipLaunchCooperativeKernel((void*)fwd_kernel, dim3(grid_blocks), dim3(256), args, 0, stream);
  if (e != hipSuccess) fprintf(stderr, "cooperative launch failed: %s (grid %d)\n", hipGetErrorString(e), grid_blocks);
#endif
}
```

```cpp
#define ONE_LAUNCH 1
#include <hip/hip_runtime.h>
#include <hip/hip_cooperative_groups.h>
#include <stdint.h>
#include <stdio.h>
namespace cg = cooperative_groups;

typedef unsigned short bf16_t;
typedef short bf16x8 __attribute__((ext_vector_type(8)));
typedef float f32x16 __attribute__((ext_vector_type(16)));
typedef float f32x4 __attribute__((ext_vector_type(4)));
typedef float f32x2 __attribute__((ext_vector_type(2)));
typedef unsigned u32x4 __attribute__((ext_vector_type(4)));
typedef unsigned u32x2 __attribute__((ext_vector_type(2)));
#define DI __device__ __forceinline__
#define MFMA32(a, b, c) __builtin_amdgcn_mfma_f32_32x32x16_bf16((a), (b), (c), 0, 0, 0)

constexpr int NT = 40960;
constexpr int NCTX = 8192;
constexpr int NK = 45056;
constexpr int ULD = 3488;
constexpr int MODLD = 3072;
constexpr int SMEM_BYTES = 78848;

constexpr size_t OFF_WIN = 0;
constexpr size_t OFF_WO = 16777216;
constexpr size_t OFF_WOUT = 19922944;
constexpr size_t OFF_WU = 22020096;
constexpr size_t OFF_MOD = 22282240;
constexpr size_t OFF_BONUS = 22724608;
constexpr size_t OFF_CS16 = 25346048;
constexpr size_t OFF_CS8 = 25354240;
constexpr size_t OFF_CNT = 25358336;
constexpr size_t OFF_BAR = 524742912;
constexpr size_t OFF_U = 25358592;
constexpr size_t OFF_R1 = 311095552;
constexpr size_t OFF_KA = OFF_R1;
constexpr size_t OFF_VAT = 513208576;
constexpr size_t OFF_KN = OFF_R1 + 23068672;
constexpr size_t OFF_VBT = OFF_R1 + 69206016;
constexpr size_t OFF_KRB = OFF_R1 + 115343360;
constexpr size_t OFF_R2 = 429322496;
constexpr size_t WS_NEED = 524742912 + 4096;

constexpr size_t OUT_AK = 41943040, OUT_AV = 46137344, OUT_CKV = 50331648, OUT_KR = 54525952, OUT_SF = 55574528, OUT_SB = 59768832;

struct Params {
  const float* in[35];
  float* out;
  char* ws;
  int ph_begin, ph_end;
};

enum { I_XP = 0, I_XS, I_CAK, I_CAV, I_CCKV, I_CKR, I_SF, I_SB, I_C, I_CCTX, I_NORMW, I_WMOD, I_BMOD, I_WIN, I_QNW, I_KNW, I_KVNW,
       I_WUK, I_WUV, I_MUP, I_MUN, I_W0, I_WUP, I_A0, I_AUP, I_KK, I_KA, I_RK, I_LNW, I_LNB, I_WOA, I_WOB, I_WOC, I_WOUT, I_FNW };

DI int threadIdx_x_raw() { return __builtin_amdgcn_workitem_id_x(); }
DI int otid() { int t = threadIdx_x_raw(); asm volatile("" : "+v"(t)); return t; }
DI const float* opq(const float* q) { asm volatile("" : "+s"(q)); return q; }
DI float* opq(float* q) { asm volatile("" : "+s"(q)); return q; }
DI float bf2f(bf16_t v) { return __uint_as_float(((unsigned)v) << 16); }
typedef __bf16 hbf16x2 __attribute__((ext_vector_type(2)));
DI unsigned pack2(float a, float b) { f32x2 v = {a, b}; hbf16x2 r = __builtin_convertvector(v, hbf16x2); return __builtin_bit_cast(unsigned, r); }
DI bf16_t f2bf(float x) { return (bf16_t)(pack2(x, 0.f) & 0xffffu); }
DI float xsum16(float x) { const unsigned u = __float_as_uint(x); auto r = __builtin_amdgcn_permlane16_swap(u, u, false, false); return __uint_as_float(r[0]) + __uint_as_float(r[1]); }
DI float xsum32(float x) { const unsigned u = __float_as_uint(x); auto r = __builtin_amdgcn_permlane32_swap(u, u, false, false); return __uint_as_float(r[0]) + __uint_as_float(r[1]); }
DI float lo16(unsigned w) { return __uint_as_float(w << 16); }
DI float hi16(unsigned w) { return __uint_as_float(w & 0xffff0000u); }
DI void unpack8(u32x4 w, float* v) { v[0] = lo16(w.x); v[1] = hi16(w.x); v[2] = lo16(w.y); v[3] = hi16(w.y); v[4] = lo16(w.z); v[5] = hi16(w.z); v[6] = lo16(w.w); v[7] = hi16(w.w); }
DI u32x4 pack8(const float* v) { u32x4 w; w.x = pack2(v[0], v[1]); w.y = pack2(v[2], v[3]); w.z = pack2(v[4], v[5]); w.w = pack2(v[6], v[7]); return w; }
template <int K> DI float shx(float v) { return __int_as_float(__builtin_amdgcn_ds_swizzle(__float_as_int(v), 0x1f | (K << 10))); }
DI float wave_sum(float v) { v += shx<1>(v); v += shx<2>(v); v += shx<4>(v); v += shx<8>(v); v += shx<16>(v); return xsum32(v); }
DI float qsum(float v) {
  v += __int_as_float(__builtin_amdgcn_update_dpp(0, __float_as_int(v), 0xB1, 0xf, 0xf, true));
  v += __int_as_float(__builtin_amdgcn_update_dpp(0, __float_as_int(v), 0x4E, 0xf, 0xf, true));
  return v;
}
DI float osum(float v) {
  v = qsum(v);
  v += __int_as_float(__builtin_amdgcn_update_dpp(0, __float_as_int(v), 0x141, 0xf, 0xf, true));
  return v;
}
DI int crow(int reg, int h) { return (reg & 3) + 8 * (reg >> 2) + 4 * h; }
DI int crowu(int reg) { return (reg & 3) + 8 * (reg >> 2); }
DI int perm16(int t) { return (t & ~12) | ((t & 4) << 1) | ((t & 8) >> 1); }
DI float sigmoidf_(float x) { return __builtin_amdgcn_rcpf(1.0f + __expf(-x)); }
DI float siluf_(float x) { return x * __builtin_amdgcn_rcpf(1.0f + __expf(-x)); }

DI void row_decode(int row, int& seq, int& t) {
  if (row < NCTX) { seq = row >> 8; t = row & 255; } else { seq = 32 + ((row - NCTX) >> 12); t = (row - NCTX) & 4095; }
}
DI int keyrow0(int seq) { return seq < 32 ? seq * 256 : NCTX + (seq - 32) * 4608; }
DI int seq_tk(int seq) { return seq < 32 ? 256 : 4608; }

typedef __attribute__((address_space(3))) unsigned lds_u32;
template <int NJ>
DI void gemm_mainloop(f32x16 (&acc)[2][NJ], const bf16_t* __restrict__ A, int lda, int ks,
                      const bf16_t* __restrict__ Bt, int ldb, int K, char* smem) {
  constexpr int A_BYTES = 128 * 128;
  constexpr int B_BYTES = 64 * NJ * 128;
  constexpr int STAGE = A_BYTES + B_BYTES;
  const int tid = otid(), lane = tid & 63, wid = __builtin_amdgcn_readfirstlane(tid >> 6), wm = wid >> 1, wn = wid & 1;
  const int r = lane & 31, hh = lane >> 5;
  const int nk = K >> 6;
  const int lrow = tid >> 3, lc = tid & 7;
  const int gc = (lc ^ ((lrow >> 1) & 7)) * 8;
  const bf16_t* ap = A + (size_t)lrow * lda + gc;
  const bf16_t* bp = Bt + (size_t)lrow * ldb + gc;
  auto issue = [&](int kt, int buf) {
    char* base = smem + buf * STAGE + tid * 16;
    const bf16_t* ap2 = ap + (size_t)kt * ks;
    const bf16_t* bp2 = bp + (size_t)kt * 64;
#pragma unroll
    for (int p = 0; p < 4; ++p) __builtin_amdgcn_global_load_lds((const unsigned*)(ap2 + (size_t)(32 * p) * lda), (lds_u32*)(base + p * 4096), 16, 0, 0);
#pragma unroll
    for (int p = 0; p < 2 * NJ; ++p) __builtin_amdgcn_global_load_lds((const unsigned*)(bp2 + (size_t)(32 * p) * ldb), (lds_u32*)(base + A_BYTES + p * 4096), 16, 0, 0);
  };
  issue(0, 0);
  __syncthreads();
#pragma unroll 1
  for (int kt = 0; kt < nk; ++kt) {
    if (kt + 1 < nk) issue(kt + 1, (kt + 1) & 1);
    const char* base = smem + (kt & 1) * STAGE;
#pragma unroll
    for (int s = 0; s < 4; ++s) {
      bf16x8 af[2], bfr[NJ];
#pragma unroll
      for (int i = 0; i < 2; ++i) { const int row = wm * 64 + i * 32 + r; af[i] = *(const bf16x8*)(base + row * 128 + (((2 * s + hh) ^ ((row >> 1) & 7)) << 4)); }
#pragma unroll
      for (int j = 0; j < NJ; ++j) { const int row = wn * (32 * NJ) + j * 32 + r; bfr[j] = *(const bf16x8*)(base + A_BYTES + row * 128 + (((2 * s + hh) ^ ((row >> 1) & 7)) << 4)); }
#pragma unroll
      for (int i = 0; i < 2; ++i)
#pragma unroll
        for (int j = 0; j < NJ; ++j) acc[i][j] = MFMA32(af[i], bfr[j], acc[i][j]);
    }
    __syncthreads();
  }
}

template <int NJ> DI void zero_acc(f32x16 (&acc)[2][NJ]) {
#pragma unroll
  for (int i = 0; i < 2; ++i)
#pragma unroll
    for (int j = 0; j < NJ; ++j)
#pragma unroll
      for (int e = 0; e < 16; ++e) acc[i][j][e] = 0.f;
}

DI void phase_prologue(const Params& p, char* smem) {
  const int tid = otid(), lane = tid & 63, wid = __builtin_amdgcn_readfirstlane(tid >> 6);
  float* mod = (float*)(p.ws + OFF_MOD);
  if (blockIdx.x == 0) {
    if (tid < 32) ((unsigned*)(p.ws + OFF_CNT))[tid] = 0u;
    float* cs16 = (float*)(p.ws + OFF_CS16);
    float* cs8 = (float*)(p.ws + OFF_CS8);
    for (int e = tid; e < 64 * 16; e += 256) { const int pos = e >> 4, i = e & 15; const float inv = expf(-9.210340371976184f * (float)i / 16.0f); const float a = (float)pos * inv; cs16[e * 2] = cosf(a); cs16[e * 2 + 1] = sinf(a); }
    for (int e = tid; e < 64 * 8; e += 256) { const int pos = e >> 3, i = e & 7; const float inv = expf(-9.210340371976184f * (float)i / 8.0f); const float a = (float)pos * inv; cs8[e * 2] = cosf(a); cs8[e * 2 + 1] = sinf(a); }
  }
  float* sl = (float*)smem;
  float* red = sl + 9 * 1024;
  for (int e = tid; e < 9 * 1024; e += 256) { const int j = e >> 10, k = e & 1023; const float* cc0 = opq(p.in[I_CCTX]); const float* cc1 = opq(p.in[I_C]); const float c = j == 0 ? cc0[k] : cc1[(j - 1) * 1024 + k]; sl[e] = siluf_(c); }
  __syncthreads();
  for (int item = blockIdx.x; item < 192; item += gridDim.x) {
    const int l = item / 48, n = (item % 48) * 64 + lane;
    const float* w = p.in[I_WMOD] + (size_t)l * 1024 * 3072 + n;
    float a[9];
#pragma unroll
    for (int j = 0; j < 9; ++j) a[j] = 0.f;
    for (int k = wid * 256; k < wid * 256 + 256; ++k) {
      const float wv = w[(size_t)k * 3072];
#pragma unroll
      for (int j = 0; j < 9; ++j) a[j] += sl[j * 1024 + k] * wv;
    }
#pragma unroll
    for (int j = 0; j < 9; ++j) red[(wid * 9 + j) * 64 + lane] = a[j];
    __syncthreads();
    for (int e = tid; e < 9 * 64; e += 256) {
      const int j = e >> 6, c = e & 63;
      const float s = red[(0 * 9 + j) * 64 + c] + red[(1 * 9 + j) * 64 + c] + red[(2 * 9 + j) * 64 + c] + red[(3 * 9 + j) * 64 + c];
      const int nn = (item % 48) * 64 + c;
      mod[((size_t)l * 9 + j) * MODLD + nn] = s + p.in[I_BMOD][l * 3072 + nn];
    }
    __syncthreads();
  }
}

DI const float* x_row_ptr(const Params& p, int l, int row) {
  const float* xp = opq(p.in[I_XP]); const float* xs = opq(p.in[I_XS]); const float* xo = opq((const float*)p.out);
  if (l == 0) return row < NCTX ? xp + (size_t)row * 1024 : xs + (size_t)(row - NCTX) * 1024;
  return xo + (size_t)row * 1024;
}
DI void norm_row(const Params& p, int l, int row, int lane) {
  const float* x = x_row_ptr(p, l, row);
  const int j = row < NCTX ? 0 : 1 + ((row - NCTX) >> 12);
  const float* mod = (const float*)(p.ws + OFF_MOD) + ((size_t)l * 9 + j) * MODLD;
  const float* nw = p.in[I_NORMW] + l * 1024;
  bf16_t* h = (bf16_t*)(p.ws + OFF_R1) + (size_t)row * 1024;
  f32x4 v[4]; float ss = 0.f;
#pragma unroll
  for (int i = 0; i < 4; ++i) { v[i] = *(const f32x4*)(x + lane * 4 + 256 * i); ss += v[i].x * v[i].x + v[i].y * v[i].y + v[i].z * v[i].z + v[i].w * v[i].w; }
ss = wave_sum(ss);
  const float rs = rsqrtf(ss * (1.0f / 1024.0f) + 1e-6f);
#pragma unroll
  for (int i = 0; i < 4; ++i) {
    const int c = lane * 4 + 256 * i;
    const f32x4 w = *(const f32x4*)(nw + c), sh = *(const f32x4*)(mod + c), sc = *(const f32x4*)(mod + 1024 + c);
    u32x2 o;
    o.x = pack2(v[i].x * rs * w.x * (1.f + sc.x) + sh.x, v[i].y * rs * w.y * (1.f + sc.y) + sh.y);
    o.y = pack2(v[i].z * rs * w.z * (1.f + sc.z) + sh.z, v[i].w * rs * w.w * (1.f + sc.w) + sh.w);
    *(u32x2*)(h + c) = o;
  }
}

DI void norm_rows2(const Params& p, int l, int rowa, int rowb, int lane) {
  const float* xa = x_row_ptr(p, l, rowa); const float* xb = x_row_ptr(p, l, rowb);
  f32x4 va[4], vb[4];
#pragma unroll
  for (int i = 0; i < 4; ++i) va[i] = *(const f32x4*)(xa + lane * 4 + 256 * i);
#pragma unroll
  for (int i = 0; i < 4; ++i) vb[i] = *(const f32x4*)(xb + lane * 4 + 256 * i);
  const float* nw = p.in[I_NORMW] + l * 1024;
#pragma unroll
  for (int rr = 0; rr < 2; ++rr) {
    const int row = rr ? rowb : rowa;
    f32x4 (&v)[4] = rr ? vb : va;
    const int j = row < NCTX ? 0 : 1 + ((row - NCTX) >> 12);
    const float* mod = (const float*)(p.ws + OFF_MOD) + ((size_t)l * 9 + j) * MODLD;
    bf16_t* h = (bf16_t*)(p.ws + OFF_R1) + (size_t)row * 1024;
    float ss = 0.f;
#pragma unroll
    for (int i = 0; i < 4; ++i) ss += v[i].x * v[i].x + v[i].y * v[i].y + v[i].z * v[i].z + v[i].w * v[i].w;
    ss = wave_sum(ss);
    const float rs = rsqrtf(ss * (1.0f / 1024.0f) + 1e-6f);
#pragma unroll
    for (int i = 0; i < 4; ++i) {
      const int c = lane * 4 + 256 * i;
      const f32x4 w = *(const f32x4*)(nw + c), sh = *(const f32x4*)(mod + c), sc = *(const f32x4*)(mod + 1024 + c);
      u32x2 o;
      o.x = pack2(v[i].x * rs * w.x * (1.f + sc.x) + sh.x, v[i].y * rs * w.y * (1.f + sc.y) + sh.y);
      o.y = pack2(v[i].z * rs * w.z * (1.f + sc.z) + sh.z, v[i].w * rs * w.w * (1.f + sc.w) + sh.w);
      *(u32x2*)(h + c) = o;
    }
  }
}

DI int win_srccol(int j) {
  if (j < 768) return j;
  if (j < 1696) return j + 512;
  if (j < 3488) return j + 1024;
  if (j < 3584) return -1;
  if (j < 5120) { const int jj = j - 3584; return jj < 512 ? 768 + jj : (jj < 1024 ? 2208 + (jj - 512) : 4512 + (jj - 1024)); }
  return 5024 + (j - 5120);
}
DI void conv_tile(const float* __restrict__ src, int ld_src, bf16_t* dst, int ld_dst, int k0, int n0, int kind, int srcoff, char* smem) {
  float* tile = (float*)smem;
  const int tid = otid();
  const int n = tid & 63;
  int sc = kind == 0 ? win_srccol(n0 + n) : (n0 + n - srcoff);
#pragma unroll
  for (int i = 0; i < 16; ++i) { const int k = i * 4 + (tid >> 6); tile[k * 65 + n] = sc >= 0 ? src[(size_t)(k0 + k) * ld_src + sc] : 0.f; }
  __syncthreads();
#pragma unroll
  for (int i = 0; i < 8; ++i) { const int nn = i * 8 + (tid >> 5), kk = (tid & 31) * 2; *(unsigned*)(dst + (size_t)(n0 + nn) * ld_dst + k0 + kk) = pack2(tile[kk * 65 + nn], tile[(kk + 1) * 65 + nn]); }
  __syncthreads();
}

DI void phase_norm_convert(const Params& p, int l, char* smem) {
  const int tid = otid(), lane = tid & 63, wid = __builtin_amdgcn_readfirstlane(tid >> 6);
  bf16_t* WinT = (bf16_t*)(p.ws + OFF_WIN); bf16_t* WoT = (bf16_t*)(p.ws + OFF_WO); bf16_t* WoutT = (bf16_t*)(p.ws + OFF_WOUT); bf16_t* WuT = (bf16_t*)(p.ws + OFF_WU);
  const int NI_WIN = 128 * 16, NI_WO = 3 * 16 * 8, NI_WOUT = 16 * 16, NI_WU = 16 * 2;
  const int NI_CONV = NI_WIN + NI_WO + NI_WOUT + NI_WU;
  for (int item = blockIdx.x; item < NI_CONV; item += gridDim.x) {
    int it = item;
    if (it < NI_WIN) { conv_tile(p.in[I_WIN] + (size_t)l * 1024 * 8096, 8096, WinT, 1024, (it & 15) * 64, (it >> 4) * 64, 0, 0, smem); continue; }
    it -= NI_WIN;
    if (it < NI_WO) { const int br = it / 128, r2 = it % 128; const float* src = (br == 0 ? opq(p.in[I_WOA]) : (br == 1 ? opq(p.in[I_WOB]) : opq(p.in[I_WOC]))) + (size_t)l * 512 * 1024; conv_tile(src, 1024, WoT + (size_t)br * 1024 * 512, 512, (r2 & 7) * 64, (r2 >> 3) * 64, 1, 0, smem); continue; }
    it -= NI_WO;
    if (it < NI_WOUT) { conv_tile(p.in[I_WOUT] + (size_t)l * 1024 * 1024, 1024, WoutT, 1024, (it & 15) * 64, (it >> 4) * 64, 1, 0, smem); continue; }
    it -= NI_WOUT;
    { const int nt = it >> 1, kt = it & 1; const bool uv = nt >= 8; const float* src = (uv ? opq(p.in[I_WUV]) : opq(p.in[I_WUK])) + (size_t)l * 128 * 512; conv_tile(src, 512, WuT, 128, kt * 64, nt * 64, 1, uv ? 512 : 0, smem); }
  }
  for (int item = blockIdx.x; item < NT / 8; item += gridDim.x) norm_rows2(p, l, item * 8 + wid, item * 8 + 4 + wid, lane);
}

DI bool next_tile(int it, int NTN, int GN, int& mt, int& nt, int MPX = 40, int GM = 8) {
  if (gridDim.x == 512) {
    const int x = blockIdx.x & 7, local = blockIdx.x >> 3;
    const int q = it * 64 + local;
    if (q >= MPX * NTN) return false;
    const int gsz = GM * GN, g = q / gsz, w = q - g * gsz, ngroups = NTN / GN;
    const int mgi = g / ngroups, ngi = g - mgi * ngroups;
    mt = x * MPX + mgi * GM + w / GN; nt = ngi * GN + (w % GN);
    return true;
  }
  const int tile = blockIdx.x + it * gridDim.x;
  if (tile >= 8 * MPX * NTN) return false;
  mt = tile / NTN; nt = tile % NTN;
  return true;
}

DI void phase_gemm1(const Params& p, int l, char* smem) {
  const bf16_t* H = (const bf16_t*)(p.ws + OFF_R1);
  const bf16_t* W = (const bf16_t*)(p.ws + OFF_WIN);
  bf16_t* U = (bf16_t*)(p.ws + OFF_U);
  bf16_t* VAT = (bf16_t*)(p.ws + OFF_VAT);
  const int NTN = 28, ntiles = 320 * NTN;
  for (int it = 0;; ++it) {
    int mt, nt; if (!next_tile(it, NTN, 7, mt, nt)) break;
    const int m0 = mt * 128, n0 = nt * 128;
    f32x16 acc[2][2]; zero_acc<2>(acc);
    gemm_mainloop<2>(acc, H + (size_t)m0 * 1024, 1024, 64, W + (size_t)n0 * 1024, 1024, 1024, smem);
    const int lane = otid() & 63, wid = __builtin_amdgcn_readfirstlane(otid() >> 6), wm = wid >> 1, wn = wid & 1, r = lane & 31, hh = lane >> 5;
    int seq, t0; row_decode(m0, seq, t0);
#pragma unroll
    for (int j = 0; j < 2; ++j) {
      const int cb = n0 + wn * 64 + j * 32;
      if (cb >= ULD) continue;
      const int col = cb + r;
      if (cb >= 640 && cb < 768) {
        const int kvh = (col - 640) >> 6, dv = col & 63, Tk = seq_tk(seq);
        bf16_t* vt = VAT + (size_t)128 * keyrow0(seq) + (size_t)(kvh * 64 + dv) * Tk;
#pragma unroll
        for (int i = 0; i < 2; ++i) {
          const int tt = t0 + wm * 64 + i * 32;
#pragma unroll
          for (int g2 = 0; g2 < 2; ++g2) {
            float v[8];
#pragma unroll
            for (int e = 0; e < 8; ++e) v[e] = acc[i][j][g2 * 8 + e];
            *(u32x4*)(vt + tt + 16 * g2 + 8 * hh) = pack8(v);
          }
          if (seq < 32) {
            float* o = p.out + OUT_AV + ((size_t)(seq * 4 + l) * 256 + tt) * 128;
            const int lo = 4 * hh * 128 + (col - 640);
#pragma unroll
            for (int e = 0; e < 16; ++e) (o + crowu(e) * 128)[lo] = acc[i][j][e];
          }
        }
      } else {
#pragma unroll
        for (int i = 0; i < 2; ++i) {
          bf16_t* up = U + (size_t)(m0 + wm * 64 + i * 32) * ULD;
          const int lo = 4 * hh * ULD + col;
#pragma unroll
          for (int e = 0; e < 16; ++e) (up + crowu(e) * ULD)[lo] = f2bf(acc[i][j][e]);
        }
      }
    }
  }
}

struct PostIn { u32x4 q, k, bq; u32x2 br; unsigned ckv; bf16_t kr; };
DI void post_load(const Params& p, int row, int lane, PostIn& in) {
  const bf16_t* u = (const bf16_t*)(p.ws + OFF_U) + (size_t)row * ULD;
  in.q = *(const u32x4*)(u + lane * 8);
  in.k = *(const u32x4*)(u + 512 + (lane & 15) * 8);
  in.bq = *(const u32x4*)(u + 768 + (lane >> 3) * 96 + (lane & 7) * 8);
  in.br = *(const u32x2*)(u + 768 + (lane >> 3) * 96 + 64 + (lane & 7) * 4);
  in.ckv = *(const unsigned*)(u + 1536 + lane * 2);
  in.kr = u[1664 + (lane & 31)];
}
DI void post_row(const Params& p, int l, int row, int lane, const PostIn& in) {
  int seq, t; row_decode(row, seq, t);
  const bool lat = row >= NCTX;
  const int krow = keyrow0(seq) + t;
  const int prow = t >> 6, pcol = t & 63;
  bf16_t* u = (bf16_t*)(p.ws + OFF_U) + (size_t)row * ULD;
  const float* cs16 = (const float*)(p.ws + OFF_CS16);
  const float* cs8 = (const float*)(p.ws + OFF_CS8);
  const float LOG2E = 1.4426950408889634f;
#pragma unroll
  for (int which = 0; which < 2; ++which) {
    const int l8 = which == 0 ? lane : (lane & 15);
    float v[8]; unpack8(which == 0 ? in.q : in.k, v);
    float ss = 0.f;
#pragma unroll
    for (int i = 0; i < 8; ++i) ss += v[i] * v[i];
    ss += shx<1>(ss); ss += shx<2>(ss); ss += shx<4>(ss);
    const float rs = rsqrtf(ss * (1.0f / 64.0f) + 1e-6f);
    const float* nw = (which == 0 ? opq(p.in[I_QNW]) : opq(p.in[I_KNW])) + l * 64 + (lane & 7) * 8;
#pragma unroll
    for (int i = 0; i < 8; ++i) v[i] = v[i] * rs * nw[i];
    float pv[8];
#pragma unroll
    for (int i = 0; i < 8; ++i) pv[i] = shx<2>(v[i]);
    if (lat) {
      const int pos = ((lane & 7) >> 2) ? pcol : prow;
      const bool lower = (lane & 2) == 0;
      const float* cs = cs16 + (pos * 16 + (lane & 1) * 8) * 2;
#pragma unroll
      for (int i = 0; i < 8; ++i) { const float c = cs[i * 2], s = cs[i * 2 + 1]; v[i] = lower ? v[i] * c - pv[i] * s : v[i] * c + pv[i] * s; }
    }
    if (which == 0) {
      const float sc = 0.125f * LOG2E;
#pragma unroll
      for (int i = 0; i < 8; ++i) v[i] *= sc;
      *(u32x4*)(u + lane * 8) = pack8(v);
    } else if (lane < 16) {
      bf16_t* KA = (bf16_t*)(p.ws + OFF_KA);
      *(u32x4*)(KA + (size_t)krow * 128 + lane * 8) = pack8(v);
      if (!lat) {
        float* o = p.out + OUT_AK + ((size_t)(seq * 4 + l) * 256 + t) * 128 + lane * 8;
        *(f32x4*)o = (f32x4){v[0], v[1], v[2], v[3]}; *(f32x4*)(o + 4) = (f32x4){v[4], v[5], v[6], v[7]};
      }
    }
  }
  {
    const float sc = 0.10206207261596577f * LOG2E;
    const int hd = lane >> 3;
    bf16_t* q = u + 768 + hd * 96;
    { float v[8]; unpack8(in.bq, v);
#pragma unroll
      for (int i = 0; i < 8; ++i) v[i] *= sc;
      *(u32x4*)(q + (lane & 7) * 8) = pack8(v); }
    { bf16_t* qr = q + 64 + (lane & 7) * 4;
      const u32x2 w = in.br;
      float v[4] = {lo16(w.x), hi16(w.x), lo16(w.y), hi16(w.y)}, pv[4];
#pragma unroll
      for (int i = 0; i < 4; ++i) pv[i] = shx<2>(v[i]);
      if (lat) {
        const int pos = ((lane & 7) >> 2) ? pcol : prow;
        const bool lower = (lane & 2) == 0;
        const float* cs = cs8 + (pos * 8 + (lane & 1) * 4) * 2;
#pragma unroll
        for (int i = 0; i < 4; ++i) { const float c = cs[i * 2], s = cs[i * 2 + 1]; v[i] = lower ? v[i] * c - pv[i] * s : v[i] * c + pv[i] * s; }
      }
      u32x2 o; o.x = pack2(v[0] * sc, v[1] * sc); o.y = pack2(v[2] * sc, v[3] * sc);
      *(u32x2*)qr = o; }
  }
  {
    const unsigned w = in.ckv;
    float a = lo16(w), b = hi16(w);
    float ss = a * a + b * b;
ss = wave_sum(ss);
    const float rs = rsqrtf(ss * (1.0f / 128.0f) + 1e-6f);
    const float* nw = p.in[I_KVNW] + l * 128 + lane * 2;
    a = a * rs * nw[0]; b = b * rs * nw[1];
    bf16_t* CKVN = (bf16_t*)(p.ws + OFF_R2);
    *(unsigned*)(CKVN + (size_t)krow * 128 + lane * 2) = pack2(a, b);
    if (!lat) { float* o = p.out + OUT_CKV + ((size_t)(seq * 4 + l) * 256 + t) * 128 + lane * 2; *(f32x2*)o = (f32x2){a, b}; }
  }
  {
    float v = bf2f(in.kr);
    const float pv = shx<8>(v);
    if (!lat) { if (lane < 32) p.out[OUT_KR + ((size_t)(seq * 4 + l) * 256 + t) * 32 + lane] = v; }
    else {
      const int d = lane & 31; const int pos = (d >> 4) ? pcol : prow; const bool lower = (d & 8) == 0;
      const float* cs = cs8 + (pos * 8 + (d & 7)) * 2;
      v = lower ? v * cs[0] - pv * cs[1] : v * cs[0] + pv * cs[1];
    }
    if (lane < 32) ((bf16_t*)(p.ws + OFF_KRB))[(size_t)krow * 32 + lane] = f2bf(v);
  }
}
DI void post_cached_row(const Params& p, int l, int idx, int lane) {
  const int b = idx >> 9, j = idx & 511;
  const int kr0 = NCTX + b * 4608, krow = kr0 + 4096 + j;
  const size_t cb = ((size_t)(b * 4 + l) * 512 + j);
  bf16_t* KA = (bf16_t*)(p.ws + OFF_KA); bf16_t* VAT = (bf16_t*)(p.ws + OFF_VAT); bf16_t* CKVN = (bf16_t*)(p.ws + OFF_R2); bf16_t* KRB = (bf16_t*)(p.ws + OFF_KRB);
  { const f32x2 v = *(const f32x2*)(p.in[I_CAK] + cb * 128 + lane * 2); *(unsigned*)(KA + (size_t)krow * 128 + lane * 2) = pack2(v.x, v.y); }
  { const f32x2 v = *(const f32x2*)(p.in[I_CAV] + cb * 128 + lane * 2);
    bf16_t* vt = VAT + (size_t)128 * kr0 + (size_t)(lane * 2) * 4608 + perm16(4096 + j);
    vt[0] = f2bf(v.x); vt[4608] = f2bf(v.y); }
  { const f32x2 v = *(const f32x2*)(p.in[I_CCKV] + cb * 128 + lane * 2); *(unsigned*)(CKVN + (size_t)krow * 128 + lane * 2) = pack2(v.x, v.y); }
  if (lane < 32) KRB[(size_t)krow * 32 + lane] = f2bf(p.in[I_CKR][cb * 32 + lane]);
}
DI void phase_post(const Params& p, int l) {
  const int lane = otid() & 63, wid = __builtin_amdgcn_readfirstlane(otid() >> 6);
  for (int item = blockIdx.x; item < NT / 8 + 1024; item += gridDim.x) {
    if (item < NT / 8) {
      const int ra = item * 8 + wid, rb = ra + 4;
      PostIn ia, ib; post_load(p, ra, lane, ia); post_load(p, rb, lane, ib);
      post_row(p, l, ra, lane, ia); post_row(p, l, rb, lane, ib);
    }
    else post_cached_row(p, l, (item - NT / 8) * 4 + wid, lane);
  }
}

DI void phase_upproj(const Params& p, char* smem) {
  const bf16_t* A = (const bf16_t*)(p.ws + OFF_R2);
  const bf16_t* W = (const bf16_t*)(p.ws + OFF_WU);
  bf16_t* KN = (bf16_t*)(p.ws + OFF_KN); bf16_t* VBT = (bf16_t*)(p.ws + OFF_VBT);
  const int ntiles = 352 * 8;
  for (int it = 0;; ++it) {
    int mt, nt; if (!next_tile(it, 8, 8, mt, nt, 44, 4)) break;
    const int m0 = mt * 128, n0 = nt * 128;
    f32x16 acc[2][2]; zero_acc<2>(acc);
    gemm_mainloop<2>(acc, A + (size_t)m0 * 128, 128, 64, W + (size_t)n0 * 128, 128, 128, smem);
    const int lane = otid() & 63, wid = __builtin_amdgcn_readfirstlane(otid() >> 6), wm = wid >> 1, wn = wid & 1, r = lane & 31, hh = lane >> 5;
    int seq, t0;
    if (m0 < NCTX) { seq = m0 >> 8; t0 = m0 & 255; } else { const int rr = m0 - NCTX; seq = 32 + rr / 4608; t0 = rr % 4608; }
#pragma unroll
    for (int j = 0; j < 2; ++j) {
      const int col = n0 + wn * 64 + j * 32 + r;
      if (n0 < 512) {
#pragma unroll
        for (int i = 0; i < 2; ++i) {
          bf16_t* kp = KN + (size_t)(m0 + wm * 64 + i * 32) * 512;
          const int lo = 4 * hh * 512 + col;
#pragma unroll
          for (int e = 0; e < 16; ++e) (kp + crowu(e) * 512)[lo] = f2bf(acc[i][j][e]);
        }
      } else {
        const int Tk = seq_tk(seq);
        bf16_t* vt = VBT + (size_t)512 * keyrow0(seq) + (size_t)(col - 512) * Tk;
#pragma unroll
        for (int i = 0; i < 2; ++i) {
          const int tt = t0 + wm * 64 + i * 32;
#pragma unroll
          for (int g2 = 0; g2 < 2; ++g2) {
            float v[8];
#pragma unroll
            for (int e = 0; e < 8; ++e) v[e] = acc[i][j][g2 * 8 + e];
            *(u32x4*)(vt + tt + 16 * g2 + 8 * hh) = pack8(v);
          }
        }
      }
    }
  }
}

template <int DQK>
DI void attn_item(const bf16_t* Qw, int q_ld, const bf16_t* K1, int k1_ld, const bf16_t* K2, int k2_ld,
                  const bf16_t* Vt, int vt_ld, int nkeys, bf16_t* Ow, int o_ld, char* smem) {
  constexpr int KS = DQK * 2 + 16;
  constexpr int KBYTES = 64 * KS;
  constexpr int VS = 144;
  constexpr int VBYTES = 64 * VS;
  constexpr int STAGE = KBYTES + VBYTES;
  constexpr int CPR = DQK / 8;
  constexpr int NKC = 64 * CPR / 256;
  constexpr int NS = DQK / 16;
  const int tid = otid(), lane = tid & 63, r = lane & 31, hh = lane >> 5;
  bf16x8 qf[NS];
#pragma unroll
  for (int s = 0; s < NS; ++s) qf[s] = *(const bf16x8*)(Qw + (size_t)r * q_ld + 16 * s + 8 * hh);
  f32x16 o[2];
#pragma unroll
  for (int n = 0; n < 2; ++n)
#pragma unroll
    for (int e = 0; e < 16; ++e) o[n][e] = 0.f;
  float m_run = 0.f, lsum = 0.f;
  u32x4 rk0[NKC], rv0[2], rk1[NKC], rv1[2];
  int krow_[NKC], kc_[NKC];
#pragma unroll
  for (int q = 0; q < NKC; ++q) { const int id = q * 256 + tid; krow_[q] = id / CPR; kc_[q] = id % CPR; }
  const int vrow = tid >> 3, vc = tid & 7;
  auto gload = [&](int key0, u32x4 (&rk)[NKC], u32x4 (&rv)[2]) {
#pragma unroll
    for (int q = 0; q < NKC; ++q) {
      const bf16_t* src = (DQK == 64 || kc_[q] < 8) ? K1 + (size_t)(key0 + krow_[q]) * k1_ld + kc_[q] * 8 : K2 + (size_t)(key0 + krow_[q]) * k2_ld + (kc_[q] - 8) * 8;
      rk[q] = *(const u32x4*)src;
    }
#pragma unroll
    for (int q = 0; q < 2; ++q) rv[q] = *(const u32x4*)(Vt + (size_t)(vrow + 32 * q) * vt_ld + key0 + vc * 8);
  };
  auto lstore = [&](int buf, u32x4 (&rk)[NKC], u32x4 (&rv)[2]) {
    char* base = smem + buf * STAGE;
#pragma unroll
    for (int q = 0; q < NKC; ++q) *(u32x4*)(base + krow_[q] * KS + kc_[q] * 16) = rk[q];
#pragma unroll
    for (int q = 0; q < 2; ++q) *(u32x4*)(base + KBYTES + (vrow + 32 * q) * VS + vc * 16) = rv[q];
  };
  const int ntl = nkeys >> 6;
  gload(0, rk0, rv0); lstore(0, rk0, rv0);
  gload(64, rk1, rv1);
  if (ntl > 2) gload(128, rk0, rv0);
  __syncthreads();
  auto tile_body = [&](int tl, u32x4 (&rkn)[NKC], u32x4 (&rvn)[2]) {
    const char* base = smem + (tl & 1) * STAGE;
    bf16x8 kf[2][NS], vf[2][2][2];
#pragma unroll
    for (int kb = 0; kb < 2; ++kb)
#pragma unroll
      for (int ks = 0; ks < NS; ++ks) kf[kb][ks] = *(const bf16x8*)(base + (kb * 32 + r) * KS + (2 * ks + hh) * 16);
    __builtin_amdgcn_sched_barrier(0);
    f32x16 s[2];
    const float ninit = -m_run;
#pragma unroll
    for (int kb = 0; kb < 2; ++kb)
#pragma unroll
      for (int e = 0; e < 16; ++e) s[kb][e] = ninit;
#pragma unroll
    for (int ks = 0; ks < NS; ++ks)
#pragma unroll
      for (int kb = 0; kb < 2; ++kb) s[kb] = MFMA32(kf[kb][ks], qf[ks], s[kb]);
#pragma unroll
    for (int kb = 0; kb < 2; ++kb)
#pragma unroll
      for (int s2 = 0; s2 < 2; ++s2)
#pragma unroll
        for (int n = 0; n < 2; ++n) vf[kb][s2][n] = *(const bf16x8*)(base + KBYTES + (32 * n + r) * VS + (kb * 32 + 16 * s2 + 8 * hh) * 2);
    __builtin_amdgcn_sched_barrier(0);
    float mx = s[0][0];
#pragma unroll
    for (int kb = 0; kb < 2; ++kb)
#pragma unroll
      for (int e = 0; e < 16; ++e) mx = fmaxf(mx, s[kb][e]);
    { const unsigned u = __float_as_uint(mx); auto sw = __builtin_amdgcn_permlane32_swap(u, u, false, false); mx = fmaxf(__uint_as_float(sw[0]), __uint_as_float(sw[1])); }
    const bool move = (mx > 4.0f) || (mx < -20.0f);
    if (__builtin_amdgcn_ballot_w64(move) != 0ull) {
      const float dlt = move ? mx : 0.f;
      const float alpha = __builtin_amdgcn_exp2f(-dlt);
      m_run += dlt;
      lsum *= alpha;
#pragma unroll
      for (int kb = 0; kb < 2; ++kb)
#pragma unroll
        for (int e = 0; e < 16; ++e) s[kb][e] -= dlt;
#pragma unroll
      for (int n = 0; n < 2; ++n)
#pragma unroll
        for (int e = 0; e < 16; ++e) o[n][e] *= alpha;
    }
    float ps = 0.f;
#pragma unroll
    for (int kb = 0; kb < 2; ++kb)
#pragma unroll
      for (int e = 0; e < 16; ++e) { const float pe = __builtin_amdgcn_exp2f(s[kb][e]); s[kb][e] = pe; ps += pe; }
    lsum += ps;
#pragma unroll
    for (int kb = 0; kb < 2; ++kb)
#pragma unroll
      for (int s2 = 0; s2 < 2; ++s2) {
        u32x4 pw;
        pw.x = pack2(s[kb][8 * s2 + 0], s[kb][8 * s2 + 1]); pw.y = pack2(s[kb][8 * s2 + 2], s[kb][8 * s2 + 3]);
        pw.z = pack2(s[kb][8 * s2 + 4], s[kb][8 * s2 + 5]); pw.w = pack2(s[kb][8 * s2 + 6], s[kb][8 * s2 + 7]);
        const bf16x8 pf = __builtin_bit_cast(bf16x8, pw);
#pragma unroll
        for (int n = 0; n < 2; ++n) o[n] = MFMA32(vf[kb][s2][n], pf, o[n]);
      }
    if (tl + 1 < ntl) { lstore((tl + 1) & 1, rkn, rvn); if (tl + 3 < ntl) gload((tl + 3) * 64, rkn, rvn); }
    __syncthreads();
  };
  for (int tl = 0; tl < ntl; tl += 2) { tile_body(tl, rk1, rv1); tile_body(tl + 1, rk0, rv0); }
  lsum = xsum32(lsum);
  const float inv = 1.0f / lsum;
#pragma unroll
  for (int n = 0; n < 2; ++n)
#pragma unroll
    for (int g = 0; g < 4; ++g) {
      u32x2 w; w.x = pack2(o[n][4 * g] * inv, o[n][4 * g + 1] * inv); w.y = pack2(o[n][4 * g + 2] * inv, o[n][4 * g + 3] * inv);
      *(u32x2*)(Ow + (size_t)r * o_ld + 32 * n + 8 * g + 4 * hh) = w;
    }
}

DI void scan_item(const Params& p, int l, int seq, int hd, int dir, int rs, char* smem) {
  const int tid = otid(), lane = tid & 63, wv = __builtin_amdgcn_readfirstlane(tid >> 6);
  const int j8 = lane & 7, r = lane & 31, hh = lane >> 5;
  const bool lat = seq >= 32;
  const int T = lat ? 4096 : 256;
  const int row0 = lat ? NCTX + (seq - 32) * 4096 : seq * 256;
  float* vA = (float*)smem; float* vK = vA + 2048; float* vR = vK + 2048; float* vV = vR + 2048; float* vW = vV + 2048; float* vB = vW + 2048; float* ybuf = vB + 2048;
  char* raw = smem + 32768;
  char* wdx = smem + 57344; char* adx = smem + 61952;
  float* tmpb = (float*)(smem + 66816);
  const bf16_t* U = (const bf16_t*)(p.ws + OFF_U);
  bf16_t* Y = (bf16_t*)(p.ws + OFF_R2) + (dir ? (size_t)NT * 512 : 0);
  float* bonus = (float*)(p.ws + OFF_BONUS);
  const int lrow = 8 * wv + (lane >> 3), irow = rs * 32 + lrow;
  f32x2 S[4];
  if (lat) {
    const float* s0 = (dir ? opq(p.in[I_SB]) : opq(p.in[I_SF])) + ((size_t)((seq - 32) * 4 + l) * 8 + hd) * 4096 + irow * 64 + j8 * 8;
#pragma unroll
    for (int q = 0; q < 2; ++q) { const f32x4 v = *(const f32x4*)(s0 + 4 * q); S[2 * q] = (f32x2){v.x, v.y}; S[2 * q + 1] = (f32x2){v.z, v.w}; }
  } else {
#pragma unroll
    for (int q = 0; q < 4; ++q) S[q] = (f32x2){0.f, 0.f};
  }
  const int mat = wv >> 1, ntc = wv & 1, cch = ntc * 32 + r, hc = hd * 64 + cch;
  bf16x8 bfrag[4];
  {
    const float* W = (mat ? opq(p.in[I_AUP]) : opq(p.in[I_WUP])) + (size_t)(l * 2 + dir) * 64 * 512 + hc;
#pragma unroll
    for (int s4 = 0; s4 < 4; ++s4) {
      float w8[8];
#pragma unroll
      for (int j = 0; j < 8; ++j) w8[j] = W[(size_t)(16 * s4 + 8 * hh + j) * 512];
      bfrag[s4] = __builtin_bit_cast(bf16x8, pack8(w8));
    }
  }
  const float bias = (mat ? opq(p.in[I_A0]) : opq(p.in[I_W0]))[(l * 2 + dir) * 512 + hc];
  const float kav = p.in[I_KA][l * 512 + hc], rkv = p.in[I_RK][l * 512 + hc];
  float* muP = (float*)(smem + 75008); float* muN = muP + 320; float* kkL = muN + 320;
  {
    const float* mup = p.in[I_MUP] + l * 1792; const float* mun = p.in[I_MUN] + l * 1792;
    for (int e = tid; e < 320; e += 256) { const int g = e >> 6, c = e & 63; const int col = (g < 3 ? g * 512 + hd * 64 : (g == 3 ? 1536 + dir * 64 : 1664 + dir * 64)) + c; muP[e] = mup[col]; muN[e] = mun[col]; }
    if (tid < 64) kkL[tid] = p.in[I_KK][l * 512 + hd * 64 + tid];
  }
  const int nch = T >> 5;
  u32x4 pre[6];
  auto prefetch = [&](int t0) {
#pragma unroll
    for (int q = 0; q < 6; ++q) {
      const int id = q * 256 + tid;
      const int row = id / 40, cc = id - row * 40, g = cc >> 3, c8 = cc & 7;
      const int t = t0 - 1 + row;
      const int col = (g < 3 ? g * 512 + hd * 64 : (g == 3 ? 1536 + dir * 64 : 1664 + dir * 64)) + c8 * 8;
      u32x4 v = (u32x4){0u, 0u, 0u, 0u};
      if (id < 1360 && t >= 0 && t < T) v = *(const u32x4*)(U + (size_t)(row0 + t) * ULD + 1696 + col);
      pre[q] = v;
    }
  };
  prefetch((dir ? nch - 1 : 0) * 32);
  for (int ci = 0; ci < nch; ++ci) {
    const int t0 = (dir ? nch - 1 - ci : ci) * 32;
#pragma unroll
    for (int q = 0; q < 6; ++q) { const int id = q * 256 + tid; if (id < 1360) *(u32x4*)(raw + id * 16) = pre[q]; }
    __syncthreads();
    if (ci + 1 < nch) prefetch((dir ? nch - 2 - ci : ci + 1) * 32);
    {
      const int tt = tid >> 3, sub = tid & 7;
#pragma unroll 1
      for (int g = 0; g < 5; ++g) {
        const int col = (g < 3 ? g * 512 + hd * 64 : (g == 3 ? 1536 + dir * 64 : 1664 + dir * 64)) + sub * 8;
        float c[8], pv[8], nx[8], x[8];
        unpack8(*(const u32x4*)(raw + (tt + 1) * 640 + (g * 8 + sub) * 16), c);
        unpack8(*(const u32x4*)(raw + tt * 640 + (g * 8 + sub) * 16), pv);
        unpack8(*(const u32x4*)(raw + (tt + 2) * 640 + (g * 8 + sub) * 16), nx);
        const f32x4 mp0 = *(const f32x4*)(muP + g * 64 + sub * 8), mp1 = *(const f32x4*)(muP + g * 64 + sub * 8 + 4), mn0 = *(const f32x4*)(muN + g * 64 + sub * 8), mn1 = *(const f32x4*)(muN + g * 64 + sub * 8 + 4);
        const float mp[8] = {mp0.x, mp0.y, mp0.z, mp0.w, mp1.x, mp1.y, mp1.z, mp1.w}, mn[8] = {mn0.x, mn0.y, mn0.z, mn0.w, mn1.x, mn1.y, mn1.z, mn1.w};
#pragma unroll
        for (int i = 0; i < 8; ++i) x[i] = c[i] + mp[i] * (pv[i] - c[i]) + mn[i] * (nx[i] - c[i]);
        const int lo = tt * 64 + sub * 8;
        if (g == 0) { *(f32x4*)(vR + lo) = (f32x4){x[0], x[1], x[2], x[3]}; *(f32x4*)(vR + lo + 4) = (f32x4){x[4], x[5], x[6], x[7]}; }
        else if (g == 1) {
          float kk[8], ss = 0.f;
          const float* kkw = kkL + sub * 8;
#pragma unroll
          for (int i = 0; i < 8; ++i) { kk[i] = x[i] * kkw[i]; ss += kk[i] * kk[i]; }
          *(f32x4*)(vK + lo) = (f32x4){x[0], x[1], x[2], x[3]}; *(f32x4*)(vK + lo + 4) = (f32x4){x[4], x[5], x[6], x[7]};
          ss += shx<1>(ss); ss += shx<2>(ss); ss += shx<4>(ss);
          const float inv = 1.0f / fmaxf(sqrtf(ss), 1e-12f);
          *(f32x4*)(vA + lo) = (f32x4){kk[0] * inv, kk[1] * inv, kk[2] * inv, kk[3] * inv}; *(f32x4*)(vA + lo + 4) = (f32x4){kk[4] * inv, kk[5] * inv, kk[6] * inv, kk[7] * inv};
        }
        else if (g == 2) { *(f32x4*)(vV + lo) = (f32x4){x[0], x[1], x[2], x[3]}; *(f32x4*)(vV + lo + 4) = (f32x4){x[4], x[5], x[6], x[7]}; }
        else if (g == 3) { float th[8]; for (int i = 0; i < 8; ++i) th[i] = 1.0f - 2.0f * __builtin_amdgcn_rcpf(1.0f + __expf(2.0f * x[i])); *(u32x4*)(wdx + tt * 144 + sub * 16) = pack8(th); }
        else { *(u32x4*)(adx + tt * 144 + sub * 16) = pack8(x); }
      }
    }
    __syncthreads();
    {
      f32x16 acc;
#pragma unroll
      for (int e = 0; e < 16; ++e) acc[e] = 0.f;
      const char* xb = mat ? adx : wdx;
#pragma unroll
      for (int s4 = 0; s4 < 4; ++s4) { const bf16x8 af = *(const bf16x8*)(xb + r * 144 + (16 * s4 + 8 * hh) * 2); acc = MFMA32(af, bfrag[s4], acc); }
      if (mat == 0) {
#pragma unroll
        for (int e = 0; e < 16; ++e) vW[crow(e, hh) * 64 + cch] = __expf(-0.6065306597126334f * sigmoidf_(bias + acc[e]));
      } else {
#pragma unroll
        for (int e = 0; e < 16; ++e) {
          const int ix = crow(e, hh) * 64 + cch;
          const float ag = sigmoidf_(bias + acc[e]);
          const float kk = vA[ix], k = vK[ix], rr = vR[ix];
          const float kd = k * (1.0f + (ag - 1.0f) * kav);
          vK[ix] = kd; vA[ix] = -kk; vB[ix] = kk * ag; tmpb[ix] = rr * kd * rkv;
        }
      }
    }
    __syncthreads();
    {
      const int tt = tid >> 3, sub = tid & 7;
      const f32x4 b0 = *(const f32x4*)(tmpb + tt * 64 + sub * 8), b1 = *(const f32x4*)(tmpb + tt * 64 + sub * 8 + 4);
      float bs = (b0.x + b0.y) + (b0.z + b0.w) + (b1.x + b1.y) + (b1.z + b1.w);
      bs += shx<1>(bs); bs += shx<2>(bs); bs += shx<4>(bs);
      if (sub == 0 && rs == 0) bonus[((size_t)(row0 + t0 + tt) * 8 + hd) * 2 + dir] = bs;
    }
    {
      f32x4 va[2], vw[2], vb[2], vk[2], vr[2]; float vi;
      int tt = dir ? 31 : 0;
      int vo = tt * 64 + j8 * 8;
#pragma unroll
      for (int q = 0; q < 2; ++q) { va[q] = *(const f32x4*)(vA + vo + 4 * q); vw[q] = *(const f32x4*)(vW + vo + 4 * q); vb[q] = *(const f32x4*)(vB + vo + 4 * q); vk[q] = *(const f32x4*)(vK + vo + 4 * q); vr[q] = *(const f32x4*)(vR + vo + 4 * q); }
      vi = vV[tt * 64 + irow];
      for (int si = 0; si < 32; ++si) {
        const int ttn = dir ? (si < 31 ? 30 - si : 0) : (si < 31 ? si + 1 : 31);
        const int von = ttn * 64 + j8 * 8;
        f32x2 pa2 = S[0] * (f32x2){va[0].x, va[0].y}, pa3 = S[1] * (f32x2){va[0].z, va[0].w};
        pa2 += S[2] * (f32x2){va[1].x, va[1].y}; pa3 += S[3] * (f32x2){va[1].z, va[1].w};
#pragma unroll
        for (int q = 0; q < 2; ++q) va[q] = *(const f32x4*)(vA + von + 4 * q);
        pa2 += pa3;
        const float sa = osum(pa2.x + pa2.y);
        const f32x2 sa2 = (f32x2){sa, sa}, vi2 = (f32x2){vi, vi};
        f32x2 py2, py3;
        S[0] = S[0] * (f32x2){vw[0].x, vw[0].y} + (sa2 * (f32x2){vb[0].x, vb[0].y} + vi2 * (f32x2){vk[0].x, vk[0].y}); py2 = S[0] * (f32x2){vr[0].x, vr[0].y};
        S[1] = S[1] * (f32x2){vw[0].z, vw[0].w} + (sa2 * (f32x2){vb[0].z, vb[0].w} + vi2 * (f32x2){vk[0].z, vk[0].w}); py3 = S[1] * (f32x2){vr[0].z, vr[0].w};
        S[2] = S[2] * (f32x2){vw[1].x, vw[1].y} + (sa2 * (f32x2){vb[1].x, vb[1].y} + vi2 * (f32x2){vk[1].x, vk[1].y}); py2 += S[2] * (f32x2){vr[1].x, vr[1].y};
        S[3] = S[3] * (f32x2){vw[1].z, vw[1].w} + (sa2 * (f32x2){vb[1].z, vb[1].w} + vi2 * (f32x2){vk[1].z, vk[1].w}); py3 += S[3] * (f32x2){vr[1].z, vr[1].w};
#pragma unroll
        for (int q = 0; q < 2; ++q) { vw[q] = *(const f32x4*)(vW + von + 4 * q); vb[q] = *(const f32x4*)(vB + von + 4 * q); vk[q] = *(const f32x4*)(vK + von + 4 * q); vr[q] = *(const f32x4*)(vR + von + 4 * q); }
        vi = vV[ttn * 64 + irow];
        py2 += py3;
        const float py = osum(py2.x + py2.y);
        ybuf[tt * 32 + lrow] = py;
        tt = ttn;
      }
    }
    __syncthreads();
    {
      const int tt = tid >> 3, sub = tid & 7;
      const f32x4 y0 = *(const f32x4*)(ybuf + tt * 32 + sub * 4);
      u32x2 w; w.x = pack2(y0.x, y0.y); w.y = pack2(y0.z, y0.w);
      *(u32x2*)(Y + (size_t)(row0 + t0 + tt) * 512 + hd * 64 + rs * 32 + sub * 4) = w;
    }
    __syncthreads();
  }
  if (!lat) {
    float* o = opq(p.out) + (dir ? OUT_SB : OUT_SF) + ((size_t)(seq * 4 + l) * 8 + hd) * 4096 + irow * 64 + j8 * 8;
#pragma unroll
    for (int q = 0; q < 2; ++q) *(f32x4*)(o + 4 * q) = (f32x4){S[2 * q].x, S[2 * q].y, S[2 * q + 1].x, S[2 * q + 1].y};
  }
}

DI void phase_mixers(const Params& p, int l, char* smem, int part = 0) {
  const int tid = otid(), wid = __builtin_amdgcn_readfirstlane(tid >> 6);
  unsigned* cnt = (unsigned*)(p.ws + OFF_CNT) + l * 8;
  int* slot = (int*)(smem + SMEM_BYTES - 16);
  bf16_t* U = (bf16_t*)(p.ws + OFF_U);
  const bf16_t* KA = (const bf16_t*)(p.ws + OFF_KA); const bf16_t* VAT = (const bf16_t*)(p.ws + OFF_VAT);
  const bf16_t* KN = (const bf16_t*)(p.ws + OFF_KN); const bf16_t* VBT = (const bf16_t*)(p.ws + OFF_VBT); const bf16_t* KRB = (const bf16_t*)(p.ws + OFF_KRB);
  const int QLEN = 256 + 256 + 128 + 64 + 64;
  bool first = true;
  int xq = blockIdx.x & 7, tries = 0;
  for (;;) {
    int kind, seq, a, qt;
    if (first && blockIdx.x < 256) {
      const int item = blockIdx.x; kind = 0; seq = 32 + (item >> 5); a = (item >> 2) & 7; qt = item & 3;
      first = false;
    } else {
      first = false;
      if (tid == 0) *slot = (int)atomicAdd(cnt + xq, 1u);
      __syncthreads();
      const int i = __builtin_amdgcn_readfirstlane(*slot);
      __syncthreads();
      if (i >= QLEN) { if (++tries >= 8) break; xq = (xq + 1) & 7; continue; }
      if (i < 256) { const int g = xq + 8 * (i >> 7); kind = 1; seq = 32 + (g >> 1); a = g & 1; qt = i & 127; }
      else if (i < 512) { const int j = i - 256; const int g = xq + 8 * (j >> 5); kind = 2; seq = 32 + (g >> 3); a = g & 7; qt = j & 31; }
      else if (i < 640) { const int j = i - 512; kind = 0; seq = xq + 8 * (j >> 5); a = (j >> 2) & 7; qt = j & 3; }
      else if (i < 704) { const int j = i - 640; kind = 1; seq = xq + 8 * (j >> 4); a = (j >> 3) & 1; qt = j & 7; }
      else { const int j = i - 704; kind = 2; seq = xq + 8 * (j >> 4); a = (j >> 1) & 7; qt = j & 1; }
    }
    const int kr0 = keyrow0(seq), Tk = seq_tk(seq);
    const int row0 = seq < 32 ? seq * 256 : NCTX + (seq - 32) * 4096;
    if (kind == 0) scan_item(p, l, seq, a, qt & 1, qt >> 1, smem);
    else if (kind == 1) {
      const int qh = a * 4 + wid;
      bf16_t* q = U + (size_t)(row0 + qt * 32) * ULD + qh * 64;
      attn_item<64>(q, ULD, KA + (size_t)kr0 * 128 + a * 64, 128, nullptr, 0, VAT + (size_t)128 * kr0 + (size_t)(a * 64) * Tk, Tk, Tk, q, ULD, smem);
    } else {
      bf16_t* q = U + (size_t)(row0 + qt * 128 + wid * 32) * ULD + 768 + a * 96;
      attn_item<96>(q, ULD, KN + (size_t)kr0 * 512 + a * 64, 512, KRB + (size_t)kr0 * 32, 32, VBT + (size_t)512 * kr0 + (size_t)(a * 64) * Tk, Tk, Tk, q, ULD, smem);
    }
  }
}

struct CpostIn { u32x4 yf, yb, c, pv, nx; f32x2 bs; };
DI void cpost_load(const Params& p, int row, int lane, CpostIn& in) {
  int seq, t; row_decode(row, seq, t);
  const int T = seq < 32 ? 256 : 4096;
  const bf16_t* YF = (const bf16_t*)(p.ws + OFF_R2); const bf16_t* YB = YF + (size_t)NT * 512;
  const bf16_t* u = (const bf16_t*)(p.ws + OFF_U) + (size_t)row * ULD + 1696;
  const float* bonus = (const float*)(p.ws + OFF_BONUS);
  const int col = 1024 + lane * 8;
  const u32x4 z4 = (u32x4){0u, 0u, 0u, 0u};
  in.yf = *(const u32x4*)(YF + (size_t)row * 512 + lane * 8);
  in.yb = *(const u32x4*)(YB + (size_t)row * 512 + lane * 8);
  in.c = *(const u32x4*)(u + col);
  in.pv = t > 0 ? *(const u32x4*)(u - ULD + col) : z4;
  in.nx = t < T - 1 ? *(const u32x4*)(u + ULD + col) : z4;
  in.bs = *(const f32x2*)(bonus + ((size_t)row * 8 + (lane >> 3)) * 2);
}
DI void cpost_finish(const Params& p, int l, int row, int lane, const CpostIn& in) {
  bf16_t* u = (bf16_t*)(p.ws + OFF_U) + (size_t)row * ULD + 1696;
  float yf[8], yb[8], y[8];
  unpack8(in.yf, yf); unpack8(in.yb, yb);
  float s = 0.f;
#pragma unroll
  for (int i = 0; i < 8; ++i) { y[i] = yf[i] + yb[i]; s += y[i]; }
  s += shx<1>(s); s += shx<2>(s); s += shx<4>(s);
  const float mu = s * (1.0f / 64.0f);
  float q = 0.f;
#pragma unroll
  for (int i = 0; i < 8; ++i) { y[i] -= mu; q += y[i] * y[i]; }
  q += shx<1>(q); q += shx<2>(q); q += shx<4>(q);
  const float rs = rsqrtf(q * (1.0f / 64.0f) + 64e-5f);
  const int col = 1024 + lane * 8;
  float c[8], pv[8], nx[8];
  unpack8(in.c, c); unpack8(in.pv, pv); unpack8(in.nx, nx);
  const float* mup = p.in[I_MUP] + l * 1792 + col; const float* mun = p.in[I_MUN] + l * 1792 + col;
  const float* lw = p.in[I_LNW] + l * 512 + lane * 8; const float* lb = p.in[I_LNB] + l * 512 + lane * 8;
  const float bs = in.bs.x + in.bs.y;
  float o[8];
#pragma unroll
  for (int i = 0; i < 8; ++i) { const float v = c[i] + mup[i] * (pv[i] - c[i]) + mun[i] * (nx[i] - c[i]); o[i] = y[i] * rs * lw[i] + lb[i] + bs * v; }
  *(u32x4*)(u + lane * 8) = pack8(o);
}
DI void phase_renorm_cpost(const Params& p, int l) {
  const int lane = otid() & 63, wid = __builtin_amdgcn_readfirstlane(otid() >> 6);
  for (int item = blockIdx.x; item < NT / 8; item += gridDim.x) { const int ra = item * 8 + wid, rb = ra + 4; CpostIn ia, ib; cpost_load(p, ra, lane, ia); cpost_load(p, rb, lane, ib); norm_rows2(p, l, ra, rb, lane); cpost_finish(p, l, ra, lane, ia); cpost_finish(p, l, rb, lane, ib); }
}

DI void phase_zgemm(const Params& p, char* smem) {
  const bf16_t* H = (const bf16_t*)(p.ws + OFF_R1);
  const bf16_t* W = (const bf16_t*)(p.ws + OFF_WIN) + (size_t)3584 * 1024;
  bf16_t* U = (bf16_t*)(p.ws + OFF_U);
  const int ntiles = 320 * 12;
  for (int it = 0;; ++it) {
    int mt, nt; if (!next_tile(it, 12, 6, mt, nt)) break;
    const int m0 = mt * 128, n0 = nt * 128;
    f32x16 acc[2][2]; zero_acc<2>(acc);
    gemm_mainloop<2>(acc, H + (size_t)m0 * 1024, 1024, 64, W + (size_t)n0 * 1024, 1024, 1024, smem);
    const int lane = otid() & 63, wid = __builtin_amdgcn_readfirstlane(otid() >> 6), wm = wid >> 1, wn = wid & 1, r = lane & 31, hh = lane >> 5;
    bf16_t yv[2][2][16];
    int ucolj[2];
#pragma unroll
    for (int j = 0; j < 2; ++j) {
      const int col = n0 + wn * 64 + j * 32 + r;
      const int br = col >> 9, cc = col & 511;
      ucolj[j] = br == 0 ? cc : (br == 1 ? 768 + (cc >> 6) * 96 + (cc & 63) : 1696 + cc);
#pragma unroll
      for (int i = 0; i < 2; ++i) {
        const bf16_t* up = U + (size_t)(m0 + wm * 64 + i * 32) * ULD;
        const int lo = 4 * hh * ULD + ucolj[j];
#pragma unroll
        for (int e = 0; e < 16; ++e) yv[j][i][e] = (up + crowu(e) * ULD)[lo];
      }
    }
#pragma unroll
    for (int j = 0; j < 2; ++j)
#pragma unroll
      for (int i = 0; i < 2; ++i) {
        bf16_t* up = U + (size_t)(m0 + wm * 64 + i * 32) * ULD;
        const int lo = 4 * hh * ULD + ucolj[j];
#pragma unroll
        for (int e = 0; e < 16; ++e) (up + crowu(e) * ULD)[lo] = f2bf(bf2f(yv[j][i][e]) * siluf_(acc[i][j][e]));
      }
  }
}

DI void phase_merge(const Params& p, char* smem) {
  const bf16_t* H = (const bf16_t*)(p.ws + OFF_R1);
  const bf16_t* WG = (const bf16_t*)(p.ws + OFF_WIN) + (size_t)5120 * 1024;
  const bf16_t* WO = (const bf16_t*)(p.ws + OFF_WO);
  const bf16_t* U = (const bf16_t*)(p.ws + OFF_U);
  bf16_t* MX = (bf16_t*)(p.ws + OFF_R2);
  const int ntiles = 320 * 8;
  for (int it = 0;; ++it) {
    int mt, nt; if (!next_tile(it, 8, 8, mt, nt)) break;
    const int m0 = mt * 128, n0 = nt * 128;
    f32x16 mix[2][2]; zero_acc<2>(mix);
    unsigned gs[2][2][8];
#pragma unroll 1
    for (int step = 0; step < 6; ++step) {
      const int br = step >> 1, isT = step & 1;
      const int acol = br == 0 ? 0 : (br == 1 ? 768 : 1696);
      const bf16_t* Ap = isT ? U + (size_t)m0 * ULD + acol : H + (size_t)m0 * 1024;
      const bf16_t* Bp = isT ? WO + (size_t)(br * 1024 + n0) * 512 : WG + (size_t)(br * 1024 + n0) * 1024;
      f32x16 cur[2][2]; zero_acc<2>(cur);
      gemm_mainloop<2>(cur, Ap, isT ? ULD : 1024, (isT && br == 1) ? 96 : 64, Bp, isT ? 512 : 1024, isT ? 512 : 1024, smem);
      if (isT) {
#pragma unroll
        for (int i = 0; i < 2; ++i)
#pragma unroll
          for (int j = 0; j < 2; ++j)
#pragma unroll
            for (int e = 0; e < 8; ++e) { mix[i][j][2 * e] += lo16(gs[i][j][e]) * cur[i][j][2 * e]; mix[i][j][2 * e + 1] += hi16(gs[i][j][e]) * cur[i][j][2 * e + 1]; }
      } else {
#pragma unroll
        for (int i = 0; i < 2; ++i)
#pragma unroll
          for (int j = 0; j < 2; ++j)
#pragma unroll
            for (int e = 0; e < 8; ++e) gs[i][j][e] = pack2(sigmoidf_(cur[i][j][2 * e]), sigmoidf_(cur[i][j][2 * e + 1]));
      }
    }
    const int lane = otid() & 63, wid = __builtin_amdgcn_readfirstlane(otid() >> 6), wm = wid >> 1, wn = wid & 1, r = lane & 31, hh = lane >> 5;
#pragma unroll
    for (int j = 0; j < 2; ++j) {
      const int col = n0 + wn * 64 + j * 32 + r;
#pragma unroll
      for (int i = 0; i < 2; ++i) {
        bf16_t* mp = MX + (size_t)(m0 + wm * 64 + i * 32) * 1024;
        const int lo = 4 * hh * 1024 + col;
#pragma unroll
        for (int e = 0; e < 16; ++e) (mp + crowu(e) * 1024)[lo] = f2bf(mix[i][j][e]);
      }
    }
  }
}

DI void phase_out(const Params& p, int l, char* smem) {
  const bf16_t* MX = (const bf16_t*)(p.ws + OFF_R2);
  const bf16_t* W = (const bf16_t*)(p.ws + OFF_WOUT);
  const int ntiles = 320 * 8;
  for (int it = 0;; ++it) {
    int mt, nt; if (!next_tile(it, 8, 8, mt, nt)) break;
    const int m0 = mt * 128, n0 = nt * 128;
    f32x16 acc[2][2]; zero_acc<2>(acc);
    gemm_mainloop<2>(acc, MX + (size_t)m0 * 1024, 1024, 64, W + (size_t)n0 * 1024, 1024, 1024, smem);
    const int lane = otid() & 63, wid = __builtin_amdgcn_readfirstlane(otid() >> 6), wm = wid >> 1, wn = wid & 1, r = lane & 31, hh = lane >> 5;
    const int jm = m0 < NCTX ? 0 : 1 + ((m0 - NCTX) >> 12);
    const float* gate = (const float*)(p.ws + OFF_MOD) + ((size_t)l * 9 + jm) * MODLD + 2048;
    const float* xsrc = x_row_ptr(p, l, m0);
    float xv[2][2][16];
#pragma unroll
    for (int j = 0; j < 2; ++j) {
      const int lo = 4 * hh * 1024 + n0 + wn * 64 + j * 32 + r;
#pragma unroll
      for (int i = 0; i < 2; ++i) {
        const float* xs = xsrc + (size_t)(wm * 64 + i * 32) * 1024;
#pragma unroll
        for (int e = 0; e < 16; ++e) xv[j][i][e] = (xs + crowu(e) * 1024)[lo];
      }
    }
#pragma unroll
    for (int j = 0; j < 2; ++j) {
      const int col = n0 + wn * 64 + j * 32 + r;
      const float gv = gate[col];
      const int lo = 4 * hh * 1024 + col;
#pragma unroll
      for (int i = 0; i < 2; ++i) {
        float* xo = p.out + (size_t)(m0 + wm * 64 + i * 32) * 1024;
#pragma unroll
        for (int e = 0; e < 16; ++e) (xo + crowu(e) * 1024)[lo] = xv[j][i][e] + gv * acc[i][j][e];
      }
    }
  }
}

DI void phase_final(const Params& p) {
  const int lane = otid() & 63, wid = __builtin_amdgcn_readfirstlane(otid() >> 6);
  const float* nw = p.in[I_FNW];
  for (int item = blockIdx.x; item < NT / 4; item += gridDim.x) {
    float* x = p.out + (size_t)(item * 4 + wid) * 1024;
    f32x4 v[4]; float ss = 0.f;
#pragma unroll
    for (int i = 0; i < 4; ++i) { v[i] = *(const f32x4*)(x + lane * 4 + 256 * i); ss += v[i].x * v[i].x + v[i].y * v[i].y + v[i].z * v[i].z + v[i].w * v[i].w; }
ss = wave_sum(ss);
    const float rs = rsqrtf(ss * (1.0f / 1024.0f) + 1e-6f);
#pragma unroll
    for (int i = 0; i < 4; ++i) { const f32x4 w = *(const f32x4*)(nw + lane * 4 + 256 * i); *(f32x4*)(x + lane * 4 + 256 * i) = (f32x4){v[i].x * rs * w.x, v[i].y * rs * w.y, v[i].z * rs * w.z, v[i].w * rs * w.w}; }
  }
}

DI void grid_barrier(unsigned* bar, unsigned& epoch) {
  epoch += 1u;
  __syncthreads();
  if (otid() == 0) {
    const unsigned grp = blockIdx.x & 7u, per = gridDim.x >> 3;
    __builtin_amdgcn_fence(__ATOMIC_RELEASE, "agent");
    const unsigned old = __hip_atomic_fetch_add(bar + grp * 32, 1u, __ATOMIC_RELAXED, __HIP_MEMORY_SCOPE_AGENT);
    if (old + 1u == epoch * per) __hip_atomic_fetch_add(bar + 8 * 32, 1u, __ATOMIC_RELAXED, __HIP_MEMORY_SCOPE_AGENT);
    while (__hip_atomic_load(bar + 8 * 32, __ATOMIC_RELAXED, __HIP_MEMORY_SCOPE_AGENT) < epoch * 8u) __builtin_amdgcn_s_sleep(1);
    __builtin_amdgcn_fence(__ATOMIC_ACQUIRE, "agent");
  }
  __syncthreads();
}

constexpr int NPHASES = 1 + 4 * 9 + 1;
__global__ void __launch_bounds__(256, 2) fwd_kernel(Params p0) {
  __shared__ __attribute__((aligned(16))) char smem[SMEM_BYTES];
  cg::grid_group grid = cg::this_grid();
  const int ph_begin = p0.ph_begin, ph_end = p0.ph_end;
  unsigned* bar = (unsigned*)(p0.ws + OFF_BAR);
  unsigned epoch = 0u;
  for (int ph = ph_begin; ph < ph_end; ++ph) {
    auto kp = __builtin_amdgcn_kernarg_segment_ptr();
    asm volatile("" : "+s"(kp));
    typedef const __attribute__((address_space(4))) Params CParams;
    CParams* kpp = (CParams*)kp;
    Params p;
#pragma unroll
    for (int i = 0; i < 35; ++i) p.in[i] = kpp->in[i];
    p.out = kpp->out; p.ws = kpp->ws; p.ph_begin = ph_begin; p.ph_end = ph_end;
    if (ph == 0) phase_prologue(p, smem);
    else if (ph == NPHASES - 1) phase_final(p);
    else {
      const int l = (ph - 1) / 9, sp = (ph - 1) % 9;
#ifdef PROBE_SP
      if (sp == PROBE_SP) {
        switch (sp) {
          case 0: phase_norm_convert(p, l, smem); break;
          case 1: phase_gemm1(p, l, smem); break;
          case 3: phase_upproj(p, smem); break;
          case 5: phase_renorm_cpost(p, l); break;
          case 7: phase_merge(p, smem); break;
          default: break;
        }
        grid.sync();
      }
#endif
      switch (sp) {
        case 0: phase_norm_convert(p, l, smem); break;
        case 1: phase_gemm1(p, l, smem); break;
        case 2: phase_post(p, l); break;
        case 3: phase_upproj(p, smem); break;
        case 4: phase_mixers(p, l, smem); break;
        case 5: phase_renorm_cpost(p, l); break;
        case 6: phase_zgemm(p, smem); break;
        case 7: phase_merge(p, smem); break;
        default: phase_out(p, l, smem); break;
      }
    }
    if (ph + 1 < ph_end) { if (ph == 0) grid.sync(); else grid_barrier(bar, epoch); }
  }
}

extern "C" void kernel_launch(void* const* d_in, const int* in_sizes, int n_in, void* d_out, int out_size, void* d_ws, size_t ws_size, hipStream_t stream) {
  if (ws_size < WS_NEED || n_in < 35) { fprintf(stderr, "workspace too small: %zu < %zu\n", ws_size, WS_NEED); return; }
  static int grid_blocks = 0;
  if (!grid_blocks) {
    int dev = 0, cus = 0, per_cu = 0;
    hipGetDevice(&dev);
    hipDeviceGetAttribute(&cus, hipDeviceAttributeMultiprocessorCount, dev);
    hipOccupancyMaxActiveBlocksPerMultiprocessor(&per_cu, fwd_kernel, 256, 0);
    if (per_cu < 1) per_cu = 1;
    if (per_cu > 2) per_cu = 2;
    grid_blocks = cus * per_cu;
  }
  Params p{};
  for (int i = 0; i < 35; ++i) p.in[i] = (const float*)d_in[i];
  p.out = (float*)d_out; p.ws = (char*)d_ws;
#ifndef ONE_LAUNCH
  for (int ph = 0; ph < NPHASES; ++ph) {
    p.ph_begin = ph; p.ph_end = ph + 1;
    hipLaunchKernelGGL(fwd_kernel, dim3(grid_blocks), dim3(256), 0, stream, p);
  }
#else
  p.ph_begin = 0; p.ph_end = NPHASES;
  hipMemsetAsync((char*)d_ws + OFF_BAR, 0, 4096, stream);
  void* args[] = {&p};
  hipError_t e = hipLaunchCooperativeKernel((void*)fwd_kernel, dim3(grid_blocks), dim3(256), args, 0, stream);
  if (e != hipSuccess) fprintf(stderr, "cooperative launch failed: %s (grid %d)\n", hipGetErrorString(e), grid_blocks);
#endif
}
```

```cpp
#define ONE_LAUNCH 1
#include <hip/hip_runtime.h>
#include <hip/hip_cooperative_groups.h>
#include <stdint.h>
#include <stdio.h>
namespace cg = cooperative_groups;

typedef unsigned short bf16_t;
typedef short bf16x8 __attribute__((ext_vector_type(8)));
typedef float f32x16 __attribute__((ext_vector_type(16)));
typedef float f32x4 __attribute__((ext_vector_type(4)));
typedef float f32x2 __attribute__((ext_vector_type(2)));
typedef unsigned u32x4 __attribute__((ext_vector_type(4)));
typedef unsigned u32x2 __attribute__((ext_vector_type(2)));
#define DI __device__ __forceinline__
#define MFMA32(a, b, c) __builtin_amdgcn_mfma_f32_32x32x16_bf16((a), (b), (c), 0, 0, 0)

constexpr int NT = 40960;
constexpr int NCTX = 8192;
constexpr int NK = 45056;
constexpr int ULD = 3488;
constexpr int MODLD = 3072;
constexpr int SMEM_BYTES = 78848;

constexpr size_t OFF_WIN = 0;
constexpr size_t OFF_WO = 16777216;
constexpr size_t OFF_WOUT = 19922944;
constexpr size_t OFF_WU = 22020096;
constexpr size_t OFF_MOD = 22282240;
constexpr size_t OFF_BONUS = 22724608;
constexpr size_t OFF_CS16 = 25346048;
constexpr size_t OFF_CS8 = 25354240;
constexpr size_t OFF_CNT = 25358336;
constexpr size_t OFF_BAR = 524742912;
constexpr size_t OFF_U = 25358592;
constexpr size_t OFF_R1 = 311095552;
constexpr size_t OFF_KA = OFF_R1;
constexpr size_t OFF_VAT = 513208576;
constexpr size_t OFF_KN = OFF_R1 + 23068672;
constexpr size_t OFF_VBT = OFF_R1 + 69206016;
constexpr size_t OFF_KRB = OFF_R1 + 115343360;
constexpr size_t OFF_R2 = 429322496;
constexpr size_t WS_NEED = 524742912 + 4096;

constexpr size_t OUT_AK = 41943040, OUT_AV = 46137344, OUT_CKV = 50331648, OUT_KR = 54525952, OUT_SF = 55574528, OUT_SB = 59768832;

struct Params {
  const float* in[35];
  float* out;
  char* ws;
  int ph_begin, ph_end;
};

enum { I_XP = 0, I_XS, I_CAK, I_CAV, I_CCKV, I_CKR, I_SF, I_SB, I_C, I_CCTX, I_NORMW, I_WMOD, I_BMOD, I_WIN, I_QNW, I_KNW, I_KVNW,
       I_WUK, I_WUV, I_MUP, I_MUN, I_W0, I_WUP, I_A0, I_AUP, I_KK, I_KA, I_RK, I_LNW, I_LNB, I_WOA, I_WOB, I_WOC, I_WOUT, I_FNW };

DI int threadIdx_x_raw() { return __builtin_amdgcn_workitem_id_x(); }
DI int otid() { int t = threadIdx_x_raw(); asm volatile("" : "+v"(t)); return t; }
DI const float* opq(const float* q) { asm volatile("" : "+s"(q)); return q; }
DI float* opq(float* q) { asm volatile("" : "+s"(q)); return q; }
DI float bf2f(bf16_t v) { return __uint_as_float(((unsigned)v) << 16); }
typedef __bf16 hbf16x2 __attribute__((ext_vector_type(2)));
DI unsigned pack2(float a, float b) { f32x2 v = {a, b}; hbf16x2 r = __builtin_convertvector(v, hbf16x2); return __builtin_bit_cast(unsigned, r); }
DI bf16_t f2bf(float x) { return (bf16_t)(pack2(x, 0.f) & 0xffffu); }
DI float xsum16(float x) { const unsigned u = __float_as_uint(x); auto r = __builtin_amdgcn_permlane16_swap(u, u, false, false); return __uint_as_float(r[0]) + __uint_as_float(r[1]); }
DI float xsum32(float x) { const unsigned u = __float_as_uint(x); auto r = __builtin_amdgcn_permlane32_swap(u, u, false, false); return __uint_as_float(r[0]) + __uint_as_float(r[1]); }
DI float lo16(unsigned w) { return __uint_as_float(w << 16); }
DI float hi16(unsigned w) { return __uint_as_float(w & 0xffff0000u); }
DI void unpack8(u32x4 w, float* v) { v[0] = lo16(w.x); v[1] = hi16(w.x); v[2] = lo16(w.y); v[3] = hi16(w.y); v[4] = lo16(w.z); v[5] = hi16(w.z); v[6] = lo16(w.w); v[7] = hi16(w.w); }
DI u32x4 pack8(const float* v) { u32x4 w; w.x = pack2(v[0], v[1]); w.y = pack2(v[2], v[3]); w.z = pack2(v[4], v[5]); w.w = pack2(v[6], v[7]); return w; }
template <int K> DI float shx(float v) { return __int_as_float(__builtin_amdgcn_ds_swizzle(__float_as_int(v), 0x1f | (K << 10))); }
DI float wave_sum(float v) { v += shx<1>(v); v += shx<2>(v); v += shx<4>(v); v += shx<8>(v); v += shx<16>(v); return xsum32(v); }
DI float qsum(float v) {
  v += __int_as_float(__builtin_amdgcn_update_dpp(0, __float_as_int(v), 0xB1, 0xf, 0xf, true));
  v += __int_as_float(__builtin_amdgcn_update_dpp(0, __float_as_int(v), 0x4E, 0xf, 0xf, true));
  return v;
}
DI float osum(float v) {
  v = qsum(v);
  v += __int_as_float(__builtin_amdgcn_update_dpp(0, __float_as_int(v), 0x141, 0xf, 0xf, true));
  return v;
}
DI int crow(int reg, int h) { return (reg & 3) + 8 * (reg >> 2) + 4 * h; }
DI int crowu(int reg) { return (reg & 3) + 8 * (reg >> 2); }
DI int perm16(int t) { return (t & ~12) | ((t & 4) << 1) | ((t & 8) >> 1); }
DI float sigmoidf_(float x) { return __builtin_amdgcn_rcpf(1.0f + __expf(-x)); }
DI float siluf_(float x) { return x * __builtin_amdgcn_rcpf(1.0f + __expf(-x)); }

DI void row_decode(int row, int& seq, int& t) {
  if (row < NCTX) { seq = row >> 8; t = row & 255; } else { seq = 32 + ((row - NCTX) >> 12); t = (row - NCTX) & 4095; }
}
DI int keyrow0(int seq) { return seq < 32 ? seq * 256 : NCTX + (seq - 32) * 4608; }
DI int seq_tk(int seq) { return seq < 32 ? 256 : 4608; }

typedef __attribute__((address_space(3))) unsigned lds_u32;
template <int NJ>
DI void gemm_mainloop(f32x16 (&acc)[2][NJ], const bf16_t* __restrict__ A, int lda, int ks,
                      const bf16_t* __restrict__ Bt, int ldb, int K, char* smem) {
  constexpr int A_BYTES = 128 * 128;
  constexpr int B_BYTES = 64 * NJ * 128;
  constexpr int STAGE = A_BYTES + B_BYTES;
  const int tid = otid(), lane = tid & 63, wid = __builtin_amdgcn_readfirstlane(tid >> 6), wm = wid >> 1, wn = wid & 1;
  const int r = lane & 31, hh = lane >> 5;
  const int nk = K >> 6;
  const int lrow = tid >> 3, lc = tid & 7;
  const int gc = (lc ^ ((lrow >> 1) & 7)) * 8;
  const bf16_t* ap = A + (size_t)lrow * lda + gc;
  const bf16_t* bp = Bt + (size_t)lrow * ldb + gc;
  auto issue = [&](int kt, int buf) {
    char* base = smem + buf * STAGE + tid * 16;
    const bf16_t* ap2 = ap + (size_t)kt * ks;
    const bf16_t* bp2 = bp + (size_t)kt * 64;
#pragma unroll
    for (int p = 0; p < 4; ++p) __builtin_amdgcn_global_load_lds((const unsigned*)(ap2 + (size_t)(32 * p) * lda), (lds_u32*)(base + p * 4096), 16, 0, 0);
#pragma unroll
    for (int p = 0; p < 2 * NJ; ++p) __builtin_amdgcn_global_load_lds((const unsigned*)(bp2 + (size_t)(32 * p) * ldb), (lds_u32*)(base + A_BYTES + p * 4096), 16, 0, 0);
  };
  issue(0, 0);
  __syncthreads();
#pragma unroll 1
  for (int kt = 0; kt < nk; ++kt) {
    if (kt + 1 < nk) issue(kt + 1, (kt + 1) & 1);
    const char* base = smem + (kt & 1) * STAGE;
#pragma unroll
    for (int s = 0; s < 4; ++s) {
      bf16x8 af[2], bfr[NJ];
#pragma unroll
      for (int i = 0; i < 2; ++i) { const int row = wm * 64 + i * 32 + r; af[i] = *(const bf16x8*)(base + row * 128 + (((2 * s + hh) ^ ((row >> 1) & 7)) << 4)); }
#pragma unroll
      for (int j = 0; j < NJ; ++j) { const int row = wn * (32 * NJ) + j * 32 + r; bfr[j] = *(const bf16x8*)(base + A_BYTES + row * 128 + (((2 * s + hh) ^ ((row >> 1) & 7)) << 4)); }
#pragma unroll
      for (int i = 0; i < 2; ++i)
#pragma unroll
        for (int j = 0; j < NJ; ++j) acc[i][j] = MFMA32(af[i], bfr[j], acc[i][j]);
    }
    __syncthreads();
  }
}

template <int NJ> DI void zero_acc(f32x16 (&acc)[2][NJ]) {
#pragma unroll
  for (int i = 0; i < 2; ++i)
#pragma unroll
    for (int j = 0; j < NJ; ++j)
#pragma unroll
      for (int e = 0; e < 16; ++e) acc[i][j][e] = 0.f;
}

DI void phase_prologue(const Params& p, char* smem) {
  const int tid = otid(), lane = tid & 63, wid = __builtin_amdgcn_readfirstlane(tid >> 6);
  float* mod = (float*)(p.ws + OFF_MOD);
  if (blockIdx.x == 0) {
    if (tid < 32) ((unsigned*)(p.ws + OFF_CNT))[tid] = 0u;
    float* cs16 = (float*)(p.ws + OFF_CS16);
    float* cs8 = (float*)(p.ws + OFF_CS8);
    for (int e = tid; e < 64 * 16; e += 256) { const int pos = e >> 4, i = e & 15; const float inv = expf(-9.210340371976184f * (float)i / 16.0f); const float a = (float)pos * inv; cs16[e * 2] = cosf(a); cs16[e * 2 + 1] = sinf(a); }
    for (int e = tid; e < 64 * 8; e += 256) { const int pos = e >> 3, i = e & 7; const float inv = expf(-9.210340371976184f * (float)i / 8.0f); const float a = (float)pos * inv; cs8[e * 2] = cosf(a); cs8[e * 2 + 1] = sinf(a); }
  }
  float* sl = (float*)smem;
  float* red = sl + 9 * 1024;
  for (int e = tid; e < 9 * 1024; e += 256) { const int j = e >> 10, k = e & 1023; const float* cc0 = opq(p.in[I_CCTX]); const float* cc1 = opq(p.in[I_C]); const float c = j == 0 ? cc0[k] : cc1[(j - 1) * 1024 + k]; sl[e] = siluf_(c); }
  __syncthreads();
  for (int item = blockIdx.x; item < 192; item += gridDim.x) {
    const int l = item / 48, n = (item % 48) * 64 + lane;
    const float* w = p.in[I_WMOD] + (size_t)l * 1024 * 3072 + n;
    float a[9];
#pragma unroll
    for (int j = 0; j < 9; ++j) a[j] = 0.f;
    for (int k = wid * 256; k < wid * 256 + 256; ++k) {
      const float wv = w[(size_t)k * 3072];
#pragma unroll
      for (int j = 0; j < 9; ++j) a[j] += sl[j * 1024 + k] * wv;
    }
#pragma unroll
    for (int j = 0; j < 9; ++j) red[(wid * 9 + j) * 64 + lane] = a[j];
    __syncthreads();
    for (int e = tid; e < 9 * 64; e += 256) {
      const int j = e >> 6, c = e & 63;
      const float s = red[(0 * 9 + j) * 64 + c] + red[(1 * 9 + j) * 64 + c] + red[(2 * 9 + j) * 64 + c] + red[(3 * 9 + j) * 64 + c];
      const int nn = (item % 48) * 64 + c;
      mod[((size_t)l * 9 + j) * MODLD + nn] = s + p.in[I_BMOD][l * 3072 + nn];
    }
    __syncthreads();
  }
}

DI const float* x_row_ptr(const Params& p, int l, int row) {
  const float* xp = opq(p.in[I_XP]); const float* xs = opq(p.in[I_XS]); const float* xo = opq((const float*)p.out);
  if (l == 0) return row < NCTX ? xp + (size_t)row * 1024 : xs + (size_t)(row - NCTX) * 1024;
  return xo + (size_t)row * 1024;
}
DI void norm_row(const Params& p, int l, int row, int lane) {
  const float* x = x_row_ptr(p, l, row);
  const int j = row < NCTX ? 0 : 1 + ((row - NCTX) >> 12);
  const float* mod = (const float*)(p.ws + OFF_MOD) + ((size_t)l * 9 + j) * MODLD;
  const float* nw = p.in[I_NORMW] + l * 1024;
  bf16_t* h = (bf16_t*)(p.ws + OFF_R1) + (size_t)row * 1024;
  f32x4 v[4]; float ss = 0.f;
#pragma unroll
  for (int i = 0; i < 4; ++i) { v[i] = *(const f32x4*)(x + lane * 4 + 256 * i); ss += v[i].x * v[i].x + v[i].y * v[i].y + v[i].z * v[i].z + v[i].w * v[i].w; }
ss = wave_sum(ss);
  const float rs = rsqrtf(ss * (1.0f / 1024.0f) + 1e-6f);
#pragma unroll
  for (int i = 0; i < 4; ++i) {
    const int c = lane * 4 + 256 * i;
    const f32x4 w = *(const f32x4*)(nw + c), sh = *(const f32x4*)(mod + c), sc = *(const f32x4*)(mod + 1024 + c);
    u32x2 o;
    o.x = pack2(v[i].x * rs * w.x * (1.f + sc.x) + sh.x, v[i].y * rs * w.y * (1.f + sc.y) + sh.y);
    o.y = pack2(v[i].z * rs * w.z * (1.f + sc.z) + sh.z, v[i].w * rs * w.w * (1.f + sc.w) + sh.w);
    *(u32x2*)(h + c) = o;
  }
}

DI void norm_rows2(const Params& p, int l, int rowa, int rowb, int lane) {
  const float* xa = x_row_ptr(p, l, rowa); const float* xb = x_row_ptr(p, l, rowb);
  f32x4 va[4], vb[4];
#pragma unroll
  for (int i = 0; i < 4; ++i) va[i] = *(const f32x4*)(xa + lane * 4 + 256 * i);
#pragma unroll
  for (int i = 0; i < 4; ++i) vb[i] = *(const f32x4*)(xb + lane * 4 + 256 * i);
  const float* nw = p.in[I_NORMW] + l * 1024;
#pragma unroll
  for (int rr = 0; rr < 2; ++rr) {
    const int row = rr ? rowb : rowa;
    f32x4 (&v)[4] = rr ? vb : va;
    const int j = row < NCTX ? 0 : 1 + ((row - NCTX) >> 12);
    const float* mod = (const float*)(p.ws + OFF_MOD) + ((size_t)l * 9 + j) * MODLD;
    bf16_t* h = (bf16_t*)(p.ws + OFF_R1) + (size_t)row * 1024;
    float ss = 0.f;
#pragma unroll
    for (int i = 0; i < 4; ++i) ss += v[i].x * v[i].x + v[i].y * v[i].y + v[i].z * v[i].z + v[i].w * v[i].w;
    ss = wave_sum(ss);
    const float rs = rsqrtf(ss * (1.0f / 1024.0f) + 1e-6f);
#pragma unroll
    for (int i = 0; i < 4; ++i) {
      const int c = lane * 4 + 256 * i;
      const f32x4 w = *(const f32x4*)(nw + c), sh = *(const f32x4*)(mod + c), sc = *(const f32x4*)(mod + 1024 + c);
      u32x2 o;
      o.x = pack2(v[i].x * rs * w.x * (1.f + sc.x) + sh.x, v[i].y * rs * w.y * (1.f + sc.y) + sh.y);
      o.y = pack2(v[i].z * rs * w.z * (1.f + sc.z) + sh.z, v[i].w * rs * w.w * (1.f + sc.w) + sh.w);
      *(u32x2*)(h + c) = o;
    }
  }
}

DI int win_srccol(int j) {
  if (j < 768) return j;
  if (j < 1696) return j + 512;
  if (j < 3488) return j + 1024;
  if (j < 3584) return -1;
  if (j < 5120) { const int jj = j - 3584; return jj < 512 ? 768 + jj : (jj < 1024 ? 2208 + (jj - 512) : 4512 + (jj - 1024)); }
  return 5024 + (j - 5120);
}
DI void conv_tile(const float* __restrict__ src, int ld_src, bf16_t* dst, int ld_dst, int k0, int n0, int kind, int srcoff, char* smem) {
  float* tile = (float*)smem;
  const int tid = otid();
  const int n = tid & 63;
  int sc = kind == 0 ? win_srccol(n0 + n) : (n0 + n - srcoff);
#pragma unroll
  for (int i = 0; i < 16; ++i) { const int k = i * 4 + (tid >> 6); tile[k * 65 + n] = sc >= 0 ? src[(size_t)(k0 + k) * ld_src + sc] : 0.f; }
  __syncthreads();
#pragma unroll
  for (int i = 0; i < 8; ++i) { const int nn = i * 8 + (tid >> 5), kk = (tid & 31) * 2; *(unsigned*)(dst + (size_t)(n0 + nn) * ld_dst + k0 + kk) = pack2(tile[kk * 65 + nn], tile[(kk + 1) * 65 + nn]); }
  __syncthreads();
}

DI void phase_norm_convert(const Params& p, int l, char* smem) {
  const int tid = otid(), lane = tid & 63, wid = __builtin_amdgcn_readfirstlane(tid >> 6);
  bf16_t* WinT = (bf16_t*)(p.ws + OFF_WIN); bf16_t* WoT = (bf16_t*)(p.ws + OFF_WO); bf16_t* WoutT = (bf16_t*)(p.ws + OFF_WOUT); bf16_t* WuT = (bf16_t*)(p.ws + OFF_WU);
  const int NI_WIN = 128 * 16, NI_WO = 3 * 16 * 8, NI_WOUT = 16 * 16, NI_WU = 16 * 2;
  const int NI_CONV = NI_WIN + NI_WO + NI_WOUT + NI_WU;
  for (int item = blockIdx.x; item < NI_CONV; item += gridDim.x) {
    int it = item;
    if (it < NI_WIN) { conv_tile(p.in[I_WIN] + (size_t)l * 1024 * 8096, 8096, WinT, 1024, (it & 15) * 64, (it >> 4) * 64, 0, 0, smem); continue; }
    it -= NI_WIN;
    if (it < NI_WO) { const int br = it / 128, r2 = it % 128; const float* src = (br == 0 ? opq(p.in[I_WOA]) : (br == 1 ? opq(p.in[I_WOB]) : opq(p.in[I_WOC]))) + (size_t)l * 512 * 1024; conv_tile(src, 1024, WoT + (size_t)br * 1024 * 512, 512, (r2 & 7) * 64, (r2 >> 3) * 64, 1, 0, smem); continue; }
    it -= NI_WO;
    if (it < NI_WOUT) { conv_tile(p.in[I_WOUT] + (size_t)l * 1024 * 1024, 1024, WoutT, 1024, (it & 15) * 64, (it >> 4) * 64, 1, 0, smem); continue; }
    it -= NI_WOUT;
    { const int nt = it >> 1, kt = it & 1; const bool uv = nt >= 8; const float* src = (uv ? opq(p.in[I_WUV]) : opq(p.in[I_WUK])) + (size_t)l * 128 * 512; conv_tile(src, 512, WuT, 128, kt * 64, nt * 64, 1, uv ? 512 : 0, smem); }
  }
  for (int item = blockIdx.x; item < NT / 8; item += gridDim.x) norm_rows2(p, l, item * 8 + wid, item * 8 + 4 + wid, lane);
}

DI bool next_tile(int it, int NTN, int GN, int& mt, int& nt, int MPX = 40, int GM = 8) {
  if (gridDim.x == 512) {
    const int x = blockIdx.x & 7, local = blockIdx.x >> 3;
    const int q = it * 64 + local;
    if (q >= MPX * NTN) return false;
    const int gsz = GM * GN, g = q / gsz, w = q - g * gsz, ngroups = NTN / GN;
    const int mgi = g / ngroups, ngi = g - mgi * ngroups;
    mt = x * MPX + mgi * GM + w / GN; nt = ngi * GN + (w % GN);
    return true;
  }
  const int tile = blockIdx.x + it * gridDim.x;
  if (tile >= 8 * MPX * NTN) return false;
  mt = tile / NTN; nt = tile % NTN;
  return true;
}

DI void phase_gemm1(const Params& p, int l, char* smem) {
  const bf16_t* H = (const bf16_t*)(p.ws + OFF_R1);
  const bf16_t* W = (const bf16_t*)(p.ws + OFF_WIN);
  bf16_t* U = (bf16_t*)(p.ws + OFF_U);
  bf16_t* VAT = (bf16_t*)(p.ws + OFF_VAT);
  const int NTN = 28, ntiles = 320 * NTN;
  for (int it = 0;; ++it) {
    int mt, nt; if (!next_tile(it, NTN, 7, mt, nt)) break;
    const int m0 = mt * 128, n0 = nt * 128;
    f32x16 acc[2][2]; zero_acc<2>(acc);
    gemm_mainloop<2>(acc, H + (size_t)m0 * 1024, 1024, 64, W + (size_t)n0 * 1024, 1024, 1024, smem);
    const int lane = otid() & 63, wid = __builtin_amdgcn_readfirstlane(otid() >> 6), wm = wid >> 1, wn = wid & 1, r = lane & 31, hh = lane >> 5;
    int seq, t0; row_decode(m0, seq, t0);
#pragma unroll
    for (int j = 0; j < 2; ++j) {
      const int cb = n0 + wn * 64 + j * 32;
      if (cb >= ULD) continue;
      const int col = cb + r;
      if (cb >= 640 && cb < 768) {
        const int kvh = (col - 640) >> 6, dv = col & 63, Tk = seq_tk(seq);
        bf16_t* vt = VAT + (size_t)128 * keyrow0(seq) + (size_t)(kvh * 64 + dv) * Tk;
#pragma unroll
        for (int i = 0; i < 2; ++i) {
          const int tt = t0 + wm * 64 + i * 32;
#pragma unroll
          for (int g2 = 0; g2 < 2; ++g2) {
            float v[8];
#pragma unroll
            for (int e = 0; e < 8; ++e) v[e] = acc[i][j][g2 * 8 + e];
            *(u32x4*)(vt + tt + 16 * g2 + 8 * hh) = pack8(v);
          }
          if (seq < 32) {
            float* o = p.out + OUT_AV + ((size_t)(seq * 4 + l) * 256 + tt) * 128;
            const int lo = 4 * hh * 128 + (col - 640);
#pragma unroll
            for (int e = 0; e < 16; ++e) (o + crowu(e) * 128)[lo] = acc[i][j][e];
          }
        }
      } else {
#pragma unroll
        for (int i = 0; i < 2; ++i) {
          bf16_t* up = U + (size_t)(m0 + wm * 64 + i * 32) * ULD;
          const int lo = 4 * hh * ULD + col;
#pragma unroll
          for (int e = 0; e < 16; ++e) (up + crowu(e) * ULD)[lo] = f2bf(acc[i][j][e]);
        }
      }
    }
  }
}

struct PostIn { u32x4 q, k, bq; u32x2 br; unsigned ckv; bf16_t kr; };
DI void post_load(const Params& p, int row, int lane, PostIn& in) {
  const bf16_t* u = (const bf16_t*)(p.ws + OFF_U) + (size_t)row * ULD;
  in.q = *(const u32x4*)(u + lane * 8);
  in.k = *(const u32x4*)(u + 512 + (lane & 15) * 8);
  in.bq = *(const u32x4*)(u + 768 + (lane >> 3) * 96 + (lane & 7) * 8);
  in.br = *(const u32x2*)(u + 768 + (lane >> 3) * 96 + 64 + (lane & 7) * 4);
  in.ckv = *(const unsigned*)(u + 1536 + lane * 2);
  in.kr = u[1664 + (lane & 31)];
}
DI void post_row(const Params& p, int l, int row, int lane, const PostIn& in) {
  int seq, t; row_decode(row, seq, t);
  const bool lat = row >= NCTX;
  const int krow = keyrow0(seq) + t;
  const int prow = t >> 6, pcol = t & 63;
  bf16_t* u = (bf16_t*)(p.ws + OFF_U) + (size_t)row * ULD;
  const float* cs16 = (const float*)(p.ws + OFF_CS16);
  const float* cs8 = (const float*)(p.ws + OFF_CS8);
  const float LOG2E = 1.4426950408889634f;
#pragma unroll
  for (int which = 0; which < 2; ++which) {
    const int l8 = which == 0 ? lane : (lane & 15);
    float v[8]; unpack8(which == 0 ? in.q : in.k, v);
    float ss = 0.f;
#pragma unroll
    for (int i = 0; i < 8; ++i) ss += v[i] * v[i];
    ss += shx<1>(ss); ss += shx<2>(ss); ss += shx<4>(ss);
    const float rs = rsqrtf(ss * (1.0f / 64.0f) + 1e-6f);
    const float* nw = (which == 0 ? opq(p.in[I_QNW]) : opq(p.in[I_KNW])) + l * 64 + (lane & 7) * 8;
#pragma unroll
    for (int i = 0; i < 8; ++i) v[i] = v[i] * rs * nw[i];
    float pv[8];
#pragma unroll
    for (int i = 0; i < 8; ++i) pv[i] = shx<2>(v[i]);
    if (lat) {
      const int pos = ((lane & 7) >> 2) ? pcol : prow;
      const bool lower = (lane & 2) == 0;
      const float* cs = cs16 + (pos * 16 + (lane & 1) * 8) * 2;
#pragma unroll
      for (int i = 0; i < 8; ++i) { const float c = cs[i * 2], s = cs[i * 2 + 1]; v[i] = lower ? v[i] * c - pv[i] * s : v[i] * c + pv[i] * s; }
    }
    if (which == 0) {
      const float sc = 0.125f * LOG2E;
#pragma unroll
      for (int i = 0; i < 8; ++i) v[i] *= sc;
      *(u32x4*)(u + lane * 8) = pack8(v);
    } else if (lane < 16) {
      bf16_t* KA = (bf16_t*)(p.ws + OFF_KA);
      *(u32x4*)(KA + (size_t)krow * 128 + lane * 8) = pack8(v);
      if (!lat) {
        float* o = p.out + OUT_AK + ((size_t)(seq * 4 + l) * 256 + t) * 128 + lane * 8;
        *(f32x4*)o = (f32x4){v[0], v[1], v[2], v[3]}; *(f32x4*)(o + 4) = (f32x4){v[4], v[5], v[6], v[7]};
      }
    }
  }
  {
    const float sc = 0.10206207261596577f * LOG2E;
    const int hd = lane >> 3;
    bf16_t* q = u + 768 + hd * 96;
    { float v[8]; unpack8(in.bq, v);
#pragma unroll
      for (int i = 0; i < 8; ++i) v[i] *= sc;
      *(u32x4*)(q + (lane & 7) * 8) = pack8(v); }
    { bf16_t* qr = q + 64 + (lane & 7) * 4;
      const u32x2 w = in.br;
      float v[4] = {lo16(w.x), hi16(w.x), lo16(w.y), hi16(w.y)}, pv[4];
#pragma unroll
      for (int i = 0; i < 4; ++i) pv[i] = shx<2>(v[i]);
      if (lat) {
        const int pos = ((lane & 7) >> 2) ? pcol : prow;
        const bool lower = (lane & 2) == 0;
        const float* cs = cs8 + (pos * 8 + (lane & 1) * 4) * 2;
#pragma unroll
        for (int i = 0; i < 4; ++i) { const float c = cs[i * 2], s = cs[i * 2 + 1]; v[i] = lower ? v[i] * c - pv[i] * s : v[i] * c + pv[i] * s; }
      }
      u32x2 o; o.x = pack2(v[0] * sc, v[1] * sc); o.y = pack2(v[2] * sc, v[3] * sc);
      *(u32x2*)qr = o; }
  }
  {
    const unsigned w = in.ckv;
    float a = lo16(w), b = hi16(w);
    float ss = a * a + b * b;
ss = wave_sum(ss);
    const float rs = rsqrtf(ss * (1.0f / 128.0f) + 1e-6f);
    const float* nw = p.in[I_KVNW] + l * 128 + lane * 2;
    a = a * rs * nw[0]; b = b * rs * nw[1];
    bf16_t* CKVN = (bf16_t*)(p.ws + OFF_R2);
    *(unsigned*)(CKVN + (size_t)krow * 128 + lane * 2) = pack2(a, b);
    if (!lat) { float* o = p.out + OUT_CKV + ((size_t)(seq * 4 + l) * 256 + t) * 128 + lane * 2; *(f32x2*)o = (f32x2){a, b}; }
  }
  {
    float v = bf2f(in.kr);
    const float pv = shx<8>(v);
    if (!lat) { if (lane < 32) p.out[OUT_KR + ((size_t)(seq * 4 + l) * 256 + t) * 32 + lane] = v; }
    else {
      const int d = lane & 31; const int pos = (d >> 4) ? pcol : prow; const bool lower = (d & 8) == 0;
      const float* cs = cs8 + (pos * 8 + (d & 7)) * 2;
      v = lower ? v * cs[0] - pv * cs[1] : v * cs[0] + pv * cs[1];
    }
    if (lane < 32) ((bf16_t*)(p.ws + OFF_KRB))[(size_t)krow * 32 + lane] = f2bf(v);
  }
}
DI void post_cached_row(const Params& p, int l, int idx, int lane) {
  const int b = idx >> 9, j = idx & 511;
  const int kr0 = NCTX + b * 4608, krow = kr0 + 4096 + j;
  const size_t cb = ((size_t)(b * 4 + l) * 512 + j);
  bf16_t* KA = (bf16_t*)(p.ws + OFF_KA); bf16_t* VAT = (bf16_t*)(p.ws + OFF_VAT); bf16_t* CKVN = (bf16_t*)(p.ws + OFF_R2); bf16_t* KRB = (bf16_t*)(p.ws + OFF_KRB);
  { const f32x2 v = *(const f32x2*)(p.in[I_CAK] + cb * 128 + lane * 2); *(unsigned*)(KA + (size_t)krow * 128 + lane * 2) = pack2(v.x, v.y); }
  { const f32x2 v = *(const f32x2*)(p.in[I_CAV] + cb * 128 + lane * 2);
    bf16_t* vt = VAT + (size_t)128 * kr0 + (size_t)(lane * 2) * 4608 + perm16(4096 + j);
    vt[0] = f2bf(v.x); vt[4608] = f2bf(v.y); }
  { const f32x2 v = *(const f32x2*)(p.in[I_CCKV] + cb * 128 + lane * 2); *(unsigned*)(CKVN + (size_t)krow * 128 + lane * 2) = pack2(v.x, v.y); }
  if (lane < 32) KRB[(size_t)krow * 32 + lane] = f2bf(p.in[I_CKR][cb * 32 + lane]);
}
DI void phase_post(const Params& p, int l) {
  const int lane = otid() & 63, wid = __builtin_amdgcn_readfirstlane(otid() >> 6);
  for (int item = blockIdx.x; item < NT / 8 + 1024; item += gridDim.x) {
    if (item < NT / 8) {
      const int ra = item * 8 + wid, rb = ra + 4;
      PostIn ia, ib; post_load(p, ra, lane, ia); post_load(p, rb, lane, ib);
      post_row(p, l, ra, lane, ia); post_row(p, l, rb, lane, ib);
    }
    else post_cached_row(p, l, (item - NT / 8) * 4 + wid, lane);
  }
}

DI void phase_upproj(const Params& p, char* smem) {
  const bf16_t* A = (const bf16_t*)(p.ws + OFF_R2);
  const bf16_t* W = (const bf16_t*)(p.ws + OFF_WU);
  bf16_t* KN = (bf16_t*)(p.ws + OFF_KN); bf16_t* VBT = (bf16_t*)(p.ws + OFF_VBT);
  const int ntiles = 352 * 8;
  for (int it = 0;; ++it) {
    int mt, nt; if (!next_tile(it, 8, 8, mt, nt, 44, 4)) break;
    const int m0 = mt * 128, n0 = nt * 128;
    f32x16 acc[2][2]; zero_acc<2>(acc);
    gemm_mainloop<2>(acc, A + (size_t)m0 * 128, 128, 64, W + (size_t)n0 * 128, 128, 128, smem);
    const int lane = otid() & 63, wid = __builtin_amdgcn_readfirstlane(otid() >> 6), wm = wid >> 1, wn = wid & 1, r = lane & 31, hh = lane >> 5;
    int seq, t0;
    if (m0 < NCTX) { seq = m0 >> 8; t0 = m0 & 255; } else { const int rr = m0 - NCTX; seq = 32 + rr / 4608; t0 = rr % 4608; }
#pragma unroll
    for (int j = 0; j < 2; ++j) {
      const int col = n0 + wn * 64 + j * 32 + r;
      if (n0 < 512) {
#pragma unroll
        for (int i = 0; i < 2; ++i) {
          bf16_t* kp = KN + (size_t)(m0 + wm * 64 + i * 32) * 512;
          const int lo = 4 * hh * 512 + col;
#pragma unroll
          for (int e = 0; e < 16; ++e) (kp + crowu(e) * 512)[lo] = f2bf(acc[i][j][e]);
        }
      } else {
        const int Tk = seq_tk(seq);
        bf16_t* vt = VBT + (size_t)512 * keyrow0(seq) + (size_t)(col - 512) * Tk;
#pragma unroll
        for (int i = 0; i < 2; ++i) {
          const int tt = t0 + wm * 64 + i * 32;
#pragma unroll
          for (int g2 = 0; g2 < 2; ++g2) {
            float v[8];
#pragma unroll
            for (int e = 0; e < 8; ++e) v[e] = acc[i][j][g2 * 8 + e];
            *(u32x4*)(vt + tt + 16 * g2 + 8 * hh) = pack8(v);
          }
        }
      }
    }
  }
}

template <int DQK>
DI void attn_item(const bf16_t* Qw, int q_ld, const bf16_t* K1, int k1_ld, const bf16_t* K2, int k2_ld,
                  const bf16_t* Vt, int vt_ld, int nkeys, bf16_t* Ow, int o_ld, char* smem) {
  constexpr int KS = DQK * 2 + 16;
  constexpr int KBYTES = 64 * KS;
  constexpr int VS = 144;
  constexpr int VBYTES = 64 * VS;
  constexpr int STAGE = KBYTES + VBYTES;
  constexpr int CPR = DQK / 8;
  constexpr int NKC = 64 * CPR / 256;
  constexpr int NS = DQK / 16;
  const int tid = otid(), lane = tid & 63, r = lane & 31, hh = lane >> 5;
  bf16x8 qf[NS];
#pragma unroll
  for (int s = 0; s < NS; ++s) qf[s] = *(const bf16x8*)(Qw + (size_t)r * q_ld + 16 * s + 8 * hh);
  f32x16 o[2];
#pragma unroll
  for (int n = 0; n < 2; ++n)
#pragma unroll
    for (int e = 0; e < 16; ++e) o[n][e] = 0.f;
  float m_run = 0.f, lsum = 0.f;
  u32x4 rk0[NKC], rv0[2], rk1[NKC], rv1[2];
  int krow_[NKC], kc_[NKC];
#pragma unroll
  for (int q = 0; q < NKC; ++q) { const int id = q * 256 + tid; krow_[q] = id / CPR; kc_[q] = id % CPR; }
  const int vrow = tid >> 3, vc = tid & 7;
  auto gload = [&](int key0, u32x4 (&rk)[NKC], u32x4 (&rv)[2]) {
#pragma unroll
    for (int q = 0; q < NKC; ++q) {
      const bf16_t* src = (DQK == 64 || kc_[q] < 8) ? K1 + (size_t)(key0 + krow_[q]) * k1_ld + kc_[q] * 8 : K2 + (size_t)(key0 + krow_[q]) * k2_ld + (kc_[q] - 8) * 8;
      rk[q] = *(const u32x4*)src;
    }
#pragma unroll
    for (int q = 0; q < 2; ++q) rv[q] = *(const u32x4*)(Vt + (size_t)(vrow + 32 * q) * vt_ld + key0 + vc * 8);
  };
  auto lstore = [&](int buf, u32x4 (&rk)[NKC], u32x4 (&rv)[2]) {
    char* base = smem + buf * STAGE;
#pragma unroll
    for (int q = 0; q < NKC; ++q) *(u32x4*)(base + krow_[q] * KS + kc_[q] * 16) = rk[q];
#pragma unroll
    for (int q = 0; q < 2; ++q) *(u32x4*)(base + KBYTES + (vrow + 32 * q) * VS + vc * 16) = rv[q];
  };
  const int ntl = nkeys >> 6;
  gload(0, rk0, rv0); lstore(0, rk0, rv0);
  gload(64, rk1, rv1);
  if (ntl > 2) gload(128, rk0, rv0);
  __syncthreads();
  auto tile_body = [&](int tl, u32x4 (&rkn)[NKC], u32x4 (&rvn)[2]) {
    const char* base = smem + (tl & 1) * STAGE;
    bf16x8 kf[2][NS], vf[2][2][2];
#pragma unroll
    for (int kb = 0; kb < 2; ++kb)
#pragma unroll
      for (int ks = 0; ks < NS; ++ks) kf[kb][ks] = *(const bf16x8*)(base + (kb * 32 + r) * KS + (2 * ks + hh) * 16);
    __builtin_amdgcn_sched_barrier(0);
    f32x16 s[2];
    const float ninit = -m_run;
#pragma unroll
    for (int kb = 0; kb < 2; ++kb)
#pragma unroll
      for (int e = 0; e < 16; ++e) s[kb][e] = ninit;
#pragma unroll
    for (int ks = 0; ks < NS; ++ks)
#pragma unroll
      for (int kb = 0; kb < 2; ++kb) s[kb] = MFMA32(kf[kb][ks], qf[ks], s[kb]);
#pragma unroll
    for (int kb = 0; kb < 2; ++kb)
#pragma unroll
      for (int s2 = 0; s2 < 2; ++s2)
#pragma unroll
        for (int n = 0; n < 2; ++n) vf[kb][s2][n] = *(const bf16x8*)(base + KBYTES + (32 * n + r) * VS + (kb * 32 + 16 * s2 + 8 * hh) * 2);
    __builtin_amdgcn_sched_barrier(0);
    float mx = s[0][0];
#pragma unroll
    for (int kb = 0; kb < 2; ++kb)
#pragma unroll
      for (int e = 0; e < 16; ++e) mx = fmaxf(mx, s[kb][e]);
    { const unsigned u = __float_as_uint(mx); auto sw = __builtin_amdgcn_permlane32_swap(u, u, false, false); mx = fmaxf(__uint_as_float(sw[0]), __uint_as_float(sw[1])); }
    const bool move = (mx > 4.0f) || (mx < -20.0f);
    if (__builtin_amdgcn_ballot_w64(move) != 0ull) {
      const float dlt = move ? mx : 0.f;
      const float alpha = __builtin_amdgcn_exp2f(-dlt);
      m_run += dlt;
      lsum *= alpha;
#pragma unroll
      for (int kb = 0; kb < 2; ++kb)
#pragma unroll
        for (int e = 0; e < 16; ++e) s[kb][e] -= dlt;
#pragma unroll
      for (int n = 0; n < 2; ++n)
#pragma unroll
        for (int e = 0; e < 16; ++e) o[n][e] *= alpha;
    }
    float ps = 0.f;
#pragma unroll
    for (int kb = 0; kb < 2; ++kb)
#pragma unroll
      for (int e = 0; e < 16; ++e) { const float pe = __builtin_amdgcn_exp2f(s[kb][e]); s[kb][e] = pe; ps += pe; }
    lsum += ps;
#pragma unroll
    for (int kb = 0; kb < 2; ++kb)
#pragma unroll
      for (int s2 = 0; s2 < 2; ++s2) {
        u32x4 pw;
        pw.x = pack2(s[kb][8 * s2 + 0], s[kb][8 * s2 + 1]); pw.y = pack2(s[kb][8 * s2 + 2], s[kb][8 * s2 + 3]);
        pw.z = pack2(s[kb][8 * s2 + 4], s[kb][8 * s2 + 5]); pw.w = pack2(s[kb][8 * s2 + 6], s[kb][8 * s2 + 7]);
        const bf16x8 pf = __builtin_bit_cast(bf16x8, pw);
#pragma unroll
        for (int n = 0; n < 2; ++n) o[n] = MFMA32(vf[kb][s2][n], pf, o[n]);
      }
    if (tl + 1 < ntl) { lstore((tl + 1) & 1, rkn, rvn); if (tl + 3 < ntl) gload((tl + 3) * 64, rkn, rvn); }
    __syncthreads();
  };
  for (int tl = 0; tl < ntl; tl += 2) { tile_body(tl, rk1, rv1); tile_body(tl + 1, rk0, rv0); }
  lsum = xsum32(lsum);
  const float inv = 1.0f / lsum;
#pragma unroll
  for (int n = 0; n < 2; ++n)
#pragma unroll
    for (int g = 0; g < 4; ++g) {
      u32x2 w; w.x = pack2(o[n][4 * g] * inv, o[n][4 * g + 1] * inv); w.y = pack2(o[n][4 * g + 2] * inv, o[n][4 * g + 3] * inv);
      *(u32x2*)(Ow + (size_t)r * o_ld + 32 * n + 8 * g + 4 * hh) = w;
    }
}

DI void scan_item(const Params& p, int l, int seq, int hd, int dir, int rs, char* smem) {
  const int tid = otid(), lane = tid & 63, wv = __builtin_amdgcn_readfirstlane(tid >> 6);
  const int j8 = lane & 7, r = lane & 31, hh = lane >> 5;
  const bool lat = seq >= 32;
  const int T = lat ? 4096 : 256;
  const int row0 = lat ? NCTX + (seq - 32) * 4096 : seq * 256;
  float* vA = (float*)smem; float* vK = vA + 2048; float* vR = vK + 2048; float* vV = vR + 2048; float* vW = vV + 2048; float* vB = vW + 2048; float* ybuf = vB + 2048;
  char* raw = smem + 32768;
  char* wdx = smem + 57344; char* adx = smem + 61952;
  float* tmpb = (float*)(smem + 66816);
  const bf16_t* U = (const bf16_t*)(p.ws + OFF_U);
  bf16_t* Y = (bf16_t*)(p.ws + OFF_R2) + (dir ? (size_t)NT * 512 : 0);
  float* bonus = (float*)(p.ws + OFF_BONUS);
  const int lrow = 8 * wv + (lane >> 3), irow = rs * 32 + lrow;
  f32x2 S[4];
  if (lat) {
    const float* s0 = (dir ? opq(p.in[I_SB]) : opq(p.in[I_SF])) + ((size_t)((seq - 32) * 4 + l) * 8 + hd) * 4096 + irow * 64 + j8 * 8;
#pragma unroll
    for (int q = 0; q < 2; ++q) { const f32x4 v = *(const f32x4*)(s0 + 4 * q); S[2 * q] = (f32x2){v.x, v.y}; S[2 * q + 1] = (f32x2){v.z, v.w}; }
  } else {
#pragma unroll
    for (int q = 0; q < 4; ++q) S[q] = (f32x2){0.f, 0.f};
  }
  const int mat = wv >> 1, ntc = wv & 1, cch = ntc * 32 + r, hc = hd * 64 + cch;
  bf16x8 bfrag[4];
  {
    const float* W = (mat ? opq(p.in[I_AUP]) : opq(p.in[I_WUP])) + (size_t)(l * 2 + dir) * 64 * 512 + hc;
#pragma unroll
    for (int s4 = 0; s4 < 4; ++s4) {
      float w8[8];
#pragma unroll
      for (int j = 0; j < 8; ++j) w8[j] = W[(size_t)(16 * s4 + 8 * hh + j) * 512];
      bfrag[s4] = __builtin_bit_cast(bf16x8, pack8(w8));
    }
  }
  const float bias = (mat ? opq(p.in[I_A0]) : opq(p.in[I_W0]))[(l * 2 + dir) * 512 + hc];
  const float kav = p.in[I_KA][l * 512 + hc], rkv = p.in[I_RK][l * 512 + hc];
  float* muP = (float*)(smem + 75008); float* muN = muP + 320; float* kkL = muN + 320;
  {
    const float* mup = p.in[I_MUP] + l * 1792; const float* mun = p.in[I_MUN] + l * 1792;
    for (int e = tid; e < 320; e += 256) { const int g = e >> 6, c = e & 63; const int col = (g < 3 ? g * 512 + hd * 64 : (g == 3 ? 1536 + dir * 64 : 1664 + dir * 64)) + c; muP[e] = mup[col]; muN[e] = mun[col]; }
    if (tid < 64) kkL[tid] = p.in[I_KK][l * 512 + hd * 64 + tid];
  }
  const int nch = T >> 5;
  u32x4 pre[6];
  auto prefetch = [&](int t0) {
#pragma unroll
    for (int q = 0; q < 6; ++q) {
      const int id = q * 256 + tid;
      const int row = id / 40, cc = id - row * 40, g = cc >> 3, c8 = cc & 7;
      const int t = t0 - 1 + row;
      const int col = (g < 3 ? g * 512 + hd * 64 : (g == 3 ? 1536 + dir * 64 : 1664 + dir * 64)) + c8 * 8;
      u32x4 v = (u32x4){0u, 0u, 0u, 0u};
      if (id < 1360 && t >= 0 && t < T) v = *(const u32x4*)(U + (size_t)(row0 + t) * ULD + 1696 + col);
      pre[q] = v;
    }
  };
  prefetch((dir ? nch - 1 : 0) * 32);
  for (int ci = 0; ci < nch; ++ci) {
    const int t0 = (dir ? nch - 1 - ci : ci) * 32;
#pragma unroll
    for (int q = 0; q < 6; ++q) { const int id = q * 256 + tid; if (id < 1360) *(u32x4*)(raw + id * 16) = pre[q]; }
    __syncthreads();
    if (ci + 1 < nch) prefetch((dir ? nch - 2 - ci : ci + 1) * 32);
    {
      const int tt = tid >> 3, sub = tid & 7;
#pragma unroll 1
      for (int g = 0; g < 5; ++g) {
        const int col = (g < 3 ? g * 512 + hd * 64 : (g == 3 ? 1536 + dir * 64 : 1664 + dir * 64)) + sub * 8;
        float c[8], pv[8], nx[8], x[8];
        unpack8(*(const u32x4*)(raw + (tt + 1) * 640 + (g * 8 + sub) * 16), c);
        unpack8(*(const u32x4*)(raw + tt * 640 + (g * 8 + sub) * 16), pv);
        unpack8(*(const u32x4*)(raw + (tt + 2) * 640 + (g * 8 + sub) * 16), nx);
        const f32x4 mp0 = *(const f32x4*)(muP + g * 64 + sub * 8), mp1 = *(const f32x4*)(muP + g * 64 + sub * 8 + 4), mn0 = *(const f32x4*)(muN + g * 64 + sub * 8), mn1 = *(const f32x4*)(muN + g * 64 + sub * 8 + 4);
        const float mp[8] = {mp0.x, mp0.y, mp0.z, mp0.w, mp1.x, mp1.y, mp1.z, mp1.w}, mn[8] = {mn0.x, mn0.y, mn0.z, mn0.w, mn1.x, mn1.y, mn1.z, mn1.w};
#pragma unroll
        for (int i = 0; i < 8; ++i) x[i] = c[i] + mp[i] * (pv[i] - c[i]) + mn[i] * (nx[i] - c[i]);
        const int lo = tt * 64 + sub * 8;
        if (g == 0) { *(f32x4*)(vR + lo) = (f32x4){x[0], x[1], x[2], x[3]}; *(f32x4*)(vR + lo + 4) = (f32x4){x[4], x[5], x[6], x[7]}; }
        else if (g == 1) {
          float kk[8], ss = 0.f;
          const float* kkw = kkL + sub * 8;
#pragma unroll
          for (int i = 0; i < 8; ++i) { kk[i] = x[i] * kkw[i]; ss += kk[i] * kk[i]; }
          *(f32x4*)(vK + lo) = (f32x4){x[0], x[1], x[2], x[3]}; *(f32x4*)(vK + lo + 4) = (f32x4){x[4], x[5], x[6], x[7]};
          ss += shx<1>(ss); ss += shx<2>(ss); ss += shx<4>(ss);
          const float inv = 1.0f / fmaxf(sqrtf(ss), 1e-12f);
          *(f32x4*)(vA + lo) = (f32x4){kk[0] * inv, kk[1] * inv, kk[2] * inv, kk[3] * inv}; *(f32x4*)(vA + lo + 4) = (f32x4){kk[4] * inv, kk[5] * inv, kk[6] * inv, kk[7] * inv};
        }
        else if (g == 2) { *(f32x4*)(vV + lo) = (f32x4){x[0], x[1], x[2], x[3]}; *(f32x4*)(vV + lo + 4) = (f32x4){x[4], x[5], x[6], x[7]}; }
        else if (g == 3) { float th[8]; for (int i = 0; i < 8; ++i) th[i] = 1.0f - 2.0f * __builtin_amdgcn_rcpf(1.0f + __expf(2.0f * x[i])); *(u32x4*)(wdx + tt * 144 + sub * 16) = pack8(th); }
        else { *(u32x4*)(adx + tt * 144 + sub * 16) = pack8(x); }
      }
    }
    __syncthreads();
    {
      f32x16 acc;
#pragma unroll
      for (int e = 0; e < 16; ++e) acc[e] = 0.f;
      const char* xb = mat ? adx : wdx;
#pragma unroll
      for (int s4 = 0; s4 < 4; ++s4) { const bf16x8 af = *(const bf16x8*)(xb + r * 144 + (16 * s4 + 8 * hh) * 2); acc = MFMA32(af, bfrag[s4], acc); }
      if (mat == 0) {
#pragma unroll
        for (int e = 0; e < 16; ++e) vW[crow(e, hh) * 64 + cch] = __expf(-0.6065306597126334f * sigmoidf_(bias + acc[e]));
      } else {
#pragma unroll
        for (int e = 0; e < 16; ++e) {
          const int ix = crow(e, hh) * 64 + cch;
          const float ag = sigmoidf_(bias + acc[e]);
          const float kk = vA[ix], k = vK[ix], rr = vR[ix];
          const float kd = k * (1.0f + (ag - 1.0f) * kav);
          vK[ix] = kd; vA[ix] = -kk; vB[ix] = kk * ag; tmpb[ix] = rr * kd * rkv;
        }
      }
    }
    __syncthreads();
    {
      const int tt = tid >> 3, sub = tid & 7;
      const f32x4 b0 = *(const f32x4*)(tmpb + tt * 64 + sub * 8), b1 = *(const f32x4*)(tmpb + tt * 64 + sub * 8 + 4);
      float bs = (b0.x + b0.y) + (b0.z + b0.w) + (b1.x + b1.y) + (b1.z + b1.w);
      bs += shx<1>(bs); bs += shx<2>(bs); bs += shx<4>(bs);
      if (sub == 0 && rs == 0) bonus[((size_t)(row0 + t0 + tt) * 8 + hd) * 2 + dir] = bs;
    }
    {
      f32x4 va[2], vw[2], vb[2], vk[2], vr[2]; float vi;
      int tt = dir ? 31 : 0;
      int vo = tt * 64 + j8 * 8;
#pragma unroll
      for (int q = 0; q < 2; ++q) { va[q] = *(const f32x4*)(vA + vo + 4 * q); vw[q] = *(const f32x4*)(vW + vo + 4 * q); vb[q] = *(const f32x4*)(vB + vo + 4 * q); vk[q] = *(const f32x4*)(vK + vo + 4 * q); vr[q] = *(const f32x4*)(vR + vo + 4 * q); }
      vi = vV[tt * 64 + irow];
      for (int si = 0; si < 32; ++si) {
        const int ttn = dir ? (si < 31 ? 30 - si : 0) : (si < 31 ? si + 1 : 31);
        const int von = ttn * 64 + j8 * 8;
        f32x2 pa2 = S[0] * (f32x2){va[0].x, va[0].y}, pa3 = S[1] * (f32x2){va[0].z, va[0].w};
        pa2 += S[2] * (f32x2){va[1].x, va[1].y}; pa3 += S[3] * (f32x2){va[1].z, va[1].w};
#pragma unroll
        for (int q = 0; q < 2; ++q) va[q] = *(const f32x4*)(vA + von + 4 * q);
        pa2 += pa3;
        const float sa = osum(pa2.x + pa2.y);
        const f32x2 sa2 = (f32x2){sa, sa}, vi2 = (f32x2){vi, vi};
        f32x2 py2, py3;
        S[0] = S[0] * (f32x2){vw[0].x, vw[0].y} + (sa2 * (f32x2){vb[0].x, vb[0].y} + vi2 * (f32x2){vk[0].x, vk[0].y}); py2 = S[0] * (f32x2){vr[0].x, vr[0].y};
        S[1] = S[1] * (f32x2){vw[0].z, vw[0].w} + (sa2 * (f32x2){vb[0].z, vb[0].w} + vi2 * (f32x2){vk[0].z, vk[0].w}); py3 = S[1] * (f32x2){vr[0].z, vr[0].w};
        S[2] = S[2] * (f32x2){vw[1].x, vw[1].y} + (sa2 * (f32x2){vb[1].x, vb[1].y} + vi2 * (f32x2){vk[1].x, vk[1].y}); py2 += S[2] * (f32x2){vr[1].x, vr[1].y};
        S[3] = S[3] * (f32x2){vw[1].z, vw[1].w} + (sa2 * (f32x2){vb[1].z, vb[1].w} + vi2 * (f32x2){vk[1].z, vk[1].w}); py3 += S[3] * (f32x2){vr[1].z, vr[1].w};
#pragma unroll
        for (int q = 0; q < 2; ++q) { vw[q] = *(const f32x4*)(vW + von + 4 * q); vb[q] = *(const f32x4*)(vB + von + 4 * q); vk[q] = *(const f32x4*)(vK + von + 4 * q); vr[q] = *(const f32x4*)(vR + von + 4 * q); }
        vi = vV[ttn * 64 + irow];
        py2 += py3;
        const float py = osum(py2.x + py2.y);
        ybuf[tt * 32 + lrow] = py;
        tt = ttn;
      }
    }
    __syncthreads();
    {
      const int tt = tid >> 3, sub = tid & 7;
      const f32x4 y0 = *(const f32x4*)(ybuf + tt * 32 + sub * 4);
      u32x2 w; w.x = pack2(y0.x, y0.y); w.y = pack2(y0.z, y0.w);
      *(u32x2*)(Y + (size_t)(row0 + t0 + tt) * 512 + hd * 64 + rs * 32 + sub * 4) = w;
    }
    __syncthreads();
  }
  if (!lat) {
    float* o = opq(p.out) + (dir ? OUT_SB : OUT_SF) + ((size_t)(seq * 4 + l) * 8 + hd) * 4096 + irow * 64 + j8 * 8;
#pragma unroll
    for (int q = 0; q < 2; ++q) *(f32x4*)(o + 4 * q) = (f32x4){S[2 * q].x, S[2 * q].y, S[2 * q + 1].x, S[2 * q + 1].y};
  }
}

DI void phase_mixers(const Params& p, int l, char* smem, int part = 0) {
  const int tid = otid(), wid = __builtin_amdgcn_readfirstlane(tid >> 6);
  unsigned* cnt = (unsigned*)(p.ws + OFF_CNT) + l * 8;
  int* slot = (int*)(smem + SMEM_BYTES - 16);
  bf16_t* U = (bf16_t*)(p.ws + OFF_U);
  const bf16_t* KA = (const bf16_t*)(p.ws + OFF_KA); const bf16_t* VAT = (const bf16_t*)(p.ws + OFF_VAT);
  const bf16_t* KN = (const bf16_t*)(p.ws + OFF_KN); const bf16_t* VBT = (const bf16_t*)(p.ws + OFF_VBT); const bf16_t* KRB = (const bf16_t*)(p.ws + OFF_KRB);
  const int QLEN = 256 + 256 + 128 + 64 + 64;
  bool first = true;
  int xq = blockIdx.x & 7, tries = 0;
  for (;;) {
    int kind, seq, a, qt;
    if (first && blockIdx.x < 256) {
      const int item = blockIdx.x; kind = 0; seq = 32 + (item >> 5); a = (item >> 2) & 7; qt = item & 3;
      first = false;
    } else {
      first = false;
      if (tid == 0) *slot = (int)atomicAdd(cnt + xq, 1u);
      __syncthreads();
      const int i = __builtin_amdgcn_readfirstlane(*slot);
      __syncthreads();
      if (i >= QLEN) { if (++tries >= 8) break; xq = (xq + 1) & 7; continue; }
      if (i < 256) { const int g = xq + 8 * (i >> 7); kind = 1; seq = 32 + (g >> 1); a = g & 1; qt = i & 127; }
      else if (i < 512) { const int j = i - 256; const int g = xq + 8 * (j >> 5); kind = 2; seq = 32 + (g >> 3); a = g & 7; qt = j & 31; }
      else if (i < 640) { const int j = i - 512; kind = 0; seq = xq + 8 * (j >> 5); a = (j >> 2) & 7; qt = j & 3; }
      else if (i < 704) { const int j = i - 640; kind = 1; seq = xq + 8 * (j >> 4); a = (j >> 3) & 1; qt = j & 7; }
      else { const int j = i - 704; kind = 2; seq = xq + 8 * (j >> 4); a = (j >> 1) & 7; qt = j & 1; }
    }
    const int kr0 = keyrow0(seq), Tk = seq_tk(seq);
    const int row0 = seq < 32 ? seq * 256 : NCTX + (seq - 32) * 4096;
    if (kind == 0) scan_item(p, l, seq, a, qt & 1, qt >> 1, smem);
    else if (kind == 1) {
      const int qh = a * 4 + wid;
      bf16_t* q = U + (size_t)(row0 + qt * 32) * ULD + qh * 64;
      attn_item<64>(q, ULD, KA + (size_t)kr0 * 128 + a * 64, 128, nullptr, 0, VAT + (size_t)128 * kr0 + (size_t)(a * 64) * Tk, Tk, Tk, q, ULD, smem);
    } else {
      bf16_t* q = U + (size_t)(row0 + qt * 128 + wid * 32) * ULD + 768 + a * 96;
      attn_item<96>(q, ULD, KN + (size_t)kr0 * 512 + a * 64, 512, KRB + (size_t)kr0 * 32, 32, VBT + (size_t)512 * kr0 + (size_t)(a * 64) * Tk, Tk, Tk, q, ULD, smem);
    }
  }
}

struct CpostIn { u32x4 yf, yb, c, pv, nx; f32x2 bs; };
DI void cpost_load(const Params& p, int row, int lane, CpostIn& in) {
  int seq, t; row_decode(row, seq, t);
  const int T = seq < 32 ? 256 : 4096;
  const bf16_t* YF = (const bf16_t*)(p.ws + OFF_R2); const bf16_t* YB = YF + (size_t)NT * 512;
  const bf16_t* u = (const bf16_t*)(p.ws + OFF_U) + (size_t)row * ULD + 1696;
  const float* bonus = (const float*)(p.ws + OFF_BONUS);
  const int col = 1024 + lane * 8;
  const u32x4 z4 = (u32x4){0u, 0u, 0u, 0u};
  in.yf = *(const u32x4*)(YF + (size_t)row * 512 + lane * 8);
  in.yb = *(const u32x4*)(YB + (size_t)row * 512 + lane * 8);
  in.c = *(const u32x4*)(u + col);
  in.pv = t > 0 ? *(const u32x4*)(u - ULD + col) : z4;
  in.nx = t < T - 1 ? *(const u32x4*)(u + ULD + col) : z4;
  in.bs = *(const f32x2*)(bonus + ((size_t)row * 8 + (lane >> 3)) * 2);
}
DI void cpost_finish(const Params& p, int l, int row, int lane, const CpostIn& in) {
  bf16_t* u = (bf16_t*)(p.ws + OFF_U) + (size_t)row * ULD + 1696;
  float yf[8], yb[8], y[8];
  unpack8(in.yf, yf); unpack8(in.yb, yb);
  float s = 0.f;
#pragma unroll
  for (int i = 0; i < 8; ++i) { y[i] = yf[i] + yb[i]; s += y[i]; }
  s += shx<1>(s); s += shx<2>(s); s += shx<4>(s);
  const float mu = s * (1.0f / 64.0f);
  float q = 0.f;
#pragma unroll
  for (int i = 0; i < 8; ++i) { y[i] -= mu; q += y[i] * y[i]; }
  q += shx<1>(q); q += shx<2>(q); q += shx<4>(q);
  const float rs = rsqrtf(q * (1.0f / 64.0f) + 64e-5f);
  const int col = 1024 + lane * 8;
  float c[8], pv[8], nx[8];
  unpack8(in.c, c); unpack8(in.pv, pv); unpack8(in.nx, nx);
  const float* mup = p.in[I_MUP] + l * 1792 + col; const float* mun = p.in[I_MUN] + l * 1792 + col;
  const float* lw = p.in[I_LNW] + l * 512 + lane * 8; const float* lb = p.in[I_LNB] + l * 512 + lane * 8;
  const float bs = in.bs.x + in.bs.y;
  float o[8];
#pragma unroll
  for (int i = 0; i < 8; ++i) { const float v = c[i] + mup[i] * (pv[i] - c[i]) + mun[i] * (nx[i] - c[i]); o[i] = y[i] * rs * lw[i] + lb[i] + bs * v; }
  *(u32x4*)(u + lane * 8) = pack8(o);
}
DI void phase_renorm_cpost(const Params& p, int l) {
  const int lane = otid() & 63, wid = __builtin_amdgcn_readfirstlane(otid() >> 6);
  for (int item = blockIdx.x; item < NT / 8; item += gridDim.x) { const int ra = item * 8 + wid, rb = ra + 4; CpostIn ia, ib; cpost_load(p, ra, lane, ia); cpost_load(p, rb, lane, ib); norm_rows2(p, l, ra, rb, lane); cpost_finish(p, l, ra, lane, ia); cpost_finish(p, l, rb, lane, ib); }
}

DI void phase_zgemm(const Params& p, char* smem) {
  const bf16_t* H = (const bf16_t*)(p.ws + OFF_R1);
  const bf16_t* W = (const bf16_t*)(p.ws + OFF_WIN) + (size_t)3584 * 1024;
  bf16_t* U = (bf16_t*)(p.ws + OFF_U);
  const int ntiles = 320 * 12;
  for (int it = 0;; ++it) {
    int mt, nt; if (!next_tile(it, 12, 6, mt, nt)) break;
    const int m0 = mt * 128, n0 = nt * 128;
    f32x16 acc[2][2]; zero_acc<2>(acc);
    gemm_mainloop<2>(acc, H + (size_t)m0 * 1024, 1024, 64, W + (size_t)n0 * 1024, 1024, 1024, smem);
    const int lane = otid() & 63, wid = __builtin_amdgcn_readfirstlane(otid() >> 6), wm = wid >> 1, wn = wid & 1, r = lane & 31, hh = lane >> 5;
    bf16_t yv[2][2][16];
    int ucolj[2];
#pragma unroll
    for (int j = 0; j < 2; ++j) {
      const int col = n0 + wn * 64 + j * 32 + r;
      const int br = col >> 9, cc = col & 511;
      ucolj[j] = br == 0 ? cc : (br == 1 ? 768 + (cc >> 6) * 96 + (cc & 63) : 1696 + cc);
#pragma unroll
      for (int i = 0; i < 2; ++i) {
        const bf16_t* up = U + (size_t)(m0 + wm * 64 + i * 32) * ULD;
        const int lo = 4 * hh * ULD + ucolj[j];
#pragma unroll
        for (int e = 0; e < 16; ++e) yv[j][i][e] = (up + crowu(e) * ULD)[lo];
      }
    }
#pragma unroll
    for (int j = 0; j < 2; ++j)
#pragma unroll
      for (int i = 0; i < 2; ++i) {
        bf16_t* up = U + (size_t)(m0 + wm * 64 + i * 32) * ULD;
        const int lo = 4 * hh * ULD + ucolj[j];
#pragma unroll
        for (int e = 0; e < 16; ++e) (up + crowu(e) * ULD)[lo] = f2bf(bf2f(yv[j][i][e]) * siluf_(acc[i][j][e]));
      }
  }
}

DI void phase_merge(const Params& p, char* smem) {
  const bf16_t* H = (const bf16_t*)(p.ws + OFF_R1);
  const bf16_t* WG = (const bf16_t*)(p.ws + OFF_WIN) + (size_t)5120 * 1024;
  const bf16_t* WO = (const bf16_t*)(p.ws + OFF_WO);
  const bf16_t* U = (const bf16_t*)(p.ws + OFF_U);
  bf16_t* MX = (bf16_t*)(p.ws + OFF_R2);
  const int ntiles = 320 * 8;
  for (int it = 0;; ++it) {
    int mt, nt; if (!next_tile(it, 8, 8, mt, nt)) break;
    const int m0 = mt * 128, n0 = nt * 128;
    f32x16 mix[2][2]; zero_acc<2>(mix);
    unsigned gs[2][2][8];
#pragma unroll 1
    for (int step = 0; step < 6; ++step) {
      const int br = step >> 1, isT = step & 1;
      const int acol = br == 0 ? 0 : (br == 1 ? 768 : 1696);
      const bf16_t* Ap = isT ? U + (size_t)m0 * ULD + acol : H + (size_t)m0 * 1024;
      const bf16_t* Bp = isT ? WO + (size_t)(br * 1024 + n0) * 512 : WG + (size_t)(br * 1024 + n0) * 1024;
      f32x16 cur[2][2]; zero_acc<2>(cur);
      gemm_mainloop<2>(cur, Ap, isT ? ULD : 1024, (isT && br == 1) ? 96 : 64, Bp, isT ? 512 : 1024, isT ? 512 : 1024, smem);
      if (isT) {
#pragma unroll
        for (int i = 0; i < 2; ++i)
#pragma unroll
          for (int j = 0; j < 2; ++j)
#pragma unroll
            for (int e = 0; e < 8; ++e) { mix[i][j][2 * e] += lo16(gs[i][j][e]) * cur[i][j][2 * e]; mix[i][j][2 * e + 1] += hi16(gs[i][j][e]) * cur[i][j][2 * e + 1]; }
      } else {
#pragma unroll
        for (int i = 0; i < 2; ++i)
#pragma unroll
          for (int j = 0; j < 2; ++j)
#pragma unroll
            for (int e = 0; e < 8; ++e) gs[i][j][e] = pack2(sigmoidf_(cur[i][j][2 * e]), sigmoidf_(cur[i][j][2 * e + 1]));
      }
    }
    const int lane = otid() & 63, wid = __builtin_amdgcn_readfirstlane(otid() >> 6), wm = wid >> 1, wn = wid & 1, r = lane & 31, hh = lane >> 5;
#pragma unroll
    for (int j = 0; j < 2; ++j) {
      const int col = n0 + wn * 64 + j * 32 + r;
#pragma unroll
      for (int i = 0; i < 2; ++i) {
        bf16_t* mp = MX + (size_t)(m0 + wm * 64 + i * 32) * 1024;
        const int lo = 4 * hh * 1024 + col;
#pragma unroll
        for (int e = 0; e < 16; ++e) (mp + crowu(e) * 1024)[lo] = f2bf(mix[i][j][e]);
      }
    }
  }
}

DI void phase_out(const Params& p, int l, char* smem) {
  const bf16_t* MX = (const bf16_t*)(p.ws + OFF_R2);
  const bf16_t* W = (const bf16_t*)(p.ws + OFF_WOUT);
  const int ntiles = 320 * 8;
  for (int it = 0;; ++it) {
    int mt, nt; if (!next_tile(it, 8, 8, mt, nt)) break;
    const int m0 = mt * 128, n0 = nt * 128;
    const int lane = otid() & 63, wid = __builtin_amdgcn_readfirstlane(otid() >> 6), wm = wid >> 1, wn = wid & 1, r = lane & 31, hh = lane >> 5;
    const int jm = m0 < NCTX ? 0 : 1 + ((m0 - NCTX) >> 12);
    const float* gate = (const float*)(p.ws + OFF_MOD) + ((size_t)l * 9 + jm) * MODLD + 2048;
    const float* xsrc = x_row_ptr(p, l, m0);
    float xv[2][2][16];
#pragma unroll
    for (int j = 0; j < 2; ++j) {
      const int lo = 4 * hh * 1024 + n0 + wn * 64 + j * 32 + r;
#pragma unroll
      for (int i = 0; i < 2; ++i) {
        const float* xs = xsrc + (size_t)(wm * 64 + i * 32) * 1024;
#pragma unroll
        for (int e = 0; e < 16; ++e) xv[j][i][e] = (xs + crowu(e) * 1024)[lo];
      }
    }
    f32x16 acc[2][2]; zero_acc<2>(acc);
    gemm_mainloop<2>(acc, MX + (size_t)m0 * 1024, 1024, 64, W + (size_t)n0 * 1024, 1024, 1024, smem);
#pragma unroll
    for (int j = 0; j < 2; ++j) {
      const int col = n0 + wn * 64 + j * 32 + r;
      const float gv = gate[col];
      const int lo = 4 * hh * 1024 + col;
#pragma unroll
      for (int i = 0; i < 2; ++i) {
        float* xo = p.out + (size_t)(m0 + wm * 64 + i * 32) * 1024;
#pragma unroll
        for (int e = 0; e < 16; ++e) (xo + crowu(e) * 1024)[lo] = xv[j][i][e] + gv * acc[i][j][e];
      }
    }
  }
}

DI void phase_final(const Params& p) {
  const int lane = otid() & 63, wid = __builtin_amdgcn_readfirstlane(otid() >> 6);
  const float* nw = p.in[I_FNW];
  for (int item = blockIdx.x; item < NT / 4; item += gridDim.x) {
    float* x = p.out + (size_t)(item * 4 + wid) * 1024;
    f32x4 v[4]; float ss = 0.f;
#pragma unroll
    for (int i = 0; i < 4; ++i) { v[i] = *(const f32x4*)(x + lane * 4 + 256 * i); ss += v[i].x * v[i].x + v[i].y * v[i].y + v[i].z * v[i].z + v[i].w * v[i].w; }
ss = wave_sum(ss);
    const float rs = rsqrtf(ss * (1.0f / 1024.0f) + 1e-6f);
#pragma unroll
    for (int i = 0; i < 4; ++i) { const f32x4 w = *(const f32x4*)(nw + lane * 4 + 256 * i); *(f32x4*)(x + lane * 4 + 256 * i) = (f32x4){v[i].x * rs * w.x, v[i].y * rs * w.y, v[i].z * rs * w.z, v[i].w * rs * w.w}; }
  }
}

DI void grid_barrier(unsigned* bar, unsigned& epoch) {
  epoch += 1u;
  __syncthreads();
  if (otid() == 0) {
    const unsigned grp = blockIdx.x & 7u, per = gridDim.x >> 3;
    __builtin_amdgcn_fence(__ATOMIC_RELEASE, "agent");
    const unsigned old = __hip_atomic_fetch_add(bar + grp * 32, 1u, __ATOMIC_RELAXED, __HIP_MEMORY_SCOPE_AGENT);
    if (old + 1u == epoch * per) __hip_atomic_fetch_add(bar + 8 * 32, 1u, __ATOMIC_RELAXED, __HIP_MEMORY_SCOPE_AGENT);
    while (__hip_atomic_load(bar + 8 * 32, __ATOMIC_RELAXED, __HIP_MEMORY_SCOPE_AGENT) < epoch * 8u) __builtin_amdgcn_s_sleep(1);
    __builtin_amdgcn_fence(__ATOMIC_ACQUIRE, "agent");
  }
  __syncthreads();
}

constexpr int NPHASES = 1 + 4 * 9 + 1;
__global__ void __launch_bounds__(256, 2) fwd_kernel(Params p0) {
  __shared__ __attribute__((aligned(16))) char smem[SMEM_BYTES];
  cg::grid_group grid = cg::this_grid();
  const int ph_begin = p0.ph_begin, ph_end = p0.ph_end;
  unsigned* bar = (unsigned*)(p0.ws + OFF_BAR);
  unsigned epoch = 0u;
  for (int ph = ph_begin; ph < ph_end; ++ph) {
    auto kp = __builtin_amdgcn_kernarg_segment_ptr();
    asm volatile("" : "+s"(kp));
    typedef const __attribute__((address_space(4))) Params CParams;
    CParams* kpp = (CParams*)kp;
    Params p;
#pragma unroll
    for (int i = 0; i < 35; ++i) p.in[i] = kpp->in[i];
    p.out = kpp->out; p.ws = kpp->ws; p.ph_begin = ph_begin; p.ph_end = ph_end;
    if (ph == 0) phase_prologue(p, smem);
    else if (ph == NPHASES - 1) phase_final(p);
    else {
      const int l = (ph - 1) / 9, sp = (ph - 1) % 9;
#ifdef PROBE_SP
      if (sp == PROBE_SP) {
        switch (sp) {
          case 0: phase_norm_convert(p, l, smem); break;
          case 1: phase_gemm1(p, l, smem); break;
          case 3: phase_upproj(p, smem); break;
          case 5: phase_renorm_cpost(p, l); break;
          case 7: phase_merge(p, smem); break;
          default: break;
        }
        grid.sync();
      }
#endif
      switch (sp) {
        case 0: phase_norm_convert(p, l, smem); break;
        case 1: phase_gemm1(p, l, smem); break;
        case 2: phase_post(p, l); break;
        case 3: phase_upproj(p, smem); break;
        case 4: phase_mixers(p, l, smem); break;
        case 5: phase_renorm_cpost(p, l); break;
        case 6: phase_zgemm(p, smem); break;
        case 7: phase_merge(p, smem); break;
        default: phase_out(p, l, smem); break;
      }
    }
    if (ph + 1 < ph_end) { if (ph == 0) grid.sync(); else grid_barrier(bar, epoch); }
  }
}

extern "C" void kernel_launch(void* const* d_in, const int* in_sizes, int n_in, void* d_out, int out_size, void* d_ws, size_t ws_size, hipStream_t stream) {
  if (ws_size < WS_NEED || n_in < 35) { fprintf(stderr, "workspace too small: %zu < %zu\n", ws_size, WS_NEED); return; }
  static int grid_blocks = 0;
  if (!grid_blocks) {
    int dev = 0, cus = 0, per_cu = 0;
    hipGetDevice(&dev);
    hipDeviceGetAttribute(&cus, hipDeviceAttributeMultiprocessorCount, dev);
    hipOccupancyMaxActiveBlocksPerMultiprocessor(&per_cu, fwd_kernel, 256, 0);
    if (per_cu < 1) per_cu = 1;
    if (per_cu > 2) per_cu = 2;
    grid_blocks = cus * per_cu;
  }
  Params p{};
  for (int i = 0; i < 35; ++i) p.in[i] = (const float*)d_in[i];
  p.out = (float*)d_out; p.ws = (char*)d_ws;
#ifndef ONE_LAUNCH
  for (int ph = 0; ph < NPHASES; ++ph) {
    p.ph_begin = ph; p.ph_end = ph + 1;
    hipLaunchKernelGGL(fwd_kernel, dim3(grid_blocks), dim3(256), 0, stream, p);
  }
#else
  p.ph_begin = 0; p.ph_end = NPHASES;
  hipMemsetAsync((char*)d_ws + OFF_BAR, 0, 4096, stream);
  void* args[] = {&p};
  hipError_t e = hipLaunchCooperativeKernel((void*)fwd_kernel, dim3(grid_blocks), dim3(256), args, 0, stream);
  if (e != hipSuccess) fprintf(stderr, "cooperative launch failed: %s (grid %d)\n", hipGetErrorString(e), grid_blocks);
#endif
}
```

```cpp
#define ONE_LAUNCH 1
#include <hip/hip_runtime.h>
#include <hip/hip_cooperative_groups.h>
#include <stdint.h>
#include <stdio.h>
namespace cg = cooperative_groups;

typedef unsigned short bf16_t;
typedef short bf16x8 __attribute__((ext_vector_type(8)));
typedef float f32x16 __attribute__((ext_vector_type(16)));
typedef float f32x4 __attribute__((ext_vector_type(4)));
typedef float f32x2 __attribute__((ext_vector_type(2)));
typedef unsigned u32x4 __attribute__((ext_vector_type(4)));
typedef unsigned u32x2 __attribute__((ext_vector_type(2)));
#define DI __device__ __forceinline__
#define MFMA32(a, b, c) __builtin_amdgcn_mfma_f32_32x32x16_bf16((a), (b), (c), 0, 0, 0)

constexpr int NT = 40960;
constexpr int NCTX = 8192;
constexpr int NK = 45056;
constexpr int ULD = 3488;
constexpr int MODLD = 3072;
constexpr int SMEM_BYTES = 78848;

constexpr size_t OFF_WIN = 0;
constexpr size_t OFF_WO = 16777216;
constexpr size_t OFF_WOUT = 19922944;
constexpr size_t OFF_WU = 22020096;
constexpr size_t OFF_MOD = 22282240;
constexpr size_t OFF_BONUS = 22724608;
constexpr size_t OFF_CS16 = 25346048;
constexpr size_t OFF_CS8 = 25354240;
constexpr size_t OFF_CNT = 25358336;
constexpr size_t OFF_BAR = 524742912;
constexpr size_t OFF_U = 25358592;
constexpr size_t OFF_R1 = 311095552;
constexpr size_t OFF_KA = OFF_R1;
constexpr size_t OFF_VAT = 513208576;
constexpr size_t OFF_KN = OFF_R1 + 23068672;
constexpr size_t OFF_VBT = OFF_R1 + 69206016;
constexpr size_t OFF_KRB = OFF_R1 + 115343360;
constexpr size_t OFF_R2 = 429322496;
constexpr size_t WS_NEED = 524742912 + 4096;

constexpr size_t OUT_AK = 41943040, OUT_AV = 46137344, OUT_CKV = 50331648, OUT_KR = 54525952, OUT_SF = 55574528, OUT_SB = 59768832;

struct Params {
  const float* in[35];
  float* out;
  char* ws;
  int ph_begin, ph_end;
};

enum { I_XP = 0, I_XS, I_CAK, I_CAV, I_CCKV, I_CKR, I_SF, I_SB, I_C, I_CCTX, I_NORMW, I_WMOD, I_BMOD, I_WIN, I_QNW, I_KNW, I_KVNW,
       I_WUK, I_WUV, I_MUP, I_MUN, I_W0, I_WUP, I_A0, I_AUP, I_KK, I_KA, I_RK, I_LNW, I_LNB, I_WOA, I_WOB, I_WOC, I_WOUT, I_FNW };

DI int threadIdx_x_raw() { return __builtin_amdgcn_workitem_id_x(); }
DI int otid() { int t = threadIdx_x_raw(); asm volatile("" : "+v"(t)); return t; }
DI const float* opq(const float* q) { asm volatile("" : "+s"(q)); return q; }
DI float* opq(float* q) { asm volatile("" : "+s"(q)); return q; }
DI float bf2f(bf16_t v) { return __uint_as_float(((unsigned)v) << 16); }
typedef __bf16 hbf16x2 __attribute__((ext_vector_type(2)));
DI unsigned pack2(float a, float b) { f32x2 v = {a, b}; hbf16x2 r = __builtin_convertvector(v, hbf16x2); return __builtin_bit_cast(unsigned, r); }
DI bf16_t f2bf(float x) { return (bf16_t)(pack2(x, 0.f) & 0xffffu); }
DI float xsum16(float x) { const unsigned u = __float_as_uint(x); auto r = __builtin_amdgcn_permlane16_swap(u, u, false, false); return __uint_as_float(r[0]) + __uint_as_float(r[1]); }
DI float xsum32(float x) { const unsigned u = __float_as_uint(x); auto r = __builtin_amdgcn_permlane32_swap(u, u, false, false); return __uint_as_float(r[0]) + __uint_as_float(r[1]); }
DI float lo16(unsigned w) { return __uint_as_float(w << 16); }
DI float hi16(unsigned w) { return __uint_as_float(w & 0xffff0000u); }
DI void unpack8(u32x4 w, float* v) { v[0] = lo16(w.x); v[1] = hi16(w.x); v[2] = lo16(w.y); v[3] = hi16(w.y); v[4] = lo16(w.z); v[5] = hi16(w.z); v[6] = lo16(w.w); v[7] = hi16(w.w); }
DI u32x4 pack8(const float* v) { u32x4 w; w.x = pack2(v[0], v[1]); w.y = pack2(v[2], v[3]); w.z = pack2(v[4], v[5]); w.w = pack2(v[6], v[7]); return w; }
template <int K> DI float shx(float v) { return __int_as_float(__builtin_amdgcn_ds_swizzle(__float_as_int(v), 0x1f | (K << 10))); }
DI float wave_sum(float v) { v += shx<1>(v); v += shx<2>(v); v += shx<4>(v); v += shx<8>(v); v += shx<16>(v); return xsum32(v); }
DI float qsum(float v) {
  v += __int_as_float(__builtin_amdgcn_update_dpp(0, __float_as_int(v), 0xB1, 0xf, 0xf, true));
  v += __int_as_float(__builtin_amdgcn_update_dpp(0, __float_as_int(v), 0x4E, 0xf, 0xf, true));
  return v;
}
DI float osum(float v) {
  v = qsum(v);
  v += __int_as_float(__builtin_amdgcn_update_dpp(0, __float_as_int(v), 0x141, 0xf, 0xf, true));
  return v;
}
DI int crow(int reg, int h) { return (reg & 3) + 8 * (reg >> 2) + 4 * h; }
DI int crowu(int reg) { return (reg & 3) + 8 * (reg >> 2); }
DI int perm16(int t) { return (t & ~12) | ((t & 4) << 1) | ((t & 8) >> 1); }
DI float sigmoidf_(float x) { return __builtin_amdgcn_rcpf(1.0f + __expf(-x)); }
DI float siluf_(float x) { return x * __builtin_amdgcn_rcpf(1.0f + __expf(-x)); }

DI void row_decode(int row, int& seq, int& t) {
  if (row < NCTX) { seq = row >> 8; t = row & 255; } else { seq = 32 + ((row - NCTX) >> 12); t = (row - NCTX) & 4095; }
}
DI int keyrow0(int seq) { return seq < 32 ? seq * 256 : NCTX + (seq - 32) * 4608; }
DI int seq_tk(int seq) { return seq < 32 ? 256 : 4608; }

typedef __attribute__((address_space(3))) unsigned lds_u32;
template <int NJ>
DI void gemm_mainloop(f32x16 (&acc)[2][NJ], const bf16_t* __restrict__ A, int lda, int ks,
                      const bf16_t* __restrict__ Bt, int ldb, int K, char* smem) {
  constexpr int A_BYTES = 128 * 128;
  constexpr int B_BYTES = 64 * NJ * 128;
  constexpr int STAGE = A_BYTES + B_BYTES;
  const int tid = otid(), lane = tid & 63, wid = __builtin_amdgcn_readfirstlane(tid >> 6), wm = wid >> 1, wn = wid & 1;
  const int r = lane & 31, hh = lane >> 5;
  const int nk = K >> 6;
  const int lrow = tid >> 3, lc = tid & 7;
  const int gc = (lc ^ ((lrow >> 1) & 7)) * 8;
  const bf16_t* ap = A + (size_t)lrow * lda + gc;
  const bf16_t* bp = Bt + (size_t)lrow * ldb + gc;
  auto issue = [&](int kt, int buf) {
    char* base = smem + buf * STAGE + tid * 16;
    const bf16_t* ap2 = ap + (size_t)kt * ks;
    const bf16_t* bp2 = bp + (size_t)kt * 64;
#pragma unroll
    for (int p = 0; p < 4; ++p) __builtin_amdgcn_global_load_lds((const unsigned*)(ap2 + (size_t)(32 * p) * lda), (lds_u32*)(base + p * 4096), 16, 0, 0);
#pragma unroll
    for (int p = 0; p < 2 * NJ; ++p) __builtin_amdgcn_global_load_lds((const unsigned*)(bp2 + (size_t)(32 * p) * ldb), (lds_u32*)(base + A_BYTES + p * 4096), 16, 0, 0);
  };
  issue(0, 0);
  __syncthreads();
#pragma unroll 1
  for (int kt = 0; kt < nk; ++kt) {
    if (kt + 1 < nk) issue(kt + 1, (kt + 1) & 1);
    const char* base = smem + (kt & 1) * STAGE;
#pragma unroll
    for (int s = 0; s < 4; ++s) {
      bf16x8 af[2], bfr[NJ];
#pragma unroll
      for (int i = 0; i < 2; ++i) { const int row = wm * 64 + i * 32 + r; af[i] = *(const bf16x8*)(base + row * 128 + (((2 * s + hh) ^ ((row >> 1) & 7)) << 4)); }
#pragma unroll
      for (int j = 0; j < NJ; ++j) { const int row = wn * (32 * NJ) + j * 32 + r; bfr[j] = *(const bf16x8*)(base + A_BYTES + row * 128 + (((2 * s + hh) ^ ((row >> 1) & 7)) << 4)); }
#pragma unroll
      for (int i = 0; i < 2; ++i)
#pragma unroll
        for (int j = 0; j < NJ; ++j) acc[i][j] = MFMA32(af[i], bfr[j], acc[i][j]);
    }
    __syncthreads();
  }
}

template <int NJ> DI void zero_acc(f32x16 (&acc)[2][NJ]) {
#pragma unroll
  for (int i = 0; i < 2; ++i)
#pragma unroll
    for (int j = 0; j < NJ; ++j)
#pragma unroll
      for (int e = 0; e < 16; ++e) acc[i][j][e] = 0.f;
}

DI void phase_prologue(const Params& p, char* smem) {
  const int tid = otid(), lane = tid & 63, wid = __builtin_amdgcn_readfirstlane(tid >> 6);
  float* mod = (float*)(p.ws + OFF_MOD);
  if (blockIdx.x == 0) {
    if (tid < 32) ((unsigned*)(p.ws + OFF_CNT))[tid] = 0u;
    float* cs16 = (float*)(p.ws + OFF_CS16);
    float* cs8 = (float*)(p.ws + OFF_CS8);
    for (int e = tid; e < 64 * 16; e += 256) { const int pos = e >> 4, i = e & 15; const float inv = expf(-9.210340371976184f * (float)i / 16.0f); const float a = (float)pos * inv; cs16[e * 2] = cosf(a); cs16[e * 2 + 1] = sinf(a); }
    for (int e = tid; e < 64 * 8; e += 256) { const int pos = e >> 3, i = e & 7; const float inv = expf(-9.210340371976184f * (float)i / 8.0f); const float a = (float)pos * inv; cs8[e * 2] = cosf(a); cs8[e * 2 + 1] = sinf(a); }
  }
  float* sl = (float*)smem;
  float* red = sl + 9 * 1024;
  for (int e = tid; e < 9 * 1024; e += 256) { const int j = e >> 10, k = e & 1023; const float* cc0 = opq(p.in[I_CCTX]); const float* cc1 = opq(p.in[I_C]); const float c = j == 0 ? cc0[k] : cc1[(j - 1) * 1024 + k]; sl[e] = siluf_(c); }
  __syncthreads();
  for (int item = blockIdx.x; item < 192; item += gridDim.x) {
    const int l = item / 48, n = (item % 48) * 64 + lane;
    const float* w = p.in[I_WMOD] + (size_t)l * 1024 * 3072 + n;
    float a[9];
#pragma unroll
    for (int j = 0; j < 9; ++j) a[j] = 0.f;
    for (int k = wid * 256; k < wid * 256 + 256; ++k) {
      const float wv = w[(size_t)k * 3072];
#pragma unroll
      for (int j = 0; j < 9; ++j) a[j] += sl[j * 1024 + k] * wv;
    }
#pragma unroll
    for (int j = 0; j < 9; ++j) red[(wid * 9 + j) * 64 + lane] = a[j];
    __syncthreads();
    for (int e = tid; e < 9 * 64; e += 256) {
      const int j = e >> 6, c = e & 63;
      const float s = red[(0 * 9 + j) * 64 + c] + red[(1 * 9 + j) * 64 + c] + red[(2 * 9 + j) * 64 + c] + red[(3 * 9 + j) * 64 + c];
      const int nn = (item % 48) * 64 + c;
      mod[((size_t)l * 9 + j) * MODLD + nn] = s + p.in[I_BMOD][l * 3072 + nn];
    }
    __syncthreads();
  }
}

DI const float* x_row_ptr(const Params& p, int l, int row) {
  const float* xp = opq(p.in[I_XP]); const float* xs = opq(p.in[I_XS]); const float* xo = opq((const float*)p.out);
  if (l == 0) return row < NCTX ? xp + (size_t)row * 1024 : xs + (size_t)(row - NCTX) * 1024;
  return xo + (size_t)row * 1024;
}
DI void norm_row(const Params& p, int l, int row, int lane) {
  const float* x = x_row_ptr(p, l, row);
  const int j = row < NCTX ? 0 : 1 + ((row - NCTX) >> 12);
  const float* mod = (const float*)(p.ws + OFF_MOD) + ((size_t)l * 9 + j) * MODLD;
  const float* nw = p.in[I_NORMW] + l * 1024;
  bf16_t* h = (bf16_t*)(p.ws + OFF_R1) + (size_t)row * 1024;
  f32x4 v[4]; float ss = 0.f;
#pragma unroll
  for (int i = 0; i < 4; ++i) { v[i] = *(const f32x4*)(x + lane * 4 + 256 * i); ss += v[i].x * v[i].x + v[i].y * v[i].y + v[i].z * v[i].z + v[i].w * v[i].w; }
ss = wave_sum(ss);
  const float rs = rsqrtf(ss * (1.0f / 1024.0f) + 1e-6f);
#pragma unroll
  for (int i = 0; i < 4; ++i) {
    const int c = lane * 4 + 256 * i;
    const f32x4 w = *(const f32x4*)(nw + c), sh = *(const f32x4*)(mod + c), sc = *(const f32x4*)(mod + 1024 + c);
    u32x2 o;
    o.x = pack2(v[i].x * rs * w.x * (1.f + sc.x) + sh.x, v[i].y * rs * w.y * (1.f + sc.y) + sh.y);
    o.y = pack2(v[i].z * rs * w.z * (1.f + sc.z) + sh.z, v[i].w * rs * w.w * (1.f + sc.w) + sh.w);
    *(u32x2*)(h + c) = o;
  }
}

DI void norm_rows2(const Params& p, int l, int rowa, int rowb, int lane) {
  const float* xa = x_row_ptr(p, l, rowa); const float* xb = x_row_ptr(p, l, rowb);
  f32x4 va[4], vb[4];
#pragma unroll
  for (int i = 0; i < 4; ++i) va[i] = *(const f32x4*)(xa + lane * 4 + 256 * i);
#pragma unroll
  for (int i = 0; i < 4; ++i) vb[i] = *(const f32x4*)(xb + lane * 4 + 256 * i);
  const float* nw = p.in[I_NORMW] + l * 1024;
#pragma unroll
  for (int rr = 0; rr < 2; ++rr) {
    const int row = rr ? rowb : rowa;
    f32x4 (&v)[4] = rr ? vb : va;
    const int j = row < NCTX ? 0 : 1 + ((row - NCTX) >> 12);
    const float* mod = (const float*)(p.ws + OFF_MOD) + ((size_t)l * 9 + j) * MODLD;
    bf16_t* h = (bf16_t*)(p.ws + OFF_R1) + (size_t)row * 1024;
    float ss = 0.f;
#pragma unroll
    for (int i = 0; i < 4; ++i) ss += v[i].x * v[i].x + v[i].y * v[i].y + v[i].z * v[i].z + v[i].w * v[i].w;
    ss = wave_sum(ss);
    const float rs = rsqrtf(ss * (1.0f / 1024.0f) + 1e-6f);
#pragma unroll
    for (int i = 0; i < 4; ++i) {
      const int c = lane * 4 + 256 * i;
      const f32x4 w = *(const f32x4*)(nw + c), sh = *(const f32x4*)(mod + c), sc = *(const f32x4*)(mod + 1024 + c);
      u32x2 o;
      o.x = pack2(v[i].x * rs * w.x * (1.f + sc.x) + sh.x, v[i].y * rs * w.y * (1.f + sc.y) + sh.y);
      o.y = pack2(v[i].z * rs * w.z * (1.f + sc.z) + sh.z, v[i].w * rs * w.w * (1.f + sc.w) + sh.w);
      *(u32x2*)(h + c) = o;
    }
  }
}

DI int win_srccol(int j) {
  if (j < 768) return j;
  if (j < 1696) return j + 512;
  if (j < 3488) return j + 1024;
  if (j < 3584) return -1;
  if (j < 5120) { const int jj = j - 3584; return jj < 512 ? 768 + jj : (jj < 1024 ? 2208 + (jj - 512) : 4512 + (jj - 1024)); }
  return 5024 + (j - 5120);
}
DI void conv_tile(const float* __restrict__ src, int ld_src, bf16_t* dst, int ld_dst, int k0, int n0, int kind, int srcoff, char* smem) {
  float* tile = (float*)smem;
  const int tid = otid();
  const int n = tid & 63;
  int sc = kind == 0 ? win_srccol(n0 + n) : (n0 + n - srcoff);
#pragma unroll
  for (int i = 0; i < 16; ++i) { const int k = i * 4 + (tid >> 6); tile[k * 65 + n] = sc >= 0 ? src[(size_t)(k0 + k) * ld_src + sc] : 0.f; }
  __syncthreads();
#pragma unroll
  for (int i = 0; i < 8; ++i) { const int nn = i * 8 + (tid >> 5), kk = (tid & 31) * 2; *(unsigned*)(dst + (size_t)(n0 + nn) * ld_dst + k0 + kk) = pack2(tile[kk * 65 + nn], tile[(kk + 1) * 65 + nn]); }
  __syncthreads();
}

DI void phase_norm_convert(const Params& p, int l, char* smem) {
  const int tid = otid(), lane = tid & 63, wid = __builtin_amdgcn_readfirstlane(tid >> 6);
  bf16_t* WinT = (bf16_t*)(p.ws + OFF_WIN); bf16_t* WoT = (bf16_t*)(p.ws + OFF_WO); bf16_t* WoutT = (bf16_t*)(p.ws + OFF_WOUT); bf16_t* WuT = (bf16_t*)(p.ws + OFF_WU);
  const int NI_WIN = 128 * 16, NI_WO = 3 * 16 * 8, NI_WOUT = 16 * 16, NI_WU = 16 * 2;
  const int NI_CONV = NI_WIN + NI_WO + NI_WOUT + NI_WU;
  for (int item = blockIdx.x; item < NI_CONV; item += gridDim.x) {
    int it = item;
    if (it < NI_WIN) { conv_tile(p.in[I_WIN] + (size_t)l * 1024 * 8096, 8096, WinT, 1024, (it & 15) * 64, (it >> 4) * 64, 0, 0, smem); continue; }
    it -= NI_WIN;
    if (it < NI_WO) { const int br = it / 128, r2 = it % 128; const float* src = (br == 0 ? opq(p.in[I_WOA]) : (br == 1 ? opq(p.in[I_WOB]) : opq(p.in[I_WOC]))) + (size_t)l * 512 * 1024; conv_tile(src, 1024, WoT + (size_t)br * 1024 * 512, 512, (r2 & 7) * 64, (r2 >> 3) * 64, 1, 0, smem); continue; }
    it -= NI_WO;
    if (it < NI_WOUT) { conv_tile(p.in[I_WOUT] + (size_t)l * 1024 * 1024, 1024, WoutT, 1024, (it & 15) * 64, (it >> 4) * 64, 1, 0, smem); continue; }
    it -= NI_WOUT;
    { const int nt = it >> 1, kt = it & 1; const bool uv = nt >= 8; const float* src = (uv ? opq(p.in[I_WUV]) : opq(p.in[I_WUK])) + (size_t)l * 128 * 512; conv_tile(src, 512, WuT, 128, kt * 64, nt * 64, 1, uv ? 512 : 0, smem); }
  }
  for (int item = blockIdx.x; item < NT / 8; item += gridDim.x) norm_rows2(p, l, item * 8 + wid, item * 8 + 4 + wid, lane);
}

DI bool next_tile(int it, int NTN, int GN, int& mt, int& nt, int MPX = 40, int GM = 8) {
  if (gridDim.x == 512) {
    const int x = blockIdx.x & 7, local = blockIdx.x >> 3;
    const int q = it * 64 + local;
    if (q >= MPX * NTN) return false;
    const int gsz = GM * GN, g = q / gsz, w = q - g * gsz, ngroups = NTN / GN;
    const int mgi = g / ngroups, ngi = g - mgi * ngroups;
    mt = x * MPX + mgi * GM + w / GN; nt = ngi * GN + (w % GN);
    return true;
  }
  const int tile = blockIdx.x + it * gridDim.x;
  if (tile >= 8 * MPX * NTN) return false;
  mt = tile / NTN; nt = tile % NTN;
  return true;
}

DI void phase_gemm1(const Params& p, int l, char* smem) {
  const bf16_t* H = (const bf16_t*)(p.ws + OFF_R1);
  const bf16_t* W = (const bf16_t*)(p.ws + OFF_WIN);
  bf16_t* U = (bf16_t*)(p.ws + OFF_U);
  bf16_t* VAT = (bf16_t*)(p.ws + OFF_VAT);
  const int NTN = 28, ntiles = 320 * NTN;
  for (int it = 0;; ++it) {
    int mt, nt; if (!next_tile(it, NTN, 7, mt, nt)) break;
    const int m0 = mt * 128, n0 = nt * 128;
    f32x16 acc[2][2]; zero_acc<2>(acc);
    gemm_mainloop<2>(acc, H + (size_t)m0 * 1024, 1024, 64, W + (size_t)n0 * 1024, 1024, 1024, smem);
    const int lane = otid() & 63, wid = __builtin_amdgcn_readfirstlane(otid() >> 6), wm = wid >> 1, wn = wid & 1, r = lane & 31, hh = lane >> 5;
    int seq, t0; row_decode(m0, seq, t0);
#pragma unroll
    for (int j = 0; j < 2; ++j) {
      const int cb = n0 + wn * 64 + j * 32;
      if (cb >= ULD) continue;
      const int col = cb + r;
      if (cb >= 640 && cb < 768) {
        const int kvh = (col - 640) >> 6, dv = col & 63, Tk = seq_tk(seq);
        bf16_t* vt = VAT + (size_t)128 * keyrow0(seq) + (size_t)(kvh * 64 + dv) * Tk;
#pragma unroll
        for (int i = 0; i < 2; ++i) {
          const int tt = t0 + wm * 64 + i * 32;
#pragma unroll
          for (int g2 = 0; g2 < 2; ++g2) {
            float v[8];
#pragma unroll
            for (int e = 0; e < 8; ++e) v[e] = acc[i][j][g2 * 8 + e];
            *(u32x4*)(vt + tt + 16 * g2 + 8 * hh) = pack8(v);
          }
          if (seq < 32) {
            float* o = p.out + OUT_AV + ((size_t)(seq * 4 + l) * 256 + tt) * 128;
            const int lo = 4 * hh * 128 + (col - 640);
#pragma unroll
            for (int e = 0; e < 16; ++e) (o + crowu(e) * 128)[lo] = acc[i][j][e];
          }
        }
      } else {
#pragma unroll
        for (int i = 0; i < 2; ++i) {
          bf16_t* up = U + (size_t)(m0 + wm * 64 + i * 32) * ULD;
          const int lo = 4 * hh * ULD + col;
#pragma unroll
          for (int e = 0; e < 16; ++e) (up + crowu(e) * ULD)[lo] = f2bf(acc[i][j][e]);
        }
      }
    }
  }
}

struct PostIn { u32x4 q, k, bq; u32x2 br; unsigned ckv; bf16_t kr; };
DI void post_load(const Params& p, int row, int lane, PostIn& in) {
  const bf16_t* u = (const bf16_t*)(p.ws + OFF_U) + (size_t)row * ULD;
  in.q = *(const u32x4*)(u + lane * 8);
  in.k = *(const u32x4*)(u + 512 + (lane & 15) * 8);
  in.bq = *(const u32x4*)(u + 768 + (lane >> 3) * 96 + (lane & 7) * 8);
  in.br = *(const u32x2*)(u + 768 + (lane >> 3) * 96 + 64 + (lane & 7) * 4);
  in.ckv = *(const unsigned*)(u + 1536 + lane * 2);
  in.kr = u[1664 + (lane & 31)];
}
DI void post_row(const Params& p, int l, int row, int lane, const PostIn& in) {
  int seq, t; row_decode(row, seq, t);
  const bool lat = row >= NCTX;
  const int krow = keyrow0(seq) + t;
  const int prow = t >> 6, pcol = t & 63;
  bf16_t* u = (bf16_t*)(p.ws + OFF_U) + (size_t)row * ULD;
  const float* cs16 = (const float*)(p.ws + OFF_CS16);
  const float* cs8 = (const float*)(p.ws + OFF_CS8);
  const float LOG2E = 1.4426950408889634f;
#pragma unroll
  for (int which = 0; which < 2; ++which) {
    const int l8 = which == 0 ? lane : (lane & 15);
    float v[8]; unpack8(which == 0 ? in.q : in.k, v);
    float ss = 0.f;
#pragma unroll
    for (int i = 0; i < 8; ++i) ss += v[i] * v[i];
    ss += shx<1>(ss); ss += shx<2>(ss); ss += shx<4>(ss);
    const float rs = rsqrtf(ss * (1.0f / 64.0f) + 1e-6f);
    const float* nw = (which == 0 ? opq(p.in[I_QNW]) : opq(p.in[I_KNW])) + l * 64 + (lane & 7) * 8;
#pragma unroll
    for (int i = 0; i < 8; ++i) v[i] = v[i] * rs * nw[i];
    float pv[8];
#pragma unroll
    for (int i = 0; i < 8; ++i) pv[i] = shx<2>(v[i]);
    if (lat) {
      const int pos = ((lane & 7) >> 2) ? pcol : prow;
      const bool lower = (lane & 2) == 0;
      const float* cs = cs16 + (pos * 16 + (lane & 1) * 8) * 2;
#pragma unroll
      for (int i = 0; i < 8; ++i) { const float c = cs[i * 2], s = cs[i * 2 + 1]; v[i] = lower ? v[i] * c - pv[i] * s : v[i] * c + pv[i] * s; }
    }
    if (which == 0) {
      const float sc = 0.125f * LOG2E;
#pragma unroll
      for (int i = 0; i < 8; ++i) v[i] *= sc;
      *(u32x4*)(u + lane * 8) = pack8(v);
    } else if (lane < 16) {
      bf16_t* KA = (bf16_t*)(p.ws + OFF_KA);
      *(u32x4*)(KA + (size_t)krow * 128 + lane * 8) = pack8(v);
      if (!lat) {
        float* o = p.out + OUT_AK + ((size_t)(seq * 4 + l) * 256 + t) * 128 + lane * 8;
        *(f32x4*)o = (f32x4){v[0], v[1], v[2], v[3]}; *(f32x4*)(o + 4) = (f32x4){v[4], v[5], v[6], v[7]};
      }
    }
  }
  {
    const float sc = 0.10206207261596577f * LOG2E;
    const int hd = lane >> 3;
    bf16_t* q = u + 768 + hd * 96;
    { float v[8]; unpack8(in.bq, v);
#pragma unroll
      for (int i = 0; i < 8; ++i) v[i] *= sc;
      *(u32x4*)(q + (lane & 7) * 8) = pack8(v); }
    { bf16_t* qr = q + 64 + (lane & 7) * 4;
      const u32x2 w = in.br;
      float v[4] = {lo16(w.x), hi16(w.x), lo16(w.y), hi16(w.y)}, pv[4];
#pragma unroll
      for (int i = 0; i < 4; ++i) pv[i] = shx<2>(v[i]);
      if (lat) {
        const int pos = ((lane & 7) >> 2) ? pcol : prow;
        const bool lower = (lane & 2) == 0;
        const float* cs = cs8 + (pos * 8 + (lane & 1) * 4) * 2;
#pragma unroll
        for (int i = 0; i < 4; ++i) { const float c = cs[i * 2], s = cs[i * 2 + 1]; v[i] = lower ? v[i] * c - pv[i] * s : v[i] * c + pv[i] * s; }
      }
      u32x2 o; o.x = pack2(v[0] * sc, v[1] * sc); o.y = pack2(v[2] * sc, v[3] * sc);
      *(u32x2*)qr = o; }
  }
  {
    const unsigned w = in.ckv;
    float a = lo16(w), b = hi16(w);
    float ss = a * a + b * b;
ss = wave_sum(ss);
    const float rs = rsqrtf(ss * (1.0f / 128.0f) + 1e-6f);
    const float* nw = p.in[I_KVNW] + l * 128 + lane * 2;
    a = a * rs * nw[0]; b = b * rs * nw[1];
    bf16_t* CKVN = (bf16_t*)(p.ws + OFF_R2);
    *(unsigned*)(CKVN + (size_t)krow * 128 + lane * 2) = pack2(a, b);
    if (!lat) { float* o = p.out + OUT_CKV + ((size_t)(seq * 4 + l) * 256 + t) * 128 + lane * 2; *(f32x2*)o = (f32x2){a, b}; }
  }
  {
    float v = bf2f(in.kr);
    const float pv = shx<8>(v);
    if (!lat) { if (lane < 32) p.out[OUT_KR + ((size_t)(seq * 4 + l) * 256 + t) * 32 + lane] = v; }
    else {
      const int d = lane & 31; const int pos = (d >> 4) ? pcol : prow; const bool lower = (d & 8) == 0;
      const float* cs = cs8 + (pos * 8 + (d & 7)) * 2;
      v = lower ? v * cs[0] - pv * cs[1] : v * cs[0] + pv * cs[1];
    }
    if (lane < 32) ((bf16_t*)(p.ws + OFF_KRB))[(size_t)krow * 32 + lane] = f2bf(v);
  }
}
DI void post_cached_row(const Params& p, int l, int idx, int lane) {
  const int b = idx >> 9, j = idx & 511;
  const int kr0 = NCTX + b * 4608, krow = kr0 + 4096 + j;
  const size_t cb = ((size_t)(b * 4 + l) * 512 + j);
  bf16_t* KA = (bf16_t*)(p.ws + OFF_KA); bf16_t* VAT = (bf16_t*)(p.ws + OFF_VAT); bf16_t* CKVN = (bf16_t*)(p.ws + OFF_R2); bf16_t* KRB = (bf16_t*)(p.ws + OFF_KRB);
  { const f32x2 v = *(const f32x2*)(p.in[I_CAK] + cb * 128 + lane * 2); *(unsigned*)(KA + (size_t)krow * 128 + lane * 2) = pack2(v.x, v.y); }
  { const f32x2 v = *(const f32x2*)(p.in[I_CAV] + cb * 128 + lane * 2);
    bf16_t* vt = VAT + (size_t)128 * kr0 + (size_t)(lane * 2) * 4608 + perm16(4096 + j);
    vt[0] = f2bf(v.x); vt[4608] = f2bf(v.y); }
  { const f32x2 v = *(const f32x2*)(p.in[I_CCKV] + cb * 128 + lane * 2); *(unsigned*)(CKVN + (size_t)krow * 128 + lane * 2) = pack2(v.x, v.y); }
  if (lane < 32) KRB[(size_t)krow * 32 + lane] = f2bf(p.in[I_CKR][cb * 32 + lane]);
}
DI void phase_post(const Params& p, int l) {
  const int lane = otid() & 63, wid = __builtin_amdgcn_readfirstlane(otid() >> 6);
  for (int item = blockIdx.x; item < NT / 8 + 1024; item += gridDim.x) {
    if (item < NT / 8) {
      const int ra = item * 8 + wid, rb = ra + 4;
      PostIn ia, ib; post_load(p, ra, lane, ia); post_load(p, rb, lane, ib);
      post_row(p, l, ra, lane, ia); post_row(p, l, rb, lane, ib);
    }
    else post_cached_row(p, l, (item - NT / 8) * 4 + wid, lane);
  }
}

DI void phase_upproj(const Params& p, char* smem) {
  const bf16_t* A = (const bf16_t*)(p.ws + OFF_R2);
  const bf16_t* W = (const bf16_t*)(p.ws + OFF_WU);
  bf16_t* KN = (bf16_t*)(p.ws + OFF_KN); bf16_t* VBT = (bf16_t*)(p.ws + OFF_VBT);
  const int ntiles = 352 * 8;
  for (int it = 0;; ++it) {
    int mt, nt; if (!next_tile(it, 8, 8, mt, nt, 44, 4)) break;
    const int m0 = mt * 128, n0 = nt * 128;
    f32x16 acc[2][2]; zero_acc<2>(acc);
    gemm_mainloop<2>(acc, A + (size_t)m0 * 128, 128, 64, W + (size_t)n0 * 128, 128, 128, smem);
    const int lane = otid() & 63, wid = __builtin_amdgcn_readfirstlane(otid() >> 6), wm = wid >> 1, wn = wid & 1, r = lane & 31, hh = lane >> 5;
    int seq, t0;
    if (m0 < NCTX) { seq = m0 >> 8; t0 = m0 & 255; } else { const int rr = m0 - NCTX; seq = 32 + rr / 4608; t0 = rr % 4608; }
#pragma unroll
    for (int j = 0; j < 2; ++j) {
      const int col = n0 + wn * 64 + j * 32 + r;
      if (n0 < 512) {
#pragma unroll
        for (int i = 0; i < 2; ++i) {
          bf16_t* kp = KN + (size_t)(m0 + wm * 64 + i * 32) * 512;
          const int lo = 4 * hh * 512 + col;
#pragma unroll
          for (int e = 0; e < 16; ++e) (kp + crowu(e) * 512)[lo] = f2bf(acc[i][j][e]);
        }
      } else {
        const int Tk = seq_tk(seq);
        bf16_t* vt = VBT + (size_t)512 * keyrow0(seq) + (size_t)(col - 512) * Tk;
#pragma unroll
        for (int i = 0; i < 2; ++i) {
          const int tt = t0 + wm * 64 + i * 32;
#pragma unroll
          for (int g2 = 0; g2 < 2; ++g2) {
            float v[8];
#pragma unroll
            for (int e = 0; e < 8; ++e) v[e] = acc[i][j][g2 * 8 + e];
            *(u32x4*)(vt + tt + 16 * g2 + 8 * hh) = pack8(v);
          }
        }
      }
    }
  }
}

template <int DQK>
DI void attn_item(const bf16_t* Qw, int q_ld, const bf16_t* K1, int k1_ld, const bf16_t* K2, int k2_ld,
                  const bf16_t* Vt, int vt_ld, int nkeys, bf16_t* Ow, int o_ld, char* smem) {
  constexpr int KS = DQK * 2 + 16;
  constexpr int KBYTES = 64 * KS;
  constexpr int VS = 144;
  constexpr int VBYTES = 64 * VS;
  constexpr int STAGE = KBYTES + VBYTES;
  constexpr int CPR = DQK / 8;
  constexpr int NKC = 64 * CPR / 256;
  constexpr int NS = DQK / 16;
  const int tid = otid(), lane = tid & 63, r = lane & 31, hh = lane >> 5;
  bf16x8 qf[NS];
#pragma unroll
  for (int s = 0; s < NS; ++s) qf[s] = *(const bf16x8*)(Qw + (size_t)r * q_ld + 16 * s + 8 * hh);
  f32x16 o[2];
#pragma unroll
  for (int n = 0; n < 2; ++n)
#pragma unroll
    for (int e = 0; e < 16; ++e) o[n][e] = 0.f;
  float m_run = 0.f, lsum = 0.f;
  u32x4 rk0[NKC], rv0[2], rk1[NKC], rv1[2];
  int krow_[NKC], kc_[NKC];
#pragma unroll
  for (int q = 0; q < NKC; ++q) { const int id = q * 256 + tid; krow_[q] = id / CPR; kc_[q] = id % CPR; }
  const int vrow = tid >> 3, vc = tid & 7;
  auto gload = [&](int key0, u32x4 (&rk)[NKC], u32x4 (&rv)[2]) {
#pragma unroll
    for (int q = 0; q < NKC; ++q) {
      const bf16_t* src = (DQK == 64 || kc_[q] < 8) ? K1 + (size_t)(key0 + krow_[q]) * k1_ld + kc_[q] * 8 : K2 + (size_t)(key0 + krow_[q]) * k2_ld + (kc_[q] - 8) * 8;
      rk[q] = *(const u32x4*)src;
    }
#pragma unroll
    for (int q = 0; q < 2; ++q) rv[q] = *(const u32x4*)(Vt + (size_t)(vrow + 32 * q) * vt_ld + key0 + vc * 8);
  };
  auto lstore = [&](int buf, u32x4 (&rk)[NKC], u32x4 (&rv)[2]) {
    char* base = smem + buf * STAGE;
#pragma unroll
    for (int q = 0; q < NKC; ++q) *(u32x4*)(base + krow_[q] * KS + kc_[q] * 16) = rk[q];
#pragma unroll
    for (int q = 0; q < 2; ++q) *(u32x4*)(base + KBYTES + (vrow + 32 * q) * VS + vc * 16) = rv[q];
  };
  const int ntl = nkeys >> 6;
  gload(0, rk0, rv0); lstore(0, rk0, rv0);
  gload(64, rk1, rv1);
  if (ntl > 2) gload(128, rk0, rv0);
  __syncthreads();
  auto tile_body = [&](int tl, u32x4 (&rkn)[NKC], u32x4 (&rvn)[2]) {
    const char* base = smem + (tl & 1) * STAGE;
    bf16x8 kf[2][NS], vf[2][2][2];
#pragma unroll
    for (int kb = 0; kb < 2; ++kb)
#pragma unroll
      for (int ks = 0; ks < NS; ++ks) kf[kb][ks] = *(const bf16x8*)(base + (kb * 32 + r) * KS + (2 * ks + hh) * 16);
    __builtin_amdgcn_sched_barrier(0);
    f32x16 s[2];
    const float ninit = -m_run;
#pragma unroll
    for (int kb = 0; kb < 2; ++kb)
#pragma unroll
      for (int e = 0; e < 16; ++e) s[kb][e] = ninit;
#pragma unroll
    for (int ks = 0; ks < NS; ++ks)
#pragma unroll
      for (int kb = 0; kb < 2; ++kb) s[kb] = MFMA32(kf[kb][ks], qf[ks], s[kb]);
#pragma unroll
    for (int kb = 0; kb < 2; ++kb)
#pragma unroll
      for (int s2 = 0; s2 < 2; ++s2)
#pragma unroll
        for (int n = 0; n < 2; ++n) vf[kb][s2][n] = *(const bf16x8*)(base + KBYTES + (32 * n + r) * VS + (kb * 32 + 16 * s2 + 8 * hh) * 2);
    __builtin_amdgcn_sched_barrier(0);
    float mx = s[0][0];
#pragma unroll
    for (int kb = 0; kb < 2; ++kb)
#pragma unroll
      for (int e = 0; e < 16; ++e) mx = fmaxf(mx, s[kb][e]);
    { const unsigned u = __float_as_uint(mx); auto sw = __builtin_amdgcn_permlane32_swap(u, u, false, false); mx = fmaxf(__uint_as_float(sw[0]), __uint_as_float(sw[1])); }
    const bool move = (mx > 4.0f) || (mx < -20.0f);
    if (__builtin_amdgcn_ballot_w64(move) != 0ull) {
      const float dlt = move ? mx : 0.f;
      const float alpha = __builtin_amdgcn_exp2f(-dlt);
      m_run += dlt;
      lsum *= alpha;
#pragma unroll
      for (int kb = 0; kb < 2; ++kb)
#pragma unroll
        for (int e = 0; e < 16; ++e) s[kb][e] -= dlt;
#pragma unroll
      for (int n = 0; n < 2; ++n)
#pragma unroll
        for (int e = 0; e < 16; ++e) o[n][e] *= alpha;
    }
    float ps = 0.f;
#pragma unroll
    for (int kb = 0; kb < 2; ++kb)
#pragma unroll
      for (int e = 0; e < 16; ++e) { const float pe = __builtin_amdgcn_exp2f(s[kb][e]); s[kb][e] = pe; ps += pe; }
    lsum += ps;
#pragma unroll
    for (int kb = 0; kb < 2; ++kb)
#pragma unroll
      for (int s2 = 0; s2 < 2; ++s2) {
        u32x4 pw;
        pw.x = pack2(s[kb][8 * s2 + 0], s[kb][8 * s2 + 1]); pw.y = pack2(s[kb][8 * s2 + 2], s[kb][8 * s2 + 3]);
        pw.z = pack2(s[kb][8 * s2 + 4], s[kb][8 * s2 + 5]); pw.w = pack2(s[kb][8 * s2 + 6], s[kb][8 * s2 + 7]);
        const bf16x8 pf = __builtin_bit_cast(bf16x8, pw);
#pragma unroll
        for (int n = 0; n < 2; ++n) o[n] = MFMA32(vf[kb][s2][n], pf, o[n]);
      }
    if (tl + 1 < ntl) { lstore((tl + 1) & 1, rkn, rvn); if (tl + 3 < ntl) gload((tl + 3) * 64, rkn, rvn); }
    __syncthreads();
  };
  for (int tl = 0; tl < ntl; tl += 2) { tile_body(tl, rk1, rv1); tile_body(tl + 1, rk0, rv0); }
  lsum = xsum32(lsum);
  const float inv = 1.0f / lsum;
#pragma unroll
  for (int n = 0; n < 2; ++n)
#pragma unroll
    for (int g = 0; g < 4; ++g) {
      u32x2 w; w.x = pack2(o[n][4 * g] * inv, o[n][4 * g + 1] * inv); w.y = pack2(o[n][4 * g + 2] * inv, o[n][4 * g + 3] * inv);
      *(u32x2*)(Ow + (size_t)r * o_ld + 32 * n + 8 * g + 4 * hh) = w;
    }
}

DI void scan_item(const Params& p, int l, int seq, int hd, int dir, int rs, char* smem) {
  const int tid = otid(), lane = tid & 63, wv = __builtin_amdgcn_readfirstlane(tid >> 6);
  const int j8 = lane & 7, r = lane & 31, hh = lane >> 5;
  const bool lat = seq >= 32;
  const int T = lat ? 4096 : 256;
  const int row0 = lat ? NCTX + (seq - 32) * 4096 : seq * 256;
  float* vA = (float*)smem; float* vK = vA + 2048; float* vR = vK + 2048; float* vV = vR + 2048; float* vW = vV + 2048; float* vB = vW + 2048; float* ybuf = vB + 2048;
  char* raw = smem + 32768;
  char* wdx = smem + 57344; char* adx = smem + 61952;
  float* tmpb = (float*)(smem + 66816);
  const bf16_t* U = (const bf16_t*)(p.ws + OFF_U);
  bf16_t* Y = (bf16_t*)(p.ws + OFF_R2) + (dir ? (size_t)NT * 512 : 0);
  float* bonus = (float*)(p.ws + OFF_BONUS);
  const int lrow = 8 * wv + (lane >> 3), irow = rs * 32 + lrow;
  f32x2 S[4];
  if (lat) {
    const float* s0 = (dir ? opq(p.in[I_SB]) : opq(p.in[I_SF])) + ((size_t)((seq - 32) * 4 + l) * 8 + hd) * 4096 + irow * 64 + j8 * 8;
#pragma unroll
    for (int q = 0; q < 2; ++q) { const f32x4 v = *(const f32x4*)(s0 + 4 * q); S[2 * q] = (f32x2){v.x, v.y}; S[2 * q + 1] = (f32x2){v.z, v.w}; }
  } else {
#pragma unroll
    for (int q = 0; q < 4; ++q) S[q] = (f32x2){0.f, 0.f};
  }
  const int mat = wv >> 1, ntc = wv & 1, cch = ntc * 32 + r, hc = hd * 64 + cch;
  bf16x8 bfrag[4];
  {
    const float* W = (mat ? opq(p.in[I_AUP]) : opq(p.in[I_WUP])) + (size_t)(l * 2 + dir) * 64 * 512 + hc;
#pragma unroll
    for (int s4 = 0; s4 < 4; ++s4) {
      float w8[8];
#pragma unroll
      for (int j = 0; j < 8; ++j) w8[j] = W[(size_t)(16 * s4 + 8 * hh + j) * 512];
      bfrag[s4] = __builtin_bit_cast(bf16x8, pack8(w8));
    }
  }
  const float bias = (mat ? opq(p.in[I_A0]) : opq(p.in[I_W0]))[(l * 2 + dir) * 512 + hc];
  const float kav = p.in[I_KA][l * 512 + hc], rkv = p.in[I_RK][l * 512 + hc];
  float* muP = (float*)(smem + 75008); float* muN = muP + 320; float* kkL = muN + 320;
  {
    const float* mup = p.in[I_MUP] + l * 1792; const float* mun = p.in[I_MUN] + l * 1792;
    for (int e = tid; e < 320; e += 256) { const int g = e >> 6, c = e & 63; const int col = (g < 3 ? g * 512 + hd * 64 : (g == 3 ? 1536 + dir * 64 : 1664 + dir * 64)) + c; muP[e] = mup[col]; muN[e] = mun[col]; }
    if (tid < 64) kkL[tid] = p.in[I_KK][l * 512 + hd * 64 + tid];
  }
  const int nch = T >> 5;
  u32x4 pre[6];
  auto prefetch = [&](int t0) {
#pragma unroll
    for (int q = 0; q < 6; ++q) {
      const int id = q * 256 + tid;
      const int row = id / 40, cc = id - row * 40, g = cc >> 3, c8 = cc & 7;
      const int t = t0 - 1 + row;
      const int col = (g < 3 ? g * 512 + hd * 64 : (g == 3 ? 1536 + dir * 64 : 1664 + dir * 64)) + c8 * 8;
      u32x4 v = (u32x4){0u, 0u, 0u, 0u};
      if (id < 1360 && t >= 0 && t < T) v = *(const u32x4*)(U + (size_t)(row0 + t) * ULD + 1696 + col);
      pre[q] = v;
    }
  };
  prefetch((dir ? nch - 1 : 0) * 32);
  for (int ci = 0; ci < nch; ++ci) {
    const int t0 = (dir ? nch - 1 - ci : ci) * 32;
#pragma unroll
    for (int q = 0; q < 6; ++q) { const int id = q * 256 + tid; if (id < 1360) *(u32x4*)(raw + id * 16) = pre[q]; }
    __syncthreads();
    if (ci + 1 < nch) prefetch((dir ? nch - 2 - ci : ci + 1) * 32);
    {
      const int tt = tid >> 3, sub = tid & 7;
#pragma unroll 1
      for (int g = 0; g < 5; ++g) {
        const int col = (g < 3 ? g * 512 + hd * 64 : (g == 3 ? 1536 + dir * 64 : 1664 + dir * 64)) + sub * 8;
        float c[8], pv[8], nx[8], x[8];
        unpack8(*(const u32x4*)(raw + (tt + 1) * 640 + (g * 8 + sub) * 16), c);
        unpack8(*(const u32x4*)(raw + tt * 640 + (g * 8 + sub) * 16), pv);
        unpack8(*(const u32x4*)(raw + (tt + 2) * 640 + (g * 8 + sub) * 16), nx);
        const f32x4 mp0 = *(const f32x4*)(muP + g * 64 + sub * 8), mp1 = *(const f32x4*)(muP + g * 64 + sub * 8 + 4), mn0 = *(const f32x4*)(muN + g * 64 + sub * 8), mn1 = *(const f32x4*)(muN + g * 64 + sub * 8 + 4);
        const float mp[8] = {mp0.x, mp0.y, mp0.z, mp0.w, mp1.x, mp1.y, mp1.z, mp1.w}, mn[8] = {mn0.x, mn0.y, mn0.z, mn0.w, mn1.x, mn1.y, mn1.z, mn1.w};
#pragma unroll
        for (int i = 0; i < 8; ++i) x[i] = c[i] + mp[i] * (pv[i] - c[i]) + mn[i] * (nx[i] - c[i]);
        const int lo = tt * 64 + sub * 8;
        if (g == 0) { *(f32x4*)(vR + lo) = (f32x4){x[0], x[1], x[2], x[3]}; *(f32x4*)(vR + lo + 4) = (f32x4){x[4], x[5], x[6], x[7]}; }
        else if (g == 1) {
          float kk[8], ss = 0.f;
          const float* kkw = kkL + sub * 8;
#pragma unroll
          for (int i = 0; i < 8; ++i) { kk[i] = x[i] * kkw[i]; ss += kk[i] * kk[i]; }
          *(f32x4*)(vK + lo) = (f32x4){x[0], x[1], x[2], x[3]}; *(f32x4*)(vK + lo + 4) = (f32x4){x[4], x[5], x[6], x[7]};
          ss += shx<1>(ss); ss += shx<2>(ss); ss += shx<4>(ss);
          const float inv = 1.0f / fmaxf(sqrtf(ss), 1e-12f);
          *(f32x4*)(vA + lo) = (f32x4){kk[0] * inv, kk[1] * inv, kk[2] * inv, kk[3] * inv}; *(f32x4*)(vA + lo + 4) = (f32x4){kk[4] * inv, kk[5] * inv, kk[6] * inv, kk[7] * inv};
        }
        else if (g == 2) { *(f32x4*)(vV + lo) = (f32x4){x[0], x[1], x[2], x[3]}; *(f32x4*)(vV + lo + 4) = (f32x4){x[4], x[5], x[6], x[7]}; }
        else if (g == 3) { float th[8]; for (int i = 0; i < 8; ++i) th[i] = 1.0f - 2.0f * __builtin_amdgcn_rcpf(1.0f + __expf(2.0f * x[i])); *(u32x4*)(wdx + tt * 144 + sub * 16) = pack8(th); }
        else { *(u32x4*)(adx + tt * 144 + sub * 16) = pack8(x); }
      }
    }
    __syncthreads();
    {
      f32x16 acc;
#pragma unroll
      for (int e = 0; e < 16; ++e) acc[e] = 0.f;
      const char* xb = mat ? adx : wdx;
#pragma unroll
      for (int s4 = 0; s4 < 4; ++s4) { const bf16x8 af = *(const bf16x8*)(xb + r * 144 + (16 * s4 + 8 * hh) * 2); acc = MFMA32(af, bfrag[s4], acc); }
      if (mat == 0) {
#pragma unroll
        for (int e = 0; e < 16; ++e) vW[crow(e, hh) * 64 + cch] = __expf(-0.6065306597126334f * sigmoidf_(bias + acc[e]));
      } else {
#pragma unroll
        for (int e = 0; e < 16; ++e) {
          const int ix = crow(e, hh) * 64 + cch;
          const float ag = sigmoidf_(bias + acc[e]);
          const float kk = vA[ix], k = vK[ix], rr = vR[ix];
          const float kd = k * (1.0f + (ag - 1.0f) * kav);
          vK[ix] = kd; vA[ix] = -kk; vB[ix] = kk * ag; tmpb[ix] = rr * kd * rkv;
        }
      }
    }
    __syncthreads();
    {
      const int tt = tid >> 3, sub = tid & 7;
      const f32x4 b0 = *(const f32x4*)(tmpb + tt * 64 + sub * 8), b1 = *(const f32x4*)(tmpb + tt * 64 + sub * 8 + 4);
      float bs = (b0.x + b0.y) + (b0.z + b0.w) + (b1.x + b1.y) + (b1.z + b1.w);
      bs += shx<1>(bs); bs += shx<2>(bs); bs += shx<4>(bs);
      if (sub == 0 && rs == 0) bonus[((size_t)(row0 + t0 + tt) * 8 + hd) * 2 + dir] = bs;
    }
    {
      f32x4 va[2], vw[2], vb[2], vk[2], vr[2]; float vi;
      int tt = dir ? 31 : 0;
      int vo = tt * 64 + j8 * 8;
#pragma unroll
      for (int q = 0; q < 2; ++q) { va[q] = *(const f32x4*)(vA + vo + 4 * q); vw[q] = *(const f32x4*)(vW + vo + 4 * q); vb[q] = *(const f32x4*)(vB + vo + 4 * q); vk[q] = *(const f32x4*)(vK + vo + 4 * q); vr[q] = *(const f32x4*)(vR + vo + 4 * q); }
      vi = vV[tt * 64 + irow];
      for (int si = 0; si < 32; ++si) {
        const int ttn = dir ? (si < 31 ? 30 - si : 0) : (si < 31 ? si + 1 : 31);
        const int von = ttn * 64 + j8 * 8;
        f32x2 pa2 = S[0] * (f32x2){va[0].x, va[0].y}, pa3 = S[1] * (f32x2){va[0].z, va[0].w};
        pa2 += S[2] * (f32x2){va[1].x, va[1].y}; pa3 += S[3] * (f32x2){va[1].z, va[1].w};
#pragma unroll
        for (int q = 0; q < 2; ++q) va[q] = *(const f32x4*)(vA + von + 4 * q);
        pa2 += pa3;
        const float sa = osum(pa2.x + pa2.y);
        const f32x2 sa2 = (f32x2){sa, sa}, vi2 = (f32x2){vi, vi};
        f32x2 py2, py3;
        S[0] = S[0] * (f32x2){vw[0].x, vw[0].y} + (sa2 * (f32x2){vb[0].x, vb[0].y} + vi2 * (f32x2){vk[0].x, vk[0].y}); py2 = S[0] * (f32x2){vr[0].x, vr[0].y};
        S[1] = S[1] * (f32x2){vw[0].z, vw[0].w} + (sa2 * (f32x2){vb[0].z, vb[0].w} + vi2 * (f32x2){vk[0].z, vk[0].w}); py3 = S[1] * (f32x2){vr[0].z, vr[0].w};
        S[2] = S[2] * (f32x2){vw[1].x, vw[1].y} + (sa2 * (f32x2){vb[1].x, vb[1].y} + vi2 * (f32x2){vk[1].x, vk[1].y}); py2 += S[2] * (f32x2){vr[1].x, vr[1].y};
        S[3] = S[3] * (f32x2){vw[1].z, vw[1].w} + (sa2 * (f32x2){vb[1].z, vb[1].w} + vi2 * (f32x2){vk[1].z, vk[1].w}); py3 += S[3] * (f32x2){vr[1].z, vr[1].w};
#pragma unroll
        for (int q = 0; q < 2; ++q) { vw[q] = *(const f32x4*)(vW + von + 4 * q); vb[q] = *(const f32x4*)(vB + von + 4 * q); vk[q] = *(const f32x4*)(vK + von + 4 * q); vr[q] = *(const f32x4*)(vR + von + 4 * q); }
        vi = vV[ttn * 64 + irow];
        py2 += py3;
        const float py = osum(py2.x + py2.y);
        ybuf[tt * 32 + lrow] = py;
        tt = ttn;
      }
    }
    __syncthreads();
    {
      const int tt = tid >> 3, sub = tid & 7;
      const f32x4 y0 = *(const f32x4*)(ybuf + tt * 32 + sub * 4);
      u32x2 w; w.x = pack2(y0.x, y0.y); w.y = pack2(y0.z, y0.w);
      *(u32x2*)(Y + (size_t)(row0 + t0 + tt) * 512 + hd * 64 + rs * 32 + sub * 4) = w;
    }
    __syncthreads();
  }
  if (!lat) {
    float* o = opq(p.out) + (dir ? OUT_SB : OUT_SF) + ((size_t)(seq * 4 + l) * 8 + hd) * 4096 + irow * 64 + j8 * 8;
#pragma unroll
    for (int q = 0; q < 2; ++q) *(f32x4*)(o + 4 * q) = (f32x4){S[2 * q].x, S[2 * q].y, S[2 * q + 1].x, S[2 * q + 1].y};
  }
}

DI void phase_mixers(const Params& p, int l, char* smem, int part = 0) {
  const int tid = otid(), wid = __builtin_amdgcn_readfirstlane(tid >> 6);
  unsigned* cnt = (unsigned*)(p.ws + OFF_CNT) + l * 8;
  int* slot = (int*)(smem + SMEM_BYTES - 16);
  bf16_t* U = (bf16_t*)(p.ws + OFF_U);
  const bf16_t* KA = (const bf16_t*)(p.ws + OFF_KA); const bf16_t* VAT = (const bf16_t*)(p.ws + OFF_VAT);
  const bf16_t* KN = (const bf16_t*)(p.ws + OFF_KN); const bf16_t* VBT = (const bf16_t*)(p.ws + OFF_VBT); const bf16_t* KRB = (const bf16_t*)(p.ws + OFF_KRB);
  const int QLEN = 256 + 256 + 128 + 64 + 64;
  bool first = true;
  int xq = blockIdx.x & 7, tries = 0;
  for (;;) {
    int kind, seq, a, qt;
    if (first && blockIdx.x < 256) {
      const int item = blockIdx.x; kind = 0; seq = 32 + (item >> 5); a = (item >> 2) & 7; qt = item & 3;
      first = false;
    } else {
      first = false;
      if (tid == 0) *slot = (int)atomicAdd(cnt + xq, 1u);
      __syncthreads();
      const int i = __builtin_amdgcn_readfirstlane(*slot);
      __syncthreads();
      if (i >= QLEN) { if (++tries >= 8) break; xq = (xq + 1) & 7; continue; }
      if (i < 256) { const int g = xq + 8 * (i >> 7); kind = 1; seq = 32 + (g >> 1); a = g & 1; qt = i & 127; }
      else if (i < 512) { const int j = i - 256; const int g = xq + 8 * (j >> 5); kind = 2; seq = 32 + (g >> 3); a = g & 7; qt = j & 31; }
      else if (i < 640) { const int j = i - 512; kind = 0; seq = xq + 8 * (j >> 5); a = (j >> 2) & 7; qt = j & 3; }
      else if (i < 704) { const int j = i - 640; kind = 1; seq = xq + 8 * (j >> 4); a = (j >> 3) & 1; qt = j & 7; }
      else { const int j = i - 704; kind = 2; seq = xq + 8 * (j >> 4); a = (j >> 1) & 7; qt = j & 1; }
    }
    const int kr0 = keyrow0(seq), Tk = seq_tk(seq);
    const int row0 = seq < 32 ? seq * 256 : NCTX + (seq - 32) * 4096;
    if (kind == 0) scan_item(p, l, seq, a, qt & 1, qt >> 1, smem);
    else if (kind == 1) {
      const int qh = a * 4 + wid;
      bf16_t* q = U + (size_t)(row0 + qt * 32) * ULD + qh * 64;
      attn_item<64>(q, ULD, KA + (size_t)kr0 * 128 + a * 64, 128, nullptr, 0, VAT + (size_t)128 * kr0 + (size_t)(a * 64) * Tk, Tk, Tk, q, ULD, smem);
    } else {
      bf16_t* q = U + (size_t)(row0 + qt * 128 + wid * 32) * ULD + 768 + a * 96;
      attn_item<96>(q, ULD, KN + (size_t)kr0 * 512 + a * 64, 512, KRB + (size_t)kr0 * 32, 32, VBT + (size_t)512 * kr0 + (size_t)(a * 64) * Tk, Tk, Tk, q, ULD, smem);
    }
  }
}

struct CpostIn { u32x4 yf, yb, c, pv, nx; f32x2 bs; };
DI void cpost_load(const Params& p, int row, int lane, CpostIn& in) {
  int seq, t; row_decode(row, seq, t);
  const int T = seq < 32 ? 256 : 4096;
  const bf16_t* YF = (const bf16_t*)(p.ws + OFF_R2); const bf16_t* YB = YF + (size_t)NT * 512;
  const bf16_t* u = (const bf16_t*)(p.ws + OFF_U) + (size_t)row * ULD + 1696;
  const float* bonus = (const float*)(p.ws + OFF_BONUS);
  const int col = 1024 + lane * 8;
  const u32x4 z4 = (u32x4){0u, 0u, 0u, 0u};
  in.yf = *(const u32x4*)(YF + (size_t)row * 512 + lane * 8);
  in.yb = *(const u32x4*)(YB + (size_t)row * 512 + lane * 8);
  in.c = *(const u32x4*)(u + col);
  in.pv = t > 0 ? *(const u32x4*)(u - ULD + col) : z4;
  in.nx = t < T - 1 ? *(const u32x4*)(u + ULD + col) : z4;
  in.bs = *(const f32x2*)(bonus + ((size_t)row * 8 + (lane >> 3)) * 2);
}
DI void cpost_finish(const Params& p, int l, int row, int lane, const CpostIn& in) {
  bf16_t* u = (bf16_t*)(p.ws + OFF_U) + (size_t)row * ULD + 1696;
  float yf[8], yb[8], y[8];
  unpack8(in.yf, yf); unpack8(in.yb, yb);
  float s = 0.f;
#pragma unroll
  for (int i = 0; i < 8; ++i) { y[i] = yf[i] + yb[i]; s += y[i]; }
  s += shx<1>(s); s += shx<2>(s); s += shx<4>(s);
  const float mu = s * (1.0f / 64.0f);
  float q = 0.f;
#pragma unroll
  for (int i = 0; i < 8; ++i) { y[i] -= mu; q += y[i] * y[i]; }
  q += shx<1>(q); q += shx<2>(q); q += shx<4>(q);
  const float rs = rsqrtf(q * (1.0f / 64.0f) + 64e-5f);
  const int col = 1024 + lane * 8;
  float c[8], pv[8], nx[8];
  unpack8(in.c, c); unpack8(in.pv, pv); unpack8(in.nx, nx);
  const float* mup = p.in[I_MUP] + l * 1792 + col; const float* mun = p.in[I_MUN] + l * 1792 + col;
  const float* lw = p.in[I_LNW] + l * 512 + lane * 8; const float* lb = p.in[I_LNB] + l * 512 + lane * 8;
  const float bs = in.bs.x + in.bs.y;
  float o[8];
#pragma unroll
  for (int i = 0; i < 8; ++i) { const float v = c[i] + mup[i] * (pv[i] - c[i]) + mun[i] * (nx[i] - c[i]); o[i] = y[i] * rs * lw[i] + lb[i] + bs * v; }
  *(u32x4*)(u + lane * 8) = pack8(o);
}
DI void phase_renorm_cpost(const Params& p, int l) {
  const int lane = otid() & 63, wid = __builtin_amdgcn_readfirstlane(otid() >> 6);
  for (int item = blockIdx.x; item < NT / 8; item += gridDim.x) { const int ra = item * 8 + wid, rb = ra + 4; CpostIn ia, ib; cpost_load(p, ra, lane, ia); cpost_load(p, rb, lane, ib); norm_rows2(p, l, ra, rb, lane); cpost_finish(p, l, ra, lane, ia); cpost_finish(p, l, rb, lane, ib); }
}

DI void phase_zgemm(const Params& p, char* smem) {
  const bf16_t* H = (const bf16_t*)(p.ws + OFF_R1);
  const bf16_t* W = (const bf16_t*)(p.ws + OFF_WIN) + (size_t)3584 * 1024;
  bf16_t* U = (bf16_t*)(p.ws + OFF_U);
  const int ntiles = 320 * 12;
  for (int it = 0;; ++it) {
    int mt, nt; if (!next_tile(it, 12, 6, mt, nt)) break;
    const int m0 = mt * 128, n0 = nt * 128;
    f32x16 acc[2][2]; zero_acc<2>(acc);
    gemm_mainloop<2>(acc, H + (size_t)m0 * 1024, 1024, 64, W + (size_t)n0 * 1024, 1024, 1024, smem);
    const int lane = otid() & 63, wid = __builtin_amdgcn_readfirstlane(otid() >> 6), wm = wid >> 1, wn = wid & 1, r = lane & 31, hh = lane >> 5;
    bf16_t yv[2][2][16];
    int ucolj[2];
#pragma unroll
    for (int j = 0; j < 2; ++j) {
      const int col = n0 + wn * 64 + j * 32 + r;
      const int br = col >> 9, cc = col & 511;
      ucolj[j] = br == 0 ? cc : (br == 1 ? 768 + (cc >> 6) * 96 + (cc & 63) : 1696 + cc);
#pragma unroll
      for (int i = 0; i < 2; ++i) {
        const bf16_t* up = U + (size_t)(m0 + wm * 64 + i * 32) * ULD;
        const int lo = 4 * hh * ULD + ucolj[j];
#pragma unroll
        for (int e = 0; e < 16; ++e) yv[j][i][e] = (up + crowu(e) * ULD)[lo];
      }
    }
#pragma unroll
    for (int j = 0; j < 2; ++j)
#pragma unroll
      for (int i = 0; i < 2; ++i) {
        bf16_t* up = U + (size_t)(m0 + wm * 64 + i * 32) * ULD;
        const int lo = 4 * hh * ULD + ucolj[j];
#pragma unroll
        for (int e = 0; e < 16; ++e) (up + crowu(e) * ULD)[lo] = f2bf(bf2f(yv[j][i][e]) * siluf_(acc[i][j][e]));
      }
  }
}

DI void phase_merge(const Params& p, char* smem) {
  const bf16_t* H = (const bf16_t*)(p.ws + OFF_R1);
  const bf16_t* WG = (const bf16_t*)(p.ws + OFF_WIN) + (size_t)5120 * 1024;
  const bf16_t* WO = (const bf16_t*)(p.ws + OFF_WO);
  const bf16_t* U = (const bf16_t*)(p.ws + OFF_U);
  bf16_t* MX = (bf16_t*)(p.ws + OFF_R2);
  const int ntiles = 320 * 8;
  for (int it = 0;; ++it) {
    int mt, nt; if (!next_tile(it, 8, 8, mt, nt)) break;
    const int m0 = mt * 128, n0 = nt * 128;
    f32x16 mix[2][2]; zero_acc<2>(mix);
    unsigned gs[2][2][8];
#pragma unroll 1
    for (int step = 0; step < 6; ++step) {
      const int br = step >> 1, isT = step & 1;
      const int acol = br == 0 ? 0 : (br == 1 ? 768 : 1696);
      const bf16_t* Ap = isT ? U + (size_t)m0 * ULD + acol : H + (size_t)m0 * 1024;
      const bf16_t* Bp = isT ? WO + (size_t)(br * 1024 + n0) * 512 : WG + (size_t)(br * 1024 + n0) * 1024;
      f32x16 cur[2][2]; zero_acc<2>(cur);
      gemm_mainloop<2>(cur, Ap, isT ? ULD : 1024, (isT && br == 1) ? 96 : 64, Bp, isT ? 512 : 1024, isT ? 512 : 1024, smem);
      if (isT) {
#pragma unroll
        for (int i = 0; i < 2; ++i)
#pragma unroll
          for (int j = 0; j < 2; ++j)
#pragma unroll
            for (int e = 0; e < 8; ++e) { mix[i][j][2 * e] += lo16(gs[i][j][e]) * cur[i][j][2 * e]; mix[i][j][2 * e + 1] += hi16(gs[i][j][e]) * cur[i][j][2 * e + 1]; }
      } else {
#pragma unroll
        for (int i = 0; i < 2; ++i)
#pragma unroll
          for (int j = 0; j < 2; ++j)
#pragma unroll
            for (int e = 0; e < 8; ++e) gs[i][j][e] = pack2(sigmoidf_(cur[i][j][2 * e]), sigmoidf_(cur[i][j][2 * e + 1]));
      }
    }
    const int lane = otid() & 63, wid = __builtin_amdgcn_readfirstlane(otid() >> 6), wm = wid >> 1, wn = wid & 1, r = lane & 31, hh = lane >> 5;
#pragma unroll
    for (int j = 0; j < 2; ++j) {
      const int col = n0 + wn * 64 + j * 32 + r;
#pragma unroll
      for (int i = 0; i < 2; ++i) {
        bf16_t* mp = MX + (size_t)(m0 + wm * 64 + i * 32) * 1024;
        const int lo = 4 * hh * 1024 + col;
#pragma unroll
        for (int e = 0; e < 16; ++e) (mp + crowu(e) * 1024)[lo] = f2bf(mix[i][j][e]);
      }
    }
  }
}

DI void phase_out(const Params& p, int l, char* smem) {
  const bf16_t* MX = (const bf16_t*)(p.ws + OFF_R2);
  const bf16_t* W = (const bf16_t*)(p.ws + OFF_WOUT);
  const int ntiles = 320 * 8;
  for (int it = 0;; ++it) {
    int mt, nt; if (!next_tile(it, 8, 8, mt, nt)) break;
    const int m0 = mt * 128, n0 = nt * 128;
    const int lane = otid() & 63, wid = __builtin_amdgcn_readfirstlane(otid() >> 6), wm = wid >> 1, wn = wid & 1, r = lane & 31, hh = lane >> 5;
    const int jm = m0 < NCTX ? 0 : 1 + ((m0 - NCTX) >> 12);
    const float* gate = (const float*)(p.ws + OFF_MOD) + ((size_t)l * 9 + jm) * MODLD + 2048;
    const float* xsrc = x_row_ptr(p, l, m0);
    float xv[2][2][16];
#pragma unroll
    for (int j = 0; j < 2; ++j) {
      const int lo = 4 * hh * 1024 + n0 + wn * 64 + j * 32 + r;
#pragma unroll
      for (int i = 0; i < 2; ++i) {
        const float* xs = xsrc + (size_t)(wm * 64 + i * 32) * 1024;
#pragma unroll
        for (int e = 0; e < 16; ++e) xv[j][i][e] = (xs + crowu(e) * 1024)[lo];
      }
    }
    f32x16 acc[2][2]; zero_acc<2>(acc);
    gemm_mainloop<2>(acc, MX + (size_t)m0 * 1024, 1024, 64, W + (size_t)n0 * 1024, 1024, 1024, smem);
#pragma unroll
    for (int j = 0; j < 2; ++j) {
      const int col = n0 + wn * 64 + j * 32 + r;
      const float gv = gate[col];
      const int lo = 4 * hh * 1024 + col;
#pragma unroll
      for (int i = 0; i < 2; ++i) {
        float* xo = p.out + (size_t)(m0 + wm * 64 + i * 32) * 1024;
#pragma unroll
        for (int e = 0; e < 16; ++e) (xo + crowu(e) * 1024)[lo] = xv[j][i][e] + gv * acc[i][j][e];
      }
    }
  }
}

DI void phase_final(const Params& p) {
  const int lane = otid() & 63, wid = __builtin_amdgcn_readfirstlane(otid() >> 6);
  const float* nw = p.in[I_FNW];
  for (int item = blockIdx.x; item < NT / 8; item += gridDim.x) {
    float* xa = p.out + (size_t)(item * 8 + wid) * 1024;
    float* xb = xa + 4 * 1024;
    f32x4 va[4], vb[4];
#pragma unroll
    for (int i = 0; i < 4; ++i) va[i] = *(const f32x4*)(xa + lane * 4 + 256 * i);
#pragma unroll
    for (int i = 0; i < 4; ++i) vb[i] = *(const f32x4*)(xb + lane * 4 + 256 * i);
    float sa = 0.f, sb = 0.f;
#pragma unroll
    for (int i = 0; i < 4; ++i) { sa += va[i].x * va[i].x + va[i].y * va[i].y + va[i].z * va[i].z + va[i].w * va[i].w; sb += vb[i].x * vb[i].x + vb[i].y * vb[i].y + vb[i].z * vb[i].z + vb[i].w * vb[i].w; }
    sa = wave_sum(sa); sb = wave_sum(sb);
    const float ra = rsqrtf(sa * (1.0f / 1024.0f) + 1e-6f), rb = rsqrtf(sb * (1.0f / 1024.0f) + 1e-6f);
#pragma unroll
    for (int i = 0; i < 4; ++i) {
      const f32x4 w = *(const f32x4*)(nw + lane * 4 + 256 * i);
      *(f32x4*)(xa + lane * 4 + 256 * i) = (f32x4){va[i].x * ra * w.x, va[i].y * ra * w.y, va[i].z * ra * w.z, va[i].w * ra * w.w};
      *(f32x4*)(xb + lane * 4 + 256 * i) = (f32x4){vb[i].x * rb * w.x, vb[i].y * rb * w.y, vb[i].z * rb * w.z, vb[i].w * rb * w.w};
    }
  }
}

DI void grid_barrier(unsigned* bar, unsigned& epoch) {
  epoch += 1u;
  __syncthreads();
  if (otid() == 0) {
    const unsigned grp = blockIdx.x & 7u, per = gridDim.x >> 3;
    __builtin_amdgcn_fence(__ATOMIC_RELEASE, "agent");
    const unsigned old = __hip_atomic_fetch_add(bar + grp * 32, 1u, __ATOMIC_RELAXED, __HIP_MEMORY_SCOPE_AGENT);
    if (old + 1u == epoch * per) __hip_atomic_fetch_add(bar + 8 * 32, 1u, __ATOMIC_RELAXED, __HIP_MEMORY_SCOPE_AGENT);
    while (__hip_atomic_load(bar + 8 * 32, __ATOMIC_RELAXED, __HIP_MEMORY_SCOPE_AGENT) < epoch * 8u) __builtin_amdgcn_s_sleep(1);
    __builtin_amdgcn_fence(__ATOMIC_ACQUIRE, "agent");
  }
  __syncthreads();
}

constexpr int NPHASES = 1 + 4 * 9 + 1;
__global__ void __launch_bounds__(256, 2) fwd_kernel(Params p0) {
  __shared__ __attribute__((aligned(16))) char smem[SMEM_BYTES];
  cg::grid_group grid = cg::this_grid();
  const int ph_begin = p0.ph_begin, ph_end = p0.ph_end;
  unsigned* bar = (unsigned*)(p0.ws + OFF_BAR);
  unsigned epoch = 0u;
  for (int ph = ph_begin; ph < ph_end; ++ph) {
    auto kp = __builtin_amdgcn_kernarg_segment_ptr();
    asm volatile("" : "+s"(kp));
    typedef const __attribute__((address_space(4))) Params CParams;
    CParams* kpp = (CParams*)kp;
    Params p;
#pragma unroll
    for (int i = 0; i < 35; ++i) p.in[i] = kpp->in[i];
    p.out = kpp->out; p.ws = kpp->ws; p.ph_begin = ph_begin; p.ph_end = ph_end;
    if (ph == 0) phase_prologue(p, smem);
    else if (ph == NPHASES - 1) phase_final(p);
    else {
      const int l = (ph - 1) / 9, sp = (ph - 1) % 9;
#ifdef PROBE_SP
      if (sp == PROBE_SP) {
        switch (sp) {
          case 0: phase_norm_convert(p, l, smem); break;
          case 1: phase_gemm1(p, l, smem); break;
          case 3: phase_upproj(p, smem); break;
          case 5: phase_renorm_cpost(p, l); break;
          case 7: phase_merge(p, smem); break;
          default: break;
        }
        grid.sync();
      }
#endif
      switch (sp) {
        case 0: phase_norm_convert(p, l, smem); break;
        case 1: phase_gemm1(p, l, smem); break;
        case 2: phase_post(p, l); break;
        case 3: phase_upproj(p, smem); break;
        case 4: phase_mixers(p, l, smem); break;
        case 5: phase_renorm_cpost(p, l); break;
        case 6: phase_zgemm(p, smem); break;
        case 7: phase_merge(p, smem); break;
        default: phase_out(p, l, smem); break;
      }
    }
    if (ph + 1 < ph_end) { if (ph == 0) grid.sync(); else grid_barrier(bar, epoch); }
  }
}

extern "C" void kernel_launch(void* const* d_in, const int* in_sizes, int n_in, void* d_out, int out_size, void* d_ws, size_t ws_size, hipStream_t stream) {
  if (ws_size < WS_NEED || n_in < 35) { fprintf(stderr, "workspace too small: %zu < %zu\n", ws_size, WS_NEED); return; }
  static int grid_blocks = 0;
  if (!grid_blocks) {
    int dev = 0, cus = 0, per_cu = 0;
    hipGetDevice(&dev);
    hipDeviceGetAttribute(&cus, hipDeviceAttributeMultiprocessorCount, dev);
    hipOccupancyMaxActiveBlocksPerMultiprocessor(&per_cu, fwd_kernel, 256, 0);
    if (per_cu < 1) per_cu = 1;
    if (per_cu > 2) per_cu = 2;
    grid_blocks = cus * per_cu;
  }
  Params p{};
  for (int i = 0; i < 35; ++i) p.in[i] = (const float*)d_in[i];
  p.out = (float*)d_out; p.ws = (char*)d_ws;
#ifndef ONE_LAUNCH
  for (int ph = 0; ph < NPHASES; ++ph) {
    p.ph_begin = ph; p.ph_end = ph + 1;
    hipLaunchKernelGGL(fwd_kernel, dim3(grid_blocks), dim3(256), 0, stream, p);
  }
#else
  p.ph_begin = 0; p.ph_end = NPHASES;
  hipMemsetAsync((char*)d_ws + OFF_BAR, 0, 4096, stream);
  void* args[] = {&p};
  hipError_t e = hipLaunchCooperativeKernel((void*)fwd_kernel, dim3(grid_blocks), dim3(256), args, 0, stream);
  if (e != hipSuccess) fprintf(stderr, "cooperative launch failed: %s (grid %d)\n", hipGetErrorString(e), grid_blocks);
#endif
}
```
